# Optimizing an MI355X kernel written in HIP

```python
import jax, jax.numpy as jnp
from jax import lax
import numpy as np

D_MODEL = 4096
BATCH = 1
SEQ = 8192
DEPTH = 1

CTX_LEN = 256
GRID_W = 64
D_RWKV = D_MODEL // 2
D_CONV = D_MODEL - D_RWKV
HEAD_SIZE = 64
N_HEADS_RWKV = D_RWKV // HEAD_SIZE
DECAY_LORA = 96
ICLR_LORA = 96
GATE_LORA = 256
D_FF = -(-8 * D_MODEL // (3 * 256)) * 256

OFF_K = 0
OFF_V = OFF_K + D_RWKV
OFF_WL = OFF_V + D_RWKV
OFF_AL = OFF_WL + DECAY_LORA
STATE_COLS = OFF_AL + ICLR_LORA
OFF_R = STATE_COLS
OFF_GL = OFF_R + D_RWKV
RWKV_COLS = OFF_GL + GATE_LORA
IN_COLS = RWKV_COLS + 3 * D_CONV

NORM_EPS = 1e-6
LNX_EPS = 64e-5

kernel_name = "hybrid_rwkv7_shortconv_dit_block"


def _rmsnorm(x, gain):
    xf = x.astype(jnp.float32)
    y = xf * lax.rsqrt(jnp.mean(xf * xf, axis=-1, keepdims=True) + NORM_EPS)
    return (y * gain.astype(jnp.float32)).astype(x.dtype)


def _modulate(h, shift, scale):
    return h * (1 + scale) + shift


def _neighbours(z, n_rows, row_len):
    b, t, ch = z.shape
    zr = z.reshape(b, n_rows, row_len, ch)
    prev = jnp.pad(zr[:, :, :-1], ((0, 0), (0, 0), (1, 0), (0, 0))).reshape(b, t, ch)
    nxt = jnp.pad(zr[:, :, 1:], ((0, 0), (0, 0), (0, 1), (0, 0))).reshape(b, t, ch)
    return prev, nxt


def _token_shift(z, mu, n_rows, row_len):
    prev, nxt = _neighbours(z, n_rows, row_len)
    return z + mu * (0.5 * (prev + nxt) - z)


def _short_conv(u, w, n_rows, row_len):
    prev, nxt = _neighbours(u, n_rows, row_len)
    return w[0] * prev + w[1] * u + w[2] * nxt


def _split_heads(t):
    b, s, _ = t.shape
    return t.reshape(b, s, N_HEADS_RWKV, HEAD_SIZE)


def _state_inputs(za, k_k, k_a, w0, w_decay_up, a0, w_iclr_up):
    f32 = jnp.float32
    k = za[..., OFF_K:OFF_V].astype(f32)
    v = _split_heads(za[..., OFF_V:OFF_WL].astype(f32))
    wl = jnp.tanh(za[..., OFF_WL:OFF_AL].astype(f32))
    al = za[..., OFF_AL:STATE_COLS].astype(f32)
    kk = _split_heads(k * k_k.astype(f32))
    kk = kk / jnp.maximum(jnp.sqrt(jnp.sum(kk * kk, axis=-1, keepdims=True)), 1e-12)
    k_a = k_a.astype(f32)
    dirs = []
    for d in range(2):
        w_log = -jax.nn.softplus(-(w0[d].astype(f32) + wl @ w_decay_up[d].astype(f32))) - 0.5
        decay = jnp.exp(-jnp.exp(w_log))
        a = jax.nn.sigmoid(a0[d].astype(f32) + al @ w_iclr_up[d].astype(f32))
        k_d = k * (1 + (a - 1) * k_a)
        dirs.append((_split_heads(decay), _split_heads(k_d), _split_heads(a)))
    return v, kk, dirs


def _wkv_scan(state0, decay, k, v, kk, a, r, reverse):
    tm = lambda t: jnp.moveaxis(t, 1, 0)
    xs = (tm(decay), tm(k), tm(v), tm(-kk), tm(kk * a))
    if r is not None:
        xs = xs + (tm(r),)

    def step(s, inp):
        w_t, k_t, v_t, a_t, b_t = inp[:5]
        sa = jnp.einsum("bhvk,bhk->bhv", s, a_t)
        s = s * w_t[:, :, None, :] + sa[..., None] * b_t[:, :, None, :] + v_t[..., None] * k_t[:, :, None, :]
        y = jnp.einsum("bhvk,bhk->bhv", s, inp[5]) if len(inp) == 6 else None
        return s, y

    s_final, ys = lax.scan(step, state0, xs, reverse=reverse)
    return s_final, (None if r is None else jnp.moveaxis(ys, 0, 1))


def _rwkv_readout(za, r, ys, ks, v, r_k, lnx_w, lnx_b, w_gate_up):
    f32 = jnp.float32
    b, t = za.shape[:2]
    y = ys[0] + ys[1]
    mu = jnp.mean(y, axis=-1, keepdims=True)
    var = jnp.mean(jnp.square(y - mu), axis=-1, keepdims=True)
    y = ((y - mu) * lax.rsqrt(var + LNX_EPS)).reshape(b, t, D_RWKV) * lnx_w.astype(f32) + lnx_b.astype(f32)
    rk = r_k.astype(f32)
    bonus = jnp.sum(r * ks[0] * rk, axis=-1, keepdims=True) * v + jnp.sum(r * ks[1] * rk, axis=-1, keepdims=True) * v
    y = y + bonus.reshape(b, t, D_RWKV)
    g = jax.nn.sigmoid(za[..., OFF_GL:RWKV_COLS].astype(f32)) @ w_gate_up.astype(f32)
    return y * g


def _swiglu(h, w_gate, w_up, w_down):
    return (jax.nn.silu(h @ w_gate) * (h @ w_up)) @ w_down


def setup_inputs(seed: int = 0) -> dict:
    key = jax.random.key(seed)
    ks = jax.random.split(key, 32)
    f = jnp.float32
    L = DEPTH
    nrm = lambda k, shape, s: jax.random.normal(k, shape, f) * s
    return {
        "x": nrm(ks[0], (BATCH, SEQ, D_MODEL), 1.0),
        "c": nrm(ks[1], (BATCH, D_MODEL), 1.0),
        "ctx": nrm(ks[2], (BATCH, CTX_LEN, D_MODEL), 1.0),
        "c_ctx": nrm(ks[3], (D_MODEL,), 1.0),
        "w_ada": nrm(ks[4], (L, D_MODEL, 6 * D_MODEL), 0.5 * D_MODEL ** -0.5),
        "b_ada": nrm(ks[5], (L, 6 * D_MODEL), 0.02),
        "norm1": 1.0 + nrm(ks[6], (L, D_MODEL), 0.02),
        "w_in": nrm(ks[7], (L, D_MODEL, IN_COLS), D_MODEL ** -0.5),
        "mu_shift": jax.random.uniform(ks[8], (L, RWKV_COLS), f),
        "k_k": 0.85 + nrm(ks[9], (L, D_RWKV), 0.02),
        "k_a": 1.0 + nrm(ks[10], (L, D_RWKV), 0.02),
        "r_k": nrm(ks[11], (L, N_HEADS_RWKV, HEAD_SIZE), 0.1),
        "w0": nrm(ks[12], (L, 2, D_RWKV), 0.5),
        "w_decay_up": nrm(ks[13], (L, 2, DECAY_LORA, D_RWKV), 0.5 * DECAY_LORA ** -0.5),
        "a0": nrm(ks[14], (L, 2, D_RWKV), 0.1),
        "w_iclr_up": nrm(ks[15], (L, 2, ICLR_LORA, D_RWKV), 0.5 * ICLR_LORA ** -0.5),
        "w_gate_up": nrm(ks[16], (L, GATE_LORA, D_RWKV), GATE_LORA ** -0.5),
        "lnx_w": 1.0 + nrm(ks[17], (L, D_RWKV), 0.02),
        "lnx_b": nrm(ks[18], (L, D_RWKV), 0.02),
        "conv_w": nrm(ks[19], (L, 3, D_CONV), 3 ** -0.5),
        "w_out": nrm(ks[20], (L, D_MODEL, D_MODEL), D_MODEL ** -0.5),
        "norm2": 1.0 + nrm(ks[21], (L, D_MODEL), 0.02),
        "w_ffn_gate": nrm(ks[22], (L, D_MODEL, D_FF), D_MODEL ** -0.5),
        "w_ffn_up": nrm(ks[23], (L, D_MODEL, D_FF), D_MODEL ** -0.5),
        "w_ffn_down": nrm(ks[24], (L, D_FF, D_MODEL), D_FF ** -0.5),
        "norm_f": 1.0 + nrm(ks[25], (D_MODEL,), 0.02),
    }


def reference(x, c, ctx, c_ctx, w_ada, b_ada, norm1, w_in, mu_shift, k_k, k_a, r_k, w0, w_decay_up, a0,
              w_iclr_up, w_gate_up, lnx_w, lnx_b, conv_w, w_out, norm2, w_ffn_gate, w_ffn_up, w_ffn_down, norm_f):
    dt = x.dtype
    b = x.shape[0]
    rows = x.shape[1] // GRID_W
    ctx_len = ctx.shape[1]
    silu_c = jax.nn.silu(c)
    silu_cc = jax.nn.silu(c_ctx)[None, :]
    for i in range(DEPTH):
        last = i == DEPTH - 1
        mod = (silu_c @ w_ada[i] + b_ada[i])[:, None, :]
        mod_c = (silu_cc @ w_ada[i] + b_ada[i])[:, None, :]
        sh1, sc1, g1, sh2, sc2, g2 = jnp.split(mod, 6, axis=-1)
        csh1, csc1, cg1, csh2, csc2, cg2 = jnp.split(mod_c, 6, axis=-1)

        h = _modulate(_rmsnorm(x, norm1[i]), sh1, sc1)
        hc = _modulate(_rmsnorm(ctx, norm1[i]), csh1, csc1)
        z = h @ w_in[i]
        zc = hc @ (w_in[i][:, :STATE_COLS] if last else w_in[i])
        za = _token_shift(z[..., :RWKV_COLS], mu_shift[i], rows, GRID_W)
        n_ca = min(zc.shape[-1], RWKV_COLS)
        zca = _token_shift(zc[..., :n_ca], mu_shift[i][:n_ca], 1, ctx_len)

        v_l, kk_l, dirs_l = _state_inputs(za, k_k[i], k_a[i], w0[i], w_decay_up[i], a0[i], w_iclr_up[i])
        v_c, kk_c, dirs_c = _state_inputs(zca, k_k[i], k_k[i] * 0 + k_a[i], w0[i], w_decay_up[i], a0[i], w_iclr_up[i]) if False else _state_inputs(zca, k_k[i], k_a[i], w0[i], w_decay_up[i], a0[i], w_iclr_up[i])
        r_l = _split_heads(za[..., OFF_R:OFF_GL].astype(jnp.float32))
        r_c = None if last else _split_heads(zca[..., OFF_R:OFF_GL].astype(jnp.float32))
        state0 = jnp.zeros((b, N_HEADS_RWKV, HEAD_SIZE, HEAD_SIZE), jnp.float32)
        ys_l, ys_c = [], []
        for d in range(2):
            rev = d == 1
            dec_c, k_cd, a_cd = dirs_c[d]
            s_ctx, y_c = _wkv_scan(state0, dec_c, k_cd, v_c, kk_c, a_cd, r_c, rev)
            dec_l, k_ld, a_ld = dirs_l[d]
            _, y_l = _wkv_scan(s_ctx, dec_l, k_ld, v_l, kk_l, a_ld, r_l, rev)
            ys_l.append(y_l)
            ys_c.append(y_c)
        y_rwkv = _rwkv_readout(za, r_l, ys_l, [dd[1] for dd in dirs_l], v_l, r_k[i], lnx_w[i], lnx_b[i], w_gate_up[i])

        b_g, c_g, x_g = jnp.split(z[..., RWKV_COLS:], 3, axis=-1)
        y_conv = b_g * _short_conv(c_g * x_g, conv_w[i], rows, GRID_W)

        x = x + g1 * (jnp.concatenate([y_rwkv.astype(dt), y_conv], axis=-1) @ w_out[i])
        x = x + g2 * _swiglu(_modulate(_rmsnorm(x, norm2[i]), sh2, sc2), w_ffn_gate[i], w_ffn_up[i], w_ffn_down[i])

        if not last:
            yc_rwkv = _rwkv_readout(zca, r_c, ys_c, [dd[1] for dd in dirs_c], v_c, r_k[i], lnx_w[i], lnx_b[i], w_gate_up[i])
            bc_g, cc_g, xc_g = jnp.split(zc[..., RWKV_COLS:], 3, axis=-1)
            yc_conv = bc_g * _short_conv(cc_g * xc_g, conv_w[i], 1, ctx_len)
            ctx = ctx + cg1 * (jnp.concatenate([yc_rwkv.astype(dt), yc_conv], axis=-1) @ w_out[i])
            ctx = ctx + cg2 * _swiglu(_modulate(_rmsnorm(ctx, norm2[i]), csh2, csc2), w_ffn_gate[i], w_ffn_up[i], w_ffn_down[i])
    return _rmsnorm(x, norm_f)
```

```cpp
#include <hip/hip_runtime.h>
#include <cstdio>
#include <cstdint>
namespace pg8 {
#define PG8_LAS __attribute__((address_space(3)))
typedef unsigned short bf16_t;
typedef short bf16x8 __attribute__((ext_vector_type(8)));
typedef float f32x4 __attribute__((ext_vector_type(4)));
typedef unsigned u32x4 __attribute__((ext_vector_type(4)));
constexpr int BM = 256, BK = 64, HALF = 128, HTB = HALF * BK * 2  , STAGE_BYTES = 8 * HTB, NXCD = 8, WGM = 8;

__host__ __device__ __forceinline__ int lds_byte(int r, int c) { const int st = (r >> 4) * 2 + (c >> 5), rr = r & 15, cc = c & 31, ob = rr * 64 + cc * 2; return st * 1024 + (ob ^ (((ob >> 9) & 1) << 5)); }
__host__ __device__ __forceinline__ void stage_rc(int b, int& R, int& C) { const int st = b / 1024, sb = b % 1024, swz = sb ^ (((sb >> 9) & 1) << 5); R = (st >> 1) * 16 + swz / 64; C = (st & 1) * 32 + (swz % 64) / 2; }
__host__ __device__ __forceinline__ int perm32(int rho) { const int n = rho >> 4, i = rho & 15; return 8 * (i >> 2) + 4 * n + (i & 3); }

__device__ __forceinline__ int mk_lane() { int l; asm volatile("v_mbcnt_lo_u32_b32 %0, -1, 0\n\tv_mbcnt_hi_u32_b32 %0, -1, %0" : "=v"(l)); return l; }
struct Unit { int pm, pn; };
struct Gemm { const bf16_t* A; const bf16_t* Bt; int M, N, K; };

struct StaticOrder {
    int nM, nN, nwg, G, c;
    __host__ __device__ void init(int M, int N, int G_, int c_) { nM = M / BM; nN = N / BM; nwg = nM * nN; G = G_; c = c_; }
    __host__ __device__ bool next(int i, Unit& u) const {
        const long L = (long)i * G + c; if (L >= nwg) return false;
        int wgid = (int)L; { const int q = nwg / NXCD, r = nwg % NXCD, xcd = wgid % NXCD, off = wgid / NXCD; wgid = (xcd < r ? xcd * (q + 1) : r * (q + 1) + (xcd - r) * q) + off; }
        const int nig = WGM * nN, gid = wgid / nig, fm = gid * WGM, gsz = (nM - fm) < WGM ? (nM - fm) : WGM;
        u.pm = fm + ((wgid % nig) % gsz); u.pn = (wgid % nig) / gsz; return true;
    }
    __device__ __forceinline__ void a_ready(const Unit&) const {}
    __device__ __forceinline__ void done(const Unit&) const {}
};

__device__ __forceinline__ unsigned cvt_pk_bf16(float lo, float hi) { unsigned r; asm volatile("v_cvt_pk_bf16_f32 %0, %1, %2" : "=v"(r) : "v"(lo), "v"(hi)); return r; }
typedef float f32x2 __attribute__((ext_vector_type(2)));
__device__ __forceinline__ f32x2 gelu_pk(f32x2 v) {
    const f32x2 av = __builtin_elementwise_abs(v), d = av * 0.2316418882f + 1.0f;
    f32x2 t; t.x = __builtin_amdgcn_rcpf(d.x); t.y = __builtin_amdgcn_rcpf(d.y);
    f32x2 q = t * 0.5307027145f + (-0.7265760135f); q = q * t + 0.7107068705f; q = q * t + (-0.142248368f); q = q * t + 0.127414796f; q = q * t;
    const f32x2 s = (v * v) * (-0.72134752044f);
    f32x2 e; e.x = __builtin_amdgcn_exp2f(s.x); e.y = __builtin_amdgcn_exp2f(s.y);
    const f32x2 m = v * (q * e), r = v - m;
    f32x2 o; o.x = v.x < 0.f ? m.x : r.x; o.y = v.y < 0.f ? m.y : r.y; return o;
}

template <int ACT  > struct EpiBf16 {
    static constexpr bool PERM = true, AFTER_DRAIN = false; static_assert(ACT == 0 || ACT == 1, "EpiBf16: ACT is 0 (none) or 1 (gelu_pk)");
    bf16_t* O; int ldc; const float* bias; int split_cols; size_t split_stride; float scale0;
    __device__ __forceinline__ void operator()(const f32x4 (&acc)[2][2][4][2], const Unit& u, int wr, int wc, int fr, int fq) const {
        const int row0 = u.pm * BM + wr * 64 + fr; int colt = u.pn * BM; bf16_t* base = O;
        float sc = 1.f; if (split_cols) { const int t = colt / split_cols; base += (size_t)t * split_stride; colt -= t * split_cols; if (t == 0) sc = scale0; }
        const int col0 = colt + wc * 32 + 8 * fq, bcol0 = u.pn * BM + wc * 32 + 8 * fq;
        f32x4 bv[2][2];
#pragma unroll
        for (int bj = 0; bj < 2; ++bj)
#pragma unroll
            for (int n = 0; n < 2; ++n) bv[bj][n] = bias ? *(const f32x4*)(bias + bcol0 + bj * HALF + 4 * n) : (f32x4){0.f, 0.f, 0.f, 0.f};
#pragma unroll
        for (int ai = 0; ai < 2; ++ai)
#pragma unroll
            for (int m = 0; m < 4; ++m) { bf16_t* rowp = base + (size_t)(row0 + ai * HALF + m * 16) * ldc + col0;
#pragma unroll
                for (int bj = 0; bj < 2; ++bj) { f32x4 v0 = acc[ai][bj][m][0] + bv[bj][0], v1 = acc[ai][bj][m][1] + bv[bj][1];
                    if (ACT == 1) { f32x2 a = gelu_pk((f32x2){v0[0], v0[1]}), b = gelu_pk((f32x2){v0[2], v0[3]}), c = gelu_pk((f32x2){v1[0], v1[1]}), d = gelu_pk((f32x2){v1[2], v1[3]});
                        v0 = (f32x4){a.x, a.y, b.x, b.y}; v1 = (f32x4){c.x, c.y, d.x, d.y}; }
                    v0 = v0 * sc; v1 = v1 * sc; u32x4 w; w.x = cvt_pk_bf16(v0[0], v0[1]); w.y = cvt_pk_bf16(v0[2], v0[3]); w.z = cvt_pk_bf16(v1[0], v1[1]); w.w = cvt_pk_bf16(v1[2], v1[3]);
                    *(u32x4*)(rowp + bj * HALF) = w; } }
    }
};
__device__ __forceinline__ float sigmoidf_(float x) { return __builtin_amdgcn_rcpf(1.0f + __expf(-x)); }
struct EpiResid {
    static constexpr bool PERM = false, AFTER_DRAIN = false;
    const float* base; float* out; int ldc; const float* gvec;
    __device__ __forceinline__ void operator()(const f32x4 (&acc)[2][2][4][2], const Unit& u, int wr, int wc, int fr, int fq) const {
        const int row0 = u.pm * BM + wr * 64 + fr, col0 = u.pn * BM + wc * 32 + 4 * fq;
        f32x4 gv[2][2];
#pragma unroll
        for (int bj = 0; bj < 2; ++bj)
#pragma unroll
            for (int n = 0; n < 2; ++n) gv[bj][n] = *(const __attribute__((address_space(1))) f32x4*)(gvec + col0 + bj * HALF + n * 16);
#pragma unroll
        for (int ai = 0; ai < 2; ++ai)
#pragma unroll
            for (int m = 0; m < 4; ++m) { const size_t off = (size_t)(row0 + ai * HALF + m * 16) * ldc + col0;
#pragma unroll
                for (int bj = 0; bj < 2; ++bj)
#pragma unroll
                    for (int n = 0; n < 2; ++n) { const f32x4 bs = *(const __attribute__((address_space(1))) f32x4*)(base + off + bj * HALF + n * 16);
                        *(__attribute__((address_space(1))) f32x4*)(out + off + bj * HALF + n * 16) = bs + gv[bj][n] * acc[ai][bj][m][n]; }
                if (m & 1) asm volatile("" ::: "memory"); }
    }
};
struct EpiSwiglu {
    static constexpr bool PERM = true, AFTER_DRAIN = false;
    bf16_t* O; int ldc;
    __device__ __forceinline__ void operator()(const f32x4 (&acc)[2][2][4][2], const Unit& u, int wr, int wc, int fr, int fq) const {
        const int row0 = u.pm * BM + wr * 64 + fr, col0 = u.pn * HALF + wc * 32 + 8 * fq;
#pragma unroll
        for (int ai = 0; ai < 2; ++ai)
#pragma unroll
            for (int m = 0; m < 4; ++m) { bf16_t* rowp = O + (size_t)(row0 + ai * HALF + m * 16) * ldc + col0;
                f32x4 h0, h1;
#pragma unroll
                for (int j = 0; j < 4; ++j) { const float g0 = acc[ai][0][m][0][j], g1 = acc[ai][0][m][1][j];
                    h0[j] = g0 * sigmoidf_(g0) * acc[ai][1][m][0][j]; h1[j] = g1 * sigmoidf_(g1) * acc[ai][1][m][1][j]; }
                u32x4 w; w.x = cvt_pk_bf16(h0[0], h0[1]); w.y = cvt_pk_bf16(h0[2], h0[3]); w.z = cvt_pk_bf16(h1[0], h1[1]); w.w = cvt_pk_bf16(h1[2], h1[3]);
                *(__attribute__((address_space(1))) u32x4*)rowp = w; }
    }
};
struct EpiLora {
    static constexpr bool PERM = true, AFTER_DRAIN = false;
    float* PD; const float* PS; const float* kbuf; const float* w0; const float* a0; const float* k_a; int TT;
    __device__ __forceinline__ void operator()(const f32x4 (&acc)[2][2][4][2], const Unit& u, int wr, int wc, int fr, int fq) const {
        typedef __attribute__((address_space(1))) f32x4 gf4; typedef const __attribute__((address_space(1))) f32x4 cgf4;
        const int q = u.pn >> 3, d = q & 1, isic = q >> 1, chb = (u.pn & 7) * 256;
        const int row0 = u.pm * BM + wr * 64 + fr;
#pragma unroll
        for (int bj = 0; bj < 2; ++bj) {
            const int c8 = chb + bj * HALF + wc * 32 + 8 * fq, h = c8 >> 6, ch = c8 & 63;
            const float* bp = (isic ? a0 : w0) + d * 2048 + c8;
            const f32x4 b0 = *(cgf4*)bp, b1 = *(cgf4*)(bp + 4);
            f32x4 ka0 = (f32x4){0.f, 0.f, 0.f, 0.f}, ka1 = ka0;
            if (isic) { ka0 = *(cgf4*)(k_a + c8); ka1 = *(cgf4*)(k_a + c8 + 4); }
#pragma unroll
            for (int ai = 0; ai < 2; ++ai)
#pragma unroll
                for (int m = 0; m < 4; ++m) {
                    const int tok = row0 + ai * HALF + m * 16;
                    float* pd = PD + ((size_t)(d * 32 + h) * TT + tok) * 192 + ch;
                    const f32x4 x0 = acc[ai][bj][m][0] + b0, x1 = acc[ai][bj][m][1] + b1;
                    if (!isic) {
                        f32x4 w0v, w1v;
#pragma unroll
                        for (int j = 0; j < 4; ++j) { w0v[j] = __expf(-0.60653066f * sigmoidf_(x0[j])); w1v[j] = __expf(-0.60653066f * sigmoidf_(x1[j])); }
                        *(gf4*)pd = w0v; *(gf4*)(pd + 4) = w1v;
                    } else {
                        const float* ps = PS + ((size_t)h * TT + tok) * 192 + ch;
                        const f32x4 nk0 = *(cgf4*)ps, nk1 = *(cgf4*)(ps + 4);
                        const float* kp = kbuf + (size_t)tok * 2048 + c8;
                        const f32x4 k0 = *(cgf4*)kp, k1 = *(cgf4*)(kp + 4);
                        f32x4 bb0, bb1, kd0, kd1;
#pragma unroll
                        for (int j = 0; j < 4; ++j) { const float a0v = sigmoidf_(x0[j]), a1v = sigmoidf_(x1[j]);
                            bb0[j] = -nk0[j] * a0v; bb1[j] = -nk1[j] * a1v;
                            kd0[j] = k0[j] * (1.0f + (a0v - 1.0f) * ka0[j]); kd1[j] = k1[j] * (1.0f + (a1v - 1.0f) * ka1[j]); }
                        *(gf4*)(pd + 64) = bb0; *(gf4*)(pd + 68) = bb1; *(gf4*)(pd + 128) = kd0; *(gf4*)(pd + 132) = kd1;
                    }
                    asm volatile("" ::: "memory");
                }
        }
    }
};
template <class Epi, class Sched, bool ALIGN_EPI = false, bool SP2 = false>
__device__ __forceinline__ void gemm_phase(PG8_LAS unsigned char* lds, const Gemm g, const Sched& S, const Epi& E, const int wid) {
    const int lane = mk_lane(), tid = wid * 64 + lane, wr = wid >> 2, wc = wid & 3, fr = lane & 15, fq = lane >> 4;
    const int K = g.K, nt = K / BK;
    unsigned voffA[2], voffB[2];
#pragma unroll
    for (int i = 0; i < 2; ++i) { int R, C; stage_rc(tid * 16 + i * 8192, R, C); const int Rb = Epi::PERM ? ((R & ~31) + perm32(R & 31)) : R;
        voffA[i] = (unsigned)(R * K + C) * 2u; voffB[i] = (unsigned)(Rb * K + C) * 2u; }
    const size_t kstep = (size_t)(BK * 2);
    const size_t hstep = (size_t)HALF * K * 2;
    const size_t tstep = 2 * hstep;
    const unsigned ldsw = (unsigned)wid * 1024u;
    const int aoff = lds_byte(wr * 64 + fr, fq * 8), boff = lds_byte(wc * 32 + fr, fq * 8);
#define PG8_SA(b, h) (((b) * 2 + (h)) * HTB)
#define PG8_SB(b, h) ((4 + (b) * 2 + (h)) * HTB)
#define PG8_STAGE(bufoff, gbase, voff) do { _Pragma("unroll") for (int _i = 0; _i < 2; ++_i) \
        __builtin_amdgcn_global_load_lds((const unsigned*)((const char*)(gbase) + (voff)[_i]), (PG8_LAS unsigned*)(lds + (bufoff) + ldsw + _i * 8192), 16, 0, 0); } while (0)
#define PG8_LDA(dst, b, h) do { _Pragma("unroll") for (int m = 0; m < 4; ++m) _Pragma("unroll") for (int k = 0; k < 2; ++k) dst[m][k] = *(const PG8_LAS bf16x8*)(lds + PG8_SA(b, h) + aoff + m * 2048 + k * 1024); } while (0)
#define PG8_LDB(dst, b, h) do { _Pragma("unroll") for (int n = 0; n < 2; ++n) _Pragma("unroll") for (int k = 0; k < 2; ++k) dst[n][k] = *(const PG8_LAS bf16x8*)(lds + PG8_SB(b, h) + boff + n * 2048 + k * 1024); } while (0)
#define PG8_MMA(ai, bj, At, Bt) do { __builtin_amdgcn_s_setprio(1); _Pragma("unroll") for (int m = 0; m < 4; ++m) _Pragma("unroll") for (int n = 0; n < 2; ++n) _Pragma("unroll") for (int k = 0; k < 2; ++k) \
        acc[ai][bj][m][n] = __builtin_amdgcn_mfma_f32_16x16x32_bf16(Bt[n][k], At[m][k], acc[ai][bj][m][n], 0, 0, 0); __builtin_amdgcn_s_setprio(0); } while (0)
#define PG8_WAIT_V(n) asm volatile("s_waitcnt vmcnt(" #n ")" ::: "memory")
#define PG8_WAIT_L(n) asm volatile("s_waitcnt lgkmcnt(" #n ")" ::: "memory")
#define PG8_BAR __builtin_amdgcn_s_barrier()
#define PG8_SCHED __builtin_amdgcn_sched_barrier(0)
    Unit cur, nxt; int ui = 0;
    if (!S.next(0, cur)) return;
    f32x4 acc[2][2][4][2];
#pragma unroll
    for (int a = 0; a < 2; ++a)
#pragma unroll
        for (int b = 0; b < 2; ++b)
#pragma unroll
            for (int m = 0; m < 4; ++m)
#pragma unroll
                for (int n = 0; n < 2; ++n) acc[a][b][m][n] = (f32x4){0.f, 0.f, 0.f, 0.f};
    bf16x8 At[4][2], B0[2][2], B1[2][2];
    const char* cA = (const char*)g.A + (size_t)cur.pm * tstep; const char* cB = (const char*)g.Bt + (size_t)cur.pn * tstep;
    S.a_ready(cur);
    if constexpr (SP2) {
        PG8_STAGE(PG8_SB(0, 0), cB, voffB); PG8_STAGE(PG8_SB(0, 1), cB + hstep, voffB); PG8_STAGE(PG8_SA(0, 0), cA, voffA); PG8_STAGE(PG8_SA(0, 1), cA + hstep, voffA);
        if (wr == 1) PG8_BAR;
        PG8_WAIT_V(2); PG8_BAR;
        PG8_STAGE(PG8_SB(1, 0), cB + kstep, voffB); PG8_STAGE(PG8_SA(1, 0), cA + kstep, voffA); PG8_STAGE(PG8_SB(1, 1), cB + hstep + kstep, voffB);
        PG8_WAIT_V(6); PG8_BAR;
    } else {
        PG8_STAGE(PG8_SB(0, 0), cB, voffB); PG8_STAGE(PG8_SA(0, 0), cA, voffA); PG8_STAGE(PG8_SB(0, 1), cB + hstep, voffB); PG8_STAGE(PG8_SA(0, 1), cA + hstep, voffA);
        if (wr == 1) PG8_BAR;
        PG8_WAIT_V(4); PG8_BAR;
        PG8_STAGE(PG8_SB(1, 0), cB + kstep, voffB); PG8_STAGE(PG8_SA(1, 0), cA + kstep, voffA); PG8_STAGE(PG8_SB(1, 1), cB + hstep + kstep, voffB);
        PG8_WAIT_V(6); PG8_BAR;
    }
    for (;;) {
        const bool has_next = S.next(ui + 1, nxt);
        const char* nA = has_next ? (const char*)g.A + (size_t)nxt.pm * tstep : cA; const char* nB = has_next ? (const char*)g.Bt + (size_t)nxt.pn * tstep : cB;
        for (int t = 0; t < nt; t += 2) {
            const bool last = (t == nt - 2);
            const char* a1 = cA + (size_t)(t + 1) * kstep;
            const char* a2 = last ? nA : cA + (size_t)(t + 2) * kstep; const char* b2 = last ? nB : cB + (size_t)(t + 2) * kstep;
            const char* a3 = a2 + kstep; const char* b3 = b2 + kstep;
            if (last && has_next) S.a_ready(nxt);
            if constexpr (SP2) {
            PG8_LDB(B0, 0, 0); PG8_LDB(B1, 0, 1); PG8_SCHED; PG8_LDA(At, 0, 0); PG8_STAGE(PG8_SA(1, 1), a1 + hstep, voffA);
            PG8_WAIT_V(8); PG8_WAIT_L(0); PG8_BAR; PG8_MMA(0, 0, At, B0); PG8_MMA(0, 1, At, B1); PG8_BAR; PG8_SCHED;
            PG8_LDA(At, 0, 1); PG8_STAGE(PG8_SB(0, 0), b2, voffB); PG8_STAGE(PG8_SB(0, 1), b2 + hstep, voffB); PG8_STAGE(PG8_SA(0, 0), a2, voffA);
            PG8_WAIT_V(8); PG8_WAIT_L(0); PG8_BAR; PG8_MMA(1, 0, At, B0); PG8_MMA(1, 1, At, B1); PG8_BAR; PG8_SCHED;
            PG8_LDB(B0, 1, 0); PG8_LDB(B1, 1, 1); PG8_SCHED; PG8_LDA(At, 1, 0); PG8_STAGE(PG8_SA(0, 1), a2 + hstep, voffA);
            PG8_WAIT_V(8); PG8_WAIT_L(0); PG8_BAR; PG8_MMA(0, 0, At, B0); PG8_MMA(0, 1, At, B1); PG8_BAR; PG8_SCHED;
            PG8_LDA(At, 1, 1); PG8_STAGE(PG8_SB(1, 0), b3, voffB); PG8_STAGE(PG8_SB(1, 1), b3 + hstep, voffB); PG8_STAGE(PG8_SA(1, 0), a3, voffA);
            PG8_WAIT_V(8); PG8_WAIT_L(0); PG8_BAR; PG8_MMA(1, 0, At, B0); PG8_MMA(1, 1, At, B1); PG8_BAR; PG8_SCHED;
            } else {
            PG8_LDB(B0, 0, 0); PG8_SCHED; PG8_LDA(At, 0, 0); PG8_STAGE(PG8_SA(1, 1), a1 + hstep, voffA);
            PG8_WAIT_L(8); PG8_BAR; PG8_WAIT_L(0); PG8_MMA(0, 0, At, B0); PG8_BAR; PG8_SCHED;
            PG8_LDB(B1, 0, 1); PG8_STAGE(PG8_SB(0, 0), b2, voffB);
            PG8_BAR; PG8_WAIT_L(0); PG8_MMA(0, 1, At, B1); PG8_BAR;
            PG8_LDA(At, 0, 1); PG8_STAGE(PG8_SA(0, 0), a2, voffA);
            PG8_BAR; PG8_WAIT_L(0); PG8_MMA(1, 0, At, B0); PG8_BAR; PG8_SCHED;
            PG8_STAGE(PG8_SB(0, 1), b2 + hstep, voffB);
            PG8_WAIT_V(6); PG8_BAR; PG8_MMA(1, 1, At, B1); PG8_BAR;
            PG8_LDB(B0, 1, 0); PG8_SCHED; PG8_LDA(At, 1, 0); PG8_STAGE(PG8_SA(0, 1), a2 + hstep, voffA);
            PG8_WAIT_L(8); PG8_BAR; PG8_WAIT_L(0); PG8_MMA(0, 0, At, B0); PG8_BAR; PG8_SCHED;
            PG8_LDB(B1, 1, 1); PG8_STAGE(PG8_SB(1, 0), b3, voffB);
            PG8_BAR; PG8_WAIT_L(0); PG8_MMA(0, 1, At, B1); PG8_BAR;
            PG8_LDA(At, 1, 1); PG8_STAGE(PG8_SA(1, 0), a3, voffA);
            PG8_BAR; PG8_WAIT_L(0); PG8_MMA(1, 0, At, B0); PG8_BAR; PG8_SCHED;
            PG8_STAGE(PG8_SB(1, 1), b3 + hstep, voffB);
            PG8_WAIT_V(6); PG8_BAR; PG8_MMA(1, 1, At, B1); PG8_BAR;
            }
        }
        if constexpr (ALIGN_EPI) { if (wr == 0) PG8_BAR; }
        if constexpr (!Epi::AFTER_DRAIN) { const int l2 = mk_lane(); E(acc, cur, wr, wc, l2 & 15, l2 >> 4); S.done(cur); }
        if (!has_next) break;
#pragma unroll
        for (int a = 0; a < 2; ++a)
#pragma unroll
            for (int b = 0; b < 2; ++b)
#pragma unroll
                for (int m = 0; m < 4; ++m)
#pragma unroll
                    for (int n = 0; n < 2; ++n) acc[a][b][m][n] = (f32x4){0.f, 0.f, 0.f, 0.f};
        cur = nxt; cA = nA; cB = nB; ++ui;
        if constexpr (ALIGN_EPI) { if (wr == 1) PG8_BAR; }
    }
    PG8_WAIT_V(0);
    if constexpr (!ALIGN_EPI) { if (wr == 0) PG8_BAR; }
    PG8_BAR;
    if constexpr (Epi::AFTER_DRAIN) { E.fused(acc, cur, wr, wc, fr, fq, lds, wid, lane); S.done(cur); }
#undef PG8_SA
#undef PG8_SB
#undef PG8_STAGE
#undef PG8_LDA
#undef PG8_LDB
#undef PG8_MMA
#undef PG8_WAIT_V
#undef PG8_WAIT_L
#undef PG8_BAR
#undef PG8_SCHED
}
}

constexpr int NWAVES = 8;
#ifndef MK_N_LAUNCHES
#define MK_N_LAUNCHES 1
#endif
constexpr int N_PHASES = 14;
constexpr int N_LAUNCHES = MK_N_LAUNCHES;

constexpr int D = 4096, T = 8192, CTXL = 256, TT = T + CTXL;
constexpr int DR = 2048, DC = 2048, NH = 32, HS = 64;
constexpr int OFF_K = 0, OFF_V = 2048, OFF_WL = 4096, OFF_AL = 4192, OFF_R = 4288, OFF_GL = 6336, RWKV_COLS = 6592;
constexpr int OFF_CB = 6592, OFF_CC = 8640, OFF_CX = 10688, IN_COLS = 12736, NZ = 12800;
constexpr int NCTXZ = 4352;
constexpr int DFF = 11008, NGU = 2 * DFF;
constexpr int NLORA = 8192, KLORA = 256, KGATE = 256;
constexpr int MODN = 6 * D;
constexpr int NKC = 16;
constexpr float NORM_EPS = 1e-6f, LNX_EPS = 64e-5f;
constexpr int CHUNK = 256, NCHUNK = 33;

constexpr size_t MiB = 1u << 20;
constexpr size_t WS_CTL = 0, CTL_ZERO_BYTES = 1 * MiB;
constexpr size_t WS_MODP = 1 * MiB;
constexpr size_t WS_MODV = 5 * MiB;
constexpr size_t WS_WLORA = 6 * MiB;
constexpr size_t WS_WGATE = 10 * MiB;
constexpr size_t WS_ALORA = 11 * MiB;
constexpr size_t WS_AGATE = 16 * MiB;
constexpr size_t WS_WOUT = 20 * MiB;
constexpr size_t WS_WGU = 52 * MiB;
constexpr size_t WS_WDN = 224 * MiB;
constexpr size_t WS_WIN = 310 * MiB;
constexpr size_t WS_PU = 310 * MiB;
constexpr size_t WS_SST = 374 * MiB;
constexpr size_t WS_A1 = 410 * MiB;
constexpr size_t WS_Z = 476 * MiB;
constexpr size_t WS_YS = 476 * MiB;
constexpr size_t WS_PS = 683 * MiB;
constexpr size_t WS_X1 = 683 * MiB;
constexpr size_t WS_PD = 881 * MiB;
constexpr size_t WS_ACT = 881 * MiB;
constexpr size_t WS_KBUF = 1277 * MiB;
constexpr size_t WS_G = 1343 * MiB;
constexpr size_t WS_CAT = 1375 * MiB;
constexpr size_t WS_END = 1439 * MiB;
static_assert(WS_MODP + (size_t)NKC * 2 * MODN * 4 <= WS_MODV && WS_ALORA + (size_t)TT * 256 * 2 <= WS_AGATE && WS_WGU + (size_t)NGU * D * 2 <= WS_WDN && WS_WDN + (size_t)D * DFF * 2 <= WS_WIN, "ws map 1");
static_assert(WS_WIN + (size_t)NZ * D * 2 <= WS_A1 && WS_SST + (size_t)64 * NCHUNK * 16384 <= WS_A1 && WS_A1 + (size_t)TT * D * 2 <= WS_Z && WS_Z + (size_t)TT * NZ * 2 <= WS_PS, "ws map 2");
static_assert(WS_PS + (size_t)32 * TT * 768 <= WS_PD && WS_PD + (size_t)64 * TT * 768 <= WS_KBUF && WS_KBUF + (size_t)TT * 2048 * 4 <= WS_G && WS_G + (size_t)T * 2048 * 2 <= WS_CAT && WS_CAT + (size_t)T * D * 2 <= WS_END, "ws map 3");
static_assert(WS_ACT + (size_t)T * DFF * 2 <= WS_KBUF && WS_X1 + (size_t)T * D * 4 <= WS_PD && WS_YS + (size_t)2 * T * 2048 * 4 <= WS_PS, "ws map 4");
constexpr int CW_TMO = 0;
constexpr int CW_BAR = 4096;

constexpr int RING_OFF = 0, RING_BYTES = 131072;
constexpr int LDSCTL_OFF = RING_BYTES, MISC_OFF = LDSCTL_OFF + 320;
constexpr int LDS_BYTES = 147456;
static_assert(MISC_OFF + 128 <= LDS_BYTES, "LDS map");

#define GAS __attribute__((address_space(1)))
#define LAS __attribute__((address_space(3)))
typedef unsigned short bf16;
typedef unsigned v4u __attribute__((ext_vector_type(4)));
typedef unsigned v2u __attribute__((ext_vector_type(2)));
typedef float f32x4 __attribute__((ext_vector_type(4)));
typedef GAS unsigned gu32;
#define RLX_AGENT __ATOMIC_RELAXED, __HIP_MEMORY_SCOPE_AGENT
#define LDS_WAIT() asm volatile("s_waitcnt lgkmcnt(0)" ::: "memory")
#define VM_WAIT() asm volatile("s_waitcnt vmcnt(0)" ::: "memory")
__device__ __forceinline__ unsigned f2bf(float f) { unsigned u = __builtin_bit_cast(unsigned, f); return (u + 0x7fffu + ((u >> 16) & 1u)) >> 16; }
__device__ __forceinline__ unsigned pk2(float lo, float hi) { return f2bf(lo) | (f2bf(hi) << 16); }
__device__ __forceinline__ float bflo(unsigned w) { return __builtin_bit_cast(float, w << 16); }
__device__ __forceinline__ float bfhi(unsigned w) { return __builtin_bit_cast(float, w & 0xffff0000u); }
__device__ __forceinline__ float sigm(float x) { return 1.0f / (1.0f + __expf(-x)); }

#define XB_TMO      128
#define XB_XCNT(j)  (256  + 64 * (j))
#define XB_XSUB(j)  (1280 + 64 * (j))
#define XB_XGEN(j)  (2304 + 64 * (j))
#define XB_TOP      3328
#define XB_TOPGEN   3392
#define XCD_BAR_WORDS 3456
#define XB_SPIN_CAP (1u << 18)
__device__ __forceinline__ unsigned xb_ld(unsigned* p)              { return __hip_atomic_load(p, __ATOMIC_RELAXED, __HIP_MEMORY_SCOPE_AGENT); }
__device__ __forceinline__ unsigned xb_add(unsigned* p, unsigned v) { return __hip_atomic_fetch_add(p, v, __ATOMIC_RELAXED, __HIP_MEMORY_SCOPE_AGENT); }
__device__ __forceinline__ unsigned xb_xcc_id() { return (unsigned)__builtin_amdgcn_s_getreg((3 << 11) | 20) & 0xFu; }
#define XB_SPIN(cond, bar) do { unsigned _sp = 0; while (cond) { __builtin_amdgcn_s_sleep(1); \
    if ((++_sp & 255u) == 0u) { if (xb_ld(&(bar)[XB_TMO])) break; if (_sp > XB_SPIN_CAP) { atomicAdd(&(bar)[XB_TMO], 1u); break; } } } } while (0)
struct XcdBarrier { unsigned* bar; unsigned x; volatile LAS unsigned* st; };
__device__ __forceinline__ XcdBarrier xcd_barrier_post(unsigned* bar, volatile LAS unsigned* st) {
    XcdBarrier b; b.bar = bar; b.x = xb_xcc_id(); b.st = st;
    if (threadIdx.x == 0) (void)xb_add(&bar[XB_XCNT(b.x)], 1u);
    return b;
}
__device__ __forceinline__ void xcd_barrier_complete(unsigned* bar, unsigned x, unsigned& nloc, unsigned& nx) {
    const unsigned G = gridDim.x * gridDim.y * gridDim.z;
    unsigned sum, cnt, mine, sp = 0u;
    for (;;) {
        sum = 0u; cnt = 0u; mine = 0u;
#pragma unroll
        for (unsigned j = 0; j < 16; ++j) { const unsigned c = xb_ld(&bar[XB_XCNT(j)]); sum += c; cnt += (c > 0u) ? 1u : 0u; mine = (j == x) ? c : mine; }
        if (sum == G) break;
        __builtin_amdgcn_s_sleep(1);
        if ((++sp & 255u) == 0u) { if (xb_ld(&bar[XB_TMO])) break; if (sp > XB_SPIN_CAP) { atomicAdd(&bar[XB_TMO], 1u); break; } }
    }
    nloc = mine > 0u ? mine : 1u; nx = cnt > 0u ? cnt : 1u;
}
__device__ __forceinline__ void xcd_barrier(const XcdBarrier& b, const int wave) {
    asm volatile("s_waitcnt vmcnt(0)" ::: "memory");
    __syncthreads();
    if (wave == 0 && pg8::mk_lane() == 0) {
        unsigned* bar = b.bar;
        __builtin_amdgcn_s_waitcnt(0);
        unsigned nloc = b.st[0], nx = b.st[1];
        if (nloc == 0u) { xcd_barrier_complete(bar, b.x, nloc, nx); b.st[0] = nloc; b.st[1] = nx; }
        const unsigned old = xb_add(&bar[XB_XSUB(b.x)], 1u);
        const unsigned gen = old / nloc;
        if (old + 1u == (gen + 1u) * nloc) {
            __builtin_amdgcn_fence(__ATOMIC_RELEASE, "agent");
            asm volatile("s_waitcnt vmcnt(0)" ::: "memory");
            const unsigned og = xb_add(&bar[XB_TOP], 1u);
            const unsigned tg = og / nx;
            if (og + 1u == (tg + 1u) * nx) xb_add(&bar[XB_TOPGEN], 1u);
            else XB_SPIN(xb_ld(&bar[XB_TOPGEN]) == tg, bar);
            __builtin_amdgcn_fence(__ATOMIC_ACQUIRE, "agent");
            xb_add(&bar[XB_XGEN(b.x)], 1u);
            asm volatile("s_waitcnt vmcnt(0)" ::: "memory");
        } else {
            XB_SPIN(xb_ld(&bar[XB_XGEN(b.x)]) == gen, bar);
            __builtin_amdgcn_fence(__ATOMIC_ACQUIRE, "agent");
            asm volatile("s_waitcnt vmcnt(0)" ::: "memory");
        }
    }
    __syncthreads();
}

struct Frame {
    LAS unsigned char* lds;
    volatile LAS unsigned* MISC;
    gu32* ctl;
    int wave;
    int vcu, G;
    unsigned char* ws;
    const float* in[26];
    float* out;
};
enum { I_X = 0, I_C, I_CTX, I_CCTX, I_WADA, I_BADA, I_NORM1, I_WIN, I_MU, I_KK, I_KA, I_RK, I_W0, I_WDU, I_A0, I_WIU, I_WGU, I_LNXW, I_LNXB, I_CONVW, I_WOUT, I_NORM2, I_WFG, I_WFU, I_WFD, I_NORMF };

__device__ __forceinline__ float wave_sum(float v) {
#pragma unroll
    for (int o = 1; o < 64; o <<= 1) v += __shfl_xor(v, o);
    return v;
}

__device__ __forceinline__ void p0_transpose_item(const float* W, int K, int N, bf16* WT, int ldk, int row_off, LAS float* scr, int item, int lane) {
    const int nblk = N / 32, kb = item / nblk, nb = item % nblk, k0 = 64 * kb, n0 = 32 * nb;
#pragma unroll 8
    for (int i = 0; i < 32; ++i) { const int kk = 2 * i + (lane >> 5); scr[kk * 33 + (lane & 31)] = *(const GAS float*)(W + (size_t)(k0 + kk) * N + n0 + (lane & 31)); }
    LDS_WAIT(); asm volatile("" ::: "memory");
    const int c = lane & 7;
#pragma unroll
    for (int j = 0; j < 4; ++j) { const int n = (lane >> 3) + 8 * j; const LAS float* s = scr + (8 * c) * 33 + n;
        v4u o; o.x = pk2(s[0 * 33], s[1 * 33]); o.y = pk2(s[2 * 33], s[3 * 33]); o.z = pk2(s[4 * 33], s[5 * 33]); o.w = pk2(s[6 * 33], s[7 * 33]);
        *(GAS v4u*)(WT + (size_t)(row_off + n0 + n) * ldk + k0 + 8 * c) = o; }
    LDS_WAIT(); asm volatile("" ::: "memory");
}
constexpr int TI_IN = (D / 64) * (IN_COLS / 32), TI_OUT = (D / 64) * (D / 32), TI_G = (D / 64) * (DFF / 32), TI_DN = (DFF / 64) * (D / 32);
constexpr int TI_TOTAL = TI_IN + TI_OUT + 2 * TI_G + TI_DN;
constexpr int GEMV_UNITS = NKC * (MODN / 256);
constexpr int TI_PER_GEMV_WAVE = 43, TI_PER_OTHER_WAVE = 67;
static_assert(GEMV_UNITS <= 2048 && GEMV_UNITS * TI_PER_GEMV_WAVE + (2048 - GEMV_UNITS) * TI_PER_OTHER_WAVE >= TI_TOTAL, "P0 item split");

__device__ __forceinline__ void p0_gemv_unit(Frame& F, int unit, int lane) {
    const int kc = unit / (MODN / 256), cc = unit % (MODN / 256);
    const int k0 = kc * 256, col = cc * 256 + lane * 4;
    int sv[4], sc[4];
#pragma unroll
    for (int q = 0; q < 4; ++q) { const float c = *(const GAS float*)(F.in[I_C] + k0 + q * 64 + lane), cx = *(const GAS float*)(F.in[I_CCTX] + k0 + q * 64 + lane);
        sv[q] = __builtin_bit_cast(int, c * sigm(c)); sc[q] = __builtin_bit_cast(int, cx * sigm(cx)); }
    f32x4 a0 = (f32x4){0.f, 0.f, 0.f, 0.f}, a1 = a0;
    const GAS f32x4* wp = (const GAS f32x4*)(F.in[I_WADA] + (size_t)k0 * MODN + col);
#pragma unroll
    for (int q = 0; q < 4; ++q) {
#pragma unroll 16
        for (int i = 0; i < 64; ++i) { const f32x4 w = wp[(size_t)(q * 64 + i) * (MODN / 4)];
            const float s = __builtin_bit_cast(float, __builtin_amdgcn_readlane(sv[q], i)), t = __builtin_bit_cast(float, __builtin_amdgcn_readlane(sc[q], i));
            a0 += w * s; a1 += w * t; }
    }
    float* mp = (float*)(F.ws + WS_MODP);
    *(GAS f32x4*)(mp + (size_t)(kc * 2 + 0) * MODN + col) = a0;
    *(GAS f32x4*)(mp + (size_t)(kc * 2 + 1) * MODN + col) = a1;
}

__device__ __forceinline__ void p0_prologue(Frame& F) {
    LAS float* scr = (LAS float*)(F.lds + RING_OFF + F.wave * 16384);
    const int lane = pg8::mk_lane();
    const int gw = F.vcu * NWAVES + F.wave, NGW = F.G * NWAVES;
    const int gt = gw * 64 + lane, NGT = NGW * 64;
    {
        unsigned* wl = (unsigned*)(F.ws + WS_WLORA);
        for (int i = gt; i < NLORA * KLORA / 2; i += NGT) { const int n = i >> 7, k = (i & 127) * 2, q = n >> 11, ch = n & 2047; float v0 = 0.f, v1 = 0.f;
            if (k < 96) { if (q < 2) { v0 = *(const GAS float*)(F.in[I_WDU] + (size_t)(q * 96 + k) * 2048 + ch); v1 = *(const GAS float*)(F.in[I_WDU] + (size_t)(q * 96 + k + 1) * 2048 + ch); } }
            else if (k < 192) { if (q >= 2) { v0 = *(const GAS float*)(F.in[I_WIU] + (size_t)((q - 2) * 96 + k - 96) * 2048 + ch); v1 = *(const GAS float*)(F.in[I_WIU] + (size_t)((q - 2) * 96 + k - 95) * 2048 + ch); } }
            *(GAS unsigned*)(wl + i) = pk2(v0, v1); }
        unsigned* wg = (unsigned*)(F.ws + WS_WGATE);
        for (int i = gt; i < 2048 * KGATE / 2; i += NGT) { const int n = i >> 7, k = (i & 127) * 2;
            *(GAS unsigned*)(wg + i) = pk2(*(const GAS float*)(F.in[I_WGU] + (size_t)k * 2048 + n), *(const GAS float*)(F.in[I_WGU] + (size_t)(k + 1) * 2048 + n)); }
        v4u* zp = (v4u*)(F.ws + WS_WIN + (size_t)IN_COLS * D * 2);
        for (int i = gt; i < (NZ - IN_COLS) * D * 2 / 16; i += NGT) *(GAS v4u*)(zp + i) = (v4u){0u, 0u, 0u, 0u};
    }
    for (int u = gw; u < GEMV_UNITS; u += NGW) p0_gemv_unit(F, u, lane);
    int it0, it1;
    if (gw < GEMV_UNITS) { it0 = gw * TI_PER_GEMV_WAVE; it1 = it0 + TI_PER_GEMV_WAVE; }
    else { it0 = GEMV_UNITS * TI_PER_GEMV_WAVE + (gw - GEMV_UNITS) * TI_PER_OTHER_WAVE; it1 = it0 + TI_PER_OTHER_WAVE; }
    if (NGW != 2048) { const int per = (TI_TOTAL + NGW - 1) / NGW; it0 = gw * per; it1 = it0 + per; if (gw >= GEMV_UNITS) { } }
    if (it1 > TI_TOTAL) it1 = TI_TOTAL;
    for (int it = it0; it < it1; ++it) {
        int r = it;
        if (r < TI_IN) { p0_transpose_item(F.in[I_WIN], D, IN_COLS, (bf16*)(F.ws + WS_WIN), D, 0, scr, r, lane); continue; } r -= TI_IN;
        if (r < TI_OUT) { p0_transpose_item(F.in[I_WOUT], D, D, (bf16*)(F.ws + WS_WOUT), D, 0, scr, r, lane); continue; } r -= TI_OUT;
        if (r < TI_G) { const int n0 = 32 * (r % (DFF / 32)); p0_transpose_item(F.in[I_WFG], D, DFF, (bf16*)(F.ws + WS_WGU), D, 256 * (n0 >> 7) + (n0 & 127) - n0, scr, r, lane); continue; } r -= TI_G;
        if (r < TI_G) { const int n0 = 32 * (r % (DFF / 32)); p0_transpose_item(F.in[I_WFU], D, DFF, (bf16*)(F.ws + WS_WGU), D, 256 * (n0 >> 7) + 128 + (n0 & 127) - n0, scr, r, lane); continue; } r -= TI_G;
        p0_transpose_item(F.in[I_WFD], DFF, D, (bf16*)(F.ws + WS_WDN), DFF, 0, scr, r, lane);
    }
}

__device__ __forceinline__ void norm_row(const float* xrow, bf16* orow, const LAS float* gs, const LAS float* sh, int lane) {
    const GAS f32x4* xr = (const GAS f32x4*)xrow + lane;
    f32x4 v[16]; float s = 0.f;
#pragma unroll
    for (int j = 0; j < 16; ++j) { v[j] = xr[64 * j]; s += (v[j].x * v[j].x + v[j].y * v[j].y) + (v[j].z * v[j].z + v[j].w * v[j].w); }
    const float rstd = 1.0f / sqrtf(wave_sum(s) * (1.f / D) + NORM_EPS);
    GAS v2u* o8 = (GAS v2u*)orow + lane;
#pragma unroll
    for (int j = 0; j < 16; ++j) { const f32x4 g = *(const LAS f32x4*)(gs + 4 * lane + 256 * j), b = *(const LAS f32x4*)(sh + 4 * lane + 256 * j);
        const f32x4 y = v[j] * rstd * g + b; v2u o; o.x = pk2(y.x, y.y); o.y = pk2(y.z, y.w); o8[64 * j] = o; }
}
__device__ __forceinline__ void p1_norm1(Frame& F) {
    const int lane = pg8::mk_lane(), tid = F.wave * 64 + lane;
    LAS float* tab = (LAS float*)(F.lds + RING_OFF);
    const float* mp = (const float*)(F.ws + WS_MODP);
    for (int i = tid; i < 4 * D; i += NWAVES * 64) {
        const int which = i >> 12, k = i & (D - 1), isc = which >> 1, part = which & 1;
        const int col = part == 0 ? D + k : k;
        float s = *(const GAS float*)(F.in[I_BADA] + col);
#pragma unroll
        for (int p = 0; p < NKC; ++p) s += *(const GAS float*)(mp + (size_t)(p * 2 + isc) * MODN + col);
        tab[i] = part == 0 ? *(const GAS float*)(F.in[I_NORM1] + k) * (1.0f + s) : s;
    }
    {
        float* mv = (float*)(F.ws + WS_MODV);
        for (int i = F.vcu * (NWAVES * 64) + tid; i < 2 * MODN; i += F.G * NWAVES * 64) { const int isc = i / MODN, col = i % MODN;
            float s = *(const GAS float*)(F.in[I_BADA] + col);
#pragma unroll
            for (int p = 0; p < NKC; ++p) s += *(const GAS float*)(mp + (size_t)(p * 2 + isc) * MODN + col);
            *(GAS float*)(mv + i) = s; }
    }
    __syncthreads();
    const int gw = F.vcu * NWAVES + F.wave, NGW = F.G * NWAVES;
    bf16* A1 = (bf16*)(F.ws + WS_A1);
    for (int m = gw; m < TT; m += NGW) {
        if (m < T) norm_row(F.in[I_X] + (size_t)m * D, A1 + (size_t)m * D, tab, tab + D, lane);
        else norm_row(F.in[I_CTX] + (size_t)(m - T) * D, A1 + (size_t)m * D, tab + 2 * D, tab + 3 * D, lane);
    }
    __syncthreads();
}
__device__ __forceinline__ void p10_norm2(Frame& F) {
    const int lane = pg8::mk_lane(), tid = F.wave * 64 + lane;
    LAS float* tab = (LAS float*)(F.lds + RING_OFF);
    const float* mv = (const float*)(F.ws + WS_MODV);
    for (int i = tid; i < 2 * D; i += NWAVES * 64) { const int part = i >> 12, k = i & (D - 1);
        tab[i] = part == 0 ? *(const GAS float*)(F.in[I_NORM2] + k) * (1.0f + *(const GAS float*)(mv + 4 * D + k)) : *(const GAS float*)(mv + 3 * D + k); }
    __syncthreads();
    const int gw = F.vcu * NWAVES + F.wave, NGW = F.G * NWAVES;
    bf16* A1 = (bf16*)(F.ws + WS_A1); const float* X1 = (const float*)(F.ws + WS_X1);
    for (int m = gw; m < T; m += NGW) norm_row(X1 + (size_t)m * D, A1 + (size_t)m * D, tab, tab + D, lane);
    __syncthreads();
}
__device__ __forceinline__ void p13_final(Frame& F) {
    const int lane = pg8::mk_lane();
    const int gw = F.vcu * NWAVES + F.wave, NGW = F.G * NWAVES;
    for (int m = gw; m < T; m += NGW) {
        GAS f32x4* xr = (GAS f32x4*)(F.out + (size_t)m * D) + lane;
        f32x4 v[16]; float s = 0.f;
#pragma unroll
        for (int j = 0; j < 16; ++j) { v[j] = xr[64 * j]; s += (v[j].x * v[j].x + v[j].y * v[j].y) + (v[j].z * v[j].z + v[j].w * v[j].w); }
        const float rstd = 1.0f / sqrtf(wave_sum(s) * (1.f / D) + NORM_EPS);
#pragma unroll
        for (int j = 0; j < 16; ++j) { const f32x4 g = *((const GAS f32x4*)F.in[I_NORMF] + lane + 64 * j); xr[64 * j] = v[j] * rstd * g; }
    }
}

__device__ __forceinline__ void ld8(const bf16* p, float (&f)[8]) { const v4u r = *(const GAS v4u*)p;
    f[0] = bflo(r.x); f[1] = bfhi(r.x); f[2] = bflo(r.y); f[3] = bfhi(r.y); f[4] = bflo(r.z); f[5] = bfhi(r.z); f[6] = bflo(r.w); f[7] = bfhi(r.w); }
__device__ __forceinline__ void ldf8(const float* p, float (&f)[8]) { const f32x4 a = *(const GAS f32x4*)p, b = *(const GAS f32x4*)(p + 4);
    f[0] = a.x; f[1] = a.y; f[2] = a.z; f[3] = a.w; f[4] = b.x; f[5] = b.y; f[6] = b.z; f[7] = b.w; }
__device__ __forceinline__ void stf8(float* p, const float (&f)[8]) { *(GAS f32x4*)p = (f32x4){f[0], f[1], f[2], f[3]}; *(GAS f32x4*)(p + 4) = (f32x4){f[4], f[5], f[6], f[7]}; }
__device__ __forceinline__ void stb8(bf16* p, const float (&f)[8]) { v4u o; o.x = pk2(f[0], f[1]); o.y = pk2(f[2], f[3]); o.z = pk2(f[4], f[5]); o.w = pk2(f[6], f[7]); *(GAS v4u*)p = o; }
__device__ __forceinline__ void za8(const bf16* Z, int row, bool hp, bool hn, int c, const float* mu, float (&o)[8]) {
    float zc[8], zp[8], zn[8], m8[8];
    ld8(Z + (size_t)row * NZ + c, zc);
    if (hp) ld8(Z + (size_t)(row - 1) * NZ + c, zp); else { _Pragma("unroll") for (int i = 0; i < 8; ++i) zp[i] = 0.f; }
    if (hn) ld8(Z + (size_t)(row + 1) * NZ + c, zn); else { _Pragma("unroll") for (int i = 0; i < 8; ++i) zn[i] = 0.f; }
    ldf8(mu + c, m8);
#pragma unroll
    for (int i = 0; i < 8; ++i) o[i] = zc[i] + m8[i] * (0.5f * (zp[i] + zn[i]) - zc[i]);
}
__device__ __forceinline__ void p3_prep(Frame& F) {
    const bf16* Z = (const bf16*)(F.ws + WS_Z);
    float* PS = (float*)(F.ws + WS_PS); float* KB = (float*)(F.ws + WS_KBUF);
    bf16* AL = (bf16*)(F.ws + WS_ALORA); bf16* AG = (bf16*)(F.ws + WS_AGATE); bf16* CAT = (bf16*)(F.ws + WS_CAT);
    const float* mu = F.in[I_MU];
    const int tpb = (TT + F.G - 1) / F.G;
    const int tok0 = F.vcu * tpb;
    const int lane = pg8::mk_lane();
    for (int it = F.wave; it < tpb * 18; it += NWAVES) {
        const int type = it / tpb, tok = tok0 + it % tpb;
        if (tok >= TT) continue;
        const bool isctx = tok >= T;
        const int pos = isctx ? tok - T : (tok & 63);
        const bool hp = pos > 0, hn = isctx ? (pos < CTXL - 1) : (pos < 63);
        if (type < 12) {
            const int kind = type >> 2, j = type & 3, c = j * 512 + lane * 8, h = c >> 6, ch = c & 63;
            if (isctx && kind == 2) continue;
            const int zoff = kind == 0 ? OFF_K : (kind == 1 ? OFF_V : OFF_R);
            float v[8]; za8(Z, tok, hp, hn, zoff + c, mu, v);
            float* ps = PS + ((size_t)h * TT + tok) * 192 + ch;
            if (kind == 0) {
                stf8(KB + (size_t)tok * 2048 + c, v);
                float kk8[8], q[8]; ldf8(F.in[I_KK] + c, kk8); float ss = 0.f;
#pragma unroll
                for (int i = 0; i < 8; ++i) { q[i] = v[i] * kk8[i]; ss += q[i] * q[i]; }
                ss += __shfl_xor(ss, 1); ss += __shfl_xor(ss, 2); ss += __shfl_xor(ss, 4);
                const float inv = -1.0f / fmaxf(sqrtf(ss), 1e-12f);
#pragma unroll
                for (int i = 0; i < 8; ++i) q[i] *= inv;
                stf8(ps, q);
            } else if (kind == 1) stf8(ps + 128, v);
            else stf8(ps + 64, v);
        } else if (type == 12) {
            if (lane < 32) {
                float v[8];
                if (lane < 24) { za8(Z, tok, hp, hn, OFF_WL + lane * 8, mu, v);
                    if (lane < 12) { _Pragma("unroll") for (int i = 0; i < 8; ++i) v[i] = tanhf(v[i]); } }
                else { _Pragma("unroll") for (int i = 0; i < 8; ++i) v[i] = 0.f; }
                stb8(AL + (size_t)tok * KLORA + lane * 8, v);
            }
        } else if (type == 13) {
            if (!isctx && lane < 32) { float v[8]; za8(Z, tok, hp, hn, OFF_GL + lane * 8, mu, v);
#pragma unroll
                for (int i = 0; i < 8; ++i) v[i] = sigm(v[i]);
                stb8(AG + (size_t)tok * KGATE + lane * 8, v); }
        } else if (!isctx) {
            const int j = type - 14, c = j * 512 + lane * 8;
            float bg[8], cc[8], xc[8], cp[8], xp[8], cn[8], xn[8], w0[8], w1[8], w2[8], y[8];
            const bf16* zr = Z + (size_t)tok * NZ;
            ld8(zr + OFF_CB + c, bg); ld8(zr + OFF_CC + c, cc); ld8(zr + OFF_CX + c, xc);
            if (hp) { ld8(zr - NZ + OFF_CC + c, cp); ld8(zr - NZ + OFF_CX + c, xp); } else { _Pragma("unroll") for (int i = 0; i < 8; ++i) { cp[i] = 0.f; xp[i] = 0.f; } }
            if (hn) { ld8(zr + NZ + OFF_CC + c, cn); ld8(zr + NZ + OFF_CX + c, xn); } else { _Pragma("unroll") for (int i = 0; i < 8; ++i) { cn[i] = 0.f; xn[i] = 0.f; } }
            ldf8(F.in[I_CONVW] + c, w0); ldf8(F.in[I_CONVW] + 2048 + c, w1); ldf8(F.in[I_CONVW] + 4096 + c, w2);
#pragma unroll
            for (int i = 0; i < 8; ++i) y[i] = bg[i] * (w0[i] * (cp[i] * xp[i]) + w1[i] * (cc[i] * xc[i]) + w2[i] * (cn[i] * xn[i]));
            stb8(CAT + (size_t)tok * D + DR + c, y);
        }
    }
}

__device__ __forceinline__ int scan_tokbase(int d, int c, int n) {
    const int i0 = 4 * n;
    if (c == 0) return T + (d == 0 ? i0 : CTXL - 4 - i0);
    const int p0 = (c - 1) * CHUNK + i0;
    return d == 0 ? p0 : T - 4 - p0;
}
__device__ __forceinline__ void scan_gload(const float* PD, const float* PS, int d, int h, int tb, int lane, f32x4 (&R)[6]) {
    const GAS f32x4* gd = (const GAS f32x4*)(PD + ((size_t)(d * 32 + h) * TT + tb) * 192) + lane;
    const GAS f32x4* gs = (const GAS f32x4*)(PS + ((size_t)h * TT + tb) * 192) + lane;
#pragma unroll
    for (int j = 0; j < 3; ++j) { R[j] = gd[64 * j]; R[3 + j] = gs[64 * j]; }
}
__device__ __forceinline__ void scan_lstore(LAS unsigned char* buf, int lane, const f32x4 (&R)[6]) {
#pragma unroll
    for (int j = 0; j < 6; ++j) *((LAS f32x4*)buf + 64 * j + lane) = R[j];
}
#define MK_FENCE() asm volatile("" ::: "memory")
__device__ __forceinline__ void p5_scanA(Frame& F) {
    const float* PD = (const float*)(F.ws + WS_PD); const float* PS = (const float*)(F.ws + WS_PS);
    float* PU = (float*)(F.ws + WS_PU);
    const int lane = pg8::mk_lane();
    LAS unsigned char* my = F.lds + RING_OFF + F.wave * 12288;
    for (int unit = F.vcu * NWAVES + F.wave; unit < 2048; unit += F.G * NWAVES) {
        const int d = unit & 1, h = (unit >> 1) & 31, c = unit >> 6;
        float P[64], U[64];
        const int lane_i = pg8::mk_lane();
#pragma unroll
        for (int k = 0; k < 64; ++k) { P[k] = (k == lane_i) ? 1.0f : 0.0f; U[k] = 0.0f; }
        f32x4 R[6];
        scan_gload(PD, PS, d, h, scan_tokbase(d, c, 0), lane, R); scan_lstore(my, lane, R);
        scan_gload(PD, PS, d, h, scan_tokbase(d, c, 1), lane, R);
        for (int n = 0; n < 64; ++n) {
            scan_lstore(my + ((n + 1) & 1) * 6144, lane, R);
            if (n + 2 < 64) scan_gload(PD, PS, d, h, scan_tokbase(d, c, n + 2), lane, R);
            const LAS unsigned char* buf = my + (n & 1) * 6144;
#pragma unroll 1
            for (int jj = 0; jj < 4; ++jj) {
                const int slot = d == 0 ? jj : 3 - jj;
                const LAS f32x4* pw = (const LAS f32x4*)(buf + slot * 768);
                const LAS f32x4* pa = (const LAS f32x4*)(buf + 3072 + slot * 768);
                const float vv = ((const LAS float*)pa)[128 + lane];
                f32x4 A[2][4], W[2][2], B[2][2], Kd[2][2];
#pragma unroll
                for (int j = 0; j < 4; ++j) A[0][j] = pa[j];
                float sp0 = 0.f, sp1 = 0.f, su0 = 0.f, su1 = 0.f;
#pragma unroll
                for (int s = 0; s < 4; ++s) {
                    if (s + 1 < 4) {
#pragma unroll
                        for (int j = 0; j < 4; ++j) A[(s + 1) & 1][j] = pa[4 * (s + 1) + j];
                    } else {
#pragma unroll
                        for (int j = 0; j < 2; ++j) { W[0][j] = pw[j]; B[0][j] = pw[16 + j]; Kd[0][j] = pw[32 + j]; }
                    }
                    MK_FENCE();
#pragma unroll
                    for (int j = 0; j < 4; ++j) { const f32x4 a = A[s & 1][j]; const int k = 16 * s + 4 * j;
                        sp0 += P[k] * a.x; sp1 += P[k + 1] * a.y; sp0 += P[k + 2] * a.z; sp1 += P[k + 3] * a.w;
                        su0 += U[k] * a.x; su1 += U[k + 1] * a.y; su0 += U[k + 2] * a.z; su1 += U[k + 3] * a.w; }
                }
                const float saP = sp0 + sp1, saU = su0 + su1;
#pragma unroll
                for (int s = 0; s < 8; ++s) {
                    if (s + 1 < 8) {
#pragma unroll
                        for (int j = 0; j < 2; ++j) { W[(s + 1) & 1][j] = pw[2 * (s + 1) + j]; B[(s + 1) & 1][j] = pw[16 + 2 * (s + 1) + j]; Kd[(s + 1) & 1][j] = pw[32 + 2 * (s + 1) + j]; }
                    }
                    MK_FENCE();
#pragma unroll
                    for (int j = 0; j < 2; ++j) { const f32x4 w = W[s & 1][j], bb = B[s & 1][j], kd = Kd[s & 1][j]; const int k = 8 * s + 4 * j;
#pragma unroll
                        for (int e = 0; e < 4; ++e) { P[k + e] = P[k + e] * w[e] + saP * bb[e]; U[k + e] = U[k + e] * w[e] + saU * bb[e] + vv * kd[e]; } }
                }
            }
        }
        GAS f32x4* po = (GAS f32x4*)(PU + ((size_t)unit * 2 + 0) * 4096 + lane * 64);
        GAS f32x4* uo = (GAS f32x4*)(PU + ((size_t)unit * 2 + 1) * 4096 + lane * 64);
#pragma unroll
        for (int k4 = 0; k4 < 16; ++k4) { po[k4] = (f32x4){P[4 * k4], P[4 * k4 + 1], P[4 * k4 + 2], P[4 * k4 + 3]}; uo[k4] = (f32x4){U[4 * k4], U[4 * k4 + 1], U[4 * k4 + 2], U[4 * k4 + 3]}; }
    }
}
__device__ __forceinline__ void p6_scanB(Frame& F) {
    const GAS char* PU = (const GAS char*)(F.ws + WS_PU); GAS char* SST = (GAS char*)(F.ws + WS_SST);
    LAS float* Pi = (LAS float*)(F.lds + RING_OFF);
    LAS float* Sb = (LAS float*)(F.lds + RING_OFF + 16384);
    const int w = F.wave;
    for (int q = F.vcu; q < 64; q += F.G) {
        const unsigned lane = (unsigned)pg8::mk_lane(), tid = (unsigned)w * 64u + lane;
        const unsigned rowoff = lane * 256u, myoff = lane * 256u + (unsigned)w * 32u;
        float S[64];
        {   const GAS char* u0 = PU + ((size_t)q * 2 + 1) * 16384;
#pragma unroll
            for (int k4 = 0; k4 < 16; ++k4) { const f32x4 t = *(const GAS f32x4*)(u0 + rowoff + 16u * k4); S[4 * k4] = t.x; S[4 * k4 + 1] = t.y; S[4 * k4 + 2] = t.z; S[4 * k4 + 3] = t.w; } }
        if (w == 0) {
            GAS char* so = SST + ((size_t)q * NCHUNK + 1) * 16384;
#pragma unroll
            for (int k4 = 0; k4 < 16; ++k4) *(GAS f32x4*)(so + rowoff + 16u * k4) = (f32x4){S[4 * k4], S[4 * k4 + 1], S[4 * k4 + 2], S[4 * k4 + 3]};
        }
        for (int c = 1; c < 32; ++c) {
            const size_t unit = (size_t)q + 64 * c;
            const GAS char* pg = PU + (unit * 2 + 0) * 16384; const GAS char* ug = PU + (unit * 2 + 1) * 16384;
            {   const f32x4 t0 = *(const GAS f32x4*)(pg + tid * 32u), t1 = *(const GAS f32x4*)(pg + tid * 32u + 16u);
                *((LAS f32x4*)Pi + tid * 2) = t0; *((LAS f32x4*)Pi + tid * 2 + 1) = t1; }
            f32x4 a0 = *(const GAS f32x4*)(ug + myoff), a1 = *(const GAS f32x4*)(ug + myoff + 16u);
            __syncthreads();
#pragma unroll
            for (int i = 0; i < 64; ++i) { const f32x4 p0 = *(const LAS f32x4*)(Pi + i * 64 + 8 * w), p1 = *(const LAS f32x4*)(Pi + i * 64 + 8 * w + 4);
                a0 += p0 * S[i]; a1 += p1 * S[i];
                if ((i & 7) == 7) MK_FENCE(); }
            *(LAS f32x4*)(Sb + lane * 68 + 8 * w) = a0; *(LAS f32x4*)(Sb + lane * 68 + 8 * w + 4) = a1;
            {   GAS char* so = SST + ((size_t)q * NCHUNK + c + 1) * 16384; *(GAS f32x4*)(so + myoff) = a0; *(GAS f32x4*)(so + myoff + 16u) = a1; }
            __syncthreads();
#pragma unroll
            for (int k4 = 0; k4 < 16; ++k4) { const f32x4 t = *(const LAS f32x4*)(Sb + lane * 68 + 4 * k4); S[4 * k4] = t.x; S[4 * k4 + 1] = t.y; S[4 * k4 + 2] = t.z; S[4 * k4 + 3] = t.w; }
        }
        __syncthreads();
    }
}
__device__ __forceinline__ void p7_scanC(Frame& F) {
    const float* PD = (const float*)(F.ws + WS_PD); const float* PS = (const float*)(F.ws + WS_PS);
    const float* SST = (const float*)(F.ws + WS_SST); float* YS = (float*)(F.ws + WS_YS);
    const int lane = pg8::mk_lane();
    LAS unsigned char* my = F.lds + RING_OFF + F.wave * 12288;
    for (int unit = F.vcu * NWAVES + F.wave; unit < 2048; unit += F.G * NWAVES) {
        const int d = unit & 1, h = (unit >> 1) & 31, c = (unit >> 6) + 1, q = unit & 63;
        float S[64];
        {   const GAS f32x4* s0 = (const GAS f32x4*)(SST + ((size_t)q * NCHUNK + c) * 4096 + lane * 64);
#pragma unroll
            for (int k4 = 0; k4 < 16; ++k4) { const f32x4 t = s0[k4]; S[4 * k4] = t.x; S[4 * k4 + 1] = t.y; S[4 * k4 + 2] = t.z; S[4 * k4 + 3] = t.w; } }
        f32x4 R[6];
        scan_gload(PD, PS, d, h, scan_tokbase(d, c, 0), lane, R); scan_lstore(my, lane, R);
        scan_gload(PD, PS, d, h, scan_tokbase(d, c, 1), lane, R);
        float* yo = YS + (size_t)d * T * 2048 + h * 64 + lane;
        for (int n = 0; n < 64; ++n) {
            scan_lstore(my + ((n + 1) & 1) * 6144, lane, R);
            if (n + 2 < 64) scan_gload(PD, PS, d, h, scan_tokbase(d, c, n + 2), lane, R);
            const LAS unsigned char* buf = my + (n & 1) * 6144;
            const int tb = scan_tokbase(d, c, n);
#pragma unroll 1
            for (int jj = 0; jj < 4; ++jj) {
                const int slot = d == 0 ? jj : 3 - jj;
                const LAS f32x4* pw = (const LAS f32x4*)(buf + slot * 768);
                const LAS f32x4* pa = (const LAS f32x4*)(buf + 3072 + slot * 768);
                const float vv = ((const LAS float*)pa)[128 + lane];
                f32x4 A[2][4], W[2][2], B[2][2], Kd[2][2], Rr[2][2];
#pragma unroll
                for (int j = 0; j < 4; ++j) A[0][j] = pa[j];
                float s0 = 0.f, s1 = 0.f, s2 = 0.f, s3 = 0.f;
#pragma unroll
                for (int s = 0; s < 4; ++s) {
                    if (s + 1 < 4) {
#pragma unroll
                        for (int j = 0; j < 4; ++j) A[(s + 1) & 1][j] = pa[4 * (s + 1) + j];
                    } else {
#pragma unroll
                        for (int j = 0; j < 2; ++j) { W[0][j] = pw[j]; B[0][j] = pw[16 + j]; Kd[0][j] = pw[32 + j]; Rr[0][j] = pa[16 + j]; }
                    }
                    MK_FENCE();
#pragma unroll
                    for (int j = 0; j < 4; ++j) { const f32x4 a = A[s & 1][j]; const int k = 16 * s + 4 * j;
                        s0 += S[k] * a.x; s1 += S[k + 1] * a.y; s2 += S[k + 2] * a.z; s3 += S[k + 3] * a.w; }
                }
                const float sa = (s0 + s1) + (s2 + s3);
                float y0 = 0.f, y1 = 0.f, y2 = 0.f, y3 = 0.f;
#pragma unroll
                for (int s = 0; s < 8; ++s) {
                    if (s + 1 < 8) {
#pragma unroll
                        for (int j = 0; j < 2; ++j) { W[(s + 1) & 1][j] = pw[2 * (s + 1) + j]; B[(s + 1) & 1][j] = pw[16 + 2 * (s + 1) + j]; Kd[(s + 1) & 1][j] = pw[32 + 2 * (s + 1) + j]; Rr[(s + 1) & 1][j] = pa[16 + 2 * (s + 1) + j]; }
                    }
                    MK_FENCE();
#pragma unroll
                    for (int j = 0; j < 2; ++j) { const f32x4 w = W[s & 1][j], bb = B[s & 1][j], kd = Kd[s & 1][j], r = Rr[s & 1][j]; const int k = 8 * s + 4 * j;
#pragma unroll
                        for (int e = 0; e < 4; ++e) S[k + e] = S[k + e] * w[e] + sa * bb[e] + vv * kd[e];
                        y0 += S[k] * r.x; y1 += S[k + 1] * r.y; y2 += S[k + 2] * r.z; y3 += S[k + 3] * r.w; }
                }
                *(GAS float*)(yo + (size_t)(tb + slot) * 2048) = (y0 + y1) + (y2 + y3);
            }
        }
    }
}

__device__ __forceinline__ void p8_readout(Frame& F) {
    const float* PD = (const float*)(F.ws + WS_PD); const float* PS = (const float*)(F.ws + WS_PS); const float* YS = (const float*)(F.ws + WS_YS);
    const bf16* G = (const bf16*)(F.ws + WS_G); bf16* CAT = (bf16*)(F.ws + WS_CAT);
    const int tpb = (T + F.G - 1) / F.G, tok0 = F.vcu * tpb, lane = pg8::mk_lane();
    for (int it = F.wave; it < tpb * 4; it += NWAVES) {
        const int j = it / tpb, tok = tok0 + it % tpb;
        if (tok >= T) continue;
        const int c = j * 512 + lane * 8, h = c >> 6, ch = c & 63;
        float y0[8], y1[8], y[8];
        ldf8(YS + (size_t)tok * 2048 + c, y0); ldf8(YS + ((size_t)T + tok) * 2048 + c, y1);
        float s = 0.f;
#pragma unroll
        for (int i = 0; i < 8; ++i) { y[i] = y0[i] + y1[i]; s += y[i]; }
        s += __shfl_xor(s, 1); s += __shfl_xor(s, 2); s += __shfl_xor(s, 4);
        const float mean = s * (1.0f / 64.0f); float q = 0.f;
#pragma unroll
        for (int i = 0; i < 8; ++i) { const float dlt = y[i] - mean; q += dlt * dlt; }
        q += __shfl_xor(q, 1); q += __shfl_xor(q, 2); q += __shfl_xor(q, 4);
        const float rstd = 1.0f / sqrtf(q * (1.0f / 64.0f) + LNX_EPS);
        float r8[8], v8[8], k0[8], k1[8], rk[8], lw[8], lb[8], g8[8];
        const float* ps = PS + ((size_t)h * TT + tok) * 192 + ch;
        ldf8(ps + 64, r8); ldf8(ps + 128, v8);
        ldf8(PD + ((size_t)h * TT + tok) * 192 + 128 + ch, k0); ldf8(PD + ((size_t)(32 + h) * TT + tok) * 192 + 128 + ch, k1);
        ldf8(F.in[I_RK] + c, rk); ldf8(F.in[I_LNXW] + c, lw); ldf8(F.in[I_LNXB] + c, lb);
        ld8(G + (size_t)tok * 2048 + c, g8);
        float dot = 0.f;
#pragma unroll
        for (int i = 0; i < 8; ++i) dot += r8[i] * (k0[i] + k1[i]) * rk[i];
        dot += __shfl_xor(dot, 1); dot += __shfl_xor(dot, 2); dot += __shfl_xor(dot, 4);
        float o[8];
#pragma unroll
        for (int i = 0; i < 8; ++i) o[i] = ((y[i] - mean) * rstd * lw[i] + lb[i] + dot * v8[i]) * g8[i];
        stb8(CAT + (size_t)tok * D + c, o);
    }
}

struct Args { const float* in[26]; float* out; unsigned char* ws; int ph_lo, ph_hi, li, pad; };
__global__ void __launch_bounds__(NWAVES * 64, 2) mk_fwd(Args args) {
    extern __shared__ __attribute__((aligned(16))) unsigned char lds[];
    Frame F;
    F.lds = (LAS unsigned char*)lds;
    F.MISC = (volatile LAS unsigned*)(F.lds + MISC_OFF);
    F.wave = __builtin_amdgcn_readfirstlane((int)(threadIdx.x >> 6));
    F.G = gridDim.x; { const int bx = blockIdx.x; F.vcu = (F.G % 8 == 0) ? (bx % 8) * (F.G / 8) + bx / 8 : bx; }
    F.ws = args.ws; F.ctl = (gu32*)(args.ws + WS_CTL); F.out = args.out;
#pragma unroll
    for (int i = 0; i < 26; ++i) F.in[i] = args.in[i];
    for (int u = threadIdx.x; u < (LDS_BYTES - LDSCTL_OFF) / 4; u += NWAVES * 64) ((LAS unsigned*)(F.lds + LDSCTL_OFF))[u] = 0u;
    __syncthreads();
    XcdBarrier bar; bar.bar = (unsigned*)(F.ctl + CW_BAR); bar.x = 0; bar.st = nullptr;
    if (N_LAUNCHES == 1) bar = xcd_barrier_post((unsigned*)(F.ctl + CW_BAR), F.MISC + 8);
#define GRID_BAR() do { if (N_LAUNCHES == 1) xcd_barrier(bar, F.wave); } while (0)
    const int lo = args.ph_lo, hi = args.ph_hi;
#define IN(k) (lo <= (k) && (k) < hi)
#define BOTH(k) (IN(k) && IN((k) + 1))
    bf16* A1 = (bf16*)(F.ws + WS_A1); bf16* Zb = (bf16*)(F.ws + WS_Z);
    const float* MV = (const float*)(F.ws + WS_MODV);

    if (IN(0)) { asm volatile("; MK_PHASE 0" ::: "memory"); p0_prologue(F); if (BOTH(0)) GRID_BAR(); }
    if (IN(1)) { asm volatile("; MK_PHASE 1" ::: "memory"); p1_norm1(F); if (BOTH(1)) GRID_BAR(); }
    if (IN(2)) { asm volatile("; MK_PHASE 2" ::: "memory");
        { pg8::Gemm g{A1, (const bf16*)(F.ws + WS_WIN), T, NZ, D}; pg8::StaticOrder S; S.init(T, NZ, F.G, (int)blockIdx.x);
          pg8::EpiBf16<0> E{Zb, NZ, nullptr, 0, 0, 1.f};
          pg8::gemm_phase<pg8::EpiBf16<0>, pg8::StaticOrder, true, true>(F.lds + RING_OFF, g, S, E, F.wave); }
        { pg8::Gemm g{A1 + (size_t)T * D, (const bf16*)(F.ws + WS_WIN), CTXL, NCTXZ, D}; pg8::StaticOrder S; S.init(CTXL, NCTXZ, F.G, (int)((blockIdx.x + F.G - 64) % F.G));
          pg8::EpiBf16<0> E{Zb + (size_t)T * NZ, NZ, nullptr, 0, 0, 1.f};
          pg8::gemm_phase<pg8::EpiBf16<0>, pg8::StaticOrder, true, true>(F.lds + RING_OFF, g, S, E, F.wave); }
        if (BOTH(2)) GRID_BAR();
    }
    if (IN(3)) { asm volatile("; MK_PHASE 3" ::: "memory"); p3_prep(F); if (BOTH(3)) GRID_BAR(); }
    if (IN(4)) { asm volatile("; MK_PHASE 4" ::: "memory");
        { pg8::Gemm g{(const bf16*)(F.ws + WS_ALORA), (const bf16*)(F.ws + WS_WLORA), TT, NLORA, KLORA}; pg8::StaticOrder S; S.init(TT, NLORA, F.G, (int)blockIdx.x);
          pg8::EpiLora E{(float*)(F.ws + WS_PD), (const float*)(F.ws + WS_PS), (const float*)(F.ws + WS_KBUF), F.in[I_W0], F.in[I_A0], F.in[I_KA], TT};
          pg8::gemm_phase<pg8::EpiLora, pg8::StaticOrder, true, true>(F.lds + RING_OFF, g, S, E, F.wave); }
        { pg8::Gemm g{(const bf16*)(F.ws + WS_AGATE), (const bf16*)(F.ws + WS_WGATE), T, DR, KGATE}; pg8::StaticOrder S; S.init(T, DR, F.G, (int)blockIdx.x);
          pg8::EpiBf16<0> E{(bf16*)(F.ws + WS_G), DR, nullptr, 0, 0, 1.f};
          pg8::gemm_phase<pg8::EpiBf16<0>, pg8::StaticOrder, true, true>(F.lds + RING_OFF, g, S, E, F.wave); }
        if (BOTH(4)) GRID_BAR();
    }
    if (IN(5)) { asm volatile("; MK_PHASE 5" ::: "memory"); p5_scanA(F); if (BOTH(5)) GRID_BAR(); }
    if (IN(6)) { asm volatile("; MK_PHASE 6" ::: "memory"); p6_scanB(F); if (BOTH(6)) GRID_BAR(); }
    if (IN(7)) { asm volatile("; MK_PHASE 7" ::: "memory"); p7_scanC(F); if (BOTH(7)) GRID_BAR(); }
    if (IN(8)) { asm volatile("; MK_PHASE 8" ::: "memory"); p8_readout(F); if (BOTH(8)) GRID_BAR(); }
    if (IN(9)) { asm volatile("; MK_PHASE 9" ::: "memory");
        pg8::Gemm g{(const bf16*)(F.ws + WS_CAT), (const bf16*)(F.ws + WS_WOUT), T, D, D}; pg8::StaticOrder S; S.init(T, D, F.G, (int)blockIdx.x);
        pg8::EpiResid E{F.in[I_X], (float*)(F.ws + WS_X1), D, MV + 2 * D};
        pg8::gemm_phase<pg8::EpiResid, pg8::StaticOrder, true, true>(F.lds + RING_OFF, g, S, E, F.wave);
        if (BOTH(9)) GRID_BAR();
    }
    if (IN(10)) { asm volatile("; MK_PHASE 10" ::: "memory"); p10_norm2(F); if (BOTH(10)) GRID_BAR(); }
    if (IN(11)) { asm volatile("; MK_PHASE 11" ::: "memory");
        pg8::Gemm g{A1, (const bf16*)(F.ws + WS_WGU), T, NGU, D}; pg8::StaticOrder S; S.init(T, NGU, F.G, (int)blockIdx.x);
        pg8::EpiSwiglu E{(bf16*)(F.ws + WS_ACT), DFF};
        pg8::gemm_phase<pg8::EpiSwiglu, pg8::StaticOrder, true, true>(F.lds + RING_OFF, g, S, E, F.wave);
        if (BOTH(11)) GRID_BAR();
    }
    if (IN(12)) { asm volatile("; MK_PHASE 12" ::: "memory");
        pg8::Gemm g{(const bf16*)(F.ws + WS_ACT), (const bf16*)(F.ws + WS_WDN), T, D, DFF}; pg8::StaticOrder S; S.init(T, D, F.G, (int)blockIdx.x);
        pg8::EpiResid E{(const float*)(F.ws + WS_X1), F.out, D, MV + 5 * D};
        pg8::gemm_phase<pg8::EpiResid, pg8::StaticOrder, true, true>(F.lds + RING_OFF, g, S, E, F.wave);
        if (BOTH(12)) GRID_BAR();
    }
    if (IN(13)) { asm volatile("; MK_PHASE 13" ::: "memory"); p13_final(F); }
#undef IN
#undef BOTH
}

extern "C" void kernel_launch(void* const* d_in, const int* in_sizes, int n_in, void* d_out, int out_size, void* d_ws, size_t ws_size, hipStream_t stream) {
    static int grid = 0;
    if (grid == 0) {
        if (n_in != 26 || out_size != T * D || ws_size < WS_END) { fprintf(stderr, "kernel_launch: unexpected shapes: n_in %d out %d ws %zu (need %zu)\n", n_in, out_size, ws_size, (size_t)WS_END); grid = -1; return; }
        int dev = 0, cus = 0, per_cu = 0;
        if (hipGetDevice(&dev) != hipSuccess || hipDeviceGetAttribute(&cus, hipDeviceAttributeMultiprocessorCount, dev) != hipSuccess) { grid = -1; return; }
        if (hipFuncSetAttribute((const void*)mk_fwd, hipFuncAttributeMaxDynamicSharedMemorySize, LDS_BYTES) != hipSuccess) { fprintf(stderr, "kernel_launch: hipFuncSetAttribute failed\n"); grid = -1; return; }
        if (hipOccupancyMaxActiveBlocksPerMultiprocessor(&per_cu, (const void*)mk_fwd, NWAVES * 64, LDS_BYTES) != hipSuccess || per_cu < 1)
            fprintf(stderr, "kernel_launch: note: occupancy query reports %d workgroups per CU\n", per_cu);
        (void)hipGetLastError();
        grid = cus;
    }
    if (grid < 0) return;
    if (hipMemsetAsync((char*)d_ws + WS_CTL, 0, CTL_ZERO_BYTES, stream) != hipSuccess) return;
    Args a{};
    for (int i = 0; i < 26; ++i) a.in[i] = (const float*)d_in[i];
    a.out = (float*)d_out; a.ws = (unsigned char*)d_ws;
    for (int li = 0; li < N_LAUNCHES; ++li) {
        if (N_LAUNCHES == 1) { a.ph_lo = 0; a.ph_hi = N_PHASES; } else { a.ph_lo = li * N_PHASES / N_LAUNCHES; a.ph_hi = (li + 1) * N_PHASES / N_LAUNCHES; }
        a.li = li;
        hipLaunchKernelGGL(mk_fwd, dim3(grid), dim3(NWAVES * 64), LDS_BYTES, stream, a);
        if (hipPeekAtLastError() != hipSuccess) break;
    }
}
```

```cpp
#include <hip/hip_runtime.h>
#include <cstdio>
#include <cstdint>
namespace pg8 {
#define PG8_LAS __attribute__((address_space(3)))
typedef unsigned short bf16_t;
typedef short bf16x8 __attribute__((ext_vector_type(8)));
typedef float f32x4 __attribute__((ext_vector_type(4)));
typedef unsigned u32x4 __attribute__((ext_vector_type(4)));
constexpr int BM = 256, BK = 64, HALF = 128, HTB = HALF * BK * 2  , STAGE_BYTES = 8 * HTB, NXCD = 8, WGM = 8;

__host__ __device__ __forceinline__ int lds_byte(int r, int c) { const int st = (r >> 4) * 2 + (c >> 5), rr = r & 15, cc = c & 31, ob = rr * 64 + cc * 2; return st * 1024 + (ob ^ (((ob >> 9) & 1) << 5)); }
__host__ __device__ __forceinline__ void stage_rc(int b, int& R, int& C) { const int st = b / 1024, sb = b % 1024, swz = sb ^ (((sb >> 9) & 1) << 5); R = (st >> 1) * 16 + swz / 64; C = (st & 1) * 32 + (swz % 64) / 2; }
__host__ __device__ __forceinline__ int perm32(int rho) { const int n = rho >> 4, i = rho & 15; return 8 * (i >> 2) + 4 * n + (i & 3); }

__device__ __forceinline__ int mk_lane() { int l; asm volatile("v_mbcnt_lo_u32_b32 %0, -1, 0\n\tv_mbcnt_hi_u32_b32 %0, -1, %0" : "=v"(l)); return l; }
struct Unit { int pm, pn; };
struct Gemm { const bf16_t* A; const bf16_t* Bt; int M, N, K; };

struct StaticOrder {
    int nM, nN, nwg, G, c;
    __host__ __device__ void init(int M, int N, int G_, int c_) { nM = M / BM; nN = N / BM; nwg = nM * nN; G = G_; c = c_; }
    __host__ __device__ bool next(int i, Unit& u) const {
        const long L = (long)i * G + c; if (L >= nwg) return false;
        int wgid = (int)L; { const int q = nwg / NXCD, r = nwg % NXCD, xcd = wgid % NXCD, off = wgid / NXCD; wgid = (xcd < r ? xcd * (q + 1) : r * (q + 1) + (xcd - r) * q) + off; }
        const int nig = WGM * nN, gid = wgid / nig, fm = gid * WGM, gsz = (nM - fm) < WGM ? (nM - fm) : WGM;
        u.pm = fm + ((wgid % nig) % gsz); u.pn = (wgid % nig) / gsz; return true;
    }
    __device__ __forceinline__ void a_ready(const Unit&) const {}
    __device__ __forceinline__ void done(const Unit&) const {}
};

__device__ __forceinline__ unsigned cvt_pk_bf16(float lo, float hi) { unsigned r; asm volatile("v_cvt_pk_bf16_f32 %0, %1, %2" : "=v"(r) : "v"(lo), "v"(hi)); return r; }
typedef float f32x2 __attribute__((ext_vector_type(2)));
__device__ __forceinline__ f32x2 gelu_pk(f32x2 v) {
    const f32x2 av = __builtin_elementwise_abs(v), d = av * 0.2316418882f + 1.0f;
    f32x2 t; t.x = __builtin_amdgcn_rcpf(d.x); t.y = __builtin_amdgcn_rcpf(d.y);
    f32x2 q = t * 0.5307027145f + (-0.7265760135f); q = q * t + 0.7107068705f; q = q * t + (-0.142248368f); q = q * t + 0.127414796f; q = q * t;
    const f32x2 s = (v * v) * (-0.72134752044f);
    f32x2 e; e.x = __builtin_amdgcn_exp2f(s.x); e.y = __builtin_amdgcn_exp2f(s.y);
    const f32x2 m = v * (q * e), r = v - m;
    f32x2 o; o.x = v.x < 0.f ? m.x : r.x; o.y = v.y < 0.f ? m.y : r.y; return o;
}

template <int ACT  > struct EpiBf16 {
    static constexpr bool PERM = true, AFTER_DRAIN = false; static_assert(ACT == 0 || ACT == 1, "EpiBf16: ACT is 0 (none) or 1 (gelu_pk)");
    bf16_t* O; int ldc; const float* bias; int split_cols; size_t split_stride; float scale0;
    __device__ __forceinline__ void operator()(const f32x4 (&acc)[2][2][4][2], const Unit& u, int wr, int wc, int fr, int fq) const {
        const int row0 = u.pm * BM + wr * 64 + fr; int colt = u.pn * BM; bf16_t* base = O;
        float sc = 1.f; if (split_cols) { const int t = colt / split_cols; base += (size_t)t * split_stride; colt -= t * split_cols; if (t == 0) sc = scale0; }
        const int col0 = colt + wc * 32 + 8 * fq, bcol0 = u.pn * BM + wc * 32 + 8 * fq;
        f32x4 bv[2][2];
#pragma unroll
        for (int bj = 0; bj < 2; ++bj)
#pragma unroll
            for (int n = 0; n < 2; ++n) bv[bj][n] = bias ? *(const f32x4*)(bias + bcol0 + bj * HALF + 4 * n) : (f32x4){0.f, 0.f, 0.f, 0.f};
#pragma unroll
        for (int ai = 0; ai < 2; ++ai)
#pragma unroll
            for (int m = 0; m < 4; ++m) { bf16_t* rowp = base + (size_t)(row0 + ai * HALF + m * 16) * ldc + col0;
#pragma unroll
                for (int bj = 0; bj < 2; ++bj) { f32x4 v0 = acc[ai][bj][m][0] + bv[bj][0], v1 = acc[ai][bj][m][1] + bv[bj][1];
                    if (ACT == 1) { f32x2 a = gelu_pk((f32x2){v0[0], v0[1]}), b = gelu_pk((f32x2){v0[2], v0[3]}), c = gelu_pk((f32x2){v1[0], v1[1]}), d = gelu_pk((f32x2){v1[2], v1[3]});
                        v0 = (f32x4){a.x, a.y, b.x, b.y}; v1 = (f32x4){c.x, c.y, d.x, d.y}; }
                    v0 = v0 * sc; v1 = v1 * sc; u32x4 w; w.x = cvt_pk_bf16(v0[0], v0[1]); w.y = cvt_pk_bf16(v0[2], v0[3]); w.z = cvt_pk_bf16(v1[0], v1[1]); w.w = cvt_pk_bf16(v1[2], v1[3]);
                    *(u32x4*)(rowp + bj * HALF) = w; } }
    }
};
__device__ __forceinline__ float sigmoidf_(float x) { return __builtin_amdgcn_rcpf(1.0f + __expf(-x)); }
struct EpiResid {
    static constexpr bool PERM = false, AFTER_DRAIN = false;
    const float* base; float* out; int ldc; const float* gvec;
    __device__ __forceinline__ void operator()(const f32x4 (&acc)[2][2][4][2], const Unit& u, int wr, int wc, int fr, int fq) const {
        const int row0 = u.pm * BM + wr * 64 + fr, col0 = u.pn * BM + wc * 32 + 4 * fq;
        f32x4 gv[2][2];
#pragma unroll
        for (int bj = 0; bj < 2; ++bj)
#pragma unroll
            for (int n = 0; n < 2; ++n) gv[bj][n] = *(const __attribute__((address_space(1))) f32x4*)(gvec + col0 + bj * HALF + n * 16);
#pragma unroll
        for (int ai = 0; ai < 2; ++ai)
#pragma unroll
            for (int m = 0; m < 4; ++m) { const size_t off = (size_t)(row0 + ai * HALF + m * 16) * ldc + col0;
#pragma unroll
                for (int bj = 0; bj < 2; ++bj)
#pragma unroll
                    for (int n = 0; n < 2; ++n) { const f32x4 bs = *(const __attribute__((address_space(1))) f32x4*)(base + off + bj * HALF + n * 16);
                        *(__attribute__((address_space(1))) f32x4*)(out + off + bj * HALF + n * 16) = bs + gv[bj][n] * acc[ai][bj][m][n]; }
                if (m & 1) asm volatile("" ::: "memory"); }
    }
};
struct EpiSwiglu {
    static constexpr bool PERM = true, AFTER_DRAIN = false;
    bf16_t* O; int ldc;
    __device__ __forceinline__ void operator()(const f32x4 (&acc)[2][2][4][2], const Unit& u, int wr, int wc, int fr, int fq) const {
        const int row0 = u.pm * BM + wr * 64 + fr, col0 = u.pn * HALF + wc * 32 + 8 * fq;
#pragma unroll
        for (int ai = 0; ai < 2; ++ai)
#pragma unroll
            for (int m = 0; m < 4; ++m) { bf16_t* rowp = O + (size_t)(row0 + ai * HALF + m * 16) * ldc + col0;
                f32x4 h0, h1;
#pragma unroll
                for (int j = 0; j < 4; ++j) { const float g0 = acc[ai][0][m][0][j], g1 = acc[ai][0][m][1][j];
                    h0[j] = g0 * sigmoidf_(g0) * acc[ai][1][m][0][j]; h1[j] = g1 * sigmoidf_(g1) * acc[ai][1][m][1][j]; }
                u32x4 w; w.x = cvt_pk_bf16(h0[0], h0[1]); w.y = cvt_pk_bf16(h0[2], h0[3]); w.z = cvt_pk_bf16(h1[0], h1[1]); w.w = cvt_pk_bf16(h1[2], h1[3]);
                *(__attribute__((address_space(1))) u32x4*)rowp = w; }
    }
};
template <int CTRL> __device__ __forceinline__ float dpp_f(float old, float src) { return __builtin_bit_cast(float, __builtin_amdgcn_update_dpp(__builtin_bit_cast(int, old), __builtin_bit_cast(int, src), CTRL, 0xf, 0xf, false)); }
struct EpiLora {
    static constexpr bool PERM = true, AFTER_DRAIN = false;
    float* PK; float* GE; bf16_t* KD; const float* kbuf; const float* kkbuf; const float* rbuf; const float* w0; const float* a0; const float* k_a; int TT;
    __device__ __forceinline__ void operator()(const f32x4 (&acc)[2][2][4][2], const Unit& u, int wr, int wc, int fr, int fq) const {
        typedef __attribute__((address_space(1))) f32x4 gf4; typedef const __attribute__((address_space(1))) f32x4 cgf4;
        const int d = u.pn >> 4, cg = u.pn & 15;
        const int c8 = cg * HALF + wc * 32 + 8 * fq, h = c8 >> 6, ch = c8 & 63;
        const int row0 = u.pm * BM + wr * 64 + fr;
#pragma unroll
        for (int n = 0; n < 2; ++n) {
            const f32x4 w0v = *(cgf4*)(w0 + d * 2048 + c8 + 4 * n), a0v = *(cgf4*)(a0 + d * 2048 + c8 + 4 * n), kav = *(cgf4*)(k_a + c8 + 4 * n);
            const int chn = ch + 4 * n;
#pragma unroll
            for (int ai = 0; ai < 2; ++ai)
#pragma unroll
                for (int m = 0; m < 4; ++m) {
                    const int tok = row0 + ai * HALF + m * 16;
                    f32x4 g, gp;
                    const f32x4 x = acc[ai][0][m][n] + w0v;
#pragma unroll
                    for (int j = 0; j < 4; ++j) { float w = __expf(-0.60653066f * sigmoidf_(x[j]));
                        if (d == 0) { w *= dpp_f<0x111>(1.0f, w); w *= dpp_f<0x112>(1.0f, w); w *= dpp_f<0x114>(1.0f, w); w *= dpp_f<0x118>(1.0f, w); g[j] = w; gp[j] = dpp_f<0x111>(1.0f, w); }
                        else        { w *= dpp_f<0x101>(1.0f, w); w *= dpp_f<0x102>(1.0f, w); w *= dpp_f<0x104>(1.0f, w); w *= dpp_f<0x108>(1.0f, w); g[j] = w; gp[j] = dpp_f<0x101>(1.0f, w); } }
                    float* pk = PK + ((size_t)(d * 32 + h) * TT + tok) * 256;
                    const size_t fo = (size_t)tok * 2048 + c8 + 4 * n;
                    const f32x4 xa = acc[ai][1][m][n] + a0v;
                    const f32x4 k4 = *(cgf4*)(kbuf + fo), kk4 = *(cgf4*)(kkbuf + fo), r4 = *(cgf4*)(rbuf + fo);
                    f32x4 at, rt, bt, kdt; float kdv[4];
#pragma unroll
                    for (int j = 0; j < 4; ++j) { const float a = sigmoidf_(xa[j]), rg = __builtin_amdgcn_rcpf(g[j]);
                        kdv[j] = k4[j] * (1.0f + (a - 1.0f) * kav[j]);
                        at[j] = -kk4[j] * gp[j]; rt[j] = r4[j] * g[j]; bt[j] = kk4[j] * a * rg; kdt[j] = kdv[j] * rg; }
                    *(gf4*)(pk + chn) = at; *(gf4*)(pk + 64 + chn) = rt;
                    *(gf4*)(pk + 128 + (chn >> 5) * 64 + (chn & 31)) = bt; *(gf4*)(pk + 160 + (chn >> 5) * 64 + (chn & 31)) = kdt;
                    typedef unsigned u32x2 __attribute__((ext_vector_type(2)));
                    u32x2 kw; kw.x = cvt_pk_bf16(kdv[0], kdv[1]); kw.y = cvt_pk_bf16(kdv[2], kdv[3]);
                    *(__attribute__((address_space(1))) u32x2*)(KD + (size_t)d * TT * 2048 + fo) = kw;
                    if (fr == (d == 0 ? 15 : 0)) *(gf4*)(GE + ((size_t)(d * 32 + h) * (TT / 16) + (tok >> 4)) * 64 + chn) = g;
                    asm volatile("" ::: "memory");
                }
        }
    }
};
template <class Epi, class Sched, bool ALIGN_EPI = false, bool SP2 = false>
__device__ __forceinline__ void gemm_phase(PG8_LAS unsigned char* lds, const Gemm g, const Sched& S, const Epi& E, const int wid) {
    const int lane = mk_lane(), tid = wid * 64 + lane, wr = wid >> 2, wc = wid & 3, fr = lane & 15, fq = lane >> 4;
    const int K = g.K, nt = K / BK;
    unsigned voffA[2], voffB[2];
#pragma unroll
    for (int i = 0; i < 2; ++i) { int R, C; stage_rc(tid * 16 + i * 8192, R, C); const int Rb = Epi::PERM ? ((R & ~31) + perm32(R & 31)) : R;
        voffA[i] = (unsigned)(R * K + C) * 2u; voffB[i] = (unsigned)(Rb * K + C) * 2u; }
    const size_t kstep = (size_t)(BK * 2);
    const size_t hstep = (size_t)HALF * K * 2;
    const size_t tstep = 2 * hstep;
    const unsigned ldsw = (unsigned)wid * 1024u;
    const int aoff = lds_byte(wr * 64 + fr, fq * 8), boff = lds_byte(wc * 32 + fr, fq * 8);
#define PG8_SA(b, h) (((b) * 2 + (h)) * HTB)
#define PG8_SB(b, h) ((4 + (b) * 2 + (h)) * HTB)
#define PG8_STAGE(bufoff, gbase, voff) do { _Pragma("unroll") for (int _i = 0; _i < 2; ++_i) \
        __builtin_amdgcn_global_load_lds((const unsigned*)((const char*)(gbase) + (voff)[_i]), (PG8_LAS unsigned*)(lds + (bufoff) + ldsw + _i * 8192), 16, 0, 0); } while (0)
#define PG8_LDA(dst, b, h) do { _Pragma("unroll") for (int m = 0; m < 4; ++m) _Pragma("unroll") for (int k = 0; k < 2; ++k) dst[m][k] = *(const PG8_LAS bf16x8*)(lds + PG8_SA(b, h) + aoff + m * 2048 + k * 1024); } while (0)
#define PG8_LDB(dst, b, h) do { _Pragma("unroll") for (int n = 0; n < 2; ++n) _Pragma("unroll") for (int k = 0; k < 2; ++k) dst[n][k] = *(const PG8_LAS bf16x8*)(lds + PG8_SB(b, h) + boff + n * 2048 + k * 1024); } while (0)
#define PG8_MMA(ai, bj, At, Bt) do { __builtin_amdgcn_s_setprio(1); _Pragma("unroll") for (int m = 0; m < 4; ++m) _Pragma("unroll") for (int n = 0; n < 2; ++n) _Pragma("unroll") for (int k = 0; k < 2; ++k) \
        acc[ai][bj][m][n] = __builtin_amdgcn_mfma_f32_16x16x32_bf16(Bt[n][k], At[m][k], acc[ai][bj][m][n], 0, 0, 0); __builtin_amdgcn_s_setprio(0); } while (0)
#define PG8_WAIT_V(n) asm volatile("s_waitcnt vmcnt(" #n ")" ::: "memory")
#define PG8_WAIT_L(n) asm volatile("s_waitcnt lgkmcnt(" #n ")" ::: "memory")
#define PG8_BAR __builtin_amdgcn_s_barrier()
#define PG8_SCHED __builtin_amdgcn_sched_barrier(0)
    Unit cur, nxt; int ui = 0;
    if (!S.next(0, cur)) return;
    f32x4 acc[2][2][4][2];
#pragma unroll
    for (int a = 0; a < 2; ++a)
#pragma unroll
        for (int b = 0; b < 2; ++b)
#pragma unroll
            for (int m = 0; m < 4; ++m)
#pragma unroll
                for (int n = 0; n < 2; ++n) acc[a][b][m][n] = (f32x4){0.f, 0.f, 0.f, 0.f};
    bf16x8 At[4][2], B0[2][2], B1[2][2];
    const char* cA = (const char*)g.A + (size_t)cur.pm * tstep; const char* cB = (const char*)g.Bt + (size_t)cur.pn * tstep;
    S.a_ready(cur);
    if constexpr (SP2) {
        PG8_STAGE(PG8_SB(0, 0), cB, voffB); PG8_STAGE(PG8_SB(0, 1), cB + hstep, voffB); PG8_STAGE(PG8_SA(0, 0), cA, voffA); PG8_STAGE(PG8_SA(0, 1), cA + hstep, voffA);
        if (wr == 1) PG8_BAR;
        PG8_WAIT_V(2); PG8_BAR;
        PG8_STAGE(PG8_SB(1, 0), cB + kstep, voffB); PG8_STAGE(PG8_SA(1, 0), cA + kstep, voffA); PG8_STAGE(PG8_SB(1, 1), cB + hstep + kstep, voffB);
        PG8_WAIT_V(6); PG8_BAR;
    } else {
        PG8_STAGE(PG8_SB(0, 0), cB, voffB); PG8_STAGE(PG8_SA(0, 0), cA, voffA); PG8_STAGE(PG8_SB(0, 1), cB + hstep, voffB); PG8_STAGE(PG8_SA(0, 1), cA + hstep, voffA);
        if (wr == 1) PG8_BAR;
        PG8_WAIT_V(4); PG8_BAR;
        PG8_STAGE(PG8_SB(1, 0), cB + kstep, voffB); PG8_STAGE(PG8_SA(1, 0), cA + kstep, voffA); PG8_STAGE(PG8_SB(1, 1), cB + hstep + kstep, voffB);
        PG8_WAIT_V(6); PG8_BAR;
    }
    for (;;) {
        const bool has_next = S.next(ui + 1, nxt);
        const char* nA = has_next ? (const char*)g.A + (size_t)nxt.pm * tstep : cA; const char* nB = has_next ? (const char*)g.Bt + (size_t)nxt.pn * tstep : cB;
        for (int t = 0; t < nt; t += 2) {
            const bool last = (t == nt - 2);
            const char* a1 = cA + (size_t)(t + 1) * kstep;
            const char* a2 = last ? nA : cA + (size_t)(t + 2) * kstep; const char* b2 = last ? nB : cB + (size_t)(t + 2) * kstep;
            const char* a3 = a2 + kstep; const char* b3 = b2 + kstep;
            if (last && has_next) S.a_ready(nxt);
            if constexpr (SP2) {
            PG8_LDB(B0, 0, 0); PG8_LDB(B1, 0, 1); PG8_SCHED; PG8_LDA(At, 0, 0); PG8_STAGE(PG8_SA(1, 1), a1 + hstep, voffA);
            PG8_WAIT_V(8); PG8_WAIT_L(0); PG8_BAR; PG8_MMA(0, 0, At, B0); PG8_MMA(0, 1, At, B1); PG8_BAR; PG8_SCHED;
            PG8_LDA(At, 0, 1); PG8_STAGE(PG8_SB(0, 0), b2, voffB); PG8_STAGE(PG8_SB(0, 1), b2 + hstep, voffB); PG8_STAGE(PG8_SA(0, 0), a2, voffA);
            PG8_WAIT_V(8); PG8_WAIT_L(0); PG8_BAR; PG8_MMA(1, 0, At, B0); PG8_MMA(1, 1, At, B1); PG8_BAR; PG8_SCHED;
            PG8_LDB(B0, 1, 0); PG8_LDB(B1, 1, 1); PG8_SCHED; PG8_LDA(At, 1, 0); PG8_STAGE(PG8_SA(0, 1), a2 + hstep, voffA);
            PG8_WAIT_V(8); PG8_WAIT_L(0); PG8_BAR; PG8_MMA(0, 0, At, B0); PG8_MMA(0, 1, At, B1); PG8_BAR; PG8_SCHED;
            PG8_LDA(At, 1, 1); PG8_STAGE(PG8_SB(1, 0), b3, voffB); PG8_STAGE(PG8_SB(1, 1), b3 + hstep, voffB); PG8_STAGE(PG8_SA(1, 0), a3, voffA);
            PG8_WAIT_V(8); PG8_WAIT_L(0); PG8_BAR; PG8_MMA(1, 0, At, B0); PG8_MMA(1, 1, At, B1); PG8_BAR; PG8_SCHED;
            } else {
            PG8_LDB(B0, 0, 0); PG8_SCHED; PG8_LDA(At, 0, 0); PG8_STAGE(PG8_SA(1, 1), a1 + hstep, voffA);
            PG8_WAIT_L(8); PG8_BAR; PG8_WAIT_L(0); PG8_MMA(0, 0, At, B0); PG8_BAR; PG8_SCHED;
            PG8_LDB(B1, 0, 1); PG8_STAGE(PG8_SB(0, 0), b2, voffB);
            PG8_BAR; PG8_WAIT_L(0); PG8_MMA(0, 1, At, B1); PG8_BAR;
            PG8_LDA(At, 0, 1); PG8_STAGE(PG8_SA(0, 0), a2, voffA);
            PG8_BAR; PG8_WAIT_L(0); PG8_MMA(1, 0, At, B0); PG8_BAR; PG8_SCHED;
            PG8_STAGE(PG8_SB(0, 1), b2 + hstep, voffB);
            PG8_WAIT_V(6); PG8_BAR; PG8_MMA(1, 1, At, B1); PG8_BAR;
            PG8_LDB(B0, 1, 0); PG8_SCHED; PG8_LDA(At, 1, 0); PG8_STAGE(PG8_SA(0, 1), a2 + hstep, voffA);
            PG8_WAIT_L(8); PG8_BAR; PG8_WAIT_L(0); PG8_MMA(0, 0, At, B0); PG8_BAR; PG8_SCHED;
            PG8_LDB(B1, 1, 1); PG8_STAGE(PG8_SB(1, 0), b3, voffB);
            PG8_BAR; PG8_WAIT_L(0); PG8_MMA(0, 1, At, B1); PG8_BAR;
            PG8_LDA(At, 1, 1); PG8_STAGE(PG8_SA(1, 0), a3, voffA);
            PG8_BAR; PG8_WAIT_L(0); PG8_MMA(1, 0, At, B0); PG8_BAR; PG8_SCHED;
            PG8_STAGE(PG8_SB(1, 1), b3 + hstep, voffB);
            PG8_WAIT_V(6); PG8_BAR; PG8_MMA(1, 1, At, B1); PG8_BAR;
            }
        }
        if constexpr (ALIGN_EPI) { if (wr == 0) PG8_BAR; }
        if constexpr (!Epi::AFTER_DRAIN) { const int l2 = mk_lane(); E(acc, cur, wr, wc, l2 & 15, l2 >> 4); S.done(cur); }
        if (!has_next) break;
#pragma unroll
        for (int a = 0; a < 2; ++a)
#pragma unroll
            for (int b = 0; b < 2; ++b)
#pragma unroll
                for (int m = 0; m < 4; ++m)
#pragma unroll
                    for (int n = 0; n < 2; ++n) acc[a][b][m][n] = (f32x4){0.f, 0.f, 0.f, 0.f};
        cur = nxt; cA = nA; cB = nB; ++ui;
        if constexpr (ALIGN_EPI) { if (wr == 1) PG8_BAR; }
    }
    PG8_WAIT_V(0);
    if constexpr (!ALIGN_EPI) { if (wr == 0) PG8_BAR; }
    PG8_BAR;
    if constexpr (Epi::AFTER_DRAIN) { E.fused(acc, cur, wr, wc, fr, fq, lds, wid, lane); S.done(cur); }
#undef PG8_SA
#undef PG8_SB
#undef PG8_STAGE
#undef PG8_LDA
#undef PG8_LDB
#undef PG8_MMA
#undef PG8_WAIT_V
#undef PG8_WAIT_L
#undef PG8_BAR
#undef PG8_SCHED
}
}

constexpr int NWAVES = 8;
#ifndef MK_N_LAUNCHES
#define MK_N_LAUNCHES 1
#endif
constexpr int N_PHASES = 14;
#ifndef MK_REPS
#define MK_REPS {1,1,1,1,1,1,1,1,1,1,1,1,1,1}
#endif
constexpr int PH_REPS[14] = MK_REPS;
constexpr int N_LAUNCHES = MK_N_LAUNCHES;

constexpr int D = 4096, T = 8192, CTXL = 256, TT = T + CTXL;
constexpr int DR = 2048, DC = 2048, NH = 32, HS = 64;
constexpr int OFF_K = 0, OFF_V = 2048, OFF_WL = 4096, OFF_AL = 4192, OFF_R = 4288, OFF_GL = 6336, RWKV_COLS = 6592;
constexpr int OFF_CB = 6592, OFF_CC = 8640, OFF_CX = 10688, IN_COLS = 12736, NZ = 12800;
constexpr int NCTXZ = 4352;
constexpr int DFF = 11008, NGU = 2 * DFF;
constexpr int NLORA = 8192, KLORA = 256, KGATE = 256;
constexpr int MODN = 6 * D;
constexpr int NKC = 16;
constexpr float NORM_EPS = 1e-6f, LNX_EPS = 64e-5f;
constexpr int CHUNK = 256, NCHUNK = 33;

constexpr size_t MiB = 1u << 20;
constexpr size_t WS_CTL = 0, CTL_ZERO_BYTES = 1 * MiB;
constexpr size_t WS_MODP = 1 * MiB;
constexpr size_t WS_MODV = 5 * MiB;
constexpr size_t WS_WLORA = 6 * MiB;
constexpr size_t WS_WGATE = 10 * MiB;
constexpr size_t WS_ALORA = 11 * MiB;
constexpr size_t WS_AGATE = 16 * MiB;
constexpr size_t WS_WOUT = 20 * MiB;
constexpr size_t WS_WGU = 52 * MiB;
constexpr size_t WS_WDN = 224 * MiB;
constexpr size_t WS_WIN = 310 * MiB;
constexpr size_t WS_PU = 310 * MiB;
constexpr size_t WS_SST = 374 * MiB;
constexpr size_t WS_A1 = 410 * MiB;
constexpr size_t WS_CAT = 410 * MiB;
constexpr size_t WS_Z = 476 * MiB;
constexpr size_t WS_YS = 476 * MiB;
constexpr size_t WS_KD = 604 * MiB;
constexpr size_t WS_GE = 670 * MiB;
constexpr size_t WS_KBUF = 683 * MiB;
constexpr size_t WS_KKBUF = 749 * MiB;
constexpr size_t WS_RBUF = 815 * MiB;
constexpr size_t WS_VBUF = 881 * MiB;
constexpr size_t WS_X1 = 683 * MiB;
constexpr size_t WS_PK = 947 * MiB;
constexpr size_t WS_ACT = 947 * MiB;
constexpr size_t WS_G = 1475 * MiB;
constexpr size_t WS_END = 1507 * MiB;
static_assert(WS_MODP + (size_t)NKC * 2 * MODN * 4 <= WS_MODV && WS_ALORA + (size_t)TT * 256 * 2 <= WS_AGATE && WS_WGU + (size_t)NGU * D * 2 <= WS_WDN && WS_WDN + (size_t)D * DFF * 2 <= WS_WIN, "ws map 1");
static_assert(WS_WIN + (size_t)NZ * D * 2 <= WS_A1 && WS_SST + (size_t)64 * NCHUNK * 16384 <= WS_A1 && WS_A1 + (size_t)TT * D * 2 <= WS_Z && WS_Z + (size_t)TT * NZ * 2 <= WS_KBUF, "ws map 2");
static_assert(WS_YS + (size_t)2 * T * 2048 * 4 <= WS_KD && WS_KD + (size_t)2 * TT * 2048 * 2 <= WS_GE && WS_GE + (size_t)64 * (TT / 16) * 256 <= WS_KBUF, "ws map 3");
static_assert(WS_KBUF + (size_t)TT * 2048 * 4 <= WS_KKBUF && WS_KKBUF + (size_t)TT * 2048 * 4 <= WS_RBUF && WS_RBUF + (size_t)TT * 2048 * 4 <= WS_VBUF && WS_VBUF + (size_t)TT * 2048 * 4 <= WS_PK, "ws map 4");
static_assert(WS_X1 + (size_t)T * D * 4 <= WS_RBUF && WS_PK + (size_t)64 * TT * 1024 <= WS_G && WS_ACT + (size_t)T * DFF * 2 <= WS_G && WS_G + (size_t)T * 2048 * 2 <= WS_END && WS_CAT + (size_t)T * D * 2 <= WS_Z, "ws map 5");
constexpr int CW_TMO = 0;
constexpr int CW_BAR = 4096;

constexpr int RING_OFF = 0, RING_BYTES = 131072;
constexpr int LDSCTL_OFF = RING_BYTES, MISC_OFF = LDSCTL_OFF + 320;
constexpr int LDS_BYTES = 147456;
static_assert(MISC_OFF + 128 <= LDS_BYTES, "LDS map");

#define GAS __attribute__((address_space(1)))
#define LAS __attribute__((address_space(3)))
typedef unsigned short bf16;
typedef unsigned v4u __attribute__((ext_vector_type(4)));
typedef unsigned v2u __attribute__((ext_vector_type(2)));
typedef float f32x4 __attribute__((ext_vector_type(4)));
typedef GAS unsigned gu32;
#define RLX_AGENT __ATOMIC_RELAXED, __HIP_MEMORY_SCOPE_AGENT
#define LDS_WAIT() asm volatile("s_waitcnt lgkmcnt(0)" ::: "memory")
#define VM_WAIT() asm volatile("s_waitcnt vmcnt(0)" ::: "memory")
__device__ __forceinline__ unsigned f2bf(float f) { unsigned u = __builtin_bit_cast(unsigned, f); return (u + 0x7fffu + ((u >> 16) & 1u)) >> 16; }
__device__ __forceinline__ unsigned pk2(float lo, float hi) { return f2bf(lo) | (f2bf(hi) << 16); }
__device__ __forceinline__ float bflo(unsigned w) { return __builtin_bit_cast(float, w << 16); }
__device__ __forceinline__ float bfhi(unsigned w) { return __builtin_bit_cast(float, w & 0xffff0000u); }
__device__ __forceinline__ float sigm(float x) { return 1.0f / (1.0f + __expf(-x)); }

#define XB_TMO      128
#define XB_XCNT(j)  (256  + 64 * (j))
#define XB_XSUB(j)  (1280 + 64 * (j))
#define XB_XGEN(j)  (2304 + 64 * (j))
#define XB_TOP      3328
#define XB_TOPGEN   3392
#define XCD_BAR_WORDS 3456
#define XB_SPIN_CAP (1u << 18)
__device__ __forceinline__ unsigned xb_ld(unsigned* p)              { return __hip_atomic_load(p, __ATOMIC_RELAXED, __HIP_MEMORY_SCOPE_AGENT); }
__device__ __forceinline__ unsigned xb_add(unsigned* p, unsigned v) { return __hip_atomic_fetch_add(p, v, __ATOMIC_RELAXED, __HIP_MEMORY_SCOPE_AGENT); }
__device__ __forceinline__ unsigned xb_xcc_id() { return (unsigned)__builtin_amdgcn_s_getreg((3 << 11) | 20) & 0xFu; }
#define XB_SPIN(cond, bar) do { unsigned _sp = 0; while (cond) { __builtin_amdgcn_s_sleep(1); \
    if ((++_sp & 255u) == 0u) { if (xb_ld(&(bar)[XB_TMO])) break; if (_sp > XB_SPIN_CAP) { atomicAdd(&(bar)[XB_TMO], 1u); break; } } } } while (0)
struct XcdBarrier { unsigned* bar; unsigned x; volatile LAS unsigned* st; };
__device__ __forceinline__ XcdBarrier xcd_barrier_post(unsigned* bar, volatile LAS unsigned* st) {
    XcdBarrier b; b.bar = bar; b.x = xb_xcc_id(); b.st = st;
    if (threadIdx.x == 0) (void)xb_add(&bar[XB_XCNT(b.x)], 1u);
    return b;
}
__device__ __forceinline__ void xcd_barrier_complete(unsigned* bar, unsigned x, unsigned& nloc, unsigned& nx) {
    const unsigned G = gridDim.x * gridDim.y * gridDim.z;
    unsigned sum, cnt, mine, sp = 0u;
    for (;;) {
        sum = 0u; cnt = 0u; mine = 0u;
#pragma unroll
        for (unsigned j = 0; j < 16; ++j) { const unsigned c = xb_ld(&bar[XB_XCNT(j)]); sum += c; cnt += (c > 0u) ? 1u : 0u; mine = (j == x) ? c : mine; }
        if (sum == G) break;
        __builtin_amdgcn_s_sleep(1);
        if ((++sp & 255u) == 0u) { if (xb_ld(&bar[XB_TMO])) break; if (sp > XB_SPIN_CAP) { atomicAdd(&bar[XB_TMO], 1u); break; } }
    }
    nloc = mine > 0u ? mine : 1u; nx = cnt > 0u ? cnt : 1u;
}
__device__ __forceinline__ void xcd_barrier(const XcdBarrier& b, const int wave) {
    asm volatile("s_waitcnt vmcnt(0)" ::: "memory");
    __syncthreads();
    if (wave == 0 && pg8::mk_lane() == 0) {
        unsigned* bar = b.bar;
        __builtin_amdgcn_s_waitcnt(0);
        unsigned nloc = b.st[0], nx = b.st[1];
        if (nloc == 0u) { xcd_barrier_complete(bar, b.x, nloc, nx); b.st[0] = nloc; b.st[1] = nx; }
        const unsigned old = xb_add(&bar[XB_XSUB(b.x)], 1u);
        const unsigned gen = old / nloc;
        if (old + 1u == (gen + 1u) * nloc) {
            __builtin_amdgcn_fence(__ATOMIC_RELEASE, "agent");
            asm volatile("s_waitcnt vmcnt(0)" ::: "memory");
            const unsigned og = xb_add(&bar[XB_TOP], 1u);
            const unsigned tg = og / nx;
            if (og + 1u == (tg + 1u) * nx) xb_add(&bar[XB_TOPGEN], 1u);
            else XB_SPIN(xb_ld(&bar[XB_TOPGEN]) == tg, bar);
            __builtin_amdgcn_fence(__ATOMIC_ACQUIRE, "agent");
            xb_add(&bar[XB_XGEN(b.x)], 1u);
            asm volatile("s_waitcnt vmcnt(0)" ::: "memory");
        } else {
            XB_SPIN(xb_ld(&bar[XB_XGEN(b.x)]) == gen, bar);
            __builtin_amdgcn_fence(__ATOMIC_ACQUIRE, "agent");
            asm volatile("s_waitcnt vmcnt(0)" ::: "memory");
        }
    }
    __syncthreads();
}

struct Frame {
    LAS unsigned char* lds;
    volatile LAS unsigned* MISC;
    gu32* ctl;
    int wave;
    int vcu, G;
    unsigned char* ws;
    const float* in[26];
    float* out;
};
enum { I_X = 0, I_C, I_CTX, I_CCTX, I_WADA, I_BADA, I_NORM1, I_WIN, I_MU, I_KK, I_KA, I_RK, I_W0, I_WDU, I_A0, I_WIU, I_WGU, I_LNXW, I_LNXB, I_CONVW, I_WOUT, I_NORM2, I_WFG, I_WFU, I_WFD, I_NORMF };

__device__ __forceinline__ float wave_sum(float v) {
#pragma unroll
    for (int o = 1; o < 64; o <<= 1) v += __shfl_xor(v, o);
    return v;
}

__device__ __forceinline__ void p0_transpose_item(const float* W, int K, int N, bf16* WT, int ldk, int row_off, LAS float* scr, int item, int lane) {
    const int nblk = N / 32, kb = item / nblk, nb = item % nblk, k0 = 64 * kb, n0 = 32 * nb;
#pragma unroll 8
    for (int i = 0; i < 32; ++i) { const int kk = 2 * i + (lane >> 5); scr[kk * 33 + (lane & 31)] = *(const GAS float*)(W + (size_t)(k0 + kk) * N + n0 + (lane & 31)); }
    LDS_WAIT(); asm volatile("" ::: "memory");
    const int c = lane & 7;
#pragma unroll
    for (int j = 0; j < 4; ++j) { const int n = (lane >> 3) + 8 * j; const LAS float* s = scr + (8 * c) * 33 + n;
        v4u o; o.x = pk2(s[0 * 33], s[1 * 33]); o.y = pk2(s[2 * 33], s[3 * 33]); o.z = pk2(s[4 * 33], s[5 * 33]); o.w = pk2(s[6 * 33], s[7 * 33]);
        *(GAS v4u*)(WT + (size_t)(row_off + n0 + n) * ldk + k0 + 8 * c) = o; }
    LDS_WAIT(); asm volatile("" ::: "memory");
}
constexpr int TI_IN = (D / 64) * (IN_COLS / 32), TI_OUT = (D / 64) * (D / 32), TI_G = (D / 64) * (DFF / 32), TI_DN = (DFF / 64) * (D / 32);
constexpr int TI_TOTAL = TI_IN + TI_OUT + 2 * TI_G + TI_DN;
constexpr int GEMV_UNITS = NKC * (MODN / 256);
constexpr int TI_PER_GEMV_WAVE = 43, TI_PER_OTHER_WAVE = 67;
static_assert(GEMV_UNITS <= 2048 && GEMV_UNITS * TI_PER_GEMV_WAVE + (2048 - GEMV_UNITS) * TI_PER_OTHER_WAVE >= TI_TOTAL, "P0 item split");

__device__ __forceinline__ void p0_gemv_unit(Frame& F, int unit, int lane) {
    const int kc = unit / (MODN / 256), cc = unit % (MODN / 256);
    const int k0 = kc * 256, col = cc * 256 + lane * 4;
    int sv[4], sc[4];
#pragma unroll
    for (int q = 0; q < 4; ++q) { const float c = *(const GAS float*)(F.in[I_C] + k0 + q * 64 + lane), cx = *(const GAS float*)(F.in[I_CCTX] + k0 + q * 64 + lane);
        sv[q] = __builtin_bit_cast(int, c * sigm(c)); sc[q] = __builtin_bit_cast(int, cx * sigm(cx)); }
    f32x4 a0 = (f32x4){0.f, 0.f, 0.f, 0.f}, a1 = a0;
    const GAS f32x4* wp = (const GAS f32x4*)(F.in[I_WADA] + (size_t)k0 * MODN + col);
#pragma unroll
    for (int q = 0; q < 4; ++q) {
#pragma unroll 16
        for (int i = 0; i < 64; ++i) { const f32x4 w = wp[(size_t)(q * 64 + i) * (MODN / 4)];
            const float s = __builtin_bit_cast(float, __builtin_amdgcn_readlane(sv[q], i)), t = __builtin_bit_cast(float, __builtin_amdgcn_readlane(sc[q], i));
            a0 += w * s; a1 += w * t; }
    }
    float* mp = (float*)(F.ws + WS_MODP);
    *(GAS f32x4*)(mp + (size_t)(kc * 2 + 0) * MODN + col) = a0;
    *(GAS f32x4*)(mp + (size_t)(kc * 2 + 1) * MODN + col) = a1;
}

__device__ __forceinline__ void p0_prologue(Frame& F) {
    LAS float* scr = (LAS float*)(F.lds + RING_OFF + F.wave * 16384);
    const int lane = pg8::mk_lane();
    const int gw = F.vcu * NWAVES + F.wave, NGW = F.G * NWAVES;
    const int gt = gw * 64 + lane, NGT = NGW * 64;
    {
        unsigned* wl = (unsigned*)(F.ws + WS_WLORA);
        for (int i = gt; i < NLORA * KLORA / 2; i += NGT) { const int n = i >> 7, k = (i & 127) * 2, pn = n >> 8, d = pn >> 4, isic = (n >> 7) & 1, ch = (pn & 15) * 128 + (n & 127); float v0 = 0.f, v1 = 0.f;
            if (k < 96) { if (!isic) { v0 = *(const GAS float*)(F.in[I_WDU] + (size_t)(d * 96 + k) * 2048 + ch); v1 = *(const GAS float*)(F.in[I_WDU] + (size_t)(d * 96 + k + 1) * 2048 + ch); } }
            else if (k < 192) { if (isic) { v0 = *(const GAS float*)(F.in[I_WIU] + (size_t)(d * 96 + k - 96) * 2048 + ch); v1 = *(const GAS float*)(F.in[I_WIU] + (size_t)(d * 96 + k - 95) * 2048 + ch); } }
            *(GAS unsigned*)(wl + i) = pk2(v0, v1); }
        unsigned* wg = (unsigned*)(F.ws + WS_WGATE);
        for (int i = gt; i < 2048 * KGATE / 2; i += NGT) { const int n = i >> 7, k = (i & 127) * 2;
            *(GAS unsigned*)(wg + i) = pk2(*(const GAS float*)(F.in[I_WGU] + (size_t)k * 2048 + n), *(const GAS float*)(F.in[I_WGU] + (size_t)(k + 1) * 2048 + n)); }
        v4u* zp = (v4u*)(F.ws + WS_WIN + (size_t)IN_COLS * D * 2);
        for (int i = gt; i < (NZ - IN_COLS) * D * 2 / 16; i += NGT) *(GAS v4u*)(zp + i) = (v4u){0u, 0u, 0u, 0u};
    }
    for (int u = gw; u < GEMV_UNITS; u += NGW) p0_gemv_unit(F, u, lane);
    int it0, it1;
    if (gw < GEMV_UNITS) { it0 = gw * TI_PER_GEMV_WAVE; it1 = it0 + TI_PER_GEMV_WAVE; }
    else { it0 = GEMV_UNITS * TI_PER_GEMV_WAVE + (gw - GEMV_UNITS) * TI_PER_OTHER_WAVE; it1 = it0 + TI_PER_OTHER_WAVE; }
    if (NGW != 2048) { const int per = (TI_TOTAL + NGW - 1) / NGW; it0 = gw * per; it1 = it0 + per; if (gw >= GEMV_UNITS) { } }
    if (it1 > TI_TOTAL) it1 = TI_TOTAL;
    for (int it = it0; it < it1; ++it) {
        int r = it;
        if (r < TI_IN) { p0_transpose_item(F.in[I_WIN], D, IN_COLS, (bf16*)(F.ws + WS_WIN), D, 0, scr, r, lane); continue; } r -= TI_IN;
        if (r < TI_OUT) { p0_transpose_item(F.in[I_WOUT], D, D, (bf16*)(F.ws + WS_WOUT), D, 0, scr, r, lane); continue; } r -= TI_OUT;
        if (r < TI_G) { const int n0 = 32 * (r % (DFF / 32)); p0_transpose_item(F.in[I_WFG], D, DFF, (bf16*)(F.ws + WS_WGU), D, 256 * (n0 >> 7) + (n0 & 127) - n0, scr, r, lane); continue; } r -= TI_G;
        if (r < TI_G) { const int n0 = 32 * (r % (DFF / 32)); p0_transpose_item(F.in[I_WFU], D, DFF, (bf16*)(F.ws + WS_WGU), D, 256 * (n0 >> 7) + 128 + (n0 & 127) - n0, scr, r, lane); continue; } r -= TI_G;
        p0_transpose_item(F.in[I_WFD], DFF, D, (bf16*)(F.ws + WS_WDN), DFF, 0, scr, r, lane);
    }
}

__device__ __forceinline__ void norm_row(const float* xrow, bf16* orow, const LAS float* gs, const LAS float* sh, int lane) {
    const GAS f32x4* xr = (const GAS f32x4*)xrow + lane;
    f32x4 v[16]; float s = 0.f;
#pragma unroll
    for (int j = 0; j < 16; ++j) { v[j] = xr[64 * j]; s += (v[j].x * v[j].x + v[j].y * v[j].y) + (v[j].z * v[j].z + v[j].w * v[j].w); }
    const float rstd = 1.0f / sqrtf(wave_sum(s) * (1.f / D) + NORM_EPS);
    GAS v2u* o8 = (GAS v2u*)orow + lane;
#pragma unroll
    for (int j = 0; j < 16; ++j) { const f32x4 g = *(const LAS f32x4*)(gs + 4 * lane + 256 * j), b = *(const LAS f32x4*)(sh + 4 * lane + 256 * j);
        const f32x4 y = v[j] * rstd * g + b; v2u o; o.x = pk2(y.x, y.y); o.y = pk2(y.z, y.w); o8[64 * j] = o; }
}
__device__ __forceinline__ void p1_norm1(Frame& F) {
    const int lane = pg8::mk_lane(), tid = F.wave * 64 + lane;
    LAS float* tab = (LAS float*)(F.lds + RING_OFF);
    const float* mp = (const float*)(F.ws + WS_MODP);
    for (int i = tid; i < 4 * D; i += NWAVES * 64) {
        const int which = i >> 12, k = i & (D - 1), isc = which >> 1, part = which & 1;
        const int col = part == 0 ? D + k : k;
        float s = *(const GAS float*)(F.in[I_BADA] + col);
#pragma unroll
        for (int p = 0; p < NKC; ++p) s += *(const GAS float*)(mp + (size_t)(p * 2 + isc) * MODN + col);
        tab[i] = part == 0 ? *(const GAS float*)(F.in[I_NORM1] + k) * (1.0f + s) : s;
    }
    {
        float* mv = (float*)(F.ws + WS_MODV);
        for (int i = F.vcu * (NWAVES * 64) + tid; i < 2 * MODN; i += F.G * NWAVES * 64) { const int isc = i / MODN, col = i % MODN;
            float s = *(const GAS float*)(F.in[I_BADA] + col);
#pragma unroll
            for (int p = 0; p < NKC; ++p) s += *(const GAS float*)(mp + (size_t)(p * 2 + isc) * MODN + col);
            *(GAS float*)(mv + i) = s; }
    }
    __syncthreads();
    const int gw = F.vcu * NWAVES + F.wave, NGW = F.G * NWAVES;
    bf16* A1 = (bf16*)(F.ws + WS_A1);
    for (int m = gw; m < TT; m += NGW) {
        if (m < T) norm_row(F.in[I_X] + (size_t)m * D, A1 + (size_t)m * D, tab, tab + D, lane);
        else norm_row(F.in[I_CTX] + (size_t)(m - T) * D, A1 + (size_t)m * D, tab + 2 * D, tab + 3 * D, lane);
    }
    __syncthreads();
}
__device__ __forceinline__ void p10_norm2(Frame& F) {
    const int lane = pg8::mk_lane(), tid = F.wave * 64 + lane;
    LAS float* tab = (LAS float*)(F.lds + RING_OFF);
    const float* mv = (const float*)(F.ws + WS_MODV);
    for (int i = tid; i < 2 * D; i += NWAVES * 64) { const int part = i >> 12, k = i & (D - 1);
        tab[i] = part == 0 ? *(const GAS float*)(F.in[I_NORM2] + k) * (1.0f + *(const GAS float*)(mv + 4 * D + k)) : *(const GAS float*)(mv + 3 * D + k); }
    __syncthreads();
    const int gw = F.vcu * NWAVES + F.wave, NGW = F.G * NWAVES;
    bf16* A1 = (bf16*)(F.ws + WS_A1); const float* X1 = (const float*)(F.ws + WS_X1);
    for (int m = gw; m < T; m += NGW) norm_row(X1 + (size_t)m * D, A1 + (size_t)m * D, tab, tab + D, lane);
    __syncthreads();
}
__device__ __forceinline__ void p13_final(Frame& F) {
    const int lane = pg8::mk_lane();
    const int gw = F.vcu * NWAVES + F.wave, NGW = F.G * NWAVES;
    for (int m = gw; m < T; m += NGW) {
        GAS f32x4* xr = (GAS f32x4*)(F.out + (size_t)m * D) + lane;
        f32x4 v[16]; float s = 0.f;
#pragma unroll
        for (int j = 0; j < 16; ++j) { v[j] = xr[64 * j]; s += (v[j].x * v[j].x + v[j].y * v[j].y) + (v[j].z * v[j].z + v[j].w * v[j].w); }
        const float rstd = 1.0f / sqrtf(wave_sum(s) * (1.f / D) + NORM_EPS);
#pragma unroll
        for (int j = 0; j < 16; ++j) { const f32x4 g = *((const GAS f32x4*)F.in[I_NORMF] + lane + 64 * j); xr[64 * j] = v[j] * rstd * g; }
    }
}

__device__ __forceinline__ void ld8(const bf16* p, float (&f)[8]) { const v4u r = *(const GAS v4u*)p;
    f[0] = bflo(r.x); f[1] = bfhi(r.x); f[2] = bflo(r.y); f[3] = bfhi(r.y); f[4] = bflo(r.z); f[5] = bfhi(r.z); f[6] = bflo(r.w); f[7] = bfhi(r.w); }
__device__ __forceinline__ void ldf8(const float* p, float (&f)[8]) { const f32x4 a = *(const GAS f32x4*)p, b = *(const GAS f32x4*)(p + 4);
    f[0] = a.x; f[1] = a.y; f[2] = a.z; f[3] = a.w; f[4] = b.x; f[5] = b.y; f[6] = b.z; f[7] = b.w; }
__device__ __forceinline__ void stf8(float* p, const float (&f)[8]) { *(GAS f32x4*)p = (f32x4){f[0], f[1], f[2], f[3]}; *(GAS f32x4*)(p + 4) = (f32x4){f[4], f[5], f[6], f[7]}; }
__device__ __forceinline__ void stb8(bf16* p, const float (&f)[8]) { v4u o; o.x = pk2(f[0], f[1]); o.y = pk2(f[2], f[3]); o.z = pk2(f[4], f[5]); o.w = pk2(f[6], f[7]); *(GAS v4u*)p = o; }
__device__ __forceinline__ void za8(const bf16* Z, int row, bool hp, bool hn, int c, const float* mu, float (&o)[8]) {
    float zc[8], zp[8], zn[8], m8[8];
    ld8(Z + (size_t)row * NZ + c, zc);
    if (hp) ld8(Z + (size_t)(row - 1) * NZ + c, zp); else { _Pragma("unroll") for (int i = 0; i < 8; ++i) zp[i] = 0.f; }
    if (hn) ld8(Z + (size_t)(row + 1) * NZ + c, zn); else { _Pragma("unroll") for (int i = 0; i < 8; ++i) zn[i] = 0.f; }
    ldf8(mu + c, m8);
#pragma unroll
    for (int i = 0; i < 8; ++i) o[i] = zc[i] + m8[i] * (0.5f * (zp[i] + zn[i]) - zc[i]);
}
__device__ __forceinline__ void p3_prep(Frame& F) {
    const bf16* Z = (const bf16*)(F.ws + WS_Z);
    float* KB = (float*)(F.ws + WS_KBUF); float* KKB = (float*)(F.ws + WS_KKBUF); float* RB = (float*)(F.ws + WS_RBUF); float* VB = (float*)(F.ws + WS_VBUF);
    bf16* AL = (bf16*)(F.ws + WS_ALORA); bf16* AG = (bf16*)(F.ws + WS_AGATE); bf16* CAT = (bf16*)(F.ws + WS_CAT);
    const float* mu = F.in[I_MU];
    const int tpb = (TT + F.G - 1) / F.G;
    const int tok0 = F.vcu * tpb;
    const int lane = pg8::mk_lane();
    for (int it = F.wave; it < tpb * 18; it += NWAVES) {
        const int type = it / tpb, tok = tok0 + it % tpb;
        if (tok >= TT) continue;
        const bool isctx = tok >= T;
        const int pos = isctx ? tok - T : (tok & 63);
        const bool hp = pos > 0, hn = isctx ? (pos < CTXL - 1) : (pos < 63);
        if (type < 12) {
            const int kind = type >> 2, j = type & 3, c = j * 512 + lane * 8;
            if (isctx && kind == 2) continue;
            const int zoff = kind == 0 ? OFF_K : (kind == 1 ? OFF_V : OFF_R);
            float v[8]; za8(Z, tok, hp, hn, zoff + c, mu, v);
            const size_t fo = (size_t)tok * 2048 + c;
            if (kind == 0) {
                stf8(KB + fo, v);
                float kk8[8], q[8]; ldf8(F.in[I_KK] + c, kk8); float ss = 0.f;
#pragma unroll
                for (int i = 0; i < 8; ++i) { q[i] = v[i] * kk8[i]; ss += q[i] * q[i]; }
                ss += __shfl_xor(ss, 1); ss += __shfl_xor(ss, 2); ss += __shfl_xor(ss, 4);
                const float inv = 1.0f / fmaxf(sqrtf(ss), 1e-12f);
#pragma unroll
                for (int i = 0; i < 8; ++i) q[i] *= inv;
                stf8(KKB + fo, q);
            } else if (kind == 1) stf8(VB + fo, v);
            else stf8(RB + fo, v);
        } else if (type == 12) {
            if (lane < 32) {
                float v[8];
                if (lane < 24) { za8(Z, tok, hp, hn, OFF_WL + lane * 8, mu, v);
                    if (lane < 12) { _Pragma("unroll") for (int i = 0; i < 8; ++i) v[i] = tanhf(v[i]); } }
                else { _Pragma("unroll") for (int i = 0; i < 8; ++i) v[i] = 0.f; }
                stb8(AL + (size_t)tok * KLORA + lane * 8, v);
            }
        } else if (type == 13) {
            if (!isctx && lane < 32) { float v[8]; za8(Z, tok, hp, hn, OFF_GL + lane * 8, mu, v);
#pragma unroll
                for (int i = 0; i < 8; ++i) v[i] = sigm(v[i]);
                stb8(AG + (size_t)tok * KGATE + lane * 8, v); }
        } else if (!isctx) {
            const int j = type - 14, c = j * 512 + lane * 8;
            float bg[8], cc[8], xc[8], cp[8], xp[8], cn[8], xn[8], w0[8], w1[8], w2[8], y[8];
            const bf16* zr = Z + (size_t)tok * NZ;
            ld8(zr + OFF_CB + c, bg); ld8(zr + OFF_CC + c, cc); ld8(zr + OFF_CX + c, xc);
            if (hp) { ld8(zr - NZ + OFF_CC + c, cp); ld8(zr - NZ + OFF_CX + c, xp); } else { _Pragma("unroll") for (int i = 0; i < 8; ++i) { cp[i] = 0.f; xp[i] = 0.f; } }
            if (hn) { ld8(zr + NZ + OFF_CC + c, cn); ld8(zr + NZ + OFF_CX + c, xn); } else { _Pragma("unroll") for (int i = 0; i < 8; ++i) { cn[i] = 0.f; xn[i] = 0.f; } }
            ldf8(F.in[I_CONVW] + c, w0); ldf8(F.in[I_CONVW] + 2048 + c, w1); ldf8(F.in[I_CONVW] + 4096 + c, w2);
#pragma unroll
            for (int i = 0; i < 8; ++i) y[i] = bg[i] * (w0[i] * (cp[i] * xp[i]) + w1[i] * (cc[i] * xc[i]) + w2[i] * (cn[i] * xn[i]));
            stb8(CAT + (size_t)tok * D + DR + c, y);
        }
    }
}

typedef float f32x16 __attribute__((ext_vector_type(16)));
#define MK_FENCE() asm volatile("" ::: "memory")
__device__ __forceinline__ void swap32(float& x, float& y) { asm volatile("s_nop 1\n\tv_permlane32_swap_b32 %0, %1\n\ts_nop 1" : "+v"(x), "+v"(y)); }
__device__ __forceinline__ int scan_tokbase(int d, int c, int n) {
    const int i0 = 4 * n;
    if (c == 0) return T + (d == 0 ? i0 : CTXL - 4 - i0);
    const int p0 = (c - 1) * CHUNK + i0;
    return d == 0 ? p0 : T - 4 - p0;
}
struct ScanRegs { f32x4 p[4]; float v[4]; };
__device__ __forceinline__ void scan_gload(const float* PK, const float* VB, int d, int h, int tb, int lane, ScanRegs& R) {
    const GAS f32x4* gp = (const GAS f32x4*)(PK + ((size_t)(d * 32 + h) * TT + tb) * 256) + lane;
    const GAS float* gv = (const GAS float*)(VB + (size_t)tb * 2048 + h * 64) + lane;
#pragma unroll
    for (int j = 0; j < 4; ++j) { R.p[j] = gp[64 * j]; R.v[j] = gv[2048 * j]; }
}
__device__ __forceinline__ void scan_lstore(LAS unsigned char* buf, int lane, const ScanRegs& R) {
#pragma unroll
    for (int j = 0; j < 4; ++j) { *((LAS f32x4*)buf + 64 * j + lane) = R.p[j]; *((LAS float*)(buf + 4096) + 64 * j + lane) = R.v[j]; }
}
__device__ __forceinline__ void scan_matvec(const f32x16 (&Tt)[2][2], const LAS float* vec, int hl, float& sa) {
    float p0a = 0.f, p0b = 0.f, p1a = 0.f, p1b = 0.f;
#pragma unroll
    for (int I = 0; I < 2; ++I)
#pragma unroll
        for (int qd = 0; qd < 4; ++qd) { const f32x4 a = *(const LAS f32x4*)(vec + 32 * I + 8 * qd + 4 * hl);
            p0a += Tt[I][0][4 * qd] * a.x; p0b += Tt[I][0][4 * qd + 1] * a.y; p0a += Tt[I][0][4 * qd + 2] * a.z; p0b += Tt[I][0][4 * qd + 3] * a.w;
            p1a += Tt[I][1][4 * qd] * a.x; p1b += Tt[I][1][4 * qd + 1] * a.y; p1a += Tt[I][1][4 * qd + 2] * a.z; p1b += Tt[I][1][4 * qd + 3] * a.w; }
    float p0 = p0a + p0b, p1 = p1a + p1b;
    swap32(p0, p1);
    sa = p0 + p1;
}
__device__ __forceinline__ void scan_renorm(f32x16 (&Tt)[2][2], const float* ge, int hl) {
#pragma unroll
    for (int I = 0; I < 2; ++I)
#pragma unroll
        for (int qd = 0; qd < 4; ++qd) { const f32x4 g = *(const GAS f32x4*)(ge + 32 * I + 8 * qd + 4 * hl);
#pragma unroll
            for (int e = 0; e < 4; ++e) { Tt[I][0][4 * qd + e] *= g[e]; Tt[I][1][4 * qd + e] *= g[e]; } }
}
__device__ __forceinline__ void scan_store_T(const f32x16 (&Tt)[2][2], float* dst, int lane) {
#pragma unroll
    for (int I = 0; I < 2; ++I)
#pragma unroll
        for (int J = 0; J < 2; ++J)
#pragma unroll
            for (int reg = 0; reg < 16; ++reg) *(GAS float*)(dst + (32 * I + 8 * (reg >> 2) + 4 * (lane >> 5) + (reg & 3)) * 64 + 32 * J + (lane & 31)) = Tt[I][J][reg];
}
__device__ __forceinline__ void p5_scanA(Frame& F) {
    const float* PK = (const float*)(F.ws + WS_PK); const float* VB = (const float*)(F.ws + WS_VBUF); const float* GE = (const float*)(F.ws + WS_GE);
    float* PU = (float*)(F.ws + WS_PU);
    LAS unsigned char* my = F.lds + RING_OFF + F.wave * 10240;
    for (int unit = F.vcu * NWAVES + F.wave; unit < 2048; unit += F.G * NWAVES) {
        const int d = unit & 1, h = (unit >> 1) & 31, c = unit >> 6;
        const int lane = pg8::mk_lane(), hl = lane >> 5;
        f32x16 TP[2][2], TU[2][2];
#pragma unroll
        for (int I = 0; I < 2; ++I)
#pragma unroll
            for (int J = 0; J < 2; ++J)
#pragma unroll
                for (int reg = 0; reg < 16; ++reg) { TP[I][J][reg] = (32 * I + 8 * (reg >> 2) + 4 * hl + (reg & 3) == 32 * J + (lane & 31)) ? 1.0f : 0.0f; TU[I][J][reg] = 0.0f; }
        ScanRegs RA, RB;
        scan_gload(PK, VB, d, h, scan_tokbase(d, c, 0), lane, RA); scan_lstore(my, lane, RA);
        scan_gload(PK, VB, d, h, scan_tokbase(d, c, 1), lane, RA);
        scan_gload(PK, VB, d, h, scan_tokbase(d, c, 2), lane, RB);
#pragma unroll 1
        for (int n2 = 0; n2 < 32; ++n2) {
#pragma unroll
            for (int par = 0; par < 2; ++par) {
                const int n = 2 * n2 + par;
                ScanRegs& R = par == 0 ? RA : RB;
                scan_lstore(my + ((n + 1) & 1) * 5120, lane, R);
                if (n + 3 < 64) scan_gload(PK, VB, d, h, scan_tokbase(d, c, n + 3), lane, R);
                const LAS unsigned char* buf = my + (n & 1) * 5120;
#pragma unroll 1
                for (int jj = 0; jj < 4; ++jj) {
                    const int slot = d == 0 ? jj : 3 - jj;
                    const LAS float* pk = (const LAS float*)(buf + slot * 1024);
                    float vv = ((const LAS float*)(buf + 4096))[slot * 64 + lane];
                    float bk0 = pk[128 + lane], bk1 = pk[192 + lane];
                    float saP, saU;
                    {
                        float p0a = 0.f, p0b = 0.f, p1a = 0.f, p1b = 0.f, u0a = 0.f, u0b = 0.f, u1a = 0.f, u1b = 0.f;
#pragma unroll
                        for (int I = 0; I < 2; ++I)
#pragma unroll
                            for (int qd = 0; qd < 4; ++qd) { const f32x4 a = *(const LAS f32x4*)(pk + 32 * I + 8 * qd + 4 * hl);
                                p0a += TP[I][0][4 * qd] * a.x; p0b += TP[I][0][4 * qd + 1] * a.y; p0a += TP[I][0][4 * qd + 2] * a.z; p0b += TP[I][0][4 * qd + 3] * a.w;
                                p1a += TP[I][1][4 * qd] * a.x; p1b += TP[I][1][4 * qd + 1] * a.y; p1a += TP[I][1][4 * qd + 2] * a.z; p1b += TP[I][1][4 * qd + 3] * a.w;
                                u0a += TU[I][0][4 * qd] * a.x; u0b += TU[I][0][4 * qd + 1] * a.y; u0a += TU[I][0][4 * qd + 2] * a.z; u0b += TU[I][0][4 * qd + 3] * a.w;
                                u1a += TU[I][1][4 * qd] * a.x; u1b += TU[I][1][4 * qd + 1] * a.y; u1a += TU[I][1][4 * qd + 2] * a.z; u1b += TU[I][1][4 * qd + 3] * a.w; }
                        float p0 = p0a + p0b, p1 = p1a + p1b, u0 = u0a + u0b, u1 = u1a + u1b;
                        swap32(p0, p1); swap32(u0, u1); saP = p0 + p1; saU = u0 + u1;
                    }
                    float zz = 0.0f;
                    swap32(saU, vv);
                    swap32(saP, zz);
                    TU[0][0] = __builtin_amdgcn_mfma_f32_32x32x2f32(bk0, saU, TU[0][0], 0, 0, 0); TU[0][1] = __builtin_amdgcn_mfma_f32_32x32x2f32(bk0, vv, TU[0][1], 0, 0, 0);
                    TU[1][0] = __builtin_amdgcn_mfma_f32_32x32x2f32(bk1, saU, TU[1][0], 0, 0, 0); TU[1][1] = __builtin_amdgcn_mfma_f32_32x32x2f32(bk1, vv, TU[1][1], 0, 0, 0);
                    TP[0][0] = __builtin_amdgcn_mfma_f32_32x32x2f32(bk0, saP, TP[0][0], 0, 0, 0); TP[0][1] = __builtin_amdgcn_mfma_f32_32x32x2f32(bk0, zz, TP[0][1], 0, 0, 0);
                    TP[1][0] = __builtin_amdgcn_mfma_f32_32x32x2f32(bk1, saP, TP[1][0], 0, 0, 0); TP[1][1] = __builtin_amdgcn_mfma_f32_32x32x2f32(bk1, zz, TP[1][1], 0, 0, 0);
                }
                if ((n & 3) == 3) {
                    const int tbk = scan_tokbase(d, c, n - 3 + (d == 0 ? 0 : 3));
                    const float* ge = GE + ((size_t)(d * 32 + h) * (TT / 16) + (tbk >> 4)) * 64;
                    scan_renorm(TP, ge, hl); scan_renorm(TU, ge, hl);
                }
            }
        }
        scan_store_T(TP, PU + ((size_t)unit * 2 + 0) * 4096, lane);
        scan_store_T(TU, PU + ((size_t)unit * 2 + 1) * 4096, lane);
    }
}
__device__ __forceinline__ void p6_scanB(Frame& F) {
    const GAS char* PU = (const GAS char*)(F.ws + WS_PU); GAS char* SST = (GAS char*)(F.ws + WS_SST);
    LAS float* Pi = (LAS float*)(F.lds + RING_OFF);
    LAS float* Tb = (LAS float*)(F.lds + RING_OFF + 16384);
    const int w = F.wave;
    for (int q = F.vcu; q < 64; q += F.G) {
        const unsigned lane = (unsigned)pg8::mk_lane(), tid = (unsigned)w * 64u + lane;
        float Tc[64];
        {   const GAS char* u0 = PU + ((size_t)q * 2 + 1) * 16384;
#pragma unroll
            for (int i = 0; i < 64; ++i) Tc[i] = *(const GAS float*)(u0 + (unsigned)i * 256u + lane * 4u); }
        if (w == 0) {
            GAS char* so = SST + ((size_t)q * NCHUNK + 1) * 16384;
#pragma unroll
            for (int i = 0; i < 64; ++i) *(GAS float*)(so + (unsigned)i * 256u + lane * 4u) = Tc[i];
        }
        for (int c = 1; c < 32; ++c) {
            const size_t unit = (size_t)q + 64 * c;
            const GAS char* pg = PU + (unit * 2 + 0) * 16384; const GAS char* ug = PU + (unit * 2 + 1) * 16384;
            {   const f32x4 t0 = *(const GAS f32x4*)(pg + tid * 32u), t1 = *(const GAS f32x4*)(pg + tid * 32u + 16u);
                *((LAS f32x4*)Pi + tid * 2) = t0; *((LAS f32x4*)Pi + tid * 2 + 1) = t1; }
            float o[8];
#pragma unroll
            for (int kk = 0; kk < 8; ++kk) o[kk] = *(const GAS float*)(ug + (unsigned)(8 * w + kk) * 256u + lane * 4u);
            __syncthreads();
#pragma unroll
            for (int kk = 0; kk < 8; ++kk) {
                float s0 = 0.f, s1 = 0.f;
#pragma unroll
                for (int i4 = 0; i4 < 16; ++i4) { const f32x4 p = *(const LAS f32x4*)(Pi + (8 * w + kk) * 64 + 4 * i4);
                    s0 += p.x * Tc[4 * i4]; s1 += p.y * Tc[4 * i4 + 1]; s0 += p.z * Tc[4 * i4 + 2]; s1 += p.w * Tc[4 * i4 + 3]; }
                o[kk] += s0 + s1;
                MK_FENCE();
            }
            {   GAS char* so = SST + ((size_t)q * NCHUNK + c + 1) * 16384;
#pragma unroll
                for (int kk = 0; kk < 8; ++kk) { Tb[(8 * w + kk) * 64 + lane] = o[kk]; *(GAS float*)(so + (unsigned)(8 * w + kk) * 256u + lane * 4u) = o[kk]; } }
            __syncthreads();
#pragma unroll
            for (int i = 0; i < 64; ++i) Tc[i] = Tb[i * 64 + lane];
        }
        __syncthreads();
    }
}
__device__ __forceinline__ void p7_scanC(Frame& F) {
    const float* PK = (const float*)(F.ws + WS_PK); const float* VB = (const float*)(F.ws + WS_VBUF); const float* GE = (const float*)(F.ws + WS_GE);
    const float* SST = (const float*)(F.ws + WS_SST); float* YS = (float*)(F.ws + WS_YS);
    LAS unsigned char* my = F.lds + RING_OFF + F.wave * 10240;
    for (int unit = F.vcu * NWAVES + F.wave; unit < 2048; unit += F.G * NWAVES) {
        const int d = unit & 1, h = (unit >> 1) & 31, c = (unit >> 6) + 1, q = unit & 63;
        const int lane = pg8::mk_lane(), hl = lane >> 5;
        f32x16 Tt[2][2];
        {   const float* s0 = SST + ((size_t)q * NCHUNK + c) * 4096;
#pragma unroll
            for (int I = 0; I < 2; ++I)
#pragma unroll
                for (int J = 0; J < 2; ++J)
#pragma unroll
                    for (int reg = 0; reg < 16; ++reg) Tt[I][J][reg] = *(const GAS float*)(s0 + (32 * I + 8 * (reg >> 2) + 4 * hl + (reg & 3)) * 64 + 32 * J + (lane & 31)); }
        ScanRegs RA, RB;
        scan_gload(PK, VB, d, h, scan_tokbase(d, c, 0), lane, RA); scan_lstore(my, lane, RA);
        scan_gload(PK, VB, d, h, scan_tokbase(d, c, 1), lane, RA);
        scan_gload(PK, VB, d, h, scan_tokbase(d, c, 2), lane, RB);
        float* yo = YS + (size_t)d * T * 2048 + h * 64 + lane;
#pragma unroll 1
        for (int n2 = 0; n2 < 32; ++n2) {
#pragma unroll
            for (int par = 0; par < 2; ++par) {
                const int n = 2 * n2 + par;
                ScanRegs& R = par == 0 ? RA : RB;
                scan_lstore(my + ((n + 1) & 1) * 5120, lane, R);
                if (n + 3 < 64) scan_gload(PK, VB, d, h, scan_tokbase(d, c, n + 3), lane, R);
                const LAS unsigned char* buf = my + (n & 1) * 5120;
                const int tb = scan_tokbase(d, c, n);
#pragma unroll 1
                for (int jj = 0; jj < 4; ++jj) {
                    const int slot = d == 0 ? jj : 3 - jj;
                    const LAS float* pk = (const LAS float*)(buf + slot * 1024);
                    float vv = ((const LAS float*)(buf + 4096))[slot * 64 + lane];
                    float bk0 = pk[128 + lane], bk1 = pk[192 + lane];
                    float sa; scan_matvec(Tt, pk, hl, sa);
                    swap32(sa, vv);
                    Tt[0][0] = __builtin_amdgcn_mfma_f32_32x32x2f32(bk0, sa, Tt[0][0], 0, 0, 0); Tt[0][1] = __builtin_amdgcn_mfma_f32_32x32x2f32(bk0, vv, Tt[0][1], 0, 0, 0);
                    Tt[1][0] = __builtin_amdgcn_mfma_f32_32x32x2f32(bk1, sa, Tt[1][0], 0, 0, 0); Tt[1][1] = __builtin_amdgcn_mfma_f32_32x32x2f32(bk1, vv, Tt[1][1], 0, 0, 0);
                    float y; scan_matvec(Tt, pk + 64, hl, y);
                    *(GAS float*)(yo + (size_t)(tb + slot) * 2048) = y;
                }
                if ((n & 3) == 3) {
                    const int tbk = scan_tokbase(d, c, n - 3 + (d == 0 ? 0 : 3));
                    scan_renorm(Tt, GE + ((size_t)(d * 32 + h) * (TT / 16) + (tbk >> 4)) * 64, hl);
                }
            }
        }
    }
}

__device__ __forceinline__ void p8_readout(Frame& F) {
    const float* RB = (const float*)(F.ws + WS_RBUF); const float* VB = (const float*)(F.ws + WS_VBUF); const float* YS = (const float*)(F.ws + WS_YS);
    const bf16* KD = (const bf16*)(F.ws + WS_KD);
    const bf16* G = (const bf16*)(F.ws + WS_G); bf16* CAT = (bf16*)(F.ws + WS_CAT);
    const int tpb = (T + F.G - 1) / F.G, tok0 = F.vcu * tpb, lane = pg8::mk_lane();
    for (int it = F.wave; it < tpb * 4; it += NWAVES) {
        const int j = it / tpb, tok = tok0 + it % tpb;
        if (tok >= T) continue;
        const int c = j * 512 + lane * 8;
        float y0[8], y1[8], y[8];
        ldf8(YS + (size_t)tok * 2048 + c, y0); ldf8(YS + ((size_t)T + tok) * 2048 + c, y1);
        float s = 0.f;
#pragma unroll
        for (int i = 0; i < 8; ++i) { y[i] = y0[i] + y1[i]; s += y[i]; }
        s += __shfl_xor(s, 1); s += __shfl_xor(s, 2); s += __shfl_xor(s, 4);
        const float mean = s * (1.0f / 64.0f); float q = 0.f;
#pragma unroll
        for (int i = 0; i < 8; ++i) { const float dlt = y[i] - mean; q += dlt * dlt; }
        q += __shfl_xor(q, 1); q += __shfl_xor(q, 2); q += __shfl_xor(q, 4);
        const float rstd = 1.0f / sqrtf(q * (1.0f / 64.0f) + LNX_EPS);
        float r8[8], v8[8], k0[8], k1[8], rk[8], lw[8], lb[8], g8[8];
        ldf8(RB + (size_t)tok * 2048 + c, r8); ldf8(VB + (size_t)tok * 2048 + c, v8);
        ld8(KD + (size_t)tok * 2048 + c, k0); ld8(KD + ((size_t)TT + tok) * 2048 + c, k1);
        ldf8(F.in[I_RK] + c, rk); ldf8(F.in[I_LNXW] + c, lw); ldf8(F.in[I_LNXB] + c, lb);
        ld8(G + (size_t)tok * 2048 + c, g8);
        float dot = 0.f;
#pragma unroll
        for (int i = 0; i < 8; ++i) dot += r8[i] * (k0[i] + k1[i]) * rk[i];
        dot += __shfl_xor(dot, 1); dot += __shfl_xor(dot, 2); dot += __shfl_xor(dot, 4);
        float o[8];
#pragma unroll
        for (int i = 0; i < 8; ++i) o[i] = ((y[i] - mean) * rstd * lw[i] + lb[i] + dot * v8[i]) * g8[i];
        stb8(CAT + (size_t)tok * D + c, o);
    }
}

template <int K> __device__ __forceinline__ void run_phase(Frame& F) {
    bf16* A1 = (bf16*)(F.ws + WS_A1); bf16* Zb = (bf16*)(F.ws + WS_Z);
    const float* MV = (const float*)(F.ws + WS_MODV);
    (void)A1; (void)Zb; (void)MV;
    asm volatile("; MK_PHASE %0" :: "i"(K) : "memory");
    if constexpr (K == 0) { p0_prologue(F);
    }
    if constexpr (K == 1) { p1_norm1(F);
    }
    if constexpr (K == 2) {
        { pg8::Gemm g{A1, (const bf16*)(F.ws + WS_WIN), T, NZ, D}; pg8::StaticOrder S; S.init(T, NZ, F.G, (int)blockIdx.x);
          pg8::EpiBf16<0> E{Zb, NZ, nullptr, 0, 0, 1.f};
          pg8::gemm_phase<pg8::EpiBf16<0>, pg8::StaticOrder, true, true>(F.lds + RING_OFF, g, S, E, F.wave); }
        { pg8::Gemm g{A1 + (size_t)T * D, (const bf16*)(F.ws + WS_WIN), CTXL, NCTXZ, D}; pg8::StaticOrder S; S.init(CTXL, NCTXZ, F.G, (int)((blockIdx.x + F.G - 64) % F.G));
          pg8::EpiBf16<0> E{Zb + (size_t)T * NZ, NZ, nullptr, 0, 0, 1.f};
          pg8::gemm_phase<pg8::EpiBf16<0>, pg8::StaticOrder, true, true>(F.lds + RING_OFF, g, S, E, F.wave); }

    }
    if constexpr (K == 3) { p3_prep(F);
    }
    if constexpr (K == 4) {
        { int kl = KLORA; asm volatile("" : "+s"(kl));
          pg8::Gemm g{(const bf16*)(F.ws + WS_ALORA), (const bf16*)(F.ws + WS_WLORA), TT, NLORA, kl}; pg8::StaticOrder S; S.init(TT, NLORA, F.G, (int)blockIdx.x);
          pg8::EpiLora E{(float*)(F.ws + WS_PK), (float*)(F.ws + WS_GE), (bf16*)(F.ws + WS_KD), (const float*)(F.ws + WS_KBUF), (const float*)(F.ws + WS_KKBUF), (const float*)(F.ws + WS_RBUF), F.in[I_W0], F.in[I_A0], F.in[I_KA], TT};
          pg8::gemm_phase<pg8::EpiLora, pg8::StaticOrder, true, true>(F.lds + RING_OFF, g, S, E, F.wave); }
        { int kl = KGATE; asm volatile("" : "+s"(kl));
          pg8::Gemm g{(const bf16*)(F.ws + WS_AGATE), (const bf16*)(F.ws + WS_WGATE), T, DR, kl}; pg8::StaticOrder S; S.init(T, DR, F.G, (int)blockIdx.x);
          pg8::EpiBf16<0> E{(bf16*)(F.ws + WS_G), DR, nullptr, 0, 0, 1.f};
          pg8::gemm_phase<pg8::EpiBf16<0>, pg8::StaticOrder, true, true>(F.lds + RING_OFF, g, S, E, F.wave); }

    }
    if constexpr (K == 5) { p5_scanA(F);
    }
    if constexpr (K == 6) { p6_scanB(F);
    }
    if constexpr (K == 7) { p7_scanC(F);
    }
    if constexpr (K == 8) { p8_readout(F);
    }
    if constexpr (K == 9) {
        pg8::Gemm g{(const bf16*)(F.ws + WS_CAT), (const bf16*)(F.ws + WS_WOUT), T, D, D}; pg8::StaticOrder S; S.init(T, D, F.G, (int)blockIdx.x);
        pg8::EpiResid E{F.in[I_X], (float*)(F.ws + WS_X1), D, MV + 2 * D};
        pg8::gemm_phase<pg8::EpiResid, pg8::StaticOrder, true, true>(F.lds + RING_OFF, g, S, E, F.wave);

    }
    if constexpr (K == 10) { p10_norm2(F);
    }
    if constexpr (K == 11) {
        pg8::Gemm g{A1, (const bf16*)(F.ws + WS_WGU), T, NGU, D}; pg8::StaticOrder S; S.init(T, NGU, F.G, (int)blockIdx.x);
        pg8::EpiSwiglu E{(bf16*)(F.ws + WS_ACT), DFF};
        pg8::gemm_phase<pg8::EpiSwiglu, pg8::StaticOrder, true, true>(F.lds + RING_OFF, g, S, E, F.wave);

    }
    if constexpr (K == 12) {
        pg8::Gemm g{(const bf16*)(F.ws + WS_ACT), (const bf16*)(F.ws + WS_WDN), T, D, DFF}; pg8::StaticOrder S; S.init(T, D, F.G, (int)blockIdx.x);
        pg8::EpiResid E{(const float*)(F.ws + WS_X1), F.out, D, MV + 5 * D};
        pg8::gemm_phase<pg8::EpiResid, pg8::StaticOrder, true, true>(F.lds + RING_OFF, g, S, E, F.wave);

    }
    if constexpr (K == 13) { p13_final(F);
    }
}

struct Args { const float* in[26]; float* out; unsigned char* ws; int ph_lo, ph_hi, li, pad; };
__global__ void __launch_bounds__(NWAVES * 64, 2) mk_fwd(Args args) {
    extern __shared__ __attribute__((aligned(16))) unsigned char lds[];
    Frame F;
    F.lds = (LAS unsigned char*)lds;
    F.MISC = (volatile LAS unsigned*)(F.lds + MISC_OFF);
    F.wave = __builtin_amdgcn_readfirstlane((int)(threadIdx.x >> 6));
    F.G = gridDim.x; { const int bx = blockIdx.x; F.vcu = (F.G % 8 == 0) ? (bx % 8) * (F.G / 8) + bx / 8 : bx; }
    F.ws = args.ws; F.ctl = (gu32*)(args.ws + WS_CTL); F.out = args.out;
#pragma unroll
    for (int i = 0; i < 26; ++i) F.in[i] = args.in[i];
    for (int u = threadIdx.x; u < (LDS_BYTES - LDSCTL_OFF) / 4; u += NWAVES * 64) ((LAS unsigned*)(F.lds + LDSCTL_OFF))[u] = 0u;
    __syncthreads();
    XcdBarrier bar; bar.bar = (unsigned*)(F.ctl + CW_BAR); bar.x = 0; bar.st = nullptr;
    if (N_LAUNCHES == 1) bar = xcd_barrier_post((unsigned*)(F.ctl + CW_BAR), F.MISC + 8);
#define GRID_BAR() do { if (N_LAUNCHES == 1) xcd_barrier(bar, F.wave); } while (0)
    const int lo = args.ph_lo, hi = args.ph_hi;
#define IN(k) (lo <= (k) && (k) < hi)
#define BOTH(k) (IN(k) && IN((k) + 1))

    if (IN(0)) { run_phase<0>(F); if constexpr (PH_REPS[0] > 1) { GRID_BAR(); run_phase<0>(F); } if constexpr (PH_REPS[0] > 2) { GRID_BAR(); run_phase<0>(F); } if (BOTH(0)) GRID_BAR(); }
    if (IN(1)) { run_phase<1>(F); if constexpr (PH_REPS[1] > 1) { GRID_BAR(); run_phase<1>(F); } if constexpr (PH_REPS[1] > 2) { GRID_BAR(); run_phase<1>(F); } if (BOTH(1)) GRID_BAR(); }
    if (IN(2)) { run_phase<2>(F); if constexpr (PH_REPS[2] > 1) { GRID_BAR(); run_phase<2>(F); } if constexpr (PH_REPS[2] > 2) { GRID_BAR(); run_phase<2>(F); } if (BOTH(2)) GRID_BAR(); }
    if (IN(3)) { run_phase<3>(F); if constexpr (PH_REPS[3] > 1) { GRID_BAR(); run_phase<3>(F); } if constexpr (PH_REPS[3] > 2) { GRID_BAR(); run_phase<3>(F); } if (BOTH(3)) GRID_BAR(); }
    if (IN(4)) { run_phase<4>(F); if constexpr (PH_REPS[4] > 1) { GRID_BAR(); run_phase<4>(F); } if constexpr (PH_REPS[4] > 2) { GRID_BAR(); run_phase<4>(F); } if (BOTH(4)) GRID_BAR(); }
    if (IN(5)) { run_phase<5>(F); if constexpr (PH_REPS[5] > 1) { GRID_BAR(); run_phase<5>(F); } if constexpr (PH_REPS[5] > 2) { GRID_BAR(); run_phase<5>(F); } if (BOTH(5)) GRID_BAR(); }
    if (IN(6)) { run_phase<6>(F); if constexpr (PH_REPS[6] > 1) { GRID_BAR(); run_phase<6>(F); } if constexpr (PH_REPS[6] > 2) { GRID_BAR(); run_phase<6>(F); } if (BOTH(6)) GRID_BAR(); }
    if (IN(7)) { run_phase<7>(F); if constexpr (PH_REPS[7] > 1) { GRID_BAR(); run_phase<7>(F); } if constexpr (PH_REPS[7] > 2) { GRID_BAR(); run_phase<7>(F); } if (BOTH(7)) GRID_BAR(); }
    if (IN(8)) { run_phase<8>(F); if constexpr (PH_REPS[8] > 1) { GRID_BAR(); run_phase<8>(F); } if constexpr (PH_REPS[8] > 2) { GRID_BAR(); run_phase<8>(F); } if (BOTH(8)) GRID_BAR(); }
    if (IN(9)) { run_phase<9>(F); if constexpr (PH_REPS[9] > 1) { GRID_BAR(); run_phase<9>(F); } if constexpr (PH_REPS[9] > 2) { GRID_BAR(); run_phase<9>(F); } if (BOTH(9)) GRID_BAR(); }
    if (IN(10)) { run_phase<10>(F); if constexpr (PH_REPS[10] > 1) { GRID_BAR(); run_phase<10>(F); } if constexpr (PH_REPS[10] > 2) { GRID_BAR(); run_phase<10>(F); } if (BOTH(10)) GRID_BAR(); }
    if (IN(11)) { run_phase<11>(F); if constexpr (PH_REPS[11] > 1) { GRID_BAR(); run_phase<11>(F); } if constexpr (PH_REPS[11] > 2) { GRID_BAR(); run_phase<11>(F); } if (BOTH(11)) GRID_BAR(); }
    if (IN(12)) { run_phase<12>(F); if constexpr (PH_REPS[12] > 1) { GRID_BAR(); run_phase<12>(F); } if constexpr (PH_REPS[12] > 2) { GRID_BAR(); run_phase<12>(F); } if (BOTH(12)) GRID_BAR(); }
    if (IN(13)) { run_phase<13>(F); if constexpr (PH_REPS[13] > 1) { GRID_BAR(); run_phase<13>(F); } if constexpr (PH_REPS[13] > 2) { GRID_BAR(); run_phase<13>(F); } if (BOTH(13)) GRID_BAR(); }
#undef IN
#undef BOTH
}

extern "C" void kernel_launch(void* const* d_in, const int* in_sizes, int n_in, void* d_out, int out_size, void* d_ws, size_t ws_size, hipStream_t stream) {
    static int grid = 0;
    if (grid == 0) {
        if (n_in != 26 || out_size != T * D || ws_size < WS_END) { fprintf(stderr, "kernel_launch: unexpected shapes: n_in %d out %d ws %zu (need %zu)\n", n_in, out_size, ws_size, (size_t)WS_END); grid = -1; return; }
        int dev = 0, cus = 0, per_cu = 0;
        if (hipGetDevice(&dev) != hipSuccess || hipDeviceGetAttribute(&cus, hipDeviceAttributeMultiprocessorCount, dev) != hipSuccess) { grid = -1; return; }
        if (hipFuncSetAttribute((const void*)mk_fwd, hipFuncAttributeMaxDynamicSharedMemorySize, LDS_BYTES) != hipSuccess) { fprintf(stderr, "kernel_launch: hipFuncSetAttribute failed\n"); grid = -1; return; }
        if (hipOccupancyMaxActiveBlocksPerMultiprocessor(&per_cu, (const void*)mk_fwd, NWAVES * 64, LDS_BYTES) != hipSuccess || per_cu < 1)
            fprintf(stderr, "kernel_launch: note: occupancy query reports %d workgroups per CU\n", per_cu);
        (void)hipGetLastError();
        grid = cus;
    }
    if (grid < 0) return;
    if (hipMemsetAsync((char*)d_ws + WS_CTL, 0, CTL_ZERO_BYTES, stream) != hipSuccess) return;
    Args a{};
    for (int i = 0; i < 26; ++i) a.in[i] = (const float*)d_in[i];
    a.out = (float*)d_out; a.ws = (unsigned char*)d_ws;
    for (int li = 0; li < N_LAUNCHES; ++li) {
        if (N_LAUNCHES == 1) { a.ph_lo = 0; a.ph_hi = N_PHASES; } else { a.ph_lo = li * N_PHASES / N_LAUNCHES; a.ph_hi = (li + 1) * N_PHASES / N_LAUNCHES; }
        a.li = li;
        hipLaunchKernelGGL(mk_fwd, dim3(grid), dim3(NWAVES * 64), LDS_BYTES, stream, a);
        if (hipPeekAtLastError() != hipSuccess) break;
    }
}
```

```cpp
#include <hip/hip_runtime.h>
#include <cstdio>
#include <cstdint>
namespace pg8 {
#define PG8_LAS __attribute__((address_space(3)))
typedef unsigned short bf16_t;
typedef short bf16x8 __attribute__((ext_vector_type(8)));
typedef float f32x4 __attribute__((ext_vector_type(4)));
typedef unsigned u32x4 __attribute__((ext_vector_type(4)));
constexpr int BM = 256, BK = 64, HALF = 128, HTB = HALF * BK * 2  , STAGE_BYTES = 8 * HTB, NXCD = 8, WGM = 8;

__host__ __device__ __forceinline__ int lds_byte(int r, int c) { const int st = (r >> 4) * 2 + (c >> 5), rr = r & 15, cc = c & 31, ob = rr * 64 + cc * 2; return st * 1024 + (ob ^ (((ob >> 9) & 1) << 5)); }
__host__ __device__ __forceinline__ void stage_rc(int b, int& R, int& C) { const int st = b / 1024, sb = b % 1024, swz = sb ^ (((sb >> 9) & 1) << 5); R = (st >> 1) * 16 + swz / 64; C = (st & 1) * 32 + (swz % 64) / 2; }
__host__ __device__ __forceinline__ int perm32(int rho) { const int n = rho >> 4, i = rho & 15; return 8 * (i >> 2) + 4 * n + (i & 3); }

__device__ __forceinline__ int mk_lane() { int l; asm volatile("v_mbcnt_lo_u32_b32 %0, -1, 0\n\tv_mbcnt_hi_u32_b32 %0, -1, %0" : "=v"(l)); return l; }
struct Unit { int pm, pn; };
struct Gemm { const bf16_t* A; const bf16_t* Bt; int M, N, K; };

struct StaticOrder {
    int nM, nN, nwg, G, c;
    __host__ __device__ void init(int M, int N, int G_, int c_) { nM = M / BM; nN = N / BM; nwg = nM * nN; G = G_; c = c_; }
    __host__ __device__ bool next(int i, Unit& u) const {
        const long L = (long)i * G + c; if (L >= nwg) return false;
        int wgid = (int)L; { const int q = nwg / NXCD, r = nwg % NXCD, xcd = wgid % NXCD, off = wgid / NXCD; wgid = (xcd < r ? xcd * (q + 1) : r * (q + 1) + (xcd - r) * q) + off; }
        const int nig = WGM * nN, gid = wgid / nig, fm = gid * WGM, gsz = (nM - fm) < WGM ? (nM - fm) : WGM;
        u.pm = fm + ((wgid % nig) % gsz); u.pn = (wgid % nig) / gsz; return true;
    }
    __device__ __forceinline__ void a_ready(const Unit&) const {}
    __device__ __forceinline__ void done(const Unit&) const {}
};

__device__ __forceinline__ unsigned cvt_pk_bf16(float lo, float hi) { unsigned r; asm volatile("v_cvt_pk_bf16_f32 %0, %1, %2" : "=v"(r) : "v"(lo), "v"(hi)); return r; }
typedef float f32x2 __attribute__((ext_vector_type(2)));
__device__ __forceinline__ f32x2 gelu_pk(f32x2 v) {
    const f32x2 av = __builtin_elementwise_abs(v), d = av * 0.2316418882f + 1.0f;
    f32x2 t; t.x = __builtin_amdgcn_rcpf(d.x); t.y = __builtin_amdgcn_rcpf(d.y);
    f32x2 q = t * 0.5307027145f + (-0.7265760135f); q = q * t + 0.7107068705f; q = q * t + (-0.142248368f); q = q * t + 0.127414796f; q = q * t;
    const f32x2 s = (v * v) * (-0.72134752044f);
    f32x2 e; e.x = __builtin_amdgcn_exp2f(s.x); e.y = __builtin_amdgcn_exp2f(s.y);
    const f32x2 m = v * (q * e), r = v - m;
    f32x2 o; o.x = v.x < 0.f ? m.x : r.x; o.y = v.y < 0.f ? m.y : r.y; return o;
}

template <int ACT  > struct EpiBf16 {
    static constexpr bool PERM = true, AFTER_DRAIN = false; static_assert(ACT == 0 || ACT == 1, "EpiBf16: ACT is 0 (none) or 1 (gelu_pk)");
    bf16_t* O; int ldc; const float* bias; int split_cols; size_t split_stride; float scale0;
    __device__ __forceinline__ void operator()(const f32x4 (&acc)[2][2][4][2], const Unit& u, int wr, int wc, int fr, int fq) const {
        const int row0 = u.pm * BM + wr * 64 + fr; int colt = u.pn * BM; bf16_t* base = O;
        float sc = 1.f; if (split_cols) { const int t = colt / split_cols; base += (size_t)t * split_stride; colt -= t * split_cols; if (t == 0) sc = scale0; }
        const int col0 = colt + wc * 32 + 8 * fq, bcol0 = u.pn * BM + wc * 32 + 8 * fq;
        f32x4 bv[2][2];
#pragma unroll
        for (int bj = 0; bj < 2; ++bj)
#pragma unroll
            for (int n = 0; n < 2; ++n) bv[bj][n] = bias ? *(const f32x4*)(bias + bcol0 + bj * HALF + 4 * n) : (f32x4){0.f, 0.f, 0.f, 0.f};
#pragma unroll
        for (int ai = 0; ai < 2; ++ai)
#pragma unroll
            for (int m = 0; m < 4; ++m) { bf16_t* rowp = base + (size_t)(row0 + ai * HALF + m * 16) * ldc + col0;
#pragma unroll
                for (int bj = 0; bj < 2; ++bj) { f32x4 v0 = acc[ai][bj][m][0] + bv[bj][0], v1 = acc[ai][bj][m][1] + bv[bj][1];
                    if (ACT == 1) { f32x2 a = gelu_pk((f32x2){v0[0], v0[1]}), b = gelu_pk((f32x2){v0[2], v0[3]}), c = gelu_pk((f32x2){v1[0], v1[1]}), d = gelu_pk((f32x2){v1[2], v1[3]});
                        v0 = (f32x4){a.x, a.y, b.x, b.y}; v1 = (f32x4){c.x, c.y, d.x, d.y}; }
                    v0 = v0 * sc; v1 = v1 * sc; u32x4 w; w.x = cvt_pk_bf16(v0[0], v0[1]); w.y = cvt_pk_bf16(v0[2], v0[3]); w.z = cvt_pk_bf16(v1[0], v1[1]); w.w = cvt_pk_bf16(v1[2], v1[3]);
                    *(u32x4*)(rowp + bj * HALF) = w; } }
    }
};
__device__ __forceinline__ float sigmoidf_(float x) { return __builtin_amdgcn_rcpf(1.0f + __expf(-x)); }
struct EpiResid {
    static constexpr bool PERM = false, AFTER_DRAIN = false;
    const float* base; float* out; int ldc; const float* gvec;
    __device__ __forceinline__ void operator()(const f32x4 (&acc)[2][2][4][2], const Unit& u, int wr, int wc, int fr, int fq) const {
        const int row0 = u.pm * BM + wr * 64 + fr, col0 = u.pn * BM + wc * 32 + 4 * fq;
        f32x4 gv[2][2];
#pragma unroll
        for (int bj = 0; bj < 2; ++bj)
#pragma unroll
            for (int n = 0; n < 2; ++n) gv[bj][n] = *(const __attribute__((address_space(1))) f32x4*)(gvec + col0 + bj * HALF + n * 16);
#pragma unroll
        for (int ai = 0; ai < 2; ++ai)
#pragma unroll
            for (int m = 0; m < 4; ++m) { const size_t off = (size_t)(row0 + ai * HALF + m * 16) * ldc + col0;
#pragma unroll
                for (int bj = 0; bj < 2; ++bj)
#pragma unroll
                    for (int n = 0; n < 2; ++n) { const f32x4 bs = *(const __attribute__((address_space(1))) f32x4*)(base + off + bj * HALF + n * 16);
                        *(__attribute__((address_space(1))) f32x4*)(out + off + bj * HALF + n * 16) = bs + gv[bj][n] * acc[ai][bj][m][n]; }
                if (m & 1) asm volatile("" ::: "memory"); }
    }
};
struct EpiSwiglu {
    static constexpr bool PERM = true, AFTER_DRAIN = false;
    bf16_t* O; int ldc;
    __device__ __forceinline__ void operator()(const f32x4 (&acc)[2][2][4][2], const Unit& u, int wr, int wc, int fr, int fq) const {
        const int row0 = u.pm * BM + wr * 64 + fr, col0 = u.pn * HALF + wc * 32 + 8 * fq;
#pragma unroll
        for (int ai = 0; ai < 2; ++ai)
#pragma unroll
            for (int m = 0; m < 4; ++m) { bf16_t* rowp = O + (size_t)(row0 + ai * HALF + m * 16) * ldc + col0;
                f32x4 h0, h1;
#pragma unroll
                for (int j = 0; j < 4; ++j) { const float g0 = acc[ai][0][m][0][j], g1 = acc[ai][0][m][1][j];
                    h0[j] = g0 * sigmoidf_(g0) * acc[ai][1][m][0][j]; h1[j] = g1 * sigmoidf_(g1) * acc[ai][1][m][1][j]; }
                u32x4 w; w.x = cvt_pk_bf16(h0[0], h0[1]); w.y = cvt_pk_bf16(h0[2], h0[3]); w.z = cvt_pk_bf16(h1[0], h1[1]); w.w = cvt_pk_bf16(h1[2], h1[3]);
                *(__attribute__((address_space(1))) u32x4*)rowp = w; }
    }
};
template <int CTRL> __device__ __forceinline__ float dpp_f(float old, float src) { return __builtin_bit_cast(float, __builtin_amdgcn_update_dpp(__builtin_bit_cast(int, old), __builtin_bit_cast(int, src), CTRL, 0xf, 0xf, false)); }
struct EpiLora {
    static constexpr bool PERM = true, AFTER_DRAIN = false;
    float* PK; float* GE; bf16_t* KD; const float* kbuf; const float* kkbuf; const float* rbuf; const float* w0; const float* a0; const float* k_a; int TT;
    __device__ __forceinline__ void operator()(const f32x4 (&acc)[2][2][4][2], const Unit& u, int wr, int wc, int fr, int fq) const {
        typedef __attribute__((address_space(1))) f32x4 gf4; typedef const __attribute__((address_space(1))) f32x4 cgf4;
        const int d = u.pn >> 4, cg = u.pn & 15;
        const int c8 = cg * HALF + wc * 32 + 8 * fq, h = c8 >> 6, ch = c8 & 63;
        const int row0 = u.pm * BM + wr * 64 + fr;
        f32x4 w0v[2], a0v[2], kav[2];
#pragma unroll
        for (int n = 0; n < 2; ++n) { w0v[n] = *(cgf4*)(w0 + d * 2048 + c8 + 4 * n); a0v[n] = *(cgf4*)(a0 + d * 2048 + c8 + 4 * n); kav[n] = *(cgf4*)(k_a + c8 + 4 * n); }
        f32x4 kq[2][2], kkq[2][2], rq[2][2];
        { const size_t fo0 = (size_t)row0 * 2048 + c8;
#pragma unroll
          for (int n = 0; n < 2; ++n) { kq[0][n] = *(cgf4*)(kbuf + fo0 + 4 * n); kkq[0][n] = *(cgf4*)(kkbuf + fo0 + 4 * n); rq[0][n] = *(cgf4*)(rbuf + fo0 + 4 * n); } }
#pragma unroll
        for (int it = 0; it < 8; ++it) {
            const int ai = it >> 2, m = it & 3;
            if (it + 1 < 8) { const size_t fo1 = (size_t)(row0 + ((it + 1) >> 2) * HALF + ((it + 1) & 3) * 16) * 2048 + c8;
#pragma unroll
                for (int n = 0; n < 2; ++n) { kq[(it + 1) & 1][n] = *(cgf4*)(kbuf + fo1 + 4 * n); kkq[(it + 1) & 1][n] = *(cgf4*)(kkbuf + fo1 + 4 * n); rq[(it + 1) & 1][n] = *(cgf4*)(rbuf + fo1 + 4 * n); } }
            asm volatile("" ::: "memory");
            const int tok = row0 + ai * HALF + m * 16;
            float* pk = PK + ((size_t)(d * 32 + h) * TT + tok) * 256;
            const size_t fo = (size_t)tok * 2048 + c8;
            f32x4 g[2]; u32x4 kw;
#pragma unroll
            for (int n = 0; n < 2; ++n) {
                f32x4 gp;
                const f32x4 x = acc[ai][0][m][n] + w0v[n];
#pragma unroll
                for (int j = 0; j < 4; ++j) { float w = __expf(-0.60653066f * sigmoidf_(x[j]));
                    if (d == 0) { w *= dpp_f<0x111>(1.0f, w); w *= dpp_f<0x112>(1.0f, w); w *= dpp_f<0x114>(1.0f, w); w *= dpp_f<0x118>(1.0f, w); g[n][j] = w; gp[j] = dpp_f<0x111>(1.0f, w); }
                    else        { w *= dpp_f<0x101>(1.0f, w); w *= dpp_f<0x102>(1.0f, w); w *= dpp_f<0x104>(1.0f, w); w *= dpp_f<0x108>(1.0f, w); g[n][j] = w; gp[j] = dpp_f<0x101>(1.0f, w); } }
                const f32x4 xa = acc[ai][1][m][n] + a0v[n];
                const f32x4 k4 = kq[it & 1][n], kk4 = kkq[it & 1][n], r4 = rq[it & 1][n];
                f32x4 at, rt, bt, kdt; float kdv[4];
#pragma unroll
                for (int j = 0; j < 4; ++j) { const float a = sigmoidf_(xa[j]), rg = __builtin_amdgcn_rcpf(g[n][j]);
                    kdv[j] = k4[j] * (1.0f + (a - 1.0f) * kav[n][j]);
                    at[j] = -kk4[j] * gp[j]; rt[j] = r4[j] * g[n][j]; bt[j] = kk4[j] * a * rg; kdt[j] = kdv[j] * rg; }
                const int chn = ch + 4 * n;
                *(gf4*)(pk + chn) = at; *(gf4*)(pk + 64 + chn) = rt;
                *(gf4*)(pk + 128 + (chn >> 5) * 64 + (chn & 31)) = bt; *(gf4*)(pk + 160 + (chn >> 5) * 64 + (chn & 31)) = kdt;
                if (n == 0) { kw.x = cvt_pk_bf16(kdv[0], kdv[1]); kw.y = cvt_pk_bf16(kdv[2], kdv[3]); } else { kw.z = cvt_pk_bf16(kdv[0], kdv[1]); kw.w = cvt_pk_bf16(kdv[2], kdv[3]); }
            }
            *(__attribute__((address_space(1))) u32x4*)(KD + (size_t)d * TT * 2048 + fo) = kw;
            if (fr == (d == 0 ? 15 : 0)) { float* ge = GE + ((size_t)(d * 32 + h) * (TT / 16) + (tok >> 4)) * 64 + ch; *(gf4*)ge = g[0]; *(gf4*)(ge + 4) = g[1]; }
        }
    }
};
template <class Epi, class Sched, bool ALIGN_EPI = false, bool SP2 = false>
__device__ __forceinline__ void gemm_phase(PG8_LAS unsigned char* lds, const Gemm g, const Sched& S, const Epi& E, const int wid) {
    const int lane = mk_lane(), tid = wid * 64 + lane, wr = wid >> 2, wc = wid & 3, fr = lane & 15, fq = lane >> 4;
    const int K = g.K, nt = K / BK;
    unsigned voffA[2], voffB[2];
#pragma unroll
    for (int i = 0; i < 2; ++i) { int R, C; stage_rc(tid * 16 + i * 8192, R, C); const int Rb = Epi::PERM ? ((R & ~31) + perm32(R & 31)) : R;
        voffA[i] = (unsigned)(R * K + C) * 2u; voffB[i] = (unsigned)(Rb * K + C) * 2u; }
    const size_t kstep = (size_t)(BK * 2);
    const size_t hstep = (size_t)HALF * K * 2;
    const size_t tstep = 2 * hstep;
    const unsigned ldsw = (unsigned)wid * 1024u;
    const int aoff = lds_byte(wr * 64 + fr, fq * 8), boff = lds_byte(wc * 32 + fr, fq * 8);
#define PG8_SA(b, h) (((b) * 2 + (h)) * HTB)
#define PG8_SB(b, h) ((4 + (b) * 2 + (h)) * HTB)
#define PG8_STAGE(bufoff, gbase, voff) do { _Pragma("unroll") for (int _i = 0; _i < 2; ++_i) \
        __builtin_amdgcn_global_load_lds((const unsigned*)((const char*)(gbase) + (voff)[_i]), (PG8_LAS unsigned*)(lds + (bufoff) + ldsw + _i * 8192), 16, 0, 0); } while (0)
#define PG8_LDA(dst, b, h) do { _Pragma("unroll") for (int m = 0; m < 4; ++m) _Pragma("unroll") for (int k = 0; k < 2; ++k) dst[m][k] = *(const PG8_LAS bf16x8*)(lds + PG8_SA(b, h) + aoff + m * 2048 + k * 1024); } while (0)
#define PG8_LDB(dst, b, h) do { _Pragma("unroll") for (int n = 0; n < 2; ++n) _Pragma("unroll") for (int k = 0; k < 2; ++k) dst[n][k] = *(const PG8_LAS bf16x8*)(lds + PG8_SB(b, h) + boff + n * 2048 + k * 1024); } while (0)
#define PG8_MMA(ai, bj, At, Bt) do { __builtin_amdgcn_s_setprio(1); _Pragma("unroll") for (int m = 0; m < 4; ++m) _Pragma("unroll") for (int n = 0; n < 2; ++n) _Pragma("unroll") for (int k = 0; k < 2; ++k) \
        acc[ai][bj][m][n] = __builtin_amdgcn_mfma_f32_16x16x32_bf16(Bt[n][k], At[m][k], acc[ai][bj][m][n], 0, 0, 0); __builtin_amdgcn_s_setprio(0); } while (0)
#define PG8_WAIT_V(n) asm volatile("s_waitcnt vmcnt(" #n ")" ::: "memory")
#define PG8_WAIT_L(n) asm volatile("s_waitcnt lgkmcnt(" #n ")" ::: "memory")
#define PG8_BAR __builtin_amdgcn_s_barrier()
#define PG8_SCHED __builtin_amdgcn_sched_barrier(0)
    Unit cur, nxt; int ui = 0;
    if (!S.next(0, cur)) return;
    f32x4 acc[2][2][4][2];
#pragma unroll
    for (int a = 0; a < 2; ++a)
#pragma unroll
        for (int b = 0; b < 2; ++b)
#pragma unroll
            for (int m = 0; m < 4; ++m)
#pragma unroll
                for (int n = 0; n < 2; ++n) acc[a][b][m][n] = (f32x4){0.f, 0.f, 0.f, 0.f};
    bf16x8 At[4][2], B0[2][2], B1[2][2];
    const char* cA = (const char*)g.A + (size_t)cur.pm * tstep; const char* cB = (const char*)g.Bt + (size_t)cur.pn * tstep;
    S.a_ready(cur);
    if constexpr (SP2) {
        PG8_STAGE(PG8_SB(0, 0), cB, voffB); PG8_STAGE(PG8_SB(0, 1), cB + hstep, voffB); PG8_STAGE(PG8_SA(0, 0), cA, voffA); PG8_STAGE(PG8_SA(0, 1), cA + hstep, voffA);
        if (wr == 1) PG8_BAR;
        PG8_WAIT_V(2); PG8_BAR;
        PG8_STAGE(PG8_SB(1, 0), cB + kstep, voffB); PG8_STAGE(PG8_SA(1, 0), cA + kstep, voffA); PG8_STAGE(PG8_SB(1, 1), cB + hstep + kstep, voffB);
        PG8_WAIT_V(6); PG8_BAR;
    } else {
        PG8_STAGE(PG8_SB(0, 0), cB, voffB); PG8_STAGE(PG8_SA(0, 0), cA, voffA); PG8_STAGE(PG8_SB(0, 1), cB + hstep, voffB); PG8_STAGE(PG8_SA(0, 1), cA + hstep, voffA);
        if (wr == 1) PG8_BAR;
        PG8_WAIT_V(4); PG8_BAR;
        PG8_STAGE(PG8_SB(1, 0), cB + kstep, voffB); PG8_STAGE(PG8_SA(1, 0), cA + kstep, voffA); PG8_STAGE(PG8_SB(1, 1), cB + hstep + kstep, voffB);
        PG8_WAIT_V(6); PG8_BAR;
    }
    for (;;) {
        const bool has_next = S.next(ui + 1, nxt);
        const char* nA = has_next ? (const char*)g.A + (size_t)nxt.pm * tstep : cA; const char* nB = has_next ? (const char*)g.Bt + (size_t)nxt.pn * tstep : cB;
        for (int t = 0; t < nt; t += 2) {
            const bool last = (t == nt - 2);
            const char* a1 = cA + (size_t)(t + 1) * kstep;
            const char* a2 = last ? nA : cA + (size_t)(t + 2) * kstep; const char* b2 = last ? nB : cB + (size_t)(t + 2) * kstep;
            const char* a3 = a2 + kstep; const char* b3 = b2 + kstep;
            if (last && has_next) S.a_ready(nxt);
            if constexpr (SP2) {
            PG8_LDB(B0, 0, 0); PG8_LDB(B1, 0, 1); PG8_SCHED; PG8_LDA(At, 0, 0); PG8_STAGE(PG8_SA(1, 1), a1 + hstep, voffA);
            PG8_WAIT_V(8); PG8_WAIT_L(0); PG8_BAR; PG8_MMA(0, 0, At, B0); PG8_MMA(0, 1, At, B1); PG8_BAR; PG8_SCHED;
            PG8_LDA(At, 0, 1); PG8_STAGE(PG8_SB(0, 0), b2, voffB); PG8_STAGE(PG8_SB(0, 1), b2 + hstep, voffB); PG8_STAGE(PG8_SA(0, 0), a2, voffA);
            PG8_WAIT_V(8); PG8_WAIT_L(0); PG8_BAR; PG8_MMA(1, 0, At, B0); PG8_MMA(1, 1, At, B1); PG8_BAR; PG8_SCHED;
            PG8_LDB(B0, 1, 0); PG8_LDB(B1, 1, 1); PG8_SCHED; PG8_LDA(At, 1, 0); PG8_STAGE(PG8_SA(0, 1), a2 + hstep, voffA);
            PG8_WAIT_V(8); PG8_WAIT_L(0); PG8_BAR; PG8_MMA(0, 0, At, B0); PG8_MMA(0, 1, At, B1); PG8_BAR; PG8_SCHED;
            PG8_LDA(At, 1, 1); PG8_STAGE(PG8_SB(1, 0), b3, voffB); PG8_STAGE(PG8_SB(1, 1), b3 + hstep, voffB); PG8_STAGE(PG8_SA(1, 0), a3, voffA);
            PG8_WAIT_V(8); PG8_WAIT_L(0); PG8_BAR; PG8_MMA(1, 0, At, B0); PG8_MMA(1, 1, At, B1); PG8_BAR; PG8_SCHED;
            } else {
            PG8_LDB(B0, 0, 0); PG8_SCHED; PG8_LDA(At, 0, 0); PG8_STAGE(PG8_SA(1, 1), a1 + hstep, voffA);
            PG8_WAIT_L(8); PG8_BAR; PG8_WAIT_L(0); PG8_MMA(0, 0, At, B0); PG8_BAR; PG8_SCHED;
            PG8_LDB(B1, 0, 1); PG8_STAGE(PG8_SB(0, 0), b2, voffB);
            PG8_BAR; PG8_WAIT_L(0); PG8_MMA(0, 1, At, B1); PG8_BAR;
            PG8_LDA(At, 0, 1); PG8_STAGE(PG8_SA(0, 0), a2, voffA);
            PG8_BAR; PG8_WAIT_L(0); PG8_MMA(1, 0, At, B0); PG8_BAR; PG8_SCHED;
            PG8_STAGE(PG8_SB(0, 1), b2 + hstep, voffB);
            PG8_WAIT_V(6); PG8_BAR; PG8_MMA(1, 1, At, B1); PG8_BAR;
            PG8_LDB(B0, 1, 0); PG8_SCHED; PG8_LDA(At, 1, 0); PG8_STAGE(PG8_SA(0, 1), a2 + hstep, voffA);
            PG8_WAIT_L(8); PG8_BAR; PG8_WAIT_L(0); PG8_MMA(0, 0, At, B0); PG8_BAR; PG8_SCHED;
            PG8_LDB(B1, 1, 1); PG8_STAGE(PG8_SB(1, 0), b3, voffB);
            PG8_BAR; PG8_WAIT_L(0); PG8_MMA(0, 1, At, B1); PG8_BAR;
            PG8_LDA(At, 1, 1); PG8_STAGE(PG8_SA(1, 0), a3, voffA);
            PG8_BAR; PG8_WAIT_L(0); PG8_MMA(1, 0, At, B0); PG8_BAR; PG8_SCHED;
            PG8_STAGE(PG8_SB(1, 1), b3 + hstep, voffB);
            PG8_WAIT_V(6); PG8_BAR; PG8_MMA(1, 1, At, B1); PG8_BAR;
            }
        }
        if constexpr (ALIGN_EPI) { if (wr == 0) PG8_BAR; }
        if constexpr (!Epi::AFTER_DRAIN) { const int l2 = mk_lane(); E(acc, cur, wr, wc, l2 & 15, l2 >> 4); S.done(cur); }
        if (!has_next) break;
#pragma unroll
        for (int a = 0; a < 2; ++a)
#pragma unroll
            for (int b = 0; b < 2; ++b)
#pragma unroll
                for (int m = 0; m < 4; ++m)
#pragma unroll
                    for (int n = 0; n < 2; ++n) acc[a][b][m][n] = (f32x4){0.f, 0.f, 0.f, 0.f};
        cur = nxt; cA = nA; cB = nB; ++ui;
        if constexpr (ALIGN_EPI) { if (wr == 1) PG8_BAR; }
    }
    PG8_WAIT_V(0);
    if constexpr (!ALIGN_EPI) { if (wr == 0) PG8_BAR; }
    PG8_BAR;
    if constexpr (Epi::AFTER_DRAIN) { E.fused(acc, cur, wr, wc, fr, fq, lds, wid, lane); S.done(cur); }
#undef PG8_SA
#undef PG8_SB
#undef PG8_STAGE
#undef PG8_LDA
#undef PG8_LDB
#undef PG8_MMA
#undef PG8_WAIT_V
#undef PG8_WAIT_L
#undef PG8_BAR
#undef PG8_SCHED
}
}

constexpr int NWAVES = 8;
#ifndef MK_N_LAUNCHES
#define MK_N_LAUNCHES 1
#endif
constexpr int N_PHASES = 14;
#ifndef MK_REPS
#define MK_REPS {1,1,1,1,1,1,1,1,1,1,1,1,1,1}
#endif
constexpr int PH_REPS[14] = MK_REPS;
#ifndef MK_TPA
#define MK_TPA -1
#endif
#ifndef MK_TPB
#define MK_TPB -1
#endif
constexpr int TPA = MK_TPA, TPB = MK_TPB;
constexpr int N_LAUNCHES = MK_N_LAUNCHES;

constexpr int D = 4096, T = 8192, CTXL = 256, TT = T + CTXL;
constexpr int DR = 2048, DC = 2048, NH = 32, HS = 64;
constexpr int OFF_K = 0, OFF_V = 2048, OFF_WL = 4096, OFF_AL = 4192, OFF_R = 4288, OFF_GL = 6336, RWKV_COLS = 6592;
constexpr int OFF_CB = 6592, OFF_CC = 8640, OFF_CX = 10688, IN_COLS = 12736, NZ = 12800;
constexpr int NCTXZ = 4352;
constexpr int DFF = 11008, NGU = 2 * DFF;
constexpr int NLORA = 8192, KLORA = 256, KGATE = 256;
constexpr int MODN = 6 * D;
constexpr int NKC = 16;
constexpr float NORM_EPS = 1e-6f, LNX_EPS = 64e-5f;
constexpr int CHUNK = 256, NCHUNK = 33;

constexpr size_t MiB = 1u << 20;
constexpr size_t WS_CTL = 0, CTL_ZERO_BYTES = 1 * MiB;
constexpr size_t WS_MODP = 1 * MiB;
constexpr size_t WS_MODV = 5 * MiB;
constexpr size_t WS_WLORA = 6 * MiB;
constexpr size_t WS_WGATE = 10 * MiB;
constexpr size_t WS_ALORA = 11 * MiB;
constexpr size_t WS_AGATE = 16 * MiB;
constexpr size_t WS_WOUT = 20 * MiB;
constexpr size_t WS_WGU = 52 * MiB;
constexpr size_t WS_WDN = 224 * MiB;
constexpr size_t WS_WIN = 310 * MiB;
constexpr size_t WS_PU = 310 * MiB;
constexpr size_t WS_SST = 374 * MiB;
constexpr size_t WS_A1 = 410 * MiB;
constexpr size_t WS_CAT = 410 * MiB;
constexpr size_t WS_Z = 476 * MiB;
constexpr size_t WS_YS = 476 * MiB;
constexpr size_t WS_KD = 604 * MiB;
constexpr size_t WS_GE = 670 * MiB;
constexpr size_t WS_KBUF = 683 * MiB;
constexpr size_t WS_KKBUF = 749 * MiB;
constexpr size_t WS_RBUF = 815 * MiB;
constexpr size_t WS_VBUF = 881 * MiB;
constexpr size_t WS_X1 = 683 * MiB;
constexpr size_t WS_PK = 947 * MiB;
constexpr size_t WS_ACT = 947 * MiB;
constexpr size_t WS_G = 1475 * MiB;
constexpr size_t WS_END = 1507 * MiB;
static_assert(WS_MODP + (size_t)NKC * 2 * MODN * 4 <= WS_MODV && WS_ALORA + (size_t)TT * 256 * 2 <= WS_AGATE && WS_WGU + (size_t)NGU * D * 2 <= WS_WDN && WS_WDN + (size_t)D * DFF * 2 <= WS_WIN, "ws map 1");
static_assert(WS_WIN + (size_t)NZ * D * 2 <= WS_A1 && WS_SST + (size_t)64 * NCHUNK * 16384 <= WS_A1 && WS_A1 + (size_t)TT * D * 2 <= WS_Z && WS_Z + (size_t)TT * NZ * 2 <= WS_KBUF, "ws map 2");
static_assert(WS_YS + (size_t)2 * T * 2048 * 4 <= WS_KD && WS_KD + (size_t)2 * TT * 2048 * 2 <= WS_GE && WS_GE + (size_t)64 * (TT / 16) * 256 <= WS_KBUF, "ws map 3");
static_assert(WS_KBUF + (size_t)TT * 2048 * 4 <= WS_KKBUF && WS_KKBUF + (size_t)TT * 2048 * 4 <= WS_RBUF && WS_RBUF + (size_t)TT * 2048 * 4 <= WS_VBUF && WS_VBUF + (size_t)TT * 2048 * 4 <= WS_PK, "ws map 4");
static_assert(WS_X1 + (size_t)T * D * 4 <= WS_RBUF && WS_PK + (size_t)64 * TT * 1024 <= WS_G && WS_ACT + (size_t)T * DFF * 2 <= WS_G && WS_G + (size_t)T * 2048 * 2 <= WS_END && WS_CAT + (size_t)T * D * 2 <= WS_Z, "ws map 5");
constexpr int CW_TMO = 0;
constexpr int CW_BAR = 4096;

constexpr int RING_OFF = 0, RING_BYTES = 131072;
constexpr int LDSCTL_OFF = RING_BYTES, MISC_OFF = LDSCTL_OFF + 320;
constexpr int LDS_BYTES = 147456;
static_assert(MISC_OFF + 128 <= LDS_BYTES, "LDS map");

#define GAS __attribute__((address_space(1)))
#define LAS __attribute__((address_space(3)))
typedef unsigned short bf16;
typedef unsigned v4u __attribute__((ext_vector_type(4)));
typedef unsigned v2u __attribute__((ext_vector_type(2)));
typedef float f32x4 __attribute__((ext_vector_type(4)));
typedef GAS unsigned gu32;
#define RLX_AGENT __ATOMIC_RELAXED, __HIP_MEMORY_SCOPE_AGENT
#define LDS_WAIT() asm volatile("s_waitcnt lgkmcnt(0)" ::: "memory")
#define VM_WAIT() asm volatile("s_waitcnt vmcnt(0)" ::: "memory")
__device__ __forceinline__ unsigned f2bf(float f) { unsigned u = __builtin_bit_cast(unsigned, f); return (u + 0x7fffu + ((u >> 16) & 1u)) >> 16; }
__device__ __forceinline__ unsigned pk2(float lo, float hi) { return f2bf(lo) | (f2bf(hi) << 16); }
__device__ __forceinline__ float bflo(unsigned w) { return __builtin_bit_cast(float, w << 16); }
__device__ __forceinline__ float bfhi(unsigned w) { return __builtin_bit_cast(float, w & 0xffff0000u); }
__device__ __forceinline__ float sigm(float x) { return 1.0f / (1.0f + __expf(-x)); }

#define XB_TMO      128
#define XB_XCNT(j)  (256  + 64 * (j))
#define XB_XSUB(j)  (1280 + 64 * (j))
#define XB_XGEN(j)  (2304 + 64 * (j))
#define XB_TOP      3328
#define XB_TOPGEN   3392
#define XCD_BAR_WORDS 3456
#define XB_SPIN_CAP (1u << 18)
__device__ __forceinline__ unsigned xb_ld(unsigned* p)              { return __hip_atomic_load(p, __ATOMIC_RELAXED, __HIP_MEMORY_SCOPE_AGENT); }
__device__ __forceinline__ unsigned xb_add(unsigned* p, unsigned v) { return __hip_atomic_fetch_add(p, v, __ATOMIC_RELAXED, __HIP_MEMORY_SCOPE_AGENT); }
__device__ __forceinline__ unsigned xb_xcc_id() { return (unsigned)__builtin_amdgcn_s_getreg((3 << 11) | 20) & 0xFu; }
#define XB_SPIN(cond, bar) do { unsigned _sp = 0; while (cond) { __builtin_amdgcn_s_sleep(1); \
    if ((++_sp & 255u) == 0u) { if (xb_ld(&(bar)[XB_TMO])) break; if (_sp > XB_SPIN_CAP) { atomicAdd(&(bar)[XB_TMO], 1u); break; } } } } while (0)
struct XcdBarrier { unsigned* bar; unsigned x; volatile LAS unsigned* st; };
__device__ __forceinline__ XcdBarrier xcd_barrier_post(unsigned* bar, volatile LAS unsigned* st) {
    XcdBarrier b; b.bar = bar; b.x = xb_xcc_id(); b.st = st;
    if (threadIdx.x == 0) (void)xb_add(&bar[XB_XCNT(b.x)], 1u);
    return b;
}
__device__ __forceinline__ void xcd_barrier_complete(unsigned* bar, unsigned x, unsigned& nloc, unsigned& nx) {
    const unsigned G = gridDim.x * gridDim.y * gridDim.z;
    unsigned sum, cnt, mine, sp = 0u;
    for (;;) {
        sum = 0u; cnt = 0u; mine = 0u;
#pragma unroll
        for (unsigned j = 0; j < 16; ++j) { const unsigned c = xb_ld(&bar[XB_XCNT(j)]); sum += c; cnt += (c > 0u) ? 1u : 0u; mine = (j == x) ? c : mine; }
        if (sum == G) break;
        __builtin_amdgcn_s_sleep(1);
        if ((++sp & 255u) == 0u) { if (xb_ld(&bar[XB_TMO])) break; if (sp > XB_SPIN_CAP) { atomicAdd(&bar[XB_TMO], 1u); break; } }
    }
    nloc = mine > 0u ? mine : 1u; nx = cnt > 0u ? cnt : 1u;
}
__device__ __forceinline__ void xcd_barrier(const XcdBarrier& b, const int wave) {
    asm volatile("s_waitcnt vmcnt(0)" ::: "memory");
    __syncthreads();
    if (wave == 0 && pg8::mk_lane() == 0) {
        unsigned* bar = b.bar;
        __builtin_amdgcn_s_waitcnt(0);
        unsigned nloc = b.st[0], nx = b.st[1];
        if (nloc == 0u) { xcd_barrier_complete(bar, b.x, nloc, nx); b.st[0] = nloc; b.st[1] = nx; }
        const unsigned old = xb_add(&bar[XB_XSUB(b.x)], 1u);
        const unsigned gen = old / nloc;
        if (old + 1u == (gen + 1u) * nloc) {
            __builtin_amdgcn_fence(__ATOMIC_RELEASE, "agent");
            asm volatile("s_waitcnt vmcnt(0)" ::: "memory");
            const unsigned og = xb_add(&bar[XB_TOP], 1u);
            const unsigned tg = og / nx;
            if (og + 1u == (tg + 1u) * nx) xb_add(&bar[XB_TOPGEN], 1u);
            else XB_SPIN(xb_ld(&bar[XB_TOPGEN]) == tg, bar);
            __builtin_amdgcn_fence(__ATOMIC_ACQUIRE, "agent");
            xb_add(&bar[XB_XGEN(b.x)], 1u);
            asm volatile("s_waitcnt vmcnt(0)" ::: "memory");
        } else {
            XB_SPIN(xb_ld(&bar[XB_XGEN(b.x)]) == gen, bar);
            __builtin_amdgcn_fence(__ATOMIC_ACQUIRE, "agent");
            asm volatile("s_waitcnt vmcnt(0)" ::: "memory");
        }
    }
    __syncthreads();
}

struct Frame {
    LAS unsigned char* lds;
    volatile LAS unsigned* MISC;
    gu32* ctl;
    int wave;
    int vcu, G;
    unsigned char* ws;
    const float* in[26];
    float* out;
};
enum { I_X = 0, I_C, I_CTX, I_CCTX, I_WADA, I_BADA, I_NORM1, I_WIN, I_MU, I_KK, I_KA, I_RK, I_W0, I_WDU, I_A0, I_WIU, I_WGU, I_LNXW, I_LNXB, I_CONVW, I_WOUT, I_NORM2, I_WFG, I_WFU, I_WFD, I_NORMF };

__device__ __forceinline__ float wave_sum(float v) {
#pragma unroll
    for (int o = 1; o < 64; o <<= 1) v += __shfl_xor(v, o);
    return v;
}

__device__ __forceinline__ void p0_transpose_item(const float* W, int K, int N, bf16* WT, int ldk, int row_off, LAS float* scr, int item, int lane) {
    const int nblk = N / 32, kb = item / nblk, nb = item % nblk, k0 = 64 * kb, n0 = 32 * nb;
#pragma unroll 8
    for (int i = 0; i < 32; ++i) { const int kk = 2 * i + (lane >> 5); scr[kk * 33 + (lane & 31)] = *(const GAS float*)(W + (size_t)(k0 + kk) * N + n0 + (lane & 31)); }
    LDS_WAIT(); asm volatile("" ::: "memory");
    const int c = lane & 7;
#pragma unroll
    for (int j = 0; j < 4; ++j) { const int n = (lane >> 3) + 8 * j; const LAS float* s = scr + (8 * c) * 33 + n;
        v4u o; o.x = pk2(s[0 * 33], s[1 * 33]); o.y = pk2(s[2 * 33], s[3 * 33]); o.z = pk2(s[4 * 33], s[5 * 33]); o.w = pk2(s[6 * 33], s[7 * 33]);
        *(GAS v4u*)(WT + (size_t)(row_off + n0 + n) * ldk + k0 + 8 * c) = o; }
    LDS_WAIT(); asm volatile("" ::: "memory");
}
constexpr int TI_IN = (D / 64) * (IN_COLS / 32), TI_OUT = (D / 64) * (D / 32), TI_G = (D / 64) * (DFF / 32), TI_DN = (DFF / 64) * (D / 32);
constexpr int TI_TOTAL = TI_IN + TI_OUT + 2 * TI_G + TI_DN;
constexpr int GEMV_UNITS = NKC * (MODN / 256);
constexpr int TI_PER_GEMV_WAVE = 43, TI_PER_OTHER_WAVE = 67;
static_assert(GEMV_UNITS <= 2048 && GEMV_UNITS * TI_PER_GEMV_WAVE + (2048 - GEMV_UNITS) * TI_PER_OTHER_WAVE >= TI_TOTAL, "P0 item split");

__device__ __forceinline__ void p0_gemv_unit(Frame& F, int unit, int lane) {
    const int kc = unit / (MODN / 256), cc = unit % (MODN / 256);
    const int k0 = kc * 256, col = cc * 256 + lane * 4;
    int sv[4], sc[4];
#pragma unroll
    for (int q = 0; q < 4; ++q) { const float c = *(const GAS float*)(F.in[I_C] + k0 + q * 64 + lane), cx = *(const GAS float*)(F.in[I_CCTX] + k0 + q * 64 + lane);
        sv[q] = __builtin_bit_cast(int, c * sigm(c)); sc[q] = __builtin_bit_cast(int, cx * sigm(cx)); }
    f32x4 a0 = (f32x4){0.f, 0.f, 0.f, 0.f}, a1 = a0;
    const GAS f32x4* wp = (const GAS f32x4*)(F.in[I_WADA] + (size_t)k0 * MODN + col);
#pragma unroll
    for (int q = 0; q < 4; ++q) {
#pragma unroll 16
        for (int i = 0; i < 64; ++i) { const f32x4 w = wp[(size_t)(q * 64 + i) * (MODN / 4)];
            const float s = __builtin_bit_cast(float, __builtin_amdgcn_readlane(sv[q], i)), t = __builtin_bit_cast(float, __builtin_amdgcn_readlane(sc[q], i));
            a0 += w * s; a1 += w * t; }
    }
    float* mp = (float*)(F.ws + WS_MODP);
    *(GAS f32x4*)(mp + (size_t)(kc * 2 + 0) * MODN + col) = a0;
    *(GAS f32x4*)(mp + (size_t)(kc * 2 + 1) * MODN + col) = a1;
}

__device__ __forceinline__ void p0_prologue(Frame& F) {
    LAS float* scr = (LAS float*)(F.lds + RING_OFF + F.wave * 16384);
    const int lane = pg8::mk_lane();
    const int gw = F.vcu * NWAVES + F.wave, NGW = F.G * NWAVES;
    const int gt = gw * 64 + lane, NGT = NGW * 64;
    {
        unsigned* wl = (unsigned*)(F.ws + WS_WLORA);
        for (int i = gt; i < NLORA * KLORA / 2; i += NGT) { const int n = i >> 7, k = (i & 127) * 2, pn = n >> 8, d = pn >> 4, isic = (n >> 7) & 1, ch = (pn & 15) * 128 + (n & 127); float v0 = 0.f, v1 = 0.f;
            if (k < 96) { if (!isic) { v0 = *(const GAS float*)(F.in[I_WDU] + (size_t)(d * 96 + k) * 2048 + ch); v1 = *(const GAS float*)(F.in[I_WDU] + (size_t)(d * 96 + k + 1) * 2048 + ch); } }
            else if (k < 192) { if (isic) { v0 = *(const GAS float*)(F.in[I_WIU] + (size_t)(d * 96 + k - 96) * 2048 + ch); v1 = *(const GAS float*)(F.in[I_WIU] + (size_t)(d * 96 + k - 95) * 2048 + ch); } }
            *(GAS unsigned*)(wl + i) = pk2(v0, v1); }
        unsigned* wg = (unsigned*)(F.ws + WS_WGATE);
        for (int i = gt; i < 2048 * KGATE / 2; i += NGT) { const int n = i >> 7, k = (i & 127) * 2;
            *(GAS unsigned*)(wg + i) = pk2(*(const GAS float*)(F.in[I_WGU] + (size_t)k * 2048 + n), *(const GAS float*)(F.in[I_WGU] + (size_t)(k + 1) * 2048 + n)); }
        v4u* zp = (v4u*)(F.ws + WS_WIN + (size_t)IN_COLS * D * 2);
        for (int i = gt; i < (NZ - IN_COLS) * D * 2 / 16; i += NGT) *(GAS v4u*)(zp + i) = (v4u){0u, 0u, 0u, 0u};
    }
    for (int u = gw; u < GEMV_UNITS; u += NGW) p0_gemv_unit(F, u, lane);
    int it0, it1;
    if (gw < GEMV_UNITS) { it0 = gw * TI_PER_GEMV_WAVE; it1 = it0 + TI_PER_GEMV_WAVE; }
    else { it0 = GEMV_UNITS * TI_PER_GEMV_WAVE + (gw - GEMV_UNITS) * TI_PER_OTHER_WAVE; it1 = it0 + TI_PER_OTHER_WAVE; }
    if (NGW != 2048) { const int per = (TI_TOTAL + NGW - 1) / NGW; it0 = gw * per; it1 = it0 + per; if (gw >= GEMV_UNITS) { } }
    if (it1 > TI_TOTAL) it1 = TI_TOTAL;
    for (int it = it0; it < it1; ++it) {
        int r = it;
        if (r < TI_IN) { p0_transpose_item(F.in[I_WIN], D, IN_COLS, (bf16*)(F.ws + WS_WIN), D, 0, scr, r, lane); continue; } r -= TI_IN;
        if (r < TI_OUT) { p0_transpose_item(F.in[I_WOUT], D, D, (bf16*)(F.ws + WS_WOUT), D, 0, scr, r, lane); continue; } r -= TI_OUT;
        if (r < TI_G) { const int n0 = 32 * (r % (DFF / 32)); p0_transpose_item(F.in[I_WFG], D, DFF, (bf16*)(F.ws + WS_WGU), D, 256 * (n0 >> 7) + (n0 & 127) - n0, scr, r, lane); continue; } r -= TI_G;
        if (r < TI_G) { const int n0 = 32 * (r % (DFF / 32)); p0_transpose_item(F.in[I_WFU], D, DFF, (bf16*)(F.ws + WS_WGU), D, 256 * (n0 >> 7) + 128 + (n0 & 127) - n0, scr, r, lane); continue; } r -= TI_G;
        p0_transpose_item(F.in[I_WFD], DFF, D, (bf16*)(F.ws + WS_WDN), DFF, 0, scr, r, lane);
    }
}

__device__ __forceinline__ void norm_row(const float* xrow, bf16* orow, const LAS float* gs, const LAS float* sh, int lane) {
    const GAS f32x4* xr = (const GAS f32x4*)xrow + lane;
    f32x4 v[16]; float s = 0.f;
#pragma unroll
    for (int j = 0; j < 16; ++j) { v[j] = xr[64 * j]; s += (v[j].x * v[j].x + v[j].y * v[j].y) + (v[j].z * v[j].z + v[j].w * v[j].w); }
    const float rstd = 1.0f / sqrtf(wave_sum(s) * (1.f / D) + NORM_EPS);
    GAS v2u* o8 = (GAS v2u*)orow + lane;
#pragma unroll
    for (int j = 0; j < 16; ++j) { const f32x4 g = *(const LAS f32x4*)(gs + 4 * lane + 256 * j), b = *(const LAS f32x4*)(sh + 4 * lane + 256 * j);
        const f32x4 y = v[j] * rstd * g + b; v2u o; o.x = pk2(y.x, y.y); o.y = pk2(y.z, y.w); o8[64 * j] = o; }
}
__device__ __forceinline__ void p1_norm1(Frame& F) {
    const int lane = pg8::mk_lane(), tid = F.wave * 64 + lane;
    LAS float* tab = (LAS float*)(F.lds + RING_OFF);
    const float* mp = (const float*)(F.ws + WS_MODP);
    for (int i = tid; i < 4 * D; i += NWAVES * 64) {
        const int which = i >> 12, k = i & (D - 1), isc = which >> 1, part = which & 1;
        const int col = part == 0 ? D + k : k;
        float s = *(const GAS float*)(F.in[I_BADA] + col);
#pragma unroll
        for (int p = 0; p < NKC; ++p) s += *(const GAS float*)(mp + (size_t)(p * 2 + isc) * MODN + col);
        tab[i] = part == 0 ? *(const GAS float*)(F.in[I_NORM1] + k) * (1.0f + s) : s;
    }
    {
        float* mv = (float*)(F.ws + WS_MODV);
        for (int i = F.vcu * (NWAVES * 64) + tid; i < 2 * MODN; i += F.G * NWAVES * 64) { const int isc = i / MODN, col = i % MODN;
            float s = *(const GAS float*)(F.in[I_BADA] + col);
#pragma unroll
            for (int p = 0; p < NKC; ++p) s += *(const GAS float*)(mp + (size_t)(p * 2 + isc) * MODN + col);
            *(GAS float*)(mv + i) = s; }
    }
    __syncthreads();
    const int gw = F.vcu * NWAVES + F.wave, NGW = F.G * NWAVES;
    bf16* A1 = (bf16*)(F.ws + WS_A1);
    for (int m = gw; m < TT; m += NGW) {
        if (m < T) norm_row(F.in[I_X] + (size_t)m * D, A1 + (size_t)m * D, tab, tab + D, lane);
        else norm_row(F.in[I_CTX] + (size_t)(m - T) * D, A1 + (size_t)m * D, tab + 2 * D, tab + 3 * D, lane);
    }
    __syncthreads();
}
__device__ __forceinline__ void p10_norm2(Frame& F) {
    const int lane = pg8::mk_lane(), tid = F.wave * 64 + lane;
    LAS float* tab = (LAS float*)(F.lds + RING_OFF);
    const float* mv = (const float*)(F.ws + WS_MODV);
    for (int i = tid; i < 2 * D; i += NWAVES * 64) { const int part = i >> 12, k = i & (D - 1);
        tab[i] = part == 0 ? *(const GAS float*)(F.in[I_NORM2] + k) * (1.0f + *(const GAS float*)(mv + 4 * D + k)) : *(const GAS float*)(mv + 3 * D + k); }
    __syncthreads();
    const int gw = F.vcu * NWAVES + F.wave, NGW = F.G * NWAVES;
    bf16* A1 = (bf16*)(F.ws + WS_A1); const float* X1 = (const float*)(F.ws + WS_X1);
    for (int m = gw; m < T; m += NGW) norm_row(X1 + (size_t)m * D, A1 + (size_t)m * D, tab, tab + D, lane);
    __syncthreads();
}
__device__ __forceinline__ void p13_final(Frame& F) {
    const int lane = pg8::mk_lane();
    const int gw = F.vcu * NWAVES + F.wave, NGW = F.G * NWAVES;
    for (int m = gw; m < T; m += NGW) {
        GAS f32x4* xr = (GAS f32x4*)(F.out + (size_t)m * D) + lane;
        f32x4 v[16]; float s = 0.f;
#pragma unroll
        for (int j = 0; j < 16; ++j) { v[j] = xr[64 * j]; s += (v[j].x * v[j].x + v[j].y * v[j].y) + (v[j].z * v[j].z + v[j].w * v[j].w); }
        const float rstd = 1.0f / sqrtf(wave_sum(s) * (1.f / D) + NORM_EPS);
#pragma unroll
        for (int j = 0; j < 16; ++j) { const f32x4 g = *((const GAS f32x4*)F.in[I_NORMF] + lane + 64 * j); xr[64 * j] = v[j] * rstd * g; }
    }
}

__device__ __forceinline__ void ld8(const bf16* p, float (&f)[8]) { const v4u r = *(const GAS v4u*)p;
    f[0] = bflo(r.x); f[1] = bfhi(r.x); f[2] = bflo(r.y); f[3] = bfhi(r.y); f[4] = bflo(r.z); f[5] = bfhi(r.z); f[6] = bflo(r.w); f[7] = bfhi(r.w); }
__device__ __forceinline__ void ldf8(const float* p, float (&f)[8]) { const f32x4 a = *(const GAS f32x4*)p, b = *(const GAS f32x4*)(p + 4);
    f[0] = a.x; f[1] = a.y; f[2] = a.z; f[3] = a.w; f[4] = b.x; f[5] = b.y; f[6] = b.z; f[7] = b.w; }
__device__ __forceinline__ void stf8(float* p, const float (&f)[8]) { *(GAS f32x4*)p = (f32x4){f[0], f[1], f[2], f[3]}; *(GAS f32x4*)(p + 4) = (f32x4){f[4], f[5], f[6], f[7]}; }
__device__ __forceinline__ void stb8(bf16* p, const float (&f)[8]) { v4u o; o.x = pk2(f[0], f[1]); o.y = pk2(f[2], f[3]); o.z = pk2(f[4], f[5]); o.w = pk2(f[6], f[7]); *(GAS v4u*)p = o; }
__device__ __forceinline__ void za8(const bf16* Z, int row, bool hp, bool hn, int c, const float* mu, float (&o)[8]) {
    float zc[8], zp[8], zn[8], m8[8];
    ld8(Z + (size_t)row * NZ + c, zc);
    if (hp) ld8(Z + (size_t)(row - 1) * NZ + c, zp); else { _Pragma("unroll") for (int i = 0; i < 8; ++i) zp[i] = 0.f; }
    if (hn) ld8(Z + (size_t)(row + 1) * NZ + c, zn); else { _Pragma("unroll") for (int i = 0; i < 8; ++i) zn[i] = 0.f; }
    ldf8(mu + c, m8);
#pragma unroll
    for (int i = 0; i < 8; ++i) o[i] = zc[i] + m8[i] * (0.5f * (zp[i] + zn[i]) - zc[i]);
}
__device__ __forceinline__ void p3_prep(Frame& F) {
    const bf16* Z = (const bf16*)(F.ws + WS_Z);
    float* KB = (float*)(F.ws + WS_KBUF); float* KKB = (float*)(F.ws + WS_KKBUF); float* RB = (float*)(F.ws + WS_RBUF); float* VB = (float*)(F.ws + WS_VBUF);
    bf16* AL = (bf16*)(F.ws + WS_ALORA); bf16* AG = (bf16*)(F.ws + WS_AGATE); bf16* CAT = (bf16*)(F.ws + WS_CAT);
    const float* mu = F.in[I_MU];
    const int tpb = (TT + F.G - 1) / F.G;
    const int tok0 = F.vcu * tpb;
    const int lane = pg8::mk_lane();
    for (int it = F.wave; it < tpb * 18; it += NWAVES) {
        const int type = it / tpb, tok = tok0 + it % tpb;
        if (tok >= TT) continue;
        const bool isctx = tok >= T;
        const int pos = isctx ? tok - T : (tok & 63);
        const bool hp = pos > 0, hn = isctx ? (pos < CTXL - 1) : (pos < 63);
        if (type < 12) {
            const int kind = type >> 2, j = type & 3, c = j * 512 + lane * 8;
            if (isctx && kind == 2) continue;
            const int zoff = kind == 0 ? OFF_K : (kind == 1 ? OFF_V : OFF_R);
            float v[8]; za8(Z, tok, hp, hn, zoff + c, mu, v);
            const size_t fo = (size_t)tok * 2048 + c;
            if (kind == 0) {
                stf8(KB + fo, v);
                float kk8[8], q[8]; ldf8(F.in[I_KK] + c, kk8); float ss = 0.f;
#pragma unroll
                for (int i = 0; i < 8; ++i) { q[i] = v[i] * kk8[i]; ss += q[i] * q[i]; }
                ss += __shfl_xor(ss, 1); ss += __shfl_xor(ss, 2); ss += __shfl_xor(ss, 4);
                const float inv = 1.0f / fmaxf(sqrtf(ss), 1e-12f);
#pragma unroll
                for (int i = 0; i < 8; ++i) q[i] *= inv;
                stf8(KKB + fo, q);
            } else if (kind == 1) stf8(VB + fo, v);
            else stf8(RB + fo, v);
        } else if (type == 12) {
            if (lane < 32) {
                float v[8];
                if (lane < 24) { za8(Z, tok, hp, hn, OFF_WL + lane * 8, mu, v);
                    if (lane < 12) { _Pragma("unroll") for (int i = 0; i < 8; ++i) v[i] = tanhf(v[i]); } }
                else { _Pragma("unroll") for (int i = 0; i < 8; ++i) v[i] = 0.f; }
                stb8(AL + (size_t)tok * KLORA + lane * 8, v);
            }
        } else if (type == 13) {
            if (!isctx && lane < 32) { float v[8]; za8(Z, tok, hp, hn, OFF_GL + lane * 8, mu, v);
#pragma unroll
                for (int i = 0; i < 8; ++i) v[i] = sigm(v[i]);
                stb8(AG + (size_t)tok * KGATE + lane * 8, v); }
        } else if (!isctx) {
            const int j = type - 14, c = j * 512 + lane * 8;
            float bg[8], cc[8], xc[8], cp[8], xp[8], cn[8], xn[8], w0[8], w1[8], w2[8], y[8];
            const bf16* zr = Z + (size_t)tok * NZ;
            ld8(zr + OFF_CB + c, bg); ld8(zr + OFF_CC + c, cc); ld8(zr + OFF_CX + c, xc);
            if (hp) { ld8(zr - NZ + OFF_CC + c, cp); ld8(zr - NZ + OFF_CX + c, xp); } else { _Pragma("unroll") for (int i = 0; i < 8; ++i) { cp[i] = 0.f; xp[i] = 0.f; } }
            if (hn) { ld8(zr + NZ + OFF_CC + c, cn); ld8(zr + NZ + OFF_CX + c, xn); } else { _Pragma("unroll") for (int i = 0; i < 8; ++i) { cn[i] = 0.f; xn[i] = 0.f; } }
            ldf8(F.in[I_CONVW] + c, w0); ldf8(F.in[I_CONVW] + 2048 + c, w1); ldf8(F.in[I_CONVW] + 4096 + c, w2);
#pragma unroll
            for (int i = 0; i < 8; ++i) y[i] = bg[i] * (w0[i] * (cp[i] * xp[i]) + w1[i] * (cc[i] * xc[i]) + w2[i] * (cn[i] * xn[i]));
            stb8(CAT + (size_t)tok * D + DR + c, y);
        }
    }
}

typedef float f32x16 __attribute__((ext_vector_type(16)));
#define MK_FENCE() asm volatile("" ::: "memory")
__device__ __forceinline__ void swap32(float& x, float& y) { asm volatile("s_nop 1\n\tv_permlane32_swap_b32 %0, %1\n\ts_nop 1" : "+v"(x), "+v"(y)); }
__device__ __forceinline__ int scan_tokbase(int d, int c, int n) {
    const int i0 = 4 * n;
    if (c == 0) return T + (d == 0 ? i0 : CTXL - 4 - i0);
    const int p0 = (c - 1) * CHUNK + i0;
    return d == 0 ? p0 : T - 4 - p0;
}
struct ScanRegs { f32x4 p[4]; float v[4]; };
__device__ __forceinline__ void scan_gload(const float* PK, const float* VB, int d, int h, int tb, int lane, ScanRegs& R) {
    const GAS f32x4* gp = (const GAS f32x4*)(PK + ((size_t)(d * 32 + h) * TT + tb) * 256) + lane;
    const GAS float* gv = (const GAS float*)(VB + (size_t)tb * 2048 + h * 64) + lane;
#pragma unroll
    for (int j = 0; j < 4; ++j) { R.p[j] = gp[64 * j]; R.v[j] = gv[2048 * j]; }
}
__device__ __forceinline__ void scan_lstore(LAS unsigned char* buf, int lane, const ScanRegs& R) {
#pragma unroll
    for (int j = 0; j < 4; ++j) { *((LAS f32x4*)buf + 64 * j + lane) = R.p[j]; *((LAS float*)(buf + 4096) + 64 * j + lane) = R.v[j]; }
}
__device__ __forceinline__ void scan_matvec(const f32x16 (&Tt)[2][2], const LAS float* vec, int hl, float& sa) {
    float p0a = 0.f, p0b = 0.f, p1a = 0.f, p1b = 0.f;
#pragma unroll
    for (int I = 0; I < 2; ++I)
#pragma unroll
        for (int qd = 0; qd < 4; ++qd) { const f32x4 a = *(const LAS f32x4*)(vec + 32 * I + 8 * qd + 4 * hl);
            p0a += Tt[I][0][4 * qd] * a.x; p0b += Tt[I][0][4 * qd + 1] * a.y; p0a += Tt[I][0][4 * qd + 2] * a.z; p0b += Tt[I][0][4 * qd + 3] * a.w;
            p1a += Tt[I][1][4 * qd] * a.x; p1b += Tt[I][1][4 * qd + 1] * a.y; p1a += Tt[I][1][4 * qd + 2] * a.z; p1b += Tt[I][1][4 * qd + 3] * a.w; }
    float p0 = p0a + p0b, p1 = p1a + p1b;
    swap32(p0, p1);
    sa = p0 + p1;
}
__device__ __forceinline__ void scan_renorm(f32x16 (&Tt)[2][2], const float* ge, int hl) {
#pragma unroll
    for (int I = 0; I < 2; ++I)
#pragma unroll
        for (int qd = 0; qd < 4; ++qd) { const f32x4 g = *(const GAS f32x4*)(ge + 32 * I + 8 * qd + 4 * hl);
#pragma unroll
            for (int e = 0; e < 4; ++e) { Tt[I][0][4 * qd + e] *= g[e]; Tt[I][1][4 * qd + e] *= g[e]; } }
}
__device__ __forceinline__ void scan_store_T(const f32x16 (&Tt)[2][2], float* dst, int lane) {
#pragma unroll
    for (int I = 0; I < 2; ++I)
#pragma unroll
        for (int J = 0; J < 2; ++J)
#pragma unroll
            for (int reg = 0; reg < 16; ++reg) *(GAS float*)(dst + (32 * I + 8 * (reg >> 2) + 4 * (lane >> 5) + (reg & 3)) * 64 + 32 * J + (lane & 31)) = Tt[I][J][reg];
}
__device__ __forceinline__ void p5_scanA(Frame& F) {
    const float* PK = (const float*)(F.ws + WS_PK); const float* VB = (const float*)(F.ws + WS_VBUF); const float* GE = (const float*)(F.ws + WS_GE);
    float* PU = (float*)(F.ws + WS_PU);
    LAS unsigned char* my = F.lds + RING_OFF + F.wave * 10240;
    for (int unit = F.vcu * NWAVES + F.wave; unit < 2048; unit += F.G * NWAVES) {
        const int d = unit & 1, h = (unit >> 1) & 31, c = unit >> 6;
        const int lane = pg8::mk_lane(), hl = lane >> 5;
        f32x16 TP[2][2], TU[2][2];
#pragma unroll
        for (int I = 0; I < 2; ++I)
#pragma unroll
            for (int J = 0; J < 2; ++J)
#pragma unroll
                for (int reg = 0; reg < 16; ++reg) { TP[I][J][reg] = (32 * I + 8 * (reg >> 2) + 4 * hl + (reg & 3) == 32 * J + (lane & 31)) ? 1.0f : 0.0f; TU[I][J][reg] = 0.0f; }
        ScanRegs RA, RB;
        scan_gload(PK, VB, d, h, scan_tokbase(d, c, 0), lane, RA); scan_lstore(my, lane, RA);
        scan_gload(PK, VB, d, h, scan_tokbase(d, c, 1), lane, RA);
        scan_gload(PK, VB, d, h, scan_tokbase(d, c, 2), lane, RB);
#pragma unroll 1
        for (int n2 = 0; n2 < 32; ++n2) {
#pragma unroll
            for (int par = 0; par < 2; ++par) {
                const int n = 2 * n2 + par;
                ScanRegs& R = par == 0 ? RA : RB;
                scan_lstore(my + ((n + 1) & 1) * 5120, lane, R);
                if (n + 3 < 64) scan_gload(PK, VB, d, h, scan_tokbase(d, c, n + 3), lane, R);
                const LAS unsigned char* buf = my + (n & 1) * 5120;
#pragma unroll 1
                for (int jj = 0; jj < 4; ++jj) {
                    const int slot = d == 0 ? jj : 3 - jj;
                    const LAS float* pk = (const LAS float*)(buf + slot * 1024);
                    float vv = ((const LAS float*)(buf + 4096))[slot * 64 + lane];
                    float bk0 = pk[128 + lane], bk1 = pk[192 + lane];
                    float saP, saU;
                    {
                        float p0a = 0.f, p0b = 0.f, p1a = 0.f, p1b = 0.f, u0a = 0.f, u0b = 0.f, u1a = 0.f, u1b = 0.f;
#pragma unroll
                        for (int I = 0; I < 2; ++I)
#pragma unroll
                            for (int qd = 0; qd < 4; ++qd) { const f32x4 a = *(const LAS f32x4*)(pk + 32 * I + 8 * qd + 4 * hl);
                                p0a += TP[I][0][4 * qd] * a.x; p0b += TP[I][0][4 * qd + 1] * a.y; p0a += TP[I][0][4 * qd + 2] * a.z; p0b += TP[I][0][4 * qd + 3] * a.w;
                                p1a += TP[I][1][4 * qd] * a.x; p1b += TP[I][1][4 * qd + 1] * a.y; p1a += TP[I][1][4 * qd + 2] * a.z; p1b += TP[I][1][4 * qd + 3] * a.w;
                                u0a += TU[I][0][4 * qd] * a.x; u0b += TU[I][0][4 * qd + 1] * a.y; u0a += TU[I][0][4 * qd + 2] * a.z; u0b += TU[I][0][4 * qd + 3] * a.w;
                                u1a += TU[I][1][4 * qd] * a.x; u1b += TU[I][1][4 * qd + 1] * a.y; u1a += TU[I][1][4 * qd + 2] * a.z; u1b += TU[I][1][4 * qd + 3] * a.w; }
                        float p0 = p0a + p0b, p1 = p1a + p1b, u0 = u0a + u0b, u1 = u1a + u1b;
                        swap32(p0, p1); swap32(u0, u1); saP = p0 + p1; saU = u0 + u1;
                    }
                    float zz = 0.0f;
                    swap32(saU, vv);
                    swap32(saP, zz);
                    TU[0][0] = __builtin_amdgcn_mfma_f32_32x32x2f32(bk0, saU, TU[0][0], 0, 0, 0); TU[0][1] = __builtin_amdgcn_mfma_f32_32x32x2f32(bk0, vv, TU[0][1], 0, 0, 0);
                    TU[1][0] = __builtin_amdgcn_mfma_f32_32x32x2f32(bk1, saU, TU[1][0], 0, 0, 0); TU[1][1] = __builtin_amdgcn_mfma_f32_32x32x2f32(bk1, vv, TU[1][1], 0, 0, 0);
                    TP[0][0] = __builtin_amdgcn_mfma_f32_32x32x2f32(bk0, saP, TP[0][0], 0, 0, 0); TP[0][1] = __builtin_amdgcn_mfma_f32_32x32x2f32(bk0, zz, TP[0][1], 0, 0, 0);
                    TP[1][0] = __builtin_amdgcn_mfma_f32_32x32x2f32(bk1, saP, TP[1][0], 0, 0, 0); TP[1][1] = __builtin_amdgcn_mfma_f32_32x32x2f32(bk1, zz, TP[1][1], 0, 0, 0);
                }
                if ((n & 3) == 3) {
                    const int tbk = scan_tokbase(d, c, n - 3 + (d == 0 ? 0 : 3));
                    const float* ge = GE + ((size_t)(d * 32 + h) * (TT / 16) + (tbk >> 4)) * 64;
                    scan_renorm(TP, ge, hl); scan_renorm(TU, ge, hl);
                }
            }
        }
        scan_store_T(TP, PU + ((size_t)unit * 2 + 0) * 4096, lane);
        scan_store_T(TU, PU + ((size_t)unit * 2 + 1) * 4096, lane);
    }
}
__device__ __forceinline__ void p6_scanB(Frame& F) {
    const GAS char* PU = (const GAS char*)(F.ws + WS_PU); GAS char* SST = (GAS char*)(F.ws + WS_SST);
    LAS float* Pi = (LAS float*)(F.lds + RING_OFF);
    LAS float* Tb = (LAS float*)(F.lds + RING_OFF + 16384);
    const int w = F.wave;
    for (int q = F.vcu; q < 64; q += F.G) {
        const unsigned lane = (unsigned)pg8::mk_lane(), tid = (unsigned)w * 64u + lane;
        float Tc[64];
        {   const GAS char* u0 = PU + ((size_t)q * 2 + 1) * 16384;
#pragma unroll
            for (int i = 0; i < 64; ++i) Tc[i] = *(const GAS float*)(u0 + (unsigned)i * 256u + lane * 4u); }
        if (w == 0) {
            GAS char* so = SST + ((size_t)q * NCHUNK + 1) * 16384;
#pragma unroll
            for (int i = 0; i < 64; ++i) *(GAS float*)(so + (unsigned)i * 256u + lane * 4u) = Tc[i];
        }
        for (int c = 1; c < 32; ++c) {
            const size_t unit = (size_t)q + 64 * c;
            const GAS char* pg = PU + (unit * 2 + 0) * 16384; const GAS char* ug = PU + (unit * 2 + 1) * 16384;
            {   const f32x4 t0 = *(const GAS f32x4*)(pg + tid * 32u), t1 = *(const GAS f32x4*)(pg + tid * 32u + 16u);
                *((LAS f32x4*)Pi + tid * 2) = t0; *((LAS f32x4*)Pi + tid * 2 + 1) = t1; }
            float o[8];
#pragma unroll
            for (int kk = 0; kk < 8; ++kk) o[kk] = *(const GAS float*)(ug + (unsigned)(8 * w + kk) * 256u + lane * 4u);
            __syncthreads();
#pragma unroll
            for (int kk = 0; kk < 8; ++kk) {
                float s0 = 0.f, s1 = 0.f;
#pragma unroll
                for (int i4 = 0; i4 < 16; ++i4) { const f32x4 p = *(const LAS f32x4*)(Pi + (8 * w + kk) * 64 + 4 * i4);
                    s0 += p.x * Tc[4 * i4]; s1 += p.y * Tc[4 * i4 + 1]; s0 += p.z * Tc[4 * i4 + 2]; s1 += p.w * Tc[4 * i4 + 3]; }
                o[kk] += s0 + s1;
                MK_FENCE();
            }
            {   GAS char* so = SST + ((size_t)q * NCHUNK + c + 1) * 16384;
#pragma unroll
                for (int kk = 0; kk < 8; ++kk) { Tb[(8 * w + kk) * 64 + lane] = o[kk]; *(GAS float*)(so + (unsigned)(8 * w + kk) * 256u + lane * 4u) = o[kk]; } }
            __syncthreads();
#pragma unroll
            for (int i = 0; i < 64; ++i) Tc[i] = Tb[i * 64 + lane];
        }
        __syncthreads();
    }
}
__device__ __forceinline__ void p7_scanC(Frame& F) {
    const float* PK = (const float*)(F.ws + WS_PK); const float* VB = (const float*)(F.ws + WS_VBUF); const float* GE = (const float*)(F.ws + WS_GE);
    const float* SST = (const float*)(F.ws + WS_SST); float* YS = (float*)(F.ws + WS_YS);
    LAS unsigned char* my = F.lds + RING_OFF + F.wave * 10240;
    for (int unit = F.vcu * NWAVES + F.wave; unit < 2048; unit += F.G * NWAVES) {
        const int d = unit & 1, h = (unit >> 1) & 31, c = (unit >> 6) + 1, q = unit & 63;
        const int lane = pg8::mk_lane(), hl = lane >> 5;
        f32x16 Tt[2][2];
        {   const float* s0 = SST + ((size_t)q * NCHUNK + c) * 4096;
#pragma unroll
            for (int I = 0; I < 2; ++I)
#pragma unroll
                for (int J = 0; J < 2; ++J)
#pragma unroll
                    for (int reg = 0; reg < 16; ++reg) Tt[I][J][reg] = *(const GAS float*)(s0 + (32 * I + 8 * (reg >> 2) + 4 * hl + (reg & 3)) * 64 + 32 * J + (lane & 31)); }
        ScanRegs RA, RB;
        scan_gload(PK, VB, d, h, scan_tokbase(d, c, 0), lane, RA); scan_lstore(my, lane, RA);
        scan_gload(PK, VB, d, h, scan_tokbase(d, c, 1), lane, RA);
        scan_gload(PK, VB, d, h, scan_tokbase(d, c, 2), lane, RB);
        float* yo = YS + (size_t)d * T * 2048 + h * 64 + lane;
#pragma unroll 1
        for (int n2 = 0; n2 < 32; ++n2) {
#pragma unroll
            for (int par = 0; par < 2; ++par) {
                const int n = 2 * n2 + par;
                ScanRegs& R = par == 0 ? RA : RB;
                scan_lstore(my + ((n + 1) & 1) * 5120, lane, R);
                if (n + 3 < 64) scan_gload(PK, VB, d, h, scan_tokbase(d, c, n + 3), lane, R);
                const LAS unsigned char* buf = my + (n & 1) * 5120;
                const int tb = scan_tokbase(d, c, n);
#pragma unroll 1
                for (int jj = 0; jj < 4; ++jj) {
                    const int slot = d == 0 ? jj : 3 - jj;
                    const LAS float* pk = (const LAS float*)(buf + slot * 1024);
                    float vv = ((const LAS float*)(buf + 4096))[slot * 64 + lane];
                    float bk0 = pk[128 + lane], bk1 = pk[192 + lane];
                    float sa; scan_matvec(Tt, pk, hl, sa);
                    swap32(sa, vv);
                    Tt[0][0] = __builtin_amdgcn_mfma_f32_32x32x2f32(bk0, sa, Tt[0][0], 0, 0, 0); Tt[0][1] = __builtin_amdgcn_mfma_f32_32x32x2f32(bk0, vv, Tt[0][1], 0, 0, 0);
                    Tt[1][0] = __builtin_amdgcn_mfma_f32_32x32x2f32(bk1, sa, Tt[1][0], 0, 0, 0); Tt[1][1] = __builtin_amdgcn_mfma_f32_32x32x2f32(bk1, vv, Tt[1][1], 0, 0, 0);
                    float y; scan_matvec(Tt, pk + 64, hl, y);
                    *(GAS float*)(yo + (size_t)(tb + slot) * 2048) = y;
                }
                if ((n & 3) == 3) {
                    const int tbk = scan_tokbase(d, c, n - 3 + (d == 0 ? 0 : 3));
                    scan_renorm(Tt, GE + ((size_t)(d * 32 + h) * (TT / 16) + (tbk >> 4)) * 64, hl);
                }
            }
        }
    }
}

__device__ __forceinline__ void p8_readout(Frame& F) {
    const float* RB = (const float*)(F.ws + WS_RBUF); const float* VB = (const float*)(F.ws + WS_VBUF); const float* YS = (const float*)(F.ws + WS_YS);
    const bf16* KD = (const bf16*)(F.ws + WS_KD);
    const bf16* G = (const bf16*)(F.ws + WS_G); bf16* CAT = (bf16*)(F.ws + WS_CAT);
    const int tpb = (T + F.G - 1) / F.G, tok0 = F.vcu * tpb, lane = pg8::mk_lane();
    for (int it = F.wave; it < tpb * 4; it += NWAVES) {
        const int j = it / tpb, tok = tok0 + it % tpb;
        if (tok >= T) continue;
        const int c = j * 512 + lane * 8;
        float y0[8], y1[8], y[8];
        ldf8(YS + (size_t)tok * 2048 + c, y0); ldf8(YS + ((size_t)T + tok) * 2048 + c, y1);
        float s = 0.f;
#pragma unroll
        for (int i = 0; i < 8; ++i) { y[i] = y0[i] + y1[i]; s += y[i]; }
        s += __shfl_xor(s, 1); s += __shfl_xor(s, 2); s += __shfl_xor(s, 4);
        const float mean = s * (1.0f / 64.0f); float q = 0.f;
#pragma unroll
        for (int i = 0; i < 8; ++i) { const float dlt = y[i] - mean; q += dlt * dlt; }
        q += __shfl_xor(q, 1); q += __shfl_xor(q, 2); q += __shfl_xor(q, 4);
        const float rstd = 1.0f / sqrtf(q * (1.0f / 64.0f) + LNX_EPS);
        float r8[8], v8[8], k0[8], k1[8], rk[8], lw[8], lb[8], g8[8];
        ldf8(RB + (size_t)tok * 2048 + c, r8); ldf8(VB + (size_t)tok * 2048 + c, v8);
        ld8(KD + (size_t)tok * 2048 + c, k0); ld8(KD + ((size_t)TT + tok) * 2048 + c, k1);
        ldf8(F.in[I_RK] + c, rk); ldf8(F.in[I_LNXW] + c, lw); ldf8(F.in[I_LNXB] + c, lb);
        ld8(G + (size_t)tok * 2048 + c, g8);
        float dot = 0.f;
#pragma unroll
        for (int i = 0; i < 8; ++i) dot += r8[i] * (k0[i] + k1[i]) * rk[i];
        dot += __shfl_xor(dot, 1); dot += __shfl_xor(dot, 2); dot += __shfl_xor(dot, 4);
        float o[8];
#pragma unroll
        for (int i = 0; i < 8; ++i) o[i] = ((y[i] - mean) * rstd * lw[i] + lb[i] + dot * v8[i]) * g8[i];
        stb8(CAT + (size_t)tok * D + c, o);
    }
}

template <int K> __device__ __forceinline__ void run_phase(Frame& F) {
    bf16* A1 = (bf16*)(F.ws + WS_A1); bf16* Zb = (bf16*)(F.ws + WS_Z);
    const float* MV = (const float*)(F.ws + WS_MODV);
    (void)A1; (void)Zb; (void)MV;
    asm volatile("; MK_PHASE %0" :: "i"(K) : "memory");
    if constexpr (K == 0) { p0_prologue(F);
    }
    if constexpr (K == 1) { p1_norm1(F);
    }
    if constexpr (K == 2) {
        { pg8::Gemm g{A1, (const bf16*)(F.ws + WS_WIN), T, NZ, D}; pg8::StaticOrder S; S.init(T, NZ, F.G, (int)blockIdx.x);
          pg8::EpiBf16<0> E{Zb, NZ, nullptr, 0, 0, 1.f};
          pg8::gemm_phase<pg8::EpiBf16<0>, pg8::StaticOrder, true, true>(F.lds + RING_OFF, g, S, E, F.wave); }
        { pg8::Gemm g{A1 + (size_t)T * D, (const bf16*)(F.ws + WS_WIN), CTXL, NCTXZ, D}; pg8::StaticOrder S; S.init(CTXL, NCTXZ, F.G, (int)((blockIdx.x + F.G - 64) % F.G));
          pg8::EpiBf16<0> E{Zb + (size_t)T * NZ, NZ, nullptr, 0, 0, 1.f};
          pg8::gemm_phase<pg8::EpiBf16<0>, pg8::StaticOrder, true, true>(F.lds + RING_OFF, g, S, E, F.wave); }

    }
    if constexpr (K == 3) { p3_prep(F);
    }
    if constexpr (K == 4) {
        { int kl = KLORA; asm volatile("" : "+s"(kl));
          pg8::Gemm g{(const bf16*)(F.ws + WS_ALORA), (const bf16*)(F.ws + WS_WLORA), TT, NLORA, kl}; pg8::StaticOrder S; S.init(TT, NLORA, F.G, (int)blockIdx.x);
          pg8::EpiLora E{(float*)(F.ws + WS_PK), (float*)(F.ws + WS_GE), (bf16*)(F.ws + WS_KD), (const float*)(F.ws + WS_KBUF), (const float*)(F.ws + WS_KKBUF), (const float*)(F.ws + WS_RBUF), F.in[I_W0], F.in[I_A0], F.in[I_KA], TT};
          pg8::gemm_phase<pg8::EpiLora, pg8::StaticOrder, true, true>(F.lds + RING_OFF, g, S, E, F.wave); }
        { int kl = KGATE; asm volatile("" : "+s"(kl));
          pg8::Gemm g{(const bf16*)(F.ws + WS_AGATE), (const bf16*)(F.ws + WS_WGATE), T, DR, kl}; pg8::StaticOrder S; S.init(T, DR, F.G, (int)blockIdx.x);
          pg8::EpiBf16<0> E{(bf16*)(F.ws + WS_G), DR, nullptr, 0, 0, 1.f};
          pg8::gemm_phase<pg8::EpiBf16<0>, pg8::StaticOrder, true, true>(F.lds + RING_OFF, g, S, E, F.wave); }

    }
    if constexpr (K == 5) { p5_scanA(F);
    }
    if constexpr (K == 6) { p6_scanB(F);
    }
    if constexpr (K == 7) { p7_scanC(F);
    }
    if constexpr (K == 8) { p8_readout(F);
    }
    if constexpr (K == 9) {
        pg8::Gemm g{(const bf16*)(F.ws + WS_CAT), (const bf16*)(F.ws + WS_WOUT), T, D, D}; pg8::StaticOrder S; S.init(T, D, F.G, (int)blockIdx.x);
        pg8::EpiResid E{F.in[I_X], (float*)(F.ws + WS_X1), D, MV + 2 * D};
        pg8::gemm_phase<pg8::EpiResid, pg8::StaticOrder, true, true>(F.lds + RING_OFF, g, S, E, F.wave);

    }
    if constexpr (K == 10) { p10_norm2(F);
    }
    if constexpr (K == 11) {
        pg8::Gemm g{A1, (const bf16*)(F.ws + WS_WGU), T, NGU, D}; pg8::StaticOrder S; S.init(T, NGU, F.G, (int)blockIdx.x);
        pg8::EpiSwiglu E{(bf16*)(F.ws + WS_ACT), DFF};
        pg8::gemm_phase<pg8::EpiSwiglu, pg8::StaticOrder, true, true>(F.lds + RING_OFF, g, S, E, F.wave);

    }
    if constexpr (K == 12) {
        pg8::Gemm g{(const bf16*)(F.ws + WS_ACT), (const bf16*)(F.ws + WS_WDN), T, D, DFF}; pg8::StaticOrder S; S.init(T, D, F.G, (int)blockIdx.x);
        pg8::EpiResid E{(const float*)(F.ws + WS_X1), F.out, D, MV + 5 * D};
        pg8::gemm_phase<pg8::EpiResid, pg8::StaticOrder, true, true>(F.lds + RING_OFF, g, S, E, F.wave);

    }
    if constexpr (K == 13) { p13_final(F);
    }
}

struct Args { const float* in[26]; float* out; unsigned char* ws; int ph_lo, ph_hi, li, pad; };
__global__ void __launch_bounds__(NWAVES * 64, 2) mk_fwd(Args args) {
    extern __shared__ __attribute__((aligned(16))) unsigned char lds[];
    Frame F;
    F.lds = (LAS unsigned char*)lds;
    F.MISC = (volatile LAS unsigned*)(F.lds + MISC_OFF);
    F.wave = __builtin_amdgcn_readfirstlane((int)(threadIdx.x >> 6));
    F.G = gridDim.x; { const int bx = blockIdx.x; F.vcu = (F.G % 8 == 0) ? (bx % 8) * (F.G / 8) + bx / 8 : bx; }
    F.ws = args.ws; F.ctl = (gu32*)(args.ws + WS_CTL); F.out = args.out;
#pragma unroll
    for (int i = 0; i < 26; ++i) F.in[i] = args.in[i];
    for (int u = threadIdx.x; u < (LDS_BYTES - LDSCTL_OFF) / 4; u += NWAVES * 64) ((LAS unsigned*)(F.lds + LDSCTL_OFF))[u] = 0u;
    __syncthreads();
    XcdBarrier bar; bar.bar = (unsigned*)(F.ctl + CW_BAR); bar.x = 0; bar.st = nullptr;
    if (N_LAUNCHES == 1) bar = xcd_barrier_post((unsigned*)(F.ctl + CW_BAR), F.MISC + 8);
#define GRID_BAR() do { if (N_LAUNCHES == 1) xcd_barrier(bar, F.wave); } while (0)
    unsigned long long tp0 = 0, tpa = 0, tpb = 0; (void)tp0;
    const int lo = args.ph_lo, hi = args.ph_hi;
#define IN(k) (lo <= (k) && (k) < hi)
#define BOTH(k) (IN(k) && IN((k) + 1))

    if (IN(0)) { if constexpr (0 == TPA || 0 == TPB) tp0 = __builtin_amdgcn_s_memrealtime(); run_phase<0>(F); if constexpr (PH_REPS[0] > 1) { GRID_BAR(); run_phase<0>(F); } if constexpr (PH_REPS[0] > 2) { GRID_BAR(); run_phase<0>(F); } if (BOTH(0)) GRID_BAR(); if constexpr (0 == TPA) tpa = __builtin_amdgcn_s_memrealtime() - tp0; if constexpr (0 == TPB) tpb = __builtin_amdgcn_s_memrealtime() - tp0; }
    if (IN(1)) { if constexpr (1 == TPA || 1 == TPB) tp0 = __builtin_amdgcn_s_memrealtime(); run_phase<1>(F); if constexpr (PH_REPS[1] > 1) { GRID_BAR(); run_phase<1>(F); } if constexpr (PH_REPS[1] > 2) { GRID_BAR(); run_phase<1>(F); } if (BOTH(1)) GRID_BAR(); if constexpr (1 == TPA) tpa = __builtin_amdgcn_s_memrealtime() - tp0; if constexpr (1 == TPB) tpb = __builtin_amdgcn_s_memrealtime() - tp0; }
    if (IN(2)) { if constexpr (2 == TPA || 2 == TPB) tp0 = __builtin_amdgcn_s_memrealtime(); run_phase<2>(F); if constexpr (PH_REPS[2] > 1) { GRID_BAR(); run_phase<2>(F); } if constexpr (PH_REPS[2] > 2) { GRID_BAR(); run_phase<2>(F); } if (BOTH(2)) GRID_BAR(); if constexpr (2 == TPA) tpa = __builtin_amdgcn_s_memrealtime() - tp0; if constexpr (2 == TPB) tpb = __builtin_amdgcn_s_memrealtime() - tp0; }
    if (IN(3)) { if constexpr (3 == TPA || 3 == TPB) tp0 = __builtin_amdgcn_s_memrealtime(); run_phase<3>(F); if constexpr (PH_REPS[3] > 1) { GRID_BAR(); run_phase<3>(F); } if constexpr (PH_REPS[3] > 2) { GRID_BAR(); run_phase<3>(F); } if (BOTH(3)) GRID_BAR(); if constexpr (3 == TPA) tpa = __builtin_amdgcn_s_memrealtime() - tp0; if constexpr (3 == TPB) tpb = __builtin_amdgcn_s_memrealtime() - tp0; }
    if (IN(4)) { if constexpr (4 == TPA || 4 == TPB) tp0 = __builtin_amdgcn_s_memrealtime(); run_phase<4>(F); if constexpr (PH_REPS[4] > 1) { GRID_BAR(); run_phase<4>(F); } if constexpr (PH_REPS[4] > 2) { GRID_BAR(); run_phase<4>(F); } if (BOTH(4)) GRID_BAR(); if constexpr (4 == TPA) tpa = __builtin_amdgcn_s_memrealtime() - tp0; if constexpr (4 == TPB) tpb = __builtin_amdgcn_s_memrealtime() - tp0; }
    if (IN(5)) { if constexpr (5 == TPA || 5 == TPB) tp0 = __builtin_amdgcn_s_memrealtime(); run_phase<5>(F); if constexpr (PH_REPS[5] > 1) { GRID_BAR(); run_phase<5>(F); } if constexpr (PH_REPS[5] > 2) { GRID_BAR(); run_phase<5>(F); } if (BOTH(5)) GRID_BAR(); if constexpr (5 == TPA) tpa = __builtin_amdgcn_s_memrealtime() - tp0; if constexpr (5 == TPB) tpb = __builtin_amdgcn_s_memrealtime() - tp0; }
    if (IN(6)) { if constexpr (6 == TPA || 6 == TPB) tp0 = __builtin_amdgcn_s_memrealtime(); run_phase<6>(F); if constexpr (PH_REPS[6] > 1) { GRID_BAR(); run_phase<6>(F); } if constexpr (PH_REPS[6] > 2) { GRID_BAR(); run_phase<6>(F); } if (BOTH(6)) GRID_BAR(); if constexpr (6 == TPA) tpa = __builtin_amdgcn_s_memrealtime() - tp0; if constexpr (6 == TPB) tpb = __builtin_amdgcn_s_memrealtime() - tp0; }
    if (IN(7)) { if constexpr (7 == TPA || 7 == TPB) tp0 = __builtin_amdgcn_s_memrealtime(); run_phase<7>(F); if constexpr (PH_REPS[7] > 1) { GRID_BAR(); run_phase<7>(F); } if constexpr (PH_REPS[7] > 2) { GRID_BAR(); run_phase<7>(F); } if (BOTH(7)) GRID_BAR(); if constexpr (7 == TPA) tpa = __builtin_amdgcn_s_memrealtime() - tp0; if constexpr (7 == TPB) tpb = __builtin_amdgcn_s_memrealtime() - tp0; }
    if (IN(8)) { if constexpr (8 == TPA || 8 == TPB) tp0 = __builtin_amdgcn_s_memrealtime(); run_phase<8>(F); if constexpr (PH_REPS[8] > 1) { GRID_BAR(); run_phase<8>(F); } if constexpr (PH_REPS[8] > 2) { GRID_BAR(); run_phase<8>(F); } if (BOTH(8)) GRID_BAR(); if constexpr (8 == TPA) tpa = __builtin_amdgcn_s_memrealtime() - tp0; if constexpr (8 == TPB) tpb = __builtin_amdgcn_s_memrealtime() - tp0; }
    if (IN(9)) { if constexpr (9 == TPA || 9 == TPB) tp0 = __builtin_amdgcn_s_memrealtime(); run_phase<9>(F); if constexpr (PH_REPS[9] > 1) { GRID_BAR(); run_phase<9>(F); } if constexpr (PH_REPS[9] > 2) { GRID_BAR(); run_phase<9>(F); } if (BOTH(9)) GRID_BAR(); if constexpr (9 == TPA) tpa = __builtin_amdgcn_s_memrealtime() - tp0; if constexpr (9 == TPB) tpb = __builtin_amdgcn_s_memrealtime() - tp0; }
    if (IN(10)) { if constexpr (10 == TPA || 10 == TPB) tp0 = __builtin_amdgcn_s_memrealtime(); run_phase<10>(F); if constexpr (PH_REPS[10] > 1) { GRID_BAR(); run_phase<10>(F); } if constexpr (PH_REPS[10] > 2) { GRID_BAR(); run_phase<10>(F); } if (BOTH(10)) GRID_BAR(); if constexpr (10 == TPA) tpa = __builtin_amdgcn_s_memrealtime() - tp0; if constexpr (10 == TPB) tpb = __builtin_amdgcn_s_memrealtime() - tp0; }
    if (IN(11)) { if constexpr (11 == TPA || 11 == TPB) tp0 = __builtin_amdgcn_s_memrealtime(); run_phase<11>(F); if constexpr (PH_REPS[11] > 1) { GRID_BAR(); run_phase<11>(F); } if constexpr (PH_REPS[11] > 2) { GRID_BAR(); run_phase<11>(F); } if (BOTH(11)) GRID_BAR(); if constexpr (11 == TPA) tpa = __builtin_amdgcn_s_memrealtime() - tp0; if constexpr (11 == TPB) tpb = __builtin_amdgcn_s_memrealtime() - tp0; }
    if (IN(12)) { if constexpr (12 == TPA || 12 == TPB) tp0 = __builtin_amdgcn_s_memrealtime(); run_phase<12>(F); if constexpr (PH_REPS[12] > 1) { GRID_BAR(); run_phase<12>(F); } if constexpr (PH_REPS[12] > 2) { GRID_BAR(); run_phase<12>(F); } if (BOTH(12)) GRID_BAR(); if constexpr (12 == TPA) tpa = __builtin_amdgcn_s_memrealtime() - tp0; if constexpr (12 == TPB) tpb = __builtin_amdgcn_s_memrealtime() - tp0; }
    if (IN(13)) { if constexpr (13 == TPA || 13 == TPB) tp0 = __builtin_amdgcn_s_memrealtime(); run_phase<13>(F); if constexpr (PH_REPS[13] > 1) { GRID_BAR(); run_phase<13>(F); } if constexpr (PH_REPS[13] > 2) { GRID_BAR(); run_phase<13>(F); } if (BOTH(13)) GRID_BAR(); if constexpr (13 == TPA) tpa = __builtin_amdgcn_s_memrealtime() - tp0; if constexpr (13 == TPB) tpb = __builtin_amdgcn_s_memrealtime() - tp0; }
    if constexpr (TPA >= 0 || TPB >= 0) {
        if (blockIdx.x == 0 && F.wave == 0) { const unsigned long long ua = (tpa + 500ull) / 1000ull, ub = (tpb + 500ull) / 1000ull, extra = ua * 100000ull + ub * 1000ull, t1 = __builtin_amdgcn_s_memrealtime();
            while (__builtin_amdgcn_s_memrealtime() - t1 < extra) __builtin_amdgcn_s_sleep(16); }
    }
#undef IN
#undef BOTH
}

extern "C" void kernel_launch(void* const* d_in, const int* in_sizes, int n_in, void* d_out, int out_size, void* d_ws, size_t ws_size, hipStream_t stream) {
    static int grid = 0;
    if (grid == 0) {
        if (n_in != 26 || out_size != T * D || ws_size < WS_END) { fprintf(stderr, "kernel_launch: unexpected shapes: n_in %d out %d ws %zu (need %zu)\n", n_in, out_size, ws_size, (size_t)WS_END); grid = -1; return; }
        int dev = 0, cus = 0, per_cu = 0;
        if (hipGetDevice(&dev) != hipSuccess || hipDeviceGetAttribute(&cus, hipDeviceAttributeMultiprocessorCount, dev) != hipSuccess) { grid = -1; return; }
        if (hipFuncSetAttribute((const void*)mk_fwd, hipFuncAttributeMaxDynamicSharedMemorySize, LDS_BYTES) != hipSuccess) { fprintf(stderr, "kernel_launch: hipFuncSetAttribute failed\n"); grid = -1; return; }
        if (hipOccupancyMaxActiveBlocksPerMultiprocessor(&per_cu, (const void*)mk_fwd, NWAVES * 64, LDS_BYTES) != hipSuccess || per_cu < 1)
            fprintf(stderr, "kernel_launch: note: occupancy query reports %d workgroups per CU\n", per_cu);
        (void)hipGetLastError();
        grid = cus;
    }
    if (grid < 0) return;
    if (hipMemsetAsync((char*)d_ws + WS_CTL, 0, CTL_ZERO_BYTES, stream) != hipSuccess) return;
    Args a{};
    for (int i = 0; i < 26; ++i) a.in[i] = (const float*)d_in[i];
    a.out = (float*)d_out; a.ws = (unsigned char*)d_ws;
    for (int li = 0; li < N_LAUNCHES; ++li) {
        if (N_LAUNCHES == 1) { a.ph_lo = 0; a.ph_hi = N_PHASES; } else { a.ph_lo = li * N_PHASES / N_LAUNCHES; a.ph_hi = (li + 1) * N_PHASES / N_LAUNCHES; }
        a.li = li;
        hipLaunchKernelGGL(mk_fwd, dim3(grid), dim3(NWAVES * 64), LDS_BYTES, stream, a);
        if (hipPeekAtLastError() != hipSuccess) break;
    }
}
```

```cpp
#include <hip/hip_runtime.h>
#include <cstdio>
#include <cstdint>
namespace pg8 {
#define PG8_LAS __attribute__((address_space(3)))
typedef unsigned short bf16_t;
typedef short bf16x8 __attribute__((ext_vector_type(8)));
typedef float f32x4 __attribute__((ext_vector_type(4)));
typedef unsigned u32x4 __attribute__((ext_vector_type(4)));
constexpr int BM = 256, BK = 64, HALF = 128, HTB = HALF * BK * 2  , STAGE_BYTES = 8 * HTB, NXCD = 8, WGM = 8;

__host__ __device__ __forceinline__ int lds_byte(int r, int c) { const int st = (r >> 4) * 2 + (c >> 5), rr = r & 15, cc = c & 31, ob = rr * 64 + cc * 2; return st * 1024 + (ob ^ (((ob >> 9) & 1) << 5)); }
__host__ __device__ __forceinline__ void stage_rc(int b, int& R, int& C) { const int st = b / 1024, sb = b % 1024, swz = sb ^ (((sb >> 9) & 1) << 5); R = (st >> 1) * 16 + swz / 64; C = (st & 1) * 32 + (swz % 64) / 2; }
__host__ __device__ __forceinline__ int perm32(int rho) { const int n = rho >> 4, i = rho & 15; return 8 * (i >> 2) + 4 * n + (i & 3); }

__device__ __forceinline__ int mk_lane() { int l; asm volatile("v_mbcnt_lo_u32_b32 %0, -1, 0\n\tv_mbcnt_hi_u32_b32 %0, -1, %0" : "=v"(l)); return l; }
struct Unit { int pm, pn; };
struct Gemm { const bf16_t* A; const bf16_t* Bt; int M, N, K; };

struct StaticOrder {
    int nM, nN, nwg, G, c;
    __host__ __device__ void init(int M, int N, int G_, int c_) { nM = M / BM; nN = N / BM; nwg = nM * nN; G = G_; c = c_; }
    __host__ __device__ bool next(int i, Unit& u) const {
        const long L = (long)i * G + c; if (L >= nwg) return false;
        int wgid = (int)L; { const int q = nwg / NXCD, r = nwg % NXCD, xcd = wgid % NXCD, off = wgid / NXCD; wgid = (xcd < r ? xcd * (q + 1) : r * (q + 1) + (xcd - r) * q) + off; }
        const int nig = WGM * nN, gid = wgid / nig, fm = gid * WGM, gsz = (nM - fm) < WGM ? (nM - fm) : WGM;
        u.pm = fm + ((wgid % nig) % gsz); u.pn = (wgid % nig) / gsz; return true;
    }
    __device__ __forceinline__ void a_ready(const Unit&) const {}
    __device__ __forceinline__ void done(const Unit&) const {}
};

__device__ __forceinline__ unsigned cvt_pk_bf16(float lo, float hi) { unsigned r; asm volatile("v_cvt_pk_bf16_f32 %0, %1, %2" : "=v"(r) : "v"(lo), "v"(hi)); return r; }
typedef float f32x2 __attribute__((ext_vector_type(2)));
__device__ __forceinline__ f32x2 gelu_pk(f32x2 v) {
    const f32x2 av = __builtin_elementwise_abs(v), d = av * 0.2316418882f + 1.0f;
    f32x2 t; t.x = __builtin_amdgcn_rcpf(d.x); t.y = __builtin_amdgcn_rcpf(d.y);
    f32x2 q = t * 0.5307027145f + (-0.7265760135f); q = q * t + 0.7107068705f; q = q * t + (-0.142248368f); q = q * t + 0.127414796f; q = q * t;
    const f32x2 s = (v * v) * (-0.72134752044f);
    f32x2 e; e.x = __builtin_amdgcn_exp2f(s.x); e.y = __builtin_amdgcn_exp2f(s.y);
    const f32x2 m = v * (q * e), r = v - m;
    f32x2 o; o.x = v.x < 0.f ? m.x : r.x; o.y = v.y < 0.f ? m.y : r.y; return o;
}

template <int ACT  > struct EpiBf16 {
    static constexpr bool PERM = true, AFTER_DRAIN = false; static_assert(ACT == 0 || ACT == 1, "EpiBf16: ACT is 0 (none) or 1 (gelu_pk)");
    bf16_t* O; int ldc; const float* bias; int split_cols; size_t split_stride; float scale0;
    __device__ __forceinline__ void operator()(const f32x4 (&acc)[2][2][4][2], const Unit& u, int wr, int wc, int fr, int fq) const {
        const int row0 = u.pm * BM + wr * 64 + fr; int colt = u.pn * BM; bf16_t* base = O;
        float sc = 1.f; if (split_cols) { const int t = colt / split_cols; base += (size_t)t * split_stride; colt -= t * split_cols; if (t == 0) sc = scale0; }
        const int col0 = colt + wc * 32 + 8 * fq, bcol0 = u.pn * BM + wc * 32 + 8 * fq;
        f32x4 bv[2][2];
#pragma unroll
        for (int bj = 0; bj < 2; ++bj)
#pragma unroll
            for (int n = 0; n < 2; ++n) bv[bj][n] = bias ? *(const f32x4*)(bias + bcol0 + bj * HALF + 4 * n) : (f32x4){0.f, 0.f, 0.f, 0.f};
#pragma unroll
        for (int ai = 0; ai < 2; ++ai)
#pragma unroll
            for (int m = 0; m < 4; ++m) { bf16_t* rowp = base + (size_t)(row0 + ai * HALF + m * 16) * ldc + col0;
#pragma unroll
                for (int bj = 0; bj < 2; ++bj) { f32x4 v0 = acc[ai][bj][m][0] + bv[bj][0], v1 = acc[ai][bj][m][1] + bv[bj][1];
                    if (ACT == 1) { f32x2 a = gelu_pk((f32x2){v0[0], v0[1]}), b = gelu_pk((f32x2){v0[2], v0[3]}), c = gelu_pk((f32x2){v1[0], v1[1]}), d = gelu_pk((f32x2){v1[2], v1[3]});
                        v0 = (f32x4){a.x, a.y, b.x, b.y}; v1 = (f32x4){c.x, c.y, d.x, d.y}; }
                    v0 = v0 * sc; v1 = v1 * sc; u32x4 w; w.x = cvt_pk_bf16(v0[0], v0[1]); w.y = cvt_pk_bf16(v0[2], v0[3]); w.z = cvt_pk_bf16(v1[0], v1[1]); w.w = cvt_pk_bf16(v1[2], v1[3]);
                    *(u32x4*)(rowp + bj * HALF) = w; } }
    }
};
__device__ __forceinline__ float sigmoidf_(float x) { return __builtin_amdgcn_rcpf(1.0f + __expf(-x)); }
struct EpiResid {
    static constexpr bool PERM = false, AFTER_DRAIN = false;
    const float* base; float* out; int ldc; const float* gvec;
    __device__ __forceinline__ void operator()(const f32x4 (&acc)[2][2][4][2], const Unit& u, int wr, int wc, int fr, int fq) const {
        const int row0 = u.pm * BM + wr * 64 + fr, col0 = u.pn * BM + wc * 32 + 4 * fq;
        f32x4 gv[2][2];
#pragma unroll
        for (int bj = 0; bj < 2; ++bj)
#pragma unroll
            for (int n = 0; n < 2; ++n) gv[bj][n] = *(const __attribute__((address_space(1))) f32x4*)(gvec + col0 + bj * HALF + n * 16);
#pragma unroll
        for (int ai = 0; ai < 2; ++ai)
#pragma unroll
            for (int m = 0; m < 4; ++m) { const size_t off = (size_t)(row0 + ai * HALF + m * 16) * ldc + col0;
#pragma unroll
                for (int bj = 0; bj < 2; ++bj)
#pragma unroll
                    for (int n = 0; n < 2; ++n) { const f32x4 bs = *(const __attribute__((address_space(1))) f32x4*)(base + off + bj * HALF + n * 16);
                        *(__attribute__((address_space(1))) f32x4*)(out + off + bj * HALF + n * 16) = bs + gv[bj][n] * acc[ai][bj][m][n]; }
                if (m & 1) asm volatile("" ::: "memory"); }
    }
};
struct EpiSwiglu {
    static constexpr bool PERM = true, AFTER_DRAIN = false;
    bf16_t* O; int ldc;
    __device__ __forceinline__ void operator()(const f32x4 (&acc)[2][2][4][2], const Unit& u, int wr, int wc, int fr, int fq) const {
        const int row0 = u.pm * BM + wr * 64 + fr, col0 = u.pn * HALF + wc * 32 + 8 * fq;
#pragma unroll
        for (int ai = 0; ai < 2; ++ai)
#pragma unroll
            for (int m = 0; m < 4; ++m) { bf16_t* rowp = O + (size_t)(row0 + ai * HALF + m * 16) * ldc + col0;
                f32x4 h0, h1;
#pragma unroll
                for (int j = 0; j < 4; ++j) { const float g0 = acc[ai][0][m][0][j], g1 = acc[ai][0][m][1][j];
                    h0[j] = g0 * sigmoidf_(g0) * acc[ai][1][m][0][j]; h1[j] = g1 * sigmoidf_(g1) * acc[ai][1][m][1][j]; }
                u32x4 w; w.x = cvt_pk_bf16(h0[0], h0[1]); w.y = cvt_pk_bf16(h0[2], h0[3]); w.z = cvt_pk_bf16(h1[0], h1[1]); w.w = cvt_pk_bf16(h1[2], h1[3]);
                *(__attribute__((address_space(1))) u32x4*)rowp = w; }
    }
};
template <int CTRL> __device__ __forceinline__ float dpp_f(float old, float src) { return __builtin_bit_cast(float, __builtin_amdgcn_update_dpp(__builtin_bit_cast(int, old), __builtin_bit_cast(int, src), CTRL, 0xf, 0xf, false)); }
struct EpiLora {
    static constexpr bool PERM = true, AFTER_DRAIN = false;
    float* PK; float* GE; bf16_t* KD; const float* kbuf; const float* kkbuf; const float* rbuf; const float* w0; const float* a0; const float* k_a; int TT;
    __device__ __forceinline__ void operator()(const f32x4 (&acc)[2][2][4][2], const Unit& u, int wr, int wc, int fr, int fq) const {
        typedef __attribute__((address_space(1))) f32x4 gf4; typedef const __attribute__((address_space(1))) f32x4 cgf4;
        const int d = u.pn >> 4, cg = u.pn & 15;
        const int c8 = cg * HALF + wc * 32 + 8 * fq, h = c8 >> 6, ch = c8 & 63;
        const int row0 = u.pm * BM + wr * 64 + fr;
        f32x4 w0v[2], a0v[2], kav[2];
#pragma unroll
        for (int n = 0; n < 2; ++n) { w0v[n] = *(cgf4*)(w0 + d * 2048 + c8 + 4 * n); a0v[n] = *(cgf4*)(a0 + d * 2048 + c8 + 4 * n); kav[n] = *(cgf4*)(k_a + c8 + 4 * n); }
        f32x4 kq[2][2], kkq[2][2], rq[2][2];
        { const size_t fo0 = (size_t)row0 * 2048 + c8;
#pragma unroll
          for (int n = 0; n < 2; ++n) { kq[0][n] = *(cgf4*)(kbuf + fo0 + 4 * n); kkq[0][n] = *(cgf4*)(kkbuf + fo0 + 4 * n); rq[0][n] = *(cgf4*)(rbuf + fo0 + 4 * n); } }
#pragma unroll
        for (int it = 0; it < 8; ++it) {
            const int ai = it >> 2, m = it & 3;
            if (it + 1 < 8) { const size_t fo1 = (size_t)(row0 + ((it + 1) >> 2) * HALF + ((it + 1) & 3) * 16) * 2048 + c8;
#pragma unroll
                for (int n = 0; n < 2; ++n) { kq[(it + 1) & 1][n] = *(cgf4*)(kbuf + fo1 + 4 * n); kkq[(it + 1) & 1][n] = *(cgf4*)(kkbuf + fo1 + 4 * n); rq[(it + 1) & 1][n] = *(cgf4*)(rbuf + fo1 + 4 * n); } }
            asm volatile("" ::: "memory");
            const int tok = row0 + ai * HALF + m * 16;
            float* pk = PK + ((size_t)(d * 32 + h) * TT + tok) * 256;
            const size_t fo = (size_t)tok * 2048 + c8;
            f32x4 g[2]; u32x4 kw;
#pragma unroll
            for (int n = 0; n < 2; ++n) {
                f32x4 gp;
                const f32x4 x = acc[ai][0][m][n] + w0v[n];
#pragma unroll
                for (int j = 0; j < 4; ++j) { float w = __expf(-0.60653066f * sigmoidf_(x[j]));
                    if (d == 0) { w *= dpp_f<0x111>(1.0f, w); w *= dpp_f<0x112>(1.0f, w); w *= dpp_f<0x114>(1.0f, w); w *= dpp_f<0x118>(1.0f, w); g[n][j] = w; gp[j] = dpp_f<0x111>(1.0f, w); }
                    else        { w *= dpp_f<0x101>(1.0f, w); w *= dpp_f<0x102>(1.0f, w); w *= dpp_f<0x104>(1.0f, w); w *= dpp_f<0x108>(1.0f, w); g[n][j] = w; gp[j] = dpp_f<0x101>(1.0f, w); } }
                const f32x4 xa = acc[ai][1][m][n] + a0v[n];
                const f32x4 k4 = kq[it & 1][n], kk4 = kkq[it & 1][n], r4 = rq[it & 1][n];
                f32x4 at, rt, bt, kdt; float kdv[4];
#pragma unroll
                for (int j = 0; j < 4; ++j) { const float a = sigmoidf_(xa[j]), rg = __builtin_amdgcn_rcpf(g[n][j]);
                    kdv[j] = k4[j] * (1.0f + (a - 1.0f) * kav[n][j]);
                    at[j] = -kk4[j] * gp[j]; rt[j] = r4[j] * g[n][j]; bt[j] = kk4[j] * a * rg; kdt[j] = kdv[j] * rg; }
                const int chn = ch + 4 * n;
                *(gf4*)(pk + chn) = at; *(gf4*)(pk + 64 + chn) = rt;
                *(gf4*)(pk + 128 + (chn >> 5) * 64 + (chn & 31)) = bt; *(gf4*)(pk + 160 + (chn >> 5) * 64 + (chn & 31)) = kdt;
                if (n == 0) { kw.x = cvt_pk_bf16(kdv[0], kdv[1]); kw.y = cvt_pk_bf16(kdv[2], kdv[3]); } else { kw.z = cvt_pk_bf16(kdv[0], kdv[1]); kw.w = cvt_pk_bf16(kdv[2], kdv[3]); }
            }
            *(__attribute__((address_space(1))) u32x4*)(KD + (size_t)d * TT * 2048 + fo) = kw;
            if (fr == (d == 0 ? 15 : 0)) { float* ge = GE + ((size_t)(d * 32 + h) * (TT / 16) + (tok >> 4)) * 64 + ch; *(gf4*)ge = g[0]; *(gf4*)(ge + 4) = g[1]; }
        }
    }
};
template <class Epi, class Sched, bool ALIGN_EPI = false, bool SP2 = false>
__device__ __forceinline__ void gemm_phase(PG8_LAS unsigned char* lds, const Gemm g, const Sched& S, const Epi& E, const int wid) {
    const int lane = mk_lane(), tid = wid * 64 + lane, wr = wid >> 2, wc = wid & 3, fr = lane & 15, fq = lane >> 4;
    const int K = g.K, nt = K / BK;
    unsigned voffA[2], voffB[2];
#pragma unroll
    for (int i = 0; i < 2; ++i) { int R, C; stage_rc(tid * 16 + i * 8192, R, C); const int Rb = Epi::PERM ? ((R & ~31) + perm32(R & 31)) : R;
        voffA[i] = (unsigned)(R * K + C) * 2u; voffB[i] = (unsigned)(Rb * K + C) * 2u; }
    const size_t kstep = (size_t)(BK * 2);
    const size_t hstep = (size_t)HALF * K * 2;
    const size_t tstep = 2 * hstep;
    const unsigned ldsw = (unsigned)wid * 1024u;
    const int aoff = lds_byte(wr * 64 + fr, fq * 8), boff = lds_byte(wc * 32 + fr, fq * 8);
#define PG8_SA(b, h) (((b) * 2 + (h)) * HTB)
#define PG8_SB(b, h) ((4 + (b) * 2 + (h)) * HTB)
#define PG8_STAGE(bufoff, gbase, voff) do { _Pragma("unroll") for (int _i = 0; _i < 2; ++_i) \
        __builtin_amdgcn_global_load_lds((const unsigned*)((const char*)(gbase) + (voff)[_i]), (PG8_LAS unsigned*)(lds + (bufoff) + ldsw + _i * 8192), 16, 0, 0); } while (0)
#define PG8_LDA(dst, b, h) do { _Pragma("unroll") for (int m = 0; m < 4; ++m) _Pragma("unroll") for (int k = 0; k < 2; ++k) dst[m][k] = *(const PG8_LAS bf16x8*)(lds + PG8_SA(b, h) + aoff + m * 2048 + k * 1024); } while (0)
#define PG8_LDB(dst, b, h) do { _Pragma("unroll") for (int n = 0; n < 2; ++n) _Pragma("unroll") for (int k = 0; k < 2; ++k) dst[n][k] = *(const PG8_LAS bf16x8*)(lds + PG8_SB(b, h) + boff + n * 2048 + k * 1024); } while (0)
#define PG8_MMA(ai, bj, At, Bt) do { __builtin_amdgcn_s_setprio(1); _Pragma("unroll") for (int m = 0; m < 4; ++m) _Pragma("unroll") for (int n = 0; n < 2; ++n) _Pragma("unroll") for (int k = 0; k < 2; ++k) \
        acc[ai][bj][m][n] = __builtin_amdgcn_mfma_f32_16x16x32_bf16(Bt[n][k], At[m][k], acc[ai][bj][m][n], 0, 0, 0); __builtin_amdgcn_s_setprio(0); } while (0)
#define PG8_WAIT_V(n) asm volatile("s_waitcnt vmcnt(" #n ")" ::: "memory")
#define PG8_WAIT_L(n) asm volatile("s_waitcnt lgkmcnt(" #n ")" ::: "memory")
#define PG8_BAR __builtin_amdgcn_s_barrier()
#define PG8_SCHED __builtin_amdgcn_sched_barrier(0)
    Unit cur, nxt; int ui = 0;
    if (!S.next(0, cur)) return;
    f32x4 acc[2][2][4][2];
#pragma unroll
    for (int a = 0; a < 2; ++a)
#pragma unroll
        for (int b = 0; b < 2; ++b)
#pragma unroll
            for (int m = 0; m < 4; ++m)
#pragma unroll
                for (int n = 0; n < 2; ++n) acc[a][b][m][n] = (f32x4){0.f, 0.f, 0.f, 0.f};
    bf16x8 At[4][2], B0[2][2], B1[2][2];
    const char* cA = (const char*)g.A + (size_t)cur.pm * tstep; const char* cB = (const char*)g.Bt + (size_t)cur.pn * tstep;
    S.a_ready(cur);
    if constexpr (SP2) {
        PG8_STAGE(PG8_SB(0, 0), cB, voffB); PG8_STAGE(PG8_SB(0, 1), cB + hstep, voffB); PG8_STAGE(PG8_SA(0, 0), cA, voffA); PG8_STAGE(PG8_SA(0, 1), cA + hstep, voffA);
        if (wr == 1) PG8_BAR;
        PG8_WAIT_V(2); PG8_BAR;
        PG8_STAGE(PG8_SB(1, 0), cB + kstep, voffB); PG8_STAGE(PG8_SA(1, 0), cA + kstep, voffA); PG8_STAGE(PG8_SB(1, 1), cB + hstep + kstep, voffB);
        PG8_WAIT_V(6); PG8_BAR;
    } else {
        PG8_STAGE(PG8_SB(0, 0), cB, voffB); PG8_STAGE(PG8_SA(0, 0), cA, voffA); PG8_STAGE(PG8_SB(0, 1), cB + hstep, voffB); PG8_STAGE(PG8_SA(0, 1), cA + hstep, voffA);
        if (wr == 1) PG8_BAR;
        PG8_WAIT_V(4); PG8_BAR;
        PG8_STAGE(PG8_SB(1, 0), cB + kstep, voffB); PG8_STAGE(PG8_SA(1, 0), cA + kstep, voffA); PG8_STAGE(PG8_SB(1, 1), cB + hstep + kstep, voffB);
        PG8_WAIT_V(6); PG8_BAR;
    }
    for (;;) {
        const bool has_next = S.next(ui + 1, nxt);
        const char* nA = has_next ? (const char*)g.A + (size_t)nxt.pm * tstep : cA; const char* nB = has_next ? (const char*)g.Bt + (size_t)nxt.pn * tstep : cB;
        for (int t = 0; t < nt; t += 2) {
            const bool last = (t == nt - 2);
            const char* a1 = cA + (size_t)(t + 1) * kstep;
            const char* a2 = last ? nA : cA + (size_t)(t + 2) * kstep; const char* b2 = last ? nB : cB + (size_t)(t + 2) * kstep;
            const char* a3 = a2 + kstep; const char* b3 = b2 + kstep;
            if (last && has_next) S.a_ready(nxt);
            if constexpr (SP2) {
            PG8_LDB(B0, 0, 0); PG8_LDB(B1, 0, 1); PG8_SCHED; PG8_LDA(At, 0, 0); PG8_STAGE(PG8_SA(1, 1), a1 + hstep, voffA);
            PG8_WAIT_V(8); PG8_WAIT_L(0); PG8_BAR; PG8_MMA(0, 0, At, B0); PG8_MMA(0, 1, At, B1); PG8_BAR; PG8_SCHED;
            PG8_LDA(At, 0, 1); PG8_STAGE(PG8_SB(0, 0), b2, voffB); PG8_STAGE(PG8_SB(0, 1), b2 + hstep, voffB); PG8_STAGE(PG8_SA(0, 0), a2, voffA);
            PG8_WAIT_V(8); PG8_WAIT_L(0); PG8_BAR; PG8_MMA(1, 0, At, B0); PG8_MMA(1, 1, At, B1); PG8_BAR; PG8_SCHED;
            PG8_LDB(B0, 1, 0); PG8_LDB(B1, 1, 1); PG8_SCHED; PG8_LDA(At, 1, 0); PG8_STAGE(PG8_SA(0, 1), a2 + hstep, voffA);
            PG8_WAIT_V(8); PG8_WAIT_L(0); PG8_BAR; PG8_MMA(0, 0, At, B0); PG8_MMA(0, 1, At, B1); PG8_BAR; PG8_SCHED;
            PG8_LDA(At, 1, 1); PG8_STAGE(PG8_SB(1, 0), b3, voffB); PG8_STAGE(PG8_SB(1, 1), b3 + hstep, voffB); PG8_STAGE(PG8_SA(1, 0), a3, voffA);
            PG8_WAIT_V(8); PG8_WAIT_L(0); PG8_BAR; PG8_MMA(1, 0, At, B0); PG8_MMA(1, 1, At, B1); PG8_BAR; PG8_SCHED;
            } else {
            PG8_LDB(B0, 0, 0); PG8_SCHED; PG8_LDA(At, 0, 0); PG8_STAGE(PG8_SA(1, 1), a1 + hstep, voffA);
            PG8_WAIT_L(8); PG8_BAR; PG8_WAIT_L(0); PG8_MMA(0, 0, At, B0); PG8_BAR; PG8_SCHED;
            PG8_LDB(B1, 0, 1); PG8_STAGE(PG8_SB(0, 0), b2, voffB);
            PG8_BAR; PG8_WAIT_L(0); PG8_MMA(0, 1, At, B1); PG8_BAR;
            PG8_LDA(At, 0, 1); PG8_STAGE(PG8_SA(0, 0), a2, voffA);
            PG8_BAR; PG8_WAIT_L(0); PG8_MMA(1, 0, At, B0); PG8_BAR; PG8_SCHED;
            PG8_STAGE(PG8_SB(0, 1), b2 + hstep, voffB);
            PG8_WAIT_V(6); PG8_BAR; PG8_MMA(1, 1, At, B1); PG8_BAR;
            PG8_LDB(B0, 1, 0); PG8_SCHED; PG8_LDA(At, 1, 0); PG8_STAGE(PG8_SA(0, 1), a2 + hstep, voffA);
            PG8_WAIT_L(8); PG8_BAR; PG8_WAIT_L(0); PG8_MMA(0, 0, At, B0); PG8_BAR; PG8_SCHED;
            PG8_LDB(B1, 1, 1); PG8_STAGE(PG8_SB(1, 0), b3, voffB);
            PG8_BAR; PG8_WAIT_L(0); PG8_MMA(0, 1, At, B1); PG8_BAR;
            PG8_LDA(At, 1, 1); PG8_STAGE(PG8_SA(1, 0), a3, voffA);
            PG8_BAR; PG8_WAIT_L(0); PG8_MMA(1, 0, At, B0); PG8_BAR; PG8_SCHED;
            PG8_STAGE(PG8_SB(1, 1), b3 + hstep, voffB);
            PG8_WAIT_V(6); PG8_BAR; PG8_MMA(1, 1, At, B1); PG8_BAR;
            }
        }
        if constexpr (ALIGN_EPI) { if (wr == 0) PG8_BAR; }
        if constexpr (!Epi::AFTER_DRAIN) { const int l2 = mk_lane(); E(acc, cur, wr, wc, l2 & 15, l2 >> 4); S.done(cur); }
        if (!has_next) break;
#pragma unroll
        for (int a = 0; a < 2; ++a)
#pragma unroll
            for (int b = 0; b < 2; ++b)
#pragma unroll
                for (int m = 0; m < 4; ++m)
#pragma unroll
                    for (int n = 0; n < 2; ++n) acc[a][b][m][n] = (f32x4){0.f, 0.f, 0.f, 0.f};
        cur = nxt; cA = nA; cB = nB; ++ui;
        if constexpr (ALIGN_EPI) { if (wr == 1) PG8_BAR; }
    }
    PG8_WAIT_V(0);
    if constexpr (!ALIGN_EPI) { if (wr == 0) PG8_BAR; }
    PG8_BAR;
    if constexpr (Epi::AFTER_DRAIN) { E.fused(acc, cur, wr, wc, fr, fq, lds, wid, lane); S.done(cur); }
#undef PG8_SA
#undef PG8_SB
#undef PG8_STAGE
#undef PG8_LDA
#undef PG8_LDB
#undef PG8_MMA
#undef PG8_WAIT_V
#undef PG8_WAIT_L
#undef PG8_BAR
#undef PG8_SCHED
}
}

constexpr int NWAVES = 8;
#ifndef MK_N_LAUNCHES
#define MK_N_LAUNCHES 1
#endif
constexpr int N_PHASES = 14;
#ifndef MK_REPS
#define MK_REPS {1,1,1,1,1,1,1,1,1,1,1,1,1,1}
#endif
constexpr int PH_REPS[14] = MK_REPS;
#ifndef MK_TPA
#define MK_TPA -1
#endif
#ifndef MK_TPB
#define MK_TPB -1
#endif
constexpr int TPA = MK_TPA, TPB = MK_TPB;
constexpr int N_LAUNCHES = MK_N_LAUNCHES;

constexpr int D = 4096, T = 8192, CTXL = 256, TT = T + CTXL;
constexpr int DR = 2048, DC = 2048, NH = 32, HS = 64;
constexpr int OFF_K = 0, OFF_V = 2048, OFF_WL = 4096, OFF_AL = 4192, OFF_R = 4288, OFF_GL = 6336, RWKV_COLS = 6592;
constexpr int OFF_CB = 6592, OFF_CC = 8640, OFF_CX = 10688, IN_COLS = 12736, NZ = 12800;
constexpr int NCTXZ = 4352;
constexpr int DFF = 11008, NGU = 2 * DFF;
constexpr int NLORA = 8192, KLORA = 256, KGATE = 256;
constexpr int MODN = 6 * D;
constexpr int NKC = 16;
constexpr float NORM_EPS = 1e-6f, LNX_EPS = 64e-5f;
constexpr int CHUNK = 256, NCHUNK = 33;

constexpr size_t MiB = 1u << 20;
constexpr size_t WS_CTL = 0, CTL_ZERO_BYTES = 1 * MiB;
constexpr size_t WS_MODP = 1 * MiB;
constexpr size_t WS_MODV = 5 * MiB;
constexpr size_t WS_WLORA = 6 * MiB;
constexpr size_t WS_WGATE = 10 * MiB;
constexpr size_t WS_ALORA = 11 * MiB;
constexpr size_t WS_AGATE = 16 * MiB;
constexpr size_t WS_WOUT = 20 * MiB;
constexpr size_t WS_WGU = 52 * MiB;
constexpr size_t WS_WDN = 224 * MiB;
constexpr size_t WS_WIN = 310 * MiB;
constexpr size_t WS_PU = 310 * MiB;
constexpr size_t WS_SST = 374 * MiB;
constexpr size_t WS_A1 = 410 * MiB;
constexpr size_t WS_CAT = 410 * MiB;
constexpr size_t WS_Z = 476 * MiB;
constexpr size_t WS_YS = 476 * MiB;
constexpr size_t WS_KD = 604 * MiB;
constexpr size_t WS_GE = 670 * MiB;
constexpr size_t WS_KBUF = 683 * MiB;
constexpr size_t WS_KKBUF = 749 * MiB;
constexpr size_t WS_RBUF = 815 * MiB;
constexpr size_t WS_VBUF = 881 * MiB;
constexpr size_t WS_X1 = 683 * MiB;
constexpr size_t WS_PK = 947 * MiB;
constexpr size_t WS_ACT = 947 * MiB;
constexpr size_t WS_G = 1475 * MiB;
constexpr size_t WS_END = 1507 * MiB;
static_assert(WS_MODP + (size_t)NKC * 2 * MODN * 4 <= WS_MODV && WS_ALORA + (size_t)TT * 256 * 2 <= WS_AGATE && WS_WGU + (size_t)NGU * D * 2 <= WS_WDN && WS_WDN + (size_t)D * DFF * 2 <= WS_WIN, "ws map 1");
static_assert(WS_WIN + (size_t)NZ * D * 2 <= WS_A1 && WS_SST + (size_t)64 * NCHUNK * 16384 <= WS_A1 && WS_A1 + (size_t)TT * D * 2 <= WS_Z && WS_Z + (size_t)TT * NZ * 2 <= WS_KBUF, "ws map 2");
static_assert(WS_YS + (size_t)2 * T * 2048 * 4 <= WS_KD && WS_KD + (size_t)2 * TT * 2048 * 2 <= WS_GE && WS_GE + (size_t)64 * (TT / 16) * 256 <= WS_KBUF, "ws map 3");
static_assert(WS_KBUF + (size_t)TT * 2048 * 4 <= WS_KKBUF && WS_KKBUF + (size_t)TT * 2048 * 4 <= WS_RBUF && WS_RBUF + (size_t)TT * 2048 * 4 <= WS_VBUF && WS_VBUF + (size_t)TT * 2048 * 4 <= WS_PK, "ws map 4");
static_assert(WS_X1 + (size_t)T * D * 4 <= WS_RBUF && WS_PK + (size_t)64 * TT * 1024 <= WS_G && WS_ACT + (size_t)T * DFF * 2 <= WS_G && WS_G + (size_t)T * 2048 * 2 <= WS_END && WS_CAT + (size_t)T * D * 2 <= WS_Z, "ws map 5");
constexpr int CW_TMO = 0;
constexpr int CW_BAR = 4096;

constexpr int RING_OFF = 0, RING_BYTES = 131072;
constexpr int LDSCTL_OFF = RING_BYTES, MISC_OFF = LDSCTL_OFF + 320;
constexpr int LDS_BYTES = 147456;
static_assert(MISC_OFF + 128 <= LDS_BYTES, "LDS map");

#define GAS __attribute__((address_space(1)))
#define LAS __attribute__((address_space(3)))
typedef unsigned short bf16;
typedef unsigned v4u __attribute__((ext_vector_type(4)));
typedef unsigned v2u __attribute__((ext_vector_type(2)));
typedef float f32x4 __attribute__((ext_vector_type(4)));
typedef GAS unsigned gu32;
#define RLX_AGENT __ATOMIC_RELAXED, __HIP_MEMORY_SCOPE_AGENT
#define LDS_WAIT() asm volatile("s_waitcnt lgkmcnt(0)" ::: "memory")
#define VM_WAIT() asm volatile("s_waitcnt vmcnt(0)" ::: "memory")
__device__ __forceinline__ unsigned f2bf(float f) { unsigned u = __builtin_bit_cast(unsigned, f); return (u + 0x7fffu + ((u >> 16) & 1u)) >> 16; }
__device__ __forceinline__ unsigned pk2(float lo, float hi) { return f2bf(lo) | (f2bf(hi) << 16); }
__device__ __forceinline__ float bflo(unsigned w) { return __builtin_bit_cast(float, w << 16); }
__device__ __forceinline__ float bfhi(unsigned w) { return __builtin_bit_cast(float, w & 0xffff0000u); }
__device__ __forceinline__ float sigm(float x) { return 1.0f / (1.0f + __expf(-x)); }

#define XB_TMO      128
#define XB_XCNT(j)  (256  + 64 * (j))
#define XB_XSUB(j)  (1280 + 64 * (j))
#define XB_XGEN(j)  (2304 + 64 * (j))
#define XB_TOP      3328
#define XB_TOPGEN   3392
#define XCD_BAR_WORDS 3456
#define XB_SPIN_CAP (1u << 18)
__device__ __forceinline__ unsigned xb_ld(unsigned* p)              { return __hip_atomic_load(p, __ATOMIC_RELAXED, __HIP_MEMORY_SCOPE_AGENT); }
__device__ __forceinline__ unsigned xb_add(unsigned* p, unsigned v) { return __hip_atomic_fetch_add(p, v, __ATOMIC_RELAXED, __HIP_MEMORY_SCOPE_AGENT); }
__device__ __forceinline__ unsigned xb_xcc_id() { return (unsigned)__builtin_amdgcn_s_getreg((3 << 11) | 20) & 0xFu; }
#define XB_SPIN(cond, bar) do { unsigned _sp = 0; while (cond) { __builtin_amdgcn_s_sleep(1); \
    if ((++_sp & 255u) == 0u) { if (xb_ld(&(bar)[XB_TMO])) break; if (_sp > XB_SPIN_CAP) { atomicAdd(&(bar)[XB_TMO], 1u); break; } } } } while (0)
struct XcdBarrier { unsigned* bar; unsigned x; volatile LAS unsigned* st; };
__device__ __forceinline__ XcdBarrier xcd_barrier_post(unsigned* bar, volatile LAS unsigned* st) {
    XcdBarrier b; b.bar = bar; b.x = xb_xcc_id(); b.st = st;
    if (threadIdx.x == 0) (void)xb_add(&bar[XB_XCNT(b.x)], 1u);
    return b;
}
__device__ __forceinline__ void xcd_barrier_complete(unsigned* bar, unsigned x, unsigned& nloc, unsigned& nx) {
    const unsigned G = gridDim.x * gridDim.y * gridDim.z;
    unsigned sum, cnt, mine, sp = 0u;
    for (;;) {
        sum = 0u; cnt = 0u; mine = 0u;
#pragma unroll
        for (unsigned j = 0; j < 16; ++j) { const unsigned c = xb_ld(&bar[XB_XCNT(j)]); sum += c; cnt += (c > 0u) ? 1u : 0u; mine = (j == x) ? c : mine; }
        if (sum == G) break;
        __builtin_amdgcn_s_sleep(1);
        if ((++sp & 255u) == 0u) { if (xb_ld(&bar[XB_TMO])) break; if (sp > XB_SPIN_CAP) { atomicAdd(&bar[XB_TMO], 1u); break; } }
    }
    nloc = mine > 0u ? mine : 1u; nx = cnt > 0u ? cnt : 1u;
}
__device__ __forceinline__ void xcd_barrier(const XcdBarrier& b, const int wave) {
    asm volatile("s_waitcnt vmcnt(0)" ::: "memory");
    __syncthreads();
    if (wave == 0 && pg8::mk_lane() == 0) {
        unsigned* bar = b.bar;
        __builtin_amdgcn_s_waitcnt(0);
        unsigned nloc = b.st[0], nx = b.st[1];
        if (nloc == 0u) { xcd_barrier_complete(bar, b.x, nloc, nx); b.st[0] = nloc; b.st[1] = nx; }
        const unsigned old = xb_add(&bar[XB_XSUB(b.x)], 1u);
        const unsigned gen = old / nloc;
        if (old + 1u == (gen + 1u) * nloc) {
            __builtin_amdgcn_fence(__ATOMIC_RELEASE, "agent");
            asm volatile("s_waitcnt vmcnt(0)" ::: "memory");
            const unsigned og = xb_add(&bar[XB_TOP], 1u);
            const unsigned tg = og / nx;
            if (og + 1u == (tg + 1u) * nx) xb_add(&bar[XB_TOPGEN], 1u);
            else XB_SPIN(xb_ld(&bar[XB_TOPGEN]) == tg, bar);
            __builtin_amdgcn_fence(__ATOMIC_ACQUIRE, "agent");
            xb_add(&bar[XB_XGEN(b.x)], 1u);
            asm volatile("s_waitcnt vmcnt(0)" ::: "memory");
        } else {
            XB_SPIN(xb_ld(&bar[XB_XGEN(b.x)]) == gen, bar);
            __builtin_amdgcn_fence(__ATOMIC_ACQUIRE, "agent");
            asm volatile("s_waitcnt vmcnt(0)" ::: "memory");
        }
    }
    __syncthreads();
}

struct Frame {
    LAS unsigned char* lds;
    volatile LAS unsigned* MISC;
    gu32* ctl;
    int wave;
    int vcu, G;
    unsigned char* ws;
    const float* in[26];
    float* out;
};
enum { I_X = 0, I_C, I_CTX, I_CCTX, I_WADA, I_BADA, I_NORM1, I_WIN, I_MU, I_KK, I_KA, I_RK, I_W0, I_WDU, I_A0, I_WIU, I_WGU, I_LNXW, I_LNXB, I_CONVW, I_WOUT, I_NORM2, I_WFG, I_WFU, I_WFD, I_NORMF };

__device__ __forceinline__ float wave_sum(float v) {
#pragma unroll
    for (int o = 1; o < 64; o <<= 1) v += __shfl_xor(v, o);
    return v;
}

__device__ __forceinline__ void p0_transpose_item(const float* W, int K, int N, bf16* WT, int ldk, int row_off, LAS float* scr, int item, int lane) {
    const int nblk = N / 32, kb = item / nblk, nb = item % nblk, k0 = 64 * kb, n0 = 32 * nb;
#pragma unroll 8
    for (int i = 0; i < 32; ++i) { const int kk = 2 * i + (lane >> 5); scr[kk * 33 + (lane & 31)] = *(const GAS float*)(W + (size_t)(k0 + kk) * N + n0 + (lane & 31)); }
    LDS_WAIT(); asm volatile("" ::: "memory");
    const int c = lane & 7;
#pragma unroll
    for (int j = 0; j < 4; ++j) { const int n = (lane >> 3) + 8 * j; const LAS float* s = scr + (8 * c) * 33 + n;
        v4u o; o.x = pk2(s[0 * 33], s[1 * 33]); o.y = pk2(s[2 * 33], s[3 * 33]); o.z = pk2(s[4 * 33], s[5 * 33]); o.w = pk2(s[6 * 33], s[7 * 33]);
        *(GAS v4u*)(WT + (size_t)(row_off + n0 + n) * ldk + k0 + 8 * c) = o; }
    LDS_WAIT(); asm volatile("" ::: "memory");
}
constexpr int TI_IN = (D / 64) * (IN_COLS / 32), TI_OUT = (D / 64) * (D / 32), TI_G = (D / 64) * (DFF / 32), TI_DN = (DFF / 64) * (D / 32);
constexpr int TI_TOTAL = TI_IN + TI_OUT + 2 * TI_G + TI_DN;
constexpr int GEMV_UNITS = NKC * (MODN / 256);
constexpr int TI_PER_GEMV_WAVE = 43, TI_PER_OTHER_WAVE = 67;
static_assert(GEMV_UNITS <= 2048 && GEMV_UNITS * TI_PER_GEMV_WAVE + (2048 - GEMV_UNITS) * TI_PER_OTHER_WAVE >= TI_TOTAL, "P0 item split");

__device__ __forceinline__ void p0_gemv_unit(Frame& F, int unit, int lane) {
    const int kc = unit / (MODN / 256), cc = unit % (MODN / 256);
    const int k0 = kc * 256, col = cc * 256 + lane * 4;
    int sv[4], sc[4];
#pragma unroll
    for (int q = 0; q < 4; ++q) { const float c = *(const GAS float*)(F.in[I_C] + k0 + q * 64 + lane), cx = *(const GAS float*)(F.in[I_CCTX] + k0 + q * 64 + lane);
        sv[q] = __builtin_bit_cast(int, c * sigm(c)); sc[q] = __builtin_bit_cast(int, cx * sigm(cx)); }
    f32x4 a0 = (f32x4){0.f, 0.f, 0.f, 0.f}, a1 = a0;
    const GAS f32x4* wp = (const GAS f32x4*)(F.in[I_WADA] + (size_t)k0 * MODN + col);
#pragma unroll
    for (int q = 0; q < 4; ++q) {
#pragma unroll 16
        for (int i = 0; i < 64; ++i) { const f32x4 w = wp[(size_t)(q * 64 + i) * (MODN / 4)];
            const float s = __builtin_bit_cast(float, __builtin_amdgcn_readlane(sv[q], i)), t = __builtin_bit_cast(float, __builtin_amdgcn_readlane(sc[q], i));
            a0 += w * s; a1 += w * t; }
    }
    float* mp = (float*)(F.ws + WS_MODP);
    *(GAS f32x4*)(mp + (size_t)(kc * 2 + 0) * MODN + col) = a0;
    *(GAS f32x4*)(mp + (size_t)(kc * 2 + 1) * MODN + col) = a1;
}

__device__ __forceinline__ void p0_prologue(Frame& F) {
    LAS float* scr = (LAS float*)(F.lds + RING_OFF + F.wave * 16384);
    const int lane = pg8::mk_lane();
    const int gw = F.vcu * NWAVES + F.wave, NGW = F.G * NWAVES;
    const int gt = gw * 64 + lane, NGT = NGW * 64;
    {
        unsigned* wl = (unsigned*)(F.ws + WS_WLORA);
        for (int i = gt; i < NLORA * KLORA / 2; i += NGT) { const int n = i >> 7, k = (i & 127) * 2, pn = n >> 8, d = pn >> 4, isic = (n >> 7) & 1, ch = (pn & 15) * 128 + (n & 127); float v0 = 0.f, v1 = 0.f;
            if (k < 96) { if (!isic) { v0 = *(const GAS float*)(F.in[I_WDU] + (size_t)(d * 96 + k) * 2048 + ch); v1 = *(const GAS float*)(F.in[I_WDU] + (size_t)(d * 96 + k + 1) * 2048 + ch); } }
            else if (k < 192) { if (isic) { v0 = *(const GAS float*)(F.in[I_WIU] + (size_t)(d * 96 + k - 96) * 2048 + ch); v1 = *(const GAS float*)(F.in[I_WIU] + (size_t)(d * 96 + k - 95) * 2048 + ch); } }
            *(GAS unsigned*)(wl + i) = pk2(v0, v1); }
        unsigned* wg = (unsigned*)(F.ws + WS_WGATE);
        for (int i = gt; i < 2048 * KGATE / 2; i += NGT) { const int n = i >> 7, k = (i & 127) * 2;
            *(GAS unsigned*)(wg + i) = pk2(*(const GAS float*)(F.in[I_WGU] + (size_t)k * 2048 + n), *(const GAS float*)(F.in[I_WGU] + (size_t)(k + 1) * 2048 + n)); }
        v4u* zp = (v4u*)(F.ws + WS_WIN + (size_t)IN_COLS * D * 2);
        for (int i = gt; i < (NZ - IN_COLS) * D * 2 / 16; i += NGT) *(GAS v4u*)(zp + i) = (v4u){0u, 0u, 0u, 0u};
    }
    for (int u = gw; u < GEMV_UNITS; u += NGW) p0_gemv_unit(F, u, lane);
    int it0, it1;
    if (gw < GEMV_UNITS) { it0 = gw * TI_PER_GEMV_WAVE; it1 = it0 + TI_PER_GEMV_WAVE; }
    else { it0 = GEMV_UNITS * TI_PER_GEMV_WAVE + (gw - GEMV_UNITS) * TI_PER_OTHER_WAVE; it1 = it0 + TI_PER_OTHER_WAVE; }
    if (NGW != 2048) { const int per = (TI_TOTAL + NGW - 1) / NGW; it0 = gw * per; it1 = it0 + per; if (gw >= GEMV_UNITS) { } }
    if (it1 > TI_TOTAL) it1 = TI_TOTAL;
    for (int it = it0; it < it1; ++it) {
        int r = it;
        if (r < TI_IN) { p0_transpose_item(F.in[I_WIN], D, IN_COLS, (bf16*)(F.ws + WS_WIN), D, 0, scr, r, lane); continue; } r -= TI_IN;
        if (r < TI_OUT) { p0_transpose_item(F.in[I_WOUT], D, D, (bf16*)(F.ws + WS_WOUT), D, 0, scr, r, lane); continue; } r -= TI_OUT;
        if (r < TI_G) { const int n0 = 32 * (r % (DFF / 32)); p0_transpose_item(F.in[I_WFG], D, DFF, (bf16*)(F.ws + WS_WGU), D, 256 * (n0 >> 7) + (n0 & 127) - n0, scr, r, lane); continue; } r -= TI_G;
        if (r < TI_G) { const int n0 = 32 * (r % (DFF / 32)); p0_transpose_item(F.in[I_WFU], D, DFF, (bf16*)(F.ws + WS_WGU), D, 256 * (n0 >> 7) + 128 + (n0 & 127) - n0, scr, r, lane); continue; } r -= TI_G;
        p0_transpose_item(F.in[I_WFD], DFF, D, (bf16*)(F.ws + WS_WDN), DFF, 0, scr, r, lane);
    }
}

__device__ __forceinline__ void norm_row(const float* xrow, bf16* orow, const LAS float* gs, const LAS float* sh, int lane) {
    const GAS f32x4* xr = (const GAS f32x4*)xrow + lane;
    f32x4 v[16]; float s = 0.f;
#pragma unroll
    for (int j = 0; j < 16; ++j) { v[j] = xr[64 * j]; s += (v[j].x * v[j].x + v[j].y * v[j].y) + (v[j].z * v[j].z + v[j].w * v[j].w); }
    const float rstd = 1.0f / sqrtf(wave_sum(s) * (1.f / D) + NORM_EPS);
    GAS v2u* o8 = (GAS v2u*)orow + lane;
#pragma unroll
    for (int j = 0; j < 16; ++j) { const f32x4 g = *(const LAS f32x4*)(gs + 4 * lane + 256 * j), b = *(const LAS f32x4*)(sh + 4 * lane + 256 * j);
        const f32x4 y = v[j] * rstd * g + b; v2u o; o.x = pk2(y.x, y.y); o.y = pk2(y.z, y.w); o8[64 * j] = o; }
}
__device__ __forceinline__ void p1_norm1(Frame& F) {
    const int lane = pg8::mk_lane(), tid = F.wave * 64 + lane;
    LAS float* tab = (LAS float*)(F.lds + RING_OFF);
    const float* mp = (const float*)(F.ws + WS_MODP);
    for (int i = tid; i < 4 * D; i += NWAVES * 64) {
        const int which = i >> 12, k = i & (D - 1), isc = which >> 1, part = which & 1;
        const int col = part == 0 ? D + k : k;
        float s = *(const GAS float*)(F.in[I_BADA] + col);
#pragma unroll
        for (int p = 0; p < NKC; ++p) s += *(const GAS float*)(mp + (size_t)(p * 2 + isc) * MODN + col);
        tab[i] = part == 0 ? *(const GAS float*)(F.in[I_NORM1] + k) * (1.0f + s) : s;
    }
    {
        float* mv = (float*)(F.ws + WS_MODV);
        for (int i = F.vcu * (NWAVES * 64) + tid; i < 2 * MODN; i += F.G * NWAVES * 64) { const int isc = i / MODN, col = i % MODN;
            float s = *(const GAS float*)(F.in[I_BADA] + col);
#pragma unroll
            for (int p = 0; p < NKC; ++p) s += *(const GAS float*)(mp + (size_t)(p * 2 + isc) * MODN + col);
            *(GAS float*)(mv + i) = s; }
    }
    __syncthreads();
    const int gw = F.vcu * NWAVES + F.wave, NGW = F.G * NWAVES;
    bf16* A1 = (bf16*)(F.ws + WS_A1);
    for (int m = gw; m < TT; m += NGW) {
        if (m < T) norm_row(F.in[I_X] + (size_t)m * D, A1 + (size_t)m * D, tab, tab + D, lane);
        else norm_row(F.in[I_CTX] + (size_t)(m - T) * D, A1 + (size_t)m * D, tab + 2 * D, tab + 3 * D, lane);
    }
    __syncthreads();
}
__device__ __forceinline__ void p10_norm2(Frame& F) {
    const int lane = pg8::mk_lane(), tid = F.wave * 64 + lane;
    LAS float* tab = (LAS float*)(F.lds + RING_OFF);
    const float* mv = (const float*)(F.ws + WS_MODV);
    for (int i = tid; i < 2 * D; i += NWAVES * 64) { const int part = i >> 12, k = i & (D - 1);
        tab[i] = part == 0 ? *(const GAS float*)(F.in[I_NORM2] + k) * (1.0f + *(const GAS float*)(mv + 4 * D + k)) : *(const GAS float*)(mv + 3 * D + k); }
    __syncthreads();
    const int gw = F.vcu * NWAVES + F.wave, NGW = F.G * NWAVES;
    bf16* A1 = (bf16*)(F.ws + WS_A1); const float* X1 = (const float*)(F.ws + WS_X1);
    for (int m = gw; m < T; m += NGW) norm_row(X1 + (size_t)m * D, A1 + (size_t)m * D, tab, tab + D, lane);
    __syncthreads();
}
__device__ __forceinline__ void p13_final(Frame& F) {
    const int lane = pg8::mk_lane();
    const int gw = F.vcu * NWAVES + F.wave, NGW = F.G * NWAVES;
    for (int m = gw; m < T; m += NGW) {
        GAS f32x4* xr = (GAS f32x4*)(F.out + (size_t)m * D) + lane;
        f32x4 v[16]; float s = 0.f;
#pragma unroll
        for (int j = 0; j < 16; ++j) { v[j] = xr[64 * j]; s += (v[j].x * v[j].x + v[j].y * v[j].y) + (v[j].z * v[j].z + v[j].w * v[j].w); }
        const float rstd = 1.0f / sqrtf(wave_sum(s) * (1.f / D) + NORM_EPS);
#pragma unroll
        for (int j = 0; j < 16; ++j) { const f32x4 g = *((const GAS f32x4*)F.in[I_NORMF] + lane + 64 * j); xr[64 * j] = v[j] * rstd * g; }
    }
}

__device__ __forceinline__ void ld8(const bf16* p, float (&f)[8]) { const v4u r = *(const GAS v4u*)p;
    f[0] = bflo(r.x); f[1] = bfhi(r.x); f[2] = bflo(r.y); f[3] = bfhi(r.y); f[4] = bflo(r.z); f[5] = bfhi(r.z); f[6] = bflo(r.w); f[7] = bfhi(r.w); }
__device__ __forceinline__ void ldf8(const float* p, float (&f)[8]) { const f32x4 a = *(const GAS f32x4*)p, b = *(const GAS f32x4*)(p + 4);
    f[0] = a.x; f[1] = a.y; f[2] = a.z; f[3] = a.w; f[4] = b.x; f[5] = b.y; f[6] = b.z; f[7] = b.w; }
__device__ __forceinline__ void stf8(float* p, const float (&f)[8]) { *(GAS f32x4*)p = (f32x4){f[0], f[1], f[2], f[3]}; *(GAS f32x4*)(p + 4) = (f32x4){f[4], f[5], f[6], f[7]}; }
__device__ __forceinline__ void stb8(bf16* p, const float (&f)[8]) { v4u o; o.x = pk2(f[0], f[1]); o.y = pk2(f[2], f[3]); o.z = pk2(f[4], f[5]); o.w = pk2(f[6], f[7]); *(GAS v4u*)p = o; }
__device__ __forceinline__ void za8(const bf16* Z, int row, bool hp, bool hn, int c, const float* mu, float (&o)[8]) {
    float zc[8], zp[8], zn[8], m8[8];
    ld8(Z + (size_t)row * NZ + c, zc);
    if (hp) ld8(Z + (size_t)(row - 1) * NZ + c, zp); else { _Pragma("unroll") for (int i = 0; i < 8; ++i) zp[i] = 0.f; }
    if (hn) ld8(Z + (size_t)(row + 1) * NZ + c, zn); else { _Pragma("unroll") for (int i = 0; i < 8; ++i) zn[i] = 0.f; }
    ldf8(mu + c, m8);
#pragma unroll
    for (int i = 0; i < 8; ++i) o[i] = zc[i] + m8[i] * (0.5f * (zp[i] + zn[i]) - zc[i]);
}
__device__ __forceinline__ void p3_prep(Frame& F) {
    const bf16* Z = (const bf16*)(F.ws + WS_Z);
    float* KB = (float*)(F.ws + WS_KBUF); float* KKB = (float*)(F.ws + WS_KKBUF); float* RB = (float*)(F.ws + WS_RBUF); float* VB = (float*)(F.ws + WS_VBUF);
    bf16* AL = (bf16*)(F.ws + WS_ALORA); bf16* AG = (bf16*)(F.ws + WS_AGATE); bf16* CAT = (bf16*)(F.ws + WS_CAT);
    const float* mu = F.in[I_MU];
    const int tpb = (TT + F.G - 1) / F.G;
    const int tok0 = F.vcu * tpb;
    const int lane = pg8::mk_lane();
    for (int it = F.wave; it < tpb * 18; it += NWAVES) {
        const int type = it / tpb, tok = tok0 + it % tpb;
        if (tok >= TT) continue;
        const bool isctx = tok >= T;
        const int pos = isctx ? tok - T : (tok & 63);
        const bool hp = pos > 0, hn = isctx ? (pos < CTXL - 1) : (pos < 63);
        if (type < 12) {
            const int kind = type >> 2, j = type & 3, c = j * 512 + lane * 8;
            if (isctx && kind == 2) continue;
            const int zoff = kind == 0 ? OFF_K : (kind == 1 ? OFF_V : OFF_R);
            float v[8]; za8(Z, tok, hp, hn, zoff + c, mu, v);
            const size_t fo = (size_t)tok * 2048 + c;
            if (kind == 0) {
                stf8(KB + fo, v);
                float kk8[8], q[8]; ldf8(F.in[I_KK] + c, kk8); float ss = 0.f;
#pragma unroll
                for (int i = 0; i < 8; ++i) { q[i] = v[i] * kk8[i]; ss += q[i] * q[i]; }
                ss += __shfl_xor(ss, 1); ss += __shfl_xor(ss, 2); ss += __shfl_xor(ss, 4);
                const float inv = 1.0f / fmaxf(sqrtf(ss), 1e-12f);
#pragma unroll
                for (int i = 0; i < 8; ++i) q[i] *= inv;
                stf8(KKB + fo, q);
            } else if (kind == 1) stf8(VB + fo, v);
            else stf8(RB + fo, v);
        } else if (type == 12) {
            if (lane < 32) {
                float v[8];
                if (lane < 24) { za8(Z, tok, hp, hn, OFF_WL + lane * 8, mu, v);
                    if (lane < 12) { _Pragma("unroll") for (int i = 0; i < 8; ++i) v[i] = tanhf(v[i]); } }
                else { _Pragma("unroll") for (int i = 0; i < 8; ++i) v[i] = 0.f; }
                stb8(AL + (size_t)tok * KLORA + lane * 8, v);
            }
        } else if (type == 13) {
            if (!isctx && lane < 32) { float v[8]; za8(Z, tok, hp, hn, OFF_GL + lane * 8, mu, v);
#pragma unroll
                for (int i = 0; i < 8; ++i) v[i] = sigm(v[i]);
                stb8(AG + (size_t)tok * KGATE + lane * 8, v); }
        } else if (!isctx) {
            const int j = type - 14, c = j * 512 + lane * 8;
            float bg[8], cc[8], xc[8], cp[8], xp[8], cn[8], xn[8], w0[8], w1[8], w2[8], y[8];
            const bf16* zr = Z + (size_t)tok * NZ;
            ld8(zr + OFF_CB + c, bg); ld8(zr + OFF_CC + c, cc); ld8(zr + OFF_CX + c, xc);
            if (hp) { ld8(zr - NZ + OFF_CC + c, cp); ld8(zr - NZ + OFF_CX + c, xp); } else { _Pragma("unroll") for (int i = 0; i < 8; ++i) { cp[i] = 0.f; xp[i] = 0.f; } }
            if (hn) { ld8(zr + NZ + OFF_CC + c, cn); ld8(zr + NZ + OFF_CX + c, xn); } else { _Pragma("unroll") for (int i = 0; i < 8; ++i) { cn[i] = 0.f; xn[i] = 0.f; } }
            ldf8(F.in[I_CONVW] + c, w0); ldf8(F.in[I_CONVW] + 2048 + c, w1); ldf8(F.in[I_CONVW] + 4096 + c, w2);
#pragma unroll
            for (int i = 0; i < 8; ++i) y[i] = bg[i] * (w0[i] * (cp[i] * xp[i]) + w1[i] * (cc[i] * xc[i]) + w2[i] * (cn[i] * xn[i]));
            stb8(CAT + (size_t)tok * D + DR + c, y);
        }
    }
}

typedef float f32x16 __attribute__((ext_vector_type(16)));
#define MK_FENCE() asm volatile("" ::: "memory")
__device__ __forceinline__ void swap32(float& x, float& y) { asm volatile("s_nop 1\n\tv_permlane32_swap_b32 %0, %1\n\ts_nop 1" : "+v"(x), "+v"(y)); }
__device__ __forceinline__ int scan_tokbase(int d, int c, int n) {
    const int i0 = 4 * n;
    if (c == 0) return T + (d == 0 ? i0 : CTXL - 4 - i0);
    const int p0 = (c - 1) * CHUNK + i0;
    return d == 0 ? p0 : T - 4 - p0;
}
struct ScanRegs { f32x4 p[4]; float v[4]; };
__device__ __forceinline__ void scan_gload(const float* PK, const float* VB, int d, int h, int tb, int lane, ScanRegs& R) {
    const GAS f32x4* gp = (const GAS f32x4*)(PK + ((size_t)(d * 32 + h) * TT + tb) * 256) + lane;
    const GAS float* gv = (const GAS float*)(VB + (size_t)tb * 2048 + h * 64) + lane;
#pragma unroll
    for (int j = 0; j < 4; ++j) { R.p[j] = gp[64 * j]; R.v[j] = gv[2048 * j]; }
}
__device__ __forceinline__ void scan_lstore(LAS unsigned char* buf, int lane, const ScanRegs& R) {
#pragma unroll
    for (int j = 0; j < 4; ++j) { *((LAS f32x4*)buf + 64 * j + lane) = R.p[j]; *((LAS float*)(buf + 4096) + 64 * j + lane) = R.v[j]; }
}
__device__ __forceinline__ void scan_matvec(const f32x16 (&Tt)[2][2], const LAS float* vec, int hl, float& sa) {
    float p0a = 0.f, p0b = 0.f, p1a = 0.f, p1b = 0.f;
#pragma unroll
    for (int I = 0; I < 2; ++I)
#pragma unroll
        for (int qd = 0; qd < 4; ++qd) { const f32x4 a = *(const LAS f32x4*)(vec + 32 * I + 8 * qd + 4 * hl);
            p0a += Tt[I][0][4 * qd] * a.x; p0b += Tt[I][0][4 * qd + 1] * a.y; p0a += Tt[I][0][4 * qd + 2] * a.z; p0b += Tt[I][0][4 * qd + 3] * a.w;
            p1a += Tt[I][1][4 * qd] * a.x; p1b += Tt[I][1][4 * qd + 1] * a.y; p1a += Tt[I][1][4 * qd + 2] * a.z; p1b += Tt[I][1][4 * qd + 3] * a.w; }
    float p0 = p0a + p0b, p1 = p1a + p1b;
    swap32(p0, p1);
    sa = p0 + p1;
}
__device__ __forceinline__ void scan_renorm(f32x16 (&Tt)[2][2], const float* ge, int hl) {
#pragma unroll
    for (int I = 0; I < 2; ++I)
#pragma unroll
        for (int qd = 0; qd < 4; ++qd) { const f32x4 g = *(const GAS f32x4*)(ge + 32 * I + 8 * qd + 4 * hl);
#pragma unroll
            for (int e = 0; e < 4; ++e) { Tt[I][0][4 * qd + e] *= g[e]; Tt[I][1][4 * qd + e] *= g[e]; } }
}
__device__ __forceinline__ void scan_store_T(const f32x16 (&Tt)[2][2], float* dst, int lane) {
#pragma unroll
    for (int I = 0; I < 2; ++I)
#pragma unroll
        for (int J = 0; J < 2; ++J)
#pragma unroll
            for (int reg = 0; reg < 16; ++reg) *(GAS float*)(dst + (32 * I + 8 * (reg >> 2) + 4 * (lane >> 5) + (reg & 3)) * 64 + 32 * J + (lane & 31)) = Tt[I][J][reg];
}
__device__ __forceinline__ void p5_scanA(Frame& F) {
    const float* PK = (const float*)(F.ws + WS_PK); const float* VB = (const float*)(F.ws + WS_VBUF); const float* GE = (const float*)(F.ws + WS_GE);
    float* PU = (float*)(F.ws + WS_PU);
    LAS unsigned char* my = F.lds + RING_OFF + F.wave * 10240;
    for (int unit = F.vcu * NWAVES + F.wave; unit < 2048; unit += F.G * NWAVES) {
        const int d = unit & 1, h = (unit >> 1) & 31, c = unit >> 6;
        const int lane = pg8::mk_lane(), hl = lane >> 5;
        f32x16 TP[2][2], TU[2][2];
#pragma unroll
        for (int I = 0; I < 2; ++I)
#pragma unroll
            for (int J = 0; J < 2; ++J)
#pragma unroll
                for (int reg = 0; reg < 16; ++reg) { TP[I][J][reg] = (32 * I + 8 * (reg >> 2) + 4 * hl + (reg & 3) == 32 * J + (lane & 31)) ? 1.0f : 0.0f; TU[I][J][reg] = 0.0f; }
        ScanRegs RA, RB;
        scan_gload(PK, VB, d, h, scan_tokbase(d, c, 0), lane, RA); scan_lstore(my, lane, RA);
        scan_gload(PK, VB, d, h, scan_tokbase(d, c, 1), lane, RA);
        scan_gload(PK, VB, d, h, scan_tokbase(d, c, 2), lane, RB);
#pragma unroll 1
        for (int n2 = 0; n2 < 32; ++n2) {
#pragma unroll
            for (int par = 0; par < 2; ++par) {
                const int n = 2 * n2 + par;
                ScanRegs& R = par == 0 ? RA : RB;
                scan_lstore(my + ((n + 1) & 1) * 5120, lane, R);
                if (n + 3 < 64) scan_gload(PK, VB, d, h, scan_tokbase(d, c, n + 3), lane, R);
                const LAS unsigned char* buf = my + (n & 1) * 5120;
#pragma unroll 1
                for (int jj = 0; jj < 4; ++jj) {
                    const int slot = d == 0 ? jj : 3 - jj;
                    const LAS float* pk = (const LAS float*)(buf + slot * 1024);
                    float vv = ((const LAS float*)(buf + 4096))[slot * 64 + lane];
                    float bk0 = pk[128 + lane], bk1 = pk[192 + lane];
                    float saP, saU;
                    {
                        float p0a = 0.f, p0b = 0.f, p1a = 0.f, p1b = 0.f, u0a = 0.f, u0b = 0.f, u1a = 0.f, u1b = 0.f;
#pragma unroll
                        for (int I = 0; I < 2; ++I)
#pragma unroll
                            for (int qd = 0; qd < 4; ++qd) { const f32x4 a = *(const LAS f32x4*)(pk + 32 * I + 8 * qd + 4 * hl);
                                p0a += TP[I][0][4 * qd] * a.x; p0b += TP[I][0][4 * qd + 1] * a.y; p0a += TP[I][0][4 * qd + 2] * a.z; p0b += TP[I][0][4 * qd + 3] * a.w;
                                p1a += TP[I][1][4 * qd] * a.x; p1b += TP[I][1][4 * qd + 1] * a.y; p1a += TP[I][1][4 * qd + 2] * a.z; p1b += TP[I][1][4 * qd + 3] * a.w;
                                u0a += TU[I][0][4 * qd] * a.x; u0b += TU[I][0][4 * qd + 1] * a.y; u0a += TU[I][0][4 * qd + 2] * a.z; u0b += TU[I][0][4 * qd + 3] * a.w;
                                u1a += TU[I][1][4 * qd] * a.x; u1b += TU[I][1][4 * qd + 1] * a.y; u1a += TU[I][1][4 * qd + 2] * a.z; u1b += TU[I][1][4 * qd + 3] * a.w; }
                        float p0 = p0a + p0b, p1 = p1a + p1b, u0 = u0a + u0b, u1 = u1a + u1b;
                        swap32(p0, p1); swap32(u0, u1); saP = p0 + p1; saU = u0 + u1;
                    }
                    float zz = 0.0f;
                    swap32(saU, vv);
                    swap32(saP, zz);
                    TU[0][0] = __builtin_amdgcn_mfma_f32_32x32x2f32(bk0, saU, TU[0][0], 0, 0, 0); TU[0][1] = __builtin_amdgcn_mfma_f32_32x32x2f32(bk0, vv, TU[0][1], 0, 0, 0);
                    TU[1][0] = __builtin_amdgcn_mfma_f32_32x32x2f32(bk1, saU, TU[1][0], 0, 0, 0); TU[1][1] = __builtin_amdgcn_mfma_f32_32x32x2f32(bk1, vv, TU[1][1], 0, 0, 0);
                    TP[0][0] = __builtin_amdgcn_mfma_f32_32x32x2f32(bk0, saP, TP[0][0], 0, 0, 0); TP[0][1] = __builtin_amdgcn_mfma_f32_32x32x2f32(bk0, zz, TP[0][1], 0, 0, 0);
                    TP[1][0] = __builtin_amdgcn_mfma_f32_32x32x2f32(bk1, saP, TP[1][0], 0, 0, 0); TP[1][1] = __builtin_amdgcn_mfma_f32_32x32x2f32(bk1, zz, TP[1][1], 0, 0, 0);
                }
                if ((n & 3) == 3) {
                    const int tbk = scan_tokbase(d, c, n - 3 + (d == 0 ? 0 : 3));
                    const float* ge = GE + ((size_t)(d * 32 + h) * (TT / 16) + (tbk >> 4)) * 64;
                    scan_renorm(TP, ge, hl); scan_renorm(TU, ge, hl);
                }
            }
        }
        scan_store_T(TP, PU + ((size_t)unit * 2 + 0) * 4096, lane);
        scan_store_T(TU, PU + ((size_t)unit * 2 + 1) * 4096, lane);
    }
}
__device__ __forceinline__ void p6_scanB(Frame& F) {
    const GAS char* PU = (const GAS char*)(F.ws + WS_PU); GAS char* SST = (GAS char*)(F.ws + WS_SST);
    LAS float* PiB = (LAS float*)(F.lds + RING_OFF);
    LAS float* TbB = (LAS float*)(F.lds + RING_OFF + 2 * 16640);
    const int w = F.wave;
    for (int q = F.vcu; q < 64; q += F.G) {
        const unsigned lane = (unsigned)pg8::mk_lane(), tid = (unsigned)w * 64u + lane, hl = lane >> 5, l31 = lane & 31u;
        const unsigned I1 = ((unsigned)w >> 1) & 1u, J = (unsigned)w & 1u;
        {   const GAS char* u0 = PU + ((size_t)q * 2 + 1) * 16384; GAS char* so = SST + ((size_t)q * NCHUNK + 1) * 16384;
            const f32x4 t0 = *(const GAS f32x4*)(u0 + tid * 32u), t1 = *(const GAS f32x4*)(u0 + tid * 32u + 16u);
            *((LAS f32x4*)TbB + tid * 2) = t0; *((LAS f32x4*)TbB + tid * 2 + 1) = t1;
            *(GAS f32x4*)(so + tid * 32u) = t0; *(GAS f32x4*)(so + tid * 32u + 16u) = t1; }
        f32x4 pn0, pn1; f32x16 un;
        {   const GAS char* pg = PU + (((size_t)q + 64) * 2 + 0) * 16384; pn0 = *(const GAS f32x4*)(pg + tid * 32u); pn1 = *(const GAS f32x4*)(pg + tid * 32u + 16u);
            const unsigned pb = (tid >> 3) * 65u + (tid & 7u) * 8u;
#pragma unroll
            for (int e = 0; e < 4; ++e) { PiB[pb + e] = pn0[e]; PiB[pb + 4 + e] = pn1[e]; }
            const GAS char* ug = PU + (((size_t)q + 64) * 2 + 1) * 16384;
#pragma unroll
            for (int r = 0; r < 16; ++r) un[r] = (w < 4) ? *(const GAS float*)(ug + ((32u * I1 + 8u * (r >> 2) + 4u * hl + (r & 3)) * 64u + 32u * J + l31) * 4u) : 0.f; }
        __syncthreads();
        for (int c = 1; c < 32; ++c) {
            const LAS float* Pi = PiB + ((c - 1) & 1) * 4160; const LAS float* Tb = TbB + ((c - 1) & 1) * 4096;
            LAS float* PiN = PiB + (c & 1) * 4160; LAS float* TbN = TbB + (c & 1) * 4096;
            f32x16 acc = un;
            if (c + 1 < 32) {
                const GAS char* pg = PU + (((size_t)q + 64 * (c + 1)) * 2 + 0) * 16384; pn0 = *(const GAS f32x4*)(pg + tid * 32u); pn1 = *(const GAS f32x4*)(pg + tid * 32u + 16u);
                const GAS char* ug = PU + (((size_t)q + 64 * (c + 1)) * 2 + 1) * 16384;
                if (w < 4) {
#pragma unroll
                    for (int r = 0; r < 16; ++r) un[r] = *(const GAS float*)(ug + ((32u * I1 + 8u * (r >> 2) + 4u * hl + (r & 3)) * 64u + 32u * J + l31) * 4u); }
            }
            if (w < 4) {
#pragma unroll
                for (int s2 = 0; s2 < 32; ++s2) { const float av = Pi[(32u * I1 + l31) * 65u + 2u * s2 + hl], bv = Tb[(2u * s2 + hl) * 64u + 32u * J + l31];
                    acc = __builtin_amdgcn_mfma_f32_32x32x2f32(av, bv, acc, 0, 0, 0);
                    if ((s2 & 7) == 7) MK_FENCE(); }
                GAS char* so = SST + ((size_t)q * NCHUNK + c + 1) * 16384;
#pragma unroll
                for (int r = 0; r < 16; ++r) { const unsigned e = (32u * I1 + 8u * (r >> 2) + 4u * hl + (r & 3)) * 64u + 32u * J + l31; TbN[e] = acc[r]; *(GAS float*)(so + e * 4u) = acc[r]; }
            }
            if (c + 1 < 32) { const unsigned pb = (tid >> 3) * 65u + (tid & 7u) * 8u;
#pragma unroll
                for (int e = 0; e < 4; ++e) { PiN[pb + e] = pn0[e]; PiN[pb + 4 + e] = pn1[e]; } }
            __syncthreads();
        }
    }
}
__device__ __forceinline__ void p7_scanC(Frame& F) {
    const float* PK = (const float*)(F.ws + WS_PK); const float* VB = (const float*)(F.ws + WS_VBUF); const float* GE = (const float*)(F.ws + WS_GE);
    const float* SST = (const float*)(F.ws + WS_SST); float* YS = (float*)(F.ws + WS_YS);
    LAS unsigned char* my = F.lds + RING_OFF + F.wave * 10240;
    for (int unit = F.vcu * NWAVES + F.wave; unit < 2048; unit += F.G * NWAVES) {
        const int d = unit & 1, h = (unit >> 1) & 31, c = (unit >> 6) + 1, q = unit & 63;
        const int lane = pg8::mk_lane(), hl = lane >> 5;
        f32x16 Tt[2][2];
        {   const float* s0 = SST + ((size_t)q * NCHUNK + c) * 4096;
#pragma unroll
            for (int I = 0; I < 2; ++I)
#pragma unroll
                for (int J = 0; J < 2; ++J)
#pragma unroll
                    for (int reg = 0; reg < 16; ++reg) Tt[I][J][reg] = *(const GAS float*)(s0 + (32 * I + 8 * (reg >> 2) + 4 * hl + (reg & 3)) * 64 + 32 * J + (lane & 31)); }
        ScanRegs RA, RB;
        scan_gload(PK, VB, d, h, scan_tokbase(d, c, 0), lane, RA); scan_lstore(my, lane, RA);
        scan_gload(PK, VB, d, h, scan_tokbase(d, c, 1), lane, RA);
        scan_gload(PK, VB, d, h, scan_tokbase(d, c, 2), lane, RB);
        float* yo = YS + (size_t)d * T * 2048 + h * 64 + lane;
#pragma unroll 1
        for (int n2 = 0; n2 < 32; ++n2) {
#pragma unroll
            for (int par = 0; par < 2; ++par) {
                const int n = 2 * n2 + par;
                ScanRegs& R = par == 0 ? RA : RB;
                scan_lstore(my + ((n + 1) & 1) * 5120, lane, R);
                if (n + 3 < 64) scan_gload(PK, VB, d, h, scan_tokbase(d, c, n + 3), lane, R);
                const LAS unsigned char* buf = my + (n & 1) * 5120;
                const int tb = scan_tokbase(d, c, n);
#pragma unroll 1
                for (int jj = 0; jj < 4; ++jj) {
                    const int slot = d == 0 ? jj : 3 - jj;
                    const LAS float* pk = (const LAS float*)(buf + slot * 1024);
                    float vv = ((const LAS float*)(buf + 4096))[slot * 64 + lane];
                    float bk0 = pk[128 + lane], bk1 = pk[192 + lane];
                    float sa; scan_matvec(Tt, pk, hl, sa);
                    swap32(sa, vv);
                    Tt[0][0] = __builtin_amdgcn_mfma_f32_32x32x2f32(bk0, sa, Tt[0][0], 0, 0, 0); Tt[0][1] = __builtin_amdgcn_mfma_f32_32x32x2f32(bk0, vv, Tt[0][1], 0, 0, 0);
                    Tt[1][0] = __builtin_amdgcn_mfma_f32_32x32x2f32(bk1, sa, Tt[1][0], 0, 0, 0); Tt[1][1] = __builtin_amdgcn_mfma_f32_32x32x2f32(bk1, vv, Tt[1][1], 0, 0, 0);
                    float y; scan_matvec(Tt, pk + 64, hl, y);
                    *(GAS float*)(yo + (size_t)(tb + slot) * 2048) = y;
                }
                if ((n & 3) == 3) {
                    const int tbk = scan_tokbase(d, c, n - 3 + (d == 0 ? 0 : 3));
                    scan_renorm(Tt, GE + ((size_t)(d * 32 + h) * (TT / 16) + (tbk >> 4)) * 64, hl);
                }
            }
        }
    }
}

__device__ __forceinline__ void p8_readout(Frame& F) {
    const float* RB = (const float*)(F.ws + WS_RBUF); const float* VB = (const float*)(F.ws + WS_VBUF); const float* YS = (const float*)(F.ws + WS_YS);
    const bf16* KD = (const bf16*)(F.ws + WS_KD);
    const bf16* G = (const bf16*)(F.ws + WS_G); bf16* CAT = (bf16*)(F.ws + WS_CAT);
    const int tpb = (T + F.G - 1) / F.G, tok0 = F.vcu * tpb, lane = pg8::mk_lane();
    for (int it = F.wave; it < tpb * 4; it += NWAVES) {
        const int j = it / tpb, tok = tok0 + it % tpb;
        if (tok >= T) continue;
        const int c = j * 512 + lane * 8;
        float y0[8], y1[8], y[8];
        ldf8(YS + (size_t)tok * 2048 + c, y0); ldf8(YS + ((size_t)T + tok) * 2048 + c, y1);
        float s = 0.f;
#pragma unroll
        for (int i = 0; i < 8; ++i) { y[i] = y0[i] + y1[i]; s += y[i]; }
        s += __shfl_xor(s, 1); s += __shfl_xor(s, 2); s += __shfl_xor(s, 4);
        const float mean = s * (1.0f / 64.0f); float q = 0.f;
#pragma unroll
        for (int i = 0; i < 8; ++i) { const float dlt = y[i] - mean; q += dlt * dlt; }
        q += __shfl_xor(q, 1); q += __shfl_xor(q, 2); q += __shfl_xor(q, 4);
        const float rstd = 1.0f / sqrtf(q * (1.0f / 64.0f) + LNX_EPS);
        float r8[8], v8[8], k0[8], k1[8], rk[8], lw[8], lb[8], g8[8];
        ldf8(RB + (size_t)tok * 2048 + c, r8); ldf8(VB + (size_t)tok * 2048 + c, v8);
        ld8(KD + (size_t)tok * 2048 + c, k0); ld8(KD + ((size_t)TT + tok) * 2048 + c, k1);
        ldf8(F.in[I_RK] + c, rk); ldf8(F.in[I_LNXW] + c, lw); ldf8(F.in[I_LNXB] + c, lb);
        ld8(G + (size_t)tok * 2048 + c, g8);
        float dot = 0.f;
#pragma unroll
        for (int i = 0; i < 8; ++i) dot += r8[i] * (k0[i] + k1[i]) * rk[i];
        dot += __shfl_xor(dot, 1); dot += __shfl_xor(dot, 2); dot += __shfl_xor(dot, 4);
        float o[8];
#pragma unroll
        for (int i = 0; i < 8; ++i) o[i] = ((y[i] - mean) * rstd * lw[i] + lb[i] + dot * v8[i]) * g8[i];
        stb8(CAT + (size_t)tok * D + c, o);
    }
}

template <int K> __device__ __forceinline__ void run_phase(Frame& F) {
    bf16* A1 = (bf16*)(F.ws + WS_A1); bf16* Zb = (bf16*)(F.ws + WS_Z);
    const float* MV = (const float*)(F.ws + WS_MODV);
    (void)A1; (void)Zb; (void)MV;
    asm volatile("; MK_PHASE %0" :: "i"(K) : "memory");
    if constexpr (K == 0) { p0_prologue(F);
    }
    if constexpr (K == 1) { p1_norm1(F);
    }
    if constexpr (K == 2) {
        { pg8::Gemm g{A1, (const bf16*)(F.ws + WS_WIN), T, NZ, D}; pg8::StaticOrder S; S.init(T, NZ, F.G, (int)blockIdx.x);
          pg8::EpiBf16<0> E{Zb, NZ, nullptr, 0, 0, 1.f};
          pg8::gemm_phase<pg8::EpiBf16<0>, pg8::StaticOrder, true, true>(F.lds + RING_OFF, g, S, E, F.wave); }
        { pg8::Gemm g{A1 + (size_t)T * D, (const bf16*)(F.ws + WS_WIN), CTXL, NCTXZ, D}; pg8::StaticOrder S; S.init(CTXL, NCTXZ, F.G, (int)((blockIdx.x + F.G - 64) % F.G));
          pg8::EpiBf16<0> E{Zb + (size_t)T * NZ, NZ, nullptr, 0, 0, 1.f};
          pg8::gemm_phase<pg8::EpiBf16<0>, pg8::StaticOrder, true, true>(F.lds + RING_OFF, g, S, E, F.wave); }

    }
    if constexpr (K == 3) { p3_prep(F);
    }
    if constexpr (K == 4) {
        { int kl = KLORA; asm volatile("" : "+s"(kl));
          pg8::Gemm g{(const bf16*)(F.ws + WS_ALORA), (const bf16*)(F.ws + WS_WLORA), TT, NLORA, kl}; pg8::StaticOrder S; S.init(TT, NLORA, F.G, (int)blockIdx.x);
          pg8::EpiLora E{(float*)(F.ws + WS_PK), (float*)(F.ws + WS_GE), (bf16*)(F.ws + WS_KD), (const float*)(F.ws + WS_KBUF), (const float*)(F.ws + WS_KKBUF), (const float*)(F.ws + WS_RBUF), F.in[I_W0], F.in[I_A0], F.in[I_KA], TT};
          pg8::gemm_phase<pg8::EpiLora, pg8::StaticOrder, true, true>(F.lds + RING_OFF, g, S, E, F.wave); }
        { int kl = KGATE; asm volatile("" : "+s"(kl));
          pg8::Gemm g{(const bf16*)(F.ws + WS_AGATE), (const bf16*)(F.ws + WS_WGATE), T, DR, kl}; pg8::StaticOrder S; S.init(T, DR, F.G, (int)blockIdx.x);
          pg8::EpiBf16<0> E{(bf16*)(F.ws + WS_G), DR, nullptr, 0, 0, 1.f};
          pg8::gemm_phase<pg8::EpiBf16<0>, pg8::StaticOrder, true, true>(F.lds + RING_OFF, g, S, E, F.wave); }

    }
    if constexpr (K == 5) { p5_scanA(F);
    }
    if constexpr (K == 6) { p6_scanB(F);
    }
    if constexpr (K == 7) { p7_scanC(F);
    }
    if constexpr (K == 8) { p8_readout(F);
    }
    if constexpr (K == 9) {
        pg8::Gemm g{(const bf16*)(F.ws + WS_CAT), (const bf16*)(F.ws + WS_WOUT), T, D, D}; pg8::StaticOrder S; S.init(T, D, F.G, (int)blockIdx.x);
        pg8::EpiResid E{F.in[I_X], (float*)(F.ws + WS_X1), D, MV + 2 * D};
        pg8::gemm_phase<pg8::EpiResid, pg8::StaticOrder, true, true>(F.lds + RING_OFF, g, S, E, F.wave);

    }
    if constexpr (K == 10) { p10_norm2(F);
    }
    if constexpr (K == 11) {
        pg8::Gemm g{A1, (const bf16*)(F.ws + WS_WGU), T, NGU, D}; pg8::StaticOrder S; S.init(T, NGU, F.G, (int)blockIdx.x);
        pg8::EpiSwiglu E{(bf16*)(F.ws + WS_ACT), DFF};
        pg8::gemm_phase<pg8::EpiSwiglu, pg8::StaticOrder, true, true>(F.lds + RING_OFF, g, S, E, F.wave);

    }
    if constexpr (K == 12) {
        pg8::Gemm g{(const bf16*)(F.ws + WS_ACT), (const bf16*)(F.ws + WS_WDN), T, D, DFF}; pg8::StaticOrder S; S.init(T, D, F.G, (int)blockIdx.x);
        pg8::EpiResid E{(const float*)(F.ws + WS_X1), F.out, D, MV + 5 * D};
        pg8::gemm_phase<pg8::EpiResid, pg8::StaticOrder, true, true>(F.lds + RING_OFF, g, S, E, F.wave);

    }
    if constexpr (K == 13) { p13_final(F);
    }
}

struct Args { const float* in[26]; float* out; unsigned char* ws; int ph_lo, ph_hi, li, pad; };
__global__ void __launch_bounds__(NWAVES * 64, 2) mk_fwd(Args args) {
    extern __shared__ __attribute__((aligned(16))) unsigned char lds[];
    Frame F;
    F.lds = (LAS unsigned char*)lds;
    F.MISC = (volatile LAS unsigned*)(F.lds + MISC_OFF);
    F.wave = __builtin_amdgcn_readfirstlane((int)(threadIdx.x >> 6));
    F.G = gridDim.x; { const int bx = blockIdx.x; F.vcu = (F.G % 8 == 0) ? (bx % 8) * (F.G / 8) + bx / 8 : bx; }
    F.ws = args.ws; F.ctl = (gu32*)(args.ws + WS_CTL); F.out = args.out;
#pragma unroll
    for (int i = 0; i < 26; ++i) F.in[i] = args.in[i];
    for (int u = threadIdx.x; u < (LDS_BYTES - LDSCTL_OFF) / 4; u += NWAVES * 64) ((LAS unsigned*)(F.lds + LDSCTL_OFF))[u] = 0u;
    __syncthreads();
    XcdBarrier bar; bar.bar = (unsigned*)(F.ctl + CW_BAR); bar.x = 0; bar.st = nullptr;
    if (N_LAUNCHES == 1) bar = xcd_barrier_post((unsigned*)(F.ctl + CW_BAR), F.MISC + 8);
#define GRID_BAR() do { if (N_LAUNCHES == 1) xcd_barrier(bar, F.wave); } while (0)
    unsigned long long tp0 = 0, tpa = 0, tpb = 0; (void)tp0;
    const int lo = args.ph_lo, hi = args.ph_hi;
#define IN(k) (lo <= (k) && (k) < hi)
#define BOTH(k) (IN(k) && IN((k) + 1))

    if (IN(0)) { if constexpr (0 == TPA || 0 == TPB) tp0 = __builtin_amdgcn_s_memrealtime(); run_phase<0>(F); if constexpr (PH_REPS[0] > 1) { GRID_BAR(); run_phase<0>(F); } if constexpr (PH_REPS[0] > 2) { GRID_BAR(); run_phase<0>(F); } if (BOTH(0)) GRID_BAR(); if constexpr (0 == TPA) tpa = __builtin_amdgcn_s_memrealtime() - tp0; if constexpr (0 == TPB) tpb = __builtin_amdgcn_s_memrealtime() - tp0; }
    if (IN(1)) { if constexpr (1 == TPA || 1 == TPB) tp0 = __builtin_amdgcn_s_memrealtime(); run_phase<1>(F); if constexpr (PH_REPS[1] > 1) { GRID_BAR(); run_phase<1>(F); } if constexpr (PH_REPS[1] > 2) { GRID_BAR(); run_phase<1>(F); } if (BOTH(1)) GRID_BAR(); if constexpr (1 == TPA) tpa = __builtin_amdgcn_s_memrealtime() - tp0; if constexpr (1 == TPB) tpb = __builtin_amdgcn_s_memrealtime() - tp0; }
    if (IN(2)) { if constexpr (2 == TPA || 2 == TPB) tp0 = __builtin_amdgcn_s_memrealtime(); run_phase<2>(F); if constexpr (PH_REPS[2] > 1) { GRID_BAR(); run_phase<2>(F); } if constexpr (PH_REPS[2] > 2) { GRID_BAR(); run_phase<2>(F); } if (BOTH(2)) GRID_BAR(); if constexpr (2 == TPA) tpa = __builtin_amdgcn_s_memrealtime() - tp0; if constexpr (2 == TPB) tpb = __builtin_amdgcn_s_memrealtime() - tp0; }
    if (IN(3)) { if constexpr (3 == TPA || 3 == TPB) tp0 = __builtin_amdgcn_s_memrealtime(); run_phase<3>(F); if constexpr (PH_REPS[3] > 1) { GRID_BAR(); run_phase<3>(F); } if constexpr (PH_REPS[3] > 2) { GRID_BAR(); run_phase<3>(F); } if (BOTH(3)) GRID_BAR(); if constexpr (3 == TPA) tpa = __builtin_amdgcn_s_memrealtime() - tp0; if constexpr (3 == TPB) tpb = __builtin_amdgcn_s_memrealtime() - tp0; }
    if (IN(4)) { if constexpr (4 == TPA || 4 == TPB) tp0 = __builtin_amdgcn_s_memrealtime(); run_phase<4>(F); if constexpr (PH_REPS[4] > 1) { GRID_BAR(); run_phase<4>(F); } if constexpr (PH_REPS[4] > 2) { GRID_BAR(); run_phase<4>(F); } if (BOTH(4)) GRID_BAR(); if constexpr (4 == TPA) tpa = __builtin_amdgcn_s_memrealtime() - tp0; if constexpr (4 == TPB) tpb = __builtin_amdgcn_s_memrealtime() - tp0; }
    if (IN(5)) { if constexpr (5 == TPA || 5 == TPB) tp0 = __builtin_amdgcn_s_memrealtime(); run_phase<5>(F); if constexpr (PH_REPS[5] > 1) { GRID_BAR(); run_phase<5>(F); } if constexpr (PH_REPS[5] > 2) { GRID_BAR(); run_phase<5>(F); } if (BOTH(5)) GRID_BAR(); if constexpr (5 == TPA) tpa = __builtin_amdgcn_s_memrealtime() - tp0; if constexpr (5 == TPB) tpb = __builtin_amdgcn_s_memrealtime() - tp0; }
    if (IN(6)) { if constexpr (6 == TPA || 6 == TPB) tp0 = __builtin_amdgcn_s_memrealtime(); run_phase<6>(F); if constexpr (PH_REPS[6] > 1) { GRID_BAR(); run_phase<6>(F); } if constexpr (PH_REPS[6] > 2) { GRID_BAR(); run_phase<6>(F); } if (BOTH(6)) GRID_BAR(); if constexpr (6 == TPA) tpa = __builtin_amdgcn_s_memrealtime() - tp0; if constexpr (6 == TPB) tpb = __builtin_amdgcn_s_memrealtime() - tp0; }
    if (IN(7)) { if constexpr (7 == TPA || 7 == TPB) tp0 = __builtin_amdgcn_s_memrealtime(); run_phase<7>(F); if constexpr (PH_REPS[7] > 1) { GRID_BAR(); run_phase<7>(F); } if constexpr (PH_REPS[7] > 2) { GRID_BAR(); run_phase<7>(F); } if (BOTH(7)) GRID_BAR(); if constexpr (7 == TPA) tpa = __builtin_amdgcn_s_memrealtime() - tp0; if constexpr (7 == TPB) tpb = __builtin_amdgcn_s_memrealtime() - tp0; }
    if (IN(8)) { if constexpr (8 == TPA || 8 == TPB) tp0 = __builtin_amdgcn_s_memrealtime(); run_phase<8>(F); if constexpr (PH_REPS[8] > 1) { GRID_BAR(); run_phase<8>(F); } if constexpr (PH_REPS[8] > 2) { GRID_BAR(); run_phase<8>(F); } if (BOTH(8)) GRID_BAR(); if constexpr (8 == TPA) tpa = __builtin_amdgcn_s_memrealtime() - tp0; if constexpr (8 == TPB) tpb = __builtin_amdgcn_s_memrealtime() - tp0; }
    if (IN(9)) { if constexpr (9 == TPA || 9 == TPB) tp0 = __builtin_amdgcn_s_memrealtime(); run_phase<9>(F); if constexpr (PH_REPS[9] > 1) { GRID_BAR(); run_phase<9>(F); } if constexpr (PH_REPS[9] > 2) { GRID_BAR(); run_phase<9>(F); } if (BOTH(9)) GRID_BAR(); if constexpr (9 == TPA) tpa = __builtin_amdgcn_s_memrealtime() - tp0; if constexpr (9 == TPB) tpb = __builtin_amdgcn_s_memrealtime() - tp0; }
    if (IN(10)) { if constexpr (10 == TPA || 10 == TPB) tp0 = __builtin_amdgcn_s_memrealtime(); run_phase<10>(F); if constexpr (PH_REPS[10] > 1) { GRID_BAR(); run_phase<10>(F); } if constexpr (PH_REPS[10] > 2) { GRID_BAR(); run_phase<10>(F); } if (BOTH(10)) GRID_BAR(); if constexpr (10 == TPA) tpa = __builtin_amdgcn_s_memrealtime() - tp0; if constexpr (10 == TPB) tpb = __builtin_amdgcn_s_memrealtime() - tp0; }
    if (IN(11)) { if constexpr (11 == TPA || 11 == TPB) tp0 = __builtin_amdgcn_s_memrealtime(); run_phase<11>(F); if constexpr (PH_REPS[11] > 1) { GRID_BAR(); run_phase<11>(F); } if constexpr (PH_REPS[11] > 2) { GRID_BAR(); run_phase<11>(F); } if (BOTH(11)) GRID_BAR(); if constexpr (11 == TPA) tpa = __builtin_amdgcn_s_memrealtime() - tp0; if constexpr (11 == TPB) tpb = __builtin_amdgcn_s_memrealtime() - tp0; }
    if (IN(12)) { if constexpr (12 == TPA || 12 == TPB) tp0 = __builtin_amdgcn_s_memrealtime(); run_phase<12>(F); if constexpr (PH_REPS[12] > 1) { GRID_BAR(); run_phase<12>(F); } if constexpr (PH_REPS[12] > 2) { GRID_BAR(); run_phase<12>(F); } if (BOTH(12)) GRID_BAR(); if constexpr (12 == TPA) tpa = __builtin_amdgcn_s_memrealtime() - tp0; if constexpr (12 == TPB) tpb = __builtin_amdgcn_s_memrealtime() - tp0; }
    if (IN(13)) { if constexpr (13 == TPA || 13 == TPB) tp0 = __builtin_amdgcn_s_memrealtime(); run_phase<13>(F); if constexpr (PH_REPS[13] > 1) { GRID_BAR(); run_phase<13>(F); } if constexpr (PH_REPS[13] > 2) { GRID_BAR(); run_phase<13>(F); } if (BOTH(13)) GRID_BAR(); if constexpr (13 == TPA) tpa = __builtin_amdgcn_s_memrealtime() - tp0; if constexpr (13 == TPB) tpb = __builtin_amdgcn_s_memrealtime() - tp0; }
    if constexpr (TPA >= 0 || TPB >= 0) {
        if (blockIdx.x == 0 && F.wave == 0) { const unsigned long long ua = (tpa + 500ull) / 1000ull, ub = (tpb + 500ull) / 1000ull, extra = ua * 100000ull + ub * 1000ull, t1 = __builtin_amdgcn_s_memrealtime();
            while (__builtin_amdgcn_s_memrealtime() - t1 < extra) __builtin_amdgcn_s_sleep(16); }
    }
#undef IN
#undef BOTH
}

extern "C" void kernel_launch(void* const* d_in, const int* in_sizes, int n_in, void* d_out, int out_size, void* d_ws, size_t ws_size, hipStream_t stream) {
    static int grid = 0;
    if (grid == 0) {
        if (n_in != 26 || out_size != T * D || ws_size < WS_END) { fprintf(stderr, "kernel_launch: unexpected shapes: n_in %d out %d ws %zu (need %zu)\n", n_in, out_size, ws_size, (size_t)WS_END); grid = -1; return; }
        int dev = 0, cus = 0, per_cu = 0;
        if (hipGetDevice(&dev) != hipSuccess || hipDeviceGetAttribute(&cus, hipDeviceAttributeMultiprocessorCount, dev) != hipSuccess) { grid = -1; return; }
        if (hipFuncSetAttribute((const void*)mk_fwd, hipFuncAttributeMaxDynamicSharedMemorySize, LDS_BYTES) != hipSuccess) { fprintf(stderr, "kernel_launch: hipFuncSetAttribute failed\n"); grid = -1; return; }
        if (hipOccupancyMaxActiveBlocksPerMultiprocessor(&per_cu, (const void*)mk_fwd, NWAVES * 64, LDS_BYTES) != hipSuccess || per_cu < 1)
            fprintf(stderr, "kernel_launch: note: occupancy query reports %d workgroups per CU\n", per_cu);
        (void)hipGetLastError();
        grid = cus;
    }
    if (grid < 0) return;
    if (hipMemsetAsync((char*)d_ws + WS_CTL, 0, CTL_ZERO_BYTES, stream) != hipSuccess) return;
    Args a{};
    for (int i = 0; i < 26; ++i) a.in[i] = (const float*)d_in[i];
    a.out = (float*)d_out; a.ws = (unsigned char*)d_ws;
    for (int li = 0; li < N_LAUNCHES; ++li) {
        if (N_LAUNCHES == 1) { a.ph_lo = 0; a.ph_hi = N_PHASES; } else { a.ph_lo = li * N_PHASES / N_LAUNCHES; a.ph_hi = (li + 1) * N_PHASES / N_LAUNCHES; }
        a.li = li;
        hipLaunchKernelGGL(mk_fwd, dim3(grid), dim3(NWAVES * 64), LDS_BYTES, stream, a);
        if (hipPeekAtLastError() != hipSuccess) break;
    }
}
```

```cpp
#include <hip/hip_runtime.h>
#include <cstdio>
#include <cstdint>
namespace pg8 {
#define PG8_LAS __attribute__((address_space(3)))
typedef unsigned short bf16_t;
typedef short bf16x8 __attribute__((ext_vector_type(8)));
typedef float f32x4 __attribute__((ext_vector_type(4)));
typedef unsigned u32x4 __attribute__((ext_vector_type(4)));
constexpr int BM = 256, BK = 64, HALF = 128, HTB = HALF * BK * 2  , STAGE_BYTES = 8 * HTB, NXCD = 8, WGM = 8;

__host__ __device__ __forceinline__ int lds_byte(int r, int c) { const int st = (r >> 4) * 2 + (c >> 5), rr = r & 15, cc = c & 31, ob = rr * 64 + cc * 2; return st * 1024 + (ob ^ (((ob >> 9) & 1) << 5)); }
__host__ __device__ __forceinline__ void stage_rc(int b, int& R, int& C) { const int st = b / 1024, sb = b % 1024, swz = sb ^ (((sb >> 9) & 1) << 5); R = (st >> 1) * 16 + swz / 64; C = (st & 1) * 32 + (swz % 64) / 2; }
__host__ __device__ __forceinline__ int perm32(int rho) { const int n = rho >> 4, i = rho & 15; return 8 * (i >> 2) + 4 * n + (i & 3); }

__device__ __forceinline__ int mk_lane() { int l; asm volatile("v_mbcnt_lo_u32_b32 %0, -1, 0\n\tv_mbcnt_hi_u32_b32 %0, -1, %0" : "=v"(l)); return l; }
struct Unit { int pm, pn; };
struct Gemm { const bf16_t* A; const bf16_t* Bt; int M, N, K; };

struct StaticOrder {
    int nM, nN, nwg, G, c;
    __host__ __device__ void init(int M, int N, int G_, int c_) { nM = M / BM; nN = N / BM; nwg = nM * nN; G = G_; c = c_; }
    __host__ __device__ bool next(int i, Unit& u) const {
        const long L = (long)i * G + c; if (L >= nwg) return false;
        int wgid = (int)L; { const int q = nwg / NXCD, r = nwg % NXCD, xcd = wgid % NXCD, off = wgid / NXCD; wgid = (xcd < r ? xcd * (q + 1) : r * (q + 1) + (xcd - r) * q) + off; }
        const int nig = WGM * nN, gid = wgid / nig, fm = gid * WGM, gsz = (nM - fm) < WGM ? (nM - fm) : WGM;
        u.pm = fm + ((wgid % nig) % gsz); u.pn = (wgid % nig) / gsz; return true;
    }
    __device__ __forceinline__ void a_ready(const Unit&) const {}
    __device__ __forceinline__ void done(const Unit&) const {}
};

__device__ __forceinline__ unsigned cvt_pk_bf16(float lo, float hi) { unsigned r; asm volatile("v_cvt_pk_bf16_f32 %0, %1, %2" : "=v"(r) : "v"(lo), "v"(hi)); return r; }
typedef float f32x2 __attribute__((ext_vector_type(2)));
__device__ __forceinline__ f32x2 gelu_pk(f32x2 v) {
    const f32x2 av = __builtin_elementwise_abs(v), d = av * 0.2316418882f + 1.0f;
    f32x2 t; t.x = __builtin_amdgcn_rcpf(d.x); t.y = __builtin_amdgcn_rcpf(d.y);
    f32x2 q = t * 0.5307027145f + (-0.7265760135f); q = q * t + 0.7107068705f; q = q * t + (-0.142248368f); q = q * t + 0.127414796f; q = q * t;
    const f32x2 s = (v * v) * (-0.72134752044f);
    f32x2 e; e.x = __builtin_amdgcn_exp2f(s.x); e.y = __builtin_amdgcn_exp2f(s.y);
    const f32x2 m = v * (q * e), r = v - m;
    f32x2 o; o.x = v.x < 0.f ? m.x : r.x; o.y = v.y < 0.f ? m.y : r.y; return o;
}

template <int ACT  > struct EpiBf16 {
    static constexpr bool PERM = true, AFTER_DRAIN = false; static_assert(ACT == 0 || ACT == 1, "EpiBf16: ACT is 0 (none) or 1 (gelu_pk)");
    bf16_t* O; int ldc; const float* bias; int split_cols; size_t split_stride; float scale0;
    __device__ __forceinline__ void operator()(const f32x4 (&acc)[2][2][4][2], const Unit& u, int wr, int wc, int fr, int fq) const {
        const int row0 = u.pm * BM + wr * 64 + fr; int colt = u.pn * BM; bf16_t* base = O;
        float sc = 1.f; if (split_cols) { const int t = colt / split_cols; base += (size_t)t * split_stride; colt -= t * split_cols; if (t == 0) sc = scale0; }
        const int col0 = colt + wc * 32 + 8 * fq, bcol0 = u.pn * BM + wc * 32 + 8 * fq;
        f32x4 bv[2][2];
#pragma unroll
        for (int bj = 0; bj < 2; ++bj)
#pragma unroll
            for (int n = 0; n < 2; ++n) bv[bj][n] = bias ? *(const f32x4*)(bias + bcol0 + bj * HALF + 4 * n) : (f32x4){0.f, 0.f, 0.f, 0.f};
#pragma unroll
        for (int ai = 0; ai < 2; ++ai)
#pragma unroll
            for (int m = 0; m < 4; ++m) { bf16_t* rowp = base + (size_t)(row0 + ai * HALF + m * 16) * ldc + col0;
#pragma unroll
                for (int bj = 0; bj < 2; ++bj) { f32x4 v0 = acc[ai][bj][m][0] + bv[bj][0], v1 = acc[ai][bj][m][1] + bv[bj][1];
                    if (ACT == 1) { f32x2 a = gelu_pk((f32x2){v0[0], v0[1]}), b = gelu_pk((f32x2){v0[2], v0[3]}), c = gelu_pk((f32x2){v1[0], v1[1]}), d = gelu_pk((f32x2){v1[2], v1[3]});
                        v0 = (f32x4){a.x, a.y, b.x, b.y}; v1 = (f32x4){c.x, c.y, d.x, d.y}; }
                    v0 = v0 * sc; v1 = v1 * sc; u32x4 w; w.x = cvt_pk_bf16(v0[0], v0[1]); w.y = cvt_pk_bf16(v0[2], v0[3]); w.z = cvt_pk_bf16(v1[0], v1[1]); w.w = cvt_pk_bf16(v1[2], v1[3]);
                    *(u32x4*)(rowp + bj * HALF) = w; } }
    }
};
__device__ __forceinline__ float sigmoidf_(float x) { return __builtin_amdgcn_rcpf(1.0f + __expf(-x)); }
struct EpiResid {
    static constexpr bool PERM = false, AFTER_DRAIN = false;
    const float* base; float* out; int ldc; const float* gvec;
    __device__ __forceinline__ void operator()(const f32x4 (&acc)[2][2][4][2], const Unit& u, int wr, int wc, int fr, int fq) const {
        const int row0 = u.pm * BM + wr * 64 + fr, col0 = u.pn * BM + wc * 32 + 4 * fq;
        f32x4 gv[2][2];
#pragma unroll
        for (int bj = 0; bj < 2; ++bj)
#pragma unroll
            for (int n = 0; n < 2; ++n) gv[bj][n] = *(const __attribute__((address_space(1))) f32x4*)(gvec + col0 + bj * HALF + n * 16);
#pragma unroll
        for (int ai = 0; ai < 2; ++ai)
#pragma unroll
            for (int m = 0; m < 4; ++m) { const size_t off = (size_t)(row0 + ai * HALF + m * 16) * ldc + col0;
#pragma unroll
                for (int bj = 0; bj < 2; ++bj)
#pragma unroll
                    for (int n = 0; n < 2; ++n) { const f32x4 bs = *(const __attribute__((address_space(1))) f32x4*)(base + off + bj * HALF + n * 16);
                        *(__attribute__((address_space(1))) f32x4*)(out + off + bj * HALF + n * 16) = bs + gv[bj][n] * acc[ai][bj][m][n]; }
                if (m & 1) asm volatile("" ::: "memory"); }
    }
};
struct EpiSwiglu {
    static constexpr bool PERM = true, AFTER_DRAIN = false;
    bf16_t* O; int ldc;
    __device__ __forceinline__ void operator()(const f32x4 (&acc)[2][2][4][2], const Unit& u, int wr, int wc, int fr, int fq) const {
        const int row0 = u.pm * BM + wr * 64 + fr, col0 = u.pn * HALF + wc * 32 + 8 * fq;
#pragma unroll
        for (int ai = 0; ai < 2; ++ai)
#pragma unroll
            for (int m = 0; m < 4; ++m) { bf16_t* rowp = O + (size_t)(row0 + ai * HALF + m * 16) * ldc + col0;
                f32x4 h0, h1;
#pragma unroll
                for (int j = 0; j < 4; ++j) { const float g0 = acc[ai][0][m][0][j], g1 = acc[ai][0][m][1][j];
                    h0[j] = g0 * sigmoidf_(g0) * acc[ai][1][m][0][j]; h1[j] = g1 * sigmoidf_(g1) * acc[ai][1][m][1][j]; }
                u32x4 w; w.x = cvt_pk_bf16(h0[0], h0[1]); w.y = cvt_pk_bf16(h0[2], h0[3]); w.z = cvt_pk_bf16(h1[0], h1[1]); w.w = cvt_pk_bf16(h1[2], h1[3]);
                *(__attribute__((address_space(1))) u32x4*)rowp = w; }
    }
};
template <int CTRL> __device__ __forceinline__ float dpp_f(float old, float src) { return __builtin_bit_cast(float, __builtin_amdgcn_update_dpp(__builtin_bit_cast(int, old), __builtin_bit_cast(int, src), CTRL, 0xf, 0xf, false)); }
struct EpiLora {
    static constexpr bool PERM = true, AFTER_DRAIN = false;
    float* PK; float* GE; bf16_t* KD; const float* kbuf; const float* kkbuf; const float* rbuf; const float* w0; const float* a0; const float* k_a; int TT;
    __device__ __forceinline__ void operator()(const f32x4 (&acc)[2][2][4][2], const Unit& u, int wr, int wc, int fr, int fq) const {
        typedef __attribute__((address_space(1))) f32x4 gf4; typedef const __attribute__((address_space(1))) f32x4 cgf4;
        const int d = u.pn >> 4, cg = u.pn & 15;
        const int c8 = cg * HALF + wc * 32 + 8 * fq, h = c8 >> 6, ch = c8 & 63;
        const int row0 = u.pm * BM + wr * 64 + fr;
        f32x4 w0v[2], a0v[2], kav[2];
#pragma unroll
        for (int n = 0; n < 2; ++n) { w0v[n] = *(cgf4*)(w0 + d * 2048 + c8 + 4 * n); a0v[n] = *(cgf4*)(a0 + d * 2048 + c8 + 4 * n); kav[n] = *(cgf4*)(k_a + c8 + 4 * n); }
        f32x4 kq[2][2], kkq[2][2], rq[2][2];
        { const size_t fo0 = (size_t)row0 * 2048 + c8;
#pragma unroll
          for (int n = 0; n < 2; ++n) { kq[0][n] = *(cgf4*)(kbuf + fo0 + 4 * n); kkq[0][n] = *(cgf4*)(kkbuf + fo0 + 4 * n); rq[0][n] = *(cgf4*)(rbuf + fo0 + 4 * n); } }
#pragma unroll
        for (int it = 0; it < 8; ++it) {
            const int ai = it >> 2, m = it & 3;
            if (it + 1 < 8) { const size_t fo1 = (size_t)(row0 + ((it + 1) >> 2) * HALF + ((it + 1) & 3) * 16) * 2048 + c8;
#pragma unroll
                for (int n = 0; n < 2; ++n) { kq[(it + 1) & 1][n] = *(cgf4*)(kbuf + fo1 + 4 * n); kkq[(it + 1) & 1][n] = *(cgf4*)(kkbuf + fo1 + 4 * n); rq[(it + 1) & 1][n] = *(cgf4*)(rbuf + fo1 + 4 * n); } }
            asm volatile("" ::: "memory");
            const int tok = row0 + ai * HALF + m * 16;
            float* pk = PK + ((size_t)(d * 32 + h) * TT + tok) * 256;
            const size_t fo = (size_t)tok * 2048 + c8;
            f32x4 g[2]; u32x4 kw;
#pragma unroll
            for (int n = 0; n < 2; ++n) {
                f32x4 gp;
                const f32x4 x = acc[ai][0][m][n] + w0v[n];
#pragma unroll
                for (int j = 0; j < 4; ++j) { float w = __expf(-0.60653066f * sigmoidf_(x[j]));
                    if (d == 0) { w *= dpp_f<0x111>(1.0f, w); w *= dpp_f<0x112>(1.0f, w); w *= dpp_f<0x114>(1.0f, w); w *= dpp_f<0x118>(1.0f, w); g[n][j] = w; gp[j] = dpp_f<0x111>(1.0f, w); }
                    else        { w *= dpp_f<0x101>(1.0f, w); w *= dpp_f<0x102>(1.0f, w); w *= dpp_f<0x104>(1.0f, w); w *= dpp_f<0x108>(1.0f, w); g[n][j] = w; gp[j] = dpp_f<0x101>(1.0f, w); } }
                const f32x4 xa = acc[ai][1][m][n] + a0v[n];
                const f32x4 k4 = kq[it & 1][n], kk4 = kkq[it & 1][n], r4 = rq[it & 1][n];
                f32x4 at, rt, bt, kdt; float kdv[4];
#pragma unroll
                for (int j = 0; j < 4; ++j) { const float a = sigmoidf_(xa[j]), rg = __builtin_amdgcn_rcpf(g[n][j]);
                    kdv[j] = k4[j] * (1.0f + (a - 1.0f) * kav[n][j]);
                    at[j] = -kk4[j] * gp[j]; rt[j] = r4[j] * g[n][j]; bt[j] = kk4[j] * a * rg; kdt[j] = kdv[j] * rg; }
                const int chn = ch + 4 * n;
                *(gf4*)(pk + chn) = at; *(gf4*)(pk + 64 + chn) = rt;
                *(gf4*)(pk + 128 + (chn >> 5) * 64 + (chn & 31)) = bt; *(gf4*)(pk + 160 + (chn >> 5) * 64 + (chn & 31)) = kdt;
                if (n == 0) { kw.x = cvt_pk_bf16(kdv[0], kdv[1]); kw.y = cvt_pk_bf16(kdv[2], kdv[3]); } else { kw.z = cvt_pk_bf16(kdv[0], kdv[1]); kw.w = cvt_pk_bf16(kdv[2], kdv[3]); }
            }
            *(__attribute__((address_space(1))) u32x4*)(KD + (size_t)d * TT * 2048 + fo) = kw;
            if (fr == (d == 0 ? 15 : 0)) { float* ge = GE + ((size_t)(d * 32 + h) * (TT / 16) + (tok >> 4)) * 64 + ch; *(gf4*)ge = g[0]; *(gf4*)(ge + 4) = g[1]; }
        }
    }
};
template <class Epi, class Sched, bool ALIGN_EPI = false, bool SP2 = false>
__device__ __forceinline__ void gemm_phase(PG8_LAS unsigned char* lds, const Gemm g, const Sched& S, const Epi& E, const int wid) {
    const int lane = mk_lane(), tid = wid * 64 + lane, wr = wid >> 2, wc = wid & 3, fr = lane & 15, fq = lane >> 4;
    const int K = g.K, nt = K / BK;
    unsigned voffA[2], voffB[2];
#pragma unroll
    for (int i = 0; i < 2; ++i) { int R, C; stage_rc(tid * 16 + i * 8192, R, C); const int Rb = Epi::PERM ? ((R & ~31) + perm32(R & 31)) : R;
        voffA[i] = (unsigned)(R * K + C) * 2u; voffB[i] = (unsigned)(Rb * K + C) * 2u; }
    const size_t kstep = (size_t)(BK * 2);
    const size_t hstep = (size_t)HALF * K * 2;
    const size_t tstep = 2 * hstep;
    const unsigned ldsw = (unsigned)wid * 1024u;
    const int aoff = lds_byte(wr * 64 + fr, fq * 8), boff = lds_byte(wc * 32 + fr, fq * 8);
#define PG8_SA(b, h) (((b) * 2 + (h)) * HTB)
#define PG8_SB(b, h) ((4 + (b) * 2 + (h)) * HTB)
#define PG8_STAGE(bufoff, gbase, voff) do { _Pragma("unroll") for (int _i = 0; _i < 2; ++_i) \
        __builtin_amdgcn_global_load_lds((const unsigned*)((const char*)(gbase) + (voff)[_i]), (PG8_LAS unsigned*)(lds + (bufoff) + ldsw + _i * 8192), 16, 0, 0); } while (0)
#define PG8_LDA(dst, b, h) do { _Pragma("unroll") for (int m = 0; m < 4; ++m) _Pragma("unroll") for (int k = 0; k < 2; ++k) dst[m][k] = *(const PG8_LAS bf16x8*)(lds + PG8_SA(b, h) + aoff + m * 2048 + k * 1024); } while (0)
#define PG8_LDB(dst, b, h) do { _Pragma("unroll") for (int n = 0; n < 2; ++n) _Pragma("unroll") for (int k = 0; k < 2; ++k) dst[n][k] = *(const PG8_LAS bf16x8*)(lds + PG8_SB(b, h) + boff + n * 2048 + k * 1024); } while (0)
#define PG8_MMA(ai, bj, At, Bt) do { __builtin_amdgcn_s_setprio(1); _Pragma("unroll") for (int m = 0; m < 4; ++m) _Pragma("unroll") for (int n = 0; n < 2; ++n) _Pragma("unroll") for (int k = 0; k < 2; ++k) \
        acc[ai][bj][m][n] = __builtin_amdgcn_mfma_f32_16x16x32_bf16(Bt[n][k], At[m][k], acc[ai][bj][m][n], 0, 0, 0); __builtin_amdgcn_s_setprio(0); } while (0)
#define PG8_WAIT_V(n) asm volatile("s_waitcnt vmcnt(" #n ")" ::: "memory")
#define PG8_WAIT_L(n) asm volatile("s_waitcnt lgkmcnt(" #n ")" ::: "memory")
#define PG8_BAR __builtin_amdgcn_s_barrier()
#define PG8_SCHED __builtin_amdgcn_sched_barrier(0)
    Unit cur, nxt; int ui = 0;
    if (!S.next(0, cur)) return;
    f32x4 acc[2][2][4][2];
#pragma unroll
    for (int a = 0; a < 2; ++a)
#pragma unroll
        for (int b = 0; b < 2; ++b)
#pragma unroll
            for (int m = 0; m < 4; ++m)
#pragma unroll
                for (int n = 0; n < 2; ++n) acc[a][b][m][n] = (f32x4){0.f, 0.f, 0.f, 0.f};
    bf16x8 At[4][2], B0[2][2], B1[2][2];
    const char* cA = (const char*)g.A + (size_t)cur.pm * tstep; const char* cB = (const char*)g.Bt + (size_t)cur.pn * tstep;
    S.a_ready(cur);
    if constexpr (SP2) {
        PG8_STAGE(PG8_SB(0, 0), cB, voffB); PG8_STAGE(PG8_SB(0, 1), cB + hstep, voffB); PG8_STAGE(PG8_SA(0, 0), cA, voffA); PG8_STAGE(PG8_SA(0, 1), cA + hstep, voffA);
        if (wr == 1) PG8_BAR;
        PG8_WAIT_V(2); PG8_BAR;
        PG8_STAGE(PG8_SB(1, 0), cB + kstep, voffB); PG8_STAGE(PG8_SA(1, 0), cA + kstep, voffA); PG8_STAGE(PG8_SB(1, 1), cB + hstep + kstep, voffB);
        PG8_WAIT_V(6); PG8_BAR;
    } else {
        PG8_STAGE(PG8_SB(0, 0), cB, voffB); PG8_STAGE(PG8_SA(0, 0), cA, voffA); PG8_STAGE(PG8_SB(0, 1), cB + hstep, voffB); PG8_STAGE(PG8_SA(0, 1), cA + hstep, voffA);
        if (wr == 1) PG8_BAR;
        PG8_WAIT_V(4); PG8_BAR;
        PG8_STAGE(PG8_SB(1, 0), cB + kstep, voffB); PG8_STAGE(PG8_SA(1, 0), cA + kstep, voffA); PG8_STAGE(PG8_SB(1, 1), cB + hstep + kstep, voffB);
        PG8_WAIT_V(6); PG8_BAR;
    }
    for (;;) {
        const bool has_next = S.next(ui + 1, nxt);
        const char* nA = has_next ? (const char*)g.A + (size_t)nxt.pm * tstep : cA; const char* nB = has_next ? (const char*)g.Bt + (size_t)nxt.pn * tstep : cB;
        for (int t = 0; t < nt; t += 2) {
            const bool last = (t == nt - 2);
            const char* a1 = cA + (size_t)(t + 1) * kstep;
            const char* a2 = last ? nA : cA + (size_t)(t + 2) * kstep; const char* b2 = last ? nB : cB + (size_t)(t + 2) * kstep;
            const char* a3 = a2 + kstep; const char* b3 = b2 + kstep;
            if (last && has_next) S.a_ready(nxt);
            if constexpr (SP2) {
            PG8_LDB(B0, 0, 0); PG8_LDB(B1, 0, 1); PG8_SCHED; PG8_LDA(At, 0, 0); PG8_STAGE(PG8_SA(1, 1), a1 + hstep, voffA);
            PG8_WAIT_V(8); PG8_WAIT_L(0); PG8_BAR; PG8_MMA(0, 0, At, B0); PG8_MMA(0, 1, At, B1); PG8_BAR; PG8_SCHED;
            PG8_LDA(At, 0, 1); PG8_STAGE(PG8_SB(0, 0), b2, voffB); PG8_STAGE(PG8_SB(0, 1), b2 + hstep, voffB); PG8_STAGE(PG8_SA(0, 0), a2, voffA);
            PG8_WAIT_V(8); PG8_WAIT_L(0); PG8_BAR; PG8_MMA(1, 0, At, B0); PG8_MMA(1, 1, At, B1); PG8_BAR; PG8_SCHED;
            PG8_LDB(B0, 1, 0); PG8_LDB(B1, 1, 1); PG8_SCHED; PG8_LDA(At, 1, 0); PG8_STAGE(PG8_SA(0, 1), a2 + hstep, voffA);
            PG8_WAIT_V(8); PG8_WAIT_L(0); PG8_BAR; PG8_MMA(0, 0, At, B0); PG8_MMA(0, 1, At, B1); PG8_BAR; PG8_SCHED;
            PG8_LDA(At, 1, 1); PG8_STAGE(PG8_SB(1, 0), b3, voffB); PG8_STAGE(PG8_SB(1, 1), b3 + hstep, voffB); PG8_STAGE(PG8_SA(1, 0), a3, voffA);
            PG8_WAIT_V(8); PG8_WAIT_L(0); PG8_BAR; PG8_MMA(1, 0, At, B0); PG8_MMA(1, 1, At, B1); PG8_BAR; PG8_SCHED;
            } else {
            PG8_LDB(B0, 0, 0); PG8_SCHED; PG8_LDA(At, 0, 0); PG8_STAGE(PG8_SA(1, 1), a1 + hstep, voffA);
            PG8_WAIT_L(8); PG8_BAR; PG8_WAIT_L(0); PG8_MMA(0, 0, At, B0); PG8_BAR; PG8_SCHED;
            PG8_LDB(B1, 0, 1); PG8_STAGE(PG8_SB(0, 0), b2, voffB);
            PG8_BAR; PG8_WAIT_L(0); PG8_MMA(0, 1, At, B1); PG8_BAR;
            PG8_LDA(At, 0, 1); PG8_STAGE(PG8_SA(0, 0), a2, voffA);
            PG8_BAR; PG8_WAIT_L(0); PG8_MMA(1, 0, At, B0); PG8_BAR; PG8_SCHED;
            PG8_STAGE(PG8_SB(0, 1), b2 + hstep, voffB);
            PG8_WAIT_V(6); PG8_BAR; PG8_MMA(1, 1, At, B1); PG8_BAR;
            PG8_LDB(B0, 1, 0); PG8_SCHED; PG8_LDA(At, 1, 0); PG8_STAGE(PG8_SA(0, 1), a2 + hstep, voffA);
            PG8_WAIT_L(8); PG8_BAR; PG8_WAIT_L(0); PG8_MMA(0, 0, At, B0); PG8_BAR; PG8_SCHED;
            PG8_LDB(B1, 1, 1); PG8_STAGE(PG8_SB(1, 0), b3, voffB);
            PG8_BAR; PG8_WAIT_L(0); PG8_MMA(0, 1, At, B1); PG8_BAR;
            PG8_LDA(At, 1, 1); PG8_STAGE(PG8_SA(1, 0), a3, voffA);
            PG8_BAR; PG8_WAIT_L(0); PG8_MMA(1, 0, At, B0); PG8_BAR; PG8_SCHED;
            PG8_STAGE(PG8_SB(1, 1), b3 + hstep, voffB);
            PG8_WAIT_V(6); PG8_BAR; PG8_MMA(1, 1, At, B1); PG8_BAR;
            }
        }
        if constexpr (ALIGN_EPI) { if (wr == 0) PG8_BAR; }
        if constexpr (!Epi::AFTER_DRAIN) { const int l2 = mk_lane(); E(acc, cur, wr, wc, l2 & 15, l2 >> 4); S.done(cur); }
        if (!has_next) break;
#pragma unroll
        for (int a = 0; a < 2; ++a)
#pragma unroll
            for (int b = 0; b < 2; ++b)
#pragma unroll
                for (int m = 0; m < 4; ++m)
#pragma unroll
                    for (int n = 0; n < 2; ++n) acc[a][b][m][n] = (f32x4){0.f, 0.f, 0.f, 0.f};
        cur = nxt; cA = nA; cB = nB; ++ui;
        if constexpr (ALIGN_EPI) { if (wr == 1) PG8_BAR; }
    }
    PG8_WAIT_V(0);
    if constexpr (!ALIGN_EPI) { if (wr == 0) PG8_BAR; }
    PG8_BAR;
    if constexpr (Epi::AFTER_DRAIN) { E.fused(acc, cur, wr, wc, fr, fq, lds, wid, lane); S.done(cur); }
#undef PG8_SA
#undef PG8_SB
#undef PG8_STAGE
#undef PG8_LDA
#undef PG8_LDB
#undef PG8_MMA
#undef PG8_WAIT_V
#undef PG8_WAIT_L
#undef PG8_BAR
#undef PG8_SCHED
}
}

constexpr int NWAVES = 8;
#ifndef MK_N_LAUNCHES
#define MK_N_LAUNCHES 1
#endif
constexpr int N_PHASES = 14;
#ifndef MK_REPS
#define MK_REPS {1,1,1,1,1,1,1,1,1,1,1,1,1,1}
#endif
constexpr int PH_REPS[14] = MK_REPS;
#ifndef MK_TPA
#define MK_TPA -1
#endif
#ifndef MK_TPB
#define MK_TPB -1
#endif
constexpr int TPA = MK_TPA, TPB = MK_TPB;
constexpr int N_LAUNCHES = MK_N_LAUNCHES;

constexpr int D = 4096, T = 8192, CTXL = 256, TT = T + CTXL;
constexpr int DR = 2048, DC = 2048, NH = 32, HS = 64;
constexpr int OFF_K = 0, OFF_V = 2048, OFF_WL = 4096, OFF_AL = 4192, OFF_R = 4288, OFF_GL = 6336, RWKV_COLS = 6592;
constexpr int OFF_CB = 6592, OFF_CC = 8640, OFF_CX = 10688, IN_COLS = 12736, NZ = 12800;
constexpr int NCTXZ = 4352;
constexpr int DFF = 11008, NGU = 2 * DFF;
constexpr int NLORA = 8192, KLORA = 256, KGATE = 256;
constexpr int MODN = 6 * D;
constexpr int NKC = 16;
constexpr float NORM_EPS = 1e-6f, LNX_EPS = 64e-5f;
constexpr int CHUNK = 256, NCHUNK = 33;

constexpr size_t MiB = 1u << 20;
constexpr size_t WS_CTL = 0, CTL_ZERO_BYTES = 1 * MiB;
constexpr size_t WS_MODP = 1 * MiB;
constexpr size_t WS_MODV = 5 * MiB;
constexpr size_t WS_WLORA = 6 * MiB;
constexpr size_t WS_WGATE = 10 * MiB;
constexpr size_t WS_ALORA = 11 * MiB;
constexpr size_t WS_AGATE = 16 * MiB;
constexpr size_t WS_WOUT = 20 * MiB;
constexpr size_t WS_WGU = 52 * MiB;
constexpr size_t WS_WDN = 224 * MiB;
constexpr size_t WS_WIN = 310 * MiB;
constexpr size_t WS_PU = 310 * MiB;
constexpr size_t WS_SST = 374 * MiB;
constexpr size_t WS_A1 = 410 * MiB;
constexpr size_t WS_CAT = 410 * MiB;
constexpr size_t WS_Z = 476 * MiB;
constexpr size_t WS_YS = 476 * MiB;
constexpr size_t WS_KD = 604 * MiB;
constexpr size_t WS_GE = 670 * MiB;
constexpr size_t WS_KBUF = 683 * MiB;
constexpr size_t WS_KKBUF = 749 * MiB;
constexpr size_t WS_RBUF = 815 * MiB;
constexpr size_t WS_VBUF = 881 * MiB;
constexpr size_t WS_X1 = 683 * MiB;
constexpr size_t WS_PK = 947 * MiB;
constexpr size_t WS_ACT = 947 * MiB;
constexpr size_t WS_G = 1475 * MiB;
constexpr size_t WS_END = 1507 * MiB;
static_assert(WS_MODP + (size_t)NKC * 2 * MODN * 4 <= WS_MODV && WS_ALORA + (size_t)TT * 256 * 2 <= WS_AGATE && WS_WGU + (size_t)NGU * D * 2 <= WS_WDN && WS_WDN + (size_t)D * DFF * 2 <= WS_WIN, "ws map 1");
static_assert(WS_WIN + (size_t)NZ * D * 2 <= WS_A1 && WS_SST + (size_t)64 * NCHUNK * 16384 <= WS_A1 && WS_A1 + (size_t)TT * D * 2 <= WS_Z && WS_Z + (size_t)TT * NZ * 2 <= WS_KBUF, "ws map 2");
static_assert(WS_YS + (size_t)2 * T * 2048 * 4 <= WS_KD && WS_KD + (size_t)2 * TT * 2048 * 2 <= WS_GE && WS_GE + (size_t)64 * (TT / 16) * 256 <= WS_KBUF, "ws map 3");
static_assert(WS_KBUF + (size_t)TT * 2048 * 4 <= WS_KKBUF && WS_KKBUF + (size_t)TT * 2048 * 4 <= WS_RBUF && WS_RBUF + (size_t)TT * 2048 * 4 <= WS_VBUF && WS_VBUF + (size_t)TT * 2048 * 4 <= WS_PK, "ws map 4");
static_assert(WS_X1 + (size_t)T * D * 4 <= WS_RBUF && WS_PK + (size_t)64 * TT * 1024 <= WS_G && WS_ACT + (size_t)T * DFF * 2 <= WS_G && WS_G + (size_t)T * 2048 * 2 <= WS_END && WS_CAT + (size_t)T * D * 2 <= WS_Z, "ws map 5");
constexpr int CW_TMO = 0;
constexpr int CW_BAR = 4096;

constexpr int RING_OFF = 0, RING_BYTES = 131072;
constexpr int LDSCTL_OFF = RING_BYTES, MISC_OFF = LDSCTL_OFF + 320;
constexpr int LDS_BYTES = 147456;
static_assert(MISC_OFF + 128 <= LDS_BYTES, "LDS map");

#define GAS __attribute__((address_space(1)))
#define LAS __attribute__((address_space(3)))
typedef unsigned short bf16;
typedef unsigned v4u __attribute__((ext_vector_type(4)));
typedef unsigned v2u __attribute__((ext_vector_type(2)));
typedef float f32x4 __attribute__((ext_vector_type(4)));
typedef GAS unsigned gu32;
#define RLX_AGENT __ATOMIC_RELAXED, __HIP_MEMORY_SCOPE_AGENT
#define LDS_WAIT() asm volatile("s_waitcnt lgkmcnt(0)" ::: "memory")
#define VM_WAIT() asm volatile("s_waitcnt vmcnt(0)" ::: "memory")
__device__ __forceinline__ unsigned f2bf(float f) { unsigned u = __builtin_bit_cast(unsigned, f); return (u + 0x7fffu + ((u >> 16) & 1u)) >> 16; }
__device__ __forceinline__ unsigned pk2(float lo, float hi) { return f2bf(lo) | (f2bf(hi) << 16); }
__device__ __forceinline__ float bflo(unsigned w) { return __builtin_bit_cast(float, w << 16); }
__device__ __forceinline__ float bfhi(unsigned w) { return __builtin_bit_cast(float, w & 0xffff0000u); }
__device__ __forceinline__ float sigm(float x) { return 1.0f / (1.0f + __expf(-x)); }

#define XB_TMO      128
#define XB_XCNT(j)  (256  + 64 * (j))
#define XB_XSUB(j)  (1280 + 64 * (j))
#define XB_XGEN(j)  (2304 + 64 * (j))
#define XB_TOP      3328
#define XB_TOPGEN   3392
#define XCD_BAR_WORDS 3456
#define XB_SPIN_CAP (1u << 18)
__device__ __forceinline__ unsigned xb_ld(unsigned* p)              { return __hip_atomic_load(p, __ATOMIC_RELAXED, __HIP_MEMORY_SCOPE_AGENT); }
__device__ __forceinline__ unsigned xb_add(unsigned* p, unsigned v) { return __hip_atomic_fetch_add(p, v, __ATOMIC_RELAXED, __HIP_MEMORY_SCOPE_AGENT); }
__device__ __forceinline__ unsigned xb_xcc_id() { return (unsigned)__builtin_amdgcn_s_getreg((3 << 11) | 20) & 0xFu; }
#define XB_SPIN(cond, bar) do { unsigned _sp = 0; while (cond) { __builtin_amdgcn_s_sleep(1); \
    if ((++_sp & 255u) == 0u) { if (xb_ld(&(bar)[XB_TMO])) break; if (_sp > XB_SPIN_CAP) { atomicAdd(&(bar)[XB_TMO], 1u); break; } } } } while (0)
struct XcdBarrier { unsigned* bar; unsigned x; volatile LAS unsigned* st; };
__device__ __forceinline__ XcdBarrier xcd_barrier_post(unsigned* bar, volatile LAS unsigned* st) {
    XcdBarrier b; b.bar = bar; b.x = xb_xcc_id(); b.st = st;
    if (threadIdx.x == 0) (void)xb_add(&bar[XB_XCNT(b.x)], 1u);
    return b;
}
__device__ __forceinline__ void xcd_barrier_complete(unsigned* bar, unsigned x, unsigned& nloc, unsigned& nx) {
    const unsigned G = gridDim.x * gridDim.y * gridDim.z;
    unsigned sum, cnt, mine, sp = 0u;
    for (;;) {
        sum = 0u; cnt = 0u; mine = 0u;
#pragma unroll
        for (unsigned j = 0; j < 16; ++j) { const unsigned c = xb_ld(&bar[XB_XCNT(j)]); sum += c; cnt += (c > 0u) ? 1u : 0u; mine = (j == x) ? c : mine; }
        if (sum == G) break;
        __builtin_amdgcn_s_sleep(1);
        if ((++sp & 255u) == 0u) { if (xb_ld(&bar[XB_TMO])) break; if (sp > XB_SPIN_CAP) { atomicAdd(&bar[XB_TMO], 1u); break; } }
    }
    nloc = mine > 0u ? mine : 1u; nx = cnt > 0u ? cnt : 1u;
}
__device__ __forceinline__ void xcd_barrier(const XcdBarrier& b, const int wave) {
    asm volatile("s_waitcnt vmcnt(0)" ::: "memory");
    __syncthreads();
    if (wave == 0 && pg8::mk_lane() == 0) {
        unsigned* bar = b.bar;
        __builtin_amdgcn_s_waitcnt(0);
        unsigned nloc = b.st[0], nx = b.st[1];
        if (nloc == 0u) { xcd_barrier_complete(bar, b.x, nloc, nx); b.st[0] = nloc; b.st[1] = nx; }
        const unsigned old = xb_add(&bar[XB_XSUB(b.x)], 1u);
        const unsigned gen = old / nloc;
        if (old + 1u == (gen + 1u) * nloc) {
            __builtin_amdgcn_fence(__ATOMIC_RELEASE, "agent");
            asm volatile("s_waitcnt vmcnt(0)" ::: "memory");
            const unsigned og = xb_add(&bar[XB_TOP], 1u);
            const unsigned tg = og / nx;
            if (og + 1u == (tg + 1u) * nx) xb_add(&bar[XB_TOPGEN], 1u);
            else XB_SPIN(xb_ld(&bar[XB_TOPGEN]) == tg, bar);
            __builtin_amdgcn_fence(__ATOMIC_ACQUIRE, "agent");
            xb_add(&bar[XB_XGEN(b.x)], 1u);
            asm volatile("s_waitcnt vmcnt(0)" ::: "memory");
        } else {
            XB_SPIN(xb_ld(&bar[XB_XGEN(b.x)]) == gen, bar);
            __builtin_amdgcn_fence(__ATOMIC_ACQUIRE, "agent");
            asm volatile("s_waitcnt vmcnt(0)" ::: "memory");
        }
    }
    __syncthreads();
}

struct Frame {
    LAS unsigned char* lds;
    volatile LAS unsigned* MISC;
    gu32* ctl;
    int wave;
    int vcu, G;
    unsigned char* ws;
    const float* in[26];
    float* out;
};
enum { I_X = 0, I_C, I_CTX, I_CCTX, I_WADA, I_BADA, I_NORM1, I_WIN, I_MU, I_KK, I_KA, I_RK, I_W0, I_WDU, I_A0, I_WIU, I_WGU, I_LNXW, I_LNXB, I_CONVW, I_WOUT, I_NORM2, I_WFG, I_WFU, I_WFD, I_NORMF };

__device__ __forceinline__ float wave_sum(float v) {
#pragma unroll
    for (int o = 1; o < 64; o <<= 1) v += __shfl_xor(v, o);
    return v;
}

__device__ __forceinline__ void p0_transpose_item(const float* W, int K, int N, bf16* WT, int ldk, int row_off, LAS float* scr, int item, int lane) {
    const int nblk = N / 32, kb = item / nblk, nb = item % nblk, k0 = 64 * kb, n0 = 32 * nb;
    float tv[32];
#pragma unroll
    for (int i = 0; i < 32; ++i) tv[i] = *(const GAS float*)(W + (size_t)(k0 + 2 * i + (lane >> 5)) * N + n0 + (lane & 31));
#pragma unroll
    for (int i = 0; i < 32; ++i) scr[(2 * i + (lane >> 5)) * 33 + (lane & 31)] = tv[i];
    LDS_WAIT(); asm volatile("" ::: "memory");
    const int c = lane & 7;
#pragma unroll
    for (int j = 0; j < 4; ++j) { const int n = (lane >> 3) + 8 * j; const LAS float* s = scr + (8 * c) * 33 + n;
        v4u o; o.x = pk2(s[0 * 33], s[1 * 33]); o.y = pk2(s[2 * 33], s[3 * 33]); o.z = pk2(s[4 * 33], s[5 * 33]); o.w = pk2(s[6 * 33], s[7 * 33]);
        *(GAS v4u*)(WT + (size_t)(row_off + n0 + n) * ldk + k0 + 8 * c) = o; }
    LDS_WAIT(); asm volatile("" ::: "memory");
}
constexpr int TI_IN = (D / 64) * (IN_COLS / 32), TI_OUT = (D / 64) * (D / 32), TI_G = (D / 64) * (DFF / 32), TI_DN = (DFF / 64) * (D / 32);
constexpr int TI_TOTAL = TI_IN + TI_OUT + 2 * TI_G + TI_DN;
constexpr int GEMV_UNITS = NKC * (MODN / 256);
constexpr int IB_OUT = TI_IN, IB_G = IB_OUT + TI_OUT, IB_U = IB_G + TI_G, IB_D = IB_U + TI_G;
constexpr int P2T_B = IB_OUT, P2T_E = IB_G + 13200;
constexpr int P6T_B = P2T_E, P6T_E = IB_U + 11000;
constexpr int P0X_B = P6T_E, P0X_E = IB_D + 12000;
constexpr int P11T_B = P0X_E, P11T_E = TI_TOTAL;
constexpr int P0_ITEMS = TI_IN + (P0X_E - P0X_B);
constexpr int TI_PER_GEMV_WAVE = 18, TI_PER_OTHER_WAVE = 42;
static_assert(GEMV_UNITS <= 2048 && GEMV_UNITS * TI_PER_GEMV_WAVE + (2048 - GEMV_UNITS) * TI_PER_OTHER_WAVE >= P0_ITEMS, "P0 item split");

__device__ __forceinline__ void tr_item(Frame& F, int it, LAS float* scr, int lane) {
    int r = it;
    if (r < TI_IN) { p0_transpose_item(F.in[I_WIN], D, IN_COLS, (bf16*)(F.ws + WS_WIN), D, 0, scr, r, lane); return; } r -= TI_IN;
    if (r < TI_OUT) { p0_transpose_item(F.in[I_WOUT], D, D, (bf16*)(F.ws + WS_WOUT), D, 0, scr, r, lane); return; } r -= TI_OUT;
    if (r < TI_G) { const int n0 = 32 * (r % (DFF / 32)); p0_transpose_item(F.in[I_WFG], D, DFF, (bf16*)(F.ws + WS_WGU), D, 256 * (n0 >> 7) + (n0 & 127) - n0, scr, r, lane); return; } r -= TI_G;
    if (r < TI_G) { const int n0 = 32 * (r % (DFF / 32)); p0_transpose_item(F.in[I_WFU], D, DFF, (bf16*)(F.ws + WS_WGU), D, 256 * (n0 >> 7) + 128 + (n0 & 127) - n0, scr, r, lane); return; } r -= TI_G;
    p0_transpose_item(F.in[I_WFD], DFF, D, (bf16*)(F.ws + WS_WDN), DFF, 0, scr, r, lane);
}
__device__ __forceinline__ void tr_range(Frame& F, int b, int e, int rank, int nw, LAS float* scr, int lane) {
    const int per = (e - b + nw - 1) / nw; int i0 = b + rank * per, i1 = i0 + per; if (i1 > e) i1 = e;
    for (int it = i0; it < i1; ++it) tr_item(F, it, scr, lane);
}
__device__ __forceinline__ void tr_idle(Frame& F, int b, int e, int rank_blk, int nblk) {
    if (F.G != 256 || rank_blk < 0) return;
    tr_range(F, b, e, rank_blk * NWAVES + F.wave, nblk * NWAVES, (LAS float*)(F.lds + RING_OFF + F.wave * 16384), pg8::mk_lane());
}
__device__ __forceinline__ void p0_gemv_unit(Frame& F, int unit, int lane) {
    const int kc = unit / (MODN / 256), cc = unit % (MODN / 256);
    const int k0 = kc * 256, col = cc * 256 + lane * 4;
    int sv[4], sc[4];
#pragma unroll
    for (int q = 0; q < 4; ++q) { const float c = *(const GAS float*)(F.in[I_C] + k0 + q * 64 + lane), cx = *(const GAS float*)(F.in[I_CCTX] + k0 + q * 64 + lane);
        sv[q] = __builtin_bit_cast(int, c * sigm(c)); sc[q] = __builtin_bit_cast(int, cx * sigm(cx)); }
    f32x4 a0 = (f32x4){0.f, 0.f, 0.f, 0.f}, a1 = a0;
    const GAS f32x4* wp = (const GAS f32x4*)(F.in[I_WADA] + (size_t)k0 * MODN + col);
#pragma unroll
    for (int q = 0; q < 4; ++q) {
#pragma unroll 16
        for (int i = 0; i < 64; ++i) { const f32x4 w = wp[(size_t)(q * 64 + i) * (MODN / 4)];
            const float s = __builtin_bit_cast(float, __builtin_amdgcn_readlane(sv[q], i)), t = __builtin_bit_cast(float, __builtin_amdgcn_readlane(sc[q], i));
            a0 += w * s; a1 += w * t; }
    }
    float* mp = (float*)(F.ws + WS_MODP);
    *(GAS f32x4*)(mp + (size_t)(kc * 2 + 0) * MODN + col) = a0;
    *(GAS f32x4*)(mp + (size_t)(kc * 2 + 1) * MODN + col) = a1;
}

__device__ __forceinline__ void p0_prologue(Frame& F) {
    LAS float* scr = (LAS float*)(F.lds + RING_OFF + F.wave * 16384);
    const int lane = pg8::mk_lane();
    const int gw = F.vcu * NWAVES + F.wave, NGW = F.G * NWAVES;
    const int gt = gw * 64 + lane, NGT = NGW * 64;
    {
        unsigned* wl = (unsigned*)(F.ws + WS_WLORA);
        for (int i = gt; i < NLORA * KLORA / 2; i += NGT) { const int n = i >> 7, k = (i & 127) * 2, pn = n >> 8, d = pn >> 4, isic = (n >> 7) & 1, ch = (pn & 15) * 128 + (n & 127); float v0 = 0.f, v1 = 0.f;
            if (k < 96) { if (!isic) { v0 = *(const GAS float*)(F.in[I_WDU] + (size_t)(d * 96 + k) * 2048 + ch); v1 = *(const GAS float*)(F.in[I_WDU] + (size_t)(d * 96 + k + 1) * 2048 + ch); } }
            else if (k < 192) { if (isic) { v0 = *(const GAS float*)(F.in[I_WIU] + (size_t)(d * 96 + k - 96) * 2048 + ch); v1 = *(const GAS float*)(F.in[I_WIU] + (size_t)(d * 96 + k - 95) * 2048 + ch); } }
            *(GAS unsigned*)(wl + i) = pk2(v0, v1); }
        unsigned* wg = (unsigned*)(F.ws + WS_WGATE);
        for (int i = gt; i < 2048 * KGATE / 2; i += NGT) { const int n = i >> 7, k = (i & 127) * 2;
            *(GAS unsigned*)(wg + i) = pk2(*(const GAS float*)(F.in[I_WGU] + (size_t)k * 2048 + n), *(const GAS float*)(F.in[I_WGU] + (size_t)(k + 1) * 2048 + n)); }
        v4u* zp = (v4u*)(F.ws + WS_WIN + (size_t)IN_COLS * D * 2);
        for (int i = gt; i < (NZ - IN_COLS) * D * 2 / 16; i += NGT) *(GAS v4u*)(zp + i) = (v4u){0u, 0u, 0u, 0u};
    }
    for (int u = gw; u < GEMV_UNITS; u += NGW) p0_gemv_unit(F, u, lane);
    if (F.G == 256) {
        int it0, it1;
        if (gw < GEMV_UNITS) { it0 = gw * TI_PER_GEMV_WAVE; it1 = it0 + TI_PER_GEMV_WAVE; }
        else { it0 = GEMV_UNITS * TI_PER_GEMV_WAVE + (gw - GEMV_UNITS) * TI_PER_OTHER_WAVE; it1 = it0 + TI_PER_OTHER_WAVE; }
        if (it1 > P0_ITEMS) it1 = P0_ITEMS;
        for (int it = it0; it < it1; ++it) tr_item(F, it < TI_IN ? it : P0X_B + (it - TI_IN), scr, lane);
    } else tr_range(F, 0, TI_TOTAL, gw, NGW, scr, lane);
}

__device__ __forceinline__ void norm_row(const float* xrow, bf16* orow, const LAS float* gs, const LAS float* sh, int lane) {
    const GAS f32x4* xr = (const GAS f32x4*)xrow + lane;
    f32x4 v[16]; float s = 0.f;
#pragma unroll
    for (int j = 0; j < 16; ++j) { v[j] = xr[64 * j]; s += (v[j].x * v[j].x + v[j].y * v[j].y) + (v[j].z * v[j].z + v[j].w * v[j].w); }
    const float rstd = 1.0f / sqrtf(wave_sum(s) * (1.f / D) + NORM_EPS);
    GAS v2u* o8 = (GAS v2u*)orow + lane;
#pragma unroll
    for (int j = 0; j < 16; ++j) { const f32x4 g = *(const LAS f32x4*)(gs + 4 * lane + 256 * j), b = *(const LAS f32x4*)(sh + 4 * lane + 256 * j);
        const f32x4 y = v[j] * rstd * g + b; v2u o; o.x = pk2(y.x, y.y); o.y = pk2(y.z, y.w); o8[64 * j] = o; }
}
__device__ __forceinline__ void p1_norm1(Frame& F) {
    const int lane = pg8::mk_lane(), tid = F.wave * 64 + lane;
    LAS float* tab = (LAS float*)(F.lds + RING_OFF);
    const float* mp = (const float*)(F.ws + WS_MODP);
    for (int i = tid; i < 4 * D; i += NWAVES * 64) {
        const int which = i >> 12, k = i & (D - 1), isc = which >> 1, part = which & 1;
        const int col = part == 0 ? D + k : k;
        float s = *(const GAS float*)(F.in[I_BADA] + col);
#pragma unroll
        for (int p = 0; p < NKC; ++p) s += *(const GAS float*)(mp + (size_t)(p * 2 + isc) * MODN + col);
        tab[i] = part == 0 ? *(const GAS float*)(F.in[I_NORM1] + k) * (1.0f + s) : s;
    }
    {
        float* mv = (float*)(F.ws + WS_MODV);
        for (int i = F.vcu * (NWAVES * 64) + tid; i < 2 * MODN; i += F.G * NWAVES * 64) { const int isc = i / MODN, col = i % MODN;
            float s = *(const GAS float*)(F.in[I_BADA] + col);
#pragma unroll
            for (int p = 0; p < NKC; ++p) s += *(const GAS float*)(mp + (size_t)(p * 2 + isc) * MODN + col);
            *(GAS float*)(mv + i) = s; }
    }
    __syncthreads();
    const int gw = F.vcu * NWAVES + F.wave, NGW = F.G * NWAVES;
    bf16* A1 = (bf16*)(F.ws + WS_A1);
    for (int m = gw; m < TT; m += NGW) {
        if (m < T) norm_row(F.in[I_X] + (size_t)m * D, A1 + (size_t)m * D, tab, tab + D, lane);
        else norm_row(F.in[I_CTX] + (size_t)(m - T) * D, A1 + (size_t)m * D, tab + 2 * D, tab + 3 * D, lane);
    }
    __syncthreads();
}
__device__ __forceinline__ void p10_norm2(Frame& F) {
    const int lane = pg8::mk_lane(), tid = F.wave * 64 + lane;
    LAS float* tab = (LAS float*)(F.lds + RING_OFF);
    const float* mv = (const float*)(F.ws + WS_MODV);
    for (int i = tid; i < 2 * D; i += NWAVES * 64) { const int part = i >> 12, k = i & (D - 1);
        tab[i] = part == 0 ? *(const GAS float*)(F.in[I_NORM2] + k) * (1.0f + *(const GAS float*)(mv + 4 * D + k)) : *(const GAS float*)(mv + 3 * D + k); }
    __syncthreads();
    const int gw = F.vcu * NWAVES + F.wave, NGW = F.G * NWAVES;
    bf16* A1 = (bf16*)(F.ws + WS_A1); const float* X1 = (const float*)(F.ws + WS_X1);
    for (int m = gw; m < T; m += NGW) norm_row(X1 + (size_t)m * D, A1 + (size_t)m * D, tab, tab + D, lane);
    __syncthreads();
}
__device__ __forceinline__ void p13_final(Frame& F) {
    const int lane = pg8::mk_lane();
    const int gw = F.vcu * NWAVES + F.wave, NGW = F.G * NWAVES;
    for (int m = gw; m < T; m += NGW) {
        GAS f32x4* xr = (GAS f32x4*)(F.out + (size_t)m * D) + lane;
        f32x4 v[16]; float s = 0.f;
#pragma unroll
        for (int j = 0; j < 16; ++j) { v[j] = xr[64 * j]; s += (v[j].x * v[j].x + v[j].y * v[j].y) + (v[j].z * v[j].z + v[j].w * v[j].w); }
        const float rstd = 1.0f / sqrtf(wave_sum(s) * (1.f / D) + NORM_EPS);
#pragma unroll
        for (int j = 0; j < 16; ++j) { const f32x4 g = *((const GAS f32x4*)F.in[I_NORMF] + lane + 64 * j); xr[64 * j] = v[j] * rstd * g; }
    }
}

__device__ __forceinline__ void ld8(const bf16* p, float (&f)[8]) { const v4u r = *(const GAS v4u*)p;
    f[0] = bflo(r.x); f[1] = bfhi(r.x); f[2] = bflo(r.y); f[3] = bfhi(r.y); f[4] = bflo(r.z); f[5] = bfhi(r.z); f[6] = bflo(r.w); f[7] = bfhi(r.w); }
__device__ __forceinline__ void ldf8(const float* p, float (&f)[8]) { const f32x4 a = *(const GAS f32x4*)p, b = *(const GAS f32x4*)(p + 4);
    f[0] = a.x; f[1] = a.y; f[2] = a.z; f[3] = a.w; f[4] = b.x; f[5] = b.y; f[6] = b.z; f[7] = b.w; }
__device__ __forceinline__ void stf8(float* p, const float (&f)[8]) { *(GAS f32x4*)p = (f32x4){f[0], f[1], f[2], f[3]}; *(GAS f32x4*)(p + 4) = (f32x4){f[4], f[5], f[6], f[7]}; }
__device__ __forceinline__ void stb8(bf16* p, const float (&f)[8]) { v4u o; o.x = pk2(f[0], f[1]); o.y = pk2(f[2], f[3]); o.z = pk2(f[4], f[5]); o.w = pk2(f[6], f[7]); *(GAS v4u*)p = o; }
__device__ __forceinline__ void za8(const bf16* Z, int row, bool hp, bool hn, int c, const float* mu, float (&o)[8]) {
    float zc[8], zp[8], zn[8], m8[8];
    ld8(Z + (size_t)row * NZ + c, zc);
    if (hp) ld8(Z + (size_t)(row - 1) * NZ + c, zp); else { _Pragma("unroll") for (int i = 0; i < 8; ++i) zp[i] = 0.f; }
    if (hn) ld8(Z + (size_t)(row + 1) * NZ + c, zn); else { _Pragma("unroll") for (int i = 0; i < 8; ++i) zn[i] = 0.f; }
    ldf8(mu + c, m8);
#pragma unroll
    for (int i = 0; i < 8; ++i) o[i] = zc[i] + m8[i] * (0.5f * (zp[i] + zn[i]) - zc[i]);
}
__device__ __forceinline__ void p3_prep(Frame& F) {
    const bf16* Z = (const bf16*)(F.ws + WS_Z);
    float* KB = (float*)(F.ws + WS_KBUF); float* KKB = (float*)(F.ws + WS_KKBUF); float* RB = (float*)(F.ws + WS_RBUF); float* VB = (float*)(F.ws + WS_VBUF);
    bf16* AL = (bf16*)(F.ws + WS_ALORA); bf16* AG = (bf16*)(F.ws + WS_AGATE); bf16* CAT = (bf16*)(F.ws + WS_CAT);
    const float* mu = F.in[I_MU];
    const int tpb = (TT + F.G - 1) / F.G;
    const int tok0 = F.vcu * tpb;
    const int lane = pg8::mk_lane();
    for (int it = F.wave; it < tpb * 18; it += NWAVES) {
        const int type = it / tpb, tok = tok0 + it % tpb;
        if (tok >= TT) continue;
        const bool isctx = tok >= T;
        const int pos = isctx ? tok - T : (tok & 63);
        const bool hp = pos > 0, hn = isctx ? (pos < CTXL - 1) : (pos < 63);
        if (type < 12) {
            const int kind = type >> 2, j = type & 3, c = j * 512 + lane * 8;
            if (isctx && kind == 2) continue;
            const int zoff = kind == 0 ? OFF_K : (kind == 1 ? OFF_V : OFF_R);
            float v[8]; za8(Z, tok, hp, hn, zoff + c, mu, v);
            const size_t fo = (size_t)tok * 2048 + c;
            if (kind == 0) {
                stf8(KB + fo, v);
                float kk8[8], q[8]; ldf8(F.in[I_KK] + c, kk8); float ss = 0.f;
#pragma unroll
                for (int i = 0; i < 8; ++i) { q[i] = v[i] * kk8[i]; ss += q[i] * q[i]; }
                ss += __shfl_xor(ss, 1); ss += __shfl_xor(ss, 2); ss += __shfl_xor(ss, 4);
                const float inv = 1.0f / fmaxf(sqrtf(ss), 1e-12f);
#pragma unroll
                for (int i = 0; i < 8; ++i) q[i] *= inv;
                stf8(KKB + fo, q);
            } else if (kind == 1) stf8(VB + fo, v);
            else stf8(RB + fo, v);
        } else if (type == 12) {
            if (lane < 32) {
                float v[8];
                if (lane < 24) { za8(Z, tok, hp, hn, OFF_WL + lane * 8, mu, v);
                    if (lane < 12) { _Pragma("unroll") for (int i = 0; i < 8; ++i) v[i] = tanhf(v[i]); } }
                else { _Pragma("unroll") for (int i = 0; i < 8; ++i) v[i] = 0.f; }
                stb8(AL + (size_t)tok * KLORA + lane * 8, v);
            }
        } else if (type == 13) {
            if (!isctx && lane < 32) { float v[8]; za8(Z, tok, hp, hn, OFF_GL + lane * 8, mu, v);
#pragma unroll
                for (int i = 0; i < 8; ++i) v[i] = sigm(v[i]);
                stb8(AG + (size_t)tok * KGATE + lane * 8, v); }
        } else if (!isctx) {
            const int j = type - 14, c = j * 512 + lane * 8;
            float bg[8], cc[8], xc[8], cp[8], xp[8], cn[8], xn[8], w0[8], w1[8], w2[8], y[8];
            const bf16* zr = Z + (size_t)tok * NZ;
            ld8(zr + OFF_CB + c, bg); ld8(zr + OFF_CC + c, cc); ld8(zr + OFF_CX + c, xc);
            if (hp) { ld8(zr - NZ + OFF_CC + c, cp); ld8(zr - NZ + OFF_CX + c, xp); } else { _Pragma("unroll") for (int i = 0; i < 8; ++i) { cp[i] = 0.f; xp[i] = 0.f; } }
            if (hn) { ld8(zr + NZ + OFF_CC + c, cn); ld8(zr + NZ + OFF_CX + c, xn); } else { _Pragma("unroll") for (int i = 0; i < 8; ++i) { cn[i] = 0.f; xn[i] = 0.f; } }
            ldf8(F.in[I_CONVW] + c, w0); ldf8(F.in[I_CONVW] + 2048 + c, w1); ldf8(F.in[I_CONVW] + 4096 + c, w2);
#pragma unroll
            for (int i = 0; i < 8; ++i) y[i] = bg[i] * (w0[i] * (cp[i] * xp[i]) + w1[i] * (cc[i] * xc[i]) + w2[i] * (cn[i] * xn[i]));
            stb8(CAT + (size_t)tok * D + DR + c, y);
        }
    }
}

typedef float f32x16 __attribute__((ext_vector_type(16)));
#define MK_FENCE() asm volatile("" ::: "memory")
__device__ __forceinline__ void swap32(float& x, float& y) { asm volatile("s_nop 1\n\tv_permlane32_swap_b32 %0, %1\n\ts_nop 1" : "+v"(x), "+v"(y)); }
__device__ __forceinline__ int scan_tokbase(int d, int c, int n) {
    const int i0 = 4 * n;
    if (c == 0) return T + (d == 0 ? i0 : CTXL - 4 - i0);
    const int p0 = (c - 1) * CHUNK + i0;
    return d == 0 ? p0 : T - 4 - p0;
}
struct ScanRegs { f32x4 p[4]; float v[4]; };
__device__ __forceinline__ void scan_gload(const float* PK, const float* VB, int d, int h, int tb, int lane, ScanRegs& R) {
    const GAS f32x4* gp = (const GAS f32x4*)(PK + ((size_t)(d * 32 + h) * TT + tb) * 256) + lane;
    const GAS float* gv = (const GAS float*)(VB + (size_t)tb * 2048 + h * 64) + lane;
#pragma unroll
    for (int j = 0; j < 4; ++j) { R.p[j] = gp[64 * j]; R.v[j] = gv[2048 * j]; }
}
__device__ __forceinline__ void scan_lstore(LAS unsigned char* buf, int lane, const ScanRegs& R) {
#pragma unroll
    for (int j = 0; j < 4; ++j) { *((LAS f32x4*)buf + 64 * j + lane) = R.p[j]; *((LAS float*)(buf + 4096) + 64 * j + lane) = R.v[j]; }
}
__device__ __forceinline__ void scan_matvec(const f32x16 (&Tt)[2][2], const LAS float* vec, int hl, float& sa) {
    float p0a = 0.f, p0b = 0.f, p1a = 0.f, p1b = 0.f;
#pragma unroll
    for (int I = 0; I < 2; ++I)
#pragma unroll
        for (int qd = 0; qd < 4; ++qd) { const f32x4 a = *(const LAS f32x4*)(vec + 32 * I + 8 * qd + 4 * hl);
            p0a += Tt[I][0][4 * qd] * a.x; p0b += Tt[I][0][4 * qd + 1] * a.y; p0a += Tt[I][0][4 * qd + 2] * a.z; p0b += Tt[I][0][4 * qd + 3] * a.w;
            p1a += Tt[I][1][4 * qd] * a.x; p1b += Tt[I][1][4 * qd + 1] * a.y; p1a += Tt[I][1][4 * qd + 2] * a.z; p1b += Tt[I][1][4 * qd + 3] * a.w; }
    float p0 = p0a + p0b, p1 = p1a + p1b;
    swap32(p0, p1);
    sa = p0 + p1;
}
__device__ __forceinline__ void scan_renorm(f32x16 (&Tt)[2][2], const float* ge, int hl) {
#pragma unroll
    for (int I = 0; I < 2; ++I)
#pragma unroll
        for (int qd = 0; qd < 4; ++qd) { const f32x4 g = *(const GAS f32x4*)(ge + 32 * I + 8 * qd + 4 * hl);
#pragma unroll
            for (int e = 0; e < 4; ++e) { Tt[I][0][4 * qd + e] *= g[e]; Tt[I][1][4 * qd + e] *= g[e]; } }
}
__device__ __forceinline__ void scan_store_T(const f32x16 (&Tt)[2][2], float* dst, int lane) {
#pragma unroll
    for (int I = 0; I < 2; ++I)
#pragma unroll
        for (int J = 0; J < 2; ++J)
#pragma unroll
            for (int reg = 0; reg < 16; ++reg) *(GAS float*)(dst + (32 * I + 8 * (reg >> 2) + 4 * (lane >> 5) + (reg & 3)) * 64 + 32 * J + (lane & 31)) = Tt[I][J][reg];
}
__device__ __forceinline__ void p5_scanA(Frame& F) {
    const float* PK = (const float*)(F.ws + WS_PK); const float* VB = (const float*)(F.ws + WS_VBUF); const float* GE = (const float*)(F.ws + WS_GE);
    float* PU = (float*)(F.ws + WS_PU);
    LAS unsigned char* my = F.lds + RING_OFF + F.wave * 10240;
    for (int unit = F.vcu * NWAVES + F.wave; unit < 2048; unit += F.G * NWAVES) {
        const int d = unit & 1, h = (unit >> 1) & 31, c = unit >> 6;
        const int lane = pg8::mk_lane(), hl = lane >> 5;
        f32x16 TP[2][2], TU[2][2];
#pragma unroll
        for (int I = 0; I < 2; ++I)
#pragma unroll
            for (int J = 0; J < 2; ++J)
#pragma unroll
                for (int reg = 0; reg < 16; ++reg) { TP[I][J][reg] = (32 * I + 8 * (reg >> 2) + 4 * hl + (reg & 3) == 32 * J + (lane & 31)) ? 1.0f : 0.0f; TU[I][J][reg] = 0.0f; }
        ScanRegs RA, RB;
        scan_gload(PK, VB, d, h, scan_tokbase(d, c, 0), lane, RA); scan_lstore(my, lane, RA);
        scan_gload(PK, VB, d, h, scan_tokbase(d, c, 1), lane, RA);
        scan_gload(PK, VB, d, h, scan_tokbase(d, c, 2), lane, RB);
#pragma unroll 1
        for (int n2 = 0; n2 < 32; ++n2) {
#pragma unroll
            for (int par = 0; par < 2; ++par) {
                const int n = 2 * n2 + par;
                ScanRegs& R = par == 0 ? RA : RB;
                scan_lstore(my + ((n + 1) & 1) * 5120, lane, R);
                if (n + 3 < 64) scan_gload(PK, VB, d, h, scan_tokbase(d, c, n + 3), lane, R);
                const LAS unsigned char* buf = my + (n & 1) * 5120;
#pragma unroll 1
                for (int jj = 0; jj < 4; ++jj) {
                    const int slot = d == 0 ? jj : 3 - jj;
                    const LAS float* pk = (const LAS float*)(buf + slot * 1024);
                    float vv = ((const LAS float*)(buf + 4096))[slot * 64 + lane];
                    float bk0 = pk[128 + lane], bk1 = pk[192 + lane];
                    float saP, saU;
                    {
                        float p0a = 0.f, p0b = 0.f, p1a = 0.f, p1b = 0.f, u0a = 0.f, u0b = 0.f, u1a = 0.f, u1b = 0.f;
#pragma unroll
                        for (int I = 0; I < 2; ++I)
#pragma unroll
                            for (int qd = 0; qd < 4; ++qd) { const f32x4 a = *(const LAS f32x4*)(pk + 32 * I + 8 * qd + 4 * hl);
                                p0a += TP[I][0][4 * qd] * a.x; p0b += TP[I][0][4 * qd + 1] * a.y; p0a += TP[I][0][4 * qd + 2] * a.z; p0b += TP[I][0][4 * qd + 3] * a.w;
                                p1a += TP[I][1][4 * qd] * a.x; p1b += TP[I][1][4 * qd + 1] * a.y; p1a += TP[I][1][4 * qd + 2] * a.z; p1b += TP[I][1][4 * qd + 3] * a.w;
                                u0a += TU[I][0][4 * qd] * a.x; u0b += TU[I][0][4 * qd + 1] * a.y; u0a += TU[I][0][4 * qd + 2] * a.z; u0b += TU[I][0][4 * qd + 3] * a.w;
                                u1a += TU[I][1][4 * qd] * a.x; u1b += TU[I][1][4 * qd + 1] * a.y; u1a += TU[I][1][4 * qd + 2] * a.z; u1b += TU[I][1][4 * qd + 3] * a.w; }
                        float p0 = p0a + p0b, p1 = p1a + p1b, u0 = u0a + u0b, u1 = u1a + u1b;
                        swap32(p0, p1); swap32(u0, u1); saP = p0 + p1; saU = u0 + u1;
                    }
                    float zz = 0.0f;
                    swap32(saU, vv);
                    swap32(saP, zz);
                    TU[0][0] = __builtin_amdgcn_mfma_f32_32x32x2f32(bk0, saU, TU[0][0], 0, 0, 0); TU[0][1] = __builtin_amdgcn_mfma_f32_32x32x2f32(bk0, vv, TU[0][1], 0, 0, 0);
                    TU[1][0] = __builtin_amdgcn_mfma_f32_32x32x2f32(bk1, saU, TU[1][0], 0, 0, 0); TU[1][1] = __builtin_amdgcn_mfma_f32_32x32x2f32(bk1, vv, TU[1][1], 0, 0, 0);
                    TP[0][0] = __builtin_amdgcn_mfma_f32_32x32x2f32(bk0, saP, TP[0][0], 0, 0, 0); TP[0][1] = __builtin_amdgcn_mfma_f32_32x32x2f32(bk0, zz, TP[0][1], 0, 0, 0);
                    TP[1][0] = __builtin_amdgcn_mfma_f32_32x32x2f32(bk1, saP, TP[1][0], 0, 0, 0); TP[1][1] = __builtin_amdgcn_mfma_f32_32x32x2f32(bk1, zz, TP[1][1], 0, 0, 0);
                }
                if ((n & 3) == 3) {
                    const int tbk = scan_tokbase(d, c, n - 3 + (d == 0 ? 0 : 3));
                    const float* ge = GE + ((size_t)(d * 32 + h) * (TT / 16) + (tbk >> 4)) * 64;
                    scan_renorm(TP, ge, hl); scan_renorm(TU, ge, hl);
                }
            }
        }
        scan_store_T(TP, PU + ((size_t)unit * 2 + 0) * 4096, lane);
        scan_store_T(TU, PU + ((size_t)unit * 2 + 1) * 4096, lane);
    }
}
__device__ __forceinline__ void p6_scanB(Frame& F) {
    const GAS char* PU = (const GAS char*)(F.ws + WS_PU); GAS char* SST = (GAS char*)(F.ws + WS_SST);
    LAS float* PiB = (LAS float*)(F.lds + RING_OFF);
    LAS float* TbB = (LAS float*)(F.lds + RING_OFF + 2 * 16640);
    const int w = F.wave;
    for (int q = F.vcu; q < 64; q += F.G) {
        const unsigned lane = (unsigned)pg8::mk_lane(), tid = (unsigned)w * 64u + lane, hl = lane >> 5, l31 = lane & 31u;
        const unsigned I1 = ((unsigned)w >> 1) & 1u, J = (unsigned)w & 1u;
        {   const GAS char* u0 = PU + ((size_t)q * 2 + 1) * 16384; GAS char* so = SST + ((size_t)q * NCHUNK + 1) * 16384;
            const f32x4 t0 = *(const GAS f32x4*)(u0 + tid * 32u), t1 = *(const GAS f32x4*)(u0 + tid * 32u + 16u);
            *((LAS f32x4*)TbB + tid * 2) = t0; *((LAS f32x4*)TbB + tid * 2 + 1) = t1;
            *(GAS f32x4*)(so + tid * 32u) = t0; *(GAS f32x4*)(so + tid * 32u + 16u) = t1; }
        f32x4 pn0, pn1; f32x16 un;
        {   const GAS char* pg = PU + (((size_t)q + 64) * 2 + 0) * 16384; pn0 = *(const GAS f32x4*)(pg + tid * 32u); pn1 = *(const GAS f32x4*)(pg + tid * 32u + 16u);
            const unsigned pb = (tid >> 3) * 65u + (tid & 7u) * 8u;
#pragma unroll
            for (int e = 0; e < 4; ++e) { PiB[pb + e] = pn0[e]; PiB[pb + 4 + e] = pn1[e]; }
            const GAS char* ug = PU + (((size_t)q + 64) * 2 + 1) * 16384;
#pragma unroll
            for (int r = 0; r < 16; ++r) un[r] = (w < 4) ? *(const GAS float*)(ug + ((32u * I1 + 8u * (r >> 2) + 4u * hl + (r & 3)) * 64u + 32u * J + l31) * 4u) : 0.f; }
        __syncthreads();
        for (int c = 1; c < 32; ++c) {
            const LAS float* Pi = PiB + ((c - 1) & 1) * 4160; const LAS float* Tb = TbB + ((c - 1) & 1) * 4096;
            LAS float* PiN = PiB + (c & 1) * 4160; LAS float* TbN = TbB + (c & 1) * 4096;
            f32x16 acc = un;
            if (c + 1 < 32) {
                const GAS char* pg = PU + (((size_t)q + 64 * (c + 1)) * 2 + 0) * 16384; pn0 = *(const GAS f32x4*)(pg + tid * 32u); pn1 = *(const GAS f32x4*)(pg + tid * 32u + 16u);
                const GAS char* ug = PU + (((size_t)q + 64 * (c + 1)) * 2 + 1) * 16384;
                if (w < 4) {
#pragma unroll
                    for (int r = 0; r < 16; ++r) un[r] = *(const GAS float*)(ug + ((32u * I1 + 8u * (r >> 2) + 4u * hl + (r & 3)) * 64u + 32u * J + l31) * 4u); }
            }
            if (w < 4) {
#pragma unroll
                for (int s2 = 0; s2 < 32; ++s2) { const float av = Pi[(32u * I1 + l31) * 65u + 2u * s2 + hl], bv = Tb[(2u * s2 + hl) * 64u + 32u * J + l31];
                    acc = __builtin_amdgcn_mfma_f32_32x32x2f32(av, bv, acc, 0, 0, 0);
                    if ((s2 & 7) == 7) MK_FENCE(); }
                GAS char* so = SST + ((size_t)q * NCHUNK + c + 1) * 16384;
#pragma unroll
                for (int r = 0; r < 16; ++r) { const unsigned e = (32u * I1 + 8u * (r >> 2) + 4u * hl + (r & 3)) * 64u + 32u * J + l31; TbN[e] = acc[r]; *(GAS float*)(so + e * 4u) = acc[r]; }
            }
            if (c + 1 < 32) { const unsigned pb = (tid >> 3) * 65u + (tid & 7u) * 8u;
#pragma unroll
                for (int e = 0; e < 4; ++e) { PiN[pb + e] = pn0[e]; PiN[pb + 4 + e] = pn1[e]; } }
            __syncthreads();
        }
    }
}
__device__ __forceinline__ void p7_scanC(Frame& F) {
    const float* PK = (const float*)(F.ws + WS_PK); const float* VB = (const float*)(F.ws + WS_VBUF); const float* GE = (const float*)(F.ws + WS_GE);
    const float* SST = (const float*)(F.ws + WS_SST); float* YS = (float*)(F.ws + WS_YS);
    LAS unsigned char* my = F.lds + RING_OFF + F.wave * 10240;
    for (int unit = F.vcu * NWAVES + F.wave; unit < 2048; unit += F.G * NWAVES) {
        const int d = unit & 1, h = (unit >> 1) & 31, c = (unit >> 6) + 1, q = unit & 63;
        const int lane = pg8::mk_lane(), hl = lane >> 5;
        f32x16 Tt[2][2];
        {   const float* s0 = SST + ((size_t)q * NCHUNK + c) * 4096;
#pragma unroll
            for (int I = 0; I < 2; ++I)
#pragma unroll
                for (int J = 0; J < 2; ++J)
#pragma unroll
                    for (int reg = 0; reg < 16; ++reg) Tt[I][J][reg] = *(const GAS float*)(s0 + (32 * I + 8 * (reg >> 2) + 4 * hl + (reg & 3)) * 64 + 32 * J + (lane & 31)); }
        ScanRegs RA, RB;
        scan_gload(PK, VB, d, h, scan_tokbase(d, c, 0), lane, RA); scan_lstore(my, lane, RA);
        scan_gload(PK, VB, d, h, scan_tokbase(d, c, 1), lane, RA);
        scan_gload(PK, VB, d, h, scan_tokbase(d, c, 2), lane, RB);
        float* yo = YS + (size_t)d * T * 2048 + h * 64 + lane;
#pragma unroll 1
        for (int n2 = 0; n2 < 32; ++n2) {
#pragma unroll
            for (int par = 0; par < 2; ++par) {
                const int n = 2 * n2 + par;
                ScanRegs& R = par == 0 ? RA : RB;
                scan_lstore(my + ((n + 1) & 1) * 5120, lane, R);
                if (n + 3 < 64) scan_gload(PK, VB, d, h, scan_tokbase(d, c, n + 3), lane, R);
                const LAS unsigned char* buf = my + (n & 1) * 5120;
                const int tb = scan_tokbase(d, c, n);
#pragma unroll 1
                for (int jj = 0; jj < 4; ++jj) {
                    const int slot = d == 0 ? jj : 3 - jj;
                    const LAS float* pk = (const LAS float*)(buf + slot * 1024);
                    float vv = ((const LAS float*)(buf + 4096))[slot * 64 + lane];
                    float bk0 = pk[128 + lane], bk1 = pk[192 + lane];
                    float sa; scan_matvec(Tt, pk, hl, sa);
                    swap32(sa, vv);
                    Tt[0][0] = __builtin_amdgcn_mfma_f32_32x32x2f32(bk0, sa, Tt[0][0], 0, 0, 0); Tt[0][1] = __builtin_amdgcn_mfma_f32_32x32x2f32(bk0, vv, Tt[0][1], 0, 0, 0);
                    Tt[1][0] = __builtin_amdgcn_mfma_f32_32x32x2f32(bk1, sa, Tt[1][0], 0, 0, 0); Tt[1][1] = __builtin_amdgcn_mfma_f32_32x32x2f32(bk1, vv, Tt[1][1], 0, 0, 0);
                    float y; scan_matvec(Tt, pk + 64, hl, y);
                    *(GAS float*)(yo + (size_t)(tb + slot) * 2048) = y;
                }
                if ((n & 3) == 3) {
                    const int tbk = scan_tokbase(d, c, n - 3 + (d == 0 ? 0 : 3));
                    scan_renorm(Tt, GE + ((size_t)(d * 32 + h) * (TT / 16) + (tbk >> 4)) * 64, hl);
                }
            }
        }
    }
}

__device__ __forceinline__ void p8_readout(Frame& F) {
    const float* RB = (const float*)(F.ws + WS_RBUF); const float* VB = (const float*)(F.ws + WS_VBUF); const float* YS = (const float*)(F.ws + WS_YS);
    const bf16* KD = (const bf16*)(F.ws + WS_KD);
    const bf16* G = (const bf16*)(F.ws + WS_G); bf16* CAT = (bf16*)(F.ws + WS_CAT);
    const int tpb = (T + F.G - 1) / F.G, tok0 = F.vcu * tpb, lane = pg8::mk_lane();
    for (int it = F.wave; it < tpb * 4; it += NWAVES) {
        const int j = it / tpb, tok = tok0 + it % tpb;
        if (tok >= T) continue;
        const int c = j * 512 + lane * 8;
        float y0[8], y1[8], y[8];
        ldf8(YS + (size_t)tok * 2048 + c, y0); ldf8(YS + ((size_t)T + tok) * 2048 + c, y1);
        float s = 0.f;
#pragma unroll
        for (int i = 0; i < 8; ++i) { y[i] = y0[i] + y1[i]; s += y[i]; }
        s += __shfl_xor(s, 1); s += __shfl_xor(s, 2); s += __shfl_xor(s, 4);
        const float mean = s * (1.0f / 64.0f); float q = 0.f;
#pragma unroll
        for (int i = 0; i < 8; ++i) { const float dlt = y[i] - mean; q += dlt * dlt; }
        q += __shfl_xor(q, 1); q += __shfl_xor(q, 2); q += __shfl_xor(q, 4);
        const float rstd = 1.0f / sqrtf(q * (1.0f / 64.0f) + LNX_EPS);
        float r8[8], v8[8], k0[8], k1[8], rk[8], lw[8], lb[8], g8[8];
        ldf8(RB + (size_t)tok * 2048 + c, r8); ldf8(VB + (size_t)tok * 2048 + c, v8);
        ld8(KD + (size_t)tok * 2048 + c, k0); ld8(KD + ((size_t)TT + tok) * 2048 + c, k1);
        ldf8(F.in[I_RK] + c, rk); ldf8(F.in[I_LNXW] + c, lw); ldf8(F.in[I_LNXB] + c, lb);
        ld8(G + (size_t)tok * 2048 + c, g8);
        float dot = 0.f;
#pragma unroll
        for (int i = 0; i < 8; ++i) dot += r8[i] * (k0[i] + k1[i]) * rk[i];
        dot += __shfl_xor(dot, 1); dot += __shfl_xor(dot, 2); dot += __shfl_xor(dot, 4);
        float o[8];
#pragma unroll
        for (int i = 0; i < 8; ++i) o[i] = ((y[i] - mean) * rstd * lw[i] + lb[i] + dot * v8[i]) * g8[i];
        stb8(CAT + (size_t)tok * D + c, o);
    }
}

template <int K> __device__ __forceinline__ void run_phase(Frame& F) {
    bf16* A1 = (bf16*)(F.ws + WS_A1); bf16* Zb = (bf16*)(F.ws + WS_Z);
    const float* MV = (const float*)(F.ws + WS_MODV);
    (void)A1; (void)Zb; (void)MV;
    asm volatile("; MK_PHASE %0" :: "i"(K) : "memory");
    if constexpr (K == 0) { p0_prologue(F);
    }
    if constexpr (K == 1) { p1_norm1(F);
    }
    if constexpr (K == 2) {
        { pg8::Gemm g{A1, (const bf16*)(F.ws + WS_WIN), T, NZ, D}; pg8::StaticOrder S; S.init(T, NZ, F.G, (int)blockIdx.x);
          pg8::EpiBf16<0> E{Zb, NZ, nullptr, 0, 0, 1.f};
          pg8::gemm_phase<pg8::EpiBf16<0>, pg8::StaticOrder, true, true>(F.lds + RING_OFF, g, S, E, F.wave); }
        { pg8::Gemm g{A1 + (size_t)T * D, (const bf16*)(F.ws + WS_WIN), CTXL, NCTXZ, D}; pg8::StaticOrder S; S.init(CTXL, NCTXZ, F.G, (int)((blockIdx.x + F.G - 64) % F.G));
          pg8::EpiBf16<0> E{Zb + (size_t)T * NZ, NZ, nullptr, 0, 0, 1.f};
          pg8::gemm_phase<pg8::EpiBf16<0>, pg8::StaticOrder, true, true>(F.lds + RING_OFF, g, S, E, F.wave); }
        tr_idle(F, P2T_B, P2T_E, (int)blockIdx.x - 81, 175);
    }
    if constexpr (K == 3) { p3_prep(F);
    }
    if constexpr (K == 4) {
        { int kl = KLORA; asm volatile("" : "+s"(kl));
          pg8::Gemm g{(const bf16*)(F.ws + WS_ALORA), (const bf16*)(F.ws + WS_WLORA), TT, NLORA, kl}; pg8::StaticOrder S; S.init(TT, NLORA, F.G, (int)blockIdx.x);
          pg8::EpiLora E{(float*)(F.ws + WS_PK), (float*)(F.ws + WS_GE), (bf16*)(F.ws + WS_KD), (const float*)(F.ws + WS_KBUF), (const float*)(F.ws + WS_KKBUF), (const float*)(F.ws + WS_RBUF), F.in[I_W0], F.in[I_A0], F.in[I_KA], TT};
          pg8::gemm_phase<pg8::EpiLora, pg8::StaticOrder, true, true>(F.lds + RING_OFF, g, S, E, F.wave); }
        { int kl = KGATE; asm volatile("" : "+s"(kl));
          pg8::Gemm g{(const bf16*)(F.ws + WS_AGATE), (const bf16*)(F.ws + WS_WGATE), T, DR, kl}; pg8::StaticOrder S; S.init(T, DR, F.G, (int)blockIdx.x);
          pg8::EpiBf16<0> E{(bf16*)(F.ws + WS_G), DR, nullptr, 0, 0, 1.f};
          pg8::gemm_phase<pg8::EpiBf16<0>, pg8::StaticOrder, true, true>(F.lds + RING_OFF, g, S, E, F.wave); }

    }
    if constexpr (K == 5) { p5_scanA(F);
    }
    if constexpr (K == 6) { p6_scanB(F); tr_idle(F, P6T_B, P6T_E, F.vcu - 64, 192);

    }
    if constexpr (K == 7) { p7_scanC(F);
    }
    if constexpr (K == 8) { p8_readout(F);
    }
    if constexpr (K == 9) {
        pg8::Gemm g{(const bf16*)(F.ws + WS_CAT), (const bf16*)(F.ws + WS_WOUT), T, D, D}; pg8::StaticOrder S; S.init(T, D, F.G, (int)blockIdx.x);
        pg8::EpiResid E{F.in[I_X], (float*)(F.ws + WS_X1), D, MV + 2 * D};
        pg8::gemm_phase<pg8::EpiResid, pg8::StaticOrder, true, true>(F.lds + RING_OFF, g, S, E, F.wave);

    }
    if constexpr (K == 10) { p10_norm2(F);
    }
    if constexpr (K == 11) {
        pg8::Gemm g{A1, (const bf16*)(F.ws + WS_WGU), T, NGU, D}; pg8::StaticOrder S; S.init(T, NGU, F.G, (int)blockIdx.x);
        pg8::EpiSwiglu E{(bf16*)(F.ws + WS_ACT), DFF};
        pg8::gemm_phase<pg8::EpiSwiglu, pg8::StaticOrder, true, true>(F.lds + RING_OFF, g, S, E, F.wave);
        tr_idle(F, P11T_B, P11T_E, (int)blockIdx.x - 192, 64);
    }
    if constexpr (K == 12) {
        pg8::Gemm g{(const bf16*)(F.ws + WS_ACT), (const bf16*)(F.ws + WS_WDN), T, D, DFF}; pg8::StaticOrder S; S.init(T, D, F.G, (int)blockIdx.x);
        pg8::EpiResid E{(const float*)(F.ws + WS_X1), F.out, D, MV + 5 * D};
        pg8::gemm_phase<pg8::EpiResid, pg8::StaticOrder, true, true>(F.lds + RING_OFF, g, S, E, F.wave);

    }
    if constexpr (K == 13) { p13_final(F);
    }
}

struct Args { const float* in[26]; float* out; unsigned char* ws; int ph_lo, ph_hi, li, pad; };
__global__ void __launch_bounds__(NWAVES * 64, 2) mk_fwd(Args args) {
    extern __shared__ __attribute__((aligned(16))) unsigned char lds[];
    Frame F;
    F.lds = (LAS unsigned char*)lds;
    F.MISC = (volatile LAS unsigned*)(F.lds + MISC_OFF);
    F.wave = __builtin_amdgcn_readfirstlane((int)(threadIdx.x >> 6));
    F.G = gridDim.x; { const int bx = blockIdx.x; F.vcu = (F.G % 8 == 0) ? (bx % 8) * (F.G / 8) + bx / 8 : bx; }
    F.ws = args.ws; F.ctl = (gu32*)(args.ws + WS_CTL); F.out = args.out;
#pragma unroll
    for (int i = 0; i < 26; ++i) F.in[i] = args.in[i];
    for (int u = threadIdx.x; u < (LDS_BYTES - LDSCTL_OFF) / 4; u += NWAVES * 64) ((LAS unsigned*)(F.lds + LDSCTL_OFF))[u] = 0u;
    __syncthreads();
    XcdBarrier bar; bar.bar = (unsigned*)(F.ctl + CW_BAR); bar.x = 0; bar.st = nullptr;
    if (N_LAUNCHES == 1) bar = xcd_barrier_post((unsigned*)(F.ctl + CW_BAR), F.MISC + 8);
#define GRID_BAR() do { if (N_LAUNCHES == 1) xcd_barrier(bar, F.wave); } while (0)
    unsigned long long tp0 = 0, tpa = 0, tpb = 0; (void)tp0;
    const int lo = args.ph_lo, hi = args.ph_hi;
#define IN(k) (lo <= (k) && (k) < hi)
#define BOTH(k) (IN(k) && IN((k) + 1))

    if (IN(0)) { if constexpr (0 == TPA || 0 == TPB) tp0 = __builtin_amdgcn_s_memrealtime(); run_phase<0>(F); if constexpr (PH_REPS[0] > 1) { GRID_BAR(); run_phase<0>(F); } if constexpr (PH_REPS[0] > 2) { GRID_BAR(); run_phase<0>(F); } if (BOTH(0)) GRID_BAR(); if constexpr (0 == TPA) tpa = __builtin_amdgcn_s_memrealtime() - tp0; if constexpr (0 == TPB) tpb = __builtin_amdgcn_s_memrealtime() - tp0; }
    if (IN(1)) { if constexpr (1 == TPA || 1 == TPB) tp0 = __builtin_amdgcn_s_memrealtime(); run_phase<1>(F); if constexpr (PH_REPS[1] > 1) { GRID_BAR(); run_phase<1>(F); } if constexpr (PH_REPS[1] > 2) { GRID_BAR(); run_phase<1>(F); } if (BOTH(1)) GRID_BAR(); if constexpr (1 == TPA) tpa = __builtin_amdgcn_s_memrealtime() - tp0; if constexpr (1 == TPB) tpb = __builtin_amdgcn_s_memrealtime() - tp0; }
    if (IN(2)) { if constexpr (2 == TPA || 2 == TPB) tp0 = __builtin_amdgcn_s_memrealtime(); run_phase<2>(F); if constexpr (PH_REPS[2] > 1) { GRID_BAR(); run_phase<2>(F); } if constexpr (PH_REPS[2] > 2) { GRID_BAR(); run_phase<2>(F); } if (BOTH(2)) GRID_BAR(); if constexpr (2 == TPA) tpa = __builtin_amdgcn_s_memrealtime() - tp0; if constexpr (2 == TPB) tpb = __builtin_amdgcn_s_memrealtime() - tp0; }
    if (IN(3)) { if constexpr (3 == TPA || 3 == TPB) tp0 = __builtin_amdgcn_s_memrealtime(); run_phase<3>(F); if constexpr (PH_REPS[3] > 1) { GRID_BAR(); run_phase<3>(F); } if constexpr (PH_REPS[3] > 2) { GRID_BAR(); run_phase<3>(F); } if (BOTH(3)) GRID_BAR(); if constexpr (3 == TPA) tpa = __builtin_amdgcn_s_memrealtime() - tp0; if constexpr (3 == TPB) tpb = __builtin_amdgcn_s_memrealtime() - tp0; }
    if (IN(4)) { if constexpr (4 == TPA || 4 == TPB) tp0 = __builtin_amdgcn_s_memrealtime(); run_phase<4>(F); if constexpr (PH_REPS[4] > 1) { GRID_BAR(); run_phase<4>(F); } if constexpr (PH_REPS[4] > 2) { GRID_BAR(); run_phase<4>(F); } if (BOTH(4)) GRID_BAR(); if constexpr (4 == TPA) tpa = __builtin_amdgcn_s_memrealtime() - tp0; if constexpr (4 == TPB) tpb = __builtin_amdgcn_s_memrealtime() - tp0; }
    if (IN(5)) { if constexpr (5 == TPA || 5 == TPB) tp0 = __builtin_amdgcn_s_memrealtime(); run_phase<5>(F); if constexpr (PH_REPS[5] > 1) { GRID_BAR(); run_phase<5>(F); } if constexpr (PH_REPS[5] > 2) { GRID_BAR(); run_phase<5>(F); } if (BOTH(5)) GRID_BAR(); if constexpr (5 == TPA) tpa = __builtin_amdgcn_s_memrealtime() - tp0; if constexpr (5 == TPB) tpb = __builtin_amdgcn_s_memrealtime() - tp0; }
    if (IN(6)) { if constexpr (6 == TPA || 6 == TPB) tp0 = __builtin_amdgcn_s_memrealtime(); run_phase<6>(F); if constexpr (PH_REPS[6] > 1) { GRID_BAR(); run_phase<6>(F); } if constexpr (PH_REPS[6] > 2) { GRID_BAR(); run_phase<6>(F); } if (BOTH(6)) GRID_BAR(); if constexpr (6 == TPA) tpa = __builtin_amdgcn_s_memrealtime() - tp0; if constexpr (6 == TPB) tpb = __builtin_amdgcn_s_memrealtime() - tp0; }
    if (IN(7)) { if constexpr (7 == TPA || 7 == TPB) tp0 = __builtin_amdgcn_s_memrealtime(); run_phase<7>(F); if constexpr (PH_REPS[7] > 1) { GRID_BAR(); run_phase<7>(F); } if constexpr (PH_REPS[7] > 2) { GRID_BAR(); run_phase<7>(F); } if (BOTH(7)) GRID_BAR(); if constexpr (7 == TPA) tpa = __builtin_amdgcn_s_memrealtime() - tp0; if constexpr (7 == TPB) tpb = __builtin_amdgcn_s_memrealtime() - tp0; }
    if (IN(8)) { if constexpr (8 == TPA || 8 == TPB) tp0 = __builtin_amdgcn_s_memrealtime(); run_phase<8>(F); if constexpr (PH_REPS[8] > 1) { GRID_BAR(); run_phase<8>(F); } if constexpr (PH_REPS[8] > 2) { GRID_BAR(); run_phase<8>(F); } if (BOTH(8)) GRID_BAR(); if constexpr (8 == TPA) tpa = __builtin_amdgcn_s_memrealtime() - tp0; if constexpr (8 == TPB) tpb = __builtin_amdgcn_s_memrealtime() - tp0; }
    if (IN(9)) { if constexpr (9 == TPA || 9 == TPB) tp0 = __builtin_amdgcn_s_memrealtime(); run_phase<9>(F); if constexpr (PH_REPS[9] > 1) { GRID_BAR(); run_phase<9>(F); } if constexpr (PH_REPS[9] > 2) { GRID_BAR(); run_phase<9>(F); } if (BOTH(9)) GRID_BAR(); if constexpr (9 == TPA) tpa = __builtin_amdgcn_s_memrealtime() - tp0; if constexpr (9 == TPB) tpb = __builtin_amdgcn_s_memrealtime() - tp0; }
    if (IN(10)) { if constexpr (10 == TPA || 10 == TPB) tp0 = __builtin_amdgcn_s_memrealtime(); run_phase<10>(F); if constexpr (PH_REPS[10] > 1) { GRID_BAR(); run_phase<10>(F); } if constexpr (PH_REPS[10] > 2) { GRID_BAR(); run_phase<10>(F); } if (BOTH(10)) GRID_BAR(); if constexpr (10 == TPA) tpa = __builtin_amdgcn_s_memrealtime() - tp0; if constexpr (10 == TPB) tpb = __builtin_amdgcn_s_memrealtime() - tp0; }
    if (IN(11)) { if constexpr (11 == TPA || 11 == TPB) tp0 = __builtin_amdgcn_s_memrealtime(); run_phase<11>(F); if constexpr (PH_REPS[11] > 1) { GRID_BAR(); run_phase<11>(F); } if constexpr (PH_REPS[11] > 2) { GRID_BAR(); run_phase<11>(F); } if (BOTH(11)) GRID_BAR(); if constexpr (11 == TPA) tpa = __builtin_amdgcn_s_memrealtime() - tp0; if constexpr (11 == TPB) tpb = __builtin_amdgcn_s_memrealtime() - tp0; }
    if (IN(12)) { if constexpr (12 == TPA || 12 == TPB) tp0 = __builtin_amdgcn_s_memrealtime(); run_phase<12>(F); if constexpr (PH_REPS[12] > 1) { GRID_BAR(); run_phase<12>(F); } if constexpr (PH_REPS[12] > 2) { GRID_BAR(); run_phase<12>(F); } if (BOTH(12)) GRID_BAR(); if constexpr (12 == TPA) tpa = __builtin_amdgcn_s_memrealtime() - tp0; if constexpr (12 == TPB) tpb = __builtin_amdgcn_s_memrealtime() - tp0; }
    if (IN(13)) { if constexpr (13 == TPA || 13 == TPB) tp0 = __builtin_amdgcn_s_memrealtime(); run_phase<13>(F); if constexpr (PH_REPS[13] > 1) { GRID_BAR(); run_phase<13>(F); } if constexpr (PH_REPS[13] > 2) { GRID_BAR(); run_phase<13>(F); } if (BOTH(13)) GRID_BAR(); if constexpr (13 == TPA) tpa = __builtin_amdgcn_s_memrealtime() - tp0; if constexpr (13 == TPB) tpb = __builtin_amdgcn_s_memrealtime() - tp0; }
    if constexpr (TPA >= 0 || TPB >= 0) {
        if (blockIdx.x == 0 && F.wave == 0) { const unsigned long long ua = (tpa + 500ull) / 1000ull, ub = (tpb + 500ull) / 1000ull, extra = ua * 100000ull + ub * 1000ull, t1 = __builtin_amdgcn_s_memrealtime();
            while (__builtin_amdgcn_s_memrealtime() - t1 < extra) __builtin_amdgcn_s_sleep(16); }
    }
#undef IN
#undef BOTH
}

extern "C" void kernel_launch(void* const* d_in, const int* in_sizes, int n_in, void* d_out, int out_size, void* d_ws, size_t ws_size, hipStream_t stream) {
    static int grid = 0;
    if (grid == 0) {
        if (n_in != 26 || out_size != T * D || ws_size < WS_END) { fprintf(stderr, "kernel_launch: unexpected shapes: n_in %d out %d ws %zu (need %zu)\n", n_in, out_size, ws_size, (size_t)WS_END); grid = -1; return; }
        int dev = 0, cus = 0, per_cu = 0;
        if (hipGetDevice(&dev) != hipSuccess || hipDeviceGetAttribute(&cus, hipDeviceAttributeMultiprocessorCount, dev) != hipSuccess) { grid = -1; return; }
        if (hipFuncSetAttribute((const void*)mk_fwd, hipFuncAttributeMaxDynamicSharedMemorySize, LDS_BYTES) != hipSuccess) { fprintf(stderr, "kernel_launch: hipFuncSetAttribute failed\n"); grid = -1; return; }
        if (hipOccupancyMaxActiveBlocksPerMultiprocessor(&per_cu, (const void*)mk_fwd, NWAVES * 64, LDS_BYTES) != hipSuccess || per_cu < 1)
            fprintf(stderr, "kernel_launch: note: occupancy query reports %d workgroups per CU\n", per_cu);
        (void)hipGetLastError();
        grid = cus;
    }
    if (grid < 0) return;
    if (hipMemsetAsync((char*)d_ws + WS_CTL, 0, CTL_ZERO_BYTES, stream) != hipSuccess) return;
    Args a{};
    for (int i = 0; i < 26; ++i) a.in[i] = (const float*)d_in[i];
    a.out = (float*)d_out; a.ws = (unsigned char*)d_ws;
    for (int li = 0; li < N_LAUNCHES; ++li) {
        if (N_LAUNCHES == 1) { a.ph_lo = 0; a.ph_hi = N_PHASES; } else { a.ph_lo = li * N_PHASES / N_LAUNCHES; a.ph_hi = (li + 1) * N_PHASES / N_LAUNCHES; }
        a.li = li;
        hipLaunchKernelGGL(mk_fwd, dim3(grid), dim3(NWAVES * 64), LDS_BYTES, stream, a);
        if (hipPeekAtLastError() != hipSuccess) break;
    }
}
```

```cpp
#include <hip/hip_runtime.h>
#include <cstdio>
#include <cstdint>
namespace pg8 {
#define PG8_LAS __attribute__((address_space(3)))
typedef unsigned short bf16_t;
typedef short bf16x8 __attribute__((ext_vector_type(8)));
typedef float f32x4 __attribute__((ext_vector_type(4)));
typedef unsigned u32x4 __attribute__((ext_vector_type(4)));
constexpr int BM = 256, BK = 64, HALF = 128, HTB = HALF * BK * 2  , STAGE_BYTES = 8 * HTB, NXCD = 8, WGM = 8;

__host__ __device__ __forceinline__ int lds_byte(int r, int c) { const int st = (r >> 4) * 2 + (c >> 5), rr = r & 15, cc = c & 31, ob = rr * 64 + cc * 2; return st * 1024 + (ob ^ (((ob >> 9) & 1) << 5)); }
__host__ __device__ __forceinline__ void stage_rc(int b, int& R, int& C) { const int st = b / 1024, sb = b % 1024, swz = sb ^ (((sb >> 9) & 1) << 5); R = (st >> 1) * 16 + swz / 64; C = (st & 1) * 32 + (swz % 64) / 2; }
__host__ __device__ __forceinline__ int perm32(int rho) { const int n = rho >> 4, i = rho & 15; return 8 * (i >> 2) + 4 * n + (i & 3); }

__device__ __forceinline__ int mk_lane() { int l; asm volatile("v_mbcnt_lo_u32_b32 %0, -1, 0\n\tv_mbcnt_hi_u32_b32 %0, -1, %0" : "=v"(l)); return l; }
struct Unit { int pm, pn; };
struct Gemm { const bf16_t* A; const bf16_t* Bt; int M, N, K; };

struct StaticOrder {
    int nM, nN, nwg, G, c;
    __host__ __device__ void init(int M, int N, int G_, int c_) { nM = M / BM; nN = N / BM; nwg = nM * nN; G = G_; c = c_; }
    __host__ __device__ bool next(int i, Unit& u) const {
        const long L = (long)i * G + c; if (L >= nwg) return false;
        int wgid = (int)L; { const int q = nwg / NXCD, r = nwg % NXCD, xcd = wgid % NXCD, off = wgid / NXCD; wgid = (xcd < r ? xcd * (q + 1) : r * (q + 1) + (xcd - r) * q) + off; }
        const int nig = WGM * nN, gid = wgid / nig, fm = gid * WGM, gsz = (nM - fm) < WGM ? (nM - fm) : WGM;
        u.pm = fm + ((wgid % nig) % gsz); u.pn = (wgid % nig) / gsz; return true;
    }
    __device__ __forceinline__ void a_ready(const Unit&) const {}
    __device__ __forceinline__ void done(const Unit&) const {}
};

__device__ __forceinline__ unsigned cvt_pk_bf16(float lo, float hi) { unsigned r; asm volatile("v_cvt_pk_bf16_f32 %0, %1, %2" : "=v"(r) : "v"(lo), "v"(hi)); return r; }
typedef float f32x2 __attribute__((ext_vector_type(2)));
__device__ __forceinline__ f32x2 gelu_pk(f32x2 v) {
    const f32x2 av = __builtin_elementwise_abs(v), d = av * 0.2316418882f + 1.0f;
    f32x2 t; t.x = __builtin_amdgcn_rcpf(d.x); t.y = __builtin_amdgcn_rcpf(d.y);
    f32x2 q = t * 0.5307027145f + (-0.7265760135f); q = q * t + 0.7107068705f; q = q * t + (-0.142248368f); q = q * t + 0.127414796f; q = q * t;
    const f32x2 s = (v * v) * (-0.72134752044f);
    f32x2 e; e.x = __builtin_amdgcn_exp2f(s.x); e.y = __builtin_amdgcn_exp2f(s.y);
    const f32x2 m = v * (q * e), r = v - m;
    f32x2 o; o.x = v.x < 0.f ? m.x : r.x; o.y = v.y < 0.f ? m.y : r.y; return o;
}

template <int ACT  > struct EpiBf16 {
    static constexpr bool PERM = true, AFTER_DRAIN = false; static_assert(ACT == 0 || ACT == 1, "EpiBf16: ACT is 0 (none) or 1 (gelu_pk)");
    bf16_t* O; int ldc; const float* bias; int split_cols; size_t split_stride; float scale0;
    __device__ __forceinline__ void operator()(const f32x4 (&acc)[2][2][4][2], const Unit& u, int wr, int wc, int fr, int fq) const {
        const int row0 = u.pm * BM + wr * 64 + fr; int colt = u.pn * BM; bf16_t* base = O;
        float sc = 1.f; if (split_cols) { const int t = colt / split_cols; base += (size_t)t * split_stride; colt -= t * split_cols; if (t == 0) sc = scale0; }
        const int col0 = colt + wc * 32 + 8 * fq, bcol0 = u.pn * BM + wc * 32 + 8 * fq;
        f32x4 bv[2][2];
#pragma unroll
        for (int bj = 0; bj < 2; ++bj)
#pragma unroll
            for (int n = 0; n < 2; ++n) bv[bj][n] = bias ? *(const f32x4*)(bias + bcol0 + bj * HALF + 4 * n) : (f32x4){0.f, 0.f, 0.f, 0.f};
#pragma unroll
        for (int ai = 0; ai < 2; ++ai)
#pragma unroll
            for (int m = 0; m < 4; ++m) { bf16_t* rowp = base + (size_t)(row0 + ai * HALF + m * 16) * ldc + col0;
#pragma unroll
                for (int bj = 0; bj < 2; ++bj) { f32x4 v0 = acc[ai][bj][m][0] + bv[bj][0], v1 = acc[ai][bj][m][1] + bv[bj][1];
                    if (ACT == 1) { f32x2 a = gelu_pk((f32x2){v0[0], v0[1]}), b = gelu_pk((f32x2){v0[2], v0[3]}), c = gelu_pk((f32x2){v1[0], v1[1]}), d = gelu_pk((f32x2){v1[2], v1[3]});
                        v0 = (f32x4){a.x, a.y, b.x, b.y}; v1 = (f32x4){c.x, c.y, d.x, d.y}; }
                    v0 = v0 * sc; v1 = v1 * sc; u32x4 w; w.x = cvt_pk_bf16(v0[0], v0[1]); w.y = cvt_pk_bf16(v0[2], v0[3]); w.z = cvt_pk_bf16(v1[0], v1[1]); w.w = cvt_pk_bf16(v1[2], v1[3]);
                    *(u32x4*)(rowp + bj * HALF) = w; } }
    }
};
__device__ __forceinline__ float sigmoidf_(float x) { return __builtin_amdgcn_rcpf(1.0f + __expf(-x)); }
struct EpiResid {
    static constexpr bool PERM = false, AFTER_DRAIN = false;
    const float* base; float* out; int ldc; const float* gvec;
    __device__ __forceinline__ void operator()(const f32x4 (&acc)[2][2][4][2], const Unit& u, int wr, int wc, int fr, int fq) const {
        const int row0 = u.pm * BM + wr * 64 + fr, col0 = u.pn * BM + wc * 32 + 4 * fq;
        f32x4 gv[2][2];
#pragma unroll
        for (int bj = 0; bj < 2; ++bj)
#pragma unroll
            for (int n = 0; n < 2; ++n) gv[bj][n] = *(const __attribute__((address_space(1))) f32x4*)(gvec + col0 + bj * HALF + n * 16);
#pragma unroll
        for (int ai = 0; ai < 2; ++ai)
#pragma unroll
            for (int m = 0; m < 4; ++m) { const size_t off = (size_t)(row0 + ai * HALF + m * 16) * ldc + col0;
#pragma unroll
                for (int bj = 0; bj < 2; ++bj)
#pragma unroll
                    for (int n = 0; n < 2; ++n) { const f32x4 bs = *(const __attribute__((address_space(1))) f32x4*)(base + off + bj * HALF + n * 16);
                        *(__attribute__((address_space(1))) f32x4*)(out + off + bj * HALF + n * 16) = bs + gv[bj][n] * acc[ai][bj][m][n]; }
                if (m & 1) asm volatile("" ::: "memory"); }
    }
};
struct EpiSwiglu {
    static constexpr bool PERM = true, AFTER_DRAIN = false;
    bf16_t* O; int ldc;
    __device__ __forceinline__ void operator()(const f32x4 (&acc)[2][2][4][2], const Unit& u, int wr, int wc, int fr, int fq) const {
        const int row0 = u.pm * BM + wr * 64 + fr, col0 = u.pn * HALF + wc * 32 + 8 * fq;
#pragma unroll
        for (int ai = 0; ai < 2; ++ai)
#pragma unroll
            for (int m = 0; m < 4; ++m) { bf16_t* rowp = O + (size_t)(row0 + ai * HALF + m * 16) * ldc + col0;
                f32x4 h0, h1;
#pragma unroll
                for (int j = 0; j < 4; ++j) { const float g0 = acc[ai][0][m][0][j], g1 = acc[ai][0][m][1][j];
                    h0[j] = g0 * sigmoidf_(g0) * acc[ai][1][m][0][j]; h1[j] = g1 * sigmoidf_(g1) * acc[ai][1][m][1][j]; }
                u32x4 w; w.x = cvt_pk_bf16(h0[0], h0[1]); w.y = cvt_pk_bf16(h0[2], h0[3]); w.z = cvt_pk_bf16(h1[0], h1[1]); w.w = cvt_pk_bf16(h1[2], h1[3]);
                *(__attribute__((address_space(1))) u32x4*)rowp = w; }
    }
};
template <int CTRL> __device__ __forceinline__ float dpp_f(float old, float src) { return __builtin_bit_cast(float, __builtin_amdgcn_update_dpp(__builtin_bit_cast(int, old), __builtin_bit_cast(int, src), CTRL, 0xf, 0xf, false)); }
struct EpiLora {
    static constexpr bool PERM = true, AFTER_DRAIN = false;
    unsigned char* PKB; bf16_t* KD; const float* kbuf; const float* kkbuf; const float* rbuf; const float* w0; const float* a0; const float* k_a; int TT;
    __device__ __forceinline__ void operator()(const f32x4 (&acc)[2][2][4][2], const Unit& u, int wr, int wc, int fr, int fq) const {
        typedef __attribute__((address_space(1))) f32x4 gf4; typedef const __attribute__((address_space(1))) f32x4 cgf4;
        const int d = u.pn >> 4, cg = u.pn & 15;
        const int c8 = cg * HALF + wc * 32 + 8 * fq, h = c8 >> 6, ch = c8 & 63;
        const int row0 = u.pm * BM + wr * 64 + fr;
        f32x4 w0v[2], a0v[2], kav[2];
#pragma unroll
        for (int n = 0; n < 2; ++n) { w0v[n] = *(cgf4*)(w0 + d * 2048 + c8 + 4 * n); a0v[n] = *(cgf4*)(a0 + d * 2048 + c8 + 4 * n); kav[n] = *(cgf4*)(k_a + c8 + 4 * n); }
        f32x4 kq[2][2], kkq[2][2], rq[2][2];
        { const size_t fo0 = (size_t)row0 * 2048 + c8;
#pragma unroll
          for (int n = 0; n < 2; ++n) { kq[0][n] = *(cgf4*)(kbuf + fo0 + 4 * n); kkq[0][n] = *(cgf4*)(kkbuf + fo0 + 4 * n); rq[0][n] = *(cgf4*)(rbuf + fo0 + 4 * n); } }
#pragma unroll
        for (int it = 0; it < 8; ++it) {
            const int ai = it >> 2, m = it & 3;
            if (it + 1 < 8) { const size_t fo1 = (size_t)(row0 + ((it + 1) >> 2) * HALF + ((it + 1) & 3) * 16) * 2048 + c8;
#pragma unroll
                for (int n = 0; n < 2; ++n) { kq[(it + 1) & 1][n] = *(cgf4*)(kbuf + fo1 + 4 * n); kkq[(it + 1) & 1][n] = *(cgf4*)(kkbuf + fo1 + 4 * n); rq[(it + 1) & 1][n] = *(cgf4*)(rbuf + fo1 + 4 * n); } }
            asm volatile("" ::: "memory");
            const int tok = row0 + ai * HALF + m * 16;
            const int tau = d == 0 ? (tok & 15) : 15 - (tok & 15);
            unsigned char* rec = PKB + ((size_t)(d * 32 + h) * (TT / 16) + (tok >> 4)) * 8448;
            const size_t fo = (size_t)tok * 2048 + c8;
            f32x4 g[2]; u32x4 kw;
#pragma unroll
            for (int n = 0; n < 2; ++n) {
                f32x4 gp;
                const f32x4 x = acc[ai][0][m][n] + w0v[n];
#pragma unroll
                for (int j = 0; j < 4; ++j) { float w = __expf(-0.60653066f * sigmoidf_(x[j]));
                    if (d == 0) { w *= dpp_f<0x111>(1.0f, w); w *= dpp_f<0x112>(1.0f, w); w *= dpp_f<0x114>(1.0f, w); w *= dpp_f<0x118>(1.0f, w); g[n][j] = w; gp[j] = dpp_f<0x111>(1.0f, w); }
                    else        { w *= dpp_f<0x101>(1.0f, w); w *= dpp_f<0x102>(1.0f, w); w *= dpp_f<0x104>(1.0f, w); w *= dpp_f<0x108>(1.0f, w); g[n][j] = w; gp[j] = dpp_f<0x101>(1.0f, w); } }
                const f32x4 xa = acc[ai][1][m][n] + a0v[n];
                const f32x4 k4 = kq[it & 1][n], kk4 = kkq[it & 1][n], r4 = rq[it & 1][n];
                f32x4 at, rt, bt, kdt; float kdv[4];
#pragma unroll
                for (int j = 0; j < 4; ++j) { const float a = sigmoidf_(xa[j]), rg = __builtin_amdgcn_rcpf(g[n][j]);
                    kdv[j] = k4[j] * (1.0f + (a - 1.0f) * kav[n][j]);
                    at[j] = -kk4[j] * gp[j]; rt[j] = r4[j] * g[n][j]; bt[j] = kk4[j] * a * rg; kdt[j] = kdv[j] * rg; }
                const int chn = ch + 4 * n;
                {
                    const int p0 = ((((chn >> 5) * 2 + ((chn >> 4) & 1)) * 2 + n) * 8 + ((chn >> 3) & 1) * 4);
                    typedef unsigned u32x2 __attribute__((ext_vector_type(2)));
                    __attribute__((address_space(1))) unsigned char* rp = (__attribute__((address_space(1))) unsigned char*)rec + (tau * 64 + p0) * 2;
                    u32x2 w;
                    w.x = cvt_pk_bf16(at[0], at[1]); w.y = cvt_pk_bf16(at[2], at[3]); *(__attribute__((address_space(1))) u32x2*)(rp) = w;
                    w.x = cvt_pk_bf16(rt[0], rt[1]); w.y = cvt_pk_bf16(rt[2], rt[3]); *(__attribute__((address_space(1))) u32x2*)(rp + 2048) = w;
                    w.x = cvt_pk_bf16(bt[0], bt[1]); w.y = cvt_pk_bf16(bt[2], bt[3]); *(__attribute__((address_space(1))) u32x2*)(rp + 4096) = w;
                    w.x = cvt_pk_bf16(kdt[0], kdt[1]); w.y = cvt_pk_bf16(kdt[2], kdt[3]); *(__attribute__((address_space(1))) u32x2*)(rp + 6144) = w; }
                if (n == 0) { kw.x = cvt_pk_bf16(kdv[0], kdv[1]); kw.y = cvt_pk_bf16(kdv[2], kdv[3]); } else { kw.z = cvt_pk_bf16(kdv[0], kdv[1]); kw.w = cvt_pk_bf16(kdv[2], kdv[3]); }
            }
            *(__attribute__((address_space(1))) u32x4*)(KD + (size_t)d * TT * 2048 + fo) = kw;
            if (fr == (d == 0 ? 15 : 0)) { float* ge = (float*)(rec + 8192) + ch; *(gf4*)ge = g[0]; *(gf4*)(ge + 4) = g[1]; }
        }
    }
};
template <class Epi, class Sched, bool ALIGN_EPI = false, bool SP2 = false>
__device__ __forceinline__ void gemm_phase(PG8_LAS unsigned char* lds, const Gemm g, const Sched& S, const Epi& E, const int wid) {
    const int lane = mk_lane(), tid = wid * 64 + lane, wr = wid >> 2, wc = wid & 3, fr = lane & 15, fq = lane >> 4;
    const int K = g.K, nt = K / BK;
    unsigned voffA[2], voffB[2];
#pragma unroll
    for (int i = 0; i < 2; ++i) { int R, C; stage_rc(tid * 16 + i * 8192, R, C); const int Rb = Epi::PERM ? ((R & ~31) + perm32(R & 31)) : R;
        voffA[i] = (unsigned)(R * K + C) * 2u; voffB[i] = (unsigned)(Rb * K + C) * 2u; }
    const size_t kstep = (size_t)(BK * 2);
    const size_t hstep = (size_t)HALF * K * 2;
    const size_t tstep = 2 * hstep;
    const unsigned ldsw = (unsigned)wid * 1024u;
    const int aoff = lds_byte(wr * 64 + fr, fq * 8), boff = lds_byte(wc * 32 + fr, fq * 8);
#define PG8_SA(b, h) (((b) * 2 + (h)) * HTB)
#define PG8_SB(b, h) ((4 + (b) * 2 + (h)) * HTB)
#define PG8_STAGE(bufoff, gbase, voff) do { _Pragma("unroll") for (int _i = 0; _i < 2; ++_i) \
        __builtin_amdgcn_global_load_lds((const unsigned*)((const char*)(gbase) + (voff)[_i]), (PG8_LAS unsigned*)(lds + (bufoff) + ldsw + _i * 8192), 16, 0, 0); } while (0)
#define PG8_LDA(dst, b, h) do { _Pragma("unroll") for (int m = 0; m < 4; ++m) _Pragma("unroll") for (int k = 0; k < 2; ++k) dst[m][k] = *(const PG8_LAS bf16x8*)(lds + PG8_SA(b, h) + aoff + m * 2048 + k * 1024); } while (0)
#define PG8_LDB(dst, b, h) do { _Pragma("unroll") for (int n = 0; n < 2; ++n) _Pragma("unroll") for (int k = 0; k < 2; ++k) dst[n][k] = *(const PG8_LAS bf16x8*)(lds + PG8_SB(b, h) + boff + n * 2048 + k * 1024); } while (0)
#define PG8_MMA(ai, bj, At, Bt) do { __builtin_amdgcn_s_setprio(1); _Pragma("unroll") for (int m = 0; m < 4; ++m) _Pragma("unroll") for (int n = 0; n < 2; ++n) _Pragma("unroll") for (int k = 0; k < 2; ++k) \
        acc[ai][bj][m][n] = __builtin_amdgcn_mfma_f32_16x16x32_bf16(Bt[n][k], At[m][k], acc[ai][bj][m][n], 0, 0, 0); __builtin_amdgcn_s_setprio(0); } while (0)
#define PG8_WAIT_V(n) asm volatile("s_waitcnt vmcnt(" #n ")" ::: "memory")
#define PG8_WAIT_L(n) asm volatile("s_waitcnt lgkmcnt(" #n ")" ::: "memory")
#define PG8_BAR __builtin_amdgcn_s_barrier()
#define PG8_SCHED __builtin_amdgcn_sched_barrier(0)
    Unit cur, nxt; int ui = 0;
    if (!S.next(0, cur)) return;
    f32x4 acc[2][2][4][2];
#pragma unroll
    for (int a = 0; a < 2; ++a)
#pragma unroll
        for (int b = 0; b < 2; ++b)
#pragma unroll
            for (int m = 0; m < 4; ++m)
#pragma unroll
                for (int n = 0; n < 2; ++n) acc[a][b][m][n] = (f32x4){0.f, 0.f, 0.f, 0.f};
    bf16x8 At[4][2], B0[2][2], B1[2][2];
    const char* cA = (const char*)g.A + (size_t)cur.pm * tstep; const char* cB = (const char*)g.Bt + (size_t)cur.pn * tstep;
    S.a_ready(cur);
    if constexpr (SP2) {
        PG8_STAGE(PG8_SB(0, 0), cB, voffB); PG8_STAGE(PG8_SB(0, 1), cB + hstep, voffB); PG8_STAGE(PG8_SA(0, 0), cA, voffA); PG8_STAGE(PG8_SA(0, 1), cA + hstep, voffA);
        if (wr == 1) PG8_BAR;
        PG8_WAIT_V(2); PG8_BAR;
        PG8_STAGE(PG8_SB(1, 0), cB + kstep, voffB); PG8_STAGE(PG8_SA(1, 0), cA + kstep, voffA); PG8_STAGE(PG8_SB(1, 1), cB + hstep + kstep, voffB);
        PG8_WAIT_V(6); PG8_BAR;
    } else {
        PG8_STAGE(PG8_SB(0, 0), cB, voffB); PG8_STAGE(PG8_SA(0, 0), cA, voffA); PG8_STAGE(PG8_SB(0, 1), cB + hstep, voffB); PG8_STAGE(PG8_SA(0, 1), cA + hstep, voffA);
        if (wr == 1) PG8_BAR;
        PG8_WAIT_V(4); PG8_BAR;
        PG8_STAGE(PG8_SB(1, 0), cB + kstep, voffB); PG8_STAGE(PG8_SA(1, 0), cA + kstep, voffA); PG8_STAGE(PG8_SB(1, 1), cB + hstep + kstep, voffB);
        PG8_WAIT_V(6); PG8_BAR;
    }
    for (;;) {
        const bool has_next = S.next(ui + 1, nxt);
        const char* nA = has_next ? (const char*)g.A + (size_t)nxt.pm * tstep : cA; const char* nB = has_next ? (const char*)g.Bt + (size_t)nxt.pn * tstep : cB;
        for (int t = 0; t < nt; t += 2) {
            const bool last = (t == nt - 2);
            const char* a1 = cA + (size_t)(t + 1) * kstep;
            const char* a2 = last ? nA : cA + (size_t)(t + 2) * kstep; const char* b2 = last ? nB : cB + (size_t)(t + 2) * kstep;
            const char* a3 = a2 + kstep; const char* b3 = b2 + kstep;
            if (last && has_next) S.a_ready(nxt);
            if constexpr (SP2) {
            PG8_LDB(B0, 0, 0); PG8_LDB(B1, 0, 1); PG8_SCHED; PG8_LDA(At, 0, 0); PG8_STAGE(PG8_SA(1, 1), a1 + hstep, voffA);
            PG8_WAIT_V(8); PG8_WAIT_L(0); PG8_BAR; PG8_MMA(0, 0, At, B0); PG8_MMA(0, 1, At, B1); PG8_BAR; PG8_SCHED;
            PG8_LDA(At, 0, 1); PG8_STAGE(PG8_SB(0, 0), b2, voffB); PG8_STAGE(PG8_SB(0, 1), b2 + hstep, voffB); PG8_STAGE(PG8_SA(0, 0), a2, voffA);
            PG8_WAIT_V(8); PG8_WAIT_L(0); PG8_BAR; PG8_MMA(1, 0, At, B0); PG8_MMA(1, 1, At, B1); PG8_BAR; PG8_SCHED;
            PG8_LDB(B0, 1, 0); PG8_LDB(B1, 1, 1); PG8_SCHED; PG8_LDA(At, 1, 0); PG8_STAGE(PG8_SA(0, 1), a2 + hstep, voffA);
            PG8_WAIT_V(8); PG8_WAIT_L(0); PG8_BAR; PG8_MMA(0, 0, At, B0); PG8_MMA(0, 1, At, B1); PG8_BAR; PG8_SCHED;
            PG8_LDA(At, 1, 1); PG8_STAGE(PG8_SB(1, 0), b3, voffB); PG8_STAGE(PG8_SB(1, 1), b3 + hstep, voffB); PG8_STAGE(PG8_SA(1, 0), a3, voffA);
            PG8_WAIT_V(8); PG8_WAIT_L(0); PG8_BAR; PG8_MMA(1, 0, At, B0); PG8_MMA(1, 1, At, B1); PG8_BAR; PG8_SCHED;
            } else {
            PG8_LDB(B0, 0, 0); PG8_SCHED; PG8_LDA(At, 0, 0); PG8_STAGE(PG8_SA(1, 1), a1 + hstep, voffA);
            PG8_WAIT_L(8); PG8_BAR; PG8_WAIT_L(0); PG8_MMA(0, 0, At, B0); PG8_BAR; PG8_SCHED;
            PG8_LDB(B1, 0, 1); PG8_STAGE(PG8_SB(0, 0), b2, voffB);
            PG8_BAR; PG8_WAIT_L(0); PG8_MMA(0, 1, At, B1); PG8_BAR;
            PG8_LDA(At, 0, 1); PG8_STAGE(PG8_SA(0, 0), a2, voffA);
            PG8_BAR; PG8_WAIT_L(0); PG8_MMA(1, 0, At, B0); PG8_BAR; PG8_SCHED;
            PG8_STAGE(PG8_SB(0, 1), b2 + hstep, voffB);
            PG8_WAIT_V(6); PG8_BAR; PG8_MMA(1, 1, At, B1); PG8_BAR;
            PG8_LDB(B0, 1, 0); PG8_SCHED; PG8_LDA(At, 1, 0); PG8_STAGE(PG8_SA(0, 1), a2 + hstep, voffA);
            PG8_WAIT_L(8); PG8_BAR; PG8_WAIT_L(0); PG8_MMA(0, 0, At, B0); PG8_BAR; PG8_SCHED;
            PG8_LDB(B1, 1, 1); PG8_STAGE(PG8_SB(1, 0), b3, voffB);
            PG8_BAR; PG8_WAIT_L(0); PG8_MMA(0, 1, At, B1); PG8_BAR;
            PG8_LDA(At, 1, 1); PG8_STAGE(PG8_SA(1, 0), a3, voffA);
            PG8_BAR; PG8_WAIT_L(0); PG8_MMA(1, 0, At, B0); PG8_BAR; PG8_SCHED;
            PG8_STAGE(PG8_SB(1, 1), b3 + hstep, voffB);
            PG8_WAIT_V(6); PG8_BAR; PG8_MMA(1, 1, At, B1); PG8_BAR;
            }
        }
        if constexpr (ALIGN_EPI) { if (wr == 0) PG8_BAR; }
        if constexpr (!Epi::AFTER_DRAIN) { const int l2 = mk_lane(); E(acc, cur, wr, wc, l2 & 15, l2 >> 4); S.done(cur); }
        if (!has_next) break;
#pragma unroll
        for (int a = 0; a < 2; ++a)
#pragma unroll
            for (int b = 0; b < 2; ++b)
#pragma unroll
                for (int m = 0; m < 4; ++m)
#pragma unroll
                    for (int n = 0; n < 2; ++n) acc[a][b][m][n] = (f32x4){0.f, 0.f, 0.f, 0.f};
        cur = nxt; cA = nA; cB = nB; ++ui;
        if constexpr (ALIGN_EPI) { if (wr == 1) PG8_BAR; }
    }
    PG8_WAIT_V(0);
    if constexpr (!ALIGN_EPI) { if (wr == 0) PG8_BAR; }
    PG8_BAR;
    if constexpr (Epi::AFTER_DRAIN) { E.fused(acc, cur, wr, wc, fr, fq, lds, wid, lane); S.done(cur); }
#undef PG8_SA
#undef PG8_SB
#undef PG8_STAGE
#undef PG8_LDA
#undef PG8_LDB
#undef PG8_MMA
#undef PG8_WAIT_V
#undef PG8_WAIT_L
#undef PG8_BAR
#undef PG8_SCHED
}
}

constexpr int NWAVES = 8;
#ifndef MK_N_LAUNCHES
#define MK_N_LAUNCHES 1
#endif
constexpr int N_PHASES = 14;
#ifndef MK_REPS
#define MK_REPS {1,1,1,1,1,1,1,1,1,1,1,1,1,1}
#endif
constexpr int PH_REPS[14] = MK_REPS;
#ifndef MK_TPA
#define MK_TPA -1
#endif
#ifndef MK_TPB
#define MK_TPB -1
#endif
constexpr int TPA = MK_TPA, TPB = MK_TPB;
constexpr int N_LAUNCHES = MK_N_LAUNCHES;

constexpr int D = 4096, T = 8192, CTXL = 256, TT = T + CTXL;
constexpr int DR = 2048, DC = 2048, NH = 32, HS = 64;
constexpr int OFF_K = 0, OFF_V = 2048, OFF_WL = 4096, OFF_AL = 4192, OFF_R = 4288, OFF_GL = 6336, RWKV_COLS = 6592;
constexpr int OFF_CB = 6592, OFF_CC = 8640, OFF_CX = 10688, IN_COLS = 12736, NZ = 12800;
constexpr int NCTXZ = 4352;
constexpr int DFF = 11008, NGU = 2 * DFF;
constexpr int NLORA = 8192, KLORA = 256, KGATE = 256;
constexpr int MODN = 6 * D;
constexpr int NKC = 16;
constexpr float NORM_EPS = 1e-6f, LNX_EPS = 64e-5f;
constexpr int CHUNK = 256, NCHUNK = 33;

constexpr size_t MiB = 1u << 20;
constexpr size_t WS_CTL = 0, CTL_ZERO_BYTES = 1 * MiB;
constexpr size_t WS_MODP = 1 * MiB;
constexpr size_t WS_MODV = 5 * MiB;
constexpr size_t WS_WLORA = 6 * MiB;
constexpr size_t WS_WGATE = 10 * MiB;
constexpr size_t WS_ALORA = 11 * MiB;
constexpr size_t WS_AGATE = 16 * MiB;
constexpr size_t WS_WOUT = 20 * MiB;
constexpr size_t WS_WGU = 52 * MiB;
constexpr size_t WS_WDN = 224 * MiB;
constexpr size_t WS_WIN = 310 * MiB;
constexpr size_t WS_PU = 310 * MiB;
constexpr size_t WS_SST = 374 * MiB;
constexpr size_t WS_A1 = 410 * MiB;
constexpr size_t WS_CAT = 410 * MiB;
constexpr size_t WS_Z = 476 * MiB;
constexpr size_t WS_YS = 476 * MiB;
constexpr size_t WS_KD = 604 * MiB;
constexpr size_t WS_GE = 670 * MiB;
constexpr size_t WS_KBUF = 683 * MiB;
constexpr size_t WS_KKBUF = 749 * MiB;
constexpr size_t WS_RBUF = 815 * MiB;
constexpr size_t WS_VBUF = 881 * MiB;
constexpr size_t WS_X1 = 683 * MiB;
constexpr size_t WS_PK = 947 * MiB;
constexpr size_t WS_ACT = 947 * MiB;
constexpr size_t WS_G = 1475 * MiB;
constexpr size_t WS_END = 1507 * MiB;
static_assert(WS_MODP + (size_t)NKC * 2 * MODN * 4 <= WS_MODV && WS_ALORA + (size_t)TT * 256 * 2 <= WS_AGATE && WS_WGU + (size_t)NGU * D * 2 <= WS_WDN && WS_WDN + (size_t)D * DFF * 2 <= WS_WIN, "ws map 1");
static_assert(WS_WIN + (size_t)NZ * D * 2 <= WS_A1 && WS_SST + (size_t)64 * NCHUNK * 16384 <= WS_A1 && WS_A1 + (size_t)TT * D * 2 <= WS_Z && WS_Z + (size_t)TT * NZ * 2 <= WS_KBUF, "ws map 2");
static_assert(WS_YS + (size_t)2 * T * 2048 * 4 <= WS_KD && WS_KD + (size_t)2 * TT * 2048 * 2 <= WS_GE && WS_GE + (size_t)64 * (TT / 16) * 256 <= WS_KBUF, "ws map 3");
static_assert(WS_KBUF + (size_t)TT * 2048 * 4 <= WS_KKBUF && WS_KKBUF + (size_t)TT * 2048 * 4 <= WS_RBUF && WS_RBUF + (size_t)TT * 2048 * 4 <= WS_VBUF && WS_VBUF + (size_t)TT * 2048 * 4 <= WS_PK, "ws map 4");
static_assert(WS_X1 + (size_t)T * D * 4 <= WS_RBUF && WS_PK + (size_t)64 * TT * 1024 <= WS_G && WS_ACT + (size_t)T * DFF * 2 <= WS_G && WS_G + (size_t)T * 2048 * 2 <= WS_END && WS_CAT + (size_t)T * D * 2 <= WS_Z, "ws map 5");
constexpr int CW_TMO = 0;
constexpr int CW_BAR = 4096;

constexpr int RING_OFF = 0, RING_BYTES = 131072;
constexpr int LDSCTL_OFF = RING_BYTES, MISC_OFF = LDSCTL_OFF + 320;
constexpr int LDS_BYTES = 147456;
static_assert(MISC_OFF + 128 <= LDS_BYTES, "LDS map");

#define GAS __attribute__((address_space(1)))
#define LAS __attribute__((address_space(3)))
typedef unsigned short bf16;
typedef unsigned v4u __attribute__((ext_vector_type(4)));
typedef unsigned v2u __attribute__((ext_vector_type(2)));
typedef float f32x4 __attribute__((ext_vector_type(4)));
typedef GAS unsigned gu32;
#define RLX_AGENT __ATOMIC_RELAXED, __HIP_MEMORY_SCOPE_AGENT
#define LDS_WAIT() asm volatile("s_waitcnt lgkmcnt(0)" ::: "memory")
#define VM_WAIT() asm volatile("s_waitcnt vmcnt(0)" ::: "memory")
__device__ __forceinline__ unsigned f2bf(float f) { unsigned u = __builtin_bit_cast(unsigned, f); return (u + 0x7fffu + ((u >> 16) & 1u)) >> 16; }
__device__ __forceinline__ unsigned pk2(float lo, float hi) { return f2bf(lo) | (f2bf(hi) << 16); }
__device__ __forceinline__ float bflo(unsigned w) { return __builtin_bit_cast(float, w << 16); }
__device__ __forceinline__ float bfhi(unsigned w) { return __builtin_bit_cast(float, w & 0xffff0000u); }
__device__ __forceinline__ float sigm(float x) { return 1.0f / (1.0f + __expf(-x)); }

#define XB_TMO      128
#define XB_XCNT(j)  (256  + 64 * (j))
#define XB_XSUB(j)  (1280 + 64 * (j))
#define XB_XGEN(j)  (2304 + 64 * (j))
#define XB_TOP      3328
#define XB_TOPGEN   3392
#define XCD_BAR_WORDS 3456
#define XB_SPIN_CAP (1u << 18)
__device__ __forceinline__ unsigned xb_ld(unsigned* p)              { return __hip_atomic_load(p, __ATOMIC_RELAXED, __HIP_MEMORY_SCOPE_AGENT); }
__device__ __forceinline__ unsigned xb_add(unsigned* p, unsigned v) { return __hip_atomic_fetch_add(p, v, __ATOMIC_RELAXED, __HIP_MEMORY_SCOPE_AGENT); }
__device__ __forceinline__ unsigned xb_xcc_id() { return (unsigned)__builtin_amdgcn_s_getreg((3 << 11) | 20) & 0xFu; }
#define XB_SPIN(cond, bar) do { unsigned _sp = 0; while (cond) { __builtin_amdgcn_s_sleep(1); \
    if ((++_sp & 255u) == 0u) { if (xb_ld(&(bar)[XB_TMO])) break; if (_sp > XB_SPIN_CAP) { atomicAdd(&(bar)[XB_TMO], 1u); break; } } } } while (0)
struct XcdBarrier { unsigned* bar; unsigned x; volatile LAS unsigned* st; };
__device__ __forceinline__ XcdBarrier xcd_barrier_post(unsigned* bar, volatile LAS unsigned* st) {
    XcdBarrier b; b.bar = bar; b.x = xb_xcc_id(); b.st = st;
    if (threadIdx.x == 0) (void)xb_add(&bar[XB_XCNT(b.x)], 1u);
    return b;
}
__device__ __forceinline__ void xcd_barrier_complete(unsigned* bar, unsigned x, unsigned& nloc, unsigned& nx) {
    const unsigned G = gridDim.x * gridDim.y * gridDim.z;
    unsigned sum, cnt, mine, sp = 0u;
    for (;;) {
        sum = 0u; cnt = 0u; mine = 0u;
#pragma unroll
        for (unsigned j = 0; j < 16; ++j) { const unsigned c = xb_ld(&bar[XB_XCNT(j)]); sum += c; cnt += (c > 0u) ? 1u : 0u; mine = (j == x) ? c : mine; }
        if (sum == G) break;
        __builtin_amdgcn_s_sleep(1);
        if ((++sp & 255u) == 0u) { if (xb_ld(&bar[XB_TMO])) break; if (sp > XB_SPIN_CAP) { atomicAdd(&bar[XB_TMO], 1u); break; } }
    }
    nloc = mine > 0u ? mine : 1u; nx = cnt > 0u ? cnt : 1u;
}
__device__ __forceinline__ void xcd_barrier(const XcdBarrier& b, const int wave) {
    asm volatile("s_waitcnt vmcnt(0)" ::: "memory");
    __syncthreads();
    if (wave == 0 && pg8::mk_lane() == 0) {
        unsigned* bar = b.bar;
        __builtin_amdgcn_s_waitcnt(0);
        unsigned nloc = b.st[0], nx = b.st[1];
        if (nloc == 0u) { xcd_barrier_complete(bar, b.x, nloc, nx); b.st[0] = nloc; b.st[1] = nx; }
        const unsigned old = xb_add(&bar[XB_XSUB(b.x)], 1u);
        const unsigned gen = old / nloc;
        if (old + 1u == (gen + 1u) * nloc) {
            __builtin_amdgcn_fence(__ATOMIC_RELEASE, "agent");
            asm volatile("s_waitcnt vmcnt(0)" ::: "memory");
            const unsigned og = xb_add(&bar[XB_TOP], 1u);
            const unsigned tg = og / nx;
            if (og + 1u == (tg + 1u) * nx) xb_add(&bar[XB_TOPGEN], 1u);
            else XB_SPIN(xb_ld(&bar[XB_TOPGEN]) == tg, bar);
            __builtin_amdgcn_fence(__ATOMIC_ACQUIRE, "agent");
            xb_add(&bar[XB_XGEN(b.x)], 1u);
            asm volatile("s_waitcnt vmcnt(0)" ::: "memory");
        } else {
            XB_SPIN(xb_ld(&bar[XB_XGEN(b.x)]) == gen, bar);
            __builtin_amdgcn_fence(__ATOMIC_ACQUIRE, "agent");
            asm volatile("s_waitcnt vmcnt(0)" ::: "memory");
        }
    }
    __syncthreads();
}

struct Frame {
    LAS unsigned char* lds;
    volatile LAS unsigned* MISC;
    gu32* ctl;
    int wave;
    int vcu, G;
    unsigned char* ws;
    const float* in[26];
    float* out;
};
enum { I_X = 0, I_C, I_CTX, I_CCTX, I_WADA, I_BADA, I_NORM1, I_WIN, I_MU, I_KK, I_KA, I_RK, I_W0, I_WDU, I_A0, I_WIU, I_WGU, I_LNXW, I_LNXB, I_CONVW, I_WOUT, I_NORM2, I_WFG, I_WFU, I_WFD, I_NORMF };

__device__ __forceinline__ float wave_sum(float v) {
#pragma unroll
    for (int o = 1; o < 64; o <<= 1) v += __shfl_xor(v, o);
    return v;
}

__device__ __forceinline__ void p0_transpose_item(const float* W, int K, int N, bf16* WT, int ldk, int row_off, LAS float* scr, int item, int lane) {
    const int nblk = N / 32, kb = item / nblk, nb = item % nblk, k0 = 64 * kb, n0 = 32 * nb;
    float tv[32];
#pragma unroll
    for (int i = 0; i < 32; ++i) tv[i] = *(const GAS float*)(W + (size_t)(k0 + 2 * i + (lane >> 5)) * N + n0 + (lane & 31));
#pragma unroll
    for (int i = 0; i < 32; ++i) scr[(2 * i + (lane >> 5)) * 33 + (lane & 31)] = tv[i];
    LDS_WAIT(); asm volatile("" ::: "memory");
    const int c = lane & 7;
#pragma unroll
    for (int j = 0; j < 4; ++j) { const int n = (lane >> 3) + 8 * j; const LAS float* s = scr + (8 * c) * 33 + n;
        v4u o; o.x = pk2(s[0 * 33], s[1 * 33]); o.y = pk2(s[2 * 33], s[3 * 33]); o.z = pk2(s[4 * 33], s[5 * 33]); o.w = pk2(s[6 * 33], s[7 * 33]);
        *(GAS v4u*)(WT + (size_t)(row_off + n0 + n) * ldk + k0 + 8 * c) = o; }
    LDS_WAIT(); asm volatile("" ::: "memory");
}
constexpr int TI_IN = (D / 64) * (IN_COLS / 32), TI_OUT = (D / 64) * (D / 32), TI_G = (D / 64) * (DFF / 32), TI_DN = (DFF / 64) * (D / 32);
constexpr int TI_TOTAL = TI_IN + TI_OUT + 2 * TI_G + TI_DN;
constexpr int GEMV_UNITS = NKC * (MODN / 256);
constexpr int IB_OUT = TI_IN, IB_G = IB_OUT + TI_OUT, IB_U = IB_G + TI_G, IB_D = IB_U + TI_G;
constexpr int P2T_B = IB_OUT, P2T_E = IB_G + 13200;
constexpr int P6T_B = P2T_E, P6T_E = IB_U + 11000;
constexpr int P0X_B = P6T_E, P0X_E = IB_D + 12000;
constexpr int P11T_B = P0X_E, P11T_E = TI_TOTAL;
constexpr int P0_ITEMS = TI_IN + (P0X_E - P0X_B);
constexpr int TI_PER_GEMV_WAVE = 18, TI_PER_OTHER_WAVE = 42;
static_assert(GEMV_UNITS <= 2048 && GEMV_UNITS * TI_PER_GEMV_WAVE + (2048 - GEMV_UNITS) * TI_PER_OTHER_WAVE >= P0_ITEMS, "P0 item split");

__device__ __forceinline__ void tr_item(Frame& F, int it, LAS float* scr, int lane) {
    int r = it;
    if (r < TI_IN) { p0_transpose_item(F.in[I_WIN], D, IN_COLS, (bf16*)(F.ws + WS_WIN), D, 0, scr, r, lane); return; } r -= TI_IN;
    if (r < TI_OUT) { p0_transpose_item(F.in[I_WOUT], D, D, (bf16*)(F.ws + WS_WOUT), D, 0, scr, r, lane); return; } r -= TI_OUT;
    if (r < TI_G) { const int n0 = 32 * (r % (DFF / 32)); p0_transpose_item(F.in[I_WFG], D, DFF, (bf16*)(F.ws + WS_WGU), D, 256 * (n0 >> 7) + (n0 & 127) - n0, scr, r, lane); return; } r -= TI_G;
    if (r < TI_G) { const int n0 = 32 * (r % (DFF / 32)); p0_transpose_item(F.in[I_WFU], D, DFF, (bf16*)(F.ws + WS_WGU), D, 256 * (n0 >> 7) + 128 + (n0 & 127) - n0, scr, r, lane); return; } r -= TI_G;
    p0_transpose_item(F.in[I_WFD], DFF, D, (bf16*)(F.ws + WS_WDN), DFF, 0, scr, r, lane);
}
__device__ __forceinline__ void tr_range(Frame& F, int b, int e, int rank, int nw, LAS float* scr, int lane) {
    const int per = (e - b + nw - 1) / nw; int i0 = b + rank * per, i1 = i0 + per; if (i1 > e) i1 = e;
    for (int it = i0; it < i1; ++it) tr_item(F, it, scr, lane);
}
__device__ __forceinline__ void tr_idle(Frame& F, int b, int e, int rank_blk, int nblk) {
    if (F.G != 256 || rank_blk < 0) return;
    tr_range(F, b, e, rank_blk * NWAVES + F.wave, nblk * NWAVES, (LAS float*)(F.lds + RING_OFF + F.wave * 16384), pg8::mk_lane());
}
__device__ __forceinline__ void p0_gemv_unit(Frame& F, int unit, int lane) {
    const int kc = unit / (MODN / 256), cc = unit % (MODN / 256);
    const int k0 = kc * 256, col = cc * 256 + lane * 4;
    int sv[4], sc[4];
#pragma unroll
    for (int q = 0; q < 4; ++q) { const float c = *(const GAS float*)(F.in[I_C] + k0 + q * 64 + lane), cx = *(const GAS float*)(F.in[I_CCTX] + k0 + q * 64 + lane);
        sv[q] = __builtin_bit_cast(int, c * sigm(c)); sc[q] = __builtin_bit_cast(int, cx * sigm(cx)); }
    f32x4 a0 = (f32x4){0.f, 0.f, 0.f, 0.f}, a1 = a0;
    const GAS f32x4* wp = (const GAS f32x4*)(F.in[I_WADA] + (size_t)k0 * MODN + col);
#pragma unroll
    for (int q = 0; q < 4; ++q) {
#pragma unroll 16
        for (int i = 0; i < 64; ++i) { const f32x4 w = wp[(size_t)(q * 64 + i) * (MODN / 4)];
            const float s = __builtin_bit_cast(float, __builtin_amdgcn_readlane(sv[q], i)), t = __builtin_bit_cast(float, __builtin_amdgcn_readlane(sc[q], i));
            a0 += w * s; a1 += w * t; }
    }
    float* mp = (float*)(F.ws + WS_MODP);
    *(GAS f32x4*)(mp + (size_t)(kc * 2 + 0) * MODN + col) = a0;
    *(GAS f32x4*)(mp + (size_t)(kc * 2 + 1) * MODN + col) = a1;
}

__device__ __forceinline__ void p0_prologue(Frame& F) {
    LAS float* scr = (LAS float*)(F.lds + RING_OFF + F.wave * 16384);
    const int lane = pg8::mk_lane();
    const int gw = F.vcu * NWAVES + F.wave, NGW = F.G * NWAVES;
    const int gt = gw * 64 + lane, NGT = NGW * 64;
    {
        unsigned* wl = (unsigned*)(F.ws + WS_WLORA);
        for (int i = gt; i < NLORA * KLORA / 2; i += NGT) { const int n = i >> 7, k = (i & 127) * 2, pn = n >> 8, d = pn >> 4, isic = (n >> 7) & 1, ch = (pn & 15) * 128 + (n & 127); float v0 = 0.f, v1 = 0.f;
            if (k < 96) { if (!isic) { v0 = *(const GAS float*)(F.in[I_WDU] + (size_t)(d * 96 + k) * 2048 + ch); v1 = *(const GAS float*)(F.in[I_WDU] + (size_t)(d * 96 + k + 1) * 2048 + ch); } }
            else if (k < 192) { if (isic) { v0 = *(const GAS float*)(F.in[I_WIU] + (size_t)(d * 96 + k - 96) * 2048 + ch); v1 = *(const GAS float*)(F.in[I_WIU] + (size_t)(d * 96 + k - 95) * 2048 + ch); } }
            *(GAS unsigned*)(wl + i) = pk2(v0, v1); }
        unsigned* wg = (unsigned*)(F.ws + WS_WGATE);
        for (int i = gt; i < 2048 * KGATE / 2; i += NGT) { const int n = i >> 7, k = (i & 127) * 2;
            *(GAS unsigned*)(wg + i) = pk2(*(const GAS float*)(F.in[I_WGU] + (size_t)k * 2048 + n), *(const GAS float*)(F.in[I_WGU] + (size_t)(k + 1) * 2048 + n)); }
        v4u* zp = (v4u*)(F.ws + WS_WIN + (size_t)IN_COLS * D * 2);
        for (int i = gt; i < (NZ - IN_COLS) * D * 2 / 16; i += NGT) *(GAS v4u*)(zp + i) = (v4u){0u, 0u, 0u, 0u};
    }
    for (int u = gw; u < GEMV_UNITS; u += NGW) p0_gemv_unit(F, u, lane);
    if (F.G == 256) {
        int it0, it1;
        if (gw < GEMV_UNITS) { it0 = gw * TI_PER_GEMV_WAVE; it1 = it0 + TI_PER_GEMV_WAVE; }
        else { it0 = GEMV_UNITS * TI_PER_GEMV_WAVE + (gw - GEMV_UNITS) * TI_PER_OTHER_WAVE; it1 = it0 + TI_PER_OTHER_WAVE; }
        if (it1 > P0_ITEMS) it1 = P0_ITEMS;
        for (int it = it0; it < it1; ++it) tr_item(F, it < TI_IN ? it : P0X_B + (it - TI_IN), scr, lane);
    } else tr_range(F, 0, TI_TOTAL, gw, NGW, scr, lane);
}

__device__ __forceinline__ void norm_row(const float* xrow, bf16* orow, const LAS float* gs, const LAS float* sh, int lane) {
    const GAS f32x4* xr = (const GAS f32x4*)xrow + lane;
    f32x4 v[16]; float s = 0.f;
#pragma unroll
    for (int j = 0; j < 16; ++j) { v[j] = xr[64 * j]; s += (v[j].x * v[j].x + v[j].y * v[j].y) + (v[j].z * v[j].z + v[j].w * v[j].w); }
    const float rstd = 1.0f / sqrtf(wave_sum(s) * (1.f / D) + NORM_EPS);
    GAS v2u* o8 = (GAS v2u*)orow + lane;
#pragma unroll
    for (int j = 0; j < 16; ++j) { const f32x4 g = *(const LAS f32x4*)(gs + 4 * lane + 256 * j), b = *(const LAS f32x4*)(sh + 4 * lane + 256 * j);
        const f32x4 y = v[j] * rstd * g + b; v2u o; o.x = pk2(y.x, y.y); o.y = pk2(y.z, y.w); o8[64 * j] = o; }
}
__device__ __forceinline__ void p1_norm1(Frame& F) {
    const int lane = pg8::mk_lane(), tid = F.wave * 64 + lane;
    LAS float* tab = (LAS float*)(F.lds + RING_OFF);
    const float* mp = (const float*)(F.ws + WS_MODP);
    for (int i = tid; i < 4 * D; i += NWAVES * 64) {
        const int which = i >> 12, k = i & (D - 1), isc = which >> 1, part = which & 1;
        const int col = part == 0 ? D + k : k;
        float s = *(const GAS float*)(F.in[I_BADA] + col);
#pragma unroll
        for (int p = 0; p < NKC; ++p) s += *(const GAS float*)(mp + (size_t)(p * 2 + isc) * MODN + col);
        tab[i] = part == 0 ? *(const GAS float*)(F.in[I_NORM1] + k) * (1.0f + s) : s;
    }
    {
        float* mv = (float*)(F.ws + WS_MODV);
        for (int i = F.vcu * (NWAVES * 64) + tid; i < 2 * MODN; i += F.G * NWAVES * 64) { const int isc = i / MODN, col = i % MODN;
            float s = *(const GAS float*)(F.in[I_BADA] + col);
#pragma unroll
            for (int p = 0; p < NKC; ++p) s += *(const GAS float*)(mp + (size_t)(p * 2 + isc) * MODN + col);
            *(GAS float*)(mv + i) = s; }
    }
    __syncthreads();
    const int gw = F.vcu * NWAVES + F.wave, NGW = F.G * NWAVES;
    bf16* A1 = (bf16*)(F.ws + WS_A1);
    for (int m = gw; m < TT; m += NGW) {
        if (m < T) norm_row(F.in[I_X] + (size_t)m * D, A1 + (size_t)m * D, tab, tab + D, lane);
        else norm_row(F.in[I_CTX] + (size_t)(m - T) * D, A1 + (size_t)m * D, tab + 2 * D, tab + 3 * D, lane);
    }
    __syncthreads();
}
__device__ __forceinline__ void p10_norm2(Frame& F) {
    const int lane = pg8::mk_lane(), tid = F.wave * 64 + lane;
    LAS float* tab = (LAS float*)(F.lds + RING_OFF);
    const float* mv = (const float*)(F.ws + WS_MODV);
    for (int i = tid; i < 2 * D; i += NWAVES * 64) { const int part = i >> 12, k = i & (D - 1);
        tab[i] = part == 0 ? *(const GAS float*)(F.in[I_NORM2] + k) * (1.0f + *(const GAS float*)(mv + 4 * D + k)) : *(const GAS float*)(mv + 3 * D + k); }
    __syncthreads();
    const int gw = F.vcu * NWAVES + F.wave, NGW = F.G * NWAVES;
    bf16* A1 = (bf16*)(F.ws + WS_A1); const float* X1 = (const float*)(F.ws + WS_X1);
    for (int m = gw; m < T; m += NGW) norm_row(X1 + (size_t)m * D, A1 + (size_t)m * D, tab, tab + D, lane);
    __syncthreads();
}
__device__ __forceinline__ void p13_final(Frame& F) {
    const int lane = pg8::mk_lane();
    const int gw = F.vcu * NWAVES + F.wave, NGW = F.G * NWAVES;
    for (int m = gw; m < T; m += NGW) {
        GAS f32x4* xr = (GAS f32x4*)(F.out + (size_t)m * D) + lane;
        f32x4 v[16]; float s = 0.f;
#pragma unroll
        for (int j = 0; j < 16; ++j) { v[j] = xr[64 * j]; s += (v[j].x * v[j].x + v[j].y * v[j].y) + (v[j].z * v[j].z + v[j].w * v[j].w); }
        const float rstd = 1.0f / sqrtf(wave_sum(s) * (1.f / D) + NORM_EPS);
#pragma unroll
        for (int j = 0; j < 16; ++j) { const f32x4 g = *((const GAS f32x4*)F.in[I_NORMF] + lane + 64 * j); xr[64 * j] = v[j] * rstd * g; }
    }
}

__device__ __forceinline__ void ld8(const bf16* p, float (&f)[8]) { const v4u r = *(const GAS v4u*)p;
    f[0] = bflo(r.x); f[1] = bfhi(r.x); f[2] = bflo(r.y); f[3] = bfhi(r.y); f[4] = bflo(r.z); f[5] = bfhi(r.z); f[6] = bflo(r.w); f[7] = bfhi(r.w); }
__device__ __forceinline__ void ldf8(const float* p, float (&f)[8]) { const f32x4 a = *(const GAS f32x4*)p, b = *(const GAS f32x4*)(p + 4);
    f[0] = a.x; f[1] = a.y; f[2] = a.z; f[3] = a.w; f[4] = b.x; f[5] = b.y; f[6] = b.z; f[7] = b.w; }
__device__ __forceinline__ void stf8(float* p, const float (&f)[8]) { *(GAS f32x4*)p = (f32x4){f[0], f[1], f[2], f[3]}; *(GAS f32x4*)(p + 4) = (f32x4){f[4], f[5], f[6], f[7]}; }
__device__ __forceinline__ void stb8(bf16* p, const float (&f)[8]) { v4u o; o.x = pk2(f[0], f[1]); o.y = pk2(f[2], f[3]); o.z = pk2(f[4], f[5]); o.w = pk2(f[6], f[7]); *(GAS v4u*)p = o; }
__device__ __forceinline__ void za8(const bf16* Z, int row, bool hp, bool hn, int c, const float* mu, float (&o)[8]) {
    float zc[8], zp[8], zn[8], m8[8];
    ld8(Z + (size_t)row * NZ + c, zc);
    if (hp) ld8(Z + (size_t)(row - 1) * NZ + c, zp); else { _Pragma("unroll") for (int i = 0; i < 8; ++i) zp[i] = 0.f; }
    if (hn) ld8(Z + (size_t)(row + 1) * NZ + c, zn); else { _Pragma("unroll") for (int i = 0; i < 8; ++i) zn[i] = 0.f; }
    ldf8(mu + c, m8);
#pragma unroll
    for (int i = 0; i < 8; ++i) o[i] = zc[i] + m8[i] * (0.5f * (zp[i] + zn[i]) - zc[i]);
}
__device__ __forceinline__ void zero8(float (&f)[8]) {
#pragma unroll
    for (int i = 0; i < 8; ++i) f[i] = 0.f; }
__device__ __forceinline__ void cp8(float (&d)[8], const float (&s)[8]) {
#pragma unroll
    for (int i = 0; i < 8; ++i) d[i] = s[i]; }
__device__ __forceinline__ void p3_prep(Frame& F) {
    const bf16* Z = (const bf16*)(F.ws + WS_Z);
    float* KB = (float*)(F.ws + WS_KBUF); float* KKB = (float*)(F.ws + WS_KKBUF); float* RB = (float*)(F.ws + WS_RBUF); float* VB = (float*)(F.ws + WS_VBUF);
    bf16* AL = (bf16*)(F.ws + WS_ALORA); bf16* AG = (bf16*)(F.ws + WS_AGATE); bf16* CAT = (bf16*)(F.ws + WS_CAT);
    const float* mu = F.in[I_MU];
    const int tpb = (TT + F.G - 1) / F.G;
    const int tok0 = F.vcu * tpb, half0 = (tpb + 1) / 2;
    const int lane = pg8::mk_lane();
    for (int it = F.wave; it < 36; it += NWAVES) {
        const int type = it >> 1, hf = it & 1;
        int tA = tok0 + (hf ? half0 : 0), tB = tok0 + (hf ? tpb : half0);
        if (tB > TT) tB = TT;
        if (tA >= tB) continue;
        if (type < 14) {
            int zoff, c = 0; bool act = true;
            if (type < 12) { const int kind = type >> 2; c = (type & 3) * 512 + lane * 8; zoff = (kind == 0 ? OFF_K : (kind == 1 ? OFF_V : OFF_R)) + c; }
            else if (type == 12) { act = lane < 24; zoff = OFF_WL + (act ? lane : 0) * 8; }
            else { act = lane < 32; zoff = OFF_GL + (act ? lane : 0) * 8; }
            float m8[8], kk8[8]; ldf8(mu + zoff, m8);
            if (type < 4) ldf8(F.in[I_KK] + c, kk8); else zero8(kk8);
            float zp[8], zc[8], zn[8], znn[8];
            if (tA > 0) ld8(Z + (size_t)(tA - 1) * NZ + zoff, zp); else zero8(zp);
            ld8(Z + (size_t)tA * NZ + zoff, zc);
            if (tA + 1 < TT) ld8(Z + (size_t)(tA + 1) * NZ + zoff, zn); else zero8(zn);
            for (int t = tA; t < tB; ++t) {
                if (t + 2 < TT) ld8(Z + (size_t)(t + 2) * NZ + zoff, znn); else zero8(znn);
                const bool isctx = t >= T; const int pos = isctx ? t - T : (t & 63);
                const bool hp = pos > 0, hn = isctx ? (pos < CTXL - 1) : (pos < 63);
                float v[8];
#pragma unroll
                for (int i = 0; i < 8; ++i) v[i] = zc[i] + m8[i] * (0.5f * ((hp ? zp[i] : 0.f) + (hn ? zn[i] : 0.f)) - zc[i]);
                const size_t fo = (size_t)t * 2048 + c;
                if (type < 4) {
                    stf8(KB + fo, v);
                    float q[8]; float ss = 0.f;
#pragma unroll
                    for (int i = 0; i < 8; ++i) { q[i] = v[i] * kk8[i]; ss += q[i] * q[i]; }
                    ss += __shfl_xor(ss, 1); ss += __shfl_xor(ss, 2); ss += __shfl_xor(ss, 4);
                    const float inv = 1.0f / fmaxf(sqrtf(ss), 1e-12f);
#pragma unroll
                    for (int i = 0; i < 8; ++i) q[i] *= inv;
                    stf8(KKB + fo, q);
                } else if (type < 8) stf8(VB + fo, v);
                else if (type < 12) { if (!isctx) stf8(RB + fo, v); }
                else if (type == 12) {
                    if (lane < 32) { float o[8];
                        if (lane < 12) { _Pragma("unroll") for (int i = 0; i < 8; ++i) o[i] = tanhf(v[i]); }
                        else if (lane < 24) cp8(o, v);
                        else zero8(o);
                        stb8(AL + (size_t)t * KLORA + lane * 8, o); }
                } else { if (!isctx && lane < 32) { float o[8];
#pragma unroll
                        for (int i = 0; i < 8; ++i) o[i] = sigm(v[i]);
                        stb8(AG + (size_t)t * KGATE + lane * 8, o); } }
                cp8(zp, zc); cp8(zc, zn); cp8(zn, znn);
            }
        } else {
            if (tA >= T) continue;
            if (tB > T) tB = T;
            const int c = (type - 14) * 512 + lane * 8;
            float w0[8], w1[8], w2[8];
            ldf8(F.in[I_CONVW] + c, w0); ldf8(F.in[I_CONVW] + 2048 + c, w1); ldf8(F.in[I_CONVW] + 4096 + c, w2);
            float up[8], uc[8], un[8], ca[8], xa[8], cb[8], xb[8], bg[8], bgn[8];
            if (tA > 0) { ld8(Z + (size_t)(tA - 1) * NZ + OFF_CC + c, ca); ld8(Z + (size_t)(tA - 1) * NZ + OFF_CX + c, xa); _Pragma("unroll") for (int i = 0; i < 8; ++i) up[i] = ca[i] * xa[i]; } else zero8(up);
            ld8(Z + (size_t)tA * NZ + OFF_CC + c, ca); ld8(Z + (size_t)tA * NZ + OFF_CX + c, xa);
#pragma unroll
            for (int i = 0; i < 8; ++i) uc[i] = ca[i] * xa[i];
            ld8(Z + (size_t)tA * NZ + OFF_CB + c, bg);
            if (tA + 1 < T) { ld8(Z + (size_t)(tA + 1) * NZ + OFF_CC + c, ca); ld8(Z + (size_t)(tA + 1) * NZ + OFF_CX + c, xa); } else { zero8(ca); zero8(xa); }
            for (int t = tA; t < tB; ++t) {
                if (t + 2 < T) { ld8(Z + (size_t)(t + 2) * NZ + OFF_CC + c, cb); ld8(Z + (size_t)(t + 2) * NZ + OFF_CX + c, xb); } else { zero8(cb); zero8(xb); }
                if (t + 1 < T) ld8(Z + (size_t)(t + 1) * NZ + OFF_CB + c, bgn); else zero8(bgn);
                const int pos = t & 63; const bool hp = pos > 0, hn = pos < 63;
                float y[8];
#pragma unroll
                for (int i = 0; i < 8; ++i) { un[i] = ca[i] * xa[i]; y[i] = bg[i] * (w0[i] * (hp ? up[i] : 0.f) + w1[i] * uc[i] + w2[i] * (hn ? un[i] : 0.f)); }
                stb8(CAT + (size_t)t * D + DR + c, y);
                cp8(up, uc); cp8(uc, un); cp8(ca, cb); cp8(xa, xb); cp8(bg, bgn);
            }
        }
    }
}

typedef float f32x16 __attribute__((ext_vector_type(16)));
#define MK_FENCE() asm volatile("" ::: "memory")
constexpr int REC_BYTES = 8448, NBLK = TT / 16, SCAN_LDS = REC_BYTES + 4096;
__device__ __forceinline__ void swap32(float& x, float& y) { asm volatile("s_nop 1\n\tv_permlane32_swap_b32 %0, %1\n\ts_nop 1" : "+v"(x), "+v"(y)); }
__device__ __forceinline__ int kperm(int k) { return ((((k >> 5) * 2 + ((k >> 4) & 1)) * 2 + ((k >> 2) & 1)) * 8 + ((k >> 3) & 1) * 4 + (k & 3)); }
__device__ __forceinline__ int scan_blkbase(int d, int c, int j) {
    if (c == 0) return T + (d == 0 ? 16 * j : CTXL - 16 - 16 * j);
    const int p0 = (c - 1) * CHUNK + 16 * j;
    return d == 0 ? p0 : T - 16 - p0;
}
struct BlkRegs { v4u p[8]; float ge; float v[16]; };
__device__ __forceinline__ void scan_bload(const unsigned char* PKB, const float* VB, int d, int h, int tb, int lane, BlkRegs& R) {
    const GAS unsigned char* rp = (const GAS unsigned char*)PKB + ((size_t)(d * 32 + h) * NBLK + (tb >> 4)) * REC_BYTES;
#pragma unroll
    for (int j = 0; j < 8; ++j) R.p[j] = *((const GAS v4u*)rp + 64 * j + lane);
    R.ge = *((const GAS float*)(rp + 8192) + lane);
    const GAS float* gv = (const GAS float*)(VB + (size_t)tb * 2048 + h * 64) + lane;
#pragma unroll
    for (int j = 0; j < 16; ++j) R.v[j] = gv[2048 * j];
}
__device__ __forceinline__ void scan_bstore(LAS unsigned char* buf, int lane, const BlkRegs& R) {
#pragma unroll
    for (int j = 0; j < 8; ++j) *((LAS v4u*)buf + 64 * j + lane) = R.p[j];
    *((LAS float*)(buf + 8192) + lane) = R.ge;
#pragma unroll
    for (int j = 0; j < 16; ++j) *((LAS float*)(buf + REC_BYTES) + 64 * j + lane) = R.v[j];
}
__device__ __forceinline__ void scan_vec32(const LAS unsigned char* row, int hl, float (&f)[32]) {
#pragma unroll
    for (int q = 0; q < 4; ++q) { const v4u w = *(const LAS v4u*)(row + (q * 2 + hl) * 16);
        f[8 * q + 0] = bflo(w.x); f[8 * q + 1] = bfhi(w.x); f[8 * q + 2] = bflo(w.y); f[8 * q + 3] = bfhi(w.y); f[8 * q + 4] = bflo(w.z); f[8 * q + 5] = bfhi(w.z); f[8 * q + 6] = bflo(w.w); f[8 * q + 7] = bfhi(w.w); }
}
__device__ __forceinline__ void scan_matvec(const f32x16 (&Tt)[2][2], const float (&f)[32], float& sa) {
    float p0a = 0.f, p0b = 0.f, p1a = 0.f, p1b = 0.f;
#pragma unroll
    for (int I = 0; I < 2; ++I)
#pragma unroll
        for (int r = 0; r < 16; r += 2) { p0a += Tt[I][0][r] * f[16 * I + r]; p1a += Tt[I][1][r] * f[16 * I + r]; p0b += Tt[I][0][r + 1] * f[16 * I + r + 1]; p1b += Tt[I][1][r + 1] * f[16 * I + r + 1]; }
    float p0 = p0a + p0b, p1 = p1a + p1b;
    swap32(p0, p1);
    sa = p0 + p1;
}
__device__ __forceinline__ void scan_renorm(f32x16 (&Tt)[2][2], const LAS float* ge, int hl) {
#pragma unroll
    for (int I = 0; I < 2; ++I)
#pragma unroll
        for (int qd = 0; qd < 4; ++qd) { const f32x4 g = *(const LAS f32x4*)(ge + 32 * I + 8 * qd + 4 * hl);
#pragma unroll
            for (int e = 0; e < 4; ++e) { Tt[I][0][4 * qd + e] *= g[e]; Tt[I][1][4 * qd + e] *= g[e]; } }
}
__device__ __forceinline__ void scan_store_T(const f32x16 (&Tt)[2][2], float* dst, int lane) {
#pragma unroll
    for (int I = 0; I < 2; ++I)
#pragma unroll
        for (int J = 0; J < 2; ++J)
#pragma unroll
            for (int reg = 0; reg < 16; ++reg) *(GAS float*)(dst + (32 * I + 8 * (reg >> 2) + 4 * (lane >> 5) + (reg & 3)) * 64 + 32 * J + (lane & 31)) = Tt[I][J][reg];
}
__device__ __forceinline__ void p5_scanA(Frame& F) {
    const unsigned char* PKB = F.ws + WS_PK; const float* VB = (const float*)(F.ws + WS_VBUF);
    float* PU = (float*)(F.ws + WS_PU);
    LAS unsigned char* my = F.lds + RING_OFF + F.wave * SCAN_LDS;
    for (int unit = F.vcu * NWAVES + F.wave; unit < 2048; unit += F.G * NWAVES) {
        const int d = unit & 1, h = (unit >> 1) & 31, c = unit >> 6;
        const int lane = pg8::mk_lane(), hl = lane >> 5;
        const int po0 = kperm(lane & 31) * 2 + (hl ? 6144 : 4096), po1 = kperm(32 + (lane & 31)) * 2 + (hl ? 6144 : 4096);
        f32x16 TP[2][2], TU[2][2];
#pragma unroll
        for (int I = 0; I < 2; ++I)
#pragma unroll
            for (int J = 0; J < 2; ++J)
#pragma unroll
                for (int reg = 0; reg < 16; ++reg) { TP[I][J][reg] = (32 * I + 8 * (reg >> 2) + 4 * hl + (reg & 3) == 32 * J + (lane & 31)) ? 1.0f : 0.0f; TU[I][J][reg] = 0.0f; }
        BlkRegs R;
        scan_bload(PKB, VB, d, h, scan_blkbase(d, c, 0), lane, R);
#pragma unroll 1
        for (int j = 0; j < 16; ++j) {
            scan_bstore(my, lane, R);
            if (j + 1 < 16) scan_bload(PKB, VB, d, h, scan_blkbase(d, c, j + 1), lane, R);
#pragma unroll 1
            for (int tau = 0; tau < 16; ++tau) {
                const LAS unsigned char* row = my + tau * 128;
                float vv = ((const LAS float*)(my + REC_BYTES))[(d == 0 ? tau : 15 - tau) * 64 + lane];
                const float bk0 = __builtin_bit_cast(float, (unsigned)*(const LAS unsigned short*)(row + po0) << 16), bk1 = __builtin_bit_cast(float, (unsigned)*(const LAS unsigned short*)(row + po1) << 16);
                float f[32]; scan_vec32(row, hl, f);
                float saP, saU; scan_matvec(TP, f, saP); scan_matvec(TU, f, saU);
                float zz = 0.0f;
                swap32(saU, vv);
                swap32(saP, zz);
                TU[0][0] = __builtin_amdgcn_mfma_f32_32x32x2f32(bk0, saU, TU[0][0], 0, 0, 0); TU[0][1] = __builtin_amdgcn_mfma_f32_32x32x2f32(bk0, vv, TU[0][1], 0, 0, 0);
                TU[1][0] = __builtin_amdgcn_mfma_f32_32x32x2f32(bk1, saU, TU[1][0], 0, 0, 0); TU[1][1] = __builtin_amdgcn_mfma_f32_32x32x2f32(bk1, vv, TU[1][1], 0, 0, 0);
                TP[0][0] = __builtin_amdgcn_mfma_f32_32x32x2f32(bk0, saP, TP[0][0], 0, 0, 0); TP[0][1] = __builtin_amdgcn_mfma_f32_32x32x2f32(bk0, zz, TP[0][1], 0, 0, 0);
                TP[1][0] = __builtin_amdgcn_mfma_f32_32x32x2f32(bk1, saP, TP[1][0], 0, 0, 0); TP[1][1] = __builtin_amdgcn_mfma_f32_32x32x2f32(bk1, zz, TP[1][1], 0, 0, 0);
            }
            scan_renorm(TP, (const LAS float*)(my + 8192), hl); scan_renorm(TU, (const LAS float*)(my + 8192), hl);
        }
        scan_store_T(TP, PU + ((size_t)unit * 2 + 0) * 4096, lane);
        scan_store_T(TU, PU + ((size_t)unit * 2 + 1) * 4096, lane);
    }
}
__device__ __forceinline__ void p6_scanB(Frame& F) {
    const GAS char* PU = (const GAS char*)(F.ws + WS_PU); GAS char* SST = (GAS char*)(F.ws + WS_SST);
    LAS float* PiB = (LAS float*)(F.lds + RING_OFF);
    LAS float* TbB = (LAS float*)(F.lds + RING_OFF + 2 * 16640);
    const int w = F.wave;
    for (int q = F.vcu; q < 64; q += F.G) {
        const unsigned lane = (unsigned)pg8::mk_lane(), tid = (unsigned)w * 64u + lane, hl = lane >> 5, l31 = lane & 31u;
        const unsigned I1 = ((unsigned)w >> 1) & 1u, J = (unsigned)w & 1u;
        {   const GAS char* u0 = PU + ((size_t)q * 2 + 1) * 16384; GAS char* so = SST + ((size_t)q * NCHUNK + 1) * 16384;
            const f32x4 t0 = *(const GAS f32x4*)(u0 + tid * 32u), t1 = *(const GAS f32x4*)(u0 + tid * 32u + 16u);
            *((LAS f32x4*)TbB + tid * 2) = t0; *((LAS f32x4*)TbB + tid * 2 + 1) = t1;
            *(GAS f32x4*)(so + tid * 32u) = t0; *(GAS f32x4*)(so + tid * 32u + 16u) = t1; }
        f32x4 pn0, pn1; f32x16 un;
        {   const GAS char* pg = PU + (((size_t)q + 64) * 2 + 0) * 16384; pn0 = *(const GAS f32x4*)(pg + tid * 32u); pn1 = *(const GAS f32x4*)(pg + tid * 32u + 16u);
            const unsigned pb = (tid >> 3) * 65u + (tid & 7u) * 8u;
#pragma unroll
            for (int e = 0; e < 4; ++e) { PiB[pb + e] = pn0[e]; PiB[pb + 4 + e] = pn1[e]; }
            const GAS char* ug = PU + (((size_t)q + 64) * 2 + 1) * 16384;
#pragma unroll
            for (int r = 0; r < 16; ++r) un[r] = (w < 4) ? *(const GAS float*)(ug + ((32u * I1 + 8u * (r >> 2) + 4u * hl + (r & 3)) * 64u + 32u * J + l31) * 4u) : 0.f; }
        __syncthreads();
        for (int c = 1; c < 32; ++c) {
            const LAS float* Pi = PiB + ((c - 1) & 1) * 4160; const LAS float* Tb = TbB + ((c - 1) & 1) * 4096;
            LAS float* PiN = PiB + (c & 1) * 4160; LAS float* TbN = TbB + (c & 1) * 4096;
            f32x16 acc = un;
            if (c + 1 < 32) {
                const GAS char* pg = PU + (((size_t)q + 64 * (c + 1)) * 2 + 0) * 16384; pn0 = *(const GAS f32x4*)(pg + tid * 32u); pn1 = *(const GAS f32x4*)(pg + tid * 32u + 16u);
                const GAS char* ug = PU + (((size_t)q + 64 * (c + 1)) * 2 + 1) * 16384;
                if (w < 4) {
#pragma unroll
                    for (int r = 0; r < 16; ++r) un[r] = *(const GAS float*)(ug + ((32u * I1 + 8u * (r >> 2) + 4u * hl + (r & 3)) * 64u + 32u * J + l31) * 4u); }
            }
            if (w < 4) {
#pragma unroll
                for (int s2 = 0; s2 < 32; ++s2) { const float av = Pi[(32u * I1 + l31) * 65u + 2u * s2 + hl], bv = Tb[(2u * s2 + hl) * 64u + 32u * J + l31];
                    acc = __builtin_amdgcn_mfma_f32_32x32x2f32(av, bv, acc, 0, 0, 0);
                    if ((s2 & 7) == 7) MK_FENCE(); }
                GAS char* so = SST + ((size_t)q * NCHUNK + c + 1) * 16384;
#pragma unroll
                for (int r = 0; r < 16; ++r) { const unsigned e = (32u * I1 + 8u * (r >> 2) + 4u * hl + (r & 3)) * 64u + 32u * J + l31; TbN[e] = acc[r]; *(GAS float*)(so + e * 4u) = acc[r]; }
            }
            if (c + 1 < 32) { const unsigned pb = (tid >> 3) * 65u + (tid & 7u) * 8u;
#pragma unroll
                for (int e = 0; e < 4; ++e) { PiN[pb + e] = pn0[e]; PiN[pb + 4 + e] = pn1[e]; } }
            __syncthreads();
        }
    }
}
typedef short bf16x8 __attribute__((ext_vector_type(8)));
#define MK_MFMA(a, b, c) __builtin_amdgcn_mfma_f32_32x32x16_bf16((a), (b), (c), 0, 0, 0)
constexpr int SCR_LAB = 0, SCR_LAK = 1024, SCR_MRB = 2048, SCR_MRK = 2560, SCAN_SCR = 3072;
struct RecRegs { v4u p[8]; float ge; };
__device__ __forceinline__ void scan_rload(const unsigned char* PKB, int d, int h, int tb, int lane, RecRegs& R) {
    const GAS unsigned char* rp = (const GAS unsigned char*)PKB + ((size_t)(d * 32 + h) * NBLK + (tb >> 4)) * REC_BYTES;
#pragma unroll
    for (int j = 0; j < 8; ++j) R.p[j] = *((const GAS v4u*)rp + 64 * j + lane);
    R.ge = *((const GAS float*)(rp + 8192) + lane);
}
__device__ __forceinline__ void scan_rstore(LAS unsigned char* buf, int lane, const RecRegs& R) {
#pragma unroll
    for (int j = 0; j < 8; ++j) *((LAS v4u*)buf + 64 * j + lane) = R.p[j];
    *((LAS float*)(buf + 8192) + lane) = R.ge;
}
__device__ __forceinline__ bf16x8 pack8(float a0, float a1, float a2, float a3, float a4, float a5, float a6, float a7) {
    const v4u u = {pg8::cvt_pk_bf16(a0, a1), pg8::cvt_pk_bf16(a2, a3), pg8::cvt_pk_bf16(a4, a5), pg8::cvt_pk_bf16(a6, a7)}; return __builtin_bit_cast(bf16x8, u); }
__device__ __forceinline__ f32x16 zero16() { f32x16 z;
#pragma unroll
    for (int i = 0; i < 16; ++i) z[i] = 0.f;
    return z; }
__device__ __forceinline__ void scan_tfrags(const f32x16 (&Tt)[2][2], bf16x8 (&Tf)[2][2][2]) {
#pragma unroll
    for (int I = 0; I < 2; ++I)
#pragma unroll
        for (int J = 0; J < 2; ++J)
#pragma unroll
            for (int s = 0; s < 2; ++s) Tf[I][J][s] = pack8(Tt[I][J][8 * s], Tt[I][J][8 * s + 1], Tt[I][J][8 * s + 2], Tt[I][J][8 * s + 3], Tt[I][J][8 * s + 4], Tt[I][J][8 * s + 5], Tt[I][J][8 * s + 6], Tt[I][J][8 * s + 7]);
}
__device__ __forceinline__ void scan_sfrags(float (&S)[16], bf16x8 (&Sf)[2]) {
#pragma unroll
    for (int j = 0; j < 8; ++j) swap32(S[j], S[j + 8]);
    Sf[0] = pack8(S[0], S[1], S[2], S[3], S[4], S[5], S[6], S[7]); Sf[1] = pack8(S[8], S[9], S[10], S[11], S[12], S[13], S[14], S[15]);
}
__device__ __forceinline__ void p7_scanC(Frame& F) {
    const unsigned char* PKB = F.ws + WS_PK; const float* VB = (const float*)(F.ws + WS_VBUF);
    const float* SST = (const float*)(F.ws + WS_SST); float* YS = (float*)(F.ws + WS_YS);
    LAS unsigned char* my = F.lds + RING_OFF + F.wave * (REC_BYTES + SCAN_SCR);
    LAS unsigned char* scr = my + REC_BYTES;
    for (int unit = F.vcu * NWAVES + F.wave; unit < 2048; unit += F.G * NWAVES) {
        const int d = unit & 1, h = (unit >> 1) & 31, c = (unit >> 6) + 1, q = unit & 63;
        const int lane = pg8::mk_lane(), hl = lane >> 5, l31 = lane & 31, l15 = lane & 15;
        f32x16 Tt[2][2];
        {   const float* s0 = SST + ((size_t)q * NCHUNK + c) * 4096;
#pragma unroll
            for (int I = 0; I < 2; ++I)
#pragma unroll
                for (int J = 0; J < 2; ++J)
#pragma unroll
                    for (int reg = 0; reg < 16; ++reg) Tt[I][J][reg] = *(const GAS float*)(s0 + (32 * I + 8 * (reg >> 2) + 4 * hl + (reg & 3)) * 64 + 32 * J + l31); }
        RecRegs R;
        scan_rload(PKB, d, h, scan_blkbase(d, c, 0), lane, R);
#pragma unroll 1
        for (int j = 0; j < 16; ++j) {
            const int tb = scan_blkbase(d, c, j);
            scan_rstore(my, lane, R);
            float Vv[16];
            {   const GAS float* gv = (const GAS float*)(VB + (size_t)(tb + (d == 0 ? 0 : 15)) * 2048 + h * 64) + lane; const int dstep = d == 0 ? 2048 : -2048;
#pragma unroll
                for (int t = 0; t < 16; ++t) Vv[t] = gv[t * dstep]; }
            const LAS unsigned char* arow = my + l15 * 128 + hl * 16;
            {   f32x16 Lab = zero16(), Lak = zero16(), Mrb = zero16(), Mrk = zero16();
#pragma unroll
                for (int qq = 0; qq < 4; ++qq) { const bf16x8 af = *(const LAS bf16x8*)(arow + qq * 32), rf = *(const LAS bf16x8*)(arow + 2048 + qq * 32), bf = *(const LAS bf16x8*)(arow + 4096 + qq * 32), kf = *(const LAS bf16x8*)(arow + 6144 + qq * 32);
                    Lab = MK_MFMA(af, bf, Lab); Lak = MK_MFMA(af, kf, Lak); Mrb = MK_MFMA(rf, bf, Mrb); Mrk = MK_MFMA(rf, kf, Mrk); }
                if (l31 < 16) {
                    LAS float* lb = (LAS float*)scr + 64 * hl + l31; LAS unsigned short* mb = (LAS unsigned short*)scr + 64 * hl + l31; const int lm = l31 - 4 * hl;
#pragma unroll
                    for (int r = 0; r < 8; ++r) { const int t0 = 8 * (r >> 2) + (r & 3);
                        lb[SCR_LAB / 4 + t0 * 16] = Lab[r]; lb[SCR_LAK / 4 + t0 * 16] = Lak[r];
                        mb[SCR_MRB / 2 + t0 * 16] = (unsigned short)f2bf(lm <= t0 ? Mrb[r] : 0.f); mb[SCR_MRK / 2 + t0 * 16] = (unsigned short)f2bf(lm <= t0 ? Mrk[r] : 0.f); }
                }
            }
            MK_FENCE();
            f32x16 G[2], Y[2];
            {   bf16x8 Tf[2][2][2]; scan_tfrags(Tt, Tf);
                G[0] = zero16(); G[1] = zero16(); Y[0] = zero16(); Y[1] = zero16();
#pragma unroll
                for (int qq = 0; qq < 4; ++qq) { const bf16x8 af = *(const LAS bf16x8*)(arow + qq * 32), rf = *(const LAS bf16x8*)(arow + 2048 + qq * 32);
                    G[0] = MK_MFMA(af, Tf[qq >> 1][0][qq & 1], G[0]); G[1] = MK_MFMA(af, Tf[qq >> 1][1][qq & 1], G[1]);
                    Y[0] = MK_MFMA(rf, Tf[qq >> 1][0][qq & 1], Y[0]); Y[1] = MK_MFMA(rf, Tf[qq >> 1][1][qq & 1], Y[1]); }
            }
            MK_FENCE();
            if (j + 1 < 16) scan_rload(PKB, d, h, scan_blkbase(d, c, j + 1), lane, R);
            float S[16];
#pragma unroll
            for (int r = 0; r < 8; ++r) { float x = G[0][r], y = G[1][r]; swap32(x, y); const int t = 8 * (r >> 2) + (r & 3); S[t] = x; S[t + 4] = y; }
#pragma unroll
            for (int t = 1; t < 16; ++t) {
                float acc = S[t];
#pragma unroll
                for (int s4 = 0; s4 < (t + 3) / 4; ++s4) { const f32x4 la = *(const LAS f32x4*)(scr + SCR_LAB + (t * 16 + 4 * s4) * 4), lk = *(const LAS f32x4*)(scr + SCR_LAK + (t * 16 + 4 * s4) * 4);
#pragma unroll
                    for (int e = 0; e < 4; ++e) if (4 * s4 + e < t) { acc += la[e] * S[4 * s4 + e]; acc += lk[e] * Vv[4 * s4 + e]; } }
                S[t] = acc;
            }
            bf16x8 Sf[2], Vf[2]; scan_sfrags(S, Sf); scan_sfrags(Vv, Vf);
            {   const bf16x8 mb = *(const LAS bf16x8*)(scr + SCR_MRB + l15 * 32 + hl * 16), mk = *(const LAS bf16x8*)(scr + SCR_MRK + l15 * 32 + hl * 16);
                Y[0] = MK_MFMA(mb, Sf[0], Y[0]); Y[1] = MK_MFMA(mb, Sf[1], Y[1]); Y[0] = MK_MFMA(mk, Vf[0], Y[0]); Y[1] = MK_MFMA(mk, Vf[1], Y[1]); }
#pragma unroll
            for (int I = 0; I < 2; ++I) {
                const LAS unsigned char* col = my + 4096 + (8 * hl) * 128 + kperm(32 * I + l31) * 2;
                unsigned short bs[8], ks[8];
#pragma unroll
                for (int e = 0; e < 8; ++e) { bs[e] = *(const LAS unsigned short*)(col + e * 128); ks[e] = *(const LAS unsigned short*)(col + 2048 + e * 128); }
                const v4u bu = {(unsigned)bs[0] | ((unsigned)bs[1] << 16), (unsigned)bs[2] | ((unsigned)bs[3] << 16), (unsigned)bs[4] | ((unsigned)bs[5] << 16), (unsigned)bs[6] | ((unsigned)bs[7] << 16)};
                const v4u ku = {(unsigned)ks[0] | ((unsigned)ks[1] << 16), (unsigned)ks[2] | ((unsigned)ks[3] << 16), (unsigned)ks[4] | ((unsigned)ks[5] << 16), (unsigned)ks[6] | ((unsigned)ks[7] << 16)};
                const bf16x8 ba = __builtin_bit_cast(bf16x8, bu), ka = __builtin_bit_cast(bf16x8, ku);
                Tt[I][0] = MK_MFMA(ba, Sf[0], Tt[I][0]); Tt[I][1] = MK_MFMA(ba, Sf[1], Tt[I][1]); Tt[I][0] = MK_MFMA(ka, Vf[0], Tt[I][0]); Tt[I][1] = MK_MFMA(ka, Vf[1], Tt[I][1]);
            }
            {   GAS float* yb = (GAS float*)(YS + (size_t)d * T * 2048 + (size_t)(tb + (d == 0 ? 4 * hl : 15 - 4 * hl)) * 2048 + h * 64) + l31; const int ystep = d == 0 ? 2048 : -2048;
#pragma unroll
                for (int J = 0; J < 2; ++J)
#pragma unroll
                    for (int r = 0; r < 8; ++r) yb[(8 * (r >> 2) + (r & 3)) * ystep + 32 * J] = Y[J][r]; }
            scan_renorm(Tt, (const LAS float*)(my + 8192), hl);
        }
    }
}

__device__ __forceinline__ void p8_readout(Frame& F) {
    const float* RB = (const float*)(F.ws + WS_RBUF); const float* VB = (const float*)(F.ws + WS_VBUF); const float* YS = (const float*)(F.ws + WS_YS);
    const bf16* KD = (const bf16*)(F.ws + WS_KD);
    const bf16* G = (const bf16*)(F.ws + WS_G); bf16* CAT = (bf16*)(F.ws + WS_CAT);
    const int tpb = (T + F.G - 1) / F.G, tok0 = F.vcu * tpb, lane = pg8::mk_lane();
    for (int it = F.wave; it < tpb * 4; it += NWAVES) {
        const int j = it / tpb, tok = tok0 + it % tpb;
        if (tok >= T) continue;
        const int c = j * 512 + lane * 8;
        float y0[8], y1[8], y[8];
        ldf8(YS + (size_t)tok * 2048 + c, y0); ldf8(YS + ((size_t)T + tok) * 2048 + c, y1);
        float s = 0.f;
#pragma unroll
        for (int i = 0; i < 8; ++i) { y[i] = y0[i] + y1[i]; s += y[i]; }
        s += __shfl_xor(s, 1); s += __shfl_xor(s, 2); s += __shfl_xor(s, 4);
        const float mean = s * (1.0f / 64.0f); float q = 0.f;
#pragma unroll
        for (int i = 0; i < 8; ++i) { const float dlt = y[i] - mean; q += dlt * dlt; }
        q += __shfl_xor(q, 1); q += __shfl_xor(q, 2); q += __shfl_xor(q, 4);
        const float rstd = 1.0f / sqrtf(q * (1.0f / 64.0f) + LNX_EPS);
        float r8[8], v8[8], k0[8], k1[8], rk[8], lw[8], lb[8], g8[8];
        ldf8(RB + (size_t)tok * 2048 + c, r8); ldf8(VB + (size_t)tok * 2048 + c, v8);
        ld8(KD + (size_t)tok * 2048 + c, k0); ld8(KD + ((size_t)TT + tok) * 2048 + c, k1);
        ldf8(F.in[I_RK] + c, rk); ldf8(F.in[I_LNXW] + c, lw); ldf8(F.in[I_LNXB] + c, lb);
        ld8(G + (size_t)tok * 2048 + c, g8);
        float dot = 0.f;
#pragma unroll
        for (int i = 0; i < 8; ++i) dot += r8[i] * (k0[i] + k1[i]) * rk[i];
        dot += __shfl_xor(dot, 1); dot += __shfl_xor(dot, 2); dot += __shfl_xor(dot, 4);
        float o[8];
#pragma unroll
        for (int i = 0; i < 8; ++i) o[i] = ((y[i] - mean) * rstd * lw[i] + lb[i] + dot * v8[i]) * g8[i];
        stb8(CAT + (size_t)tok * D + c, o);
    }
}

template <int K> __device__ __forceinline__ void run_phase(Frame& F) {
    bf16* A1 = (bf16*)(F.ws + WS_A1); bf16* Zb = (bf16*)(F.ws + WS_Z);
    const float* MV = (const float*)(F.ws + WS_MODV);
    (void)A1; (void)Zb; (void)MV;
    asm volatile("; MK_PHASE %0" :: "i"(K) : "memory");
    if constexpr (K == 0) { p0_prologue(F);
    }
    if constexpr (K == 1) { p1_norm1(F);
    }
    if constexpr (K == 2) {
        { pg8::Gemm g{A1, (const bf16*)(F.ws + WS_WIN), T, NZ, D}; pg8::StaticOrder S; S.init(T, NZ, F.G, (int)blockIdx.x);
          pg8::EpiBf16<0> E{Zb, NZ, nullptr, 0, 0, 1.f};
          pg8::gemm_phase<pg8::EpiBf16<0>, pg8::StaticOrder, true, true>(F.lds + RING_OFF, g, S, E, F.wave); }
        { pg8::Gemm g{A1 + (size_t)T * D, (const bf16*)(F.ws + WS_WIN), CTXL, NCTXZ, D}; pg8::StaticOrder S; S.init(CTXL, NCTXZ, F.G, (int)((blockIdx.x + F.G - 64) % F.G));
          pg8::EpiBf16<0> E{Zb + (size_t)T * NZ, NZ, nullptr, 0, 0, 1.f};
          pg8::gemm_phase<pg8::EpiBf16<0>, pg8::StaticOrder, true, true>(F.lds + RING_OFF, g, S, E, F.wave); }
        tr_idle(F, P2T_B, P2T_E, (int)blockIdx.x - 81, 175);
    }
    if constexpr (K == 3) { p3_prep(F);
    }
    if constexpr (K == 4) {
        { int kl = KLORA; asm volatile("" : "+s"(kl));
          pg8::Gemm g{(const bf16*)(F.ws + WS_ALORA), (const bf16*)(F.ws + WS_WLORA), TT, NLORA, kl}; pg8::StaticOrder S; S.init(TT, NLORA, F.G, (int)blockIdx.x);
          pg8::EpiLora E{F.ws + WS_PK, (bf16*)(F.ws + WS_KD), (const float*)(F.ws + WS_KBUF), (const float*)(F.ws + WS_KKBUF), (const float*)(F.ws + WS_RBUF), F.in[I_W0], F.in[I_A0], F.in[I_KA], TT};
          pg8::gemm_phase<pg8::EpiLora, pg8::StaticOrder, true, true>(F.lds + RING_OFF, g, S, E, F.wave); }
        { int kl = KGATE; asm volatile("" : "+s"(kl));
          pg8::Gemm g{(const bf16*)(F.ws + WS_AGATE), (const bf16*)(F.ws + WS_WGATE), T, DR, kl}; pg8::StaticOrder S; S.init(T, DR, F.G, (int)blockIdx.x);
          pg8::EpiBf16<0> E{(bf16*)(F.ws + WS_G), DR, nullptr, 0, 0, 1.f};
          pg8::gemm_phase<pg8::EpiBf16<0>, pg8::StaticOrder, true, true>(F.lds + RING_OFF, g, S, E, F.wave); }

    }
    if constexpr (K == 5) { p5_scanA(F);
    }
    if constexpr (K == 6) { p6_scanB(F); tr_idle(F, P6T_B, P6T_E, F.vcu - 64, 192);

    }
    if constexpr (K == 7) { p7_scanC(F);
    }
    if constexpr (K == 8) { p8_readout(F);
    }
    if constexpr (K == 9) {
        pg8::Gemm g{(const bf16*)(F.ws + WS_CAT), (const bf16*)(F.ws + WS_WOUT), T, D, D}; pg8::StaticOrder S; S.init(T, D, F.G, (int)blockIdx.x);
        pg8::EpiResid E{F.in[I_X], (float*)(F.ws + WS_X1), D, MV + 2 * D};
        pg8::gemm_phase<pg8::EpiResid, pg8::StaticOrder, true, true>(F.lds + RING_OFF, g, S, E, F.wave);

    }
    if constexpr (K == 10) { p10_norm2(F);
    }
    if constexpr (K == 11) {
        pg8::Gemm g{A1, (const bf16*)(F.ws + WS_WGU), T, NGU, D}; pg8::StaticOrder S; S.init(T, NGU, F.G, (int)blockIdx.x);
        pg8::EpiSwiglu E{(bf16*)(F.ws + WS_ACT), DFF};
        pg8::gemm_phase<pg8::EpiSwiglu, pg8::StaticOrder, true, true>(F.lds + RING_OFF, g, S, E, F.wave);
        tr_idle(F, P11T_B, P11T_E, (int)blockIdx.x - 192, 64);
    }
    if constexpr (K == 12) {
        pg8::Gemm g{(const bf16*)(F.ws + WS_ACT), (const bf16*)(F.ws + WS_WDN), T, D, DFF}; pg8::StaticOrder S; S.init(T, D, F.G, (int)blockIdx.x);
        pg8::EpiResid E{(const float*)(F.ws + WS_X1), F.out, D, MV + 5 * D};
        pg8::gemm_phase<pg8::EpiResid, pg8::StaticOrder, true, true>(F.lds + RING_OFF, g, S, E, F.wave);

    }
    if constexpr (K == 13) { p13_final(F);
    }
}

struct Args { const float* in[26]; float* out; unsigned char* ws; int ph_lo, ph_hi, li, pad; };
__global__ void __launch_bounds__(NWAVES * 64, 2) mk_fwd(Args args) {
    extern __shared__ __attribute__((aligned(16))) unsigned char lds[];
    Frame F;
    F.lds = (LAS unsigned char*)lds;
    F.MISC = (volatile LAS unsigned*)(F.lds + MISC_OFF);
    F.wave = __builtin_amdgcn_readfirstlane((int)(threadIdx.x >> 6));
    F.G = gridDim.x; { const int bx = blockIdx.x; F.vcu = (F.G % 8 == 0) ? (bx % 8) * (F.G / 8) + bx / 8 : bx; }
    F.ws = args.ws; F.ctl = (gu32*)(args.ws + WS_CTL); F.out = args.out;
#pragma unroll
    for (int i = 0; i < 26; ++i) F.in[i] = args.in[i];
    for (int u = threadIdx.x; u < (LDS_BYTES - LDSCTL_OFF) / 4; u += NWAVES * 64) ((LAS unsigned*)(F.lds + LDSCTL_OFF))[u] = 0u;
    __syncthreads();
    XcdBarrier bar; bar.bar = (unsigned*)(F.ctl + CW_BAR); bar.x = 0; bar.st = nullptr;
    if (N_LAUNCHES == 1) bar = xcd_barrier_post((unsigned*)(F.ctl + CW_BAR), F.MISC + 8);
#define GRID_BAR() do { if (N_LAUNCHES == 1) xcd_barrier(bar, F.wave); } while (0)
    unsigned long long tp0 = 0, tpa = 0, tpb = 0; (void)tp0;
    const int lo = args.ph_lo, hi = args.ph_hi;
#define IN(k) (lo <= (k) && (k) < hi)
#define BOTH(k) (IN(k) && IN((k) + 1))

    if (IN(0)) { if constexpr (0 == TPA || 0 == TPB) tp0 = __builtin_amdgcn_s_memrealtime(); run_phase<0>(F); if constexpr (PH_REPS[0] > 1) { GRID_BAR(); run_phase<0>(F); } if constexpr (PH_REPS[0] > 2) { GRID_BAR(); run_phase<0>(F); } if (BOTH(0)) GRID_BAR(); if constexpr (0 == TPA) tpa = __builtin_amdgcn_s_memrealtime() - tp0; if constexpr (0 == TPB) tpb = __builtin_amdgcn_s_memrealtime() - tp0; }
    if (IN(1)) { if constexpr (1 == TPA || 1 == TPB) tp0 = __builtin_amdgcn_s_memrealtime(); run_phase<1>(F); if constexpr (PH_REPS[1] > 1) { GRID_BAR(); run_phase<1>(F); } if constexpr (PH_REPS[1] > 2) { GRID_BAR(); run_phase<1>(F); } if (BOTH(1)) GRID_BAR(); if constexpr (1 == TPA) tpa = __builtin_amdgcn_s_memrealtime() - tp0; if constexpr (1 == TPB) tpb = __builtin_amdgcn_s_memrealtime() - tp0; }
    if (IN(2)) { if constexpr (2 == TPA || 2 == TPB) tp0 = __builtin_amdgcn_s_memrealtime(); run_phase<2>(F); if constexpr (PH_REPS[2] > 1) { GRID_BAR(); run_phase<2>(F); } if constexpr (PH_REPS[2] > 2) { GRID_BAR(); run_phase<2>(F); } if (BOTH(2)) GRID_BAR(); if constexpr (2 == TPA) tpa = __builtin_amdgcn_s_memrealtime() - tp0; if constexpr (2 == TPB) tpb = __builtin_amdgcn_s_memrealtime() - tp0; }
    if (IN(3)) { if constexpr (3 == TPA || 3 == TPB) tp0 = __builtin_amdgcn_s_memrealtime(); run_phase<3>(F); if constexpr (PH_REPS[3] > 1) { GRID_BAR(); run_phase<3>(F); } if constexpr (PH_REPS[3] > 2) { GRID_BAR(); run_phase<3>(F); } if (BOTH(3)) GRID_BAR(); if constexpr (3 == TPA) tpa = __builtin_amdgcn_s_memrealtime() - tp0; if constexpr (3 == TPB) tpb = __builtin_amdgcn_s_memrealtime() - tp0; }
    if (IN(4)) { if constexpr (4 == TPA || 4 == TPB) tp0 = __builtin_amdgcn_s_memrealtime(); run_phase<4>(F); if constexpr (PH_REPS[4] > 1) { GRID_BAR(); run_phase<4>(F); } if constexpr (PH_REPS[4] > 2) { GRID_BAR(); run_phase<4>(F); } if (BOTH(4)) GRID_BAR(); if constexpr (4 == TPA) tpa = __builtin_amdgcn_s_memrealtime() - tp0; if constexpr (4 == TPB) tpb = __builtin_amdgcn_s_memrealtime() - tp0; }
    if (IN(5)) { if constexpr (5 == TPA || 5 == TPB) tp0 = __builtin_amdgcn_s_memrealtime(); run_phase<5>(F); if constexpr (PH_REPS[5] > 1) { GRID_BAR(); run_phase<5>(F); } if constexpr (PH_REPS[5] > 2) { GRID_BAR(); run_phase<5>(F); } if (BOTH(5)) GRID_BAR(); if constexpr (5 == TPA) tpa = __builtin_amdgcn_s_memrealtime() - tp0; if constexpr (5 == TPB) tpb = __builtin_amdgcn_s_memrealtime() - tp0; }
    if (IN(6)) { if constexpr (6 == TPA || 6 == TPB) tp0 = __builtin_amdgcn_s_memrealtime(); run_phase<6>(F); if constexpr (PH_REPS[6] > 1) { GRID_BAR(); run_phase<6>(F); } if constexpr (PH_REPS[6] > 2) { GRID_BAR(); run_phase<6>(F); } if (BOTH(6)) GRID_BAR(); if constexpr (6 == TPA) tpa = __builtin_amdgcn_s_memrealtime() - tp0; if constexpr (6 == TPB) tpb = __builtin_amdgcn_s_memrealtime() - tp0; }
    if (IN(7)) { if constexpr (7 == TPA || 7 == TPB) tp0 = __builtin_amdgcn_s_memrealtime(); run_phase<7>(F); if constexpr (PH_REPS[7] > 1) { GRID_BAR(); run_phase<7>(F); } if constexpr (PH_REPS[7] > 2) { GRID_BAR(); run_phase<7>(F); } if (BOTH(7)) GRID_BAR(); if constexpr (7 == TPA) tpa = __builtin_amdgcn_s_memrealtime() - tp0; if constexpr (7 == TPB) tpb = __builtin_amdgcn_s_memrealtime() - tp0; }
    if (IN(8)) { if constexpr (8 == TPA || 8 == TPB) tp0 = __builtin_amdgcn_s_memrealtime(); run_phase<8>(F); if constexpr (PH_REPS[8] > 1) { GRID_BAR(); run_phase<8>(F); } if constexpr (PH_REPS[8] > 2) { GRID_BAR(); run_phase<8>(F); } if (BOTH(8)) GRID_BAR(); if constexpr (8 == TPA) tpa = __builtin_amdgcn_s_memrealtime() - tp0; if constexpr (8 == TPB) tpb = __builtin_amdgcn_s_memrealtime() - tp0; }
    if (IN(9)) { if constexpr (9 == TPA || 9 == TPB) tp0 = __builtin_amdgcn_s_memrealtime(); run_phase<9>(F); if constexpr (PH_REPS[9] > 1) { GRID_BAR(); run_phase<9>(F); } if constexpr (PH_REPS[9] > 2) { GRID_BAR(); run_phase<9>(F); } if (BOTH(9)) GRID_BAR(); if constexpr (9 == TPA) tpa = __builtin_amdgcn_s_memrealtime() - tp0; if constexpr (9 == TPB) tpb = __builtin_amdgcn_s_memrealtime() - tp0; }
    if (IN(10)) { if constexpr (10 == TPA || 10 == TPB) tp0 = __builtin_amdgcn_s_memrealtime(); run_phase<10>(F); if constexpr (PH_REPS[10] > 1) { GRID_BAR(); run_phase<10>(F); } if constexpr (PH_REPS[10] > 2) { GRID_BAR(); run_phase<10>(F); } if (BOTH(10)) GRID_BAR(); if constexpr (10 == TPA) tpa = __builtin_amdgcn_s_memrealtime() - tp0; if constexpr (10 == TPB) tpb = __builtin_amdgcn_s_memrealtime() - tp0; }
    if (IN(11)) { if constexpr (11 == TPA || 11 == TPB) tp0 = __builtin_amdgcn_s_memrealtime(); run_phase<11>(F); if constexpr (PH_REPS[11] > 1) { GRID_BAR(); run_phase<11>(F); } if constexpr (PH_REPS[11] > 2) { GRID_BAR(); run_phase<11>(F); } if (BOTH(11)) GRID_BAR(); if constexpr (11 == TPA) tpa = __builtin_amdgcn_s_memrealtime() - tp0; if constexpr (11 == TPB) tpb = __builtin_amdgcn_s_memrealtime() - tp0; }
    if (IN(12)) { if constexpr (12 == TPA || 12 == TPB) tp0 = __builtin_amdgcn_s_memrealtime(); run_phase<12>(F); if constexpr (PH_REPS[12] > 1) { GRID_BAR(); run_phase<12>(F); } if constexpr (PH_REPS[12] > 2) { GRID_BAR(); run_phase<12>(F); } if (BOTH(12)) GRID_BAR(); if constexpr (12 == TPA) tpa = __builtin_amdgcn_s_memrealtime() - tp0; if constexpr (12 == TPB) tpb = __builtin_amdgcn_s_memrealtime() - tp0; }
    if (IN(13)) { if constexpr (13 == TPA || 13 == TPB) tp0 = __builtin_amdgcn_s_memrealtime(); run_phase<13>(F); if constexpr (PH_REPS[13] > 1) { GRID_BAR(); run_phase<13>(F); } if constexpr (PH_REPS[13] > 2) { GRID_BAR(); run_phase<13>(F); } if (BOTH(13)) GRID_BAR(); if constexpr (13 == TPA) tpa = __builtin_amdgcn_s_memrealtime() - tp0; if constexpr (13 == TPB) tpb = __builtin_amdgcn_s_memrealtime() - tp0; }
    if constexpr (TPA >= 0 || TPB >= 0) {
        if (blockIdx.x == 0 && F.wave == 0) { const unsigned long long ua = (tpa + 500ull) / 1000ull, ub = (tpb + 500ull) / 1000ull, extra = ua * 100000ull + ub * 1000ull, t1 = __builtin_amdgcn_s_memrealtime();
            while (__builtin_amdgcn_s_memrealtime() - t1 < extra) __builtin_amdgcn_s_sleep(16); }
    }
#undef IN
#undef BOTH
}

extern "C" void kernel_launch(void* const* d_in, const int* in_sizes, int n_in, void* d_out, int out_size, void* d_ws, size_t ws_size, hipStream_t stream) {
    static int grid = 0;
    if (grid == 0) {
        if (n_in != 26 || out_size != T * D || ws_size < WS_END) { fprintf(stderr, "kernel_launch: unexpected shapes: n_in %d out %d ws %zu (need %zu)\n", n_in, out_size, ws_size, (size_t)WS_END); grid = -1; return; }
        int dev = 0, cus = 0, per_cu = 0;
        if (hipGetDevice(&dev) != hipSuccess || hipDeviceGetAttribute(&cus, hipDeviceAttributeMultiprocessorCount, dev) != hipSuccess) { grid = -1; return; }
        if (hipFuncSetAttribute((const void*)mk_fwd, hipFuncAttributeMaxDynamicSharedMemorySize, LDS_BYTES) != hipSuccess) { fprintf(stderr, "kernel_launch: hipFuncSetAttribute failed\n"); grid = -1; return; }
        if (hipOccupancyMaxActiveBlocksPerMultiprocessor(&per_cu, (const void*)mk_fwd, NWAVES * 64, LDS_BYTES) != hipSuccess || per_cu < 1)
            fprintf(stderr, "kernel_launch: note: occupancy query reports %d workgroups per CU\n", per_cu);
        (void)hipGetLastError();
        grid = cus;
    }
    if (grid < 0) return;
    if (hipMemsetAsync((char*)d_ws + WS_CTL, 0, CTL_ZERO_BYTES, stream) != hipSuccess) return;
    Args a{};
    for (int i = 0; i < 26; ++i) a.in[i] = (const float*)d_in[i];
    a.out = (float*)d_out; a.ws = (unsigned char*)d_ws;
    for (int li = 0; li < N_LAUNCHES; ++li) {
        if (N_LAUNCHES == 1) { a.ph_lo = 0; a.ph_hi = N_PHASES; } else { a.ph_lo = li * N_PHASES / N_LAUNCHES; a.ph_hi = (li + 1) * N_PHASES / N_LAUNCHES; }
        a.li = li;
        hipLaunchKernelGGL(mk_fwd, dim3(grid), dim3(NWAVES * 64), LDS_BYTES, stream, a);
        if (hipPeekAtLastError() != hipSuccess) break;
    }
}
```

```cpp
#include <hip/hip_runtime.h>
#include <cstdio>
#include <cstdint>
namespace pg8 {
#define PG8_LAS __attribute__((address_space(3)))
typedef unsigned short bf16_t;
typedef short bf16x8 __attribute__((ext_vector_type(8)));
typedef float f32x4 __attribute__((ext_vector_type(4)));
typedef unsigned u32x4 __attribute__((ext_vector_type(4)));
constexpr int BM = 256, BK = 64, HALF = 128, HTB = HALF * BK * 2  , STAGE_BYTES = 8 * HTB, NXCD = 8, WGM = 8;

__host__ __device__ __forceinline__ int lds_byte(int r, int c) { const int st = (r >> 4) * 2 + (c >> 5), rr = r & 15, cc = c & 31, ob = rr * 64 + cc * 2; return st * 1024 + (ob ^ (((ob >> 9) & 1) << 5)); }
__host__ __device__ __forceinline__ void stage_rc(int b, int& R, int& C) { const int st = b / 1024, sb = b % 1024, swz = sb ^ (((sb >> 9) & 1) << 5); R = (st >> 1) * 16 + swz / 64; C = (st & 1) * 32 + (swz % 64) / 2; }
__host__ __device__ __forceinline__ int perm32(int rho) { const int n = rho >> 4, i = rho & 15; return 8 * (i >> 2) + 4 * n + (i & 3); }

__device__ __forceinline__ int mk_lane() { int l; asm volatile("v_mbcnt_lo_u32_b32 %0, -1, 0\n\tv_mbcnt_hi_u32_b32 %0, -1, %0" : "=v"(l)); return l; }
struct Unit { int pm, pn; };
struct Gemm { const bf16_t* A; const bf16_t* Bt; int M, N, K; };

struct StaticOrder {
    int nM, nN, nwg, G, c;
    __host__ __device__ void init(int M, int N, int G_, int c_) { nM = M / BM; nN = N / BM; nwg = nM * nN; G = G_; c = c_; }
    __host__ __device__ bool next(int i, Unit& u) const {
        const long L = (long)i * G + c; if (L >= nwg) return false;
        int wgid = (int)L; { const int q = nwg / NXCD, r = nwg % NXCD, xcd = wgid % NXCD, off = wgid / NXCD; wgid = (xcd < r ? xcd * (q + 1) : r * (q + 1) + (xcd - r) * q) + off; }
        const int nig = WGM * nN, gid = wgid / nig, fm = gid * WGM, gsz = (nM - fm) < WGM ? (nM - fm) : WGM;
        u.pm = fm + ((wgid % nig) % gsz); u.pn = (wgid % nig) / gsz; return true;
    }
    __device__ __forceinline__ void a_ready(const Unit&) const {}
    __device__ __forceinline__ void done(const Unit&) const {}
};

__device__ __forceinline__ unsigned cvt_pk_bf16(float lo, float hi) { unsigned r; asm volatile("v_cvt_pk_bf16_f32 %0, %1, %2" : "=v"(r) : "v"(lo), "v"(hi)); return r; }
typedef float f32x2 __attribute__((ext_vector_type(2)));
__device__ __forceinline__ f32x2 gelu_pk(f32x2 v) {
    const f32x2 av = __builtin_elementwise_abs(v), d = av * 0.2316418882f + 1.0f;
    f32x2 t; t.x = __builtin_amdgcn_rcpf(d.x); t.y = __builtin_amdgcn_rcpf(d.y);
    f32x2 q = t * 0.5307027145f + (-0.7265760135f); q = q * t + 0.7107068705f; q = q * t + (-0.142248368f); q = q * t + 0.127414796f; q = q * t;
    const f32x2 s = (v * v) * (-0.72134752044f);
    f32x2 e; e.x = __builtin_amdgcn_exp2f(s.x); e.y = __builtin_amdgcn_exp2f(s.y);
    const f32x2 m = v * (q * e), r = v - m;
    f32x2 o; o.x = v.x < 0.f ? m.x : r.x; o.y = v.y < 0.f ? m.y : r.y; return o;
}

template <int ACT  > struct EpiBf16 {
    static constexpr bool PERM = true, AFTER_DRAIN = false; static_assert(ACT == 0 || ACT == 1, "EpiBf16: ACT is 0 (none) or 1 (gelu_pk)");
    bf16_t* O; int ldc; const float* bias; int split_cols; size_t split_stride; float scale0;
    __device__ __forceinline__ void operator()(const f32x4 (&acc)[2][2][4][2], const Unit& u, int wr, int wc, int fr, int fq) const {
        const int row0 = u.pm * BM + wr * 64 + fr; int colt = u.pn * BM; bf16_t* base = O;
        float sc = 1.f; if (split_cols) { const int t = colt / split_cols; base += (size_t)t * split_stride; colt -= t * split_cols; if (t == 0) sc = scale0; }
        const int col0 = colt + wc * 32 + 8 * fq, bcol0 = u.pn * BM + wc * 32 + 8 * fq;
        f32x4 bv[2][2];
#pragma unroll
        for (int bj = 0; bj < 2; ++bj)
#pragma unroll
            for (int n = 0; n < 2; ++n) bv[bj][n] = bias ? *(const f32x4*)(bias + bcol0 + bj * HALF + 4 * n) : (f32x4){0.f, 0.f, 0.f, 0.f};
#pragma unroll
        for (int ai = 0; ai < 2; ++ai)
#pragma unroll
            for (int m = 0; m < 4; ++m) { bf16_t* rowp = base + (size_t)(row0 + ai * HALF + m * 16) * ldc + col0;
#pragma unroll
                for (int bj = 0; bj < 2; ++bj) { f32x4 v0 = acc[ai][bj][m][0] + bv[bj][0], v1 = acc[ai][bj][m][1] + bv[bj][1];
                    if (ACT == 1) { f32x2 a = gelu_pk((f32x2){v0[0], v0[1]}), b = gelu_pk((f32x2){v0[2], v0[3]}), c = gelu_pk((f32x2){v1[0], v1[1]}), d = gelu_pk((f32x2){v1[2], v1[3]});
                        v0 = (f32x4){a.x, a.y, b.x, b.y}; v1 = (f32x4){c.x, c.y, d.x, d.y}; }
                    v0 = v0 * sc; v1 = v1 * sc; u32x4 w; w.x = cvt_pk_bf16(v0[0], v0[1]); w.y = cvt_pk_bf16(v0[2], v0[3]); w.z = cvt_pk_bf16(v1[0], v1[1]); w.w = cvt_pk_bf16(v1[2], v1[3]);
                    *(u32x4*)(rowp + bj * HALF) = w; } }
    }
};
__device__ __forceinline__ float sigmoidf_(float x) { return __builtin_amdgcn_rcpf(1.0f + __expf(-x)); }
struct EpiResid {
    static constexpr bool PERM = false, AFTER_DRAIN = false;
    const float* base; float* out; int ldc; const float* gvec;
    __device__ __forceinline__ void operator()(const f32x4 (&acc)[2][2][4][2], const Unit& u, int wr, int wc, int fr, int fq) const {
        const int row0 = u.pm * BM + wr * 64 + fr, col0 = u.pn * BM + wc * 32 + 4 * fq;
        f32x4 gv[2][2];
#pragma unroll
        for (int bj = 0; bj < 2; ++bj)
#pragma unroll
            for (int n = 0; n < 2; ++n) gv[bj][n] = *(const __attribute__((address_space(1))) f32x4*)(gvec + col0 + bj * HALF + n * 16);
#pragma unroll
        for (int ai = 0; ai < 2; ++ai)
#pragma unroll
            for (int m = 0; m < 4; ++m) { const size_t off = (size_t)(row0 + ai * HALF + m * 16) * ldc + col0;
#pragma unroll
                for (int bj = 0; bj < 2; ++bj)
#pragma unroll
                    for (int n = 0; n < 2; ++n) { const f32x4 bs = *(const __attribute__((address_space(1))) f32x4*)(base + off + bj * HALF + n * 16);
                        *(__attribute__((address_space(1))) f32x4*)(out + off + bj * HALF + n * 16) = bs + gv[bj][n] * acc[ai][bj][m][n]; }
                if (m & 1) asm volatile("" ::: "memory"); }
    }
};
struct EpiSwiglu {
    static constexpr bool PERM = true, AFTER_DRAIN = false;
    bf16_t* O; int ldc;
    __device__ __forceinline__ void operator()(const f32x4 (&acc)[2][2][4][2], const Unit& u, int wr, int wc, int fr, int fq) const {
        const int row0 = u.pm * BM + wr * 64 + fr, col0 = u.pn * HALF + wc * 32 + 8 * fq;
#pragma unroll
        for (int ai = 0; ai < 2; ++ai)
#pragma unroll
            for (int m = 0; m < 4; ++m) { bf16_t* rowp = O + (size_t)(row0 + ai * HALF + m * 16) * ldc + col0;
                f32x4 h0, h1;
#pragma unroll
                for (int j = 0; j < 4; ++j) { const float g0 = acc[ai][0][m][0][j], g1 = acc[ai][0][m][1][j];
                    h0[j] = g0 * sigmoidf_(g0) * acc[ai][1][m][0][j]; h1[j] = g1 * sigmoidf_(g1) * acc[ai][1][m][1][j]; }
                u32x4 w; w.x = cvt_pk_bf16(h0[0], h0[1]); w.y = cvt_pk_bf16(h0[2], h0[3]); w.z = cvt_pk_bf16(h1[0], h1[1]); w.w = cvt_pk_bf16(h1[2], h1[3]);
                *(__attribute__((address_space(1))) u32x4*)rowp = w; }
    }
};
template <int CTRL> __device__ __forceinline__ float dpp_f(float old, float src) { return __builtin_bit_cast(float, __builtin_amdgcn_update_dpp(__builtin_bit_cast(int, old), __builtin_bit_cast(int, src), CTRL, 0xf, 0xf, false)); }
struct EpiLora {
    static constexpr bool PERM = true, AFTER_DRAIN = false;
    unsigned char* PKB; bf16_t* KD; const float* kbuf; const float* kkbuf; const float* rbuf; const float* w0; const float* a0; const float* k_a; int TT;
    __device__ __forceinline__ void operator()(const f32x4 (&acc)[2][2][4][2], const Unit& u, int wr, int wc, int fr, int fq) const {
        typedef __attribute__((address_space(1))) f32x4 gf4; typedef const __attribute__((address_space(1))) f32x4 cgf4;
        const int d = u.pn >> 4, cg = u.pn & 15;
        const int c8 = cg * HALF + wc * 32 + 8 * fq, h = c8 >> 6, ch = c8 & 63;
        const int row0 = u.pm * BM + wr * 64 + fr;
        f32x4 w0v[2], a0v[2], kav[2];
#pragma unroll
        for (int n = 0; n < 2; ++n) { w0v[n] = *(cgf4*)(w0 + d * 2048 + c8 + 4 * n); a0v[n] = *(cgf4*)(a0 + d * 2048 + c8 + 4 * n); kav[n] = *(cgf4*)(k_a + c8 + 4 * n); }
        f32x4 kq[2][2], kkq[2][2], rq[2][2];
        { const size_t fo0 = (size_t)row0 * 2048 + c8;
#pragma unroll
          for (int n = 0; n < 2; ++n) { kq[0][n] = *(cgf4*)(kbuf + fo0 + 4 * n); kkq[0][n] = *(cgf4*)(kkbuf + fo0 + 4 * n); rq[0][n] = *(cgf4*)(rbuf + fo0 + 4 * n); } }
#pragma unroll
        for (int it = 0; it < 8; ++it) {
            const int ai = it >> 2, m = it & 3;
            if (it + 1 < 8) { const size_t fo1 = (size_t)(row0 + ((it + 1) >> 2) * HALF + ((it + 1) & 3) * 16) * 2048 + c8;
#pragma unroll
                for (int n = 0; n < 2; ++n) { kq[(it + 1) & 1][n] = *(cgf4*)(kbuf + fo1 + 4 * n); kkq[(it + 1) & 1][n] = *(cgf4*)(kkbuf + fo1 + 4 * n); rq[(it + 1) & 1][n] = *(cgf4*)(rbuf + fo1 + 4 * n); } }
            asm volatile("" ::: "memory");
            const int tok = row0 + ai * HALF + m * 16;
            const int tau = d == 0 ? (tok & 15) : 15 - (tok & 15);
            unsigned char* rec = PKB + ((size_t)(d * 32 + h) * (TT / 16) + (tok >> 4)) * 8448;
            const size_t fo = (size_t)tok * 2048 + c8;
            f32x4 g[2]; u32x4 kw;
#pragma unroll
            for (int n = 0; n < 2; ++n) {
                f32x4 gp;
                const f32x4 x = acc[ai][0][m][n] + w0v[n];
#pragma unroll
                for (int j = 0; j < 4; ++j) { float w = __expf(-0.60653066f * sigmoidf_(x[j]));
                    if (d == 0) { w *= dpp_f<0x111>(1.0f, w); w *= dpp_f<0x112>(1.0f, w); w *= dpp_f<0x114>(1.0f, w); w *= dpp_f<0x118>(1.0f, w); g[n][j] = w; gp[j] = dpp_f<0x111>(1.0f, w); }
                    else        { w *= dpp_f<0x101>(1.0f, w); w *= dpp_f<0x102>(1.0f, w); w *= dpp_f<0x104>(1.0f, w); w *= dpp_f<0x108>(1.0f, w); g[n][j] = w; gp[j] = dpp_f<0x101>(1.0f, w); } }
                const f32x4 xa = acc[ai][1][m][n] + a0v[n];
                const f32x4 k4 = kq[it & 1][n], kk4 = kkq[it & 1][n], r4 = rq[it & 1][n];
                f32x4 at, rt, bt, kdt; float kdv[4];
#pragma unroll
                for (int j = 0; j < 4; ++j) { const float a = sigmoidf_(xa[j]), rg = __builtin_amdgcn_rcpf(g[n][j]);
                    kdv[j] = k4[j] * (1.0f + (a - 1.0f) * kav[n][j]);
                    at[j] = -kk4[j] * gp[j]; rt[j] = r4[j] * g[n][j]; bt[j] = kk4[j] * a * rg; kdt[j] = kdv[j] * rg; }
                const int chn = ch + 4 * n;
                {
                    const int p0 = ((((chn >> 5) * 2 + ((chn >> 4) & 1)) * 2 + n) * 8 + ((chn >> 3) & 1) * 4);
                    typedef unsigned u32x2 __attribute__((ext_vector_type(2)));
                    __attribute__((address_space(1))) unsigned char* rp = (__attribute__((address_space(1))) unsigned char*)rec + (tau * 64 + p0) * 2;
                    u32x2 w;
                    w.x = cvt_pk_bf16(at[0], at[1]); w.y = cvt_pk_bf16(at[2], at[3]); *(__attribute__((address_space(1))) u32x2*)(rp) = w;
                    w.x = cvt_pk_bf16(rt[0], rt[1]); w.y = cvt_pk_bf16(rt[2], rt[3]); *(__attribute__((address_space(1))) u32x2*)(rp + 2048) = w;
                    w.x = cvt_pk_bf16(bt[0], bt[1]); w.y = cvt_pk_bf16(bt[2], bt[3]); *(__attribute__((address_space(1))) u32x2*)(rp + 4096) = w;
                    w.x = cvt_pk_bf16(kdt[0], kdt[1]); w.y = cvt_pk_bf16(kdt[2], kdt[3]); *(__attribute__((address_space(1))) u32x2*)(rp + 6144) = w; }
                if (n == 0) { kw.x = cvt_pk_bf16(kdv[0], kdv[1]); kw.y = cvt_pk_bf16(kdv[2], kdv[3]); } else { kw.z = cvt_pk_bf16(kdv[0], kdv[1]); kw.w = cvt_pk_bf16(kdv[2], kdv[3]); }
            }
            *(__attribute__((address_space(1))) u32x4*)(KD + (size_t)d * TT * 2048 + fo) = kw;
            if (fr == (d == 0 ? 15 : 0)) { float* ge = (float*)(rec + 8192) + ch; *(gf4*)ge = g[0]; *(gf4*)(ge + 4) = g[1]; }
        }
    }
};
template <class Epi, class Sched, bool ALIGN_EPI = false, bool SP2 = false>
__device__ __forceinline__ void gemm_phase(PG8_LAS unsigned char* lds, const Gemm g, const Sched& S, const Epi& E, const int wid) {
    const int lane = mk_lane(), tid = wid * 64 + lane, wr = wid >> 2, wc = wid & 3, fr = lane & 15, fq = lane >> 4;
    const int K = g.K, nt = K / BK;
    unsigned voffA[2], voffB[2];
#pragma unroll
    for (int i = 0; i < 2; ++i) { int R, C; stage_rc(tid * 16 + i * 8192, R, C); const int Rb = Epi::PERM ? ((R & ~31) + perm32(R & 31)) : R;
        voffA[i] = (unsigned)(R * K + C) * 2u; voffB[i] = (unsigned)(Rb * K + C) * 2u; }
    const size_t kstep = (size_t)(BK * 2);
    const size_t hstep = (size_t)HALF * K * 2;
    const size_t tstep = 2 * hstep;
    const unsigned ldsw = (unsigned)wid * 1024u;
    const int aoff = lds_byte(wr * 64 + fr, fq * 8), boff = lds_byte(wc * 32 + fr, fq * 8);
#define PG8_SA(b, h) (((b) * 2 + (h)) * HTB)
#define PG8_SB(b, h) ((4 + (b) * 2 + (h)) * HTB)
#define PG8_STAGE(bufoff, gbase, voff) do { _Pragma("unroll") for (int _i = 0; _i < 2; ++_i) \
        __builtin_amdgcn_global_load_lds((const unsigned*)((const char*)(gbase) + (voff)[_i]), (PG8_LAS unsigned*)(lds + (bufoff) + ldsw + _i * 8192), 16, 0, 0); } while (0)
#define PG8_LDA(dst, b, h) do { _Pragma("unroll") for (int m = 0; m < 4; ++m) _Pragma("unroll") for (int k = 0; k < 2; ++k) dst[m][k] = *(const PG8_LAS bf16x8*)(lds + PG8_SA(b, h) + aoff + m * 2048 + k * 1024); } while (0)
#define PG8_LDB(dst, b, h) do { _Pragma("unroll") for (int n = 0; n < 2; ++n) _Pragma("unroll") for (int k = 0; k < 2; ++k) dst[n][k] = *(const PG8_LAS bf16x8*)(lds + PG8_SB(b, h) + boff + n * 2048 + k * 1024); } while (0)
#define PG8_MMA(ai, bj, At, Bt) do { __builtin_amdgcn_s_setprio(1); _Pragma("unroll") for (int m = 0; m < 4; ++m) _Pragma("unroll") for (int n = 0; n < 2; ++n) _Pragma("unroll") for (int k = 0; k < 2; ++k) \
        acc[ai][bj][m][n] = __builtin_amdgcn_mfma_f32_16x16x32_bf16(Bt[n][k], At[m][k], acc[ai][bj][m][n], 0, 0, 0); __builtin_amdgcn_s_setprio(0); } while (0)
#define PG8_WAIT_V(n) asm volatile("s_waitcnt vmcnt(" #n ")" ::: "memory")
#define PG8_WAIT_L(n) asm volatile("s_waitcnt lgkmcnt(" #n ")" ::: "memory")
#define PG8_BAR __builtin_amdgcn_s_barrier()
#define PG8_SCHED __builtin_amdgcn_sched_barrier(0)
    Unit cur, nxt; int ui = 0;
    if (!S.next(0, cur)) return;
    f32x4 acc[2][2][4][2];
#pragma unroll
    for (int a = 0; a < 2; ++a)
#pragma unroll
        for (int b = 0; b < 2; ++b)
#pragma unroll
            for (int m = 0; m < 4; ++m)
#pragma unroll
                for (int n = 0; n < 2; ++n) acc[a][b][m][n] = (f32x4){0.f, 0.f, 0.f, 0.f};
    bf16x8 At[4][2], B0[2][2], B1[2][2];
    const char* cA = (const char*)g.A + (size_t)cur.pm * tstep; const char* cB = (const char*)g.Bt + (size_t)cur.pn * tstep;
    S.a_ready(cur);
    if constexpr (SP2) {
        PG8_STAGE(PG8_SB(0, 0), cB, voffB); PG8_STAGE(PG8_SB(0, 1), cB + hstep, voffB); PG8_STAGE(PG8_SA(0, 0), cA, voffA); PG8_STAGE(PG8_SA(0, 1), cA + hstep, voffA);
        if (wr == 1) PG8_BAR;
        PG8_WAIT_V(2); PG8_BAR;
        PG8_STAGE(PG8_SB(1, 0), cB + kstep, voffB); PG8_STAGE(PG8_SA(1, 0), cA + kstep, voffA); PG8_STAGE(PG8_SB(1, 1), cB + hstep + kstep, voffB);
        PG8_WAIT_V(6); PG8_BAR;
    } else {
        PG8_STAGE(PG8_SB(0, 0), cB, voffB); PG8_STAGE(PG8_SA(0, 0), cA, voffA); PG8_STAGE(PG8_SB(0, 1), cB + hstep, voffB); PG8_STAGE(PG8_SA(0, 1), cA + hstep, voffA);
        if (wr == 1) PG8_BAR;
        PG8_WAIT_V(4); PG8_BAR;
        PG8_STAGE(PG8_SB(1, 0), cB + kstep, voffB); PG8_STAGE(PG8_SA(1, 0), cA + kstep, voffA); PG8_STAGE(PG8_SB(1, 1), cB + hstep + kstep, voffB);
        PG8_WAIT_V(6); PG8_BAR;
    }
    for (;;) {
        const bool has_next = S.next(ui + 1, nxt);
        const char* nA = has_next ? (const char*)g.A + (size_t)nxt.pm * tstep : cA; const char* nB = has_next ? (const char*)g.Bt + (size_t)nxt.pn * tstep : cB;
        for (int t = 0; t < nt; t += 2) {
            const bool last = (t == nt - 2);
            const char* a1 = cA + (size_t)(t + 1) * kstep;
            const char* a2 = last ? nA : cA + (size_t)(t + 2) * kstep; const char* b2 = last ? nB : cB + (size_t)(t + 2) * kstep;
            const char* a3 = a2 + kstep; const char* b3 = b2 + kstep;
            if (last && has_next) S.a_ready(nxt);
            if constexpr (SP2) {
            PG8_LDB(B0, 0, 0); PG8_LDB(B1, 0, 1); PG8_SCHED; PG8_LDA(At, 0, 0); PG8_STAGE(PG8_SA(1, 1), a1 + hstep, voffA);
            PG8_WAIT_V(8); PG8_WAIT_L(0); PG8_BAR; PG8_MMA(0, 0, At, B0); PG8_MMA(0, 1, At, B1); PG8_BAR; PG8_SCHED;
            PG8_LDA(At, 0, 1); PG8_STAGE(PG8_SB(0, 0), b2, voffB); PG8_STAGE(PG8_SB(0, 1), b2 + hstep, voffB); PG8_STAGE(PG8_SA(0, 0), a2, voffA);
            PG8_WAIT_V(8); PG8_WAIT_L(0); PG8_BAR; PG8_MMA(1, 0, At, B0); PG8_MMA(1, 1, At, B1); PG8_BAR; PG8_SCHED;
            PG8_LDB(B0, 1, 0); PG8_LDB(B1, 1, 1); PG8_SCHED; PG8_LDA(At, 1, 0); PG8_STAGE(PG8_SA(0, 1), a2 + hstep, voffA);
            PG8_WAIT_V(8); PG8_WAIT_L(0); PG8_BAR; PG8_MMA(0, 0, At, B0); PG8_MMA(0, 1, At, B1); PG8_BAR; PG8_SCHED;
            PG8_LDA(At, 1, 1); PG8_STAGE(PG8_SB(1, 0), b3, voffB); PG8_STAGE(PG8_SB(1, 1), b3 + hstep, voffB); PG8_STAGE(PG8_SA(1, 0), a3, voffA);
            PG8_WAIT_V(8); PG8_WAIT_L(0); PG8_BAR; PG8_MMA(1, 0, At, B0); PG8_MMA(1, 1, At, B1); PG8_BAR; PG8_SCHED;
            } else {
            PG8_LDB(B0, 0, 0); PG8_SCHED; PG8_LDA(At, 0, 0); PG8_STAGE(PG8_SA(1, 1), a1 + hstep, voffA);
            PG8_WAIT_L(8); PG8_BAR; PG8_WAIT_L(0); PG8_MMA(0, 0, At, B0); PG8_BAR; PG8_SCHED;
            PG8_LDB(B1, 0, 1); PG8_STAGE(PG8_SB(0, 0), b2, voffB);
            PG8_BAR; PG8_WAIT_L(0); PG8_MMA(0, 1, At, B1); PG8_BAR;
            PG8_LDA(At, 0, 1); PG8_STAGE(PG8_SA(0, 0), a2, voffA);
            PG8_BAR; PG8_WAIT_L(0); PG8_MMA(1, 0, At, B0); PG8_BAR; PG8_SCHED;
            PG8_STAGE(PG8_SB(0, 1), b2 + hstep, voffB);
            PG8_WAIT_V(6); PG8_BAR; PG8_MMA(1, 1, At, B1); PG8_BAR;
            PG8_LDB(B0, 1, 0); PG8_SCHED; PG8_LDA(At, 1, 0); PG8_STAGE(PG8_SA(0, 1), a2 + hstep, voffA);
            PG8_WAIT_L(8); PG8_BAR; PG8_WAIT_L(0); PG8_MMA(0, 0, At, B0); PG8_BAR; PG8_SCHED;
            PG8_LDB(B1, 1, 1); PG8_STAGE(PG8_SB(1, 0), b3, voffB);
            PG8_BAR; PG8_WAIT_L(0); PG8_MMA(0, 1, At, B1); PG8_BAR;
            PG8_LDA(At, 1, 1); PG8_STAGE(PG8_SA(1, 0), a3, voffA);
            PG8_BAR; PG8_WAIT_L(0); PG8_MMA(1, 0, At, B0); PG8_BAR; PG8_SCHED;
            PG8_STAGE(PG8_SB(1, 1), b3 + hstep, voffB);
            PG8_WAIT_V(6); PG8_BAR; PG8_MMA(1, 1, At, B1); PG8_BAR;
            }
        }
        if constexpr (ALIGN_EPI) { if (wr == 0) PG8_BAR; }
        if constexpr (!Epi::AFTER_DRAIN) { const int l2 = mk_lane(); E(acc, cur, wr, wc, l2 & 15, l2 >> 4); S.done(cur); }
        if (!has_next) break;
#pragma unroll
        for (int a = 0; a < 2; ++a)
#pragma unroll
            for (int b = 0; b < 2; ++b)
#pragma unroll
                for (int m = 0; m < 4; ++m)
#pragma unroll
                    for (int n = 0; n < 2; ++n) acc[a][b][m][n] = (f32x4){0.f, 0.f, 0.f, 0.f};
        cur = nxt; cA = nA; cB = nB; ++ui;
        if constexpr (ALIGN_EPI) { if (wr == 1) PG8_BAR; }
    }
    PG8_WAIT_V(0);
    if constexpr (!ALIGN_EPI) { if (wr == 0) PG8_BAR; }
    PG8_BAR;
    if constexpr (Epi::AFTER_DRAIN) { E.fused(acc, cur, wr, wc, fr, fq, lds, wid, lane); S.done(cur); }
#undef PG8_SA
#undef PG8_SB
#undef PG8_STAGE
#undef PG8_LDA
#undef PG8_LDB
#undef PG8_MMA
#undef PG8_WAIT_V
#undef PG8_WAIT_L
#undef PG8_BAR
#undef PG8_SCHED
}
}

constexpr int NWAVES = 8;
#ifndef MK_N_LAUNCHES
#define MK_N_LAUNCHES 1
#endif
constexpr int N_PHASES = 14;
#ifndef MK_REPS
#define MK_REPS {1,1,1,1,1,1,1,1,1,1,1,1,1,1}
#endif
constexpr int PH_REPS[14] = MK_REPS;
#ifndef MK_TPA
#define MK_TPA -1
#endif
#ifndef MK_TPB
#define MK_TPB -1
#endif
constexpr int TPA = MK_TPA, TPB = MK_TPB;
constexpr int N_LAUNCHES = MK_N_LAUNCHES;

constexpr int D = 4096, T = 8192, CTXL = 256, TT = T + CTXL;
constexpr int DR = 2048, DC = 2048, NH = 32, HS = 64;
constexpr int OFF_K = 0, OFF_V = 2048, OFF_WL = 4096, OFF_AL = 4192, OFF_R = 4288, OFF_GL = 6336, RWKV_COLS = 6592;
constexpr int OFF_CB = 6592, OFF_CC = 8640, OFF_CX = 10688, IN_COLS = 12736, NZ = 12800;
constexpr int NCTXZ = 4352;
constexpr int DFF = 11008, NGU = 2 * DFF;
constexpr int NLORA = 8192, KLORA = 256, KGATE = 256;
constexpr int MODN = 6 * D;
constexpr int NKC = 16;
constexpr float NORM_EPS = 1e-6f, LNX_EPS = 64e-5f;
constexpr int CHUNK = 256, NCHUNK = 33;

constexpr size_t MiB = 1u << 20;
constexpr size_t WS_CTL = 0, CTL_ZERO_BYTES = 1 * MiB;
constexpr size_t WS_MODP = 1 * MiB;
constexpr size_t WS_MODV = 5 * MiB;
constexpr size_t WS_WLORA = 6 * MiB;
constexpr size_t WS_WGATE = 10 * MiB;
constexpr size_t WS_ALORA = 11 * MiB;
constexpr size_t WS_AGATE = 16 * MiB;
constexpr size_t WS_WOUT = 20 * MiB;
constexpr size_t WS_WGU = 52 * MiB;
constexpr size_t WS_WDN = 224 * MiB;
constexpr size_t WS_WIN = 310 * MiB;
constexpr size_t WS_PU = 310 * MiB;
constexpr size_t WS_SST = 374 * MiB;
constexpr size_t WS_A1 = 410 * MiB;
constexpr size_t WS_CAT = 410 * MiB;
constexpr size_t WS_Z = 476 * MiB;
constexpr size_t WS_YS = 476 * MiB;
constexpr size_t WS_KD = 604 * MiB;
constexpr size_t WS_GE = 670 * MiB;
constexpr size_t WS_KBUF = 683 * MiB;
constexpr size_t WS_KKBUF = 749 * MiB;
constexpr size_t WS_RBUF = 815 * MiB;
constexpr size_t WS_VBUF = 881 * MiB;
constexpr size_t WS_X1 = 683 * MiB;
constexpr size_t WS_PK = 947 * MiB;
constexpr size_t WS_ACT = 947 * MiB;
constexpr size_t WS_G = 1475 * MiB;
constexpr size_t WS_END = 1507 * MiB;
static_assert(WS_MODP + (size_t)NKC * 2 * MODN * 4 <= WS_MODV && WS_ALORA + (size_t)TT * 256 * 2 <= WS_AGATE && WS_WGU + (size_t)NGU * D * 2 <= WS_WDN && WS_WDN + (size_t)D * DFF * 2 <= WS_WIN, "ws map 1");
static_assert(WS_WIN + (size_t)NZ * D * 2 <= WS_A1 && WS_SST + (size_t)64 * NCHUNK * 16384 <= WS_A1 && WS_A1 + (size_t)TT * D * 2 <= WS_Z && WS_Z + (size_t)TT * NZ * 2 <= WS_KBUF, "ws map 2");
static_assert(WS_YS + (size_t)2 * T * 2048 * 4 <= WS_KD && WS_KD + (size_t)2 * TT * 2048 * 2 <= WS_GE && WS_GE + (size_t)64 * (TT / 16) * 256 <= WS_KBUF, "ws map 3");
static_assert(WS_KBUF + (size_t)TT * 2048 * 4 <= WS_KKBUF && WS_KKBUF + (size_t)TT * 2048 * 4 <= WS_RBUF && WS_RBUF + (size_t)TT * 2048 * 4 <= WS_VBUF && WS_VBUF + (size_t)TT * 2048 * 4 <= WS_PK, "ws map 4");
static_assert(WS_X1 + (size_t)T * D * 4 <= WS_RBUF && WS_PK + (size_t)64 * TT * 1024 <= WS_G && WS_ACT + (size_t)T * DFF * 2 <= WS_G && WS_G + (size_t)T * 2048 * 2 <= WS_END && WS_CAT + (size_t)T * D * 2 <= WS_Z, "ws map 5");
constexpr int CW_TMO = 0;
constexpr int CW_BAR = 4096;

constexpr int RING_OFF = 0, RING_BYTES = 131072;
constexpr int LDSCTL_OFF = RING_BYTES, MISC_OFF = LDSCTL_OFF + 320;
constexpr int LDS_BYTES = 147456;
static_assert(MISC_OFF + 128 <= LDS_BYTES, "LDS map");

#define GAS __attribute__((address_space(1)))
#define LAS __attribute__((address_space(3)))
typedef unsigned short bf16;
typedef unsigned v4u __attribute__((ext_vector_type(4)));
typedef unsigned v2u __attribute__((ext_vector_type(2)));
typedef float f32x4 __attribute__((ext_vector_type(4)));
typedef GAS unsigned gu32;
#define RLX_AGENT __ATOMIC_RELAXED, __HIP_MEMORY_SCOPE_AGENT
#define LDS_WAIT() asm volatile("s_waitcnt lgkmcnt(0)" ::: "memory")
#define VM_WAIT() asm volatile("s_waitcnt vmcnt(0)" ::: "memory")
__device__ __forceinline__ unsigned f2bf(float f) { unsigned u = __builtin_bit_cast(unsigned, f); return (u + 0x7fffu + ((u >> 16) & 1u)) >> 16; }
__device__ __forceinline__ unsigned pk2(float lo, float hi) { return f2bf(lo) | (f2bf(hi) << 16); }
__device__ __forceinline__ float bflo(unsigned w) { return __builtin_bit_cast(float, w << 16); }
__device__ __forceinline__ float bfhi(unsigned w) { return __builtin_bit_cast(float, w & 0xffff0000u); }
__device__ __forceinline__ float sigm(float x) { return 1.0f / (1.0f + __expf(-x)); }

#define XB_TMO      128
#define XB_XCNT(j)  (256  + 64 * (j))
#define XB_XSUB(j)  (1280 + 64 * (j))
#define XB_XGEN(j)  (2304 + 64 * (j))
#define XB_TOP      3328
#define XB_TOPGEN   3392
#define XCD_BAR_WORDS 3456
#define XB_SPIN_CAP (1u << 18)
__device__ __forceinline__ unsigned xb_ld(unsigned* p)              { return __hip_atomic_load(p, __ATOMIC_RELAXED, __HIP_MEMORY_SCOPE_AGENT); }
__device__ __forceinline__ unsigned xb_add(unsigned* p, unsigned v) { return __hip_atomic_fetch_add(p, v, __ATOMIC_RELAXED, __HIP_MEMORY_SCOPE_AGENT); }
__device__ __forceinline__ unsigned xb_xcc_id() { return (unsigned)__builtin_amdgcn_s_getreg((3 << 11) | 20) & 0xFu; }
#define XB_SPIN(cond, bar) do { unsigned _sp = 0; while (cond) { __builtin_amdgcn_s_sleep(1); \
    if ((++_sp & 255u) == 0u) { if (xb_ld(&(bar)[XB_TMO])) break; if (_sp > XB_SPIN_CAP) { atomicAdd(&(bar)[XB_TMO], 1u); break; } } } } while (0)
struct XcdBarrier { unsigned* bar; unsigned x; volatile LAS unsigned* st; };
__device__ __forceinline__ XcdBarrier xcd_barrier_post(unsigned* bar, volatile LAS unsigned* st) {
    XcdBarrier b; b.bar = bar; b.x = xb_xcc_id(); b.st = st;
    if (threadIdx.x == 0) (void)xb_add(&bar[XB_XCNT(b.x)], 1u);
    return b;
}
__device__ __forceinline__ void xcd_barrier_complete(unsigned* bar, unsigned x, unsigned& nloc, unsigned& nx) {
    const unsigned G = gridDim.x * gridDim.y * gridDim.z;
    unsigned sum, cnt, mine, sp = 0u;
    for (;;) {
        sum = 0u; cnt = 0u; mine = 0u;
#pragma unroll
        for (unsigned j = 0; j < 16; ++j) { const unsigned c = xb_ld(&bar[XB_XCNT(j)]); sum += c; cnt += (c > 0u) ? 1u : 0u; mine = (j == x) ? c : mine; }
        if (sum == G) break;
        __builtin_amdgcn_s_sleep(1);
        if ((++sp & 255u) == 0u) { if (xb_ld(&bar[XB_TMO])) break; if (sp > XB_SPIN_CAP) { atomicAdd(&bar[XB_TMO], 1u); break; } }
    }
    nloc = mine > 0u ? mine : 1u; nx = cnt > 0u ? cnt : 1u;
}
__device__ __forceinline__ void xcd_barrier(const XcdBarrier& b, const int wave) {
    asm volatile("s_waitcnt vmcnt(0)" ::: "memory");
    __syncthreads();
    if (wave == 0 && pg8::mk_lane() == 0) {
        unsigned* bar = b.bar;
        __builtin_amdgcn_s_waitcnt(0);
        unsigned nloc = b.st[0], nx = b.st[1];
        if (nloc == 0u) { xcd_barrier_complete(bar, b.x, nloc, nx); b.st[0] = nloc; b.st[1] = nx; }
        const unsigned old = xb_add(&bar[XB_XSUB(b.x)], 1u);
        const unsigned gen = old / nloc;
        if (old + 1u == (gen + 1u) * nloc) {
            __builtin_amdgcn_fence(__ATOMIC_RELEASE, "agent");
            asm volatile("s_waitcnt vmcnt(0)" ::: "memory");
            const unsigned og = xb_add(&bar[XB_TOP], 1u);
            const unsigned tg = og / nx;
            if (og + 1u == (tg + 1u) * nx) xb_add(&bar[XB_TOPGEN], 1u);
            else XB_SPIN(xb_ld(&bar[XB_TOPGEN]) == tg, bar);
            __builtin_amdgcn_fence(__ATOMIC_ACQUIRE, "agent");
            xb_add(&bar[XB_XGEN(b.x)], 1u);
            asm volatile("s_waitcnt vmcnt(0)" ::: "memory");
        } else {
            XB_SPIN(xb_ld(&bar[XB_XGEN(b.x)]) == gen, bar);
            __builtin_amdgcn_fence(__ATOMIC_ACQUIRE, "agent");
            asm volatile("s_waitcnt vmcnt(0)" ::: "memory");
        }
    }
    __syncthreads();
}

struct Frame {
    LAS unsigned char* lds;
    volatile LAS unsigned* MISC;
    gu32* ctl;
    int wave;
    int vcu, G;
    unsigned char* ws;
    const float* in[26];
    float* out;
};
enum { I_X = 0, I_C, I_CTX, I_CCTX, I_WADA, I_BADA, I_NORM1, I_WIN, I_MU, I_KK, I_KA, I_RK, I_W0, I_WDU, I_A0, I_WIU, I_WGU, I_LNXW, I_LNXB, I_CONVW, I_WOUT, I_NORM2, I_WFG, I_WFU, I_WFD, I_NORMF };

__device__ __forceinline__ float wave_sum(float v) {
#pragma unroll
    for (int o = 1; o < 64; o <<= 1) v += __shfl_xor(v, o);
    return v;
}

__device__ __forceinline__ void p0_transpose_item(const float* W, int K, int N, bf16* WT, int ldk, int row_off, LAS float* scr, int item, int lane) {
    const int nblk = N / 32, kb = item / nblk, nb = item % nblk, k0 = 64 * kb, n0 = 32 * nb;
    float tv[32];
#pragma unroll
    for (int i = 0; i < 32; ++i) tv[i] = *(const GAS float*)(W + (size_t)(k0 + 2 * i + (lane >> 5)) * N + n0 + (lane & 31));
#pragma unroll
    for (int i = 0; i < 32; ++i) scr[(2 * i + (lane >> 5)) * 33 + (lane & 31)] = tv[i];
    LDS_WAIT(); asm volatile("" ::: "memory");
    const int c = lane & 7;
#pragma unroll
    for (int j = 0; j < 4; ++j) { const int n = (lane >> 3) + 8 * j; const LAS float* s = scr + (8 * c) * 33 + n;
        v4u o; o.x = pk2(s[0 * 33], s[1 * 33]); o.y = pk2(s[2 * 33], s[3 * 33]); o.z = pk2(s[4 * 33], s[5 * 33]); o.w = pk2(s[6 * 33], s[7 * 33]);
        *(GAS v4u*)(WT + (size_t)(row_off + n0 + n) * ldk + k0 + 8 * c) = o; }
    LDS_WAIT(); asm volatile("" ::: "memory");
}
constexpr int TI_IN = (D / 64) * (IN_COLS / 32), TI_OUT = (D / 64) * (D / 32), TI_G = (D / 64) * (DFF / 32), TI_DN = (DFF / 64) * (D / 32);
constexpr int TI_TOTAL = TI_IN + TI_OUT + 2 * TI_G + TI_DN;
constexpr int GEMV_UNITS = NKC * (MODN / 256);
constexpr int IB_OUT = TI_IN, IB_G = IB_OUT + TI_OUT, IB_U = IB_G + TI_G, IB_D = IB_U + TI_G;
constexpr int P2T_B = IB_OUT, P2T_E = IB_G + 13200;
constexpr int P6T_B = P2T_E, P6T_E = IB_U + 11000;
constexpr int P0X_B = P6T_E, P0X_E = IB_D + 12000;
constexpr int P11T_B = P0X_E, P11T_E = TI_TOTAL;
constexpr int P0_ITEMS = TI_IN + (P0X_E - P0X_B);
constexpr int TI_PER_GEMV_WAVE = 18, TI_PER_OTHER_WAVE = 42;
static_assert(GEMV_UNITS <= 2048 && GEMV_UNITS * TI_PER_GEMV_WAVE + (2048 - GEMV_UNITS) * TI_PER_OTHER_WAVE >= P0_ITEMS, "P0 item split");

__device__ __forceinline__ void tr_item(Frame& F, int it, LAS float* scr, int lane) {
    int r = it;
    if (r < TI_IN) { p0_transpose_item(F.in[I_WIN], D, IN_COLS, (bf16*)(F.ws + WS_WIN), D, 0, scr, r, lane); return; } r -= TI_IN;
    if (r < TI_OUT) { p0_transpose_item(F.in[I_WOUT], D, D, (bf16*)(F.ws + WS_WOUT), D, 0, scr, r, lane); return; } r -= TI_OUT;
    if (r < TI_G) { const int n0 = 32 * (r % (DFF / 32)); p0_transpose_item(F.in[I_WFG], D, DFF, (bf16*)(F.ws + WS_WGU), D, 256 * (n0 >> 7) + (n0 & 127) - n0, scr, r, lane); return; } r -= TI_G;
    if (r < TI_G) { const int n0 = 32 * (r % (DFF / 32)); p0_transpose_item(F.in[I_WFU], D, DFF, (bf16*)(F.ws + WS_WGU), D, 256 * (n0 >> 7) + 128 + (n0 & 127) - n0, scr, r, lane); return; } r -= TI_G;
    p0_transpose_item(F.in[I_WFD], DFF, D, (bf16*)(F.ws + WS_WDN), DFF, 0, scr, r, lane);
}
__device__ __forceinline__ void tr_range(Frame& F, int b, int e, int rank, int nw, LAS float* scr, int lane) {
    const int per = (e - b + nw - 1) / nw; int i0 = b + rank * per, i1 = i0 + per; if (i1 > e) i1 = e;
    for (int it = i0; it < i1; ++it) tr_item(F, it, scr, lane);
}
__device__ __forceinline__ void tr_idle(Frame& F, int b, int e, int rank_blk, int nblk) {
    if (F.G != 256 || rank_blk < 0) return;
    tr_range(F, b, e, rank_blk * NWAVES + F.wave, nblk * NWAVES, (LAS float*)(F.lds + RING_OFF + F.wave * 16384), pg8::mk_lane());
}
__device__ __forceinline__ void p0_gemv_unit(Frame& F, int unit, int lane) {
    const int kc = unit / (MODN / 256), cc = unit % (MODN / 256);
    const int k0 = kc * 256, col = cc * 256 + lane * 4;
    int sv[4], sc[4];
#pragma unroll
    for (int q = 0; q < 4; ++q) { const float c = *(const GAS float*)(F.in[I_C] + k0 + q * 64 + lane), cx = *(const GAS float*)(F.in[I_CCTX] + k0 + q * 64 + lane);
        sv[q] = __builtin_bit_cast(int, c * sigm(c)); sc[q] = __builtin_bit_cast(int, cx * sigm(cx)); }
    f32x4 a0 = (f32x4){0.f, 0.f, 0.f, 0.f}, a1 = a0;
    const GAS f32x4* wp = (const GAS f32x4*)(F.in[I_WADA] + (size_t)k0 * MODN + col);
#pragma unroll
    for (int q = 0; q < 4; ++q) {
#pragma unroll 16
        for (int i = 0; i < 64; ++i) { const f32x4 w = wp[(size_t)(q * 64 + i) * (MODN / 4)];
            const float s = __builtin_bit_cast(float, __builtin_amdgcn_readlane(sv[q], i)), t = __builtin_bit_cast(float, __builtin_amdgcn_readlane(sc[q], i));
            a0 += w * s; a1 += w * t; }
    }
    float* mp = (float*)(F.ws + WS_MODP);
    *(GAS f32x4*)(mp + (size_t)(kc * 2 + 0) * MODN + col) = a0;
    *(GAS f32x4*)(mp + (size_t)(kc * 2 + 1) * MODN + col) = a1;
}

__device__ __forceinline__ void p0_prologue(Frame& F) {
    LAS float* scr = (LAS float*)(F.lds + RING_OFF + F.wave * 16384);
    const int lane = pg8::mk_lane();
    const int gw = F.vcu * NWAVES + F.wave, NGW = F.G * NWAVES;
    const int gt = gw * 64 + lane, NGT = NGW * 64;
    {
        unsigned* wl = (unsigned*)(F.ws + WS_WLORA);
        for (int i = gt; i < NLORA * KLORA / 2; i += NGT) { const int n = i >> 7, k = (i & 127) * 2, pn = n >> 8, d = pn >> 4, isic = (n >> 7) & 1, ch = (pn & 15) * 128 + (n & 127); float v0 = 0.f, v1 = 0.f;
            if (k < 96) { if (!isic) { v0 = *(const GAS float*)(F.in[I_WDU] + (size_t)(d * 96 + k) * 2048 + ch); v1 = *(const GAS float*)(F.in[I_WDU] + (size_t)(d * 96 + k + 1) * 2048 + ch); } }
            else if (k < 192) { if (isic) { v0 = *(const GAS float*)(F.in[I_WIU] + (size_t)(d * 96 + k - 96) * 2048 + ch); v1 = *(const GAS float*)(F.in[I_WIU] + (size_t)(d * 96 + k - 95) * 2048 + ch); } }
            *(GAS unsigned*)(wl + i) = pk2(v0, v1); }
        unsigned* wg = (unsigned*)(F.ws + WS_WGATE);
        for (int i = gt; i < 2048 * KGATE / 2; i += NGT) { const int n = i >> 7, k = (i & 127) * 2;
            *(GAS unsigned*)(wg + i) = pk2(*(const GAS float*)(F.in[I_WGU] + (size_t)k * 2048 + n), *(const GAS float*)(F.in[I_WGU] + (size_t)(k + 1) * 2048 + n)); }
        v4u* zp = (v4u*)(F.ws + WS_WIN + (size_t)IN_COLS * D * 2);
        for (int i = gt; i < (NZ - IN_COLS) * D * 2 / 16; i += NGT) *(GAS v4u*)(zp + i) = (v4u){0u, 0u, 0u, 0u};
    }
    for (int u = gw; u < GEMV_UNITS; u += NGW) p0_gemv_unit(F, u, lane);
    if (F.G == 256) {
        int it0, it1;
        if (gw < GEMV_UNITS) { it0 = gw * TI_PER_GEMV_WAVE; it1 = it0 + TI_PER_GEMV_WAVE; }
        else { it0 = GEMV_UNITS * TI_PER_GEMV_WAVE + (gw - GEMV_UNITS) * TI_PER_OTHER_WAVE; it1 = it0 + TI_PER_OTHER_WAVE; }
        if (it1 > P0_ITEMS) it1 = P0_ITEMS;
        for (int it = it0; it < it1; ++it) tr_item(F, it < TI_IN ? it : P0X_B + (it - TI_IN), scr, lane);
    } else tr_range(F, 0, TI_TOTAL, gw, NGW, scr, lane);
}

__device__ __forceinline__ void norm_row(const float* xrow, bf16* orow, const LAS float* gs, const LAS float* sh, int lane) {
    const GAS f32x4* xr = (const GAS f32x4*)xrow + lane;
    f32x4 v[16]; float s = 0.f;
#pragma unroll
    for (int j = 0; j < 16; ++j) { v[j] = xr[64 * j]; s += (v[j].x * v[j].x + v[j].y * v[j].y) + (v[j].z * v[j].z + v[j].w * v[j].w); }
    const float rstd = 1.0f / sqrtf(wave_sum(s) * (1.f / D) + NORM_EPS);
    GAS v2u* o8 = (GAS v2u*)orow + lane;
#pragma unroll
    for (int j = 0; j < 16; ++j) { const f32x4 g = *(const LAS f32x4*)(gs + 4 * lane + 256 * j), b = *(const LAS f32x4*)(sh + 4 * lane + 256 * j);
        const f32x4 y = v[j] * rstd * g + b; v2u o; o.x = pk2(y.x, y.y); o.y = pk2(y.z, y.w); o8[64 * j] = o; }
}
__device__ __forceinline__ void p1_norm1(Frame& F) {
    const int lane = pg8::mk_lane(), tid = F.wave * 64 + lane;
    LAS float* tab = (LAS float*)(F.lds + RING_OFF);
    const float* mp = (const float*)(F.ws + WS_MODP);
    for (int i = tid; i < 4 * D; i += NWAVES * 64) {
        const int which = i >> 12, k = i & (D - 1), isc = which >> 1, part = which & 1;
        const int col = part == 0 ? D + k : k;
        float s = *(const GAS float*)(F.in[I_BADA] + col);
#pragma unroll
        for (int p = 0; p < NKC; ++p) s += *(const GAS float*)(mp + (size_t)(p * 2 + isc) * MODN + col);
        tab[i] = part == 0 ? *(const GAS float*)(F.in[I_NORM1] + k) * (1.0f + s) : s;
    }
    {
        float* mv = (float*)(F.ws + WS_MODV);
        for (int i = F.vcu * (NWAVES * 64) + tid; i < 2 * MODN; i += F.G * NWAVES * 64) { const int isc = i / MODN, col = i % MODN;
            float s = *(const GAS float*)(F.in[I_BADA] + col);
#pragma unroll
            for (int p = 0; p < NKC; ++p) s += *(const GAS float*)(mp + (size_t)(p * 2 + isc) * MODN + col);
            *(GAS float*)(mv + i) = s; }
    }
    __syncthreads();
    const int gw = F.vcu * NWAVES + F.wave, NGW = F.G * NWAVES;
    bf16* A1 = (bf16*)(F.ws + WS_A1);
    for (int m = gw; m < TT; m += NGW) {
        if (m < T) norm_row(F.in[I_X] + (size_t)m * D, A1 + (size_t)m * D, tab, tab + D, lane);
        else norm_row(F.in[I_CTX] + (size_t)(m - T) * D, A1 + (size_t)m * D, tab + 2 * D, tab + 3 * D, lane);
    }
    __syncthreads();
}
__device__ __forceinline__ void p10_norm2(Frame& F) {
    const int lane = pg8::mk_lane(), tid = F.wave * 64 + lane;
    LAS float* tab = (LAS float*)(F.lds + RING_OFF);
    const float* mv = (const float*)(F.ws + WS_MODV);
    for (int i = tid; i < 2 * D; i += NWAVES * 64) { const int part = i >> 12, k = i & (D - 1);
        tab[i] = part == 0 ? *(const GAS float*)(F.in[I_NORM2] + k) * (1.0f + *(const GAS float*)(mv + 4 * D + k)) : *(const GAS float*)(mv + 3 * D + k); }
    __syncthreads();
    const int gw = F.vcu * NWAVES + F.wave, NGW = F.G * NWAVES;
    bf16* A1 = (bf16*)(F.ws + WS_A1); const float* X1 = (const float*)(F.ws + WS_X1);
    for (int m = gw; m < T; m += NGW) norm_row(X1 + (size_t)m * D, A1 + (size_t)m * D, tab, tab + D, lane);
    __syncthreads();
}
__device__ __forceinline__ void p13_final(Frame& F) {
    const int lane = pg8::mk_lane();
    const int gw = F.vcu * NWAVES + F.wave, NGW = F.G * NWAVES;
    for (int m = gw; m < T; m += NGW) {
        GAS f32x4* xr = (GAS f32x4*)(F.out + (size_t)m * D) + lane;
        f32x4 v[16]; float s = 0.f;
#pragma unroll
        for (int j = 0; j < 16; ++j) { v[j] = xr[64 * j]; s += (v[j].x * v[j].x + v[j].y * v[j].y) + (v[j].z * v[j].z + v[j].w * v[j].w); }
        const float rstd = 1.0f / sqrtf(wave_sum(s) * (1.f / D) + NORM_EPS);
#pragma unroll
        for (int j = 0; j < 16; ++j) { const f32x4 g = *((const GAS f32x4*)F.in[I_NORMF] + lane + 64 * j); xr[64 * j] = v[j] * rstd * g; }
    }
}

__device__ __forceinline__ void ld8(const bf16* p, float (&f)[8]) { const v4u r = *(const GAS v4u*)p;
    f[0] = bflo(r.x); f[1] = bfhi(r.x); f[2] = bflo(r.y); f[3] = bfhi(r.y); f[4] = bflo(r.z); f[5] = bfhi(r.z); f[6] = bflo(r.w); f[7] = bfhi(r.w); }
__device__ __forceinline__ void ldf8(const float* p, float (&f)[8]) { const f32x4 a = *(const GAS f32x4*)p, b = *(const GAS f32x4*)(p + 4);
    f[0] = a.x; f[1] = a.y; f[2] = a.z; f[3] = a.w; f[4] = b.x; f[5] = b.y; f[6] = b.z; f[7] = b.w; }
__device__ __forceinline__ void stf8(float* p, const float (&f)[8]) { *(GAS f32x4*)p = (f32x4){f[0], f[1], f[2], f[3]}; *(GAS f32x4*)(p + 4) = (f32x4){f[4], f[5], f[6], f[7]}; }
__device__ __forceinline__ void stb8(bf16* p, const float (&f)[8]) { v4u o; o.x = pk2(f[0], f[1]); o.y = pk2(f[2], f[3]); o.z = pk2(f[4], f[5]); o.w = pk2(f[6], f[7]); *(GAS v4u*)p = o; }
__device__ __forceinline__ void za8(const bf16* Z, int row, bool hp, bool hn, int c, const float* mu, float (&o)[8]) {
    float zc[8], zp[8], zn[8], m8[8];
    ld8(Z + (size_t)row * NZ + c, zc);
    if (hp) ld8(Z + (size_t)(row - 1) * NZ + c, zp); else { _Pragma("unroll") for (int i = 0; i < 8; ++i) zp[i] = 0.f; }
    if (hn) ld8(Z + (size_t)(row + 1) * NZ + c, zn); else { _Pragma("unroll") for (int i = 0; i < 8; ++i) zn[i] = 0.f; }
    ldf8(mu + c, m8);
#pragma unroll
    for (int i = 0; i < 8; ++i) o[i] = zc[i] + m8[i] * (0.5f * (zp[i] + zn[i]) - zc[i]);
}
__device__ __forceinline__ void zero8(float (&f)[8]) {
#pragma unroll
    for (int i = 0; i < 8; ++i) f[i] = 0.f; }
__device__ __forceinline__ void cp8(float (&d)[8], const float (&s)[8]) {
#pragma unroll
    for (int i = 0; i < 8; ++i) d[i] = s[i]; }
__device__ __forceinline__ void p3_prep(Frame& F) {
    const bf16* Z = (const bf16*)(F.ws + WS_Z);
    float* KB = (float*)(F.ws + WS_KBUF); float* KKB = (float*)(F.ws + WS_KKBUF); float* RB = (float*)(F.ws + WS_RBUF); float* VB = (float*)(F.ws + WS_VBUF);
    bf16* AL = (bf16*)(F.ws + WS_ALORA); bf16* AG = (bf16*)(F.ws + WS_AGATE); bf16* CAT = (bf16*)(F.ws + WS_CAT);
    const float* mu = F.in[I_MU];
    const int tpb = (TT + F.G - 1) / F.G;
    const int tok0 = F.vcu * tpb, half0 = (tpb + 1) / 2;
    const int lane = pg8::mk_lane();
    for (int it = F.wave; it < 36; it += NWAVES) {
        const int type = it >> 1, hf = it & 1;
        int tA = tok0 + (hf ? half0 : 0), tB = tok0 + (hf ? tpb : half0);
        if (tB > TT) tB = TT;
        if (tA >= tB) continue;
        if (type < 14) {
            int zoff, c = 0; bool act = true;
            if (type < 12) { const int kind = type >> 2; c = (type & 3) * 512 + lane * 8; zoff = (kind == 0 ? OFF_K : (kind == 1 ? OFF_V : OFF_R)) + c; }
            else if (type == 12) { act = lane < 24; zoff = OFF_WL + (act ? lane : 0) * 8; }
            else { act = lane < 32; zoff = OFF_GL + (act ? lane : 0) * 8; }
            float m8[8], kk8[8]; ldf8(mu + zoff, m8);
            if (type < 4) ldf8(F.in[I_KK] + c, kk8); else zero8(kk8);
            float zp[8], zc[8], zn[8], znn[8];
            if (tA > 0) ld8(Z + (size_t)(tA - 1) * NZ + zoff, zp); else zero8(zp);
            ld8(Z + (size_t)tA * NZ + zoff, zc);
            if (tA + 1 < TT) ld8(Z + (size_t)(tA + 1) * NZ + zoff, zn); else zero8(zn);
            for (int t = tA; t < tB; ++t) {
                if (t + 2 < TT) ld8(Z + (size_t)(t + 2) * NZ + zoff, znn); else zero8(znn);
                const bool isctx = t >= T; const int pos = isctx ? t - T : (t & 63);
                const bool hp = pos > 0, hn = isctx ? (pos < CTXL - 1) : (pos < 63);
                float v[8];
#pragma unroll
                for (int i = 0; i < 8; ++i) v[i] = zc[i] + m8[i] * (0.5f * ((hp ? zp[i] : 0.f) + (hn ? zn[i] : 0.f)) - zc[i]);
                const size_t fo = (size_t)t * 2048 + c;
                if (type < 4) {
                    stf8(KB + fo, v);
                    float q[8]; float ss = 0.f;
#pragma unroll
                    for (int i = 0; i < 8; ++i) { q[i] = v[i] * kk8[i]; ss += q[i] * q[i]; }
                    ss += __shfl_xor(ss, 1); ss += __shfl_xor(ss, 2); ss += __shfl_xor(ss, 4);
                    const float inv = 1.0f / fmaxf(sqrtf(ss), 1e-12f);
#pragma unroll
                    for (int i = 0; i < 8; ++i) q[i] *= inv;
                    stf8(KKB + fo, q);
                } else if (type < 8) stf8(VB + fo, v);
                else if (type < 12) { if (!isctx) stf8(RB + fo, v); }
                else if (type == 12) {
                    if (lane < 32) { float o[8];
                        if (lane < 12) { _Pragma("unroll") for (int i = 0; i < 8; ++i) o[i] = tanhf(v[i]); }
                        else if (lane < 24) cp8(o, v);
                        else zero8(o);
                        stb8(AL + (size_t)t * KLORA + lane * 8, o); }
                } else { if (!isctx && lane < 32) { float o[8];
#pragma unroll
                        for (int i = 0; i < 8; ++i) o[i] = sigm(v[i]);
                        stb8(AG + (size_t)t * KGATE + lane * 8, o); } }
                cp8(zp, zc); cp8(zc, zn); cp8(zn, znn);
            }
        } else {
            if (tA >= T) continue;
            if (tB > T) tB = T;
            const int c = (type - 14) * 512 + lane * 8;
            float w0[8], w1[8], w2[8];
            ldf8(F.in[I_CONVW] + c, w0); ldf8(F.in[I_CONVW] + 2048 + c, w1); ldf8(F.in[I_CONVW] + 4096 + c, w2);
            float up[8], uc[8], un[8], ca[8], xa[8], cb[8], xb[8], bg[8], bgn[8];
            if (tA > 0) { ld8(Z + (size_t)(tA - 1) * NZ + OFF_CC + c, ca); ld8(Z + (size_t)(tA - 1) * NZ + OFF_CX + c, xa); _Pragma("unroll") for (int i = 0; i < 8; ++i) up[i] = ca[i] * xa[i]; } else zero8(up);
            ld8(Z + (size_t)tA * NZ + OFF_CC + c, ca); ld8(Z + (size_t)tA * NZ + OFF_CX + c, xa);
#pragma unroll
            for (int i = 0; i < 8; ++i) uc[i] = ca[i] * xa[i];
            ld8(Z + (size_t)tA * NZ + OFF_CB + c, bg);
            if (tA + 1 < T) { ld8(Z + (size_t)(tA + 1) * NZ + OFF_CC + c, ca); ld8(Z + (size_t)(tA + 1) * NZ + OFF_CX + c, xa); } else { zero8(ca); zero8(xa); }
            for (int t = tA; t < tB; ++t) {
                if (t + 2 < T) { ld8(Z + (size_t)(t + 2) * NZ + OFF_CC + c, cb); ld8(Z + (size_t)(t + 2) * NZ + OFF_CX + c, xb); } else { zero8(cb); zero8(xb); }
                if (t + 1 < T) ld8(Z + (size_t)(t + 1) * NZ + OFF_CB + c, bgn); else zero8(bgn);
                const int pos = t & 63; const bool hp = pos > 0, hn = pos < 63;
                float y[8];
#pragma unroll
                for (int i = 0; i < 8; ++i) { un[i] = ca[i] * xa[i]; y[i] = bg[i] * (w0[i] * (hp ? up[i] : 0.f) + w1[i] * uc[i] + w2[i] * (hn ? un[i] : 0.f)); }
                stb8(CAT + (size_t)t * D + DR + c, y);
                cp8(up, uc); cp8(uc, un); cp8(ca, cb); cp8(xa, xb); cp8(bg, bgn);
            }
        }
    }
}

typedef float f32x16 __attribute__((ext_vector_type(16)));
#define MK_FENCE() asm volatile("" ::: "memory")
constexpr int REC_BYTES = 8448, NBLK = TT / 16, SCAN_LDS = REC_BYTES + 4096;
__device__ __forceinline__ void swap32(float& x, float& y) { asm volatile("s_nop 1\n\tv_permlane32_swap_b32 %0, %1\n\ts_nop 1" : "+v"(x), "+v"(y)); }
__device__ __forceinline__ int kperm(int k) { return ((((k >> 5) * 2 + ((k >> 4) & 1)) * 2 + ((k >> 2) & 1)) * 8 + ((k >> 3) & 1) * 4 + (k & 3)); }
__device__ __forceinline__ int scan_blkbase(int d, int c, int j) {
    if (c == 0) return T + (d == 0 ? 16 * j : CTXL - 16 - 16 * j);
    const int p0 = (c - 1) * CHUNK + 16 * j;
    return d == 0 ? p0 : T - 16 - p0;
}
struct BlkRegs { v4u p[8]; float ge; float v[16]; };
__device__ __forceinline__ void scan_bload(const unsigned char* PKB, const float* VB, int d, int h, int tb, int lane, BlkRegs& R) {
    const GAS unsigned char* rp = (const GAS unsigned char*)PKB + ((size_t)(d * 32 + h) * NBLK + (tb >> 4)) * REC_BYTES;
#pragma unroll
    for (int j = 0; j < 8; ++j) R.p[j] = *((const GAS v4u*)rp + 64 * j + lane);
    R.ge = *((const GAS float*)(rp + 8192) + lane);
    const GAS float* gv = (const GAS float*)(VB + (size_t)tb * 2048 + h * 64) + lane;
#pragma unroll
    for (int j = 0; j < 16; ++j) R.v[j] = gv[2048 * j];
}
__device__ __forceinline__ void scan_bstore(LAS unsigned char* buf, int lane, const BlkRegs& R) {
#pragma unroll
    for (int j = 0; j < 8; ++j) *((LAS v4u*)buf + 64 * j + lane) = R.p[j];
    *((LAS float*)(buf + 8192) + lane) = R.ge;
#pragma unroll
    for (int j = 0; j < 16; ++j) *((LAS float*)(buf + REC_BYTES) + 64 * j + lane) = R.v[j];
}
__device__ __forceinline__ void scan_vec32(const LAS unsigned char* row, int hl, float (&f)[32]) {
#pragma unroll
    for (int q = 0; q < 4; ++q) { const v4u w = *(const LAS v4u*)(row + (q * 2 + hl) * 16);
        f[8 * q + 0] = bflo(w.x); f[8 * q + 1] = bfhi(w.x); f[8 * q + 2] = bflo(w.y); f[8 * q + 3] = bfhi(w.y); f[8 * q + 4] = bflo(w.z); f[8 * q + 5] = bfhi(w.z); f[8 * q + 6] = bflo(w.w); f[8 * q + 7] = bfhi(w.w); }
}
__device__ __forceinline__ void scan_matvec(const f32x16 (&Tt)[2][2], const float (&f)[32], float& sa) {
    float p0a = 0.f, p0b = 0.f, p1a = 0.f, p1b = 0.f;
#pragma unroll
    for (int I = 0; I < 2; ++I)
#pragma unroll
        for (int r = 0; r < 16; r += 2) { p0a += Tt[I][0][r] * f[16 * I + r]; p1a += Tt[I][1][r] * f[16 * I + r]; p0b += Tt[I][0][r + 1] * f[16 * I + r + 1]; p1b += Tt[I][1][r + 1] * f[16 * I + r + 1]; }
    float p0 = p0a + p0b, p1 = p1a + p1b;
    swap32(p0, p1);
    sa = p0 + p1;
}
__device__ __forceinline__ void scan_renorm(f32x16 (&Tt)[2][2], const LAS float* ge, int hl) {
#pragma unroll
    for (int I = 0; I < 2; ++I)
#pragma unroll
        for (int qd = 0; qd < 4; ++qd) { const f32x4 g = *(const LAS f32x4*)(ge + 32 * I + 8 * qd + 4 * hl);
#pragma unroll
            for (int e = 0; e < 4; ++e) { Tt[I][0][4 * qd + e] *= g[e]; Tt[I][1][4 * qd + e] *= g[e]; } }
}
__device__ __forceinline__ void scan_store_T(const f32x16 (&Tt)[2][2], float* dst, int lane) {
#pragma unroll
    for (int I = 0; I < 2; ++I)
#pragma unroll
        for (int J = 0; J < 2; ++J)
#pragma unroll
            for (int reg = 0; reg < 16; ++reg) *(GAS float*)(dst + (32 * I + 8 * (reg >> 2) + 4 * (lane >> 5) + (reg & 3)) * 64 + 32 * J + (lane & 31)) = Tt[I][J][reg];
}
typedef short bf16x8 __attribute__((ext_vector_type(8)));
#define MK_MFMA(a, b, c) __builtin_amdgcn_mfma_f32_32x32x16_bf16((a), (b), (c), 0, 0, 0)
constexpr int SCR_LAB = 0, SCR_LAK = 1024, SCR_MRB = 2048, SCR_MRK = 2560, SCAN_SCR = 3072;
struct RecRegs { v4u p[8]; float ge; };
__device__ __forceinline__ void scan_rload(const unsigned char* PKB, int d, int h, int tb, int lane, RecRegs& R) {
    const GAS unsigned char* rp = (const GAS unsigned char*)PKB + ((size_t)(d * 32 + h) * NBLK + (tb >> 4)) * REC_BYTES;
#pragma unroll
    for (int j = 0; j < 8; ++j) R.p[j] = *((const GAS v4u*)rp + 64 * j + lane);
    R.ge = *((const GAS float*)(rp + 8192) + lane);
}
__device__ __forceinline__ void scan_rstore(LAS unsigned char* buf, int lane, const RecRegs& R) {
#pragma unroll
    for (int j = 0; j < 8; ++j) *((LAS v4u*)buf + 64 * j + lane) = R.p[j];
    *((LAS float*)(buf + 8192) + lane) = R.ge;
}
typedef float f32x2n __attribute__((ext_vector_type(2)));
typedef __bf16 bf16x2n __attribute__((ext_vector_type(2)));
__device__ __forceinline__ unsigned cvt2bf(float a, float b) { const f32x2n v = {a, b}; return __builtin_bit_cast(unsigned, __builtin_convertvector(v, bf16x2n)); }
__device__ __forceinline__ bf16x8 pack8(float a0, float a1, float a2, float a3, float a4, float a5, float a6, float a7) {
    const v4u u = {cvt2bf(a0, a1), cvt2bf(a2, a3), cvt2bf(a4, a5), cvt2bf(a6, a7)}; return __builtin_bit_cast(bf16x8, u); }
__device__ __forceinline__ f32x16 zero16() { f32x16 z;
#pragma unroll
    for (int i = 0; i < 16; ++i) z[i] = 0.f;
    return z; }
__device__ __forceinline__ void scan_tfrags(const f32x16 (&Tt)[2][2], bf16x8 (&Tf)[2][2][2]) {
#pragma unroll
    for (int I = 0; I < 2; ++I)
#pragma unroll
        for (int J = 0; J < 2; ++J)
#pragma unroll
            for (int s = 0; s < 2; ++s) Tf[I][J][s] = pack8(Tt[I][J][8 * s], Tt[I][J][8 * s + 1], Tt[I][J][8 * s + 2], Tt[I][J][8 * s + 3], Tt[I][J][8 * s + 4], Tt[I][J][8 * s + 5], Tt[I][J][8 * s + 6], Tt[I][J][8 * s + 7]);
}
__device__ __forceinline__ void scan_sfrags(float (&S)[16], bf16x8 (&Sf)[2]) {
#pragma unroll
    for (int j = 0; j < 8; ++j) swap32(S[j], S[j + 8]);
    Sf[0] = pack8(S[0], S[1], S[2], S[3], S[4], S[5], S[6], S[7]); Sf[1] = pack8(S[8], S[9], S[10], S[11], S[12], S[13], S[14], S[15]);
}
__device__ __forceinline__ void p5_scanA(Frame& F) {
    const unsigned char* PKB = F.ws + WS_PK; const float* VB = (const float*)(F.ws + WS_VBUF);
    float* PU = (float*)(F.ws + WS_PU);
    LAS unsigned char* my = F.lds + RING_OFF + F.wave * (REC_BYTES + SCAN_SCR);
    LAS unsigned char* scr = my + REC_BYTES;
    for (int unit = F.vcu * NWAVES + F.wave; unit < 2048; unit += F.G * NWAVES) {
        const int d = unit & 1, h = (unit >> 1) & 31, c = unit >> 6;
#pragma unroll 1
        for (int which = 0; which < 2; ++which) {
            const int lane = pg8::mk_lane(), hl = lane >> 5, l31 = lane & 31, l15 = lane & 15;
            const float idv = which ? 1.0f : 0.0f;
            f32x16 Tt[2][2];
#pragma unroll
            for (int I = 0; I < 2; ++I)
#pragma unroll
                for (int J = 0; J < 2; ++J)
#pragma unroll
                    for (int reg = 0; reg < 16; ++reg) Tt[I][J][reg] = (32 * I + 8 * (reg >> 2) + 4 * hl + (reg & 3) == 32 * J + l31) ? idv : 0.0f;
            RecRegs R;
            scan_rload(PKB, d, h, scan_blkbase(d, c, 0), lane, R);
#pragma unroll 1
            for (int j = 0; j < 16; ++j) {
                const int tb = scan_blkbase(d, c, j);
                scan_rstore(my, lane, R);
                float Vv[16];
                if (which == 0) { const GAS float* gv = (const GAS float*)(VB + (size_t)(tb + (d == 0 ? 0 : 15)) * 2048 + h * 64) + lane; const int dstep = d == 0 ? 2048 : -2048;
#pragma unroll
                    for (int t = 0; t < 16; ++t) Vv[t] = gv[t * dstep]; }
                else {
#pragma unroll
                    for (int t = 0; t < 16; ++t) Vv[t] = 0.f; }
                const LAS unsigned char* arow = my + l15 * 128 + hl * 16;
                {   f32x16 Lab = zero16(), Lak = zero16();
#pragma unroll
                    for (int qq = 0; qq < 4; ++qq) { const bf16x8 af = *(const LAS bf16x8*)(arow + qq * 32), bf = *(const LAS bf16x8*)(arow + 4096 + qq * 32), kf = *(const LAS bf16x8*)(arow + 6144 + qq * 32);
                        Lab = MK_MFMA(af, bf, Lab); Lak = MK_MFMA(af, kf, Lak); }
                    if (l31 < 16) { LAS float* lb = (LAS float*)scr + 64 * hl + l31;
#pragma unroll
                        for (int r = 0; r < 8; ++r) { const int t0 = 8 * (r >> 2) + (r & 3); lb[SCR_LAB / 4 + t0 * 16] = Lab[r]; lb[SCR_LAK / 4 + t0 * 16] = Lak[r]; } }
                }
                MK_FENCE();
                f32x16 G[2];
                {   bf16x8 Tf[2][2][2]; scan_tfrags(Tt, Tf);
                    G[0] = zero16(); G[1] = zero16();
#pragma unroll
                    for (int qq = 0; qq < 4; ++qq) { const bf16x8 af = *(const LAS bf16x8*)(arow + qq * 32);
                        G[0] = MK_MFMA(af, Tf[qq >> 1][0][qq & 1], G[0]); G[1] = MK_MFMA(af, Tf[qq >> 1][1][qq & 1], G[1]); }
                }
                MK_FENCE();
                if (j + 1 < 16) scan_rload(PKB, d, h, scan_blkbase(d, c, j + 1), lane, R);
                float S[16];
#pragma unroll
                for (int r = 0; r < 8; ++r) { float x = G[0][r], y = G[1][r]; swap32(x, y); const int t = 8 * (r >> 2) + (r & 3); S[t] = x; S[t + 4] = y; }
#pragma unroll
                for (int t = 1; t < 16; ++t) {
                    float acc = S[t];
#pragma unroll
                    for (int s4 = 0; s4 < (t + 3) / 4; ++s4) { const f32x4 la = *(const LAS f32x4*)(scr + SCR_LAB + (t * 16 + 4 * s4) * 4), lk = *(const LAS f32x4*)(scr + SCR_LAK + (t * 16 + 4 * s4) * 4);
#pragma unroll
                        for (int e = 0; e < 4; ++e) if (4 * s4 + e < t) { acc += la[e] * S[4 * s4 + e]; acc += lk[e] * Vv[4 * s4 + e]; } }
                    S[t] = acc;
                }
                bf16x8 Sf[2], Vf[2]; scan_sfrags(S, Sf); scan_sfrags(Vv, Vf);
#pragma unroll
                for (int I = 0; I < 2; ++I) {
                    const LAS unsigned char* col = my + 4096 + (8 * hl) * 128 + kperm(32 * I + l31) * 2;
                    unsigned short bs[8], ks[8];
#pragma unroll
                    for (int e = 0; e < 8; ++e) { bs[e] = *(const LAS unsigned short*)(col + e * 128); ks[e] = *(const LAS unsigned short*)(col + 2048 + e * 128); }
                    const v4u bu = {(unsigned)bs[0] | ((unsigned)bs[1] << 16), (unsigned)bs[2] | ((unsigned)bs[3] << 16), (unsigned)bs[4] | ((unsigned)bs[5] << 16), (unsigned)bs[6] | ((unsigned)bs[7] << 16)};
                    const v4u ku = {(unsigned)ks[0] | ((unsigned)ks[1] << 16), (unsigned)ks[2] | ((unsigned)ks[3] << 16), (unsigned)ks[4] | ((unsigned)ks[5] << 16), (unsigned)ks[6] | ((unsigned)ks[7] << 16)};
                    const bf16x8 ba = __builtin_bit_cast(bf16x8, bu), ka = __builtin_bit_cast(bf16x8, ku);
                    Tt[I][0] = MK_MFMA(ba, Sf[0], Tt[I][0]); Tt[I][1] = MK_MFMA(ba, Sf[1], Tt[I][1]); Tt[I][0] = MK_MFMA(ka, Vf[0], Tt[I][0]); Tt[I][1] = MK_MFMA(ka, Vf[1], Tt[I][1]);
                }
                scan_renorm(Tt, (const LAS float*)(my + 8192), hl);
            }
            scan_store_T(Tt, PU + ((size_t)unit * 2 + (which ? 0 : 1)) * 4096, lane);
        }
    }
}
__device__ __forceinline__ void p6_scanB(Frame& F) {
    const GAS char* PU = (const GAS char*)(F.ws + WS_PU); GAS char* SST = (GAS char*)(F.ws + WS_SST);
    LAS float* PiB = (LAS float*)(F.lds + RING_OFF);
    LAS float* TbB = (LAS float*)(F.lds + RING_OFF + 2 * 16640);
    const int w = F.wave;
    for (int q = F.vcu; q < 64; q += F.G) {
        const unsigned lane = (unsigned)pg8::mk_lane(), tid = (unsigned)w * 64u + lane, hl = lane >> 5, l31 = lane & 31u;
        const unsigned I1 = ((unsigned)w >> 1) & 1u, J = (unsigned)w & 1u;
        {   const GAS char* u0 = PU + ((size_t)q * 2 + 1) * 16384; GAS char* so = SST + ((size_t)q * NCHUNK + 1) * 16384;
            const f32x4 t0 = *(const GAS f32x4*)(u0 + tid * 32u), t1 = *(const GAS f32x4*)(u0 + tid * 32u + 16u);
            *((LAS f32x4*)TbB + tid * 2) = t0; *((LAS f32x4*)TbB + tid * 2 + 1) = t1;
            *(GAS f32x4*)(so + tid * 32u) = t0; *(GAS f32x4*)(so + tid * 32u + 16u) = t1; }
        f32x4 pn0, pn1; f32x16 un;
        {   const GAS char* pg = PU + (((size_t)q + 64) * 2 + 0) * 16384; pn0 = *(const GAS f32x4*)(pg + tid * 32u); pn1 = *(const GAS f32x4*)(pg + tid * 32u + 16u);
            const unsigned pb = (tid >> 3) * 65u + (tid & 7u) * 8u;
#pragma unroll
            for (int e = 0; e < 4; ++e) { PiB[pb + e] = pn0[e]; PiB[pb + 4 + e] = pn1[e]; }
            const GAS char* ug = PU + (((size_t)q + 64) * 2 + 1) * 16384;
#pragma unroll
            for (int r = 0; r < 16; ++r) un[r] = (w < 4) ? *(const GAS float*)(ug + ((32u * I1 + 8u * (r >> 2) + 4u * hl + (r & 3)) * 64u + 32u * J + l31) * 4u) : 0.f; }
        __syncthreads();
        for (int c = 1; c < 32; ++c) {
            const LAS float* Pi = PiB + ((c - 1) & 1) * 4160; const LAS float* Tb = TbB + ((c - 1) & 1) * 4096;
            LAS float* PiN = PiB + (c & 1) * 4160; LAS float* TbN = TbB + (c & 1) * 4096;
            f32x16 acc = un;
            if (c + 1 < 32) {
                const GAS char* pg = PU + (((size_t)q + 64 * (c + 1)) * 2 + 0) * 16384; pn0 = *(const GAS f32x4*)(pg + tid * 32u); pn1 = *(const GAS f32x4*)(pg + tid * 32u + 16u);
                const GAS char* ug = PU + (((size_t)q + 64 * (c + 1)) * 2 + 1) * 16384;
                if (w < 4) {
#pragma unroll
                    for (int r = 0; r < 16; ++r) un[r] = *(const GAS float*)(ug + ((32u * I1 + 8u * (r >> 2) + 4u * hl + (r & 3)) * 64u + 32u * J + l31) * 4u); }
            }
            if (w < 4) {
#pragma unroll
                for (int s2 = 0; s2 < 32; ++s2) { const float av = Pi[(32u * I1 + l31) * 65u + 2u * s2 + hl], bv = Tb[(2u * s2 + hl) * 64u + 32u * J + l31];
                    acc = __builtin_amdgcn_mfma_f32_32x32x2f32(av, bv, acc, 0, 0, 0);
                    if ((s2 & 7) == 7) MK_FENCE(); }
                GAS char* so = SST + ((size_t)q * NCHUNK + c + 1) * 16384;
#pragma unroll
                for (int r = 0; r < 16; ++r) { const unsigned e = (32u * I1 + 8u * (r >> 2) + 4u * hl + (r & 3)) * 64u + 32u * J + l31; TbN[e] = acc[r]; *(GAS float*)(so + e * 4u) = acc[r]; }
            }
            if (c + 1 < 32) { const unsigned pb = (tid >> 3) * 65u + (tid & 7u) * 8u;
#pragma unroll
                for (int e = 0; e < 4; ++e) { PiN[pb + e] = pn0[e]; PiN[pb + 4 + e] = pn1[e]; } }
            __syncthreads();
        }
    }
}
__device__ __forceinline__ void p7_scanC(Frame& F) {
    const unsigned char* PKB = F.ws + WS_PK; const float* VB = (const float*)(F.ws + WS_VBUF);
    const float* SST = (const float*)(F.ws + WS_SST); float* YS = (float*)(F.ws + WS_YS);
    LAS unsigned char* my = F.lds + RING_OFF + F.wave * (REC_BYTES + SCAN_SCR);
    LAS unsigned char* scr = my + REC_BYTES;
    for (int unit = F.vcu * NWAVES + F.wave; unit < 2048; unit += F.G * NWAVES) {
        const int d = unit & 1, h = (unit >> 1) & 31, c = (unit >> 6) + 1, q = unit & 63;
        const int lane = pg8::mk_lane(), hl = lane >> 5, l31 = lane & 31, l15 = lane & 15;
        f32x16 Tt[2][2];
        {   const float* s0 = SST + ((size_t)q * NCHUNK + c) * 4096;
#pragma unroll
            for (int I = 0; I < 2; ++I)
#pragma unroll
                for (int J = 0; J < 2; ++J)
#pragma unroll
                    for (int reg = 0; reg < 16; ++reg) Tt[I][J][reg] = *(const GAS float*)(s0 + (32 * I + 8 * (reg >> 2) + 4 * hl + (reg & 3)) * 64 + 32 * J + l31); }
        RecRegs R;
        scan_rload(PKB, d, h, scan_blkbase(d, c, 0), lane, R);
#pragma unroll 1
        for (int j = 0; j < 16; ++j) {
            const int tb = scan_blkbase(d, c, j);
            scan_rstore(my, lane, R);
            float Vv[16];
            {   const GAS float* gv = (const GAS float*)(VB + (size_t)(tb + (d == 0 ? 0 : 15)) * 2048 + h * 64) + lane; const int dstep = d == 0 ? 2048 : -2048;
#pragma unroll
                for (int t = 0; t < 16; ++t) Vv[t] = gv[t * dstep]; }
            const LAS unsigned char* arow = my + l15 * 128 + hl * 16;
            {   f32x16 Lab = zero16(), Lak = zero16(), Mrb = zero16(), Mrk = zero16();
#pragma unroll
                for (int qq = 0; qq < 4; ++qq) { const bf16x8 af = *(const LAS bf16x8*)(arow + qq * 32), rf = *(const LAS bf16x8*)(arow + 2048 + qq * 32), bf = *(const LAS bf16x8*)(arow + 4096 + qq * 32), kf = *(const LAS bf16x8*)(arow + 6144 + qq * 32);
                    Lab = MK_MFMA(af, bf, Lab); Lak = MK_MFMA(af, kf, Lak); Mrb = MK_MFMA(rf, bf, Mrb); Mrk = MK_MFMA(rf, kf, Mrk); }
                if (l31 < 16) {
                    LAS float* lb = (LAS float*)scr + 64 * hl + l31; LAS unsigned short* mb = (LAS unsigned short*)scr + 64 * hl + l31; const int lm = l31 - 4 * hl;
#pragma unroll
                    for (int r = 0; r < 8; ++r) { const int t0 = 8 * (r >> 2) + (r & 3);
                        lb[SCR_LAB / 4 + t0 * 16] = Lab[r]; lb[SCR_LAK / 4 + t0 * 16] = Lak[r];
                        mb[SCR_MRB / 2 + t0 * 16] = (unsigned short)f2bf(lm <= t0 ? Mrb[r] : 0.f); mb[SCR_MRK / 2 + t0 * 16] = (unsigned short)f2bf(lm <= t0 ? Mrk[r] : 0.f); }
                }
            }
            MK_FENCE();
            f32x16 G[2], Y[2];
            {   bf16x8 Tf[2][2][2]; scan_tfrags(Tt, Tf);
                G[0] = zero16(); G[1] = zero16(); Y[0] = zero16(); Y[1] = zero16();
#pragma unroll
                for (int qq = 0; qq < 4; ++qq) { const bf16x8 af = *(const LAS bf16x8*)(arow + qq * 32), rf = *(const LAS bf16x8*)(arow + 2048 + qq * 32);
                    G[0] = MK_MFMA(af, Tf[qq >> 1][0][qq & 1], G[0]); G[1] = MK_MFMA(af, Tf[qq >> 1][1][qq & 1], G[1]);
                    Y[0] = MK_MFMA(rf, Tf[qq >> 1][0][qq & 1], Y[0]); Y[1] = MK_MFMA(rf, Tf[qq >> 1][1][qq & 1], Y[1]); }
            }
            MK_FENCE();
            if (j + 1 < 16) scan_rload(PKB, d, h, scan_blkbase(d, c, j + 1), lane, R);
            float S[16];
#pragma unroll
            for (int r = 0; r < 8; ++r) { float x = G[0][r], y = G[1][r]; swap32(x, y); const int t = 8 * (r >> 2) + (r & 3); S[t] = x; S[t + 4] = y; }
#pragma unroll
            for (int t = 1; t < 16; ++t) {
                float acc = S[t];
#pragma unroll
                for (int s4 = 0; s4 < (t + 3) / 4; ++s4) { const f32x4 la = *(const LAS f32x4*)(scr + SCR_LAB + (t * 16 + 4 * s4) * 4), lk = *(const LAS f32x4*)(scr + SCR_LAK + (t * 16 + 4 * s4) * 4);
#pragma unroll
                    for (int e = 0; e < 4; ++e) if (4 * s4 + e < t) { acc += la[e] * S[4 * s4 + e]; acc += lk[e] * Vv[4 * s4 + e]; } }
                S[t] = acc;
            }
            bf16x8 Sf[2], Vf[2]; scan_sfrags(S, Sf); scan_sfrags(Vv, Vf);
            {   const bf16x8 mb = *(const LAS bf16x8*)(scr + SCR_MRB + l15 * 32 + hl * 16), mk = *(const LAS bf16x8*)(scr + SCR_MRK + l15 * 32 + hl * 16);
                Y[0] = MK_MFMA(mb, Sf[0], Y[0]); Y[1] = MK_MFMA(mb, Sf[1], Y[1]); Y[0] = MK_MFMA(mk, Vf[0], Y[0]); Y[1] = MK_MFMA(mk, Vf[1], Y[1]); }
#pragma unroll
            for (int I = 0; I < 2; ++I) {
                const LAS unsigned char* col = my + 4096 + (8 * hl) * 128 + kperm(32 * I + l31) * 2;
                unsigned short bs[8], ks[8];
#pragma unroll
                for (int e = 0; e < 8; ++e) { bs[e] = *(const LAS unsigned short*)(col + e * 128); ks[e] = *(const LAS unsigned short*)(col + 2048 + e * 128); }
                const v4u bu = {(unsigned)bs[0] | ((unsigned)bs[1] << 16), (unsigned)bs[2] | ((unsigned)bs[3] << 16), (unsigned)bs[4] | ((unsigned)bs[5] << 16), (unsigned)bs[6] | ((unsigned)bs[7] << 16)};
                const v4u ku = {(unsigned)ks[0] | ((unsigned)ks[1] << 16), (unsigned)ks[2] | ((unsigned)ks[3] << 16), (unsigned)ks[4] | ((unsigned)ks[5] << 16), (unsigned)ks[6] | ((unsigned)ks[7] << 16)};
                const bf16x8 ba = __builtin_bit_cast(bf16x8, bu), ka = __builtin_bit_cast(bf16x8, ku);
                Tt[I][0] = MK_MFMA(ba, Sf[0], Tt[I][0]); Tt[I][1] = MK_MFMA(ba, Sf[1], Tt[I][1]); Tt[I][0] = MK_MFMA(ka, Vf[0], Tt[I][0]); Tt[I][1] = MK_MFMA(ka, Vf[1], Tt[I][1]);
            }
            {   GAS float* yb = (GAS float*)(YS + (size_t)d * T * 2048 + (size_t)(tb + (d == 0 ? 4 * hl : 15 - 4 * hl)) * 2048 + h * 64) + l31; const int ystep = d == 0 ? 2048 : -2048;
#pragma unroll
                for (int J = 0; J < 2; ++J)
#pragma unroll
                    for (int r = 0; r < 8; ++r) yb[(8 * (r >> 2) + (r & 3)) * ystep + 32 * J] = Y[J][r]; }
            scan_renorm(Tt, (const LAS float*)(my + 8192), hl);
        }
    }
}

__device__ __forceinline__ void p8_readout(Frame& F) {
    const float* RB = (const float*)(F.ws + WS_RBUF); const float* VB = (const float*)(F.ws + WS_VBUF); const float* YS = (const float*)(F.ws + WS_YS);
    const bf16* KD = (const bf16*)(F.ws + WS_KD);
    const bf16* G = (const bf16*)(F.ws + WS_G); bf16* CAT = (bf16*)(F.ws + WS_CAT);
    const int tpb = (T + F.G - 1) / F.G, tok0 = F.vcu * tpb, lane = pg8::mk_lane();
    for (int it = F.wave; it < tpb * 4; it += NWAVES) {
        const int j = it / tpb, tok = tok0 + it % tpb;
        if (tok >= T) continue;
        const int c = j * 512 + lane * 8;
        float y0[8], y1[8], y[8];
        ldf8(YS + (size_t)tok * 2048 + c, y0); ldf8(YS + ((size_t)T + tok) * 2048 + c, y1);
        float s = 0.f;
#pragma unroll
        for (int i = 0; i < 8; ++i) { y[i] = y0[i] + y1[i]; s += y[i]; }
        s += __shfl_xor(s, 1); s += __shfl_xor(s, 2); s += __shfl_xor(s, 4);
        const float mean = s * (1.0f / 64.0f); float q = 0.f;
#pragma unroll
        for (int i = 0; i < 8; ++i) { const float dlt = y[i] - mean; q += dlt * dlt; }
        q += __shfl_xor(q, 1); q += __shfl_xor(q, 2); q += __shfl_xor(q, 4);
        const float rstd = 1.0f / sqrtf(q * (1.0f / 64.0f) + LNX_EPS);
        float r8[8], v8[8], k0[8], k1[8], rk[8], lw[8], lb[8], g8[8];
        ldf8(RB + (size_t)tok * 2048 + c, r8); ldf8(VB + (size_t)tok * 2048 + c, v8);
        ld8(KD + (size_t)tok * 2048 + c, k0); ld8(KD + ((size_t)TT + tok) * 2048 + c, k1);
        ldf8(F.in[I_RK] + c, rk); ldf8(F.in[I_LNXW] + c, lw); ldf8(F.in[I_LNXB] + c, lb);
        ld8(G + (size_t)tok * 2048 + c, g8);
        float dot = 0.f;
#pragma unroll
        for (int i = 0; i < 8; ++i) dot += r8[i] * (k0[i] + k1[i]) * rk[i];
        dot += __shfl_xor(dot, 1); dot += __shfl_xor(dot, 2); dot += __shfl_xor(dot, 4);
        float o[8];
#pragma unroll
        for (int i = 0; i < 8; ++i) o[i] = ((y[i] - mean) * rstd * lw[i] + lb[i] + dot * v8[i]) * g8[i];
        stb8(CAT + (size_t)tok * D + c, o);
    }
}

template <int K> __device__ __forceinline__ void run_phase(Frame& F) {
    bf16* A1 = (bf16*)(F.ws + WS_A1); bf16* Zb = (bf16*)(F.ws + WS_Z);
    const float* MV = (const float*)(F.ws + WS_MODV);
    (void)A1; (void)Zb; (void)MV;
    asm volatile("; MK_PHASE %0" :: "i"(K) : "memory");
    if constexpr (K == 0) { p0_prologue(F);
    }
    if constexpr (K == 1) { p1_norm1(F);
    }
    if constexpr (K == 2) {
        { pg8::Gemm g{A1, (const bf16*)(F.ws + WS_WIN), T, NZ, D}; pg8::StaticOrder S; S.init(T, NZ, F.G, (int)blockIdx.x);
          pg8::EpiBf16<0> E{Zb, NZ, nullptr, 0, 0, 1.f};
          pg8::gemm_phase<pg8::EpiBf16<0>, pg8::StaticOrder, true, true>(F.lds + RING_OFF, g, S, E, F.wave); }
        { pg8::Gemm g{A1 + (size_t)T * D, (const bf16*)(F.ws + WS_WIN), CTXL, NCTXZ, D}; pg8::StaticOrder S; S.init(CTXL, NCTXZ, F.G, (int)((blockIdx.x + F.G - 64) % F.G));
          pg8::EpiBf16<0> E{Zb + (size_t)T * NZ, NZ, nullptr, 0, 0, 1.f};
          pg8::gemm_phase<pg8::EpiBf16<0>, pg8::StaticOrder, true, true>(F.lds + RING_OFF, g, S, E, F.wave); }
        tr_idle(F, P2T_B, P2T_E, (int)blockIdx.x - 81, 175);
    }
    if constexpr (K == 3) { p3_prep(F);
    }
    if constexpr (K == 4) {
        { int kl = KLORA; asm volatile("" : "+s"(kl));
          pg8::Gemm g{(const bf16*)(F.ws + WS_ALORA), (const bf16*)(F.ws + WS_WLORA), TT, NLORA, kl}; pg8::StaticOrder S; S.init(TT, NLORA, F.G, (int)blockIdx.x);
          pg8::EpiLora E{F.ws + WS_PK, (bf16*)(F.ws + WS_KD), (const float*)(F.ws + WS_KBUF), (const float*)(F.ws + WS_KKBUF), (const float*)(F.ws + WS_RBUF), F.in[I_W0], F.in[I_A0], F.in[I_KA], TT};
          pg8::gemm_phase<pg8::EpiLora, pg8::StaticOrder, true, true>(F.lds + RING_OFF, g, S, E, F.wave); }
        { int kl = KGATE; asm volatile("" : "+s"(kl));
          pg8::Gemm g{(const bf16*)(F.ws + WS_AGATE), (const bf16*)(F.ws + WS_WGATE), T, DR, kl}; pg8::StaticOrder S; S.init(T, DR, F.G, (int)blockIdx.x);
          pg8::EpiBf16<0> E{(bf16*)(F.ws + WS_G), DR, nullptr, 0, 0, 1.f};
          pg8::gemm_phase<pg8::EpiBf16<0>, pg8::StaticOrder, true, true>(F.lds + RING_OFF, g, S, E, F.wave); }

    }
    if constexpr (K == 5) { p5_scanA(F);
    }
    if constexpr (K == 6) { p6_scanB(F); tr_idle(F, P6T_B, P6T_E, F.vcu - 64, 192);

    }
    if constexpr (K == 7) { p7_scanC(F);
    }
    if constexpr (K == 8) { p8_readout(F);
    }
    if constexpr (K == 9) {
        pg8::Gemm g{(const bf16*)(F.ws + WS_CAT), (const bf16*)(F.ws + WS_WOUT), T, D, D}; pg8::StaticOrder S; S.init(T, D, F.G, (int)blockIdx.x);
        pg8::EpiResid E{F.in[I_X], (float*)(F.ws + WS_X1), D, MV + 2 * D};
        pg8::gemm_phase<pg8::EpiResid, pg8::StaticOrder, true, true>(F.lds + RING_OFF, g, S, E, F.wave);

    }
    if constexpr (K == 10) { p10_norm2(F);
    }
    if constexpr (K == 11) {
        pg8::Gemm g{A1, (const bf16*)(F.ws + WS_WGU), T, NGU, D}; pg8::StaticOrder S; S.init(T, NGU, F.G, (int)blockIdx.x);
        pg8::EpiSwiglu E{(bf16*)(F.ws + WS_ACT), DFF};
        pg8::gemm_phase<pg8::EpiSwiglu, pg8::StaticOrder, true, true>(F.lds + RING_OFF, g, S, E, F.wave);
        tr_idle(F, P11T_B, P11T_E, (int)blockIdx.x - 192, 64);
    }
    if constexpr (K == 12) {
        pg8::Gemm g{(const bf16*)(F.ws + WS_ACT), (const bf16*)(F.ws + WS_WDN), T, D, DFF}; pg8::StaticOrder S; S.init(T, D, F.G, (int)blockIdx.x);
        pg8::EpiResid E{(const float*)(F.ws + WS_X1), F.out, D, MV + 5 * D};
        pg8::gemm_phase<pg8::EpiResid, pg8::StaticOrder, true, true>(F.lds + RING_OFF, g, S, E, F.wave);

    }
    if constexpr (K == 13) { p13_final(F);
    }
}

struct Args { const float* in[26]; float* out; unsigned char* ws; int ph_lo, ph_hi, li, pad; };
__global__ void __launch_bounds__(NWAVES * 64, 2) mk_fwd(Args args) {
    extern __shared__ __attribute__((aligned(16))) unsigned char lds[];
    Frame F;
    F.lds = (LAS unsigned char*)lds;
    F.MISC = (volatile LAS unsigned*)(F.lds + MISC_OFF);
    F.wave = __builtin_amdgcn_readfirstlane((int)(threadIdx.x >> 6));
    F.G = gridDim.x; { const int bx = blockIdx.x; F.vcu = (F.G % 8 == 0) ? (bx % 8) * (F.G / 8) + bx / 8 : bx; }
    F.ws = args.ws; F.ctl = (gu32*)(args.ws + WS_CTL); F.out = args.out;
#pragma unroll
    for (int i = 0; i < 26; ++i) F.in[i] = args.in[i];
    for (int u = threadIdx.x; u < (LDS_BYTES - LDSCTL_OFF) / 4; u += NWAVES * 64) ((LAS unsigned*)(F.lds + LDSCTL_OFF))[u] = 0u;
    __syncthreads();
    XcdBarrier bar; bar.bar = (unsigned*)(F.ctl + CW_BAR); bar.x = 0; bar.st = nullptr;
    if (N_LAUNCHES == 1) bar = xcd_barrier_post((unsigned*)(F.ctl + CW_BAR), F.MISC + 8);
#define GRID_BAR() do { if (N_LAUNCHES == 1) xcd_barrier(bar, F.wave); } while (0)
    unsigned long long tp0 = 0, tpa = 0, tpb = 0; (void)tp0;
    const int lo = args.ph_lo, hi = args.ph_hi;
#define IN(k) (lo <= (k) && (k) < hi)
#define BOTH(k) (IN(k) && IN((k) + 1))

    if (IN(0)) { if constexpr (0 == TPA || 0 == TPB) tp0 = __builtin_amdgcn_s_memrealtime(); run_phase<0>(F); if constexpr (PH_REPS[0] > 1) { GRID_BAR(); run_phase<0>(F); } if constexpr (PH_REPS[0] > 2) { GRID_BAR(); run_phase<0>(F); } if (BOTH(0)) GRID_BAR(); if constexpr (0 == TPA) tpa = __builtin_amdgcn_s_memrealtime() - tp0; if constexpr (0 == TPB) tpb = __builtin_amdgcn_s_memrealtime() - tp0; }
    if (IN(1)) { if constexpr (1 == TPA || 1 == TPB) tp0 = __builtin_amdgcn_s_memrealtime(); run_phase<1>(F); if constexpr (PH_REPS[1] > 1) { GRID_BAR(); run_phase<1>(F); } if constexpr (PH_REPS[1] > 2) { GRID_BAR(); run_phase<1>(F); } if (BOTH(1)) GRID_BAR(); if constexpr (1 == TPA) tpa = __builtin_amdgcn_s_memrealtime() - tp0; if constexpr (1 == TPB) tpb = __builtin_amdgcn_s_memrealtime() - tp0; }
    if (IN(2)) { if constexpr (2 == TPA || 2 == TPB) tp0 = __builtin_amdgcn_s_memrealtime(); run_phase<2>(F); if constexpr (PH_REPS[2] > 1) { GRID_BAR(); run_phase<2>(F); } if constexpr (PH_REPS[2] > 2) { GRID_BAR(); run_phase<2>(F); } if (BOTH(2)) GRID_BAR(); if constexpr (2 == TPA) tpa = __builtin_amdgcn_s_memrealtime() - tp0; if constexpr (2 == TPB) tpb = __builtin_amdgcn_s_memrealtime() - tp0; }
    if (IN(3)) { if constexpr (3 == TPA || 3 == TPB) tp0 = __builtin_amdgcn_s_memrealtime(); run_phase<3>(F); if constexpr (PH_REPS[3] > 1) { GRID_BAR(); run_phase<3>(F); } if constexpr (PH_REPS[3] > 2) { GRID_BAR(); run_phase<3>(F); } if (BOTH(3)) GRID_BAR(); if constexpr (3 == TPA) tpa = __builtin_amdgcn_s_memrealtime() - tp0; if constexpr (3 == TPB) tpb = __builtin_amdgcn_s_memrealtime() - tp0; }
    if (IN(4)) { if constexpr (4 == TPA || 4 == TPB) tp0 = __builtin_amdgcn_s_memrealtime(); run_phase<4>(F); if constexpr (PH_REPS[4] > 1) { GRID_BAR(); run_phase<4>(F); } if constexpr (PH_REPS[4] > 2) { GRID_BAR(); run_phase<4>(F); } if (BOTH(4)) GRID_BAR(); if constexpr (4 == TPA) tpa = __builtin_amdgcn_s_memrealtime() - tp0; if constexpr (4 == TPB) tpb = __builtin_amdgcn_s_memrealtime() - tp0; }
    if (IN(5)) { if constexpr (5 == TPA || 5 == TPB) tp0 = __builtin_amdgcn_s_memrealtime(); run_phase<5>(F); if constexpr (PH_REPS[5] > 1) { GRID_BAR(); run_phase<5>(F); } if constexpr (PH_REPS[5] > 2) { GRID_BAR(); run_phase<5>(F); } if (BOTH(5)) GRID_BAR(); if constexpr (5 == TPA) tpa = __builtin_amdgcn_s_memrealtime() - tp0; if constexpr (5 == TPB) tpb = __builtin_amdgcn_s_memrealtime() - tp0; }
    if (IN(6)) { if constexpr (6 == TPA || 6 == TPB) tp0 = __builtin_amdgcn_s_memrealtime(); run_phase<6>(F); if constexpr (PH_REPS[6] > 1) { GRID_BAR(); run_phase<6>(F); } if constexpr (PH_REPS[6] > 2) { GRID_BAR(); run_phase<6>(F); } if (BOTH(6)) GRID_BAR(); if constexpr (6 == TPA) tpa = __builtin_amdgcn_s_memrealtime() - tp0; if constexpr (6 == TPB) tpb = __builtin_amdgcn_s_memrealtime() - tp0; }
    if (IN(7)) { if constexpr (7 == TPA || 7 == TPB) tp0 = __builtin_amdgcn_s_memrealtime(); run_phase<7>(F); if constexpr (PH_REPS[7] > 1) { GRID_BAR(); run_phase<7>(F); } if constexpr (PH_REPS[7] > 2) { GRID_BAR(); run_phase<7>(F); } if (BOTH(7)) GRID_BAR(); if constexpr (7 == TPA) tpa = __builtin_amdgcn_s_memrealtime() - tp0; if constexpr (7 == TPB) tpb = __builtin_amdgcn_s_memrealtime() - tp0; }
    if (IN(8)) { if constexpr (8 == TPA || 8 == TPB) tp0 = __builtin_amdgcn_s_memrealtime(); run_phase<8>(F); if constexpr (PH_REPS[8] > 1) { GRID_BAR(); run_phase<8>(F); } if constexpr (PH_REPS[8] > 2) { GRID_BAR(); run_phase<8>(F); } if (BOTH(8)) GRID_BAR(); if constexpr (8 == TPA) tpa = __builtin_amdgcn_s_memrealtime() - tp0; if constexpr (8 == TPB) tpb = __builtin_amdgcn_s_memrealtime() - tp0; }
    if (IN(9)) { if constexpr (9 == TPA || 9 == TPB) tp0 = __builtin_amdgcn_s_memrealtime(); run_phase<9>(F); if constexpr (PH_REPS[9] > 1) { GRID_BAR(); run_phase<9>(F); } if constexpr (PH_REPS[9] > 2) { GRID_BAR(); run_phase<9>(F); } if (BOTH(9)) GRID_BAR(); if constexpr (9 == TPA) tpa = __builtin_amdgcn_s_memrealtime() - tp0; if constexpr (9 == TPB) tpb = __builtin_amdgcn_s_memrealtime() - tp0; }
    if (IN(10)) { if constexpr (10 == TPA || 10 == TPB) tp0 = __builtin_amdgcn_s_memrealtime(); run_phase<10>(F); if constexpr (PH_REPS[10] > 1) { GRID_BAR(); run_phase<10>(F); } if constexpr (PH_REPS[10] > 2) { GRID_BAR(); run_phase<10>(F); } if (BOTH(10)) GRID_BAR(); if constexpr (10 == TPA) tpa = __builtin_amdgcn_s_memrealtime() - tp0; if constexpr (10 == TPB) tpb = __builtin_amdgcn_s_memrealtime() - tp0; }
    if (IN(11)) { if constexpr (11 == TPA || 11 == TPB) tp0 = __builtin_amdgcn_s_memrealtime(); run_phase<11>(F); if constexpr (PH_REPS[11] > 1) { GRID_BAR(); run_phase<11>(F); } if constexpr (PH_REPS[11] > 2) { GRID_BAR(); run_phase<11>(F); } if (BOTH(11)) GRID_BAR(); if constexpr (11 == TPA) tpa = __builtin_amdgcn_s_memrealtime() - tp0; if constexpr (11 == TPB) tpb = __builtin_amdgcn_s_memrealtime() - tp0; }
    if (IN(12)) { if constexpr (12 == TPA || 12 == TPB) tp0 = __builtin_amdgcn_s_memrealtime(); run_phase<12>(F); if constexpr (PH_REPS[12] > 1) { GRID_BAR(); run_phase<12>(F); } if constexpr (PH_REPS[12] > 2) { GRID_BAR(); run_phase<12>(F); } if (BOTH(12)) GRID_BAR(); if constexpr (12 == TPA) tpa = __builtin_amdgcn_s_memrealtime() - tp0; if constexpr (12 == TPB) tpb = __builtin_amdgcn_s_memrealtime() - tp0; }
    if (IN(13)) { if constexpr (13 == TPA || 13 == TPB) tp0 = __builtin_amdgcn_s_memrealtime(); run_phase<13>(F); if constexpr (PH_REPS[13] > 1) { GRID_BAR(); run_phase<13>(F); } if constexpr (PH_REPS[13] > 2) { GRID_BAR(); run_phase<13>(F); } if (BOTH(13)) GRID_BAR(); if constexpr (13 == TPA) tpa = __builtin_amdgcn_s_memrealtime() - tp0; if constexpr (13 == TPB) tpb = __builtin_amdgcn_s_memrealtime() - tp0; }
    if constexpr (TPA >= 0 || TPB >= 0) {
        if (blockIdx.x == 0 && F.wave == 0) { const unsigned long long ua = (tpa + 500ull) / 1000ull, ub = (tpb + 500ull) / 1000ull, extra = ua * 100000ull + ub * 1000ull, t1 = __builtin_amdgcn_s_memrealtime();
            while (__builtin_amdgcn_s_memrealtime() - t1 < extra) __builtin_amdgcn_s_sleep(16); }
    }
#undef IN
#undef BOTH
}

extern "C" void kernel_launch(void* const* d_in, const int* in_sizes, int n_in, void* d_out, int out_size, void* d_ws, size_t ws_size, hipStream_t stream) {
    static int grid = 0;
    if (grid == 0) {
        if (n_in != 26 || out_size != T * D || ws_size < WS_END) { fprintf(stderr, "kernel_launch: unexpected shapes: n_in %d out %d ws %zu (need %zu)\n", n_in, out_size, ws_size, (size_t)WS_END); grid = -1; return; }
        int dev = 0, cus = 0, per_cu = 0;
        if (hipGetDevice(&dev) != hipSuccess || hipDeviceGetAttribute(&cus, hipDeviceAttributeMultiprocessorCount, dev) != hipSuccess) { grid = -1; return; }
        if (hipFuncSetAttribute((const void*)mk_fwd, hipFuncAttributeMaxDynamicSharedMemorySize, LDS_BYTES) != hipSuccess) { fprintf(stderr, "kernel_launch: hipFuncSetAttribute failed\n"); grid = -1; return; }
        if (hipOccupancyMaxActiveBlocksPerMultiprocessor(&per_cu, (const void*)mk_fwd, NWAVES * 64, LDS_BYTES) != hipSuccess || per_cu < 1)
            fprintf(stderr, "kernel_launch: note: occupancy query reports %d workgroups per CU\n", per_cu);
        (void)hipGetLastError();
        grid = cus;
    }
    if (grid < 0) return;
    if (hipMemsetAsync((char*)d_ws + WS_CTL, 0, CTL_ZERO_BYTES, stream) != hipSuccess) return;
    Args a{};
    for (int i = 0; i < 26; ++i) a.in[i] = (const float*)d_in[i];
    a.out = (float*)d_out; a.ws = (unsigned char*)d_ws;
    for (int li = 0; li < N_LAUNCHES; ++li) {
        if (N_LAUNCHES == 1) { a.ph_lo = 0; a.ph_hi = N_PHASES; } else { a.ph_lo = li * N_PHASES / N_LAUNCHES; a.ph_hi = (li + 1) * N_PHASES / N_LAUNCHES; }
        a.li = li;
        hipLaunchKernelGGL(mk_fwd, dim3(grid), dim3(NWAVES * 64), LDS_BYTES, stream, a);
        if (hipPeekAtLastError() != hipSuccess) break;
    }
}
```

```cpp
#include <hip/hip_runtime.h>
#include <cstdio>
#include <cstdint>
namespace pg8 {
#define PG8_LAS __attribute__((address_space(3)))
typedef unsigned short bf16_t;
typedef short bf16x8 __attribute__((ext_vector_type(8)));
typedef float f32x4 __attribute__((ext_vector_type(4)));
typedef unsigned u32x4 __attribute__((ext_vector_type(4)));
constexpr int BM = 256, BK = 64, HALF = 128, HTB = HALF * BK * 2  , STAGE_BYTES = 8 * HTB, NXCD = 8, WGM = 8;

__host__ __device__ __forceinline__ int lds_byte(int r, int c) { const int st = (r >> 4) * 2 + (c >> 5), rr = r & 15, cc = c & 31, ob = rr * 64 + cc * 2; return st * 1024 + (ob ^ (((ob >> 9) & 1) << 5)); }
__host__ __device__ __forceinline__ void stage_rc(int b, int& R, int& C) { const int st = b / 1024, sb = b % 1024, swz = sb ^ (((sb >> 9) & 1) << 5); R = (st >> 1) * 16 + swz / 64; C = (st & 1) * 32 + (swz % 64) / 2; }
__host__ __device__ __forceinline__ int perm32(int rho) { const int n = rho >> 4, i = rho & 15; return 8 * (i >> 2) + 4 * n + (i & 3); }

__device__ __forceinline__ int mk_lane() { int l; asm volatile("v_mbcnt_lo_u32_b32 %0, -1, 0\n\tv_mbcnt_hi_u32_b32 %0, -1, %0" : "=v"(l)); return l; }
struct Unit { int pm, pn; };
struct Gemm { const bf16_t* A; const bf16_t* Bt; int M, N, K; };

struct StaticOrder {
    int nM, nN, nwg, G, c;
    __host__ __device__ void init(int M, int N, int G_, int c_) { nM = M / BM; nN = N / BM; nwg = nM * nN; G = G_; c = c_; }
    __host__ __device__ bool next(int i, Unit& u) const {
        const long L = (long)i * G + c; if (L >= nwg) return false;
        int wgid = (int)L; { const int q = nwg / NXCD, r = nwg % NXCD, xcd = wgid % NXCD, off = wgid / NXCD; wgid = (xcd < r ? xcd * (q + 1) : r * (q + 1) + (xcd - r) * q) + off; }
        const int nig = WGM * nN, gid = wgid / nig, fm = gid * WGM, gsz = (nM - fm) < WGM ? (nM - fm) : WGM;
        u.pm = fm + ((wgid % nig) % gsz); u.pn = (wgid % nig) / gsz; return true;
    }
    __device__ __forceinline__ void a_ready(const Unit&) const {}
    __device__ __forceinline__ void done(const Unit&) const {}
};

__device__ __forceinline__ unsigned cvt_pk_bf16(float lo, float hi) { unsigned r; asm volatile("v_cvt_pk_bf16_f32 %0, %1, %2" : "=v"(r) : "v"(lo), "v"(hi)); return r; }
typedef float f32x2 __attribute__((ext_vector_type(2)));
__device__ __forceinline__ f32x2 gelu_pk(f32x2 v) {
    const f32x2 av = __builtin_elementwise_abs(v), d = av * 0.2316418882f + 1.0f;
    f32x2 t; t.x = __builtin_amdgcn_rcpf(d.x); t.y = __builtin_amdgcn_rcpf(d.y);
    f32x2 q = t * 0.5307027145f + (-0.7265760135f); q = q * t + 0.7107068705f; q = q * t + (-0.142248368f); q = q * t + 0.127414796f; q = q * t;
    const f32x2 s = (v * v) * (-0.72134752044f);
    f32x2 e; e.x = __builtin_amdgcn_exp2f(s.x); e.y = __builtin_amdgcn_exp2f(s.y);
    const f32x2 m = v * (q * e), r = v - m;
    f32x2 o; o.x = v.x < 0.f ? m.x : r.x; o.y = v.y < 0.f ? m.y : r.y; return o;
}

template <int ACT  > struct EpiBf16 {
    static constexpr bool PERM = true, AFTER_DRAIN = false; static_assert(ACT == 0 || ACT == 1, "EpiBf16: ACT is 0 (none) or 1 (gelu_pk)");
    bf16_t* O; int ldc; const float* bias; int split_cols; size_t split_stride; float scale0;
    __device__ __forceinline__ void operator()(const f32x4 (&acc)[2][2][4][2], const Unit& u, int wr, int wc, int fr, int fq) const {
        const int row0 = u.pm * BM + wr * 64 + fr; int colt = u.pn * BM; bf16_t* base = O;
        float sc = 1.f; if (split_cols) { const int t = colt / split_cols; base += (size_t)t * split_stride; colt -= t * split_cols; if (t == 0) sc = scale0; }
        const int col0 = colt + wc * 32 + 8 * fq, bcol0 = u.pn * BM + wc * 32 + 8 * fq;
        f32x4 bv[2][2];
#pragma unroll
        for (int bj = 0; bj < 2; ++bj)
#pragma unroll
            for (int n = 0; n < 2; ++n) bv[bj][n] = bias ? *(const f32x4*)(bias + bcol0 + bj * HALF + 4 * n) : (f32x4){0.f, 0.f, 0.f, 0.f};
#pragma unroll
        for (int ai = 0; ai < 2; ++ai)
#pragma unroll
            for (int m = 0; m < 4; ++m) { bf16_t* rowp = base + (size_t)(row0 + ai * HALF + m * 16) * ldc + col0;
#pragma unroll
                for (int bj = 0; bj < 2; ++bj) { f32x4 v0 = acc[ai][bj][m][0] + bv[bj][0], v1 = acc[ai][bj][m][1] + bv[bj][1];
                    if (ACT == 1) { f32x2 a = gelu_pk((f32x2){v0[0], v0[1]}), b = gelu_pk((f32x2){v0[2], v0[3]}), c = gelu_pk((f32x2){v1[0], v1[1]}), d = gelu_pk((f32x2){v1[2], v1[3]});
                        v0 = (f32x4){a.x, a.y, b.x, b.y}; v1 = (f32x4){c.x, c.y, d.x, d.y}; }
                    v0 = v0 * sc; v1 = v1 * sc; u32x4 w; w.x = cvt_pk_bf16(v0[0], v0[1]); w.y = cvt_pk_bf16(v0[2], v0[3]); w.z = cvt_pk_bf16(v1[0], v1[1]); w.w = cvt_pk_bf16(v1[2], v1[3]);
                    *(u32x4*)(rowp + bj * HALF) = w; } }
    }
};
__device__ __forceinline__ float sigmoidf_(float x) { return __builtin_amdgcn_rcpf(1.0f + __expf(-x)); }
struct EpiResid {
    static constexpr bool PERM = false, AFTER_DRAIN = false;
    const float* base; float* out; int ldc; const float* gvec;
    __device__ __forceinline__ void operator()(const f32x4 (&acc)[2][2][4][2], const Unit& u, int wr, int wc, int fr, int fq) const {
        const int row0 = u.pm * BM + wr * 64 + fr, col0 = u.pn * BM + wc * 32 + 4 * fq;
        f32x4 gv[2][2];
#pragma unroll
        for (int bj = 0; bj < 2; ++bj)
#pragma unroll
            for (int n = 0; n < 2; ++n) gv[bj][n] = *(const __attribute__((address_space(1))) f32x4*)(gvec + col0 + bj * HALF + n * 16);
#pragma unroll
        for (int ai = 0; ai < 2; ++ai)
#pragma unroll
            for (int m = 0; m < 4; ++m) { const size_t off = (size_t)(row0 + ai * HALF + m * 16) * ldc + col0;
#pragma unroll
                for (int bj = 0; bj < 2; ++bj)
#pragma unroll
                    for (int n = 0; n < 2; ++n) { const f32x4 bs = *(const __attribute__((address_space(1))) f32x4*)(base + off + bj * HALF + n * 16);
                        *(__attribute__((address_space(1))) f32x4*)(out + off + bj * HALF + n * 16) = bs + gv[bj][n] * acc[ai][bj][m][n]; }
                if (m & 1) asm volatile("" ::: "memory"); }
    }
};
struct EpiSwiglu {
    static constexpr bool PERM = true, AFTER_DRAIN = false;
    bf16_t* O; int ldc;
    __device__ __forceinline__ void operator()(const f32x4 (&acc)[2][2][4][2], const Unit& u, int wr, int wc, int fr, int fq) const {
        const int row0 = u.pm * BM + wr * 64 + fr, col0 = u.pn * HALF + wc * 32 + 8 * fq;
#pragma unroll
        for (int ai = 0; ai < 2; ++ai)
#pragma unroll
            for (int m = 0; m < 4; ++m) { bf16_t* rowp = O + (size_t)(row0 + ai * HALF + m * 16) * ldc + col0;
                f32x4 h0, h1;
#pragma unroll
                for (int j = 0; j < 4; ++j) { const float g0 = acc[ai][0][m][0][j], g1 = acc[ai][0][m][1][j];
                    h0[j] = g0 * sigmoidf_(g0) * acc[ai][1][m][0][j]; h1[j] = g1 * sigmoidf_(g1) * acc[ai][1][m][1][j]; }
                u32x4 w; w.x = cvt_pk_bf16(h0[0], h0[1]); w.y = cvt_pk_bf16(h0[2], h0[3]); w.z = cvt_pk_bf16(h1[0], h1[1]); w.w = cvt_pk_bf16(h1[2], h1[3]);
                *(__attribute__((address_space(1))) u32x4*)rowp = w; }
    }
};
template <int CTRL> __device__ __forceinline__ float dpp_f(float old, float src) { return __builtin_bit_cast(float, __builtin_amdgcn_update_dpp(__builtin_bit_cast(int, old), __builtin_bit_cast(int, src), CTRL, 0xf, 0xf, false)); }
struct EpiLora {
    static constexpr bool PERM = true, AFTER_DRAIN = false;
    unsigned char* PKB; bf16_t* KD; const bf16_t* kbuf; const bf16_t* kkbuf; const bf16_t* rbuf; const float* w0; const float* a0; const float* k_a; int TT;
    __device__ __forceinline__ void operator()(const f32x4 (&acc)[2][2][4][2], const Unit& u, int wr, int wc, int fr, int fq) const {
        typedef __attribute__((address_space(1))) f32x4 gf4; typedef const __attribute__((address_space(1))) f32x4 cgf4;
        const int d = u.pn >> 4, cg = u.pn & 15;
        const int c8 = cg * HALF + wc * 32 + 8 * fq, h = c8 >> 6, ch = c8 & 63;
        const int row0 = u.pm * BM + wr * 64 + fr;
        f32x4 w0v[2], a0v[2], kav[2];
#pragma unroll
        for (int n = 0; n < 2; ++n) { w0v[n] = *(cgf4*)(w0 + d * 2048 + c8 + 4 * n); a0v[n] = *(cgf4*)(a0 + d * 2048 + c8 + 4 * n); kav[n] = *(cgf4*)(k_a + c8 + 4 * n); }
        typedef unsigned u32x2l __attribute__((ext_vector_type(2))); typedef const __attribute__((address_space(1))) u32x2l cgu2;
        u32x2l kq[2][2], kkq[2][2], rq[2][2];
        { const size_t fo0 = (size_t)row0 * 2048 + c8;
#pragma unroll
          for (int n = 0; n < 2; ++n) { kq[0][n] = *(cgu2*)(kbuf + fo0 + 4 * n); kkq[0][n] = *(cgu2*)(kkbuf + fo0 + 4 * n); rq[0][n] = *(cgu2*)(rbuf + fo0 + 4 * n); } }
#pragma unroll
        for (int it = 0; it < 8; ++it) {
            const int ai = it >> 2, m = it & 3;
            if (it + 1 < 8) { const size_t fo1 = (size_t)(row0 + ((it + 1) >> 2) * HALF + ((it + 1) & 3) * 16) * 2048 + c8;
#pragma unroll
                for (int n = 0; n < 2; ++n) { kq[(it + 1) & 1][n] = *(cgu2*)(kbuf + fo1 + 4 * n); kkq[(it + 1) & 1][n] = *(cgu2*)(kkbuf + fo1 + 4 * n); rq[(it + 1) & 1][n] = *(cgu2*)(rbuf + fo1 + 4 * n); } }
            asm volatile("" ::: "memory");
            const int tok = row0 + ai * HALF + m * 16;
            const int tau = d == 0 ? (tok & 15) : 15 - (tok & 15);
            unsigned char* rec = PKB + ((size_t)(d * 32 + h) * (TT / 16) + (tok >> 4)) * 8448;
            const size_t fo = (size_t)tok * 2048 + c8;
            f32x4 g[2]; u32x4 kw;
#pragma unroll
            for (int n = 0; n < 2; ++n) {
                f32x4 gp;
                const f32x4 x = acc[ai][0][m][n] + w0v[n];
#pragma unroll
                for (int j = 0; j < 4; ++j) { float w = __expf(-0.60653066f * sigmoidf_(x[j]));
                    if (d == 0) { w *= dpp_f<0x111>(1.0f, w); w *= dpp_f<0x112>(1.0f, w); w *= dpp_f<0x114>(1.0f, w); w *= dpp_f<0x118>(1.0f, w); g[n][j] = w; gp[j] = dpp_f<0x111>(1.0f, w); }
                    else        { w *= dpp_f<0x101>(1.0f, w); w *= dpp_f<0x102>(1.0f, w); w *= dpp_f<0x104>(1.0f, w); w *= dpp_f<0x108>(1.0f, w); g[n][j] = w; gp[j] = dpp_f<0x101>(1.0f, w); } }
                const f32x4 xa = acc[ai][1][m][n] + a0v[n];
                f32x4 k4, kk4, r4;
                { const u32x2l a_ = kq[it & 1][n], b_ = kkq[it & 1][n], c_ = rq[it & 1][n];
                  k4[0] = __builtin_bit_cast(float, a_.x << 16); k4[1] = __builtin_bit_cast(float, a_.x & 0xffff0000u); k4[2] = __builtin_bit_cast(float, a_.y << 16); k4[3] = __builtin_bit_cast(float, a_.y & 0xffff0000u);
                  kk4[0] = __builtin_bit_cast(float, b_.x << 16); kk4[1] = __builtin_bit_cast(float, b_.x & 0xffff0000u); kk4[2] = __builtin_bit_cast(float, b_.y << 16); kk4[3] = __builtin_bit_cast(float, b_.y & 0xffff0000u);
                  r4[0] = __builtin_bit_cast(float, c_.x << 16); r4[1] = __builtin_bit_cast(float, c_.x & 0xffff0000u); r4[2] = __builtin_bit_cast(float, c_.y << 16); r4[3] = __builtin_bit_cast(float, c_.y & 0xffff0000u); }
                f32x4 at, rt, bt, kdt; float kdv[4];
#pragma unroll
                for (int j = 0; j < 4; ++j) { const float a = sigmoidf_(xa[j]), rg = __builtin_amdgcn_rcpf(g[n][j]);
                    kdv[j] = k4[j] * (1.0f + (a - 1.0f) * kav[n][j]);
                    at[j] = -kk4[j] * gp[j]; rt[j] = r4[j] * g[n][j]; bt[j] = kk4[j] * a * rg; kdt[j] = kdv[j] * rg; }
                const int chn = ch + 4 * n;
                {
                    const int p0 = ((((chn >> 5) * 2 + ((chn >> 4) & 1)) * 2 + n) * 8 + ((chn >> 3) & 1) * 4);
                    typedef unsigned u32x2 __attribute__((ext_vector_type(2)));
                    __attribute__((address_space(1))) unsigned char* rp = (__attribute__((address_space(1))) unsigned char*)rec + (tau * 64 + p0) * 2;
                    u32x2 w;
                    w.x = cvt_pk_bf16(at[0], at[1]); w.y = cvt_pk_bf16(at[2], at[3]); *(__attribute__((address_space(1))) u32x2*)(rp) = w;
                    w.x = cvt_pk_bf16(rt[0], rt[1]); w.y = cvt_pk_bf16(rt[2], rt[3]); *(__attribute__((address_space(1))) u32x2*)(rp + 2048) = w;
                    w.x = cvt_pk_bf16(bt[0], bt[1]); w.y = cvt_pk_bf16(bt[2], bt[3]); *(__attribute__((address_space(1))) u32x2*)(rp + 4096) = w;
                    w.x = cvt_pk_bf16(kdt[0], kdt[1]); w.y = cvt_pk_bf16(kdt[2], kdt[3]); *(__attribute__((address_space(1))) u32x2*)(rp + 6144) = w; }
                if (n == 0) { kw.x = cvt_pk_bf16(kdv[0], kdv[1]); kw.y = cvt_pk_bf16(kdv[2], kdv[3]); } else { kw.z = cvt_pk_bf16(kdv[0], kdv[1]); kw.w = cvt_pk_bf16(kdv[2], kdv[3]); }
            }
            *(__attribute__((address_space(1))) u32x4*)(KD + (size_t)d * TT * 2048 + fo) = kw;
            if (fr == (d == 0 ? 15 : 0)) { float* ge = (float*)(rec + 8192) + ch; *(gf4*)ge = g[0]; *(gf4*)(ge + 4) = g[1]; }
        }
    }
};
template <class Epi, class Sched, bool ALIGN_EPI = false, bool SP2 = false>
__device__ __forceinline__ void gemm_phase(PG8_LAS unsigned char* lds, const Gemm g, const Sched& S, const Epi& E, const int wid) {
    const int lane = mk_lane(), tid = wid * 64 + lane, wr = wid >> 2, wc = wid & 3, fr = lane & 15, fq = lane >> 4;
    const int K = g.K, nt = K / BK;
    unsigned voffA[2], voffB[2];
#pragma unroll
    for (int i = 0; i < 2; ++i) { int R, C; stage_rc(tid * 16 + i * 8192, R, C); const int Rb = Epi::PERM ? ((R & ~31) + perm32(R & 31)) : R;
        voffA[i] = (unsigned)(R * K + C) * 2u; voffB[i] = (unsigned)(Rb * K + C) * 2u; }
    const size_t kstep = (size_t)(BK * 2);
    const size_t hstep = (size_t)HALF * K * 2;
    const size_t tstep = 2 * hstep;
    const unsigned ldsw = (unsigned)wid * 1024u;
    const int aoff = lds_byte(wr * 64 + fr, fq * 8), boff = lds_byte(wc * 32 + fr, fq * 8);
#define PG8_SA(b, h) (((b) * 2 + (h)) * HTB)
#define PG8_SB(b, h) ((4 + (b) * 2 + (h)) * HTB)
#define PG8_STAGE(bufoff, gbase, voff) do { _Pragma("unroll") for (int _i = 0; _i < 2; ++_i) \
        __builtin_amdgcn_global_load_lds((const unsigned*)((const char*)(gbase) + (voff)[_i]), (PG8_LAS unsigned*)(lds + (bufoff) + ldsw + _i * 8192), 16, 0, 0); } while (0)
#define PG8_LDA(dst, b, h) do { _Pragma("unroll") for (int m = 0; m < 4; ++m) _Pragma("unroll") for (int k = 0; k < 2; ++k) dst[m][k] = *(const PG8_LAS bf16x8*)(lds + PG8_SA(b, h) + aoff + m * 2048 + k * 1024); } while (0)
#define PG8_LDB(dst, b, h) do { _Pragma("unroll") for (int n = 0; n < 2; ++n) _Pragma("unroll") for (int k = 0; k < 2; ++k) dst[n][k] = *(const PG8_LAS bf16x8*)(lds + PG8_SB(b, h) + boff + n * 2048 + k * 1024); } while (0)
#define PG8_MMA(ai, bj, At, Bt) do { __builtin_amdgcn_s_setprio(1); _Pragma("unroll") for (int m = 0; m < 4; ++m) _Pragma("unroll") for (int n = 0; n < 2; ++n) _Pragma("unroll") for (int k = 0; k < 2; ++k) \
        acc[ai][bj][m][n] = __builtin_amdgcn_mfma_f32_16x16x32_bf16(Bt[n][k], At[m][k], acc[ai][bj][m][n], 0, 0, 0); __builtin_amdgcn_s_setprio(0); } while (0)
#define PG8_WAIT_V(n) asm volatile("s_waitcnt vmcnt(" #n ")" ::: "memory")
#define PG8_WAIT_L(n) asm volatile("s_waitcnt lgkmcnt(" #n ")" ::: "memory")
#define PG8_BAR __builtin_amdgcn_s_barrier()
#define PG8_SCHED __builtin_amdgcn_sched_barrier(0)
    Unit cur, nxt; int ui = 0;
    if (!S.next(0, cur)) return;
    f32x4 acc[2][2][4][2];
#pragma unroll
    for (int a = 0; a < 2; ++a)
#pragma unroll
        for (int b = 0; b < 2; ++b)
#pragma unroll
            for (int m = 0; m < 4; ++m)
#pragma unroll
                for (int n = 0; n < 2; ++n) acc[a][b][m][n] = (f32x4){0.f, 0.f, 0.f, 0.f};
    bf16x8 At[4][2], B0[2][2], B1[2][2];
    const char* cA = (const char*)g.A + (size_t)cur.pm * tstep; const char* cB = (const char*)g.Bt + (size_t)cur.pn * tstep;
    S.a_ready(cur);
    if constexpr (SP2) {
        PG8_STAGE(PG8_SB(0, 0), cB, voffB); PG8_STAGE(PG8_SB(0, 1), cB + hstep, voffB); PG8_STAGE(PG8_SA(0, 0), cA, voffA); PG8_STAGE(PG8_SA(0, 1), cA + hstep, voffA);
        if (wr == 1) PG8_BAR;
        PG8_WAIT_V(2); PG8_BAR;
        PG8_STAGE(PG8_SB(1, 0), cB + kstep, voffB); PG8_STAGE(PG8_SA(1, 0), cA + kstep, voffA); PG8_STAGE(PG8_SB(1, 1), cB + hstep + kstep, voffB);
        PG8_WAIT_V(6); PG8_BAR;
    } else {
        PG8_STAGE(PG8_SB(0, 0), cB, voffB); PG8_STAGE(PG8_SA(0, 0), cA, voffA); PG8_STAGE(PG8_SB(0, 1), cB + hstep, voffB); PG8_STAGE(PG8_SA(0, 1), cA + hstep, voffA);
        if (wr == 1) PG8_BAR;
        PG8_WAIT_V(4); PG8_BAR;
        PG8_STAGE(PG8_SB(1, 0), cB + kstep, voffB); PG8_STAGE(PG8_SA(1, 0), cA + kstep, voffA); PG8_STAGE(PG8_SB(1, 1), cB + hstep + kstep, voffB);
        PG8_WAIT_V(6); PG8_BAR;
    }
    for (;;) {
        const bool has_next = S.next(ui + 1, nxt);
        const char* nA = has_next ? (const char*)g.A + (size_t)nxt.pm * tstep : cA; const char* nB = has_next ? (const char*)g.Bt + (size_t)nxt.pn * tstep : cB;
        for (int t = 0; t < nt; t += 2) {
            const bool last = (t == nt - 2);
            const char* a1 = cA + (size_t)(t + 1) * kstep;
            const char* a2 = last ? nA : cA + (size_t)(t + 2) * kstep; const char* b2 = last ? nB : cB + (size_t)(t + 2) * kstep;
            const char* a3 = a2 + kstep; const char* b3 = b2 + kstep;
            if (last && has_next) S.a_ready(nxt);
            if constexpr (SP2) {
            PG8_LDB(B0, 0, 0); PG8_LDB(B1, 0, 1); PG8_SCHED; PG8_LDA(At, 0, 0); PG8_STAGE(PG8_SA(1, 1), a1 + hstep, voffA);
            PG8_WAIT_V(8); PG8_WAIT_L(0); PG8_BAR; PG8_MMA(0, 0, At, B0); PG8_MMA(0, 1, At, B1); PG8_BAR; PG8_SCHED;
            PG8_LDA(At, 0, 1); PG8_STAGE(PG8_SB(0, 0), b2, voffB); PG8_STAGE(PG8_SB(0, 1), b2 + hstep, voffB); PG8_STAGE(PG8_SA(0, 0), a2, voffA);
            PG8_WAIT_V(8); PG8_WAIT_L(0); PG8_BAR; PG8_MMA(1, 0, At, B0); PG8_MMA(1, 1, At, B1); PG8_BAR; PG8_SCHED;
            PG8_LDB(B0, 1, 0); PG8_LDB(B1, 1, 1); PG8_SCHED; PG8_LDA(At, 1, 0); PG8_STAGE(PG8_SA(0, 1), a2 + hstep, voffA);
            PG8_WAIT_V(8); PG8_WAIT_L(0); PG8_BAR; PG8_MMA(0, 0, At, B0); PG8_MMA(0, 1, At, B1); PG8_BAR; PG8_SCHED;
            PG8_LDA(At, 1, 1); PG8_STAGE(PG8_SB(1, 0), b3, voffB); PG8_STAGE(PG8_SB(1, 1), b3 + hstep, voffB); PG8_STAGE(PG8_SA(1, 0), a3, voffA);
            PG8_WAIT_V(8); PG8_WAIT_L(0); PG8_BAR; PG8_MMA(1, 0, At, B0); PG8_MMA(1, 1, At, B1); PG8_BAR; PG8_SCHED;
            } else {
            PG8_LDB(B0, 0, 0); PG8_SCHED; PG8_LDA(At, 0, 0); PG8_STAGE(PG8_SA(1, 1), a1 + hstep, voffA);
            PG8_WAIT_L(8); PG8_BAR; PG8_WAIT_L(0); PG8_MMA(0, 0, At, B0); PG8_BAR; PG8_SCHED;
            PG8_LDB(B1, 0, 1); PG8_STAGE(PG8_SB(0, 0), b2, voffB);
            PG8_BAR; PG8_WAIT_L(0); PG8_MMA(0, 1, At, B1); PG8_BAR;
            PG8_LDA(At, 0, 1); PG8_STAGE(PG8_SA(0, 0), a2, voffA);
            PG8_BAR; PG8_WAIT_L(0); PG8_MMA(1, 0, At, B0); PG8_BAR; PG8_SCHED;
            PG8_STAGE(PG8_SB(0, 1), b2 + hstep, voffB);
            PG8_WAIT_V(6); PG8_BAR; PG8_MMA(1, 1, At, B1); PG8_BAR;
            PG8_LDB(B0, 1, 0); PG8_SCHED; PG8_LDA(At, 1, 0); PG8_STAGE(PG8_SA(0, 1), a2 + hstep, voffA);
            PG8_WAIT_L(8); PG8_BAR; PG8_WAIT_L(0); PG8_MMA(0, 0, At, B0); PG8_BAR; PG8_SCHED;
            PG8_LDB(B1, 1, 1); PG8_STAGE(PG8_SB(1, 0), b3, voffB);
            PG8_BAR; PG8_WAIT_L(0); PG8_MMA(0, 1, At, B1); PG8_BAR;
            PG8_LDA(At, 1, 1); PG8_STAGE(PG8_SA(1, 0), a3, voffA);
            PG8_BAR; PG8_WAIT_L(0); PG8_MMA(1, 0, At, B0); PG8_BAR; PG8_SCHED;
            PG8_STAGE(PG8_SB(1, 1), b3 + hstep, voffB);
            PG8_WAIT_V(6); PG8_BAR; PG8_MMA(1, 1, At, B1); PG8_BAR;
            }
        }
        if constexpr (ALIGN_EPI) { if (wr == 0) PG8_BAR; }
        if constexpr (!Epi::AFTER_DRAIN) { const int l2 = mk_lane(); E(acc, cur, wr, wc, l2 & 15, l2 >> 4); S.done(cur); }
        if (!has_next) break;
#pragma unroll
        for (int a = 0; a < 2; ++a)
#pragma unroll
            for (int b = 0; b < 2; ++b)
#pragma unroll
                for (int m = 0; m < 4; ++m)
#pragma unroll
                    for (int n = 0; n < 2; ++n) acc[a][b][m][n] = (f32x4){0.f, 0.f, 0.f, 0.f};
        cur = nxt; cA = nA; cB = nB; ++ui;
        if constexpr (ALIGN_EPI) { if (wr == 1) PG8_BAR; }
    }
    PG8_WAIT_V(0);
    if constexpr (!ALIGN_EPI) { if (wr == 0) PG8_BAR; }
    PG8_BAR;
    if constexpr (Epi::AFTER_DRAIN) { E.fused(acc, cur, wr, wc, fr, fq, lds, wid, lane); S.done(cur); }
#undef PG8_SA
#undef PG8_SB
#undef PG8_STAGE
#undef PG8_LDA
#undef PG8_LDB
#undef PG8_MMA
#undef PG8_WAIT_V
#undef PG8_WAIT_L
#undef PG8_BAR
#undef PG8_SCHED
}
}

constexpr int NWAVES = 8;
#ifndef MK_N_LAUNCHES
#define MK_N_LAUNCHES 1
#endif
constexpr int N_PHASES = 14;
#ifndef MK_REPS
#define MK_REPS {1,1,1,1,1,1,1,1,1,1,1,1,1,1}
#endif
constexpr int PH_REPS[14] = MK_REPS;
#ifndef MK_TPA
#define MK_TPA -1
#endif
#ifndef MK_TPB
#define MK_TPB -1
#endif
constexpr int TPA = MK_TPA, TPB = MK_TPB;
constexpr int N_LAUNCHES = MK_N_LAUNCHES;

constexpr int D = 4096, T = 8192, CTXL = 256, TT = T + CTXL;
constexpr int DR = 2048, DC = 2048, NH = 32, HS = 64;
constexpr int OFF_K = 0, OFF_V = 2048, OFF_WL = 4096, OFF_AL = 4192, OFF_R = 4288, OFF_GL = 6336, RWKV_COLS = 6592;
constexpr int OFF_CB = 6592, OFF_CC = 8640, OFF_CX = 10688, IN_COLS = 12736, NZ = 12800;
constexpr int NCTXZ = 4352;
constexpr int DFF = 11008, NGU = 2 * DFF;
constexpr int NLORA = 8192, KLORA = 256, KGATE = 256;
constexpr int MODN = 6 * D;
constexpr int NKC = 16;
constexpr float NORM_EPS = 1e-6f, LNX_EPS = 64e-5f;
constexpr int CHUNK = 256, NCHUNK = 33;

constexpr size_t MiB = 1u << 20;
constexpr size_t WS_CTL = 0, CTL_ZERO_BYTES = 1 * MiB;
constexpr size_t WS_MODP = 1 * MiB;
constexpr size_t WS_MODV = 5 * MiB;
constexpr size_t WS_WLORA = 6 * MiB;
constexpr size_t WS_WGATE = 10 * MiB;
constexpr size_t WS_ALORA = 11 * MiB;
constexpr size_t WS_AGATE = 16 * MiB;
constexpr size_t WS_WOUT = 20 * MiB;
constexpr size_t WS_WGU = 52 * MiB;
constexpr size_t WS_WDN = 224 * MiB;
constexpr size_t WS_WIN = 310 * MiB;
constexpr size_t WS_PU = 310 * MiB;
constexpr size_t WS_SST = 374 * MiB;
constexpr size_t WS_A1 = 410 * MiB;
constexpr size_t WS_CAT = 410 * MiB;
constexpr size_t WS_Z = 476 * MiB;
constexpr size_t WS_YS = 476 * MiB;
constexpr size_t WS_KD = 604 * MiB;
constexpr size_t WS_GE = 670 * MiB;
constexpr size_t WS_KBUF = 683 * MiB;
constexpr size_t WS_KKBUF = 749 * MiB;
constexpr size_t WS_RBUF = 815 * MiB;
constexpr size_t WS_VBUF = 881 * MiB;
constexpr size_t WS_X1 = 683 * MiB;
constexpr size_t WS_PK = 947 * MiB;
constexpr size_t WS_ACT = 947 * MiB;
constexpr size_t WS_G = 1475 * MiB;
constexpr size_t WS_END = 1507 * MiB;
static_assert(WS_MODP + (size_t)NKC * 2 * MODN * 4 <= WS_MODV && WS_ALORA + (size_t)TT * 256 * 2 <= WS_AGATE && WS_WGU + (size_t)NGU * D * 2 <= WS_WDN && WS_WDN + (size_t)D * DFF * 2 <= WS_WIN, "ws map 1");
static_assert(WS_WIN + (size_t)NZ * D * 2 <= WS_A1 && WS_SST + (size_t)64 * NCHUNK * 16384 <= WS_A1 && WS_A1 + (size_t)TT * D * 2 <= WS_Z && WS_Z + (size_t)TT * NZ * 2 <= WS_KBUF, "ws map 2");
static_assert(WS_YS + (size_t)2 * T * 2048 * 4 <= WS_KD && WS_KD + (size_t)2 * TT * 2048 * 2 <= WS_GE && WS_GE + (size_t)64 * (TT / 16) * 256 <= WS_KBUF, "ws map 3");
static_assert(WS_KBUF + (size_t)TT * 2048 * 4 <= WS_KKBUF && WS_KKBUF + (size_t)TT * 2048 * 4 <= WS_RBUF && WS_RBUF + (size_t)TT * 2048 * 4 <= WS_VBUF && WS_VBUF + (size_t)TT * 2048 * 4 <= WS_PK, "ws map 4");
static_assert(WS_X1 + (size_t)T * D * 4 <= WS_RBUF && WS_PK + (size_t)64 * TT * 1024 <= WS_G && WS_ACT + (size_t)T * DFF * 2 <= WS_G && WS_G + (size_t)T * 2048 * 2 <= WS_END && WS_CAT + (size_t)T * D * 2 <= WS_Z, "ws map 5");
constexpr int CW_TMO = 0;
constexpr int CW_BAR = 4096;

constexpr int RING_OFF = 0, RING_BYTES = 131072;
constexpr int LDSCTL_OFF = RING_BYTES, MISC_OFF = LDSCTL_OFF + 320;
constexpr int LDS_BYTES = 147456;
static_assert(MISC_OFF + 128 <= LDS_BYTES, "LDS map");

#define GAS __attribute__((address_space(1)))
#define LAS __attribute__((address_space(3)))
typedef unsigned short bf16;
typedef unsigned v4u __attribute__((ext_vector_type(4)));
typedef unsigned v2u __attribute__((ext_vector_type(2)));
typedef float f32x4 __attribute__((ext_vector_type(4)));
typedef GAS unsigned gu32;
#define RLX_AGENT __ATOMIC_RELAXED, __HIP_MEMORY_SCOPE_AGENT
#define LDS_WAIT() asm volatile("s_waitcnt lgkmcnt(0)" ::: "memory")
#define VM_WAIT() asm volatile("s_waitcnt vmcnt(0)" ::: "memory")
__device__ __forceinline__ unsigned f2bf(float f) { unsigned u = __builtin_bit_cast(unsigned, f); return (u + 0x7fffu + ((u >> 16) & 1u)) >> 16; }
__device__ __forceinline__ unsigned pk2(float lo, float hi) { return f2bf(lo) | (f2bf(hi) << 16); }
__device__ __forceinline__ float bflo(unsigned w) { return __builtin_bit_cast(float, w << 16); }
__device__ __forceinline__ float bfhi(unsigned w) { return __builtin_bit_cast(float, w & 0xffff0000u); }
__device__ __forceinline__ float sigm(float x) { return 1.0f / (1.0f + __expf(-x)); }

#define XB_TMO      128
#define XB_XCNT(j)  (256  + 64 * (j))
#define XB_XSUB(j)  (1280 + 64 * (j))
#define XB_XGEN(j)  (2304 + 64 * (j))
#define XB_TOP      3328
#define XB_TOPGEN   3392
#define XCD_BAR_WORDS 3456
#define XB_SPIN_CAP (1u << 18)
__device__ __forceinline__ unsigned xb_ld(unsigned* p)              { return __hip_atomic_load(p, __ATOMIC_RELAXED, __HIP_MEMORY_SCOPE_AGENT); }
__device__ __forceinline__ unsigned xb_add(unsigned* p, unsigned v) { return __hip_atomic_fetch_add(p, v, __ATOMIC_RELAXED, __HIP_MEMORY_SCOPE_AGENT); }
__device__ __forceinline__ unsigned xb_xcc_id() { return (unsigned)__builtin_amdgcn_s_getreg((3 << 11) | 20) & 0xFu; }
#define XB_SPIN(cond, bar) do { unsigned _sp = 0; while (cond) { __builtin_amdgcn_s_sleep(1); \
    if ((++_sp & 255u) == 0u) { if (xb_ld(&(bar)[XB_TMO])) break; if (_sp > XB_SPIN_CAP) { atomicAdd(&(bar)[XB_TMO], 1u); break; } } } } while (0)
struct XcdBarrier { unsigned* bar; unsigned x; volatile LAS unsigned* st; };
__device__ __forceinline__ XcdBarrier xcd_barrier_post(unsigned* bar, volatile LAS unsigned* st) {
    XcdBarrier b; b.bar = bar; b.x = xb_xcc_id(); b.st = st;
    if (threadIdx.x == 0) (void)xb_add(&bar[XB_XCNT(b.x)], 1u);
    return b;
}
__device__ __forceinline__ void xcd_barrier_complete(unsigned* bar, unsigned x, unsigned& nloc, unsigned& nx) {
    const unsigned G = gridDim.x * gridDim.y * gridDim.z;
    unsigned sum, cnt, mine, sp = 0u;
    for (;;) {
        sum = 0u; cnt = 0u; mine = 0u;
#pragma unroll
        for (unsigned j = 0; j < 16; ++j) { const unsigned c = xb_ld(&bar[XB_XCNT(j)]); sum += c; cnt += (c > 0u) ? 1u : 0u; mine = (j == x) ? c : mine; }
        if (sum == G) break;
        __builtin_amdgcn_s_sleep(1);
        if ((++sp & 255u) == 0u) { if (xb_ld(&bar[XB_TMO])) break; if (sp > XB_SPIN_CAP) { atomicAdd(&bar[XB_TMO], 1u); break; } }
    }
    nloc = mine > 0u ? mine : 1u; nx = cnt > 0u ? cnt : 1u;
}
__device__ __forceinline__ void xcd_barrier(const XcdBarrier& b, const int wave) {
    asm volatile("s_waitcnt vmcnt(0)" ::: "memory");
    __syncthreads();
    if (wave == 0 && pg8::mk_lane() == 0) {
        unsigned* bar = b.bar;
        __builtin_amdgcn_s_waitcnt(0);
        unsigned nloc = b.st[0], nx = b.st[1];
        if (nloc == 0u) { xcd_barrier_complete(bar, b.x, nloc, nx); b.st[0] = nloc; b.st[1] = nx; }
        const unsigned old = xb_add(&bar[XB_XSUB(b.x)], 1u);
        const unsigned gen = old / nloc;
        if (old + 1u == (gen + 1u) * nloc) {
            __builtin_amdgcn_fence(__ATOMIC_RELEASE, "agent");
            asm volatile("s_waitcnt vmcnt(0)" ::: "memory");
            const unsigned og = xb_add(&bar[XB_TOP], 1u);
            const unsigned tg = og / nx;
            if (og + 1u == (tg + 1u) * nx) xb_add(&bar[XB_TOPGEN], 1u);
            else XB_SPIN(xb_ld(&bar[XB_TOPGEN]) == tg, bar);
            __builtin_amdgcn_fence(__ATOMIC_ACQUIRE, "agent");
            xb_add(&bar[XB_XGEN(b.x)], 1u);
            asm volatile("s_waitcnt vmcnt(0)" ::: "memory");
        } else {
            XB_SPIN(xb_ld(&bar[XB_XGEN(b.x)]) == gen, bar);
            __builtin_amdgcn_fence(__ATOMIC_ACQUIRE, "agent");
            asm volatile("s_waitcnt vmcnt(0)" ::: "memory");
        }
    }
    __syncthreads();
}

struct Frame {
    LAS unsigned char* lds;
    volatile LAS unsigned* MISC;
    gu32* ctl;
    int wave;
    int vcu, G;
    unsigned char* ws;
    const float* in[26];
    float* out;
};
enum { I_X = 0, I_C, I_CTX, I_CCTX, I_WADA, I_BADA, I_NORM1, I_WIN, I_MU, I_KK, I_KA, I_RK, I_W0, I_WDU, I_A0, I_WIU, I_WGU, I_LNXW, I_LNXB, I_CONVW, I_WOUT, I_NORM2, I_WFG, I_WFU, I_WFD, I_NORMF };

__device__ __forceinline__ float wave_sum(float v) {
#pragma unroll
    for (int o = 1; o < 64; o <<= 1) v += __shfl_xor(v, o);
    return v;
}

__device__ __forceinline__ void p0_transpose_item(const float* W, int K, int N, bf16* WT, int ldk, int row_off, LAS float* scr, int item, int lane) {
    const int nblk = N / 32, kb = item / nblk, nb = item % nblk, k0 = 64 * kb, n0 = 32 * nb;
    float tv[32];
#pragma unroll
    for (int i = 0; i < 32; ++i) tv[i] = *(const GAS float*)(W + (size_t)(k0 + 2 * i + (lane >> 5)) * N + n0 + (lane & 31));
#pragma unroll
    for (int i = 0; i < 32; ++i) scr[(2 * i + (lane >> 5)) * 33 + (lane & 31)] = tv[i];
    LDS_WAIT(); asm volatile("" ::: "memory");
    const int c = lane & 7;
#pragma unroll
    for (int j = 0; j < 4; ++j) { const int n = (lane >> 3) + 8 * j; const LAS float* s = scr + (8 * c) * 33 + n;
        v4u o; o.x = pk2(s[0 * 33], s[1 * 33]); o.y = pk2(s[2 * 33], s[3 * 33]); o.z = pk2(s[4 * 33], s[5 * 33]); o.w = pk2(s[6 * 33], s[7 * 33]);
        *(GAS v4u*)(WT + (size_t)(row_off + n0 + n) * ldk + k0 + 8 * c) = o; }
    LDS_WAIT(); asm volatile("" ::: "memory");
}
constexpr int TI_IN = (D / 64) * (IN_COLS / 32), TI_OUT = (D / 64) * (D / 32), TI_G = (D / 64) * (DFF / 32), TI_DN = (DFF / 64) * (D / 32);
constexpr int TI_TOTAL = TI_IN + TI_OUT + 2 * TI_G + TI_DN;
constexpr int GEMV_UNITS = NKC * (MODN / 256);
constexpr int IB_OUT = TI_IN, IB_G = IB_OUT + TI_OUT, IB_U = IB_G + TI_G, IB_D = IB_U + TI_G;
constexpr int P2T_B = IB_OUT, P2T_E = IB_G + 13200;
constexpr int P6T_B = P2T_E, P6T_E = IB_U + 11000;
constexpr int P0X_B = P6T_E, P0X_E = IB_D + 12000;
constexpr int P11T_B = P0X_E, P11T_E = TI_TOTAL;
constexpr int P0_ITEMS = TI_IN + (P0X_E - P0X_B);
constexpr int TI_PER_GEMV_WAVE = 18, TI_PER_OTHER_WAVE = 42;
static_assert(GEMV_UNITS <= 2048 && GEMV_UNITS * TI_PER_GEMV_WAVE + (2048 - GEMV_UNITS) * TI_PER_OTHER_WAVE >= P0_ITEMS, "P0 item split");

__device__ __forceinline__ void tr_item(Frame& F, int it, LAS float* scr, int lane) {
    int r = it;
    if (r < TI_IN) { p0_transpose_item(F.in[I_WIN], D, IN_COLS, (bf16*)(F.ws + WS_WIN), D, 0, scr, r, lane); return; } r -= TI_IN;
    if (r < TI_OUT) { p0_transpose_item(F.in[I_WOUT], D, D, (bf16*)(F.ws + WS_WOUT), D, 0, scr, r, lane); return; } r -= TI_OUT;
    if (r < TI_G) { const int n0 = 32 * (r % (DFF / 32)); p0_transpose_item(F.in[I_WFG], D, DFF, (bf16*)(F.ws + WS_WGU), D, 256 * (n0 >> 7) + (n0 & 127) - n0, scr, r, lane); return; } r -= TI_G;
    if (r < TI_G) { const int n0 = 32 * (r % (DFF / 32)); p0_transpose_item(F.in[I_WFU], D, DFF, (bf16*)(F.ws + WS_WGU), D, 256 * (n0 >> 7) + 128 + (n0 & 127) - n0, scr, r, lane); return; } r -= TI_G;
    p0_transpose_item(F.in[I_WFD], DFF, D, (bf16*)(F.ws + WS_WDN), DFF, 0, scr, r, lane);
}
__device__ __forceinline__ void tr_range(Frame& F, int b, int e, int rank, int nw, LAS float* scr, int lane) {
    const int per = (e - b + nw - 1) / nw; int i0 = b + rank * per, i1 = i0 + per; if (i1 > e) i1 = e;
    for (int it = i0; it < i1; ++it) tr_item(F, it, scr, lane);
}
__device__ __forceinline__ void tr_idle(Frame& F, int b, int e, int rank_blk, int nblk) {
    if (F.G != 256 || rank_blk < 0) return;
    tr_range(F, b, e, rank_blk * NWAVES + F.wave, nblk * NWAVES, (LAS float*)(F.lds + RING_OFF + F.wave * 16384), pg8::mk_lane());
}
__device__ __forceinline__ void p0_gemv_unit(Frame& F, int unit, int lane) {
    const int kc = unit / (MODN / 256), cc = unit % (MODN / 256);
    const int k0 = kc * 256, col = cc * 256 + lane * 4;
    int sv[4], sc[4];
#pragma unroll
    for (int q = 0; q < 4; ++q) { const float c = *(const GAS float*)(F.in[I_C] + k0 + q * 64 + lane), cx = *(const GAS float*)(F.in[I_CCTX] + k0 + q * 64 + lane);
        sv[q] = __builtin_bit_cast(int, c * sigm(c)); sc[q] = __builtin_bit_cast(int, cx * sigm(cx)); }
    f32x4 a0 = (f32x4){0.f, 0.f, 0.f, 0.f}, a1 = a0;
    const GAS f32x4* wp = (const GAS f32x4*)(F.in[I_WADA] + (size_t)k0 * MODN + col);
#pragma unroll
    for (int q = 0; q < 4; ++q) {
#pragma unroll 16
        for (int i = 0; i < 64; ++i) { const f32x4 w = wp[(size_t)(q * 64 + i) * (MODN / 4)];
            const float s = __builtin_bit_cast(float, __builtin_amdgcn_readlane(sv[q], i)), t = __builtin_bit_cast(float, __builtin_amdgcn_readlane(sc[q], i));
            a0 += w * s; a1 += w * t; }
    }
    float* mp = (float*)(F.ws + WS_MODP);
    *(GAS f32x4*)(mp + (size_t)(kc * 2 + 0) * MODN + col) = a0;
    *(GAS f32x4*)(mp + (size_t)(kc * 2 + 1) * MODN + col) = a1;
}

__device__ __forceinline__ void p0_prologue(Frame& F) {
    LAS float* scr = (LAS float*)(F.lds + RING_OFF + F.wave * 16384);
    const int lane = pg8::mk_lane();
    const int gw = F.vcu * NWAVES + F.wave, NGW = F.G * NWAVES;
    const int gt = gw * 64 + lane, NGT = NGW * 64;
    {
        unsigned* wl = (unsigned*)(F.ws + WS_WLORA);
        for (int i = gt; i < NLORA * KLORA / 2; i += NGT) { const int n = i >> 7, k = (i & 127) * 2, pn = n >> 8, d = pn >> 4, isic = (n >> 7) & 1, ch = (pn & 15) * 128 + (n & 127); float v0 = 0.f, v1 = 0.f;
            if (k < 96) { if (!isic) { v0 = *(const GAS float*)(F.in[I_WDU] + (size_t)(d * 96 + k) * 2048 + ch); v1 = *(const GAS float*)(F.in[I_WDU] + (size_t)(d * 96 + k + 1) * 2048 + ch); } }
            else if (k < 192) { if (isic) { v0 = *(const GAS float*)(F.in[I_WIU] + (size_t)(d * 96 + k - 96) * 2048 + ch); v1 = *(const GAS float*)(F.in[I_WIU] + (size_t)(d * 96 + k - 95) * 2048 + ch); } }
            *(GAS unsigned*)(wl + i) = pk2(v0, v1); }
        unsigned* wg = (unsigned*)(F.ws + WS_WGATE);
        for (int i = gt; i < 2048 * KGATE / 2; i += NGT) { const int n = i >> 7, k = (i & 127) * 2;
            *(GAS unsigned*)(wg + i) = pk2(*(const GAS float*)(F.in[I_WGU] + (size_t)k * 2048 + n), *(const GAS float*)(F.in[I_WGU] + (size_t)(k + 1) * 2048 + n)); }
        v4u* zp = (v4u*)(F.ws + WS_WIN + (size_t)IN_COLS * D * 2);
        for (int i = gt; i < (NZ - IN_COLS) * D * 2 / 16; i += NGT) *(GAS v4u*)(zp + i) = (v4u){0u, 0u, 0u, 0u};
    }
    for (int u = gw; u < GEMV_UNITS; u += NGW) p0_gemv_unit(F, u, lane);
    if (F.G == 256) {
        int it0, it1;
        if (gw < GEMV_UNITS) { it0 = gw * TI_PER_GEMV_WAVE; it1 = it0 + TI_PER_GEMV_WAVE; }
        else { it0 = GEMV_UNITS * TI_PER_GEMV_WAVE + (gw - GEMV_UNITS) * TI_PER_OTHER_WAVE; it1 = it0 + TI_PER_OTHER_WAVE; }
        if (it1 > P0_ITEMS) it1 = P0_ITEMS;
        for (int it = it0; it < it1; ++it) tr_item(F, it < TI_IN ? it : P0X_B + (it - TI_IN), scr, lane);
    } else tr_range(F, 0, TI_TOTAL, gw, NGW, scr, lane);
}

__device__ __forceinline__ void norm_row(const float* xrow, bf16* orow, const LAS float* gs, const LAS float* sh, int lane) {
    const GAS f32x4* xr = (const GAS f32x4*)xrow + lane;
    f32x4 v[16]; float s = 0.f;
#pragma unroll
    for (int j = 0; j < 16; ++j) { v[j] = xr[64 * j]; s += (v[j].x * v[j].x + v[j].y * v[j].y) + (v[j].z * v[j].z + v[j].w * v[j].w); }
    const float rstd = 1.0f / sqrtf(wave_sum(s) * (1.f / D) + NORM_EPS);
    GAS v2u* o8 = (GAS v2u*)orow + lane;
#pragma unroll
    for (int j = 0; j < 16; ++j) { const f32x4 g = *(const LAS f32x4*)(gs + 4 * lane + 256 * j), b = *(const LAS f32x4*)(sh + 4 * lane + 256 * j);
        const f32x4 y = v[j] * rstd * g + b; v2u o; o.x = pk2(y.x, y.y); o.y = pk2(y.z, y.w); o8[64 * j] = o; }
}
__device__ __forceinline__ void p1_norm1(Frame& F) {
    const int lane = pg8::mk_lane(), tid = F.wave * 64 + lane;
    LAS float* tab = (LAS float*)(F.lds + RING_OFF);
    const float* mp = (const float*)(F.ws + WS_MODP);
    for (int i = tid; i < 4 * D; i += NWAVES * 64) {
        const int which = i >> 12, k = i & (D - 1), isc = which >> 1, part = which & 1;
        const int col = part == 0 ? D + k : k;
        float s = *(const GAS float*)(F.in[I_BADA] + col);
#pragma unroll
        for (int p = 0; p < NKC; ++p) s += *(const GAS float*)(mp + (size_t)(p * 2 + isc) * MODN + col);
        tab[i] = part == 0 ? *(const GAS float*)(F.in[I_NORM1] + k) * (1.0f + s) : s;
    }
    {
        float* mv = (float*)(F.ws + WS_MODV);
        for (int i = F.vcu * (NWAVES * 64) + tid; i < 2 * MODN; i += F.G * NWAVES * 64) { const int isc = i / MODN, col = i % MODN;
            float s = *(const GAS float*)(F.in[I_BADA] + col);
#pragma unroll
            for (int p = 0; p < NKC; ++p) s += *(const GAS float*)(mp + (size_t)(p * 2 + isc) * MODN + col);
            *(GAS float*)(mv + i) = s; }
    }
    __syncthreads();
    const int gw = F.vcu * NWAVES + F.wave, NGW = F.G * NWAVES;
    bf16* A1 = (bf16*)(F.ws + WS_A1);
    for (int m = gw; m < TT; m += NGW) {
        if (m < T) norm_row(F.in[I_X] + (size_t)m * D, A1 + (size_t)m * D, tab, tab + D, lane);
        else norm_row(F.in[I_CTX] + (size_t)(m - T) * D, A1 + (size_t)m * D, tab + 2 * D, tab + 3 * D, lane);
    }
    __syncthreads();
}
__device__ __forceinline__ void p10_norm2(Frame& F) {
    const int lane = pg8::mk_lane(), tid = F.wave * 64 + lane;
    LAS float* tab = (LAS float*)(F.lds + RING_OFF);
    const float* mv = (const float*)(F.ws + WS_MODV);
    for (int i = tid; i < 2 * D; i += NWAVES * 64) { const int part = i >> 12, k = i & (D - 1);
        tab[i] = part == 0 ? *(const GAS float*)(F.in[I_NORM2] + k) * (1.0f + *(const GAS float*)(mv + 4 * D + k)) : *(const GAS float*)(mv + 3 * D + k); }
    __syncthreads();
    const int gw = F.vcu * NWAVES + F.wave, NGW = F.G * NWAVES;
    bf16* A1 = (bf16*)(F.ws + WS_A1); const float* X1 = (const float*)(F.ws + WS_X1);
    for (int m = gw; m < T; m += NGW) norm_row(X1 + (size_t)m * D, A1 + (size_t)m * D, tab, tab + D, lane);
    __syncthreads();
}
__device__ __forceinline__ void p13_final(Frame& F) {
    const int lane = pg8::mk_lane();
    const int gw = F.vcu * NWAVES + F.wave, NGW = F.G * NWAVES;
    for (int m = gw; m < T; m += NGW) {
        GAS f32x4* xr = (GAS f32x4*)(F.out + (size_t)m * D) + lane;
        f32x4 v[16]; float s = 0.f;
#pragma unroll
        for (int j = 0; j < 16; ++j) { v[j] = xr[64 * j]; s += (v[j].x * v[j].x + v[j].y * v[j].y) + (v[j].z * v[j].z + v[j].w * v[j].w); }
        const float rstd = 1.0f / sqrtf(wave_sum(s) * (1.f / D) + NORM_EPS);
#pragma unroll
        for (int j = 0; j < 16; ++j) { const f32x4 g = *((const GAS f32x4*)F.in[I_NORMF] + lane + 64 * j); xr[64 * j] = v[j] * rstd * g; }
    }
}

__device__ __forceinline__ void ld8(const bf16* p, float (&f)[8]) { const v4u r = *(const GAS v4u*)p;
    f[0] = bflo(r.x); f[1] = bfhi(r.x); f[2] = bflo(r.y); f[3] = bfhi(r.y); f[4] = bflo(r.z); f[5] = bfhi(r.z); f[6] = bflo(r.w); f[7] = bfhi(r.w); }
__device__ __forceinline__ void ldf8(const float* p, float (&f)[8]) { const f32x4 a = *(const GAS f32x4*)p, b = *(const GAS f32x4*)(p + 4);
    f[0] = a.x; f[1] = a.y; f[2] = a.z; f[3] = a.w; f[4] = b.x; f[5] = b.y; f[6] = b.z; f[7] = b.w; }
__device__ __forceinline__ void stf8(float* p, const float (&f)[8]) { *(GAS f32x4*)p = (f32x4){f[0], f[1], f[2], f[3]}; *(GAS f32x4*)(p + 4) = (f32x4){f[4], f[5], f[6], f[7]}; }
__device__ __forceinline__ void stb8(bf16* p, const float (&f)[8]) { v4u o; o.x = pk2(f[0], f[1]); o.y = pk2(f[2], f[3]); o.z = pk2(f[4], f[5]); o.w = pk2(f[6], f[7]); *(GAS v4u*)p = o; }
__device__ __forceinline__ void za8(const bf16* Z, int row, bool hp, bool hn, int c, const float* mu, float (&o)[8]) {
    float zc[8], zp[8], zn[8], m8[8];
    ld8(Z + (size_t)row * NZ + c, zc);
    if (hp) ld8(Z + (size_t)(row - 1) * NZ + c, zp); else { _Pragma("unroll") for (int i = 0; i < 8; ++i) zp[i] = 0.f; }
    if (hn) ld8(Z + (size_t)(row + 1) * NZ + c, zn); else { _Pragma("unroll") for (int i = 0; i < 8; ++i) zn[i] = 0.f; }
    ldf8(mu + c, m8);
#pragma unroll
    for (int i = 0; i < 8; ++i) o[i] = zc[i] + m8[i] * (0.5f * (zp[i] + zn[i]) - zc[i]);
}
__device__ __forceinline__ void zero8(float (&f)[8]) {
#pragma unroll
    for (int i = 0; i < 8; ++i) f[i] = 0.f; }
__device__ __forceinline__ void cp8(float (&d)[8], const float (&s)[8]) {
#pragma unroll
    for (int i = 0; i < 8; ++i) d[i] = s[i]; }
__device__ __forceinline__ void p3_prep(Frame& F) {
    const bf16* Z = (const bf16*)(F.ws + WS_Z);
    bf16* KB = (bf16*)(F.ws + WS_KBUF); bf16* KKB = (bf16*)(F.ws + WS_KKBUF); bf16* RB = (bf16*)(F.ws + WS_RBUF); bf16* VB = (bf16*)(F.ws + WS_VBUF);
    bf16* AL = (bf16*)(F.ws + WS_ALORA); bf16* AG = (bf16*)(F.ws + WS_AGATE); bf16* CAT = (bf16*)(F.ws + WS_CAT);
    const float* mu = F.in[I_MU];
    const int tpb = (TT + F.G - 1) / F.G;
    const int tok0 = F.vcu * tpb, half0 = (tpb + 1) / 2;
    const int lane = pg8::mk_lane();
    for (int it = F.wave; it < 36; it += NWAVES) {
        const int type = it >> 1, hf = it & 1;
        int tA = tok0 + (hf ? half0 : 0), tB = tok0 + (hf ? tpb : half0);
        if (tB > TT) tB = TT;
        if (tA >= tB) continue;
        if (type < 14) {
            int zoff, c = 0; bool act = true;
            if (type < 12) { const int kind = type >> 2; c = (type & 3) * 512 + lane * 8; zoff = (kind == 0 ? OFF_K : (kind == 1 ? OFF_V : OFF_R)) + c; }
            else if (type == 12) { act = lane < 24; zoff = OFF_WL + (act ? lane : 0) * 8; }
            else { act = lane < 32; zoff = OFF_GL + (act ? lane : 0) * 8; }
            float m8[8], kk8[8]; ldf8(mu + zoff, m8);
            if (type < 4) ldf8(F.in[I_KK] + c, kk8); else zero8(kk8);
            float zp[8], zc[8], zn[8], znn[8];
            if (tA > 0) ld8(Z + (size_t)(tA - 1) * NZ + zoff, zp); else zero8(zp);
            ld8(Z + (size_t)tA * NZ + zoff, zc);
            if (tA + 1 < TT) ld8(Z + (size_t)(tA + 1) * NZ + zoff, zn); else zero8(zn);
            for (int t = tA; t < tB; ++t) {
                if (t + 2 < TT) ld8(Z + (size_t)(t + 2) * NZ + zoff, znn); else zero8(znn);
                const bool isctx = t >= T; const int pos = isctx ? t - T : (t & 63);
                const bool hp = pos > 0, hn = isctx ? (pos < CTXL - 1) : (pos < 63);
                float v[8];
#pragma unroll
                for (int i = 0; i < 8; ++i) v[i] = zc[i] + m8[i] * (0.5f * ((hp ? zp[i] : 0.f) + (hn ? zn[i] : 0.f)) - zc[i]);
                const size_t fo = (size_t)t * 2048 + c;
                if (type < 4) {
                    stb8(KB + fo, v);
                    float q[8]; float ss = 0.f;
#pragma unroll
                    for (int i = 0; i < 8; ++i) { q[i] = v[i] * kk8[i]; ss += q[i] * q[i]; }
                    ss += __shfl_xor(ss, 1); ss += __shfl_xor(ss, 2); ss += __shfl_xor(ss, 4);
                    const float inv = 1.0f / fmaxf(sqrtf(ss), 1e-12f);
#pragma unroll
                    for (int i = 0; i < 8; ++i) q[i] *= inv;
                    stb8(KKB + fo, q);
                } else if (type < 8) stb8(VB + fo, v);
                else if (type < 12) { if (!isctx) stb8(RB + fo, v); }
                else if (type == 12) {
                    if (lane < 32) { float o[8];
                        if (lane < 12) { _Pragma("unroll") for (int i = 0; i < 8; ++i) o[i] = tanhf(v[i]); }
                        else if (lane < 24) cp8(o, v);
                        else zero8(o);
                        stb8(AL + (size_t)t * KLORA + lane * 8, o); }
                } else { if (!isctx && lane < 32) { float o[8];
#pragma unroll
                        for (int i = 0; i < 8; ++i) o[i] = sigm(v[i]);
                        stb8(AG + (size_t)t * KGATE + lane * 8, o); } }
                cp8(zp, zc); cp8(zc, zn); cp8(zn, znn);
            }
        } else {
            if (tA >= T) continue;
            if (tB > T) tB = T;
            const int c = (type - 14) * 512 + lane * 8;
            float w0[8], w1[8], w2[8];
            ldf8(F.in[I_CONVW] + c, w0); ldf8(F.in[I_CONVW] + 2048 + c, w1); ldf8(F.in[I_CONVW] + 4096 + c, w2);
            float up[8], uc[8], un[8], ca[8], xa[8], cb[8], xb[8], bg[8], bgn[8];
            if (tA > 0) { ld8(Z + (size_t)(tA - 1) * NZ + OFF_CC + c, ca); ld8(Z + (size_t)(tA - 1) * NZ + OFF_CX + c, xa); _Pragma("unroll") for (int i = 0; i < 8; ++i) up[i] = ca[i] * xa[i]; } else zero8(up);
            ld8(Z + (size_t)tA * NZ + OFF_CC + c, ca); ld8(Z + (size_t)tA * NZ + OFF_CX + c, xa);
#pragma unroll
            for (int i = 0; i < 8; ++i) uc[i] = ca[i] * xa[i];
            ld8(Z + (size_t)tA * NZ + OFF_CB + c, bg);
            if (tA + 1 < T) { ld8(Z + (size_t)(tA + 1) * NZ + OFF_CC + c, ca); ld8(Z + (size_t)(tA + 1) * NZ + OFF_CX + c, xa); } else { zero8(ca); zero8(xa); }
            for (int t = tA; t < tB; ++t) {
                if (t + 2 < T) { ld8(Z + (size_t)(t + 2) * NZ + OFF_CC + c, cb); ld8(Z + (size_t)(t + 2) * NZ + OFF_CX + c, xb); } else { zero8(cb); zero8(xb); }
                if (t + 1 < T) ld8(Z + (size_t)(t + 1) * NZ + OFF_CB + c, bgn); else zero8(bgn);
                const int pos = t & 63; const bool hp = pos > 0, hn = pos < 63;
                float y[8];
#pragma unroll
                for (int i = 0; i < 8; ++i) { un[i] = ca[i] * xa[i]; y[i] = bg[i] * (w0[i] * (hp ? up[i] : 0.f) + w1[i] * uc[i] + w2[i] * (hn ? un[i] : 0.f)); }
                stb8(CAT + (size_t)t * D + DR + c, y);
                cp8(up, uc); cp8(uc, un); cp8(ca, cb); cp8(xa, xb); cp8(bg, bgn);
            }
        }
    }
}

typedef float f32x16 __attribute__((ext_vector_type(16)));
#define MK_FENCE() asm volatile("" ::: "memory")
constexpr int REC_BYTES = 8448, NBLK = TT / 16, SCAN_LDS = REC_BYTES + 4096;
__device__ __forceinline__ void swap32(float& x, float& y) { asm volatile("s_nop 1\n\tv_permlane32_swap_b32 %0, %1\n\ts_nop 1" : "+v"(x), "+v"(y)); }
__device__ __forceinline__ int kperm(int k) { return ((((k >> 5) * 2 + ((k >> 4) & 1)) * 2 + ((k >> 2) & 1)) * 8 + ((k >> 3) & 1) * 4 + (k & 3)); }
__device__ __forceinline__ int scan_blkbase(int d, int c, int j) {
    if (c == 0) return T + (d == 0 ? 16 * j : CTXL - 16 - 16 * j);
    const int p0 = (c - 1) * CHUNK + 16 * j;
    return d == 0 ? p0 : T - 16 - p0;
}
__device__ __forceinline__ void scan_vec32(const LAS unsigned char* row, int hl, float (&f)[32]) {
#pragma unroll
    for (int q = 0; q < 4; ++q) { const v4u w = *(const LAS v4u*)(row + (q * 2 + hl) * 16);
        f[8 * q + 0] = bflo(w.x); f[8 * q + 1] = bfhi(w.x); f[8 * q + 2] = bflo(w.y); f[8 * q + 3] = bfhi(w.y); f[8 * q + 4] = bflo(w.z); f[8 * q + 5] = bfhi(w.z); f[8 * q + 6] = bflo(w.w); f[8 * q + 7] = bfhi(w.w); }
}
__device__ __forceinline__ void scan_matvec(const f32x16 (&Tt)[2][2], const float (&f)[32], float& sa) {
    float p0a = 0.f, p0b = 0.f, p1a = 0.f, p1b = 0.f;
#pragma unroll
    for (int I = 0; I < 2; ++I)
#pragma unroll
        for (int r = 0; r < 16; r += 2) { p0a += Tt[I][0][r] * f[16 * I + r]; p1a += Tt[I][1][r] * f[16 * I + r]; p0b += Tt[I][0][r + 1] * f[16 * I + r + 1]; p1b += Tt[I][1][r + 1] * f[16 * I + r + 1]; }
    float p0 = p0a + p0b, p1 = p1a + p1b;
    swap32(p0, p1);
    sa = p0 + p1;
}
__device__ __forceinline__ void scan_renorm(f32x16 (&Tt)[2][2], const LAS float* ge, int hl) {
#pragma unroll
    for (int I = 0; I < 2; ++I)
#pragma unroll
        for (int qd = 0; qd < 4; ++qd) { const f32x4 g = *(const LAS f32x4*)(ge + 32 * I + 8 * qd + 4 * hl);
#pragma unroll
            for (int e = 0; e < 4; ++e) { Tt[I][0][4 * qd + e] *= g[e]; Tt[I][1][4 * qd + e] *= g[e]; } }
}
__device__ __forceinline__ void scan_store_T(const f32x16 (&Tt)[2][2], float* dst, int lane) {
#pragma unroll
    for (int I = 0; I < 2; ++I)
#pragma unroll
        for (int J = 0; J < 2; ++J)
#pragma unroll
            for (int reg = 0; reg < 16; ++reg) *(GAS float*)(dst + (32 * I + 8 * (reg >> 2) + 4 * (lane >> 5) + (reg & 3)) * 64 + 32 * J + (lane & 31)) = Tt[I][J][reg];
}
typedef short bf16x8 __attribute__((ext_vector_type(8)));
#define MK_MFMA(a, b, c) __builtin_amdgcn_mfma_f32_32x32x16_bf16((a), (b), (c), 0, 0, 0)
constexpr int SCR_LAB = 0, SCR_LAK = 1024, SCR_MRB = 2048, SCR_MRK = 2560, SCAN_SCR = 3072;
struct RecRegs { v4u p[8]; float ge; };
__device__ __forceinline__ void scan_rload(const unsigned char* PKB, int d, int h, int tb, int lane, RecRegs& R) {
    const GAS unsigned char* rp = (const GAS unsigned char*)PKB + ((size_t)(d * 32 + h) * NBLK + (tb >> 4)) * REC_BYTES;
#pragma unroll
    for (int j = 0; j < 8; ++j) R.p[j] = *((const GAS v4u*)rp + 64 * j + lane);
    R.ge = *((const GAS float*)(rp + 8192) + lane);
}
__device__ __forceinline__ void scan_rstore(LAS unsigned char* buf, int lane, const RecRegs& R) {
#pragma unroll
    for (int j = 0; j < 8; ++j) *((LAS v4u*)buf + 64 * j + lane) = R.p[j];
    *((LAS float*)(buf + 8192) + lane) = R.ge;
}
typedef float f32x2n __attribute__((ext_vector_type(2)));
typedef __bf16 bf16x2n __attribute__((ext_vector_type(2)));
__device__ __forceinline__ unsigned cvt2bf(float a, float b) { const f32x2n v = {a, b}; return __builtin_bit_cast(unsigned, __builtin_convertvector(v, bf16x2n)); }
__device__ __forceinline__ bf16x8 pack8(float a0, float a1, float a2, float a3, float a4, float a5, float a6, float a7) {
    const v4u u = {cvt2bf(a0, a1), cvt2bf(a2, a3), cvt2bf(a4, a5), cvt2bf(a6, a7)}; return __builtin_bit_cast(bf16x8, u); }
__device__ __forceinline__ f32x16 zero16() { f32x16 z;
#pragma unroll
    for (int i = 0; i < 16; ++i) z[i] = 0.f;
    return z; }
__device__ __forceinline__ void scan_tfrags(const f32x16 (&Tt)[2][2], bf16x8 (&Tf)[2][2][2]) {
#pragma unroll
    for (int I = 0; I < 2; ++I)
#pragma unroll
        for (int J = 0; J < 2; ++J)
#pragma unroll
            for (int s = 0; s < 2; ++s) Tf[I][J][s] = pack8(Tt[I][J][8 * s], Tt[I][J][8 * s + 1], Tt[I][J][8 * s + 2], Tt[I][J][8 * s + 3], Tt[I][J][8 * s + 4], Tt[I][J][8 * s + 5], Tt[I][J][8 * s + 6], Tt[I][J][8 * s + 7]);
}
__device__ __forceinline__ void scan_sfrags(float (&S)[16], bf16x8 (&Sf)[2]) {
#pragma unroll
    for (int j = 0; j < 8; ++j) swap32(S[j], S[j + 8]);
    Sf[0] = pack8(S[0], S[1], S[2], S[3], S[4], S[5], S[6], S[7]); Sf[1] = pack8(S[8], S[9], S[10], S[11], S[12], S[13], S[14], S[15]);
}
__device__ __forceinline__ void p5_scanA(Frame& F) {
    const unsigned char* PKB = F.ws + WS_PK; const bf16* VB = (const bf16*)(F.ws + WS_VBUF);
    float* PU = (float*)(F.ws + WS_PU);
    LAS unsigned char* my = F.lds + RING_OFF + F.wave * (REC_BYTES + SCAN_SCR);
    LAS unsigned char* scr = my + REC_BYTES;
    for (int unit = F.vcu * NWAVES + F.wave; unit < 2048; unit += F.G * NWAVES) {
        const int d = unit & 1, h = (unit >> 1) & 31, c = unit >> 6;
#pragma unroll 1
        for (int which = 0; which < 2; ++which) {
            const int lane = pg8::mk_lane(), hl = lane >> 5, l31 = lane & 31, l15 = lane & 15;
            const float idv = which ? 1.0f : 0.0f;
            f32x16 Tt[2][2];
#pragma unroll
            for (int I = 0; I < 2; ++I)
#pragma unroll
                for (int J = 0; J < 2; ++J)
#pragma unroll
                    for (int reg = 0; reg < 16; ++reg) Tt[I][J][reg] = (32 * I + 8 * (reg >> 2) + 4 * hl + (reg & 3) == 32 * J + l31) ? idv : 0.0f;
            RecRegs R;
            scan_rload(PKB, d, h, scan_blkbase(d, c, 0), lane, R);
#pragma unroll 1
            for (int j = 0; j < 16; ++j) {
                const int tb = scan_blkbase(d, c, j);
                scan_rstore(my, lane, R);
                float Vv[16];
                if (which == 0) { const GAS bf16* gv = (const GAS bf16*)(VB + (size_t)(tb + (d == 0 ? 0 : 15)) * 2048 + h * 64) + lane; const int dstep = d == 0 ? 2048 : -2048;
#pragma unroll
                    for (int t = 0; t < 16; ++t) Vv[t] = __builtin_bit_cast(float, (unsigned)gv[t * dstep] << 16); }
                else {
#pragma unroll
                    for (int t = 0; t < 16; ++t) Vv[t] = 0.f; }
                const LAS unsigned char* arow = my + l15 * 128 + hl * 16;
                {   f32x16 Lab = zero16(), Lak = zero16();
#pragma unroll
                    for (int qq = 0; qq < 4; ++qq) { const bf16x8 af = *(const LAS bf16x8*)(arow + qq * 32), bf = *(const LAS bf16x8*)(arow + 4096 + qq * 32), kf = *(const LAS bf16x8*)(arow + 6144 + qq * 32);
                        Lab = MK_MFMA(af, bf, Lab); Lak = MK_MFMA(af, kf, Lak); }
                    if (l31 < 16) { LAS float* lb = (LAS float*)scr + 64 * hl + l31;
#pragma unroll
                        for (int r = 0; r < 8; ++r) { const int t0 = 8 * (r >> 2) + (r & 3); lb[SCR_LAB / 4 + t0 * 16] = Lab[r]; lb[SCR_LAK / 4 + t0 * 16] = Lak[r]; } }
                }
                MK_FENCE();
                f32x16 G[2];
                {   bf16x8 Tf[2][2][2]; scan_tfrags(Tt, Tf);
                    G[0] = zero16(); G[1] = zero16();
#pragma unroll
                    for (int qq = 0; qq < 4; ++qq) { const bf16x8 af = *(const LAS bf16x8*)(arow + qq * 32);
                        G[0] = MK_MFMA(af, Tf[qq >> 1][0][qq & 1], G[0]); G[1] = MK_MFMA(af, Tf[qq >> 1][1][qq & 1], G[1]); }
                }
                MK_FENCE();
                if (j + 1 < 16) scan_rload(PKB, d, h, scan_blkbase(d, c, j + 1), lane, R);
                float S[16];
#pragma unroll
                for (int r = 0; r < 8; ++r) { float x = G[0][r], y = G[1][r]; swap32(x, y); const int t = 8 * (r >> 2) + (r & 3); S[t] = x; S[t + 4] = y; }
#pragma unroll
                for (int t = 1; t < 16; ++t) {
                    float acc = S[t];
#pragma unroll
                    for (int s4 = 0; s4 < (t + 3) / 4; ++s4) { const f32x4 la = *(const LAS f32x4*)(scr + SCR_LAB + (t * 16 + 4 * s4) * 4), lk = *(const LAS f32x4*)(scr + SCR_LAK + (t * 16 + 4 * s4) * 4);
#pragma unroll
                        for (int e = 0; e < 4; ++e) if (4 * s4 + e < t) { acc += la[e] * S[4 * s4 + e]; acc += lk[e] * Vv[4 * s4 + e]; } }
                    S[t] = acc;
                }
                bf16x8 Sf[2], Vf[2]; scan_sfrags(S, Sf); scan_sfrags(Vv, Vf);
#pragma unroll
                for (int I = 0; I < 2; ++I) {
                    const LAS unsigned char* col = my + 4096 + (8 * hl) * 128 + kperm(32 * I + l31) * 2;
                    unsigned short bs[8], ks[8];
#pragma unroll
                    for (int e = 0; e < 8; ++e) { bs[e] = *(const LAS unsigned short*)(col + e * 128); ks[e] = *(const LAS unsigned short*)(col + 2048 + e * 128); }
                    const v4u bu = {(unsigned)bs[0] | ((unsigned)bs[1] << 16), (unsigned)bs[2] | ((unsigned)bs[3] << 16), (unsigned)bs[4] | ((unsigned)bs[5] << 16), (unsigned)bs[6] | ((unsigned)bs[7] << 16)};
                    const v4u ku = {(unsigned)ks[0] | ((unsigned)ks[1] << 16), (unsigned)ks[2] | ((unsigned)ks[3] << 16), (unsigned)ks[4] | ((unsigned)ks[5] << 16), (unsigned)ks[6] | ((unsigned)ks[7] << 16)};
                    const bf16x8 ba = __builtin_bit_cast(bf16x8, bu), ka = __builtin_bit_cast(bf16x8, ku);
                    Tt[I][0] = MK_MFMA(ba, Sf[0], Tt[I][0]); Tt[I][1] = MK_MFMA(ba, Sf[1], Tt[I][1]); Tt[I][0] = MK_MFMA(ka, Vf[0], Tt[I][0]); Tt[I][1] = MK_MFMA(ka, Vf[1], Tt[I][1]);
                }
                scan_renorm(Tt, (const LAS float*)(my + 8192), hl);
            }
            scan_store_T(Tt, PU + ((size_t)unit * 2 + (which ? 0 : 1)) * 4096, lane);
        }
    }
}
__device__ __forceinline__ void p6_scanB(Frame& F) {
    const GAS char* PU = (const GAS char*)(F.ws + WS_PU); GAS char* SST = (GAS char*)(F.ws + WS_SST);
    LAS float* PiB = (LAS float*)(F.lds + RING_OFF);
    LAS float* TbB = (LAS float*)(F.lds + RING_OFF + 2 * 16640);
    const int w = F.wave;
    for (int q = F.vcu; q < 64; q += F.G) {
        const unsigned lane = (unsigned)pg8::mk_lane(), tid = (unsigned)w * 64u + lane, hl = lane >> 5, l31 = lane & 31u;
        const unsigned I1 = ((unsigned)w >> 1) & 1u, J = (unsigned)w & 1u;
        {   const GAS char* u0 = PU + ((size_t)q * 2 + 1) * 16384; GAS char* so = SST + ((size_t)q * NCHUNK + 1) * 16384;
            const f32x4 t0 = *(const GAS f32x4*)(u0 + tid * 32u), t1 = *(const GAS f32x4*)(u0 + tid * 32u + 16u);
            *((LAS f32x4*)TbB + tid * 2) = t0; *((LAS f32x4*)TbB + tid * 2 + 1) = t1;
            *(GAS f32x4*)(so + tid * 32u) = t0; *(GAS f32x4*)(so + tid * 32u + 16u) = t1; }
        f32x4 pn0, pn1; f32x16 un;
        {   const GAS char* pg = PU + (((size_t)q + 64) * 2 + 0) * 16384; pn0 = *(const GAS f32x4*)(pg + tid * 32u); pn1 = *(const GAS f32x4*)(pg + tid * 32u + 16u);
            const unsigned pb = (tid >> 3) * 65u + (tid & 7u) * 8u;
#pragma unroll
            for (int e = 0; e < 4; ++e) { PiB[pb + e] = pn0[e]; PiB[pb + 4 + e] = pn1[e]; }
            const GAS char* ug = PU + (((size_t)q + 64) * 2 + 1) * 16384;
#pragma unroll
            for (int r = 0; r < 16; ++r) un[r] = (w < 4) ? *(const GAS float*)(ug + ((32u * I1 + 8u * (r >> 2) + 4u * hl + (r & 3)) * 64u + 32u * J + l31) * 4u) : 0.f; }
        __syncthreads();
        for (int c = 1; c < 32; ++c) {
            const LAS float* Pi = PiB + ((c - 1) & 1) * 4160; const LAS float* Tb = TbB + ((c - 1) & 1) * 4096;
            LAS float* PiN = PiB + (c & 1) * 4160; LAS float* TbN = TbB + (c & 1) * 4096;
            f32x16 acc = un;
            if (c + 1 < 32) {
                const GAS char* pg = PU + (((size_t)q + 64 * (c + 1)) * 2 + 0) * 16384; pn0 = *(const GAS f32x4*)(pg + tid * 32u); pn1 = *(const GAS f32x4*)(pg + tid * 32u + 16u);
                const GAS char* ug = PU + (((size_t)q + 64 * (c + 1)) * 2 + 1) * 16384;
                if (w < 4) {
#pragma unroll
                    for (int r = 0; r < 16; ++r) un[r] = *(const GAS float*)(ug + ((32u * I1 + 8u * (r >> 2) + 4u * hl + (r & 3)) * 64u + 32u * J + l31) * 4u); }
            }
            if (w < 4) {
#pragma unroll
                for (int s2 = 0; s2 < 32; ++s2) { const float av = Pi[(32u * I1 + l31) * 65u + 2u * s2 + hl], bv = Tb[(2u * s2 + hl) * 64u + 32u * J + l31];
                    acc = __builtin_amdgcn_mfma_f32_32x32x2f32(av, bv, acc, 0, 0, 0);
                    if ((s2 & 7) == 7) MK_FENCE(); }
                GAS char* so = SST + ((size_t)q * NCHUNK + c + 1) * 16384;
#pragma unroll
                for (int r = 0; r < 16; ++r) { const unsigned e = (32u * I1 + 8u * (r >> 2) + 4u * hl + (r & 3)) * 64u + 32u * J + l31; TbN[e] = acc[r]; *(GAS float*)(so + e * 4u) = acc[r]; }
            }
            if (c + 1 < 32) { const unsigned pb = (tid >> 3) * 65u + (tid & 7u) * 8u;
#pragma unroll
                for (int e = 0; e < 4; ++e) { PiN[pb + e] = pn0[e]; PiN[pb + 4 + e] = pn1[e]; } }
            __syncthreads();
        }
    }
}
__device__ __forceinline__ void p7_scanC(Frame& F) {
    const unsigned char* PKB = F.ws + WS_PK; const bf16* VB = (const bf16*)(F.ws + WS_VBUF);
    const float* SST = (const float*)(F.ws + WS_SST); float* YS = (float*)(F.ws + WS_YS);
    LAS unsigned char* my = F.lds + RING_OFF + F.wave * (REC_BYTES + SCAN_SCR);
    LAS unsigned char* scr = my + REC_BYTES;
    for (int unit = F.vcu * NWAVES + F.wave; unit < 2048; unit += F.G * NWAVES) {
        const int d = unit & 1, h = (unit >> 1) & 31, c = (unit >> 6) + 1, q = unit & 63;
        const int lane = pg8::mk_lane(), hl = lane >> 5, l31 = lane & 31, l15 = lane & 15;
        f32x16 Tt[2][2];
        {   const float* s0 = SST + ((size_t)q * NCHUNK + c) * 4096;
#pragma unroll
            for (int I = 0; I < 2; ++I)
#pragma unroll
                for (int J = 0; J < 2; ++J)
#pragma unroll
                    for (int reg = 0; reg < 16; ++reg) Tt[I][J][reg] = *(const GAS float*)(s0 + (32 * I + 8 * (reg >> 2) + 4 * hl + (reg & 3)) * 64 + 32 * J + l31); }
        RecRegs R;
        scan_rload(PKB, d, h, scan_blkbase(d, c, 0), lane, R);
#pragma unroll 1
        for (int j = 0; j < 16; ++j) {
            const int tb = scan_blkbase(d, c, j);
            scan_rstore(my, lane, R);
            float Vv[16];
            {   const GAS bf16* gv = (const GAS bf16*)(VB + (size_t)(tb + (d == 0 ? 0 : 15)) * 2048 + h * 64) + lane; const int dstep = d == 0 ? 2048 : -2048;
#pragma unroll
                for (int t = 0; t < 16; ++t) Vv[t] = __builtin_bit_cast(float, (unsigned)gv[t * dstep] << 16); }
            const LAS unsigned char* arow = my + l15 * 128 + hl * 16;
            {   f32x16 Lab = zero16(), Lak = zero16(), Mrb = zero16(), Mrk = zero16();
#pragma unroll
                for (int qq = 0; qq < 4; ++qq) { const bf16x8 af = *(const LAS bf16x8*)(arow + qq * 32), rf = *(const LAS bf16x8*)(arow + 2048 + qq * 32), bf = *(const LAS bf16x8*)(arow + 4096 + qq * 32), kf = *(const LAS bf16x8*)(arow + 6144 + qq * 32);
                    Lab = MK_MFMA(af, bf, Lab); Lak = MK_MFMA(af, kf, Lak); Mrb = MK_MFMA(rf, bf, Mrb); Mrk = MK_MFMA(rf, kf, Mrk); }
                if (l31 < 16) {
                    LAS float* lb = (LAS float*)scr + 64 * hl + l31; LAS unsigned short* mb = (LAS unsigned short*)scr + 64 * hl + l31; const int lm = l31 - 4 * hl;
#pragma unroll
                    for (int r = 0; r < 8; ++r) { const int t0 = 8 * (r >> 2) + (r & 3);
                        lb[SCR_LAB / 4 + t0 * 16] = Lab[r]; lb[SCR_LAK / 4 + t0 * 16] = Lak[r];
                        mb[SCR_MRB / 2 + t0 * 16] = (unsigned short)f2bf(lm <= t0 ? Mrb[r] : 0.f); mb[SCR_MRK / 2 + t0 * 16] = (unsigned short)f2bf(lm <= t0 ? Mrk[r] : 0.f); }
                }
            }
            MK_FENCE();
            f32x16 G[2], Y[2];
            {   bf16x8 Tf[2][2][2]; scan_tfrags(Tt, Tf);
                G[0] = zero16(); G[1] = zero16(); Y[0] = zero16(); Y[1] = zero16();
#pragma unroll
                for (int qq = 0; qq < 4; ++qq) { const bf16x8 af = *(const LAS bf16x8*)(arow + qq * 32), rf = *(const LAS bf16x8*)(arow + 2048 + qq * 32);
                    G[0] = MK_MFMA(af, Tf[qq >> 1][0][qq & 1], G[0]); G[1] = MK_MFMA(af, Tf[qq >> 1][1][qq & 1], G[1]);
                    Y[0] = MK_MFMA(rf, Tf[qq >> 1][0][qq & 1], Y[0]); Y[1] = MK_MFMA(rf, Tf[qq >> 1][1][qq & 1], Y[1]); }
            }
            MK_FENCE();
            if (j + 1 < 16) scan_rload(PKB, d, h, scan_blkbase(d, c, j + 1), lane, R);
            float S[16];
#pragma unroll
            for (int r = 0; r < 8; ++r) { float x = G[0][r], y = G[1][r]; swap32(x, y); const int t = 8 * (r >> 2) + (r & 3); S[t] = x; S[t + 4] = y; }
#pragma unroll
            for (int t = 1; t < 16; ++t) {
                float acc = S[t];
#pragma unroll
                for (int s4 = 0; s4 < (t + 3) / 4; ++s4) { const f32x4 la = *(const LAS f32x4*)(scr + SCR_LAB + (t * 16 + 4 * s4) * 4), lk = *(const LAS f32x4*)(scr + SCR_LAK + (t * 16 + 4 * s4) * 4);
#pragma unroll
                    for (int e = 0; e < 4; ++e) if (4 * s4 + e < t) { acc += la[e] * S[4 * s4 + e]; acc += lk[e] * Vv[4 * s4 + e]; } }
                S[t] = acc;
            }
            bf16x8 Sf[2], Vf[2]; scan_sfrags(S, Sf); scan_sfrags(Vv, Vf);
            {   const bf16x8 mb = *(const LAS bf16x8*)(scr + SCR_MRB + l15 * 32 + hl * 16), mk = *(const LAS bf16x8*)(scr + SCR_MRK + l15 * 32 + hl * 16);
                Y[0] = MK_MFMA(mb, Sf[0], Y[0]); Y[1] = MK_MFMA(mb, Sf[1], Y[1]); Y[0] = MK_MFMA(mk, Vf[0], Y[0]); Y[1] = MK_MFMA(mk, Vf[1], Y[1]); }
#pragma unroll
            for (int I = 0; I < 2; ++I) {
                const LAS unsigned char* col = my + 4096 + (8 * hl) * 128 + kperm(32 * I + l31) * 2;
                unsigned short bs[8], ks[8];
#pragma unroll
                for (int e = 0; e < 8; ++e) { bs[e] = *(const LAS unsigned short*)(col + e * 128); ks[e] = *(const LAS unsigned short*)(col + 2048 + e * 128); }
                const v4u bu = {(unsigned)bs[0] | ((unsigned)bs[1] << 16), (unsigned)bs[2] | ((unsigned)bs[3] << 16), (unsigned)bs[4] | ((unsigned)bs[5] << 16), (unsigned)bs[6] | ((unsigned)bs[7] << 16)};
                const v4u ku = {(unsigned)ks[0] | ((unsigned)ks[1] << 16), (unsigned)ks[2] | ((unsigned)ks[3] << 16), (unsigned)ks[4] | ((unsigned)ks[5] << 16), (unsigned)ks[6] | ((unsigned)ks[7] << 16)};
                const bf16x8 ba = __builtin_bit_cast(bf16x8, bu), ka = __builtin_bit_cast(bf16x8, ku);
                Tt[I][0] = MK_MFMA(ba, Sf[0], Tt[I][0]); Tt[I][1] = MK_MFMA(ba, Sf[1], Tt[I][1]); Tt[I][0] = MK_MFMA(ka, Vf[0], Tt[I][0]); Tt[I][1] = MK_MFMA(ka, Vf[1], Tt[I][1]);
            }
            {   GAS float* yb = (GAS float*)(YS + (size_t)d * T * 2048 + (size_t)(tb + (d == 0 ? 4 * hl : 15 - 4 * hl)) * 2048 + h * 64) + l31; const int ystep = d == 0 ? 2048 : -2048;
#pragma unroll
                for (int J = 0; J < 2; ++J)
#pragma unroll
                    for (int r = 0; r < 8; ++r) yb[(8 * (r >> 2) + (r & 3)) * ystep + 32 * J] = Y[J][r]; }
            scan_renorm(Tt, (const LAS float*)(my + 8192), hl);
        }
    }
}

__device__ __forceinline__ void p8_readout(Frame& F) {
    const bf16* RB = (const bf16*)(F.ws + WS_RBUF); const bf16* VB = (const bf16*)(F.ws + WS_VBUF); const float* YS = (const float*)(F.ws + WS_YS);
    const bf16* KD = (const bf16*)(F.ws + WS_KD);
    const bf16* G = (const bf16*)(F.ws + WS_G); bf16* CAT = (bf16*)(F.ws + WS_CAT);
    const int tpb = (T + F.G - 1) / F.G, tok0 = F.vcu * tpb, lane = pg8::mk_lane();
    for (int it = F.wave; it < tpb * 4; it += NWAVES) {
        const int j = it / tpb, tok = tok0 + it % tpb;
        if (tok >= T) continue;
        const int c = j * 512 + lane * 8;
        float y0[8], y1[8], y[8];
        ldf8(YS + (size_t)tok * 2048 + c, y0); ldf8(YS + ((size_t)T + tok) * 2048 + c, y1);
        float s = 0.f;
#pragma unroll
        for (int i = 0; i < 8; ++i) { y[i] = y0[i] + y1[i]; s += y[i]; }
        s += __shfl_xor(s, 1); s += __shfl_xor(s, 2); s += __shfl_xor(s, 4);
        const float mean = s * (1.0f / 64.0f); float q = 0.f;
#pragma unroll
        for (int i = 0; i < 8; ++i) { const float dlt = y[i] - mean; q += dlt * dlt; }
        q += __shfl_xor(q, 1); q += __shfl_xor(q, 2); q += __shfl_xor(q, 4);
        const float rstd = 1.0f / sqrtf(q * (1.0f / 64.0f) + LNX_EPS);
        float r8[8], v8[8], k0[8], k1[8], rk[8], lw[8], lb[8], g8[8];
        ld8(RB + (size_t)tok * 2048 + c, r8); ld8(VB + (size_t)tok * 2048 + c, v8);
        ld8(KD + (size_t)tok * 2048 + c, k0); ld8(KD + ((size_t)TT + tok) * 2048 + c, k1);
        ldf8(F.in[I_RK] + c, rk); ldf8(F.in[I_LNXW] + c, lw); ldf8(F.in[I_LNXB] + c, lb);
        ld8(G + (size_t)tok * 2048 + c, g8);
        float dot = 0.f;
#pragma unroll
        for (int i = 0; i < 8; ++i) dot += r8[i] * (k0[i] + k1[i]) * rk[i];
        dot += __shfl_xor(dot, 1); dot += __shfl_xor(dot, 2); dot += __shfl_xor(dot, 4);
        float o[8];
#pragma unroll
        for (int i = 0; i < 8; ++i) o[i] = ((y[i] - mean) * rstd * lw[i] + lb[i] + dot * v8[i]) * g8[i];
        stb8(CAT + (size_t)tok * D + c, o);
    }
}

template <int K> __device__ __forceinline__ void run_phase(Frame& F) {
    bf16* A1 = (bf16*)(F.ws + WS_A1); bf16* Zb = (bf16*)(F.ws + WS_Z);
    const float* MV = (const float*)(F.ws + WS_MODV);
    (void)A1; (void)Zb; (void)MV;
    asm volatile("; MK_PHASE %0" :: "i"(K) : "memory");
    if constexpr (K == 0) { p0_prologue(F);
    }
    if constexpr (K == 1) { p1_norm1(F);
    }
    if constexpr (K == 2) {
        { pg8::Gemm g{A1, (const bf16*)(F.ws + WS_WIN), T, NZ, D}; pg8::StaticOrder S; S.init(T, NZ, F.G, (int)blockIdx.x);
          pg8::EpiBf16<0> E{Zb, NZ, nullptr, 0, 0, 1.f};
          pg8::gemm_phase<pg8::EpiBf16<0>, pg8::StaticOrder, true, true>(F.lds + RING_OFF, g, S, E, F.wave); }
        { pg8::Gemm g{A1 + (size_t)T * D, (const bf16*)(F.ws + WS_WIN), CTXL, NCTXZ, D}; pg8::StaticOrder S; S.init(CTXL, NCTXZ, F.G, (int)((blockIdx.x + F.G - 64) % F.G));
          pg8::EpiBf16<0> E{Zb + (size_t)T * NZ, NZ, nullptr, 0, 0, 1.f};
          pg8::gemm_phase<pg8::EpiBf16<0>, pg8::StaticOrder, true, true>(F.lds + RING_OFF, g, S, E, F.wave); }
        tr_idle(F, P2T_B, P2T_E, (int)blockIdx.x - 81, 175);
    }
    if constexpr (K == 3) { p3_prep(F);
    }
    if constexpr (K == 4) {
        { int kl = KLORA; asm volatile("" : "+s"(kl));
          pg8::Gemm g{(const bf16*)(F.ws + WS_ALORA), (const bf16*)(F.ws + WS_WLORA), TT, NLORA, kl}; pg8::StaticOrder S; S.init(TT, NLORA, F.G, (int)blockIdx.x);
          pg8::EpiLora E{F.ws + WS_PK, (bf16*)(F.ws + WS_KD), (const bf16*)(F.ws + WS_KBUF), (const bf16*)(F.ws + WS_KKBUF), (const bf16*)(F.ws + WS_RBUF), F.in[I_W0], F.in[I_A0], F.in[I_KA], TT};
          pg8::gemm_phase<pg8::EpiLora, pg8::StaticOrder, true, true>(F.lds + RING_OFF, g, S, E, F.wave); }
        { int kl = KGATE; asm volatile("" : "+s"(kl));
          pg8::Gemm g{(const bf16*)(F.ws + WS_AGATE), (const bf16*)(F.ws + WS_WGATE), T, DR, kl}; pg8::StaticOrder S; S.init(T, DR, F.G, (int)blockIdx.x);
          pg8::EpiBf16<0> E{(bf16*)(F.ws + WS_G), DR, nullptr, 0, 0, 1.f};
          pg8::gemm_phase<pg8::EpiBf16<0>, pg8::StaticOrder, true, true>(F.lds + RING_OFF, g, S, E, F.wave); }

    }
    if constexpr (K == 5) { p5_scanA(F);
    }
    if constexpr (K == 6) { p6_scanB(F); tr_idle(F, P6T_B, P6T_E, F.vcu - 64, 192);

    }
    if constexpr (K == 7) { p7_scanC(F);
    }
    if constexpr (K == 8) { p8_readout(F);
    }
    if constexpr (K == 9) {
        pg8::Gemm g{(const bf16*)(F.ws + WS_CAT), (const bf16*)(F.ws + WS_WOUT), T, D, D}; pg8::StaticOrder S; S.init(T, D, F.G, (int)blockIdx.x);
        pg8::EpiResid E{F.in[I_X], (float*)(F.ws + WS_X1), D, MV + 2 * D};
        pg8::gemm_phase<pg8::EpiResid, pg8::StaticOrder, true, true>(F.lds + RING_OFF, g, S, E, F.wave);

    }
    if constexpr (K == 10) { p10_norm2(F);
    }
    if constexpr (K == 11) {
        pg8::Gemm g{A1, (const bf16*)(F.ws + WS_WGU), T, NGU, D}; pg8::StaticOrder S; S.init(T, NGU, F.G, (int)blockIdx.x);
        pg8::EpiSwiglu E{(bf16*)(F.ws + WS_ACT), DFF};
        pg8::gemm_phase<pg8::EpiSwiglu, pg8::StaticOrder, true, true>(F.lds + RING_OFF, g, S, E, F.wave);
        tr_idle(F, P11T_B, P11T_E, (int)blockIdx.x - 192, 64);
    }
    if constexpr (K == 12) {
        pg8::Gemm g{(const bf16*)(F.ws + WS_ACT), (const bf16*)(F.ws + WS_WDN), T, D, DFF}; pg8::StaticOrder S; S.init(T, D, F.G, (int)blockIdx.x);
        pg8::EpiResid E{(const float*)(F.ws + WS_X1), F.out, D, MV + 5 * D};
        pg8::gemm_phase<pg8::EpiResid, pg8::StaticOrder, true, true>(F.lds + RING_OFF, g, S, E, F.wave);

    }
    if constexpr (K == 13) { p13_final(F);
    }
}

struct Args { const float* in[26]; float* out; unsigned char* ws; int ph_lo, ph_hi, li, pad; };
__global__ void __launch_bounds__(NWAVES * 64, 2) mk_fwd(Args args) {
    extern __shared__ __attribute__((aligned(16))) unsigned char lds[];
    Frame F;
    F.lds = (LAS unsigned char*)lds;
    F.MISC = (volatile LAS unsigned*)(F.lds + MISC_OFF);
    F.wave = __builtin_amdgcn_readfirstlane((int)(threadIdx.x >> 6));
    F.G = gridDim.x; { const int bx = blockIdx.x; F.vcu = (F.G % 8 == 0) ? (bx % 8) * (F.G / 8) + bx / 8 : bx; }
    F.ws = args.ws; F.ctl = (gu32*)(args.ws + WS_CTL); F.out = args.out;
#pragma unroll
    for (int i = 0; i < 26; ++i) F.in[i] = args.in[i];
    for (int u = threadIdx.x; u < (LDS_BYTES - LDSCTL_OFF) / 4; u += NWAVES * 64) ((LAS unsigned*)(F.lds + LDSCTL_OFF))[u] = 0u;
    __syncthreads();
    XcdBarrier bar; bar.bar = (unsigned*)(F.ctl + CW_BAR); bar.x = 0; bar.st = nullptr;
    if (N_LAUNCHES == 1) bar = xcd_barrier_post((unsigned*)(F.ctl + CW_BAR), F.MISC + 8);
#define GRID_BAR() do { if (N_LAUNCHES == 1) xcd_barrier(bar, F.wave); } while (0)
    unsigned long long tp0 = 0, tpa = 0, tpb = 0; (void)tp0;
    const int lo = args.ph_lo, hi = args.ph_hi;
#define IN(k) (lo <= (k) && (k) < hi)
#define BOTH(k) (IN(k) && IN((k) + 1))

    if (IN(0)) { if constexpr (0 == TPA || 0 == TPB) tp0 = __builtin_amdgcn_s_memrealtime(); run_phase<0>(F); if constexpr (PH_REPS[0] > 1) { GRID_BAR(); run_phase<0>(F); } if constexpr (PH_REPS[0] > 2) { GRID_BAR(); run_phase<0>(F); } if (BOTH(0)) GRID_BAR(); if constexpr (0 == TPA) tpa = __builtin_amdgcn_s_memrealtime() - tp0; if constexpr (0 == TPB) tpb = __builtin_amdgcn_s_memrealtime() - tp0; }
    if (IN(1)) { if constexpr (1 == TPA || 1 == TPB) tp0 = __builtin_amdgcn_s_memrealtime(); run_phase<1>(F); if constexpr (PH_REPS[1] > 1) { GRID_BAR(); run_phase<1>(F); } if constexpr (PH_REPS[1] > 2) { GRID_BAR(); run_phase<1>(F); } if (BOTH(1)) GRID_BAR(); if constexpr (1 == TPA) tpa = __builtin_amdgcn_s_memrealtime() - tp0; if constexpr (1 == TPB) tpb = __builtin_amdgcn_s_memrealtime() - tp0; }
    if (IN(2)) { if constexpr (2 == TPA || 2 == TPB) tp0 = __builtin_amdgcn_s_memrealtime(); run_phase<2>(F); if constexpr (PH_REPS[2] > 1) { GRID_BAR(); run_phase<2>(F); } if constexpr (PH_REPS[2] > 2) { GRID_BAR(); run_phase<2>(F); } if (BOTH(2)) GRID_BAR(); if constexpr (2 == TPA) tpa = __builtin_amdgcn_s_memrealtime() - tp0; if constexpr (2 == TPB) tpb = __builtin_amdgcn_s_memrealtime() - tp0; }
    if (IN(3)) { if constexpr (3 == TPA || 3 == TPB) tp0 = __builtin_amdgcn_s_memrealtime(); run_phase<3>(F); if constexpr (PH_REPS[3] > 1) { GRID_BAR(); run_phase<3>(F); } if constexpr (PH_REPS[3] > 2) { GRID_BAR(); run_phase<3>(F); } if (BOTH(3)) GRID_BAR(); if constexpr (3 == TPA) tpa = __builtin_amdgcn_s_memrealtime() - tp0; if constexpr (3 == TPB) tpb = __builtin_amdgcn_s_memrealtime() - tp0; }
    if (IN(4)) { if constexpr (4 == TPA || 4 == TPB) tp0 = __builtin_amdgcn_s_memrealtime(); run_phase<4>(F); if constexpr (PH_REPS[4] > 1) { GRID_BAR(); run_phase<4>(F); } if constexpr (PH_REPS[4] > 2) { GRID_BAR(); run_phase<4>(F); } if (BOTH(4)) GRID_BAR(); if constexpr (4 == TPA) tpa = __builtin_amdgcn_s_memrealtime() - tp0; if constexpr (4 == TPB) tpb = __builtin_amdgcn_s_memrealtime() - tp0; }
    if (IN(5)) { if constexpr (5 == TPA || 5 == TPB) tp0 = __builtin_amdgcn_s_memrealtime(); run_phase<5>(F); if constexpr (PH_REPS[5] > 1) { GRID_BAR(); run_phase<5>(F); } if constexpr (PH_REPS[5] > 2) { GRID_BAR(); run_phase<5>(F); } if (BOTH(5)) GRID_BAR(); if constexpr (5 == TPA) tpa = __builtin_amdgcn_s_memrealtime() - tp0; if constexpr (5 == TPB) tpb = __builtin_amdgcn_s_memrealtime() - tp0; }
    if (IN(6)) { if constexpr (6 == TPA || 6 == TPB) tp0 = __builtin_amdgcn_s_memrealtime(); run_phase<6>(F); if constexpr (PH_REPS[6] > 1) { GRID_BAR(); run_phase<6>(F); } if constexpr (PH_REPS[6] > 2) { GRID_BAR(); run_phase<6>(F); } if (BOTH(6)) GRID_BAR(); if constexpr (6 == TPA) tpa = __builtin_amdgcn_s_memrealtime() - tp0; if constexpr (6 == TPB) tpb = __builtin_amdgcn_s_memrealtime() - tp0; }
    if (IN(7)) { if constexpr (7 == TPA || 7 == TPB) tp0 = __builtin_amdgcn_s_memrealtime(); run_phase<7>(F); if constexpr (PH_REPS[7] > 1) { GRID_BAR(); run_phase<7>(F); } if constexpr (PH_REPS[7] > 2) { GRID_BAR(); run_phase<7>(F); } if (BOTH(7)) GRID_BAR(); if constexpr (7 == TPA) tpa = __builtin_amdgcn_s_memrealtime() - tp0; if constexpr (7 == TPB) tpb = __builtin_amdgcn_s_memrealtime() - tp0; }
    if (IN(8)) { if constexpr (8 == TPA || 8 == TPB) tp0 = __builtin_amdgcn_s_memrealtime(); run_phase<8>(F); if constexpr (PH_REPS[8] > 1) { GRID_BAR(); run_phase<8>(F); } if constexpr (PH_REPS[8] > 2) { GRID_BAR(); run_phase<8>(F); } if (BOTH(8)) GRID_BAR(); if constexpr (8 == TPA) tpa = __builtin_amdgcn_s_memrealtime() - tp0; if constexpr (8 == TPB) tpb = __builtin_amdgcn_s_memrealtime() - tp0; }
    if (IN(9)) { if constexpr (9 == TPA || 9 == TPB) tp0 = __builtin_amdgcn_s_memrealtime(); run_phase<9>(F); if constexpr (PH_REPS[9] > 1) { GRID_BAR(); run_phase<9>(F); } if constexpr (PH_REPS[9] > 2) { GRID_BAR(); run_phase<9>(F); } if (BOTH(9)) GRID_BAR(); if constexpr (9 == TPA) tpa = __builtin_amdgcn_s_memrealtime() - tp0; if constexpr (9 == TPB) tpb = __builtin_amdgcn_s_memrealtime() - tp0; }
    if (IN(10)) { if constexpr (10 == TPA || 10 == TPB) tp0 = __builtin_amdgcn_s_memrealtime(); run_phase<10>(F); if constexpr (PH_REPS[10] > 1) { GRID_BAR(); run_phase<10>(F); } if constexpr (PH_REPS[10] > 2) { GRID_BAR(); run_phase<10>(F); } if (BOTH(10)) GRID_BAR(); if constexpr (10 == TPA) tpa = __builtin_amdgcn_s_memrealtime() - tp0; if constexpr (10 == TPB) tpb = __builtin_amdgcn_s_memrealtime() - tp0; }
    if (IN(11)) { if constexpr (11 == TPA || 11 == TPB) tp0 = __builtin_amdgcn_s_memrealtime(); run_phase<11>(F); if constexpr (PH_REPS[11] > 1) { GRID_BAR(); run_phase<11>(F); } if constexpr (PH_REPS[11] > 2) { GRID_BAR(); run_phase<11>(F); } if (BOTH(11)) GRID_BAR(); if constexpr (11 == TPA) tpa = __builtin_amdgcn_s_memrealtime() - tp0; if constexpr (11 == TPB) tpb = __builtin_amdgcn_s_memrealtime() - tp0; }
    if (IN(12)) { if constexpr (12 == TPA || 12 == TPB) tp0 = __builtin_amdgcn_s_memrealtime(); run_phase<12>(F); if constexpr (PH_REPS[12] > 1) { GRID_BAR(); run_phase<12>(F); } if constexpr (PH_REPS[12] > 2) { GRID_BAR(); run_phase<12>(F); } if (BOTH(12)) GRID_BAR(); if constexpr (12 == TPA) tpa = __builtin_amdgcn_s_memrealtime() - tp0; if constexpr (12 == TPB) tpb = __builtin_amdgcn_s_memrealtime() - tp0; }
    if (IN(13)) { if constexpr (13 == TPA || 13 == TPB) tp0 = __builtin_amdgcn_s_memrealtime(); run_phase<13>(F); if constexpr (PH_REPS[13] > 1) { GRID_BAR(); run_phase<13>(F); } if constexpr (PH_REPS[13] > 2) { GRID_BAR(); run_phase<13>(F); } if (BOTH(13)) GRID_BAR(); if constexpr (13 == TPA) tpa = __builtin_amdgcn_s_memrealtime() - tp0; if constexpr (13 == TPB) tpb = __builtin_amdgcn_s_memrealtime() - tp0; }
    if constexpr (TPA >= 0 || TPB >= 0) {
        if (blockIdx.x == 0 && F.wave == 0) { const unsigned long long ua = (tpa + 500ull) / 1000ull, ub = (tpb + 500ull) / 1000ull, extra = ua * 100000ull + ub * 1000ull, t1 = __builtin_amdgcn_s_memrealtime();
            while (__builtin_amdgcn_s_memrealtime() - t1 < extra) __builtin_amdgcn_s_sleep(16); }
    }
#undef IN
#undef BOTH
}

extern "C" void kernel_launch(void* const* d_in, const int* in_sizes, int n_in, void* d_out, int out_size, void* d_ws, size_t ws_size, hipStream_t stream) {
    static int grid = 0;
    if (grid == 0) {
        if (n_in != 26 || out_size != T * D || ws_size < WS_END) { fprintf(stderr, "kernel_launch: unexpected shapes: n_in %d out %d ws %zu (need %zu)\n", n_in, out_size, ws_size, (size_t)WS_END); grid = -1; return; }
        int dev = 0, cus = 0, per_cu = 0;
        if (hipGetDevice(&dev) != hipSuccess || hipDeviceGetAttribute(&cus, hipDeviceAttributeMultiprocessorCount, dev) != hipSuccess) { grid = -1; return; }
        if (hipFuncSetAttribute((const void*)mk_fwd, hipFuncAttributeMaxDynamicSharedMemorySize, LDS_BYTES) != hipSuccess) { fprintf(stderr, "kernel_launch: hipFuncSetAttribute failed\n"); grid = -1; return; }
        if (hipOccupancyMaxActiveBlocksPerMultiprocessor(&per_cu, (const void*)mk_fwd, NWAVES * 64, LDS_BYTES) != hipSuccess || per_cu < 1)
            fprintf(stderr, "kernel_launch: note: occupancy query reports %d workgroups per CU\n", per_cu);
        (void)hipGetLastError();
        grid = cus;
    }
    if (grid < 0) return;
    if (hipMemsetAsync((char*)d_ws + WS_CTL, 0, CTL_ZERO_BYTES, stream) != hipSuccess) return;
    Args a{};
    for (int i = 0; i < 26; ++i) a.in[i] = (const float*)d_in[i];
    a.out = (float*)d_out; a.ws = (unsigned char*)d_ws;
    for (int li = 0; li < N_LAUNCHES; ++li) {
        if (N_LAUNCHES == 1) { a.ph_lo = 0; a.ph_hi = N_PHASES; } else { a.ph_lo = li * N_PHASES / N_LAUNCHES; a.ph_hi = (li + 1) * N_PHASES / N_LAUNCHES; }
        a.li = li;
        hipLaunchKernelGGL(mk_fwd, dim3(grid), dim3(NWAVES * 64), LDS_BYTES, stream, a);
        if (hipPeekAtLastError() != hipSuccess) break;
    }
}
```

```cpp
#include <hip/hip_runtime.h>
#include <cstdio>
#include <cstdint>
namespace pg8 {
#define PG8_LAS __attribute__((address_space(3)))
typedef unsigned short bf16_t;
typedef short bf16x8 __attribute__((ext_vector_type(8)));
typedef float f32x4 __attribute__((ext_vector_type(4)));
typedef unsigned u32x4 __attribute__((ext_vector_type(4)));
constexpr int BM = 256, BK = 64, HALF = 128, HTB = HALF * BK * 2  , STAGE_BYTES = 8 * HTB, NXCD = 8, WGM = 8;

__host__ __device__ __forceinline__ int lds_byte(int r, int c) { const int st = (r >> 4) * 2 + (c >> 5), rr = r & 15, cc = c & 31, ob = rr * 64 + cc * 2; return st * 1024 + (ob ^ (((ob >> 9) & 1) << 5)); }
__host__ __device__ __forceinline__ void stage_rc(int b, int& R, int& C) { const int st = b / 1024, sb = b % 1024, swz = sb ^ (((sb >> 9) & 1) << 5); R = (st >> 1) * 16 + swz / 64; C = (st & 1) * 32 + (swz % 64) / 2; }
__host__ __device__ __forceinline__ int perm32(int rho) { const int n = rho >> 4, i = rho & 15; return 8 * (i >> 2) + 4 * n + (i & 3); }

__device__ __forceinline__ int mk_lane() { int l; asm volatile("v_mbcnt_lo_u32_b32 %0, -1, 0\n\tv_mbcnt_hi_u32_b32 %0, -1, %0" : "=v"(l)); return l; }
struct Unit { int pm, pn; };
struct Gemm { const bf16_t* A; const bf16_t* Bt; int M, N, K; };

struct StaticOrder {
    int nM, nN, nwg, G, c;
    __host__ __device__ void init(int M, int N, int G_, int c_) { nM = M / BM; nN = N / BM; nwg = nM * nN; G = G_; c = c_; }
    __host__ __device__ bool next(int i, Unit& u) const {
        const long L = (long)i * G + c; if (L >= nwg) return false;
        int wgid = (int)L; { const int q = nwg / NXCD, r = nwg % NXCD, xcd = wgid % NXCD, off = wgid / NXCD; wgid = (xcd < r ? xcd * (q + 1) : r * (q + 1) + (xcd - r) * q) + off; }
        const int nig = WGM * nN, gid = wgid / nig, fm = gid * WGM, gsz = (nM - fm) < WGM ? (nM - fm) : WGM;
        u.pm = fm + ((wgid % nig) % gsz); u.pn = (wgid % nig) / gsz; return true;
    }
    __device__ __forceinline__ void a_ready(const Unit&) const {}
    __device__ __forceinline__ void done(const Unit&) const {}
};

__device__ __forceinline__ unsigned cvt_pk_bf16(float lo, float hi) { unsigned r; asm volatile("v_cvt_pk_bf16_f32 %0, %1, %2" : "=v"(r) : "v"(lo), "v"(hi)); return r; }
typedef float f32x2 __attribute__((ext_vector_type(2)));
__device__ __forceinline__ f32x2 gelu_pk(f32x2 v) {
    const f32x2 av = __builtin_elementwise_abs(v), d = av * 0.2316418882f + 1.0f;
    f32x2 t; t.x = __builtin_amdgcn_rcpf(d.x); t.y = __builtin_amdgcn_rcpf(d.y);
    f32x2 q = t * 0.5307027145f + (-0.7265760135f); q = q * t + 0.7107068705f; q = q * t + (-0.142248368f); q = q * t + 0.127414796f; q = q * t;
    const f32x2 s = (v * v) * (-0.72134752044f);
    f32x2 e; e.x = __builtin_amdgcn_exp2f(s.x); e.y = __builtin_amdgcn_exp2f(s.y);
    const f32x2 m = v * (q * e), r = v - m;
    f32x2 o; o.x = v.x < 0.f ? m.x : r.x; o.y = v.y < 0.f ? m.y : r.y; return o;
}

template <int ACT  > struct EpiBf16 {
    static constexpr bool PERM = true, AFTER_DRAIN = false; static_assert(ACT == 0 || ACT == 1, "EpiBf16: ACT is 0 (none) or 1 (gelu_pk)");
    bf16_t* O; int ldc; const float* bias; int split_cols; size_t split_stride; float scale0;
    __device__ __forceinline__ void operator()(const f32x4 (&acc)[2][2][4][2], const Unit& u, int wr, int wc, int fr, int fq) const {
        const int row0 = u.pm * BM + wr * 64 + fr; int colt = u.pn * BM; bf16_t* base = O;
        float sc = 1.f; if (split_cols) { const int t = colt / split_cols; base += (size_t)t * split_stride; colt -= t * split_cols; if (t == 0) sc = scale0; }
        const int col0 = colt + wc * 32 + 8 * fq, bcol0 = u.pn * BM + wc * 32 + 8 * fq;
        f32x4 bv[2][2];
#pragma unroll
        for (int bj = 0; bj < 2; ++bj)
#pragma unroll
            for (int n = 0; n < 2; ++n) bv[bj][n] = bias ? *(const f32x4*)(bias + bcol0 + bj * HALF + 4 * n) : (f32x4){0.f, 0.f, 0.f, 0.f};
#pragma unroll
        for (int ai = 0; ai < 2; ++ai)
#pragma unroll
            for (int m = 0; m < 4; ++m) { bf16_t* rowp = base + (size_t)(row0 + ai * HALF + m * 16) * ldc + col0;
#pragma unroll
                for (int bj = 0; bj < 2; ++bj) { f32x4 v0 = acc[ai][bj][m][0] + bv[bj][0], v1 = acc[ai][bj][m][1] + bv[bj][1];
                    if (ACT == 1) { f32x2 a = gelu_pk((f32x2){v0[0], v0[1]}), b = gelu_pk((f32x2){v0[2], v0[3]}), c = gelu_pk((f32x2){v1[0], v1[1]}), d = gelu_pk((f32x2){v1[2], v1[3]});
                        v0 = (f32x4){a.x, a.y, b.x, b.y}; v1 = (f32x4){c.x, c.y, d.x, d.y}; }
                    v0 = v0 * sc; v1 = v1 * sc; u32x4 w; w.x = cvt_pk_bf16(v0[0], v0[1]); w.y = cvt_pk_bf16(v0[2], v0[3]); w.z = cvt_pk_bf16(v1[0], v1[1]); w.w = cvt_pk_bf16(v1[2], v1[3]);
                    *(u32x4*)(rowp + bj * HALF) = w; } }
    }
};
__device__ __forceinline__ float sigmoidf_(float x) { return __builtin_amdgcn_rcpf(1.0f + __expf(-x)); }
struct EpiResid {
    static constexpr bool PERM = false, AFTER_DRAIN = false;
    const float* base; float* out; int ldc; const float* gvec;
    __device__ __forceinline__ void operator()(const f32x4 (&acc)[2][2][4][2], const Unit& u, int wr, int wc, int fr, int fq) const {
        const int row0 = u.pm * BM + wr * 64 + fr, col0 = u.pn * BM + wc * 32 + 4 * fq;
        f32x4 gv[2][2];
#pragma unroll
        for (int bj = 0; bj < 2; ++bj)
#pragma unroll
            for (int n = 0; n < 2; ++n) gv[bj][n] = *(const __attribute__((address_space(1))) f32x4*)(gvec + col0 + bj * HALF + n * 16);
#pragma unroll
        for (int ai = 0; ai < 2; ++ai)
#pragma unroll
            for (int m = 0; m < 4; ++m) { const size_t off = (size_t)(row0 + ai * HALF + m * 16) * ldc + col0;
#pragma unroll
                for (int bj = 0; bj < 2; ++bj)
#pragma unroll
                    for (int n = 0; n < 2; ++n) { const f32x4 bs = *(const __attribute__((address_space(1))) f32x4*)(base + off + bj * HALF + n * 16);
                        *(__attribute__((address_space(1))) f32x4*)(out + off + bj * HALF + n * 16) = bs + gv[bj][n] * acc[ai][bj][m][n]; }
                if (m & 1) asm volatile("" ::: "memory"); }
    }
};
struct EpiSwiglu {
    static constexpr bool PERM = true, AFTER_DRAIN = false;
    bf16_t* O; int ldc;
    __device__ __forceinline__ void operator()(const f32x4 (&acc)[2][2][4][2], const Unit& u, int wr, int wc, int fr, int fq) const {
        const int row0 = u.pm * BM + wr * 64 + fr, col0 = u.pn * HALF + wc * 32 + 8 * fq;
#pragma unroll
        for (int ai = 0; ai < 2; ++ai)
#pragma unroll
            for (int m = 0; m < 4; ++m) { bf16_t* rowp = O + (size_t)(row0 + ai * HALF + m * 16) * ldc + col0;
                f32x4 h0, h1;
#pragma unroll
                for (int j = 0; j < 4; ++j) { const float g0 = acc[ai][0][m][0][j], g1 = acc[ai][0][m][1][j];
                    h0[j] = g0 * sigmoidf_(g0) * acc[ai][1][m][0][j]; h1[j] = g1 * sigmoidf_(g1) * acc[ai][1][m][1][j]; }
                u32x4 w; w.x = cvt_pk_bf16(h0[0], h0[1]); w.y = cvt_pk_bf16(h0[2], h0[3]); w.z = cvt_pk_bf16(h1[0], h1[1]); w.w = cvt_pk_bf16(h1[2], h1[3]);
                *(__attribute__((address_space(1))) u32x4*)rowp = w; }
    }
};
template <int CTRL> __device__ __forceinline__ float dpp_f(float old, float src) { return __builtin_bit_cast(float, __builtin_amdgcn_update_dpp(__builtin_bit_cast(int, old), __builtin_bit_cast(int, src), CTRL, 0xf, 0xf, false)); }
struct EpiLora {
    static constexpr bool PERM = true, AFTER_DRAIN = false;
    unsigned char* PKB; bf16_t* KD; const bf16_t* kbuf; const bf16_t* kkbuf; const bf16_t* rbuf; const float* w0; const float* a0; const float* k_a; int TT;
    __device__ __forceinline__ void operator()(const f32x4 (&acc)[2][2][4][2], const Unit& u, int wr, int wc, int fr, int fq) const {
        typedef __attribute__((address_space(1))) f32x4 gf4; typedef const __attribute__((address_space(1))) f32x4 cgf4;
        const int d = u.pn >> 4, cg = u.pn & 15;
        const int c8 = cg * HALF + wc * 32 + 8 * fq, h = c8 >> 6, ch = c8 & 63;
        const int row0 = u.pm * BM + wr * 64 + fr;
        f32x4 w0v[2], a0v[2], kav[2];
#pragma unroll
        for (int n = 0; n < 2; ++n) { w0v[n] = *(cgf4*)(w0 + d * 2048 + c8 + 4 * n); a0v[n] = *(cgf4*)(a0 + d * 2048 + c8 + 4 * n); kav[n] = *(cgf4*)(k_a + c8 + 4 * n); }
        typedef unsigned u32x2l __attribute__((ext_vector_type(2))); typedef const __attribute__((address_space(1))) u32x2l cgu2;
        u32x2l kq[2][2], kkq[2][2], rq[2][2];
        { const size_t fo0 = (size_t)row0 * 2048 + c8;
#pragma unroll
          for (int n = 0; n < 2; ++n) { kq[0][n] = *(cgu2*)(kbuf + fo0 + 4 * n); kkq[0][n] = *(cgu2*)(kkbuf + fo0 + 4 * n); rq[0][n] = *(cgu2*)(rbuf + fo0 + 4 * n); } }
#pragma unroll
        for (int it = 0; it < 8; ++it) {
            const int ai = it >> 2, m = it & 3;
            if (it + 1 < 8) { const size_t fo1 = (size_t)(row0 + ((it + 1) >> 2) * HALF + ((it + 1) & 3) * 16) * 2048 + c8;
#pragma unroll
                for (int n = 0; n < 2; ++n) { kq[(it + 1) & 1][n] = *(cgu2*)(kbuf + fo1 + 4 * n); kkq[(it + 1) & 1][n] = *(cgu2*)(kkbuf + fo1 + 4 * n); rq[(it + 1) & 1][n] = *(cgu2*)(rbuf + fo1 + 4 * n); } }
            asm volatile("" ::: "memory");
            const int tok = row0 + ai * HALF + m * 16;
            const int tau = d == 0 ? (tok & 15) : 15 - (tok & 15);
            unsigned char* rec = PKB + ((size_t)(d * 32 + h) * (TT / 16) + (tok >> 4)) * 8448;
            const size_t fo = (size_t)tok * 2048 + c8;
            f32x4 g[2]; u32x4 kw;
#pragma unroll
            for (int n = 0; n < 2; ++n) {
                f32x4 gp;
                const f32x4 x = acc[ai][0][m][n] + w0v[n];
#pragma unroll
                for (int j = 0; j < 4; ++j) { float w = __expf(-0.60653066f * sigmoidf_(x[j]));
                    if (d == 0) { w *= dpp_f<0x111>(1.0f, w); w *= dpp_f<0x112>(1.0f, w); w *= dpp_f<0x114>(1.0f, w); w *= dpp_f<0x118>(1.0f, w); g[n][j] = w; gp[j] = dpp_f<0x111>(1.0f, w); }
                    else        { w *= dpp_f<0x101>(1.0f, w); w *= dpp_f<0x102>(1.0f, w); w *= dpp_f<0x104>(1.0f, w); w *= dpp_f<0x108>(1.0f, w); g[n][j] = w; gp[j] = dpp_f<0x101>(1.0f, w); } }
                const f32x4 xa = acc[ai][1][m][n] + a0v[n];
                f32x4 k4, kk4, r4;
                { const u32x2l a_ = kq[it & 1][n], b_ = kkq[it & 1][n], c_ = rq[it & 1][n];
                  k4[0] = __builtin_bit_cast(float, a_.x << 16); k4[1] = __builtin_bit_cast(float, a_.x & 0xffff0000u); k4[2] = __builtin_bit_cast(float, a_.y << 16); k4[3] = __builtin_bit_cast(float, a_.y & 0xffff0000u);
                  kk4[0] = __builtin_bit_cast(float, b_.x << 16); kk4[1] = __builtin_bit_cast(float, b_.x & 0xffff0000u); kk4[2] = __builtin_bit_cast(float, b_.y << 16); kk4[3] = __builtin_bit_cast(float, b_.y & 0xffff0000u);
                  r4[0] = __builtin_bit_cast(float, c_.x << 16); r4[1] = __builtin_bit_cast(float, c_.x & 0xffff0000u); r4[2] = __builtin_bit_cast(float, c_.y << 16); r4[3] = __builtin_bit_cast(float, c_.y & 0xffff0000u); }
                f32x4 at, rt, bt, kdt; float kdv[4];
#pragma unroll
                for (int j = 0; j < 4; ++j) { const float a = sigmoidf_(xa[j]), rg = __builtin_amdgcn_rcpf(g[n][j]);
                    kdv[j] = k4[j] * (1.0f + (a - 1.0f) * kav[n][j]);
                    at[j] = -kk4[j] * gp[j]; rt[j] = r4[j] * g[n][j]; bt[j] = kk4[j] * a * rg; kdt[j] = kdv[j] * rg; }
                const int chn = ch + 4 * n;
                {
                    const int p0 = ((((chn >> 5) * 2 + ((chn >> 4) & 1)) * 2 + n) * 8 + ((chn >> 3) & 1) * 4);
                    typedef unsigned u32x2 __attribute__((ext_vector_type(2)));
                    __attribute__((address_space(1))) unsigned char* rp = (__attribute__((address_space(1))) unsigned char*)rec + (tau * 64 + p0) * 2;
                    u32x2 w;
                    w.x = cvt_pk_bf16(at[0], at[1]); w.y = cvt_pk_bf16(at[2], at[3]); *(__attribute__((address_space(1))) u32x2*)(rp) = w;
                    w.x = cvt_pk_bf16(rt[0], rt[1]); w.y = cvt_pk_bf16(rt[2], rt[3]); *(__attribute__((address_space(1))) u32x2*)(rp + 2048) = w;
                    w.x = cvt_pk_bf16(bt[0], bt[1]); w.y = cvt_pk_bf16(bt[2], bt[3]); *(__attribute__((address_space(1))) u32x2*)(rp + 4096) = w;
                    w.x = cvt_pk_bf16(kdt[0], kdt[1]); w.y = cvt_pk_bf16(kdt[2], kdt[3]); *(__attribute__((address_space(1))) u32x2*)(rp + 6144) = w; }
                if (n == 0) { kw.x = cvt_pk_bf16(kdv[0], kdv[1]); kw.y = cvt_pk_bf16(kdv[2], kdv[3]); } else { kw.z = cvt_pk_bf16(kdv[0], kdv[1]); kw.w = cvt_pk_bf16(kdv[2], kdv[3]); }
            }
            *(__attribute__((address_space(1))) u32x4*)(KD + (size_t)d * TT * 2048 + fo) = kw;
            if (fr == (d == 0 ? 15 : 0)) { float* ge = (float*)(rec + 8192) + ch; *(gf4*)ge = g[0]; *(gf4*)(ge + 4) = g[1]; }
        }
    }
};
template <class Epi, class Sched, bool ALIGN_EPI = false, bool SP2 = false>
__device__ __forceinline__ void gemm_phase(PG8_LAS unsigned char* lds, const Gemm g, const Sched& S, const Epi& E, const int wid) {
    const int lane = mk_lane(), tid = wid * 64 + lane, wr = wid >> 2, wc = wid & 3, fr = lane & 15, fq = lane >> 4;
    const int K = g.K, nt = K / BK;
    unsigned voffA[2], voffB[2];
#pragma unroll
    for (int i = 0; i < 2; ++i) { int R, C; stage_rc(tid * 16 + i * 8192, R, C); const int Rb = Epi::PERM ? ((R & ~31) + perm32(R & 31)) : R;
        voffA[i] = (unsigned)(R * K + C) * 2u; voffB[i] = (unsigned)(Rb * K + C) * 2u; }
    const size_t kstep = (size_t)(BK * 2);
    const size_t hstep = (size_t)HALF * K * 2;
    const size_t tstep = 2 * hstep;
    const unsigned ldsw = (unsigned)wid * 1024u;
    const int aoff = lds_byte(wr * 64 + fr, fq * 8), boff = lds_byte(wc * 32 + fr, fq * 8);
#define PG8_SA(b, h) (((b) * 2 + (h)) * HTB)
#define PG8_SB(b, h) ((4 + (b) * 2 + (h)) * HTB)
#define PG8_STAGE(bufoff, gbase, voff) do { _Pragma("unroll") for (int _i = 0; _i < 2; ++_i) \
        __builtin_amdgcn_global_load_lds((const unsigned*)((const char*)(gbase) + (voff)[_i]), (PG8_LAS unsigned*)(lds + (bufoff) + ldsw + _i * 8192), 16, 0, 0); } while (0)
#define PG8_LDA(dst, b, h) do { _Pragma("unroll") for (int m = 0; m < 4; ++m) _Pragma("unroll") for (int k = 0; k < 2; ++k) dst[m][k] = *(const PG8_LAS bf16x8*)(lds + PG8_SA(b, h) + aoff + m * 2048 + k * 1024); } while (0)
#define PG8_LDB(dst, b, h) do { _Pragma("unroll") for (int n = 0; n < 2; ++n) _Pragma("unroll") for (int k = 0; k < 2; ++k) dst[n][k] = *(const PG8_LAS bf16x8*)(lds + PG8_SB(b, h) + boff + n * 2048 + k * 1024); } while (0)
#define PG8_MMA(ai, bj, At, Bt) do { __builtin_amdgcn_s_setprio(1); _Pragma("unroll") for (int m = 0; m < 4; ++m) _Pragma("unroll") for (int n = 0; n < 2; ++n) _Pragma("unroll") for (int k = 0; k < 2; ++k) \
        acc[ai][bj][m][n] = __builtin_amdgcn_mfma_f32_16x16x32_bf16(Bt[n][k], At[m][k], acc[ai][bj][m][n], 0, 0, 0); __builtin_amdgcn_s_setprio(0); } while (0)
#define PG8_WAIT_V(n) asm volatile("s_waitcnt vmcnt(" #n ")" ::: "memory")
#define PG8_WAIT_L(n) asm volatile("s_waitcnt lgkmcnt(" #n ")" ::: "memory")
#define PG8_BAR __builtin_amdgcn_s_barrier()
#define PG8_SCHED __builtin_amdgcn_sched_barrier(0)
    Unit cur, nxt; int ui = 0;
    if (!S.next(0, cur)) return;
    f32x4 acc[2][2][4][2];
#pragma unroll
    for (int a = 0; a < 2; ++a)
#pragma unroll
        for (int b = 0; b < 2; ++b)
#pragma unroll
            for (int m = 0; m < 4; ++m)
#pragma unroll
                for (int n = 0; n < 2; ++n) acc[a][b][m][n] = (f32x4){0.f, 0.f, 0.f, 0.f};
    bf16x8 At[4][2], B0[2][2], B1[2][2];
    const char* cA = (const char*)g.A + (size_t)cur.pm * tstep; const char* cB = (const char*)g.Bt + (size_t)cur.pn * tstep;
    S.a_ready(cur);
    if constexpr (SP2) {
        PG8_STAGE(PG8_SB(0, 0), cB, voffB); PG8_STAGE(PG8_SB(0, 1), cB + hstep, voffB); PG8_STAGE(PG8_SA(0, 0), cA, voffA); PG8_STAGE(PG8_SA(0, 1), cA + hstep, voffA);
        if (wr == 1) PG8_BAR;
        PG8_WAIT_V(2); PG8_BAR;
        PG8_STAGE(PG8_SB(1, 0), cB + kstep, voffB); PG8_STAGE(PG8_SA(1, 0), cA + kstep, voffA); PG8_STAGE(PG8_SB(1, 1), cB + hstep + kstep, voffB);
        PG8_WAIT_V(6); PG8_BAR;
    } else {
        PG8_STAGE(PG8_SB(0, 0), cB, voffB); PG8_STAGE(PG8_SA(0, 0), cA, voffA); PG8_STAGE(PG8_SB(0, 1), cB + hstep, voffB); PG8_STAGE(PG8_SA(0, 1), cA + hstep, voffA);
        if (wr == 1) PG8_BAR;
        PG8_WAIT_V(4); PG8_BAR;
        PG8_STAGE(PG8_SB(1, 0), cB + kstep, voffB); PG8_STAGE(PG8_SA(1, 0), cA + kstep, voffA); PG8_STAGE(PG8_SB(1, 1), cB + hstep + kstep, voffB);
        PG8_WAIT_V(6); PG8_BAR;
    }
    for (;;) {
        const bool has_next = S.next(ui + 1, nxt);
        const char* nA = has_next ? (const char*)g.A + (size_t)nxt.pm * tstep : cA; const char* nB = has_next ? (const char*)g.Bt + (size_t)nxt.pn * tstep : cB;
        for (int t = 0; t < nt; t += 2) {
            const bool last = (t == nt - 2);
            const char* a1 = cA + (size_t)(t + 1) * kstep;
            const char* a2 = last ? nA : cA + (size_t)(t + 2) * kstep; const char* b2 = last ? nB : cB + (size_t)(t + 2) * kstep;
            const char* a3 = a2 + kstep; const char* b3 = b2 + kstep;
            if (last && has_next) S.a_ready(nxt);
            if constexpr (SP2) {
            PG8_LDB(B0, 0, 0); PG8_LDB(B1, 0, 1); PG8_SCHED; PG8_LDA(At, 0, 0); PG8_STAGE(PG8_SA(1, 1), a1 + hstep, voffA);
            PG8_WAIT_V(8); PG8_WAIT_L(0); PG8_BAR; PG8_MMA(0, 0, At, B0); PG8_MMA(0, 1, At, B1); PG8_BAR; PG8_SCHED;
            PG8_LDA(At, 0, 1); PG8_STAGE(PG8_SB(0, 0), b2, voffB); PG8_STAGE(PG8_SB(0, 1), b2 + hstep, voffB); PG8_STAGE(PG8_SA(0, 0), a2, voffA);
            PG8_WAIT_V(8); PG8_WAIT_L(0); PG8_BAR; PG8_MMA(1, 0, At, B0); PG8_MMA(1, 1, At, B1); PG8_BAR; PG8_SCHED;
            PG8_LDB(B0, 1, 0); PG8_LDB(B1, 1, 1); PG8_SCHED; PG8_LDA(At, 1, 0); PG8_STAGE(PG8_SA(0, 1), a2 + hstep, voffA);
            PG8_WAIT_V(8); PG8_WAIT_L(0); PG8_BAR; PG8_MMA(0, 0, At, B0); PG8_MMA(0, 1, At, B1); PG8_BAR; PG8_SCHED;
            PG8_LDA(At, 1, 1); PG8_STAGE(PG8_SB(1, 0), b3, voffB); PG8_STAGE(PG8_SB(1, 1), b3 + hstep, voffB); PG8_STAGE(PG8_SA(1, 0), a3, voffA);
            PG8_WAIT_V(8); PG8_WAIT_L(0); PG8_BAR; PG8_MMA(1, 0, At, B0); PG8_MMA(1, 1, At, B1); PG8_BAR; PG8_SCHED;
            } else {
            PG8_LDB(B0, 0, 0); PG8_SCHED; PG8_LDA(At, 0, 0); PG8_STAGE(PG8_SA(1, 1), a1 + hstep, voffA);
            PG8_WAIT_L(8); PG8_BAR; PG8_WAIT_L(0); PG8_MMA(0, 0, At, B0); PG8_BAR; PG8_SCHED;
            PG8_LDB(B1, 0, 1); PG8_STAGE(PG8_SB(0, 0), b2, voffB);
            PG8_BAR; PG8_WAIT_L(0); PG8_MMA(0, 1, At, B1); PG8_BAR;
            PG8_LDA(At, 0, 1); PG8_STAGE(PG8_SA(0, 0), a2, voffA);
            PG8_BAR; PG8_WAIT_L(0); PG8_MMA(1, 0, At, B0); PG8_BAR; PG8_SCHED;
            PG8_STAGE(PG8_SB(0, 1), b2 + hstep, voffB);
            PG8_WAIT_V(6); PG8_BAR; PG8_MMA(1, 1, At, B1); PG8_BAR;
            PG8_LDB(B0, 1, 0); PG8_SCHED; PG8_LDA(At, 1, 0); PG8_STAGE(PG8_SA(0, 1), a2 + hstep, voffA);
            PG8_WAIT_L(8); PG8_BAR; PG8_WAIT_L(0); PG8_MMA(0, 0, At, B0); PG8_BAR; PG8_SCHED;
            PG8_LDB(B1, 1, 1); PG8_STAGE(PG8_SB(1, 0), b3, voffB);
            PG8_BAR; PG8_WAIT_L(0); PG8_MMA(0, 1, At, B1); PG8_BAR;
            PG8_LDA(At, 1, 1); PG8_STAGE(PG8_SA(1, 0), a3, voffA);
            PG8_BAR; PG8_WAIT_L(0); PG8_MMA(1, 0, At, B0); PG8_BAR; PG8_SCHED;
            PG8_STAGE(PG8_SB(1, 1), b3 + hstep, voffB);
            PG8_WAIT_V(6); PG8_BAR; PG8_MMA(1, 1, At, B1); PG8_BAR;
            }
        }
        if constexpr (ALIGN_EPI) { if (wr == 0) PG8_BAR; }
        if constexpr (!Epi::AFTER_DRAIN) { const int l2 = mk_lane(); E(acc, cur, wr, wc, l2 & 15, l2 >> 4); S.done(cur); }
        if (!has_next) break;
#pragma unroll
        for (int a = 0; a < 2; ++a)
#pragma unroll
            for (int b = 0; b < 2; ++b)
#pragma unroll
                for (int m = 0; m < 4; ++m)
#pragma unroll
                    for (int n = 0; n < 2; ++n) acc[a][b][m][n] = (f32x4){0.f, 0.f, 0.f, 0.f};
        cur = nxt; cA = nA; cB = nB; ++ui;
        if constexpr (ALIGN_EPI) { if (wr == 1) PG8_BAR; }
    }
    PG8_WAIT_V(0);
    if constexpr (!ALIGN_EPI) { if (wr == 0) PG8_BAR; }
    PG8_BAR;
    if constexpr (Epi::AFTER_DRAIN) { E.fused(acc, cur, wr, wc, fr, fq, lds, wid, lane); S.done(cur); }
#undef PG8_SA
#undef PG8_SB
#undef PG8_STAGE
#undef PG8_LDA
#undef PG8_LDB
#undef PG8_MMA
#undef PG8_WAIT_V
#undef PG8_WAIT_L
#undef PG8_BAR
#undef PG8_SCHED
}
}

constexpr int NWAVES = 8;
#ifndef MK_N_LAUNCHES
#define MK_N_LAUNCHES 1
#endif
constexpr int N_PHASES = 14;
#ifndef MK_REPS
#define MK_REPS {1,1,1,1,1,1,1,1,1,1,1,1,1,1}
#endif
constexpr int PH_REPS[14] = MK_REPS;
#ifndef MK_TPA
#define MK_TPA -1
#endif
#ifndef MK_TPB
#define MK_TPB -1
#endif
constexpr int TPA = MK_TPA, TPB = MK_TPB;
constexpr int N_LAUNCHES = MK_N_LAUNCHES;

constexpr int D = 4096, T = 8192, CTXL = 256, TT = T + CTXL;
constexpr int DR = 2048, DC = 2048, NH = 32, HS = 64;
constexpr int OFF_K = 0, OFF_V = 2048, OFF_WL = 4096, OFF_AL = 4192, OFF_R = 4288, OFF_GL = 6336, RWKV_COLS = 6592;
constexpr int OFF_CB = 6592, OFF_CC = 8640, OFF_CX = 10688, IN_COLS = 12736, NZ = 12800;
constexpr int NCTXZ = 4352;
constexpr int DFF = 11008, NGU = 2 * DFF;
constexpr int NLORA = 8192, KLORA = 256, KGATE = 256;
constexpr int MODN = 6 * D;
constexpr int NKC = 16;
constexpr float NORM_EPS = 1e-6f, LNX_EPS = 64e-5f;
constexpr int CHUNK = 256, NCHUNK = 33;

constexpr size_t MiB = 1u << 20;
constexpr size_t WS_CTL = 0, CTL_ZERO_BYTES = 1 * MiB;
constexpr size_t WS_MODP = 1 * MiB;
constexpr size_t WS_MODV = 5 * MiB;
constexpr size_t WS_WLORA = 6 * MiB;
constexpr size_t WS_WGATE = 10 * MiB;
constexpr size_t WS_ALORA = 11 * MiB;
constexpr size_t WS_AGATE = 16 * MiB;
constexpr size_t WS_WOUT = 20 * MiB;
constexpr size_t WS_WGU = 52 * MiB;
constexpr size_t WS_WDN = 224 * MiB;
constexpr size_t WS_WIN = 310 * MiB;
constexpr size_t WS_PU = 310 * MiB;
constexpr size_t WS_SST = 374 * MiB;
constexpr size_t WS_A1 = 410 * MiB;
constexpr size_t WS_CAT = 410 * MiB;
constexpr size_t WS_Z = 476 * MiB;
constexpr size_t WS_YS = 476 * MiB;
constexpr size_t WS_KD = 604 * MiB;
constexpr size_t WS_GE = 670 * MiB;
constexpr size_t WS_KBUF = 683 * MiB;
constexpr size_t WS_KKBUF = 749 * MiB;
constexpr size_t WS_RBUF = 815 * MiB;
constexpr size_t WS_VBUF = 881 * MiB;
constexpr size_t WS_X1 = 683 * MiB;
constexpr size_t WS_PK = 947 * MiB;
constexpr size_t WS_ACT = 947 * MiB;
constexpr size_t WS_G = 1475 * MiB;
constexpr size_t WS_END = 1507 * MiB;
static_assert(WS_MODP + (size_t)NKC * 2 * MODN * 4 <= WS_MODV && WS_ALORA + (size_t)TT * 256 * 2 <= WS_AGATE && WS_WGU + (size_t)NGU * D * 2 <= WS_WDN && WS_WDN + (size_t)D * DFF * 2 <= WS_WIN, "ws map 1");
static_assert(WS_WIN + (size_t)NZ * D * 2 <= WS_A1 && WS_SST + (size_t)64 * NCHUNK * 16384 <= WS_A1 && WS_A1 + (size_t)TT * D * 2 <= WS_Z && WS_Z + (size_t)TT * NZ * 2 <= WS_KBUF, "ws map 2");
static_assert(WS_YS + (size_t)2 * T * 2048 * 4 <= WS_KD && WS_KD + (size_t)2 * TT * 2048 * 2 <= WS_GE && WS_GE + (size_t)64 * (TT / 16) * 256 <= WS_KBUF, "ws map 3");
static_assert(WS_KBUF + (size_t)TT * 2048 * 4 <= WS_KKBUF && WS_KKBUF + (size_t)TT * 2048 * 4 <= WS_RBUF && WS_RBUF + (size_t)TT * 2048 * 4 <= WS_VBUF && WS_VBUF + (size_t)TT * 2048 * 4 <= WS_PK, "ws map 4");
static_assert(WS_X1 + (size_t)T * D * 4 <= WS_RBUF && WS_PK + (size_t)64 * TT * 1024 <= WS_G && WS_ACT + (size_t)T * DFF * 2 <= WS_G && WS_G + (size_t)T * 2048 * 2 <= WS_END && WS_CAT + (size_t)T * D * 2 <= WS_Z, "ws map 5");
constexpr int CW_TMO = 0;
constexpr int CW_BAR = 4096;

constexpr int RING_OFF = 0, RING_BYTES = 131072;
constexpr int LDSCTL_OFF = RING_BYTES, MISC_OFF = LDSCTL_OFF + 320;
constexpr int LDS_BYTES = 147456;
static_assert(MISC_OFF + 128 <= LDS_BYTES, "LDS map");

#define GAS __attribute__((address_space(1)))
#define LAS __attribute__((address_space(3)))
typedef unsigned short bf16;
typedef unsigned v4u __attribute__((ext_vector_type(4)));
typedef unsigned v2u __attribute__((ext_vector_type(2)));
typedef float f32x4 __attribute__((ext_vector_type(4)));
typedef GAS unsigned gu32;
#define RLX_AGENT __ATOMIC_RELAXED, __HIP_MEMORY_SCOPE_AGENT
#define LDS_WAIT() asm volatile("s_waitcnt lgkmcnt(0)" ::: "memory")
#define VM_WAIT() asm volatile("s_waitcnt vmcnt(0)" ::: "memory")
__device__ __forceinline__ unsigned f2bf(float f) { unsigned u = __builtin_bit_cast(unsigned, f); return (u + 0x7fffu + ((u >> 16) & 1u)) >> 16; }
__device__ __forceinline__ unsigned pk2(float lo, float hi) { return f2bf(lo) | (f2bf(hi) << 16); }
__device__ __forceinline__ float bflo(unsigned w) { return __builtin_bit_cast(float, w << 16); }
__device__ __forceinline__ float bfhi(unsigned w) { return __builtin_bit_cast(float, w & 0xffff0000u); }
__device__ __forceinline__ float sigm(float x) { return 1.0f / (1.0f + __expf(-x)); }

#define XB_TMO      128
#define XB_XCNT(j)  (256  + 64 * (j))
#define XB_XSUB(j)  (1280 + 64 * (j))
#define XB_XGEN(j)  (2304 + 64 * (j))
#define XB_TOP      3328
#define XB_TOPGEN   3392
#define XCD_BAR_WORDS 3456
#define XB_SPIN_CAP (1u << 18)
__device__ __forceinline__ unsigned xb_ld(unsigned* p)              { return __hip_atomic_load(p, __ATOMIC_RELAXED, __HIP_MEMORY_SCOPE_AGENT); }
__device__ __forceinline__ unsigned xb_add(unsigned* p, unsigned v) { return __hip_atomic_fetch_add(p, v, __ATOMIC_RELAXED, __HIP_MEMORY_SCOPE_AGENT); }
__device__ __forceinline__ unsigned xb_xcc_id() { return (unsigned)__builtin_amdgcn_s_getreg((3 << 11) | 20) & 0xFu; }
#define XB_SPIN(cond, bar) do { unsigned _sp = 0; while (cond) { __builtin_amdgcn_s_sleep(1); \
    if ((++_sp & 255u) == 0u) { if (xb_ld(&(bar)[XB_TMO])) break; if (_sp > XB_SPIN_CAP) { atomicAdd(&(bar)[XB_TMO], 1u); break; } } } } while (0)
struct XcdBarrier { unsigned* bar; unsigned x; volatile LAS unsigned* st; };
__device__ __forceinline__ XcdBarrier xcd_barrier_post(unsigned* bar, volatile LAS unsigned* st) {
    XcdBarrier b; b.bar = bar; b.x = xb_xcc_id(); b.st = st;
    if (threadIdx.x == 0) (void)xb_add(&bar[XB_XCNT(b.x)], 1u);
    return b;
}
__device__ __forceinline__ void xcd_barrier_complete(unsigned* bar, unsigned x, unsigned& nloc, unsigned& nx) {
    const unsigned G = gridDim.x * gridDim.y * gridDim.z;
    unsigned sum, cnt, mine, sp = 0u;
    for (;;) {
        sum = 0u; cnt = 0u; mine = 0u;
#pragma unroll
        for (unsigned j = 0; j < 16; ++j) { const unsigned c = xb_ld(&bar[XB_XCNT(j)]); sum += c; cnt += (c > 0u) ? 1u : 0u; mine = (j == x) ? c : mine; }
        if (sum == G) break;
        __builtin_amdgcn_s_sleep(1);
        if ((++sp & 255u) == 0u) { if (xb_ld(&bar[XB_TMO])) break; if (sp > XB_SPIN_CAP) { atomicAdd(&bar[XB_TMO], 1u); break; } }
    }
    nloc = mine > 0u ? mine : 1u; nx = cnt > 0u ? cnt : 1u;
}
__device__ __forceinline__ void xcd_barrier(const XcdBarrier& b, const int wave) {
    asm volatile("s_waitcnt vmcnt(0)" ::: "memory");
    __syncthreads();
    if (wave == 0 && pg8::mk_lane() == 0) {
        unsigned* bar = b.bar;
        __builtin_amdgcn_s_waitcnt(0);
        unsigned nloc = b.st[0], nx = b.st[1];
        if (nloc == 0u) { xcd_barrier_complete(bar, b.x, nloc, nx); b.st[0] = nloc; b.st[1] = nx; }
        const unsigned old = xb_add(&bar[XB_XSUB(b.x)], 1u);
        const unsigned gen = old / nloc;
        if (old + 1u == (gen + 1u) * nloc) {
            __builtin_amdgcn_fence(__ATOMIC_RELEASE, "agent");
            asm volatile("s_waitcnt vmcnt(0)" ::: "memory");
            const unsigned og = xb_add(&bar[XB_TOP], 1u);
            const unsigned tg = og / nx;
            if (og + 1u == (tg + 1u) * nx) xb_add(&bar[XB_TOPGEN], 1u);
            else XB_SPIN(xb_ld(&bar[XB_TOPGEN]) == tg, bar);
            __builtin_amdgcn_fence(__ATOMIC_ACQUIRE, "agent");
            xb_add(&bar[XB_XGEN(b.x)], 1u);
            asm volatile("s_waitcnt vmcnt(0)" ::: "memory");
        } else {
            XB_SPIN(xb_ld(&bar[XB_XGEN(b.x)]) == gen, bar);
            __builtin_amdgcn_fence(__ATOMIC_ACQUIRE, "agent");
            asm volatile("s_waitcnt vmcnt(0)" ::: "memory");
        }
    }
    __syncthreads();
}

struct Frame {
    LAS unsigned char* lds;
    volatile LAS unsigned* MISC;
    gu32* ctl;
    int wave;
    int vcu, G;
    unsigned char* ws;
    const float* in[26];
    float* out;
};
enum { I_X = 0, I_C, I_CTX, I_CCTX, I_WADA, I_BADA, I_NORM1, I_WIN, I_MU, I_KK, I_KA, I_RK, I_W0, I_WDU, I_A0, I_WIU, I_WGU, I_LNXW, I_LNXB, I_CONVW, I_WOUT, I_NORM2, I_WFG, I_WFU, I_WFD, I_NORMF };

__device__ __forceinline__ float wave_sum(float v) {
#pragma unroll
    for (int o = 1; o < 64; o <<= 1) v += __shfl_xor(v, o);
    return v;
}

__device__ __forceinline__ void p0_transpose_item(const float* W, int K, int N, bf16* WT, int ldk, int row_off, LAS float* scr, int item, int lane) {
    const int nblk = N / 32, kb = item / nblk, nb = item % nblk, k0 = 64 * kb, n0 = 32 * nb;
    float tv[32];
#pragma unroll
    for (int i = 0; i < 32; ++i) tv[i] = *(const GAS float*)(W + (size_t)(k0 + 2 * i + (lane >> 5)) * N + n0 + (lane & 31));
#pragma unroll
    for (int i = 0; i < 32; ++i) scr[(2 * i + (lane >> 5)) * 33 + (lane & 31)] = tv[i];
    LDS_WAIT(); asm volatile("" ::: "memory");
    const int c = lane & 7;
#pragma unroll
    for (int j = 0; j < 4; ++j) { const int n = (lane >> 3) + 8 * j; const LAS float* s = scr + (8 * c) * 33 + n;
        v4u o; o.x = pk2(s[0 * 33], s[1 * 33]); o.y = pk2(s[2 * 33], s[3 * 33]); o.z = pk2(s[4 * 33], s[5 * 33]); o.w = pk2(s[6 * 33], s[7 * 33]);
        *(GAS v4u*)(WT + (size_t)(row_off + n0 + n) * ldk + k0 + 8 * c) = o; }
    LDS_WAIT(); asm volatile("" ::: "memory");
}
constexpr int TI_IN = (D / 64) * (IN_COLS / 32), TI_OUT = (D / 64) * (D / 32), TI_G = (D / 64) * (DFF / 32), TI_DN = (DFF / 64) * (D / 32);
constexpr int TI_TOTAL = TI_IN + TI_OUT + 2 * TI_G + TI_DN;
constexpr int GEMV_UNITS = NKC * (MODN / 256);
constexpr int IB_OUT = TI_IN, IB_G = IB_OUT + TI_OUT, IB_U = IB_G + TI_G, IB_D = IB_U + TI_G;
constexpr int P2T_B = IB_OUT, P2T_E = IB_G + 13200;
constexpr int P6T_B = P2T_E, P6T_E = IB_U + 11000;
constexpr int P0X_B = P6T_E, P0X_E = IB_D + 12000;
constexpr int P11T_B = P0X_E, P11T_E = TI_TOTAL;
constexpr int P0_ITEMS = TI_IN + (P0X_E - P0X_B);
constexpr int TI_PER_GEMV_WAVE = 18, TI_PER_OTHER_WAVE = 42;
static_assert(GEMV_UNITS <= 2048 && GEMV_UNITS * TI_PER_GEMV_WAVE + (2048 - GEMV_UNITS) * TI_PER_OTHER_WAVE >= P0_ITEMS, "P0 item split");

__device__ __forceinline__ void tr_item(Frame& F, int it, LAS float* scr, int lane) {
    int r = it;
    if (r < TI_IN) { p0_transpose_item(F.in[I_WIN], D, IN_COLS, (bf16*)(F.ws + WS_WIN), D, 0, scr, r, lane); return; } r -= TI_IN;
    if (r < TI_OUT) { p0_transpose_item(F.in[I_WOUT], D, D, (bf16*)(F.ws + WS_WOUT), D, 0, scr, r, lane); return; } r -= TI_OUT;
    if (r < TI_G) { const int n0 = 32 * (r % (DFF / 32)); p0_transpose_item(F.in[I_WFG], D, DFF, (bf16*)(F.ws + WS_WGU), D, 256 * (n0 >> 7) + (n0 & 127) - n0, scr, r, lane); return; } r -= TI_G;
    if (r < TI_G) { const int n0 = 32 * (r % (DFF / 32)); p0_transpose_item(F.in[I_WFU], D, DFF, (bf16*)(F.ws + WS_WGU), D, 256 * (n0 >> 7) + 128 + (n0 & 127) - n0, scr, r, lane); return; } r -= TI_G;
    p0_transpose_item(F.in[I_WFD], DFF, D, (bf16*)(F.ws + WS_WDN), DFF, 0, scr, r, lane);
}
__device__ __forceinline__ void tr_range(Frame& F, int b, int e, int rank, int nw, LAS float* scr, int lane) {
    const int per = (e - b + nw - 1) / nw; int i0 = b + rank * per, i1 = i0 + per; if (i1 > e) i1 = e;
    for (int it = i0; it < i1; ++it) tr_item(F, it, scr, lane);
}
__device__ __forceinline__ void tr_idle(Frame& F, int b, int e, int rank_blk, int nblk) {
    if (F.G != 256 || rank_blk < 0) return;
    tr_range(F, b, e, rank_blk * NWAVES + F.wave, nblk * NWAVES, (LAS float*)(F.lds + RING_OFF + F.wave * 16384), pg8::mk_lane());
}
__device__ __forceinline__ void p0_gemv_unit(Frame& F, int unit, int lane) {
    const int kc = unit / (MODN / 256), cc = unit % (MODN / 256);
    const int k0 = kc * 256, col = cc * 256 + lane * 4;
    int sv[4], sc[4];
#pragma unroll
    for (int q = 0; q < 4; ++q) { const float c = *(const GAS float*)(F.in[I_C] + k0 + q * 64 + lane), cx = *(const GAS float*)(F.in[I_CCTX] + k0 + q * 64 + lane);
        sv[q] = __builtin_bit_cast(int, c * sigm(c)); sc[q] = __builtin_bit_cast(int, cx * sigm(cx)); }
    f32x4 a0 = (f32x4){0.f, 0.f, 0.f, 0.f}, a1 = a0;
    const GAS f32x4* wp = (const GAS f32x4*)(F.in[I_WADA] + (size_t)k0 * MODN + col);
#pragma unroll
    for (int q = 0; q < 4; ++q) {
#pragma unroll 16
        for (int i = 0; i < 64; ++i) { const f32x4 w = wp[(size_t)(q * 64 + i) * (MODN / 4)];
            const float s = __builtin_bit_cast(float, __builtin_amdgcn_readlane(sv[q], i)), t = __builtin_bit_cast(float, __builtin_amdgcn_readlane(sc[q], i));
            a0 += w * s; a1 += w * t; }
    }
    float* mp = (float*)(F.ws + WS_MODP);
    *(GAS f32x4*)(mp + (size_t)(kc * 2 + 0) * MODN + col) = a0;
    *(GAS f32x4*)(mp + (size_t)(kc * 2 + 1) * MODN + col) = a1;
}

__device__ __forceinline__ void p0_prologue(Frame& F) {
    LAS float* scr = (LAS float*)(F.lds + RING_OFF + F.wave * 16384);
    const int lane = pg8::mk_lane();
    const int gw = F.vcu * NWAVES + F.wave, NGW = F.G * NWAVES;
    const int gt = gw * 64 + lane, NGT = NGW * 64;
    {
        unsigned* wl = (unsigned*)(F.ws + WS_WLORA);
        for (int i = gt; i < NLORA * KLORA / 2; i += NGT) { const int n = i >> 7, k = (i & 127) * 2, pn = n >> 8, d = pn >> 4, isic = (n >> 7) & 1, ch = (pn & 15) * 128 + (n & 127); float v0 = 0.f, v1 = 0.f;
            if (k < 96) { if (!isic) { v0 = *(const GAS float*)(F.in[I_WDU] + (size_t)(d * 96 + k) * 2048 + ch); v1 = *(const GAS float*)(F.in[I_WDU] + (size_t)(d * 96 + k + 1) * 2048 + ch); } }
            else if (k < 192) { if (isic) { v0 = *(const GAS float*)(F.in[I_WIU] + (size_t)(d * 96 + k - 96) * 2048 + ch); v1 = *(const GAS float*)(F.in[I_WIU] + (size_t)(d * 96 + k - 95) * 2048 + ch); } }
            *(GAS unsigned*)(wl + i) = pk2(v0, v1); }
        unsigned* wg = (unsigned*)(F.ws + WS_WGATE);
        for (int i = gt; i < 2048 * KGATE / 2; i += NGT) { const int n = i >> 7, k = (i & 127) * 2;
            *(GAS unsigned*)(wg + i) = pk2(*(const GAS float*)(F.in[I_WGU] + (size_t)k * 2048 + n), *(const GAS float*)(F.in[I_WGU] + (size_t)(k + 1) * 2048 + n)); }
        v4u* zp = (v4u*)(F.ws + WS_WIN + (size_t)IN_COLS * D * 2);
        for (int i = gt; i < (NZ - IN_COLS) * D * 2 / 16; i += NGT) *(GAS v4u*)(zp + i) = (v4u){0u, 0u, 0u, 0u};
    }
    for (int u = gw; u < GEMV_UNITS; u += NGW) p0_gemv_unit(F, u, lane);
    if (F.G == 256) {
        int it0, it1;
        if (gw < GEMV_UNITS) { it0 = gw * TI_PER_GEMV_WAVE; it1 = it0 + TI_PER_GEMV_WAVE; }
        else { it0 = GEMV_UNITS * TI_PER_GEMV_WAVE + (gw - GEMV_UNITS) * TI_PER_OTHER_WAVE; it1 = it0 + TI_PER_OTHER_WAVE; }
        if (it1 > P0_ITEMS) it1 = P0_ITEMS;
        for (int it = it0; it < it1; ++it) tr_item(F, it < TI_IN ? it : P0X_B + (it - TI_IN), scr, lane);
    } else tr_range(F, 0, TI_TOTAL, gw, NGW, scr, lane);
}

__device__ __forceinline__ void norm_row_load(const float* xrow, int lane, f32x4 (&v)[16]) {
    const GAS f32x4* xr = (const GAS f32x4*)xrow + lane;
#pragma unroll
    for (int j = 0; j < 16; ++j) v[j] = xr[64 * j];
}
__device__ __forceinline__ void norm_row_finish(const f32x4 (&v)[16], bf16* orow, const LAS float* gs, const LAS float* sh, int lane) {
    float s = 0.f;
#pragma unroll
    for (int j = 0; j < 16; ++j) s += (v[j].x * v[j].x + v[j].y * v[j].y) + (v[j].z * v[j].z + v[j].w * v[j].w);
    const float rstd = 1.0f / sqrtf(wave_sum(s) * (1.f / D) + NORM_EPS);
    GAS v2u* o8 = (GAS v2u*)orow + lane;
#pragma unroll
    for (int j = 0; j < 16; ++j) { const f32x4 g = *(const LAS f32x4*)(gs + 4 * lane + 256 * j), b = *(const LAS f32x4*)(sh + 4 * lane + 256 * j);
        const f32x4 y = v[j] * rstd * g + b; v2u o; o.x = pk2(y.x, y.y); o.y = pk2(y.z, y.w); o8[64 * j] = o; }
}
__device__ __forceinline__ void norm_row(const float* xrow, bf16* orow, const LAS float* gs, const LAS float* sh, int lane) {
    f32x4 v[16]; norm_row_load(xrow, lane, v); norm_row_finish(v, orow, gs, sh, lane);
}
__device__ __forceinline__ void p1_norm1(Frame& F) {
    const int lane = pg8::mk_lane(), tid = F.wave * 64 + lane;
    const int gw = F.vcu * NWAVES + F.wave, NGW = F.G * NWAVES;
    bf16* A1 = (bf16*)(F.ws + WS_A1);
    f32x4 v0[16]; norm_row_load(F.in[I_X] + (size_t)gw * D, lane, v0);
    LAS float* tab = (LAS float*)(F.lds + RING_OFF);
    const float* mp = (const float*)(F.ws + WS_MODP);
    bool need_ctx = false;
    for (int m = F.vcu * NWAVES; m < TT; m += NGW) if (m + NWAVES > T) need_ctx = true;
    for (int i = tid; i < (need_ctx ? 4 : 2) * (D / 4); i += NWAVES * 64) {
        const int which = i >> 10, k = (i & (D / 4 - 1)) * 4, isc = which >> 1, part = which & 1;
        const int col = part == 0 ? D + k : k;
        f32x4 s = *(const GAS f32x4*)(F.in[I_BADA] + col);
#pragma unroll
        for (int p = 0; p < NKC; ++p) s += *(const GAS f32x4*)(mp + (size_t)(p * 2 + isc) * MODN + col);
        if (part == 0) s = *(const GAS f32x4*)(F.in[I_NORM1] + k) * (1.0f + s);
        *(LAS f32x4*)(tab + which * D + k) = s;
    }
    {
        float* mv = (float*)(F.ws + WS_MODV);
        for (int i = F.vcu * (NWAVES * 64) + tid; i < 2 * MODN; i += F.G * NWAVES * 64) { const int isc = i / MODN, col = i % MODN;
            float s = *(const GAS float*)(F.in[I_BADA] + col);
#pragma unroll
            for (int p = 0; p < NKC; ++p) s += *(const GAS float*)(mp + (size_t)(p * 2 + isc) * MODN + col);
            *(GAS float*)(mv + i) = s; }
    }
    __syncthreads();
    f32x4 v1[16];
#define MK_P1_SRC(m_) ((m_) < T ? F.in[I_X] + (size_t)(m_) * D : F.in[I_CTX] + (size_t)((m_) - T) * D)
#define MK_P1_FIN(v_, m_) do { if ((m_) < T) norm_row_finish(v_, A1 + (size_t)(m_) * D, tab, tab + D, lane); else norm_row_finish(v_, A1 + (size_t)(m_) * D, tab + 2 * D, tab + 3 * D, lane); } while (0)
    for (int m = gw; m < TT; m += 2 * NGW) {
        const int m2 = m + NGW, m3 = m2 + NGW;
        if (m2 < TT) norm_row_load(MK_P1_SRC(m2), lane, v1);
        MK_P1_FIN(v0, m);
        if (m2 < TT) { if (m3 < TT) norm_row_load(MK_P1_SRC(m3), lane, v0); MK_P1_FIN(v1, m2); }
    }
#undef MK_P1_SRC
#undef MK_P1_FIN
    __syncthreads();
}
__device__ __forceinline__ void p10_norm2(Frame& F) {
    const int lane = pg8::mk_lane(), tid = F.wave * 64 + lane;
    LAS float* tab = (LAS float*)(F.lds + RING_OFF);
    const float* mv = (const float*)(F.ws + WS_MODV);
    const int gw = F.vcu * NWAVES + F.wave, NGW = F.G * NWAVES;
    bf16* A1 = (bf16*)(F.ws + WS_A1); const float* X1 = (const float*)(F.ws + WS_X1);
    f32x4 v0[16], v1[16];
    if (gw < T) norm_row_load(X1 + (size_t)gw * D, lane, v0);
    for (int i = tid; i < 2 * D; i += NWAVES * 64) { const int part = i >> 12, k = i & (D - 1);
        tab[i] = part == 0 ? *(const GAS float*)(F.in[I_NORM2] + k) * (1.0f + *(const GAS float*)(mv + 4 * D + k)) : *(const GAS float*)(mv + 3 * D + k); }
    __syncthreads();
    for (int m = gw; m < T; m += 2 * NGW) {
        const int m2 = m + NGW, m3 = m2 + NGW;
        if (m2 < T) norm_row_load(X1 + (size_t)m2 * D, lane, v1);
        asm volatile("" ::: "memory");
        norm_row_finish(v0, A1 + (size_t)m * D, tab, tab + D, lane);
        asm volatile("" ::: "memory");
        if (m2 < T) { if (m3 < T) norm_row_load(X1 + (size_t)m3 * D, lane, v0); asm volatile("" ::: "memory"); norm_row_finish(v1, A1 + (size_t)m2 * D, tab, tab + D, lane); asm volatile("" ::: "memory"); }
    }
    __syncthreads();
}
__device__ __forceinline__ void p13_final(Frame& F) {
    const int lane = pg8::mk_lane();
    const int gw = F.vcu * NWAVES + F.wave, NGW = F.G * NWAVES;
    f32x4 v0[16], v1[16];
#define MK_P13_FIN(v_, m_) do { float s_ = 0.f; _Pragma("unroll") for (int j = 0; j < 16; ++j) s_ += (v_[j].x * v_[j].x + v_[j].y * v_[j].y) + (v_[j].z * v_[j].z + v_[j].w * v_[j].w); \
        const float rstd_ = 1.0f / sqrtf(wave_sum(s_) * (1.f / D) + NORM_EPS); GAS f32x4* xo_ = (GAS f32x4*)(F.out + (size_t)(m_) * D) + lane; \
        _Pragma("unroll") for (int j = 0; j < 16; ++j) xo_[64 * j] = v_[j] * rstd_ * *((const GAS f32x4*)F.in[I_NORMF] + lane + 64 * j); } while (0)
    if (gw < T) norm_row_load(F.out + (size_t)gw * D, lane, v0);
    for (int m = gw; m < T; m += 2 * NGW) {
        const int m2 = m + NGW, m3 = m2 + NGW;
        if (m2 < T) norm_row_load(F.out + (size_t)m2 * D, lane, v1);
        MK_P13_FIN(v0, m);
        if (m2 < T) { if (m3 < T) norm_row_load(F.out + (size_t)m3 * D, lane, v0); MK_P13_FIN(v1, m2); }
    }
#undef MK_P13_FIN
}

__device__ __forceinline__ void ld8(const bf16* p, float (&f)[8]) { const v4u r = *(const GAS v4u*)p;
    f[0] = bflo(r.x); f[1] = bfhi(r.x); f[2] = bflo(r.y); f[3] = bfhi(r.y); f[4] = bflo(r.z); f[5] = bfhi(r.z); f[6] = bflo(r.w); f[7] = bfhi(r.w); }
__device__ __forceinline__ void ldf8(const float* p, float (&f)[8]) { const f32x4 a = *(const GAS f32x4*)p, b = *(const GAS f32x4*)(p + 4);
    f[0] = a.x; f[1] = a.y; f[2] = a.z; f[3] = a.w; f[4] = b.x; f[5] = b.y; f[6] = b.z; f[7] = b.w; }
__device__ __forceinline__ void stf8(float* p, const float (&f)[8]) { *(GAS f32x4*)p = (f32x4){f[0], f[1], f[2], f[3]}; *(GAS f32x4*)(p + 4) = (f32x4){f[4], f[5], f[6], f[7]}; }
__device__ __forceinline__ void stb8(bf16* p, const float (&f)[8]) { v4u o; o.x = pk2(f[0], f[1]); o.y = pk2(f[2], f[3]); o.z = pk2(f[4], f[5]); o.w = pk2(f[6], f[7]); *(GAS v4u*)p = o; }
__device__ __forceinline__ void za8(const bf16* Z, int row, bool hp, bool hn, int c, const float* mu, float (&o)[8]) {
    float zc[8], zp[8], zn[8], m8[8];
    ld8(Z + (size_t)row * NZ + c, zc);
    if (hp) ld8(Z + (size_t)(row - 1) * NZ + c, zp); else { _Pragma("unroll") for (int i = 0; i < 8; ++i) zp[i] = 0.f; }
    if (hn) ld8(Z + (size_t)(row + 1) * NZ + c, zn); else { _Pragma("unroll") for (int i = 0; i < 8; ++i) zn[i] = 0.f; }
    ldf8(mu + c, m8);
#pragma unroll
    for (int i = 0; i < 8; ++i) o[i] = zc[i] + m8[i] * (0.5f * (zp[i] + zn[i]) - zc[i]);
}
__device__ __forceinline__ void zero8(float (&f)[8]) {
#pragma unroll
    for (int i = 0; i < 8; ++i) f[i] = 0.f; }
__device__ __forceinline__ void cp8(float (&d)[8], const float (&s)[8]) {
#pragma unroll
    for (int i = 0; i < 8; ++i) d[i] = s[i]; }
__device__ __forceinline__ void p3_prep(Frame& F) {
    const bf16* Z = (const bf16*)(F.ws + WS_Z);
    bf16* KB = (bf16*)(F.ws + WS_KBUF); bf16* KKB = (bf16*)(F.ws + WS_KKBUF); bf16* RB = (bf16*)(F.ws + WS_RBUF); bf16* VB = (bf16*)(F.ws + WS_VBUF);
    bf16* AL = (bf16*)(F.ws + WS_ALORA); bf16* AG = (bf16*)(F.ws + WS_AGATE); bf16* CAT = (bf16*)(F.ws + WS_CAT);
    const float* mu = F.in[I_MU];
    const int tpb = (TT + F.G - 1) / F.G;
    const int tok0 = F.vcu * tpb, half0 = (tpb + 1) / 2;
    const int lane = pg8::mk_lane();
    for (int it = F.wave; it < 36; it += NWAVES) {
        const int type = it >> 1, hf = it & 1;
        int tA = tok0 + (hf ? half0 : 0), tB = tok0 + (hf ? tpb : half0);
        if (tB > TT) tB = TT;
        if (tA >= tB) continue;
        if (type < 14) {
            int zoff, c = 0; bool act = true;
            if (type < 12) { const int kind = type >> 2; c = (type & 3) * 512 + lane * 8; zoff = (kind == 0 ? OFF_K : (kind == 1 ? OFF_V : OFF_R)) + c; }
            else if (type == 12) { act = lane < 24; zoff = OFF_WL + (act ? lane : 0) * 8; }
            else { act = lane < 32; zoff = OFF_GL + (act ? lane : 0) * 8; }
            float m8[8], kk8[8]; ldf8(mu + zoff, m8);
            if (type < 4) ldf8(F.in[I_KK] + c, kk8); else zero8(kk8);
            float zp[8], zc[8], zn[8], znn[8];
            if (tA > 0) ld8(Z + (size_t)(tA - 1) * NZ + zoff, zp); else zero8(zp);
            ld8(Z + (size_t)tA * NZ + zoff, zc);
            if (tA + 1 < TT) ld8(Z + (size_t)(tA + 1) * NZ + zoff, zn); else zero8(zn);
            for (int t = tA; t < tB; ++t) {
                if (t + 2 < TT) ld8(Z + (size_t)(t + 2) * NZ + zoff, znn); else zero8(znn);
                const bool isctx = t >= T; const int pos = isctx ? t - T : (t & 63);
                const bool hp = pos > 0, hn = isctx ? (pos < CTXL - 1) : (pos < 63);
                float v[8];
#pragma unroll
                for (int i = 0; i < 8; ++i) v[i] = zc[i] + m8[i] * (0.5f * ((hp ? zp[i] : 0.f) + (hn ? zn[i] : 0.f)) - zc[i]);
                const size_t fo = (size_t)t * 2048 + c;
                if (type < 4) {
                    stb8(KB + fo, v);
                    float q[8]; float ss = 0.f;
#pragma unroll
                    for (int i = 0; i < 8; ++i) { q[i] = v[i] * kk8[i]; ss += q[i] * q[i]; }
                    ss += __shfl_xor(ss, 1); ss += __shfl_xor(ss, 2); ss += __shfl_xor(ss, 4);
                    const float inv = 1.0f / fmaxf(sqrtf(ss), 1e-12f);
#pragma unroll
                    for (int i = 0; i < 8; ++i) q[i] *= inv;
                    stb8(KKB + fo, q);
                } else if (type < 8) stb8(VB + fo, v);
                else if (type < 12) { if (!isctx) stb8(RB + fo, v); }
                else if (type == 12) {
                    if (lane < 32) { float o[8];
                        if (lane < 12) { _Pragma("unroll") for (int i = 0; i < 8; ++i) o[i] = tanhf(v[i]); }
                        else if (lane < 24) cp8(o, v);
                        else zero8(o);
                        stb8(AL + (size_t)t * KLORA + lane * 8, o); }
                } else { if (!isctx && lane < 32) { float o[8];
#pragma unroll
                        for (int i = 0; i < 8; ++i) o[i] = sigm(v[i]);
                        stb8(AG + (size_t)t * KGATE + lane * 8, o); } }
                cp8(zp, zc); cp8(zc, zn); cp8(zn, znn);
            }
        } else {
            if (tA >= T) continue;
            if (tB > T) tB = T;
            const int c = (type - 14) * 512 + lane * 8;
            float w0[8], w1[8], w2[8];
            ldf8(F.in[I_CONVW] + c, w0); ldf8(F.in[I_CONVW] + 2048 + c, w1); ldf8(F.in[I_CONVW] + 4096 + c, w2);
            float up[8], uc[8], un[8], ca[8], xa[8], cb[8], xb[8], bg[8], bgn[8];
            if (tA > 0) { ld8(Z + (size_t)(tA - 1) * NZ + OFF_CC + c, ca); ld8(Z + (size_t)(tA - 1) * NZ + OFF_CX + c, xa); _Pragma("unroll") for (int i = 0; i < 8; ++i) up[i] = ca[i] * xa[i]; } else zero8(up);
            ld8(Z + (size_t)tA * NZ + OFF_CC + c, ca); ld8(Z + (size_t)tA * NZ + OFF_CX + c, xa);
#pragma unroll
            for (int i = 0; i < 8; ++i) uc[i] = ca[i] * xa[i];
            ld8(Z + (size_t)tA * NZ + OFF_CB + c, bg);
            if (tA + 1 < T) { ld8(Z + (size_t)(tA + 1) * NZ + OFF_CC + c, ca); ld8(Z + (size_t)(tA + 1) * NZ + OFF_CX + c, xa); } else { zero8(ca); zero8(xa); }
            for (int t = tA; t < tB; ++t) {
                if (t + 2 < T) { ld8(Z + (size_t)(t + 2) * NZ + OFF_CC + c, cb); ld8(Z + (size_t)(t + 2) * NZ + OFF_CX + c, xb); } else { zero8(cb); zero8(xb); }
                if (t + 1 < T) ld8(Z + (size_t)(t + 1) * NZ + OFF_CB + c, bgn); else zero8(bgn);
                const int pos = t & 63; const bool hp = pos > 0, hn = pos < 63;
                float y[8];
#pragma unroll
                for (int i = 0; i < 8; ++i) { un[i] = ca[i] * xa[i]; y[i] = bg[i] * (w0[i] * (hp ? up[i] : 0.f) + w1[i] * uc[i] + w2[i] * (hn ? un[i] : 0.f)); }
                stb8(CAT + (size_t)t * D + DR + c, y);
                cp8(up, uc); cp8(uc, un); cp8(ca, cb); cp8(xa, xb); cp8(bg, bgn);
            }
        }
    }
}

typedef float f32x16 __attribute__((ext_vector_type(16)));
#define MK_FENCE() asm volatile("" ::: "memory")
constexpr int REC_BYTES = 8448, NBLK = TT / 16, SCAN_LDS = REC_BYTES + 4096;
__device__ __forceinline__ void swap32(float& x, float& y) { asm volatile("s_nop 1\n\tv_permlane32_swap_b32 %0, %1\n\ts_nop 1" : "+v"(x), "+v"(y)); }
__device__ __forceinline__ int kperm(int k) { return ((((k >> 5) * 2 + ((k >> 4) & 1)) * 2 + ((k >> 2) & 1)) * 8 + ((k >> 3) & 1) * 4 + (k & 3)); }
__device__ __forceinline__ int scan_blkbase(int d, int c, int j) {
    if (c == 0) return T + (d == 0 ? 16 * j : CTXL - 16 - 16 * j);
    const int p0 = (c - 1) * CHUNK + 16 * j;
    return d == 0 ? p0 : T - 16 - p0;
}
__device__ __forceinline__ void scan_vec32(const LAS unsigned char* row, int hl, float (&f)[32]) {
#pragma unroll
    for (int q = 0; q < 4; ++q) { const v4u w = *(const LAS v4u*)(row + (q * 2 + hl) * 16);
        f[8 * q + 0] = bflo(w.x); f[8 * q + 1] = bfhi(w.x); f[8 * q + 2] = bflo(w.y); f[8 * q + 3] = bfhi(w.y); f[8 * q + 4] = bflo(w.z); f[8 * q + 5] = bfhi(w.z); f[8 * q + 6] = bflo(w.w); f[8 * q + 7] = bfhi(w.w); }
}
__device__ __forceinline__ void scan_matvec(const f32x16 (&Tt)[2][2], const float (&f)[32], float& sa) {
    float p0a = 0.f, p0b = 0.f, p1a = 0.f, p1b = 0.f;
#pragma unroll
    for (int I = 0; I < 2; ++I)
#pragma unroll
        for (int r = 0; r < 16; r += 2) { p0a += Tt[I][0][r] * f[16 * I + r]; p1a += Tt[I][1][r] * f[16 * I + r]; p0b += Tt[I][0][r + 1] * f[16 * I + r + 1]; p1b += Tt[I][1][r + 1] * f[16 * I + r + 1]; }
    float p0 = p0a + p0b, p1 = p1a + p1b;
    swap32(p0, p1);
    sa = p0 + p1;
}
__device__ __forceinline__ void scan_renorm(f32x16 (&Tt)[2][2], const LAS float* ge, int hl) {
#pragma unroll
    for (int I = 0; I < 2; ++I)
#pragma unroll
        for (int qd = 0; qd < 4; ++qd) { const f32x4 g = *(const LAS f32x4*)(ge + 32 * I + 8 * qd + 4 * hl);
#pragma unroll
            for (int e = 0; e < 4; ++e) { Tt[I][0][4 * qd + e] *= g[e]; Tt[I][1][4 * qd + e] *= g[e]; } }
}
__device__ __forceinline__ void scan_store_T(const f32x16 (&Tt)[2][2], float* dst, int lane) {
#pragma unroll
    for (int I = 0; I < 2; ++I)
#pragma unroll
        for (int J = 0; J < 2; ++J)
#pragma unroll
            for (int reg = 0; reg < 16; ++reg) *(GAS float*)(dst + (32 * I + 8 * (reg >> 2) + 4 * (lane >> 5) + (reg & 3)) * 64 + 32 * J + (lane & 31)) = Tt[I][J][reg];
}
typedef short bf16x8 __attribute__((ext_vector_type(8)));
#define MK_MFMA(a, b, c) __builtin_amdgcn_mfma_f32_32x32x16_bf16((a), (b), (c), 0, 0, 0)
constexpr int SCR_LAB = 0, SCR_LAK = 1024, SCR_MRB = 2048, SCR_MRK = 2560, SCAN_SCR = 3072;
struct RecRegs { v4u p[8]; float ge; };
__device__ __forceinline__ void scan_rload(const unsigned char* PKB, int d, int h, int tb, int lane, RecRegs& R) {
    const GAS unsigned char* rp = (const GAS unsigned char*)PKB + ((size_t)(d * 32 + h) * NBLK + (tb >> 4)) * REC_BYTES;
#pragma unroll
    for (int j = 0; j < 8; ++j) R.p[j] = *((const GAS v4u*)rp + 64 * j + lane);
    R.ge = *((const GAS float*)(rp + 8192) + lane);
}
__device__ __forceinline__ void scan_rstore(LAS unsigned char* buf, int lane, const RecRegs& R) {
#pragma unroll
    for (int j = 0; j < 8; ++j) *((LAS v4u*)buf + 64 * j + lane) = R.p[j];
    *((LAS float*)(buf + 8192) + lane) = R.ge;
}
typedef float f32x2n __attribute__((ext_vector_type(2)));
typedef __bf16 bf16x2n __attribute__((ext_vector_type(2)));
__device__ __forceinline__ unsigned cvt2bf(float a, float b) { const f32x2n v = {a, b}; return __builtin_bit_cast(unsigned, __builtin_convertvector(v, bf16x2n)); }
__device__ __forceinline__ bf16x8 pack8(float a0, float a1, float a2, float a3, float a4, float a5, float a6, float a7) {
    const v4u u = {cvt2bf(a0, a1), cvt2bf(a2, a3), cvt2bf(a4, a5), cvt2bf(a6, a7)}; return __builtin_bit_cast(bf16x8, u); }
__device__ __forceinline__ f32x16 zero16() { f32x16 z;
#pragma unroll
    for (int i = 0; i < 16; ++i) z[i] = 0.f;
    return z; }
__device__ __forceinline__ void scan_tfrags(const f32x16 (&Tt)[2][2], bf16x8 (&Tf)[2][2][2]) {
#pragma unroll
    for (int I = 0; I < 2; ++I)
#pragma unroll
        for (int J = 0; J < 2; ++J)
#pragma unroll
            for (int s = 0; s < 2; ++s) Tf[I][J][s] = pack8(Tt[I][J][8 * s], Tt[I][J][8 * s + 1], Tt[I][J][8 * s + 2], Tt[I][J][8 * s + 3], Tt[I][J][8 * s + 4], Tt[I][J][8 * s + 5], Tt[I][J][8 * s + 6], Tt[I][J][8 * s + 7]);
}
__device__ __forceinline__ void scan_sfrags(float (&S)[16], bf16x8 (&Sf)[2]) {
#pragma unroll
    for (int j = 0; j < 8; ++j) swap32(S[j], S[j + 8]);
    Sf[0] = pack8(S[0], S[1], S[2], S[3], S[4], S[5], S[6], S[7]); Sf[1] = pack8(S[8], S[9], S[10], S[11], S[12], S[13], S[14], S[15]);
}
template <int WHICH> __device__ __forceinline__ void p5_pass(Frame& F, const int unit) {
    const unsigned char* PKB = F.ws + WS_PK; const bf16* VB = (const bf16*)(F.ws + WS_VBUF);
    float* PU = (float*)(F.ws + WS_PU);
    LAS unsigned char* my = F.lds + RING_OFF + F.wave * (REC_BYTES + SCAN_SCR);
    LAS unsigned char* scr = my + REC_BYTES;
    {
        const int d = unit & 1, h = (unit >> 1) & 31, c = unit >> 6;
        constexpr int which = WHICH;
        {
            const int lane = pg8::mk_lane(), hl = lane >> 5, l31 = lane & 31, l15 = lane & 15;
            const float idv = which ? 1.0f : 0.0f;
            f32x16 Tt[2][2];
#pragma unroll
            for (int I = 0; I < 2; ++I)
#pragma unroll
                for (int J = 0; J < 2; ++J)
#pragma unroll
                    for (int reg = 0; reg < 16; ++reg) Tt[I][J][reg] = (32 * I + 8 * (reg >> 2) + 4 * hl + (reg & 3) == 32 * J + l31) ? idv : 0.0f;
            RecRegs R;
            scan_rload(PKB, d, h, scan_blkbase(d, c, 0), lane, R);
#pragma unroll 1
            for (int j = 0; j < 16; ++j) {
                const int tb = scan_blkbase(d, c, j);
                scan_rstore(my, lane, R);
                float Vv[16];
                if (which == 0) { const GAS bf16* gv = (const GAS bf16*)(VB + (size_t)(tb + (d == 0 ? 0 : 15)) * 2048 + h * 64) + lane; const int dstep = d == 0 ? 2048 : -2048;
#pragma unroll
                    for (int t = 0; t < 16; ++t) Vv[t] = __builtin_bit_cast(float, (unsigned)gv[t * dstep] << 16); }
                else {
#pragma unroll
                    for (int t = 0; t < 16; ++t) Vv[t] = 0.f; }
                const LAS unsigned char* arow = my + l15 * 128 + hl * 16;
                {   f32x16 Lab = zero16(), Lak = zero16();
#pragma unroll
                    for (int qq = 0; qq < 4; ++qq) { const bf16x8 af = *(const LAS bf16x8*)(arow + qq * 32), bf = *(const LAS bf16x8*)(arow + 4096 + qq * 32), kf = *(const LAS bf16x8*)(arow + 6144 + qq * 32);
                        Lab = MK_MFMA(af, bf, Lab); if (which == 0) Lak = MK_MFMA(af, kf, Lak); }
                    if (l31 < 16) { LAS float* lb = (LAS float*)scr + 64 * hl + l31;
#pragma unroll
                        for (int r = 0; r < 8; ++r) { const int t0 = 8 * (r >> 2) + (r & 3); lb[SCR_LAB / 4 + t0 * 16] = Lab[r]; lb[SCR_LAK / 4 + t0 * 16] = Lak[r]; } }
                }
                MK_FENCE();
                f32x16 G[2];
                {   bf16x8 Tf[2][2][2]; scan_tfrags(Tt, Tf);
                    G[0] = zero16(); G[1] = zero16();
#pragma unroll
                    for (int qq = 0; qq < 4; ++qq) { const bf16x8 af = *(const LAS bf16x8*)(arow + qq * 32);
                        G[0] = MK_MFMA(af, Tf[qq >> 1][0][qq & 1], G[0]); G[1] = MK_MFMA(af, Tf[qq >> 1][1][qq & 1], G[1]); }
                }
                MK_FENCE();
                if (j + 1 < 16) scan_rload(PKB, d, h, scan_blkbase(d, c, j + 1), lane, R);
                float S[16];
#pragma unroll
                for (int r = 0; r < 8; ++r) { float x = G[0][r], y = G[1][r]; swap32(x, y); const int t = 8 * (r >> 2) + (r & 3); S[t] = x; S[t + 4] = y; }
#pragma unroll
                for (int t = 1; t < 16; ++t) {
                    float acc = S[t], acc1 = 0.f, acc2 = 0.f, acc3 = 0.f;
#pragma unroll
                    for (int s4 = 0; s4 < (t + 3) / 4; ++s4) { const f32x4 la = *(const LAS f32x4*)(scr + SCR_LAB + (t * 16 + 4 * s4) * 4), lk = *(const LAS f32x4*)(scr + SCR_LAK + (t * 16 + 4 * s4) * 4);
#pragma unroll
                        for (int e = 0; e < 4; ++e) if (4 * s4 + e < t) { if (e & 1) acc1 += la[e] * S[4 * s4 + e]; else acc += la[e] * S[4 * s4 + e];
                            if (which == 0) { if (e & 1) acc3 += lk[e] * Vv[4 * s4 + e]; else acc2 += lk[e] * Vv[4 * s4 + e]; } } }
                    S[t] = (acc + acc1) + (acc2 + acc3);
                }
                bf16x8 Sf[2], Vf[2]; scan_sfrags(S, Sf); if (which == 0) scan_sfrags(Vv, Vf);
#pragma unroll
                for (int I = 0; I < 2; ++I) {
                    const LAS unsigned char* col = my + 4096 + (8 * hl) * 128 + kperm(32 * I + l31) * 2;
                    unsigned short bs[8], ks[8];
#pragma unroll
                    for (int e = 0; e < 8; ++e) { bs[e] = *(const LAS unsigned short*)(col + e * 128); ks[e] = *(const LAS unsigned short*)(col + 2048 + e * 128); }
                    const v4u bu = {(unsigned)bs[0] | ((unsigned)bs[1] << 16), (unsigned)bs[2] | ((unsigned)bs[3] << 16), (unsigned)bs[4] | ((unsigned)bs[5] << 16), (unsigned)bs[6] | ((unsigned)bs[7] << 16)};
                    const v4u ku = {(unsigned)ks[0] | ((unsigned)ks[1] << 16), (unsigned)ks[2] | ((unsigned)ks[3] << 16), (unsigned)ks[4] | ((unsigned)ks[5] << 16), (unsigned)ks[6] | ((unsigned)ks[7] << 16)};
                    const bf16x8 ba = __builtin_bit_cast(bf16x8, bu), ka = __builtin_bit_cast(bf16x8, ku);
                    Tt[I][0] = MK_MFMA(ba, Sf[0], Tt[I][0]); Tt[I][1] = MK_MFMA(ba, Sf[1], Tt[I][1]); if (which == 0) { Tt[I][0] = MK_MFMA(ka, Vf[0], Tt[I][0]); Tt[I][1] = MK_MFMA(ka, Vf[1], Tt[I][1]); }
                }
                scan_renorm(Tt, (const LAS float*)(my + 8192), hl);
            }
            scan_store_T(Tt, PU + ((size_t)unit * 2 + (which ? 0 : 1)) * 4096, lane);
        }
    }
}
__device__ __forceinline__ void p5_scanA(Frame& F) {
    for (int unit = F.vcu * NWAVES + F.wave; unit < 2048; unit += F.G * NWAVES) { p5_pass<0>(F, unit); if (unit >= 64) p5_pass<1>(F, unit); }
}
__device__ __forceinline__ void p6_scanB(Frame& F) {
    const GAS char* PU = (const GAS char*)(F.ws + WS_PU); GAS char* SST = (GAS char*)(F.ws + WS_SST);
    LAS float* PiB = (LAS float*)(F.lds + RING_OFF);
    LAS float* TbB = (LAS float*)(F.lds + RING_OFF + 2 * 16640);
    const int w = F.wave;
    for (int q = F.vcu; q < 64; q += F.G) {
        const unsigned lane = (unsigned)pg8::mk_lane(), tid = (unsigned)w * 64u + lane, hl = lane >> 5, l31 = lane & 31u;
        const unsigned I1 = ((unsigned)w >> 1) & 1u, J = (unsigned)w & 1u;
        {   const GAS char* u0 = PU + ((size_t)q * 2 + 1) * 16384; GAS char* so = SST + ((size_t)q * NCHUNK + 1) * 16384;
            const f32x4 t0 = *(const GAS f32x4*)(u0 + tid * 32u), t1 = *(const GAS f32x4*)(u0 + tid * 32u + 16u);
            *((LAS f32x4*)TbB + tid * 2) = t0; *((LAS f32x4*)TbB + tid * 2 + 1) = t1;
            *(GAS f32x4*)(so + tid * 32u) = t0; *(GAS f32x4*)(so + tid * 32u + 16u) = t1; }
        f32x4 pn0, pn1; f32x16 un;
        {   const GAS char* pg = PU + (((size_t)q + 64) * 2 + 0) * 16384; pn0 = *(const GAS f32x4*)(pg + tid * 32u); pn1 = *(const GAS f32x4*)(pg + tid * 32u + 16u);
            const unsigned pb = (tid >> 3) * 65u + (tid & 7u) * 8u;
#pragma unroll
            for (int e = 0; e < 4; ++e) { PiB[pb + e] = pn0[e]; PiB[pb + 4 + e] = pn1[e]; }
            const GAS char* ug = PU + (((size_t)q + 64) * 2 + 1) * 16384;
#pragma unroll
            for (int r = 0; r < 16; ++r) un[r] = (w < 4) ? *(const GAS float*)(ug + ((32u * I1 + 8u * (r >> 2) + 4u * hl + (r & 3)) * 64u + 32u * J + l31) * 4u) : 0.f; }
        __syncthreads();
        for (int c = 1; c < 32; ++c) {
            const LAS float* Pi = PiB + ((c - 1) & 1) * 4160; const LAS float* Tb = TbB + ((c - 1) & 1) * 4096;
            LAS float* PiN = PiB + (c & 1) * 4160; LAS float* TbN = TbB + (c & 1) * 4096;
            f32x16 acc = un;
            if (c + 1 < 32) {
                const GAS char* pg = PU + (((size_t)q + 64 * (c + 1)) * 2 + 0) * 16384; pn0 = *(const GAS f32x4*)(pg + tid * 32u); pn1 = *(const GAS f32x4*)(pg + tid * 32u + 16u);
                const GAS char* ug = PU + (((size_t)q + 64 * (c + 1)) * 2 + 1) * 16384;
                if (w < 4) {
#pragma unroll
                    for (int r = 0; r < 16; ++r) un[r] = *(const GAS float*)(ug + ((32u * I1 + 8u * (r >> 2) + 4u * hl + (r & 3)) * 64u + 32u * J + l31) * 4u); }
            }
            if (w < 4) {
#pragma unroll
                for (int s2 = 0; s2 < 32; ++s2) { const float av = Pi[(32u * I1 + l31) * 65u + 2u * s2 + hl], bv = Tb[(2u * s2 + hl) * 64u + 32u * J + l31];
                    acc = __builtin_amdgcn_mfma_f32_32x32x2f32(av, bv, acc, 0, 0, 0);
                    if ((s2 & 7) == 7) MK_FENCE(); }
                GAS char* so = SST + ((size_t)q * NCHUNK + c + 1) * 16384;
#pragma unroll
                for (int r = 0; r < 16; ++r) { const unsigned e = (32u * I1 + 8u * (r >> 2) + 4u * hl + (r & 3)) * 64u + 32u * J + l31; TbN[e] = acc[r]; *(GAS float*)(so + e * 4u) = acc[r]; }
            }
            if (c + 1 < 32) { const unsigned pb = (tid >> 3) * 65u + (tid & 7u) * 8u;
#pragma unroll
                for (int e = 0; e < 4; ++e) { PiN[pb + e] = pn0[e]; PiN[pb + 4 + e] = pn1[e]; } }
            __syncthreads();
        }
    }
}
__device__ __forceinline__ void p7_scanC(Frame& F) {
    const unsigned char* PKB = F.ws + WS_PK; const bf16* VB = (const bf16*)(F.ws + WS_VBUF);
    const float* SST = (const float*)(F.ws + WS_SST); float* YS = (float*)(F.ws + WS_YS);
    LAS unsigned char* my = F.lds + RING_OFF + F.wave * (REC_BYTES + SCAN_SCR);
    LAS unsigned char* scr = my + REC_BYTES;
    for (int unit = F.vcu * NWAVES + F.wave; unit < 2048; unit += F.G * NWAVES) {
        const int d = unit & 1, h = (unit >> 1) & 31, c = (unit >> 6) + 1, q = unit & 63;
        const int lane = pg8::mk_lane(), hl = lane >> 5, l31 = lane & 31, l15 = lane & 15;
        f32x16 Tt[2][2];
        {   const float* s0 = SST + ((size_t)q * NCHUNK + c) * 4096;
#pragma unroll
            for (int I = 0; I < 2; ++I)
#pragma unroll
                for (int J = 0; J < 2; ++J)
#pragma unroll
                    for (int reg = 0; reg < 16; ++reg) Tt[I][J][reg] = *(const GAS float*)(s0 + (32 * I + 8 * (reg >> 2) + 4 * hl + (reg & 3)) * 64 + 32 * J + l31); }
        RecRegs R;
        scan_rload(PKB, d, h, scan_blkbase(d, c, 0), lane, R);
#pragma unroll 1
        for (int j = 0; j < 16; ++j) {
            const int tb = scan_blkbase(d, c, j);
            scan_rstore(my, lane, R);
            float Vv[16];
            {   const GAS bf16* gv = (const GAS bf16*)(VB + (size_t)(tb + (d == 0 ? 0 : 15)) * 2048 + h * 64) + lane; const int dstep = d == 0 ? 2048 : -2048;
#pragma unroll
                for (int t = 0; t < 16; ++t) Vv[t] = __builtin_bit_cast(float, (unsigned)gv[t * dstep] << 16); }
            const LAS unsigned char* arow = my + l15 * 128 + hl * 16;
            {   f32x16 Lab = zero16(), Lak = zero16(), Mrb = zero16(), Mrk = zero16();
#pragma unroll
                for (int qq = 0; qq < 4; ++qq) { const bf16x8 af = *(const LAS bf16x8*)(arow + qq * 32), rf = *(const LAS bf16x8*)(arow + 2048 + qq * 32), bf = *(const LAS bf16x8*)(arow + 4096 + qq * 32), kf = *(const LAS bf16x8*)(arow + 6144 + qq * 32);
                    Lab = MK_MFMA(af, bf, Lab); Lak = MK_MFMA(af, kf, Lak); Mrb = MK_MFMA(rf, bf, Mrb); Mrk = MK_MFMA(rf, kf, Mrk); }
                if (l31 < 16) {
                    LAS float* lb = (LAS float*)scr + 64 * hl + l31; LAS unsigned short* mb = (LAS unsigned short*)scr + 64 * hl + l31; const int lm = l31 - 4 * hl;
#pragma unroll
                    for (int r = 0; r < 8; ++r) { const int t0 = 8 * (r >> 2) + (r & 3);
                        lb[SCR_LAB / 4 + t0 * 16] = Lab[r]; lb[SCR_LAK / 4 + t0 * 16] = Lak[r];
                        mb[SCR_MRB / 2 + t0 * 16] = (unsigned short)f2bf(lm <= t0 ? Mrb[r] : 0.f); mb[SCR_MRK / 2 + t0 * 16] = (unsigned short)f2bf(lm <= t0 ? Mrk[r] : 0.f); }
                }
            }
            MK_FENCE();
            f32x16 G[2], Y[2];
            {   bf16x8 Tf[2][2][2]; scan_tfrags(Tt, Tf);
                G[0] = zero16(); G[1] = zero16(); Y[0] = zero16(); Y[1] = zero16();
#pragma unroll
                for (int qq = 0; qq < 4; ++qq) { const bf16x8 af = *(const LAS bf16x8*)(arow + qq * 32), rf = *(const LAS bf16x8*)(arow + 2048 + qq * 32);
                    G[0] = MK_MFMA(af, Tf[qq >> 1][0][qq & 1], G[0]); G[1] = MK_MFMA(af, Tf[qq >> 1][1][qq & 1], G[1]);
                    Y[0] = MK_MFMA(rf, Tf[qq >> 1][0][qq & 1], Y[0]); Y[1] = MK_MFMA(rf, Tf[qq >> 1][1][qq & 1], Y[1]); }
            }
            MK_FENCE();
            if (j + 1 < 16) scan_rload(PKB, d, h, scan_blkbase(d, c, j + 1), lane, R);
            float S[16];
#pragma unroll
            for (int r = 0; r < 8; ++r) { float x = G[0][r], y = G[1][r]; swap32(x, y); const int t = 8 * (r >> 2) + (r & 3); S[t] = x; S[t + 4] = y; }
#pragma unroll
            for (int t = 1; t < 16; ++t) {
                float acc = S[t], acc1 = 0.f, acc2 = 0.f, acc3 = 0.f;
#pragma unroll
                for (int s4 = 0; s4 < (t + 3) / 4; ++s4) { const f32x4 la = *(const LAS f32x4*)(scr + SCR_LAB + (t * 16 + 4 * s4) * 4), lk = *(const LAS f32x4*)(scr + SCR_LAK + (t * 16 + 4 * s4) * 4);
#pragma unroll
                    for (int e = 0; e < 4; ++e) if (4 * s4 + e < t) { if (e & 1) { acc1 += la[e] * S[4 * s4 + e]; acc3 += lk[e] * Vv[4 * s4 + e]; } else { acc += la[e] * S[4 * s4 + e]; acc2 += lk[e] * Vv[4 * s4 + e]; } } }
                S[t] = (acc + acc1) + (acc2 + acc3);
            }
            bf16x8 Sf[2], Vf[2]; scan_sfrags(S, Sf); scan_sfrags(Vv, Vf);
            {   const bf16x8 mb = *(const LAS bf16x8*)(scr + SCR_MRB + l15 * 32 + hl * 16), mk = *(const LAS bf16x8*)(scr + SCR_MRK + l15 * 32 + hl * 16);
                Y[0] = MK_MFMA(mb, Sf[0], Y[0]); Y[1] = MK_MFMA(mb, Sf[1], Y[1]); Y[0] = MK_MFMA(mk, Vf[0], Y[0]); Y[1] = MK_MFMA(mk, Vf[1], Y[1]); }
#pragma unroll
            for (int I = 0; I < 2; ++I) {
                const LAS unsigned char* col = my + 4096 + (8 * hl) * 128 + kperm(32 * I + l31) * 2;
                unsigned short bs[8], ks[8];
#pragma unroll
                for (int e = 0; e < 8; ++e) { bs[e] = *(const LAS unsigned short*)(col + e * 128); ks[e] = *(const LAS unsigned short*)(col + 2048 + e * 128); }
                const v4u bu = {(unsigned)bs[0] | ((unsigned)bs[1] << 16), (unsigned)bs[2] | ((unsigned)bs[3] << 16), (unsigned)bs[4] | ((unsigned)bs[5] << 16), (unsigned)bs[6] | ((unsigned)bs[7] << 16)};
                const v4u ku = {(unsigned)ks[0] | ((unsigned)ks[1] << 16), (unsigned)ks[2] | ((unsigned)ks[3] << 16), (unsigned)ks[4] | ((unsigned)ks[5] << 16), (unsigned)ks[6] | ((unsigned)ks[7] << 16)};
                const bf16x8 ba = __builtin_bit_cast(bf16x8, bu), ka = __builtin_bit_cast(bf16x8, ku);
                Tt[I][0] = MK_MFMA(ba, Sf[0], Tt[I][0]); Tt[I][1] = MK_MFMA(ba, Sf[1], Tt[I][1]); Tt[I][0] = MK_MFMA(ka, Vf[0], Tt[I][0]); Tt[I][1] = MK_MFMA(ka, Vf[1], Tt[I][1]);
            }
            {   GAS float* yb = (GAS float*)(YS + (size_t)d * T * 2048 + (size_t)(tb + (d == 0 ? 4 * hl : 15 - 4 * hl)) * 2048 + h * 64) + l31; const int ystep = d == 0 ? 2048 : -2048;
#pragma unroll
                for (int J = 0; J < 2; ++J)
#pragma unroll
                    for (int r = 0; r < 8; ++r) yb[(8 * (r >> 2) + (r & 3)) * ystep + 32 * J] = Y[J][r]; }
            scan_renorm(Tt, (const LAS float*)(my + 8192), hl);
        }
    }
}

__device__ __forceinline__ void p8_readout(Frame& F) {
    const bf16* RB = (const bf16*)(F.ws + WS_RBUF); const bf16* VB = (const bf16*)(F.ws + WS_VBUF); const float* YS = (const float*)(F.ws + WS_YS);
    const bf16* KD = (const bf16*)(F.ws + WS_KD);
    const bf16* G = (const bf16*)(F.ws + WS_G); bf16* CAT = (bf16*)(F.ws + WS_CAT);
    const int tpb = (T + F.G - 1) / F.G, tok0 = F.vcu * tpb, lane = pg8::mk_lane();
    for (int it = F.wave; it < tpb * 4; it += NWAVES) {
        const int j = it / tpb, tok = tok0 + it % tpb;
        if (tok >= T) continue;
        const int c = j * 512 + lane * 8;
        float y0[8], y1[8], y[8];
        ldf8(YS + (size_t)tok * 2048 + c, y0); ldf8(YS + ((size_t)T + tok) * 2048 + c, y1);
        float s = 0.f;
#pragma unroll
        for (int i = 0; i < 8; ++i) { y[i] = y0[i] + y1[i]; s += y[i]; }
        s += __shfl_xor(s, 1); s += __shfl_xor(s, 2); s += __shfl_xor(s, 4);
        const float mean = s * (1.0f / 64.0f); float q = 0.f;
#pragma unroll
        for (int i = 0; i < 8; ++i) { const float dlt = y[i] - mean; q += dlt * dlt; }
        q += __shfl_xor(q, 1); q += __shfl_xor(q, 2); q += __shfl_xor(q, 4);
        const float rstd = 1.0f / sqrtf(q * (1.0f / 64.0f) + LNX_EPS);
        float r8[8], v8[8], k0[8], k1[8], rk[8], lw[8], lb[8], g8[8];
        ld8(RB + (size_t)tok * 2048 + c, r8); ld8(VB + (size_t)tok * 2048 + c, v8);
        ld8(KD + (size_t)tok * 2048 + c, k0); ld8(KD + ((size_t)TT + tok) * 2048 + c, k1);
        ldf8(F.in[I_RK] + c, rk); ldf8(F.in[I_LNXW] + c, lw); ldf8(F.in[I_LNXB] + c, lb);
        ld8(G + (size_t)tok * 2048 + c, g8);
        float dot = 0.f;
#pragma unroll
        for (int i = 0; i < 8; ++i) dot += r8[i] * (k0[i] + k1[i]) * rk[i];
        dot += __shfl_xor(dot, 1); dot += __shfl_xor(dot, 2); dot += __shfl_xor(dot, 4);
        float o[8];
#pragma unroll
        for (int i = 0; i < 8; ++i) o[i] = ((y[i] - mean) * rstd * lw[i] + lb[i] + dot * v8[i]) * g8[i];
        stb8(CAT + (size_t)tok * D + c, o);
    }
}

template <int K> __device__ __forceinline__ void run_phase(Frame& F) {
    bf16* A1 = (bf16*)(F.ws + WS_A1); bf16* Zb = (bf16*)(F.ws + WS_Z);
    const float* MV = (const float*)(F.ws + WS_MODV);
    (void)A1; (void)Zb; (void)MV;
    asm volatile("; MK_PHASE %0" :: "i"(K) : "memory");
    if constexpr (K == 0) { p0_prologue(F);
    }
    if constexpr (K == 1) { p1_norm1(F);
    }
    if constexpr (K == 2) {
        { pg8::Gemm g{A1, (const bf16*)(F.ws + WS_WIN), T, NZ, D}; pg8::StaticOrder S; S.init(T, NZ, F.G, (int)blockIdx.x);
          pg8::EpiBf16<0> E{Zb, NZ, nullptr, 0, 0, 1.f};
          pg8::gemm_phase<pg8::EpiBf16<0>, pg8::StaticOrder, true, true>(F.lds + RING_OFF, g, S, E, F.wave); }
        { pg8::Gemm g{A1 + (size_t)T * D, (const bf16*)(F.ws + WS_WIN), CTXL, NCTXZ, D}; pg8::StaticOrder S; S.init(CTXL, NCTXZ, F.G, (int)((blockIdx.x + F.G - 64) % F.G));
          pg8::EpiBf16<0> E{Zb + (size_t)T * NZ, NZ, nullptr, 0, 0, 1.f};
          pg8::gemm_phase<pg8::EpiBf16<0>, pg8::StaticOrder, true, true>(F.lds + RING_OFF, g, S, E, F.wave); }
        tr_idle(F, P2T_B, P2T_E, (int)blockIdx.x - 81, 175);
    }
    if constexpr (K == 3) { p3_prep(F);
    }
    if constexpr (K == 4) {
        { int kl = KLORA; asm volatile("" : "+s"(kl));
          pg8::Gemm g{(const bf16*)(F.ws + WS_ALORA), (const bf16*)(F.ws + WS_WLORA), TT, NLORA, kl}; pg8::StaticOrder S; S.init(TT, NLORA, F.G, (int)blockIdx.x);
          pg8::EpiLora E{F.ws + WS_PK, (bf16*)(F.ws + WS_KD), (const bf16*)(F.ws + WS_KBUF), (const bf16*)(F.ws + WS_KKBUF), (const bf16*)(F.ws + WS_RBUF), F.in[I_W0], F.in[I_A0], F.in[I_KA], TT};
          pg8::gemm_phase<pg8::EpiLora, pg8::StaticOrder, true, true>(F.lds + RING_OFF, g, S, E, F.wave); }
        { int kl = KGATE; asm volatile("" : "+s"(kl));
          pg8::Gemm g{(const bf16*)(F.ws + WS_AGATE), (const bf16*)(F.ws + WS_WGATE), T, DR, kl}; pg8::StaticOrder S; S.init(T, DR, F.G, (int)blockIdx.x);
          pg8::EpiBf16<0> E{(bf16*)(F.ws + WS_G), DR, nullptr, 0, 0, 1.f};
          pg8::gemm_phase<pg8::EpiBf16<0>, pg8::StaticOrder, true, true>(F.lds + RING_OFF, g, S, E, F.wave); }

    }
    if constexpr (K == 5) { p5_scanA(F);
    }
    if constexpr (K == 6) { p6_scanB(F); tr_idle(F, P6T_B, P6T_E, F.vcu - 64, 192);

    }
    if constexpr (K == 7) { p7_scanC(F);
    }
    if constexpr (K == 8) { p8_readout(F);
    }
    if constexpr (K == 9) {
        pg8::Gemm g{(const bf16*)(F.ws + WS_CAT), (const bf16*)(F.ws + WS_WOUT), T, D, D}; pg8::StaticOrder S; S.init(T, D, F.G, (int)blockIdx.x);
        pg8::EpiResid E{F.in[I_X], (float*)(F.ws + WS_X1), D, MV + 2 * D};
        pg8::gemm_phase<pg8::EpiResid, pg8::StaticOrder, true, true>(F.lds + RING_OFF, g, S, E, F.wave);

    }
    if constexpr (K == 10) { p10_norm2(F);
    }
    if constexpr (K == 11) {
        pg8::Gemm g{A1, (const bf16*)(F.ws + WS_WGU), T, NGU, D}; pg8::StaticOrder S; S.init(T, NGU, F.G, (int)blockIdx.x);
        pg8::EpiSwiglu E{(bf16*)(F.ws + WS_ACT), DFF};
        pg8::gemm_phase<pg8::EpiSwiglu, pg8::StaticOrder, true, true>(F.lds + RING_OFF, g, S, E, F.wave);
        tr_idle(F, P11T_B, P11T_E, (int)blockIdx.x - 192, 64);
    }
    if constexpr (K == 12) {
        pg8::Gemm g{(const bf16*)(F.ws + WS_ACT), (const bf16*)(F.ws + WS_WDN), T, D, DFF}; pg8::StaticOrder S; S.init(T, D, F.G, (int)blockIdx.x);
        pg8::EpiResid E{(const float*)(F.ws + WS_X1), F.out, D, MV + 5 * D};
        pg8::gemm_phase<pg8::EpiResid, pg8::StaticOrder, true, true>(F.lds + RING_OFF, g, S, E, F.wave);

    }
    if constexpr (K == 13) { p13_final(F);
    }
}

struct Args { const float* in[26]; float* out; unsigned char* ws; int ph_lo, ph_hi, li, pad; };
__global__ void __launch_bounds__(NWAVES * 64, 2) mk_fwd(Args args) {
    extern __shared__ __attribute__((aligned(16))) unsigned char lds[];
    Frame F;
    F.lds = (LAS unsigned char*)lds;
    F.MISC = (volatile LAS unsigned*)(F.lds + MISC_OFF);
    F.wave = __builtin_amdgcn_readfirstlane((int)(threadIdx.x >> 6));
    F.G = gridDim.x; { const int bx = blockIdx.x; F.vcu = (F.G % 8 == 0) ? (bx % 8) * (F.G / 8) + bx / 8 : bx; }
    F.ws = args.ws; F.ctl = (gu32*)(args.ws + WS_CTL); F.out = args.out;
#pragma unroll
    for (int i = 0; i < 26; ++i) F.in[i] = args.in[i];
    for (int u = threadIdx.x; u < (LDS_BYTES - LDSCTL_OFF) / 4; u += NWAVES * 64) ((LAS unsigned*)(F.lds + LDSCTL_OFF))[u] = 0u;
    __syncthreads();
    XcdBarrier bar; bar.bar = (unsigned*)(F.ctl + CW_BAR); bar.x = 0; bar.st = nullptr;
    if (N_LAUNCHES == 1) bar = xcd_barrier_post((unsigned*)(F.ctl + CW_BAR), F.MISC + 8);
#define GRID_BAR() do { if (N_LAUNCHES == 1) xcd_barrier(bar, F.wave); } while (0)
    unsigned long long tp0 = 0, tpa = 0, tpb = 0; (void)tp0;
    const int lo = args.ph_lo, hi = args.ph_hi;
#define IN(k) (lo <= (k) && (k) < hi)
#define BOTH(k) (IN(k) && IN((k) + 1))

    if (IN(0)) { if constexpr (0 == TPA || 0 == TPB) tp0 = __builtin_amdgcn_s_memrealtime(); run_phase<0>(F); if constexpr (PH_REPS[0] > 1) { GRID_BAR(); run_phase<0>(F); } if constexpr (PH_REPS[0] > 2) { GRID_BAR(); run_phase<0>(F); } if (BOTH(0)) GRID_BAR(); if constexpr (0 == TPA) tpa = __builtin_amdgcn_s_memrealtime() - tp0; if constexpr (0 == TPB) tpb = __builtin_amdgcn_s_memrealtime() - tp0; }
    if (IN(1)) { if constexpr (1 == TPA || 1 == TPB) tp0 = __builtin_amdgcn_s_memrealtime(); run_phase<1>(F); if constexpr (PH_REPS[1] > 1) { GRID_BAR(); run_phase<1>(F); } if constexpr (PH_REPS[1] > 2) { GRID_BAR(); run_phase<1>(F); } if (BOTH(1)) GRID_BAR(); if constexpr (1 == TPA) tpa = __builtin_amdgcn_s_memrealtime() - tp0; if constexpr (1 == TPB) tpb = __builtin_amdgcn_s_memrealtime() - tp0; }
    if (IN(2)) { if constexpr (2 == TPA || 2 == TPB) tp0 = __builtin_amdgcn_s_memrealtime(); run_phase<2>(F); if constexpr (PH_REPS[2] > 1) { GRID_BAR(); run_phase<2>(F); } if constexpr (PH_REPS[2] > 2) { GRID_BAR(); run_phase<2>(F); } if (BOTH(2)) GRID_BAR(); if constexpr (2 == TPA) tpa = __builtin_amdgcn_s_memrealtime() - tp0; if constexpr (2 == TPB) tpb = __builtin_amdgcn_s_memrealtime() - tp0; }
    if (IN(3)) { if constexpr (3 == TPA || 3 == TPB) tp0 = __builtin_amdgcn_s_memrealtime(); run_phase<3>(F); if constexpr (PH_REPS[3] > 1) { GRID_BAR(); run_phase<3>(F); } if constexpr (PH_REPS[3] > 2) { GRID_BAR(); run_phase<3>(F); } if (BOTH(3)) GRID_BAR(); if constexpr (3 == TPA) tpa = __builtin_amdgcn_s_memrealtime() - tp0; if constexpr (3 == TPB) tpb = __builtin_amdgcn_s_memrealtime() - tp0; }
    if (IN(4)) { if constexpr (4 == TPA || 4 == TPB) tp0 = __builtin_amdgcn_s_memrealtime(); run_phase<4>(F); if constexpr (PH_REPS[4] > 1) { GRID_BAR(); run_phase<4>(F); } if constexpr (PH_REPS[4] > 2) { GRID_BAR(); run_phase<4>(F); } if (BOTH(4)) GRID_BAR(); if constexpr (4 == TPA) tpa = __builtin_amdgcn_s_memrealtime() - tp0; if constexpr (4 == TPB) tpb = __builtin_amdgcn_s_memrealtime() - tp0; }
    if (IN(5)) { if constexpr (5 == TPA || 5 == TPB) tp0 = __builtin_amdgcn_s_memrealtime(); run_phase<5>(F); if constexpr (PH_REPS[5] > 1) { GRID_BAR(); run_phase<5>(F); } if constexpr (PH_REPS[5] > 2) { GRID_BAR(); run_phase<5>(F); } if (BOTH(5)) GRID_BAR(); if constexpr (5 == TPA) tpa = __builtin_amdgcn_s_memrealtime() - tp0; if constexpr (5 == TPB) tpb = __builtin_amdgcn_s_memrealtime() - tp0; }
    if (IN(6)) { if constexpr (6 == TPA || 6 == TPB) tp0 = __builtin_amdgcn_s_memrealtime(); run_phase<6>(F); if constexpr (PH_REPS[6] > 1) { GRID_BAR(); run_phase<6>(F); } if constexpr (PH_REPS[6] > 2) { GRID_BAR(); run_phase<6>(F); } if (BOTH(6)) GRID_BAR(); if constexpr (6 == TPA) tpa = __builtin_amdgcn_s_memrealtime() - tp0; if constexpr (6 == TPB) tpb = __builtin_amdgcn_s_memrealtime() - tp0; }
    if (IN(7)) { if constexpr (7 == TPA || 7 == TPB) tp0 = __builtin_amdgcn_s_memrealtime(); run_phase<7>(F); if constexpr (PH_REPS[7] > 1) { GRID_BAR(); run_phase<7>(F); } if constexpr (PH_REPS[7] > 2) { GRID_BAR(); run_phase<7>(F); } if (BOTH(7)) GRID_BAR(); if constexpr (7 == TPA) tpa = __builtin_amdgcn_s_memrealtime() - tp0; if constexpr (7 == TPB) tpb = __builtin_amdgcn_s_memrealtime() - tp0; }
    if (IN(8)) { if constexpr (8 == TPA || 8 == TPB) tp0 = __builtin_amdgcn_s_memrealtime(); run_phase<8>(F); if constexpr (PH_REPS[8] > 1) { GRID_BAR(); run_phase<8>(F); } if constexpr (PH_REPS[8] > 2) { GRID_BAR(); run_phase<8>(F); } if (BOTH(8)) GRID_BAR(); if constexpr (8 == TPA) tpa = __builtin_amdgcn_s_memrealtime() - tp0; if constexpr (8 == TPB) tpb = __builtin_amdgcn_s_memrealtime() - tp0; }
    if (IN(9)) { if constexpr (9 == TPA || 9 == TPB) tp0 = __builtin_amdgcn_s_memrealtime(); run_phase<9>(F); if constexpr (PH_REPS[9] > 1) { GRID_BAR(); run_phase<9>(F); } if constexpr (PH_REPS[9] > 2) { GRID_BAR(); run_phase<9>(F); } if (BOTH(9)) GRID_BAR(); if constexpr (9 == TPA) tpa = __builtin_amdgcn_s_memrealtime() - tp0; if constexpr (9 == TPB) tpb = __builtin_amdgcn_s_memrealtime() - tp0; }
    if (IN(10)) { if constexpr (10 == TPA || 10 == TPB) tp0 = __builtin_amdgcn_s_memrealtime(); run_phase<10>(F); if constexpr (PH_REPS[10] > 1) { GRID_BAR(); run_phase<10>(F); } if constexpr (PH_REPS[10] > 2) { GRID_BAR(); run_phase<10>(F); } if (BOTH(10)) GRID_BAR(); if constexpr (10 == TPA) tpa = __builtin_amdgcn_s_memrealtime() - tp0; if constexpr (10 == TPB) tpb = __builtin_amdgcn_s_memrealtime() - tp0; }
    if (IN(11)) { if constexpr (11 == TPA || 11 == TPB) tp0 = __builtin_amdgcn_s_memrealtime(); run_phase<11>(F); if constexpr (PH_REPS[11] > 1) { GRID_BAR(); run_phase<11>(F); } if constexpr (PH_REPS[11] > 2) { GRID_BAR(); run_phase<11>(F); } if (BOTH(11)) GRID_BAR(); if constexpr (11 == TPA) tpa = __builtin_amdgcn_s_memrealtime() - tp0; if constexpr (11 == TPB) tpb = __builtin_amdgcn_s_memrealtime() - tp0; }
    if (IN(12)) { if constexpr (12 == TPA || 12 == TPB) tp0 = __builtin_amdgcn_s_memrealtime(); run_phase<12>(F); if constexpr (PH_REPS[12] > 1) { GRID_BAR(); run_phase<12>(F); } if constexpr (PH_REPS[12] > 2) { GRID_BAR(); run_phase<12>(F); } if (BOTH(12)) GRID_BAR(); if constexpr (12 == TPA) tpa = __builtin_amdgcn_s_memrealtime() - tp0; if constexpr (12 == TPB) tpb = __builtin_amdgcn_s_memrealtime() - tp0; }
    if (IN(13)) { if constexpr (13 == TPA || 13 == TPB) tp0 = __builtin_amdgcn_s_memrealtime(); run_phase<13>(F); if constexpr (PH_REPS[13] > 1) { GRID_BAR(); run_phase<13>(F); } if constexpr (PH_REPS[13] > 2) { GRID_BAR(); run_phase<13>(F); } if (BOTH(13)) GRID_BAR(); if constexpr (13 == TPA) tpa = __builtin_amdgcn_s_memrealtime() - tp0; if constexpr (13 == TPB) tpb = __builtin_amdgcn_s_memrealtime() - tp0; }
    if constexpr (TPA >= 0 || TPB >= 0) {
        if (blockIdx.x == 0 && F.wave == 0) { const unsigned long long ua = (tpa + 500ull) / 1000ull, ub = (tpb + 500ull) / 1000ull, extra = ua * 100000ull + ub * 1000ull, t1 = __builtin_amdgcn_s_memrealtime();
            while (__builtin_amdgcn_s_memrealtime() - t1 < extra) __builtin_amdgcn_s_sleep(16); }
    }
#undef IN
#undef BOTH
}

extern "C" void kernel_launch(void* const* d_in, const int* in_sizes, int n_in, void* d_out, int out_size, void* d_ws, size_t ws_size, hipStream_t stream) {
    static int grid = 0;
    if (grid == 0) {
        if (n_in != 26 || out_size != T * D || ws_size < WS_END) { fprintf(stderr, "kernel_launch: unexpected shapes: n_in %d out %d ws %zu (need %zu)\n", n_in, out_size, ws_size, (size_t)WS_END); grid = -1; return; }
        int dev = 0, cus = 0, per_cu = 0;
        if (hipGetDevice(&dev) != hipSuccess || hipDeviceGetAttribute(&cus, hipDeviceAttributeMultiprocessorCount, dev) != hipSuccess) { grid = -1; return; }
        if (hipFuncSetAttribute((const void*)mk_fwd, hipFuncAttributeMaxDynamicSharedMemorySize, LDS_BYTES) != hipSuccess) { fprintf(stderr, "kernel_launch: hipFuncSetAttribute failed\n"); grid = -1; return; }
        if (hipOccupancyMaxActiveBlocksPerMultiprocessor(&per_cu, (const void*)mk_fwd, NWAVES * 64, LDS_BYTES) != hipSuccess || per_cu < 1)
            fprintf(stderr, "kernel_launch: note: occupancy query reports %d workgroups per CU\n", per_cu);
        (void)hipGetLastError();
        grid = cus;
    }
    if (grid < 0) return;
    if (hipMemsetAsync((char*)d_ws + WS_CTL, 0, CTL_ZERO_BYTES, stream) != hipSuccess) return;
    Args a{};
    for (int i = 0; i < 26; ++i) a.in[i] = (const float*)d_in[i];
    a.out = (float*)d_out; a.ws = (unsigned char*)d_ws;
    for (int li = 0; li < N_LAUNCHES; ++li) {
        if (N_LAUNCHES == 1) { a.ph_lo = 0; a.ph_hi = N_PHASES; } else { a.ph_lo = li * N_PHASES / N_LAUNCHES; a.ph_hi = (li + 1) * N_PHASES / N_LAUNCHES; }
        a.li = li;
        hipLaunchKernelGGL(mk_fwd, dim3(grid), dim3(NWAVES * 64), LDS_BYTES, stream, a);
        if (hipPeekAtLastError() != hipSuccess) break;
    }
}
```

```cpp
#include <hip/hip_runtime.h>
#include <cstdio>
#include <cstdint>
namespace pg8 {
#define PG8_LAS __attribute__((address_space(3)))
typedef unsigned short bf16_t;
typedef short bf16x8 __attribute__((ext_vector_type(8)));
typedef float f32x4 __attribute__((ext_vector_type(4)));
typedef unsigned u32x4 __attribute__((ext_vector_type(4)));
constexpr int BM = 256, BK = 64, HALF = 128, HTB = HALF * BK * 2  , STAGE_BYTES = 8 * HTB, NXCD = 8, WGM = 8;

__host__ __device__ __forceinline__ int lds_byte(int r, int c) { const int st = (r >> 4) * 2 + (c >> 5), rr = r & 15, cc = c & 31, ob = rr * 64 + cc * 2; return st * 1024 + (ob ^ (((ob >> 9) & 1) << 5)); }
__host__ __device__ __forceinline__ void stage_rc(int b, int& R, int& C) { const int st = b / 1024, sb = b % 1024, swz = sb ^ (((sb >> 9) & 1) << 5); R = (st >> 1) * 16 + swz / 64; C = (st & 1) * 32 + (swz % 64) / 2; }
__host__ __device__ __forceinline__ int perm32(int rho) { const int n = rho >> 4, i = rho & 15; return 8 * (i >> 2) + 4 * n + (i & 3); }

__device__ __forceinline__ int mk_lane() { int l; asm volatile("v_mbcnt_lo_u32_b32 %0, -1, 0\n\tv_mbcnt_hi_u32_b32 %0, -1, %0" : "=v"(l)); return l; }
struct Unit { int pm, pn; };
struct Gemm { const bf16_t* A; const bf16_t* Bt; int M, N, K; };

struct StaticOrder {
    int nM, nN, nwg, G, c;
    __host__ __device__ void init(int M, int N, int G_, int c_) { nM = M / BM; nN = N / BM; nwg = nM * nN; G = G_; c = c_; }
    __host__ __device__ bool next(int i, Unit& u) const {
        const long L = (long)i * G + c; if (L >= nwg) return false;
        int wgid = (int)L; { const int q = nwg / NXCD, r = nwg % NXCD, xcd = wgid % NXCD, off = wgid / NXCD; wgid = (xcd < r ? xcd * (q + 1) : r * (q + 1) + (xcd - r) * q) + off; }
        const int nig = WGM * nN, gid = wgid / nig, fm = gid * WGM, gsz = (nM - fm) < WGM ? (nM - fm) : WGM;
        u.pm = fm + ((wgid % nig) % gsz); u.pn = (wgid % nig) / gsz; return true;
    }
    __device__ __forceinline__ void a_ready(const Unit&) const {}
    __device__ __forceinline__ void done(const Unit&) const {}
};

__device__ __forceinline__ unsigned cvt_pk_bf16(float lo, float hi) { unsigned r; asm volatile("v_cvt_pk_bf16_f32 %0, %1, %2" : "=v"(r) : "v"(lo), "v"(hi)); return r; }
typedef float f32x2 __attribute__((ext_vector_type(2)));
__device__ __forceinline__ f32x2 gelu_pk(f32x2 v) {
    const f32x2 av = __builtin_elementwise_abs(v), d = av * 0.2316418882f + 1.0f;
    f32x2 t; t.x = __builtin_amdgcn_rcpf(d.x); t.y = __builtin_amdgcn_rcpf(d.y);
    f32x2 q = t * 0.5307027145f + (-0.7265760135f); q = q * t + 0.7107068705f; q = q * t + (-0.142248368f); q = q * t + 0.127414796f; q = q * t;
    const f32x2 s = (v * v) * (-0.72134752044f);
    f32x2 e; e.x = __builtin_amdgcn_exp2f(s.x); e.y = __builtin_amdgcn_exp2f(s.y);
    const f32x2 m = v * (q * e), r = v - m;
    f32x2 o; o.x = v.x < 0.f ? m.x : r.x; o.y = v.y < 0.f ? m.y : r.y; return o;
}

template <int ACT  > struct EpiBf16 {
    static constexpr bool PERM = true, AFTER_DRAIN = false; static_assert(ACT == 0 || ACT == 1, "EpiBf16: ACT is 0 (none) or 1 (gelu_pk)");
    bf16_t* O; int ldc; const float* bias; int split_cols; size_t split_stride; float scale0;
    __device__ __forceinline__ void operator()(const f32x4 (&acc)[2][2][4][2], const Unit& u, int wr, int wc, int fr, int fq) const {
        const int row0 = u.pm * BM + wr * 64 + fr; int colt = u.pn * BM; bf16_t* base = O;
        float sc = 1.f; if (split_cols) { const int t = colt / split_cols; base += (size_t)t * split_stride; colt -= t * split_cols; if (t == 0) sc = scale0; }
        const int col0 = colt + wc * 32 + 8 * fq, bcol0 = u.pn * BM + wc * 32 + 8 * fq;
        f32x4 bv[2][2];
#pragma unroll
        for (int bj = 0; bj < 2; ++bj)
#pragma unroll
            for (int n = 0; n < 2; ++n) bv[bj][n] = bias ? *(const f32x4*)(bias + bcol0 + bj * HALF + 4 * n) : (f32x4){0.f, 0.f, 0.f, 0.f};
#pragma unroll
        for (int ai = 0; ai < 2; ++ai)
#pragma unroll
            for (int m = 0; m < 4; ++m) { bf16_t* rowp = base + (size_t)(row0 + ai * HALF + m * 16) * ldc + col0;
#pragma unroll
                for (int bj = 0; bj < 2; ++bj) { f32x4 v0 = acc[ai][bj][m][0] + bv[bj][0], v1 = acc[ai][bj][m][1] + bv[bj][1];
                    if (ACT == 1) { f32x2 a = gelu_pk((f32x2){v0[0], v0[1]}), b = gelu_pk((f32x2){v0[2], v0[3]}), c = gelu_pk((f32x2){v1[0], v1[1]}), d = gelu_pk((f32x2){v1[2], v1[3]});
                        v0 = (f32x4){a.x, a.y, b.x, b.y}; v1 = (f32x4){c.x, c.y, d.x, d.y}; }
                    v0 = v0 * sc; v1 = v1 * sc; u32x4 w; w.x = cvt_pk_bf16(v0[0], v0[1]); w.y = cvt_pk_bf16(v0[2], v0[3]); w.z = cvt_pk_bf16(v1[0], v1[1]); w.w = cvt_pk_bf16(v1[2], v1[3]);
                    *(u32x4*)(rowp + bj * HALF) = w; } }
    }
};
__device__ __forceinline__ float sigmoidf_(float x) { return __builtin_amdgcn_rcpf(1.0f + __expf(-x)); }
struct EpiResid {
    static constexpr bool PERM = false, AFTER_DRAIN = false;
    const float* base; float* out; int ldc; const float* gvec;
    __device__ __forceinline__ void operator()(const f32x4 (&acc)[2][2][4][2], const Unit& u, int wr, int wc, int fr, int fq) const {
        const int row0 = u.pm * BM + wr * 64 + fr, col0 = u.pn * BM + wc * 32 + 4 * fq;
        f32x4 gv[2][2];
#pragma unroll
        for (int bj = 0; bj < 2; ++bj)
#pragma unroll
            for (int n = 0; n < 2; ++n) gv[bj][n] = *(const __attribute__((address_space(1))) f32x4*)(gvec + col0 + bj * HALF + n * 16);
#pragma unroll
        for (int ai = 0; ai < 2; ++ai)
#pragma unroll
            for (int m = 0; m < 4; ++m) { const size_t off = (size_t)(row0 + ai * HALF + m * 16) * ldc + col0;
#pragma unroll
                for (int bj = 0; bj < 2; ++bj)
#pragma unroll
                    for (int n = 0; n < 2; ++n) { const f32x4 bs = *(const __attribute__((address_space(1))) f32x4*)(base + off + bj * HALF + n * 16);
                        *(__attribute__((address_space(1))) f32x4*)(out + off + bj * HALF + n * 16) = bs + gv[bj][n] * acc[ai][bj][m][n]; }
                if (m & 1) asm volatile("" ::: "memory"); }
    }
};
struct EpiSwiglu {
    static constexpr bool PERM = true, AFTER_DRAIN = false;
    bf16_t* O; int ldc;
    __device__ __forceinline__ void operator()(const f32x4 (&acc)[2][2][4][2], const Unit& u, int wr, int wc, int fr, int fq) const {
        const int row0 = u.pm * BM + wr * 64 + fr, col0 = u.pn * HALF + wc * 32 + 8 * fq;
#pragma unroll
        for (int ai = 0; ai < 2; ++ai)
#pragma unroll
            for (int m = 0; m < 4; ++m) { bf16_t* rowp = O + (size_t)(row0 + ai * HALF + m * 16) * ldc + col0;
                f32x4 h0, h1;
#pragma unroll
                for (int j = 0; j < 4; ++j) { const float g0 = acc[ai][0][m][0][j], g1 = acc[ai][0][m][1][j];
                    h0[j] = g0 * sigmoidf_(g0) * acc[ai][1][m][0][j]; h1[j] = g1 * sigmoidf_(g1) * acc[ai][1][m][1][j]; }
                u32x4 w; w.x = cvt_pk_bf16(h0[0], h0[1]); w.y = cvt_pk_bf16(h0[2], h0[3]); w.z = cvt_pk_bf16(h1[0], h1[1]); w.w = cvt_pk_bf16(h1[2], h1[3]);
                *(__attribute__((address_space(1))) u32x4*)rowp = w; }
    }
};
template <int CTRL> __device__ __forceinline__ float dpp_f(float old, float src) { return __builtin_bit_cast(float, __builtin_amdgcn_update_dpp(__builtin_bit_cast(int, old), __builtin_bit_cast(int, src), CTRL, 0xf, 0xf, false)); }
struct EpiLora {
    static constexpr bool PERM = true, AFTER_DRAIN = false;
    unsigned char* PKB; bf16_t* KD; const bf16_t* kbuf; const bf16_t* kkbuf; const bf16_t* rbuf; const float* w0; const float* a0; const float* k_a; int TT;
    __device__ __forceinline__ void operator()(const f32x4 (&acc)[2][2][4][2], const Unit& u, int wr, int wc, int fr, int fq) const {
        typedef __attribute__((address_space(1))) f32x4 gf4; typedef const __attribute__((address_space(1))) f32x4 cgf4;
        const int d = u.pn >> 4, cg = u.pn & 15;
        const int c8 = cg * HALF + wc * 32 + 8 * fq, h = c8 >> 6, ch = c8 & 63;
        const int row0 = u.pm * BM + wr * 64 + fr;
        f32x4 w0v[2], a0v[2], kav[2];
#pragma unroll
        for (int n = 0; n < 2; ++n) { w0v[n] = *(cgf4*)(w0 + d * 2048 + c8 + 4 * n); a0v[n] = *(cgf4*)(a0 + d * 2048 + c8 + 4 * n); kav[n] = *(cgf4*)(k_a + c8 + 4 * n); }
        typedef unsigned u32x2l __attribute__((ext_vector_type(2))); typedef const __attribute__((address_space(1))) u32x2l cgu2;
        u32x2l kq[2][2], kkq[2][2], rq[2][2];
        { const size_t fo0 = (size_t)row0 * 2048 + c8;
#pragma unroll
          for (int n = 0; n < 2; ++n) { kq[0][n] = *(cgu2*)(kbuf + fo0 + 4 * n); kkq[0][n] = *(cgu2*)(kkbuf + fo0 + 4 * n); rq[0][n] = *(cgu2*)(rbuf + fo0 + 4 * n); } }
#pragma unroll
        for (int it = 0; it < 8; ++it) {
            const int ai = it >> 2, m = it & 3;
            if (it + 1 < 8) { const size_t fo1 = (size_t)(row0 + ((it + 1) >> 2) * HALF + ((it + 1) & 3) * 16) * 2048 + c8;
#pragma unroll
                for (int n = 0; n < 2; ++n) { kq[(it + 1) & 1][n] = *(cgu2*)(kbuf + fo1 + 4 * n); kkq[(it + 1) & 1][n] = *(cgu2*)(kkbuf + fo1 + 4 * n); rq[(it + 1) & 1][n] = *(cgu2*)(rbuf + fo1 + 4 * n); } }
            asm volatile("" ::: "memory");
            const int tok = row0 + ai * HALF + m * 16;
            const int tau = d == 0 ? (tok & 15) : 15 - (tok & 15);
            unsigned char* rec = PKB + ((size_t)(d * 32 + h) * (TT / 16) + (tok >> 4)) * 8448;
            const size_t fo = (size_t)tok * 2048 + c8;
            f32x4 g[2]; u32x4 kw;
#pragma unroll
            for (int n = 0; n < 2; ++n) {
                f32x4 gp;
                const f32x4 x = acc[ai][0][m][n] + w0v[n];
#pragma unroll
                for (int j = 0; j < 4; ++j) { float w = __expf(-0.60653066f * sigmoidf_(x[j]));
                    if (d == 0) { w *= dpp_f<0x111>(1.0f, w); w *= dpp_f<0x112>(1.0f, w); w *= dpp_f<0x114>(1.0f, w); w *= dpp_f<0x118>(1.0f, w); g[n][j] = w; gp[j] = dpp_f<0x111>(1.0f, w); }
                    else        { w *= dpp_f<0x101>(1.0f, w); w *= dpp_f<0x102>(1.0f, w); w *= dpp_f<0x104>(1.0f, w); w *= dpp_f<0x108>(1.0f, w); g[n][j] = w; gp[j] = dpp_f<0x101>(1.0f, w); } }
                const f32x4 xa = acc[ai][1][m][n] + a0v[n];
                f32x4 k4, kk4, r4;
                { const u32x2l a_ = kq[it & 1][n], b_ = kkq[it & 1][n], c_ = rq[it & 1][n];
                  k4[0] = __builtin_bit_cast(float, a_.x << 16); k4[1] = __builtin_bit_cast(float, a_.x & 0xffff0000u); k4[2] = __builtin_bit_cast(float, a_.y << 16); k4[3] = __builtin_bit_cast(float, a_.y & 0xffff0000u);
                  kk4[0] = __builtin_bit_cast(float, b_.x << 16); kk4[1] = __builtin_bit_cast(float, b_.x & 0xffff0000u); kk4[2] = __builtin_bit_cast(float, b_.y << 16); kk4[3] = __builtin_bit_cast(float, b_.y & 0xffff0000u);
                  r4[0] = __builtin_bit_cast(float, c_.x << 16); r4[1] = __builtin_bit_cast(float, c_.x & 0xffff0000u); r4[2] = __builtin_bit_cast(float, c_.y << 16); r4[3] = __builtin_bit_cast(float, c_.y & 0xffff0000u); }
                f32x4 at, rt, bt, kdt; float kdv[4];
#pragma unroll
                for (int j = 0; j < 4; ++j) { const float a = sigmoidf_(xa[j]), rg = __builtin_amdgcn_rcpf(g[n][j]);
                    kdv[j] = k4[j] * (1.0f + (a - 1.0f) * kav[n][j]);
                    at[j] = -kk4[j] * gp[j]; rt[j] = r4[j] * g[n][j]; bt[j] = kk4[j] * a * rg; kdt[j] = kdv[j] * rg; }
                const int chn = ch + 4 * n;
                {
                    const int p0 = ((((chn >> 5) * 2 + ((chn >> 4) & 1)) * 2 + n) * 8 + ((chn >> 3) & 1) * 4);
                    typedef unsigned u32x2 __attribute__((ext_vector_type(2)));
                    __attribute__((address_space(1))) unsigned char* rp = (__attribute__((address_space(1))) unsigned char*)rec + (tau * 64 + p0) * 2;
                    u32x2 w;
                    w.x = cvt_pk_bf16(at[0], at[1]); w.y = cvt_pk_bf16(at[2], at[3]); *(__attribute__((address_space(1))) u32x2*)(rp) = w;
                    w.x = cvt_pk_bf16(rt[0], rt[1]); w.y = cvt_pk_bf16(rt[2], rt[3]); *(__attribute__((address_space(1))) u32x2*)(rp + 2048) = w;
                    w.x = cvt_pk_bf16(bt[0], bt[1]); w.y = cvt_pk_bf16(bt[2], bt[3]); *(__attribute__((address_space(1))) u32x2*)(rp + 4096) = w;
                    w.x = cvt_pk_bf16(kdt[0], kdt[1]); w.y = cvt_pk_bf16(kdt[2], kdt[3]); *(__attribute__((address_space(1))) u32x2*)(rp + 6144) = w; }
                if (n == 0) { kw.x = cvt_pk_bf16(kdv[0], kdv[1]); kw.y = cvt_pk_bf16(kdv[2], kdv[3]); } else { kw.z = cvt_pk_bf16(kdv[0], kdv[1]); kw.w = cvt_pk_bf16(kdv[2], kdv[3]); }
            }
            *(__attribute__((address_space(1))) u32x4*)(KD + (size_t)d * TT * 2048 + fo) = kw;
            if (fr == (d == 0 ? 15 : 0)) { float* ge = (float*)(rec + 8192) + ch; *(gf4*)ge = g[0]; *(gf4*)(ge + 4) = g[1]; }
        }
    }
};
template <class Epi, class Sched, bool ALIGN_EPI = false, bool SP2 = false>
__device__ __forceinline__ void gemm_phase(PG8_LAS unsigned char* lds, const Gemm g, const Sched& S, const Epi& E, const int wid) {
    const int lane = mk_lane(), tid = wid * 64 + lane, wr = wid >> 2, wc = wid & 3, fr = lane & 15, fq = lane >> 4;
    const int K = g.K, nt = K / BK;
    unsigned voffA[2], voffB[2];
#pragma unroll
    for (int i = 0; i < 2; ++i) { int R, C; stage_rc(tid * 16 + i * 8192, R, C); const int Rb = Epi::PERM ? ((R & ~31) + perm32(R & 31)) : R;
        voffA[i] = (unsigned)(R * K + C) * 2u; voffB[i] = (unsigned)(Rb * K + C) * 2u; }
    const size_t kstep = (size_t)(BK * 2);
    const size_t hstep = (size_t)HALF * K * 2;
    const size_t tstep = 2 * hstep;
    const unsigned ldsw = (unsigned)wid * 1024u;
    const int aoff = lds_byte(wr * 64 + fr, fq * 8), boff = lds_byte(wc * 32 + fr, fq * 8);
#define PG8_SA(b, h) (((b) * 2 + (h)) * HTB)
#define PG8_SB(b, h) ((4 + (b) * 2 + (h)) * HTB)
#define PG8_STAGE(bufoff, gbase, voff) do { _Pragma("unroll") for (int _i = 0; _i < 2; ++_i) \
        __builtin_amdgcn_global_load_lds((const unsigned*)((const char*)(gbase) + (voff)[_i]), (PG8_LAS unsigned*)(lds + (bufoff) + ldsw + _i * 8192), 16, 0, 0); } while (0)
#define PG8_LDA(dst, b, h) do { _Pragma("unroll") for (int m = 0; m < 4; ++m) _Pragma("unroll") for (int k = 0; k < 2; ++k) dst[m][k] = *(const PG8_LAS bf16x8*)(lds + PG8_SA(b, h) + aoff + m * 2048 + k * 1024); } while (0)
#define PG8_LDB(dst, b, h) do { _Pragma("unroll") for (int n = 0; n < 2; ++n) _Pragma("unroll") for (int k = 0; k < 2; ++k) dst[n][k] = *(const PG8_LAS bf16x8*)(lds + PG8_SB(b, h) + boff + n * 2048 + k * 1024); } while (0)
#define PG8_MMA(ai, bj, At, Bt) do { __builtin_amdgcn_s_setprio(1); _Pragma("unroll") for (int m = 0; m < 4; ++m) _Pragma("unroll") for (int n = 0; n < 2; ++n) _Pragma("unroll") for (int k = 0; k < 2; ++k) \
        acc[ai][bj][m][n] = __builtin_amdgcn_mfma_f32_16x16x32_bf16(Bt[n][k], At[m][k], acc[ai][bj][m][n], 0, 0, 0); __builtin_amdgcn_s_setprio(0); } while (0)
#define PG8_WAIT_V(n) asm volatile("s_waitcnt vmcnt(" #n ")" ::: "memory")
#define PG8_WAIT_L(n) asm volatile("s_waitcnt lgkmcnt(" #n ")" ::: "memory")
#define PG8_BAR __builtin_amdgcn_s_barrier()
#define PG8_SCHED __builtin_amdgcn_sched_barrier(0)
    Unit cur, nxt; int ui = 0;
    if (!S.next(0, cur)) return;
    f32x4 acc[2][2][4][2];
#pragma unroll
    for (int a = 0; a < 2; ++a)
#pragma unroll
        for (int b = 0; b < 2; ++b)
#pragma unroll
            for (int m = 0; m < 4; ++m)
#pragma unroll
                for (int n = 0; n < 2; ++n) acc[a][b][m][n] = (f32x4){0.f, 0.f, 0.f, 0.f};
    bf16x8 At[4][2], B0[2][2], B1[2][2];
    const char* cA = (const char*)g.A + (size_t)cur.pm * tstep; const char* cB = (const char*)g.Bt + (size_t)cur.pn * tstep;
    S.a_ready(cur);
    if constexpr (SP2) {
        PG8_STAGE(PG8_SB(0, 0), cB, voffB); PG8_STAGE(PG8_SB(0, 1), cB + hstep, voffB); PG8_STAGE(PG8_SA(0, 0), cA, voffA); PG8_STAGE(PG8_SA(0, 1), cA + hstep, voffA);
        if (wr == 1) PG8_BAR;
        PG8_WAIT_V(2); PG8_BAR;
        PG8_STAGE(PG8_SB(1, 0), cB + kstep, voffB); PG8_STAGE(PG8_SA(1, 0), cA + kstep, voffA); PG8_STAGE(PG8_SB(1, 1), cB + hstep + kstep, voffB);
        PG8_WAIT_V(6); PG8_BAR;
    } else {
        PG8_STAGE(PG8_SB(0, 0), cB, voffB); PG8_STAGE(PG8_SA(0, 0), cA, voffA); PG8_STAGE(PG8_SB(0, 1), cB + hstep, voffB); PG8_STAGE(PG8_SA(0, 1), cA + hstep, voffA);
        if (wr == 1) PG8_BAR;
        PG8_WAIT_V(4); PG8_BAR;
        PG8_STAGE(PG8_SB(1, 0), cB + kstep, voffB); PG8_STAGE(PG8_SA(1, 0), cA + kstep, voffA); PG8_STAGE(PG8_SB(1, 1), cB + hstep + kstep, voffB);
        PG8_WAIT_V(6); PG8_BAR;
    }
    for (;;) {
        const bool has_next = S.next(ui + 1, nxt);
        const char* nA = has_next ? (const char*)g.A + (size_t)nxt.pm * tstep : cA; const char* nB = has_next ? (const char*)g.Bt + (size_t)nxt.pn * tstep : cB;
        for (int t = 0; t < nt; t += 2) {
            const bool last = (t == nt - 2);
            const char* a1 = cA + (size_t)(t + 1) * kstep;
            const char* a2 = last ? nA : cA + (size_t)(t + 2) * kstep; const char* b2 = last ? nB : cB + (size_t)(t + 2) * kstep;
            const char* a3 = a2 + kstep; const char* b3 = b2 + kstep;
            if (last && has_next) S.a_ready(nxt);
            if constexpr (SP2) {
            PG8_LDB(B0, 0, 0); PG8_LDB(B1, 0, 1); PG8_SCHED; PG8_LDA(At, 0, 0); PG8_STAGE(PG8_SA(1, 1), a1 + hstep, voffA);
            PG8_WAIT_V(8); PG8_WAIT_L(0); PG8_BAR; PG8_MMA(0, 0, At, B0); PG8_MMA(0, 1, At, B1); PG8_BAR; PG8_SCHED;
            PG8_LDA(At, 0, 1); PG8_STAGE(PG8_SB(0, 0), b2, voffB); PG8_STAGE(PG8_SB(0, 1), b2 + hstep, voffB); PG8_STAGE(PG8_SA(0, 0), a2, voffA);
            PG8_WAIT_V(8); PG8_WAIT_L(0); PG8_BAR; PG8_MMA(1, 0, At, B0); PG8_MMA(1, 1, At, B1); PG8_BAR; PG8_SCHED;
            PG8_LDB(B0, 1, 0); PG8_LDB(B1, 1, 1); PG8_SCHED; PG8_LDA(At, 1, 0); PG8_STAGE(PG8_SA(0, 1), a2 + hstep, voffA);
            PG8_WAIT_V(8); PG8_WAIT_L(0); PG8_BAR; PG8_MMA(0, 0, At, B0); PG8_MMA(0, 1, At, B1); PG8_BAR; PG8_SCHED;
            PG8_LDA(At, 1, 1); PG8_STAGE(PG8_SB(1, 0), b3, voffB); PG8_STAGE(PG8_SB(1, 1), b3 + hstep, voffB); PG8_STAGE(PG8_SA(1, 0), a3, voffA);
            PG8_WAIT_V(8); PG8_WAIT_L(0); PG8_BAR; PG8_MMA(1, 0, At, B0); PG8_MMA(1, 1, At, B1); PG8_BAR; PG8_SCHED;
            } else {
            PG8_LDB(B0, 0, 0); PG8_SCHED; PG8_LDA(At, 0, 0); PG8_STAGE(PG8_SA(1, 1), a1 + hstep, voffA);
            PG8_WAIT_L(8); PG8_BAR; PG8_WAIT_L(0); PG8_MMA(0, 0, At, B0); PG8_BAR; PG8_SCHED;
            PG8_LDB(B1, 0, 1); PG8_STAGE(PG8_SB(0, 0), b2, voffB);
            PG8_BAR; PG8_WAIT_L(0); PG8_MMA(0, 1, At, B1); PG8_BAR;
            PG8_LDA(At, 0, 1); PG8_STAGE(PG8_SA(0, 0), a2, voffA);
            PG8_BAR; PG8_WAIT_L(0); PG8_MMA(1, 0, At, B0); PG8_BAR; PG8_SCHED;
            PG8_STAGE(PG8_SB(0, 1), b2 + hstep, voffB);
            PG8_WAIT_V(6); PG8_BAR; PG8_MMA(1, 1, At, B1); PG8_BAR;
            PG8_LDB(B0, 1, 0); PG8_SCHED; PG8_LDA(At, 1, 0); PG8_STAGE(PG8_SA(0, 1), a2 + hstep, voffA);
            PG8_WAIT_L(8); PG8_BAR; PG8_WAIT_L(0); PG8_MMA(0, 0, At, B0); PG8_BAR; PG8_SCHED;
            PG8_LDB(B1, 1, 1); PG8_STAGE(PG8_SB(1, 0), b3, voffB);
            PG8_BAR; PG8_WAIT_L(0); PG8_MMA(0, 1, At, B1); PG8_BAR;
            PG8_LDA(At, 1, 1); PG8_STAGE(PG8_SA(1, 0), a3, voffA);
            PG8_BAR; PG8_WAIT_L(0); PG8_MMA(1, 0, At, B0); PG8_BAR; PG8_SCHED;
            PG8_STAGE(PG8_SB(1, 1), b3 + hstep, voffB);
            PG8_WAIT_V(6); PG8_BAR; PG8_MMA(1, 1, At, B1); PG8_BAR;
            }
        }
        if constexpr (ALIGN_EPI) { if (wr == 0) PG8_BAR; }
        if constexpr (!Epi::AFTER_DRAIN) { const int l2 = mk_lane(); E(acc, cur, wr, wc, l2 & 15, l2 >> 4); S.done(cur); }
        if (!has_next) break;
#pragma unroll
        for (int a = 0; a < 2; ++a)
#pragma unroll
            for (int b = 0; b < 2; ++b)
#pragma unroll
                for (int m = 0; m < 4; ++m)
#pragma unroll
                    for (int n = 0; n < 2; ++n) acc[a][b][m][n] = (f32x4){0.f, 0.f, 0.f, 0.f};
        cur = nxt; cA = nA; cB = nB; ++ui;
        if constexpr (ALIGN_EPI) { if (wr == 1) PG8_BAR; }
    }
    PG8_WAIT_V(0);
    if constexpr (!ALIGN_EPI) { if (wr == 0) PG8_BAR; }
    PG8_BAR;
    if constexpr (Epi::AFTER_DRAIN) { E.fused(acc, cur, wr, wc, fr, fq, lds, wid, lane); S.done(cur); }
#undef PG8_SA
#undef PG8_SB
#undef PG8_STAGE
#undef PG8_LDA
#undef PG8_LDB
#undef PG8_MMA
#undef PG8_WAIT_V
#undef PG8_WAIT_L
#undef PG8_BAR
#undef PG8_SCHED
}
}

constexpr int NWAVES = 8;
#ifndef MK_N_LAUNCHES
#define MK_N_LAUNCHES 1
#endif
constexpr int N_PHASES = 14;
#ifndef MK_REPS
#define MK_REPS {1,1,1,1,1,1,1,1,1,1,1,1,1,1}
#endif
constexpr int PH_REPS[14] = MK_REPS;
#ifndef MK_TPA
#define MK_TPA -1
#endif
#ifndef MK_TPB
#define MK_TPB -1
#endif
constexpr int TPA = MK_TPA, TPB = MK_TPB;
constexpr int N_LAUNCHES = MK_N_LAUNCHES;

constexpr int D = 4096, T = 8192, CTXL = 256, TT = T + CTXL;
constexpr int DR = 2048, DC = 2048, NH = 32, HS = 64;
constexpr int OFF_K = 0, OFF_V = 2048, OFF_WL = 4096, OFF_AL = 4192, OFF_R = 4288, OFF_GL = 6336, RWKV_COLS = 6592;
constexpr int OFF_CB = 6592, OFF_CC = 8640, OFF_CX = 10688, IN_COLS = 12736, NZ = 12800;
constexpr int NCTXZ = 4352;
constexpr int DFF = 11008, NGU = 2 * DFF;
constexpr int NLORA = 8192, KLORA = 256, KGATE = 256;
constexpr int MODN = 6 * D;
constexpr int NKC = 16;
constexpr float NORM_EPS = 1e-6f, LNX_EPS = 64e-5f;
constexpr int CHUNK = 256, NCHUNK = 33;

constexpr size_t MiB = 1u << 20;
constexpr size_t WS_CTL = 0, CTL_ZERO_BYTES = 1 * MiB;
constexpr size_t WS_MODP = 1 * MiB;
constexpr size_t WS_MODV = 5 * MiB;
constexpr size_t WS_WLORA = 6 * MiB;
constexpr size_t WS_WGATE = 10 * MiB;
constexpr size_t WS_ALORA = 11 * MiB;
constexpr size_t WS_AGATE = 16 * MiB;
constexpr size_t WS_WOUT = 20 * MiB;
constexpr size_t WS_WGU = 52 * MiB;
constexpr size_t WS_WDN = 224 * MiB;
constexpr size_t WS_WIN = 310 * MiB;
constexpr size_t WS_PU = 310 * MiB;
constexpr size_t WS_SST = 374 * MiB;
constexpr size_t WS_A1 = 410 * MiB;
constexpr size_t WS_CAT = 410 * MiB;
constexpr size_t WS_Z = 476 * MiB;
constexpr size_t WS_YS = 476 * MiB;
constexpr size_t WS_KD = 604 * MiB;
constexpr size_t WS_GE = 670 * MiB;
constexpr size_t WS_KBUF = 683 * MiB;
constexpr size_t WS_KKBUF = 749 * MiB;
constexpr size_t WS_RBUF = 815 * MiB;
constexpr size_t WS_VBUF = 881 * MiB;
constexpr size_t WS_X1 = 683 * MiB;
constexpr size_t WS_PK = 947 * MiB;
constexpr size_t WS_ACT = 947 * MiB;
constexpr size_t WS_G = 1475 * MiB;
constexpr size_t WS_END = 1507 * MiB;
static_assert(WS_MODP + (size_t)NKC * 2 * MODN * 4 <= WS_MODV && WS_ALORA + (size_t)TT * 256 * 2 <= WS_AGATE && WS_WGU + (size_t)NGU * D * 2 <= WS_WDN && WS_WDN + (size_t)D * DFF * 2 <= WS_WIN, "ws map 1");
static_assert(WS_WIN + (size_t)NZ * D * 2 <= WS_A1 && WS_SST + (size_t)64 * NCHUNK * 16384 <= WS_A1 && WS_A1 + (size_t)TT * D * 2 <= WS_Z && WS_Z + (size_t)TT * NZ * 2 <= WS_KBUF, "ws map 2");
static_assert(WS_YS + (size_t)2 * T * 2048 * 4 <= WS_KD && WS_KD + (size_t)2 * TT * 2048 * 2 <= WS_GE && WS_GE + (size_t)64 * (TT / 16) * 256 <= WS_KBUF, "ws map 3");
static_assert(WS_KBUF + (size_t)TT * 2048 * 4 <= WS_KKBUF && WS_KKBUF + (size_t)TT * 2048 * 4 <= WS_RBUF && WS_RBUF + (size_t)TT * 2048 * 4 <= WS_VBUF && WS_VBUF + (size_t)TT * 2048 * 4 <= WS_PK, "ws map 4");
static_assert(WS_X1 + (size_t)T * D * 4 <= WS_RBUF && WS_PK + (size_t)64 * TT * 1024 <= WS_G && WS_ACT + (size_t)T * DFF * 2 <= WS_G && WS_G + (size_t)T * 2048 * 2 <= WS_END && WS_CAT + (size_t)T * D * 2 <= WS_Z, "ws map 5");
constexpr int CW_TMO = 0;
constexpr int CW_BAR = 4096;

constexpr int RING_OFF = 0, RING_BYTES = 131072;
constexpr int LDSCTL_OFF = RING_BYTES, MISC_OFF = LDSCTL_OFF + 320;
constexpr int LDS_BYTES = 147456;
static_assert(MISC_OFF + 128 <= LDS_BYTES, "LDS map");

#define GAS __attribute__((address_space(1)))
#define LAS __attribute__((address_space(3)))
typedef unsigned short bf16;
typedef unsigned v4u __attribute__((ext_vector_type(4)));
typedef unsigned v2u __attribute__((ext_vector_type(2)));
typedef float f32x4 __attribute__((ext_vector_type(4)));
typedef GAS unsigned gu32;
#define RLX_AGENT __ATOMIC_RELAXED, __HIP_MEMORY_SCOPE_AGENT
#define LDS_WAIT() asm volatile("s_waitcnt lgkmcnt(0)" ::: "memory")
#define VM_WAIT() asm volatile("s_waitcnt vmcnt(0)" ::: "memory")
__device__ __forceinline__ unsigned f2bf(float f) { unsigned u = __builtin_bit_cast(unsigned, f); return (u + 0x7fffu + ((u >> 16) & 1u)) >> 16; }
__device__ __forceinline__ unsigned pk2(float lo, float hi) { return f2bf(lo) | (f2bf(hi) << 16); }
__device__ __forceinline__ float bflo(unsigned w) { return __builtin_bit_cast(float, w << 16); }
__device__ __forceinline__ float bfhi(unsigned w) { return __builtin_bit_cast(float, w & 0xffff0000u); }
__device__ __forceinline__ float sigm(float x) { return 1.0f / (1.0f + __expf(-x)); }

#define XB_TMO      128
#define XB_XCNT(j)  (256  + 64 * (j))
#define XB_XSUB(j)  (1280 + 64 * (j))
#define XB_XGEN(j)  (2304 + 64 * (j))
#define XB_TOP      3328
#define XB_TOPGEN   3392
#define XCD_BAR_WORDS 3456
#define XB_SPIN_CAP (1u << 18)
__device__ __forceinline__ unsigned xb_ld(unsigned* p)              { return __hip_atomic_load(p, __ATOMIC_RELAXED, __HIP_MEMORY_SCOPE_AGENT); }
__device__ __forceinline__ unsigned xb_add(unsigned* p, unsigned v) { return __hip_atomic_fetch_add(p, v, __ATOMIC_RELAXED, __HIP_MEMORY_SCOPE_AGENT); }
__device__ __forceinline__ unsigned xb_xcc_id() { return (unsigned)__builtin_amdgcn_s_getreg((3 << 11) | 20) & 0xFu; }
#define XB_SPIN(cond, bar) do { unsigned _sp = 0; while (cond) { __builtin_amdgcn_s_sleep(1); \
    if ((++_sp & 255u) == 0u) { if (xb_ld(&(bar)[XB_TMO])) break; if (_sp > XB_SPIN_CAP) { atomicAdd(&(bar)[XB_TMO], 1u); break; } } } } while (0)
struct XcdBarrier { unsigned* bar; unsigned x; volatile LAS unsigned* st; };
__device__ __forceinline__ XcdBarrier xcd_barrier_post(unsigned* bar, volatile LAS unsigned* st) {
    XcdBarrier b; b.bar = bar; b.x = xb_xcc_id(); b.st = st;
    if (threadIdx.x == 0) (void)xb_add(&bar[XB_XCNT(b.x)], 1u);
    return b;
}
__device__ __forceinline__ void xcd_barrier_complete(unsigned* bar, unsigned x, unsigned& nloc, unsigned& nx) {
    const unsigned G = gridDim.x * gridDim.y * gridDim.z;
    unsigned sum, cnt, mine, sp = 0u;
    for (;;) {
        sum = 0u; cnt = 0u; mine = 0u;
#pragma unroll
        for (unsigned j = 0; j < 16; ++j) { const unsigned c = xb_ld(&bar[XB_XCNT(j)]); sum += c; cnt += (c > 0u) ? 1u : 0u; mine = (j == x) ? c : mine; }
        if (sum == G) break;
        __builtin_amdgcn_s_sleep(1);
        if ((++sp & 255u) == 0u) { if (xb_ld(&bar[XB_TMO])) break; if (sp > XB_SPIN_CAP) { atomicAdd(&bar[XB_TMO], 1u); break; } }
    }
    nloc = mine > 0u ? mine : 1u; nx = cnt > 0u ? cnt : 1u;
}
__device__ __forceinline__ void xcd_barrier(const XcdBarrier& b, const int wave) {
    asm volatile("s_waitcnt vmcnt(0)" ::: "memory");
    __syncthreads();
    if (wave == 0 && pg8::mk_lane() == 0) {
        unsigned* bar = b.bar;
        __builtin_amdgcn_s_waitcnt(0);
        unsigned nloc = b.st[0], nx = b.st[1];
        if (nloc == 0u) { xcd_barrier_complete(bar, b.x, nloc, nx); b.st[0] = nloc; b.st[1] = nx; }
        const unsigned old = xb_add(&bar[XB_XSUB(b.x)], 1u);
        const unsigned gen = old / nloc;
        if (old + 1u == (gen + 1u) * nloc) {
            __builtin_amdgcn_fence(__ATOMIC_RELEASE, "agent");
            asm volatile("s_waitcnt vmcnt(0)" ::: "memory");
            const unsigned og = xb_add(&bar[XB_TOP], 1u);
            const unsigned tg = og / nx;
            if (og + 1u == (tg + 1u) * nx) xb_add(&bar[XB_TOPGEN], 1u);
            else XB_SPIN(xb_ld(&bar[XB_TOPGEN]) == tg, bar);
            __builtin_amdgcn_fence(__ATOMIC_ACQUIRE, "agent");
            xb_add(&bar[XB_XGEN(b.x)], 1u);
            asm volatile("s_waitcnt vmcnt(0)" ::: "memory");
        } else {
            XB_SPIN(xb_ld(&bar[XB_XGEN(b.x)]) == gen, bar);
            __builtin_amdgcn_fence(__ATOMIC_ACQUIRE, "agent");
            asm volatile("s_waitcnt vmcnt(0)" ::: "memory");
        }
    }
    __syncthreads();
}

struct Frame {
    LAS unsigned char* lds;
    volatile LAS unsigned* MISC;
    gu32* ctl;
    int wave;
    int vcu, G;
    unsigned char* ws;
    const float* in[26];
    float* out;
};
enum { I_X = 0, I_C, I_CTX, I_CCTX, I_WADA, I_BADA, I_NORM1, I_WIN, I_MU, I_KK, I_KA, I_RK, I_W0, I_WDU, I_A0, I_WIU, I_WGU, I_LNXW, I_LNXB, I_CONVW, I_WOUT, I_NORM2, I_WFG, I_WFU, I_WFD, I_NORMF };

__device__ __forceinline__ float wave_sum(float v) {
#pragma unroll
    for (int o = 1; o < 64; o <<= 1) v += __shfl_xor(v, o);
    return v;
}

__device__ __forceinline__ void p0_transpose_item(const float* W, int K, int N, bf16* WT, int ldk, int row_off, LAS float* scr, int item, int lane) {
    const int nblk = N / 32, kb = item / nblk, nb = item % nblk, k0 = 64 * kb, n0 = 32 * nb;
    float tv[32];
#pragma unroll
    for (int i = 0; i < 32; ++i) tv[i] = *(const GAS float*)(W + (size_t)(k0 + 2 * i + (lane >> 5)) * N + n0 + (lane & 31));
#pragma unroll
    for (int i = 0; i < 32; ++i) scr[(2 * i + (lane >> 5)) * 33 + (lane & 31)] = tv[i];
    LDS_WAIT(); asm volatile("" ::: "memory");
    const int c = lane & 7;
#pragma unroll
    for (int j = 0; j < 4; ++j) { const int n = (lane >> 3) + 8 * j; const LAS float* s = scr + (8 * c) * 33 + n;
        v4u o; o.x = pk2(s[0 * 33], s[1 * 33]); o.y = pk2(s[2 * 33], s[3 * 33]); o.z = pk2(s[4 * 33], s[5 * 33]); o.w = pk2(s[6 * 33], s[7 * 33]);
        *(GAS v4u*)(WT + (size_t)(row_off + n0 + n) * ldk + k0 + 8 * c) = o; }
    LDS_WAIT(); asm volatile("" ::: "memory");
}
constexpr int TI_IN = (D / 64) * (IN_COLS / 32), TI_OUT = (D / 64) * (D / 32), TI_G = (D / 64) * (DFF / 32), TI_DN = (DFF / 64) * (D / 32);
constexpr int TI_TOTAL = TI_IN + TI_OUT + 2 * TI_G + TI_DN;
constexpr int GEMV_UNITS = NKC * (MODN / 256);
constexpr int IB_OUT = TI_IN, IB_G = IB_OUT + TI_OUT, IB_U = IB_G + TI_G, IB_D = IB_U + TI_G;
constexpr int P2T_B = IB_OUT, P2T_E = IB_G + 13200;
constexpr int P6T_B = P2T_E, P6T_E = IB_U + 11000;
constexpr int P0X_B = P6T_E, P0X_E = IB_D + 12000;
constexpr int P11T_B = P0X_E, P11T_E = TI_TOTAL;
constexpr int P0_ITEMS = TI_IN + (P0X_E - P0X_B);
constexpr int TI_PER_GEMV_WAVE = 18, TI_PER_OTHER_WAVE = 42;
static_assert(GEMV_UNITS <= 2048 && GEMV_UNITS * TI_PER_GEMV_WAVE + (2048 - GEMV_UNITS) * TI_PER_OTHER_WAVE >= P0_ITEMS, "P0 item split");

__device__ __forceinline__ void tr_item(Frame& F, int it, LAS float* scr, int lane) {
    int r = it;
    if (r < TI_IN) { p0_transpose_item(F.in[I_WIN], D, IN_COLS, (bf16*)(F.ws + WS_WIN), D, 0, scr, r, lane); return; } r -= TI_IN;
    if (r < TI_OUT) { p0_transpose_item(F.in[I_WOUT], D, D, (bf16*)(F.ws + WS_WOUT), D, 0, scr, r, lane); return; } r -= TI_OUT;
    if (r < TI_G) { const int n0 = 32 * (r % (DFF / 32)); p0_transpose_item(F.in[I_WFG], D, DFF, (bf16*)(F.ws + WS_WGU), D, 256 * (n0 >> 7) + (n0 & 127) - n0, scr, r, lane); return; } r -= TI_G;
    if (r < TI_G) { const int n0 = 32 * (r % (DFF / 32)); p0_transpose_item(F.in[I_WFU], D, DFF, (bf16*)(F.ws + WS_WGU), D, 256 * (n0 >> 7) + 128 + (n0 & 127) - n0, scr, r, lane); return; } r -= TI_G;
    p0_transpose_item(F.in[I_WFD], DFF, D, (bf16*)(F.ws + WS_WDN), DFF, 0, scr, r, lane);
}
__device__ __forceinline__ void tr_range(Frame& F, int b, int e, int rank, int nw, LAS float* scr, int lane) {
    const int per = (e - b + nw - 1) / nw; int i0 = b + rank * per, i1 = i0 + per; if (i1 > e) i1 = e;
    for (int it = i0; it < i1; ++it) tr_item(F, it, scr, lane);
}
__device__ __forceinline__ void tr_idle(Frame& F, int b, int e, int rank_blk, int nblk) {
    if (F.G != 256 || rank_blk < 0) return;
    tr_range(F, b, e, rank_blk * NWAVES + F.wave, nblk * NWAVES, (LAS float*)(F.lds + RING_OFF + F.wave * 16384), pg8::mk_lane());
}
__device__ __forceinline__ void p0_gemv_unit(Frame& F, int unit, int lane) {
    const int kc = unit / (MODN / 256), cc = unit % (MODN / 256);
    const int k0 = kc * 256, col = cc * 256 + lane * 4;
    int sv[4], sc[4];
#pragma unroll
    for (int q = 0; q < 4; ++q) { const float c = *(const GAS float*)(F.in[I_C] + k0 + q * 64 + lane), cx = *(const GAS float*)(F.in[I_CCTX] + k0 + q * 64 + lane);
        sv[q] = __builtin_bit_cast(int, c * sigm(c)); sc[q] = __builtin_bit_cast(int, cx * sigm(cx)); }
    f32x4 a0 = (f32x4){0.f, 0.f, 0.f, 0.f}, a1 = a0;
    const GAS f32x4* wp = (const GAS f32x4*)(F.in[I_WADA] + (size_t)k0 * MODN + col);
#pragma unroll
    for (int q = 0; q < 4; ++q) {
#pragma unroll 16
        for (int i = 0; i < 64; ++i) { const f32x4 w = wp[(size_t)(q * 64 + i) * (MODN / 4)];
            const float s = __builtin_bit_cast(float, __builtin_amdgcn_readlane(sv[q], i)), t = __builtin_bit_cast(float, __builtin_amdgcn_readlane(sc[q], i));
            a0 += w * s; a1 += w * t; }
    }
    float* mp = (float*)(F.ws + WS_MODP);
    *(GAS f32x4*)(mp + (size_t)(kc * 2 + 0) * MODN + col) = a0;
    *(GAS f32x4*)(mp + (size_t)(kc * 2 + 1) * MODN + col) = a1;
}

__device__ __forceinline__ void p0_prologue(Frame& F) {
    LAS float* scr = (LAS float*)(F.lds + RING_OFF + F.wave * 16384);
    const int lane = pg8::mk_lane();
    const int gw = F.vcu * NWAVES + F.wave, NGW = F.G * NWAVES;
    const int gt = gw * 64 + lane, NGT = NGW * 64;
    {
        unsigned* wl = (unsigned*)(F.ws + WS_WLORA);
        for (int i = gt; i < NLORA * KLORA / 2; i += NGT) { const int n = i >> 7, k = (i & 127) * 2, pn = n >> 8, d = pn >> 4, isic = (n >> 7) & 1, ch = (pn & 15) * 128 + (n & 127); float v0 = 0.f, v1 = 0.f;
            if (k < 96) { if (!isic) { v0 = *(const GAS float*)(F.in[I_WDU] + (size_t)(d * 96 + k) * 2048 + ch); v1 = *(const GAS float*)(F.in[I_WDU] + (size_t)(d * 96 + k + 1) * 2048 + ch); } }
            else if (k < 192) { if (isic) { v0 = *(const GAS float*)(F.in[I_WIU] + (size_t)(d * 96 + k - 96) * 2048 + ch); v1 = *(const GAS float*)(F.in[I_WIU] + (size_t)(d * 96 + k - 95) * 2048 + ch); } }
            *(GAS unsigned*)(wl + i) = pk2(v0, v1); }
        unsigned* wg = (unsigned*)(F.ws + WS_WGATE);
        for (int i = gt; i < 2048 * KGATE / 2; i += NGT) { const int n = i >> 7, k = (i & 127) * 2;
            *(GAS unsigned*)(wg + i) = pk2(*(const GAS float*)(F.in[I_WGU] + (size_t)k * 2048 + n), *(const GAS float*)(F.in[I_WGU] + (size_t)(k + 1) * 2048 + n)); }
        v4u* zp = (v4u*)(F.ws + WS_WIN + (size_t)IN_COLS * D * 2);
        for (int i = gt; i < (NZ - IN_COLS) * D * 2 / 16; i += NGT) *(GAS v4u*)(zp + i) = (v4u){0u, 0u, 0u, 0u};
    }
    for (int u = gw; u < GEMV_UNITS; u += NGW) p0_gemv_unit(F, u, lane);
    if (F.G == 256) {
        int it0, it1;
        if (gw < GEMV_UNITS) { it0 = gw * TI_PER_GEMV_WAVE; it1 = it0 + TI_PER_GEMV_WAVE; }
        else { it0 = GEMV_UNITS * TI_PER_GEMV_WAVE + (gw - GEMV_UNITS) * TI_PER_OTHER_WAVE; it1 = it0 + TI_PER_OTHER_WAVE; }
        if (it1 > P0_ITEMS) it1 = P0_ITEMS;
        for (int it = it0; it < it1; ++it) tr_item(F, it < TI_IN ? it : P0X_B + (it - TI_IN), scr, lane);
    } else tr_range(F, 0, TI_TOTAL, gw, NGW, scr, lane);
}

__device__ __forceinline__ void norm_row_load(const float* xrow, int lane, f32x4 (&v)[16]) {
    const GAS f32x4* xr = (const GAS f32x4*)xrow + lane;
#pragma unroll
    for (int j = 0; j < 16; ++j) v[j] = xr[64 * j];
}
__device__ __forceinline__ void norm_row_finish(const f32x4 (&v)[16], bf16* orow, const LAS float* gs, const LAS float* sh, int lane) {
    float s = 0.f;
#pragma unroll
    for (int j = 0; j < 16; ++j) s += (v[j].x * v[j].x + v[j].y * v[j].y) + (v[j].z * v[j].z + v[j].w * v[j].w);
    const float rstd = 1.0f / sqrtf(wave_sum(s) * (1.f / D) + NORM_EPS);
    GAS v2u* o8 = (GAS v2u*)orow + lane;
#pragma unroll
    for (int j = 0; j < 16; ++j) { const f32x4 g = *(const LAS f32x4*)(gs + 4 * lane + 256 * j), b = *(const LAS f32x4*)(sh + 4 * lane + 256 * j);
        const f32x4 y = v[j] * rstd * g + b; v2u o; o.x = pk2(y.x, y.y); o.y = pk2(y.z, y.w); o8[64 * j] = o; }
}
__device__ __forceinline__ void norm_row(const float* xrow, bf16* orow, const LAS float* gs, const LAS float* sh, int lane) {
    f32x4 v[16]; norm_row_load(xrow, lane, v); norm_row_finish(v, orow, gs, sh, lane);
}
__device__ __forceinline__ void p1_norm1(Frame& F) {
    const int lane = pg8::mk_lane(), tid = F.wave * 64 + lane;
    const int gw = F.vcu * NWAVES + F.wave, NGW = F.G * NWAVES;
    bf16* A1 = (bf16*)(F.ws + WS_A1);
    f32x4 v0[16]; norm_row_load(F.in[I_X] + (size_t)gw * D, lane, v0);
    LAS float* tab = (LAS float*)(F.lds + RING_OFF);
    const float* mp = (const float*)(F.ws + WS_MODP);
    bool need_ctx = false;
    for (int m = F.vcu * NWAVES; m < TT; m += NGW) if (m + NWAVES > T) need_ctx = true;
    for (int i = tid; i < (need_ctx ? 4 : 2) * (D / 4); i += NWAVES * 64) {
        const int which = i >> 10, k = (i & (D / 4 - 1)) * 4, isc = which >> 1, part = which & 1;
        const int col = part == 0 ? D + k : k;
        f32x4 s = *(const GAS f32x4*)(F.in[I_BADA] + col);
#pragma unroll
        for (int p = 0; p < NKC; ++p) s += *(const GAS f32x4*)(mp + (size_t)(p * 2 + isc) * MODN + col);
        if (part == 0) s = *(const GAS f32x4*)(F.in[I_NORM1] + k) * (1.0f + s);
        *(LAS f32x4*)(tab + which * D + k) = s;
    }
    {
        float* mv = (float*)(F.ws + WS_MODV);
        for (int i = F.vcu * (NWAVES * 64) + tid; i < 2 * MODN; i += F.G * NWAVES * 64) { const int isc = i / MODN, col = i % MODN;
            float s = *(const GAS float*)(F.in[I_BADA] + col);
#pragma unroll
            for (int p = 0; p < NKC; ++p) s += *(const GAS float*)(mp + (size_t)(p * 2 + isc) * MODN + col);
            *(GAS float*)(mv + i) = s; }
    }
    __syncthreads();
    f32x4 v1[16];
#define MK_P1_SRC(m_) ((m_) < T ? F.in[I_X] + (size_t)(m_) * D : F.in[I_CTX] + (size_t)((m_) - T) * D)
#define MK_P1_FIN(v_, m_) do { if ((m_) < T) norm_row_finish(v_, A1 + (size_t)(m_) * D, tab, tab + D, lane); else norm_row_finish(v_, A1 + (size_t)(m_) * D, tab + 2 * D, tab + 3 * D, lane); } while (0)
    for (int m = gw; m < TT; m += 2 * NGW) {
        const int m2 = m + NGW, m3 = m2 + NGW;
        if (m2 < TT) norm_row_load(MK_P1_SRC(m2), lane, v1);
        MK_P1_FIN(v0, m);
        if (m2 < TT) { if (m3 < TT) norm_row_load(MK_P1_SRC(m3), lane, v0); MK_P1_FIN(v1, m2); }
    }
#undef MK_P1_SRC
#undef MK_P1_FIN
    __syncthreads();
}
__device__ __forceinline__ void p10_norm2(Frame& F) {
    const int lane = pg8::mk_lane(), tid = F.wave * 64 + lane;
    LAS float* tab = (LAS float*)(F.lds + RING_OFF);
    const float* mv = (const float*)(F.ws + WS_MODV);
    const int gw = F.vcu * NWAVES + F.wave, NGW = F.G * NWAVES;
    bf16* A1 = (bf16*)(F.ws + WS_A1); const float* X1 = (const float*)(F.ws + WS_X1);
    f32x4 v0[16], v1[16];
    if (gw < T) norm_row_load(X1 + (size_t)gw * D, lane, v0);
    for (int i = tid; i < 2 * D; i += NWAVES * 64) { const int part = i >> 12, k = i & (D - 1);
        tab[i] = part == 0 ? *(const GAS float*)(F.in[I_NORM2] + k) * (1.0f + *(const GAS float*)(mv + 4 * D + k)) : *(const GAS float*)(mv + 3 * D + k); }
    __syncthreads();
    for (int m = gw; m < T; m += 2 * NGW) {
        const int m2 = m + NGW, m3 = m2 + NGW;
        if (m2 < T) norm_row_load(X1 + (size_t)m2 * D, lane, v1);
        asm volatile("" ::: "memory");
        norm_row_finish(v0, A1 + (size_t)m * D, tab, tab + D, lane);
        asm volatile("" ::: "memory");
        if (m2 < T) { if (m3 < T) norm_row_load(X1 + (size_t)m3 * D, lane, v0); asm volatile("" ::: "memory"); norm_row_finish(v1, A1 + (size_t)m2 * D, tab, tab + D, lane); asm volatile("" ::: "memory"); }
    }
    __syncthreads();
}
__device__ __forceinline__ void p13_final(Frame& F) {
    const int lane = pg8::mk_lane();
    const int gw = F.vcu * NWAVES + F.wave, NGW = F.G * NWAVES;
    f32x4 v0[16], v1[16];
#define MK_P13_FIN(v_, m_) do { float s_ = 0.f; _Pragma("unroll") for (int j = 0; j < 16; ++j) s_ += (v_[j].x * v_[j].x + v_[j].y * v_[j].y) + (v_[j].z * v_[j].z + v_[j].w * v_[j].w); \
        const float rstd_ = 1.0f / sqrtf(wave_sum(s_) * (1.f / D) + NORM_EPS); GAS f32x4* xo_ = (GAS f32x4*)(F.out + (size_t)(m_) * D) + lane; \
        _Pragma("unroll") for (int j = 0; j < 16; ++j) xo_[64 * j] = v_[j] * rstd_ * *((const GAS f32x4*)F.in[I_NORMF] + lane + 64 * j); } while (0)
    if (gw < T) norm_row_load(F.out + (size_t)gw * D, lane, v0);
    for (int m = gw; m < T; m += 2 * NGW) {
        const int m2 = m + NGW, m3 = m2 + NGW;
        if (m2 < T) norm_row_load(F.out + (size_t)m2 * D, lane, v1);
        MK_P13_FIN(v0, m);
        if (m2 < T) { if (m3 < T) norm_row_load(F.out + (size_t)m3 * D, lane, v0); MK_P13_FIN(v1, m2); }
    }
#undef MK_P13_FIN
}

__device__ __forceinline__ void ld8(const bf16* p, float (&f)[8]) { const v4u r = *(const GAS v4u*)p;
    f[0] = bflo(r.x); f[1] = bfhi(r.x); f[2] = bflo(r.y); f[3] = bfhi(r.y); f[4] = bflo(r.z); f[5] = bfhi(r.z); f[6] = bflo(r.w); f[7] = bfhi(r.w); }
__device__ __forceinline__ void ldf8(const float* p, float (&f)[8]) { const f32x4 a = *(const GAS f32x4*)p, b = *(const GAS f32x4*)(p + 4);
    f[0] = a.x; f[1] = a.y; f[2] = a.z; f[3] = a.w; f[4] = b.x; f[5] = b.y; f[6] = b.z; f[7] = b.w; }
__device__ __forceinline__ void stf8(float* p, const float (&f)[8]) { *(GAS f32x4*)p = (f32x4){f[0], f[1], f[2], f[3]}; *(GAS f32x4*)(p + 4) = (f32x4){f[4], f[5], f[6], f[7]}; }
__device__ __forceinline__ void stb8(bf16* p, const float (&f)[8]) { v4u o; o.x = pk2(f[0], f[1]); o.y = pk2(f[2], f[3]); o.z = pk2(f[4], f[5]); o.w = pk2(f[6], f[7]); *(GAS v4u*)p = o; }
__device__ __forceinline__ void za8(const bf16* Z, int row, bool hp, bool hn, int c, const float* mu, float (&o)[8]) {
    float zc[8], zp[8], zn[8], m8[8];
    ld8(Z + (size_t)row * NZ + c, zc);
    if (hp) ld8(Z + (size_t)(row - 1) * NZ + c, zp); else { _Pragma("unroll") for (int i = 0; i < 8; ++i) zp[i] = 0.f; }
    if (hn) ld8(Z + (size_t)(row + 1) * NZ + c, zn); else { _Pragma("unroll") for (int i = 0; i < 8; ++i) zn[i] = 0.f; }
    ldf8(mu + c, m8);
#pragma unroll
    for (int i = 0; i < 8; ++i) o[i] = zc[i] + m8[i] * (0.5f * (zp[i] + zn[i]) - zc[i]);
}
__device__ __forceinline__ void zero8(float (&f)[8]) {
#pragma unroll
    for (int i = 0; i < 8; ++i) f[i] = 0.f; }
__device__ __forceinline__ void cp8(float (&d)[8], const float (&s)[8]) {
#pragma unroll
    for (int i = 0; i < 8; ++i) d[i] = s[i]; }
__device__ __forceinline__ void un8(const v4u r, float (&f)[8]) { f[0] = bflo(r.x); f[1] = bfhi(r.x); f[2] = bflo(r.y); f[3] = bfhi(r.y); f[4] = bflo(r.z); f[5] = bfhi(r.z); f[6] = bflo(r.w); f[7] = bfhi(r.w); }
__device__ __forceinline__ v4u ldraw(const bf16* p, bool ok) { return ok ? *(const GAS v4u*)p : (v4u){0u, 0u, 0u, 0u}; }
__device__ __forceinline__ void p3_prep(Frame& F) {
    const bf16* Z = (const bf16*)(F.ws + WS_Z);
    bf16* KB = (bf16*)(F.ws + WS_KBUF); bf16* KKB = (bf16*)(F.ws + WS_KKBUF); bf16* RB = (bf16*)(F.ws + WS_RBUF); bf16* VB = (bf16*)(F.ws + WS_VBUF);
    bf16* AL = (bf16*)(F.ws + WS_ALORA); bf16* AG = (bf16*)(F.ws + WS_AGATE); bf16* CAT = (bf16*)(F.ws + WS_CAT);
    const float* mu = F.in[I_MU];
    const int tpb = (TT + F.G - 1) / F.G;
    const int tok0 = F.vcu * tpb, half0 = (tpb + 1) / 2;
    const int lane = pg8::mk_lane();
    for (int it = F.wave; it < 36; it += NWAVES) {
        const int type = it >> 1, hf = it & 1;
        int tA = tok0 + (hf ? half0 : 0), tB = tok0 + (hf ? tpb : half0);
        if (tB > TT) tB = TT;
        if (tA >= tB) continue;
        if (type < 14) {
            int zoff, c = 0; bool act = true;
            if (type < 12) { const int kind = type >> 2; c = (type & 3) * 512 + lane * 8; zoff = (kind == 0 ? OFF_K : (kind == 1 ? OFF_V : OFF_R)) + c; }
            else if (type == 12) { act = lane < 24; zoff = OFF_WL + (act ? lane : 0) * 8; }
            else { act = lane < 32; zoff = OFF_GL + (act ? lane : 0) * 8; }
            float m8[8], kk8[8]; ldf8(mu + zoff, m8);
            if (type < 4) ldf8(F.in[I_KK] + c, kk8); else zero8(kk8);
            const bf16* zb = Z + zoff;
            v4u rw[6];
#pragma unroll
            for (int u = 0; u < 6; ++u) { const int r = tA - 1 + u; rw[u] = ldraw(zb + (size_t)(r < 0 ? 0 : r) * NZ, r >= 0 && r < TT); }
            for (int t0 = tA; t0 < tB; t0 += 4) {
                v4u nx[4];
#pragma unroll
                for (int u = 0; u < 4; ++u) { const int r = t0 + 5 + u; nx[u] = ldraw(zb + (size_t)(r < TT ? r : 0) * NZ, r < TT); }
#pragma unroll
                for (int u = 0; u < 4; ++u) {
                    const int t = t0 + u;
                    if (t < tB) {
                        const bool isctx = t >= T; const int pos = isctx ? t - T : (t & 63);
                        const bool hp = pos > 0, hn = isctx ? (pos < CTXL - 1) : (pos < 63);
                        float zp[8], zc[8], zn[8], v[8]; un8(rw[u], zp); un8(rw[u + 1], zc); un8(rw[u + 2], zn);
#pragma unroll
                        for (int i = 0; i < 8; ++i) v[i] = zc[i] + m8[i] * (0.5f * ((hp ? zp[i] : 0.f) + (hn ? zn[i] : 0.f)) - zc[i]);
                        const size_t fo = (size_t)t * 2048 + c;
                        if (type < 4) {
                            stb8(KB + fo, v);
                            float q[8]; float ss = 0.f;
#pragma unroll
                            for (int i = 0; i < 8; ++i) { q[i] = v[i] * kk8[i]; ss += q[i] * q[i]; }
                            ss += __shfl_xor(ss, 1); ss += __shfl_xor(ss, 2); ss += __shfl_xor(ss, 4);
                            const float inv = 1.0f / fmaxf(sqrtf(ss), 1e-12f);
#pragma unroll
                            for (int i = 0; i < 8; ++i) q[i] *= inv;
                            stb8(KKB + fo, q);
                        } else if (type < 8) stb8(VB + fo, v);
                        else if (type < 12) { if (!isctx) stb8(RB + fo, v); }
                        else if (type == 12) {
                            if (lane < 32) { float o[8];
                                if (lane < 12) { _Pragma("unroll") for (int i = 0; i < 8; ++i) o[i] = tanhf(v[i]); }
                                else if (lane < 24) cp8(o, v);
                                else zero8(o);
                                stb8(AL + (size_t)t * KLORA + lane * 8, o); }
                        } else { if (!isctx && lane < 32) { float o[8];
#pragma unroll
                                for (int i = 0; i < 8; ++i) o[i] = sigm(v[i]);
                                stb8(AG + (size_t)t * KGATE + lane * 8, o); } }
                    }
                }
                rw[0] = rw[4]; rw[1] = rw[5]; rw[2] = nx[0]; rw[3] = nx[1]; rw[4] = nx[2]; rw[5] = nx[3];
            }
        } else {
            if (tA >= T) continue;
            if (tB > T) tB = T;
            const int c = (type - 14) * 512 + lane * 8;
            float w0[8], w1[8], w2[8];
            ldf8(F.in[I_CONVW] + c, w0); ldf8(F.in[I_CONVW] + 2048 + c, w1); ldf8(F.in[I_CONVW] + 4096 + c, w2);
            const bf16* zc_ = Z + OFF_CC + c; const bf16* zx_ = Z + OFF_CX + c; const bf16* zb_ = Z + OFF_CB + c;
            v4u cw[6], xw[6], bw[4];
#pragma unroll
            for (int u = 0; u < 6; ++u) { const int r = tA - 1 + u; const bool ok = r >= 0 && r < T; const size_t ro = (size_t)(ok ? r : 0) * NZ; cw[u] = ldraw(zc_ + ro, ok); xw[u] = ldraw(zx_ + ro, ok); }
#pragma unroll
            for (int u = 0; u < 4; ++u) { const int r = tA + u; const bool ok = r < T; bw[u] = ldraw(zb_ + (size_t)(ok ? r : 0) * NZ, ok); }
            for (int t0 = tA; t0 < tB; t0 += 4) {
                v4u cn[4], xn[4], bn[4];
#pragma unroll
                for (int u = 0; u < 4; ++u) { const int r = t0 + 5 + u; const bool ok = r < T; const size_t ro = (size_t)(ok ? r : 0) * NZ; cn[u] = ldraw(zc_ + ro, ok); xn[u] = ldraw(zx_ + ro, ok);
                    const int rb = t0 + 4 + u; const bool okb = rb < T; bn[u] = ldraw(zb_ + (size_t)(okb ? rb : 0) * NZ, okb); }
#pragma unroll
                for (int u = 0; u < 4; ++u) {
                    const int t = t0 + u;
                    if (t < tB) {
                        const int pos = t & 63; const bool hp = pos > 0, hn = pos < 63;
                        float cp_[8], xp_[8], cc_[8], xc_[8], cn_[8], xn_[8], bg[8], y[8];
                        un8(cw[u], cp_); un8(xw[u], xp_); un8(cw[u + 1], cc_); un8(xw[u + 1], xc_); un8(cw[u + 2], cn_); un8(xw[u + 2], xn_); un8(bw[u], bg);
#pragma unroll
                        for (int i = 0; i < 8; ++i) y[i] = bg[i] * (w0[i] * (hp ? cp_[i] * xp_[i] : 0.f) + w1[i] * (cc_[i] * xc_[i]) + w2[i] * (hn ? cn_[i] * xn_[i] : 0.f));
                        stb8(CAT + (size_t)t * D + DR + c, y);
                    }
                }
                cw[0] = cw[4]; cw[1] = cw[5]; cw[2] = cn[0]; cw[3] = cn[1]; cw[4] = cn[2]; cw[5] = cn[3];
                xw[0] = xw[4]; xw[1] = xw[5]; xw[2] = xn[0]; xw[3] = xn[1]; xw[4] = xn[2]; xw[5] = xn[3];
                bw[0] = bn[0]; bw[1] = bn[1]; bw[2] = bn[2]; bw[3] = bn[3];
            }
        }
    }
}

typedef float f32x16 __attribute__((ext_vector_type(16)));
#define MK_FENCE() asm volatile("" ::: "memory")
constexpr int REC_BYTES = 8448, NBLK = TT / 16, SCAN_LDS = REC_BYTES + 4096;
__device__ __forceinline__ void swap32(float& x, float& y) { asm volatile("s_nop 1\n\tv_permlane32_swap_b32 %0, %1\n\ts_nop 1" : "+v"(x), "+v"(y)); }
__device__ __forceinline__ int kperm(int k) { return ((((k >> 5) * 2 + ((k >> 4) & 1)) * 2 + ((k >> 2) & 1)) * 8 + ((k >> 3) & 1) * 4 + (k & 3)); }
__device__ __forceinline__ int scan_blkbase(int d, int c, int j) {
    if (c == 0) return T + (d == 0 ? 16 * j : CTXL - 16 - 16 * j);
    const int p0 = (c - 1) * CHUNK + 16 * j;
    return d == 0 ? p0 : T - 16 - p0;
}
__device__ __forceinline__ void scan_vec32(const LAS unsigned char* row, int hl, float (&f)[32]) {
#pragma unroll
    for (int q = 0; q < 4; ++q) { const v4u w = *(const LAS v4u*)(row + (q * 2 + hl) * 16);
        f[8 * q + 0] = bflo(w.x); f[8 * q + 1] = bfhi(w.x); f[8 * q + 2] = bflo(w.y); f[8 * q + 3] = bfhi(w.y); f[8 * q + 4] = bflo(w.z); f[8 * q + 5] = bfhi(w.z); f[8 * q + 6] = bflo(w.w); f[8 * q + 7] = bfhi(w.w); }
}
__device__ __forceinline__ void scan_matvec(const f32x16 (&Tt)[2][2], const float (&f)[32], float& sa) {
    float p0a = 0.f, p0b = 0.f, p1a = 0.f, p1b = 0.f;
#pragma unroll
    for (int I = 0; I < 2; ++I)
#pragma unroll
        for (int r = 0; r < 16; r += 2) { p0a += Tt[I][0][r] * f[16 * I + r]; p1a += Tt[I][1][r] * f[16 * I + r]; p0b += Tt[I][0][r + 1] * f[16 * I + r + 1]; p1b += Tt[I][1][r + 1] * f[16 * I + r + 1]; }
    float p0 = p0a + p0b, p1 = p1a + p1b;
    swap32(p0, p1);
    sa = p0 + p1;
}
__device__ __forceinline__ void scan_renorm(f32x16 (&Tt)[2][2], const LAS float* ge, int hl) {
#pragma unroll
    for (int I = 0; I < 2; ++I)
#pragma unroll
        for (int qd = 0; qd < 4; ++qd) { const f32x4 g = *(const LAS f32x4*)(ge + 32 * I + 8 * qd + 4 * hl);
#pragma unroll
            for (int e = 0; e < 4; ++e) { Tt[I][0][4 * qd + e] *= g[e]; Tt[I][1][4 * qd + e] *= g[e]; } }
}
__device__ __forceinline__ void scan_store_T(const f32x16 (&Tt)[2][2], float* dst, int lane) {
#pragma unroll
    for (int I = 0; I < 2; ++I)
#pragma unroll
        for (int J = 0; J < 2; ++J)
#pragma unroll
            for (int reg = 0; reg < 16; ++reg) *(GAS float*)(dst + (32 * I + 8 * (reg >> 2) + 4 * (lane >> 5) + (reg & 3)) * 64 + 32 * J + (lane & 31)) = Tt[I][J][reg];
}
typedef short bf16x8 __attribute__((ext_vector_type(8)));
#define MK_MFMA(a, b, c) __builtin_amdgcn_mfma_f32_32x32x16_bf16((a), (b), (c), 0, 0, 0)
constexpr int SCR_LAB = 0, SCR_LAK = 1024, SCR_MRB = 2048, SCR_MRK = 2560, SCAN_SCR = 3072;
struct RecRegs { v4u p[8]; float ge; };
__device__ __forceinline__ void scan_rload(const unsigned char* PKB, int d, int h, int tb, int lane, RecRegs& R) {
    const GAS unsigned char* rp = (const GAS unsigned char*)PKB + ((size_t)(d * 32 + h) * NBLK + (tb >> 4)) * REC_BYTES;
#pragma unroll
    for (int j = 0; j < 8; ++j) R.p[j] = *((const GAS v4u*)rp + 64 * j + lane);
    R.ge = *((const GAS float*)(rp + 8192) + lane);
}
__device__ __forceinline__ void scan_rstore(LAS unsigned char* buf, int lane, const RecRegs& R) {
#pragma unroll
    for (int j = 0; j < 8; ++j) *((LAS v4u*)buf + 64 * j + lane) = R.p[j];
    *((LAS float*)(buf + 8192) + lane) = R.ge;
}
typedef float f32x2n __attribute__((ext_vector_type(2)));
typedef __bf16 bf16x2n __attribute__((ext_vector_type(2)));
__device__ __forceinline__ unsigned cvt2bf(float a, float b) { const f32x2n v = {a, b}; return __builtin_bit_cast(unsigned, __builtin_convertvector(v, bf16x2n)); }
__device__ __forceinline__ bf16x8 pack8(float a0, float a1, float a2, float a3, float a4, float a5, float a6, float a7) {
    const v4u u = {cvt2bf(a0, a1), cvt2bf(a2, a3), cvt2bf(a4, a5), cvt2bf(a6, a7)}; return __builtin_bit_cast(bf16x8, u); }
__device__ __forceinline__ f32x16 zero16() { f32x16 z;
#pragma unroll
    for (int i = 0; i < 16; ++i) z[i] = 0.f;
    return z; }
__device__ __forceinline__ void scan_tfrags(const f32x16 (&Tt)[2][2], bf16x8 (&Tf)[2][2][2]) {
#pragma unroll
    for (int I = 0; I < 2; ++I)
#pragma unroll
        for (int J = 0; J < 2; ++J)
#pragma unroll
            for (int s = 0; s < 2; ++s) Tf[I][J][s] = pack8(Tt[I][J][8 * s], Tt[I][J][8 * s + 1], Tt[I][J][8 * s + 2], Tt[I][J][8 * s + 3], Tt[I][J][8 * s + 4], Tt[I][J][8 * s + 5], Tt[I][J][8 * s + 6], Tt[I][J][8 * s + 7]);
}
__device__ __forceinline__ void scan_sfrags(float (&S)[16], bf16x8 (&Sf)[2]) {
#pragma unroll
    for (int j = 0; j < 8; ++j) swap32(S[j], S[j + 8]);
    Sf[0] = pack8(S[0], S[1], S[2], S[3], S[4], S[5], S[6], S[7]); Sf[1] = pack8(S[8], S[9], S[10], S[11], S[12], S[13], S[14], S[15]);
}
template <int WHICH> __device__ __forceinline__ void p5_pass(Frame& F, const int unit) {
    const unsigned char* PKB = F.ws + WS_PK; const bf16* VB = (const bf16*)(F.ws + WS_VBUF);
    float* PU = (float*)(F.ws + WS_PU);
    LAS unsigned char* my = F.lds + RING_OFF + F.wave * (REC_BYTES + SCAN_SCR);
    LAS unsigned char* scr = my + REC_BYTES;
    {
        const int d = unit & 1, h = (unit >> 1) & 31, c = unit >> 6;
        constexpr int which = WHICH;
        {
            const int lane = pg8::mk_lane(), hl = lane >> 5, l31 = lane & 31, l15 = lane & 15;
            const float idv = which ? 1.0f : 0.0f;
            f32x16 Tt[2][2];
#pragma unroll
            for (int I = 0; I < 2; ++I)
#pragma unroll
                for (int J = 0; J < 2; ++J)
#pragma unroll
                    for (int reg = 0; reg < 16; ++reg) Tt[I][J][reg] = (32 * I + 8 * (reg >> 2) + 4 * hl + (reg & 3) == 32 * J + l31) ? idv : 0.0f;
            RecRegs R;
            scan_rload(PKB, d, h, scan_blkbase(d, c, 0), lane, R);
#pragma unroll 1
            for (int j = 0; j < 16; ++j) {
                const int tb = scan_blkbase(d, c, j);
                scan_rstore(my, lane, R);
                float Vv[16];
                if (which == 0) { const GAS bf16* gv = (const GAS bf16*)(VB + (size_t)(tb + (d == 0 ? 0 : 15)) * 2048 + h * 64) + lane; const int dstep = d == 0 ? 2048 : -2048;
#pragma unroll
                    for (int t = 0; t < 16; ++t) Vv[t] = __builtin_bit_cast(float, (unsigned)gv[t * dstep] << 16); }
                else {
#pragma unroll
                    for (int t = 0; t < 16; ++t) Vv[t] = 0.f; }
                const LAS unsigned char* arow = my + l15 * 128 + hl * 16;
                {   f32x16 Lab = zero16(), Lak = zero16();
#pragma unroll
                    for (int qq = 0; qq < 4; ++qq) { const bf16x8 af = *(const LAS bf16x8*)(arow + qq * 32), bf = *(const LAS bf16x8*)(arow + 4096 + qq * 32), kf = *(const LAS bf16x8*)(arow + 6144 + qq * 32);
                        Lab = MK_MFMA(af, bf, Lab); if (which == 0) Lak = MK_MFMA(af, kf, Lak); }
                    if (l31 < 16) { LAS float* lb = (LAS float*)scr + 64 * hl + l31;
#pragma unroll
                        for (int r = 0; r < 8; ++r) { const int t0 = 8 * (r >> 2) + (r & 3); lb[SCR_LAB / 4 + t0 * 16] = Lab[r]; lb[SCR_LAK / 4 + t0 * 16] = Lak[r]; } }
                }
                MK_FENCE();
                f32x16 G[2];
                {   bf16x8 Tf[2][2][2]; scan_tfrags(Tt, Tf);
                    G[0] = zero16(); G[1] = zero16();
#pragma unroll
                    for (int qq = 0; qq < 4; ++qq) { const bf16x8 af = *(const LAS bf16x8*)(arow + qq * 32);
                        G[0] = MK_MFMA(af, Tf[qq >> 1][0][qq & 1], G[0]); G[1] = MK_MFMA(af, Tf[qq >> 1][1][qq & 1], G[1]); }
                }
                MK_FENCE();
                if (j + 1 < 16) scan_rload(PKB, d, h, scan_blkbase(d, c, j + 1), lane, R);
                float S[16];
#pragma unroll
                for (int r = 0; r < 8; ++r) { float x = G[0][r], y = G[1][r]; swap32(x, y); const int t = 8 * (r >> 2) + (r & 3); S[t] = x; S[t + 4] = y; }
#pragma unroll
                for (int t = 1; t < 16; ++t) {
                    float acc = S[t], acc1 = 0.f, acc2 = 0.f, acc3 = 0.f;
#pragma unroll
                    for (int s4 = 0; s4 < (t + 3) / 4; ++s4) { const f32x4 la = *(const LAS f32x4*)(scr + SCR_LAB + (t * 16 + 4 * s4) * 4), lk = *(const LAS f32x4*)(scr + SCR_LAK + (t * 16 + 4 * s4) * 4);
#pragma unroll
                        for (int e = 0; e < 4; ++e) if (4 * s4 + e < t) { if (e & 1) acc1 += la[e] * S[4 * s4 + e]; else acc += la[e] * S[4 * s4 + e];
                            if (which == 0) { if (e & 1) acc3 += lk[e] * Vv[4 * s4 + e]; else acc2 += lk[e] * Vv[4 * s4 + e]; } } }
                    S[t] = (acc + acc1) + (acc2 + acc3);
                }
                bf16x8 Sf[2], Vf[2]; scan_sfrags(S, Sf); if (which == 0) scan_sfrags(Vv, Vf);
#pragma unroll
                for (int I = 0; I < 2; ++I) {
                    const LAS unsigned char* col = my + 4096 + (8 * hl) * 128 + kperm(32 * I + l31) * 2;
                    unsigned short bs[8], ks[8];
#pragma unroll
                    for (int e = 0; e < 8; ++e) { bs[e] = *(const LAS unsigned short*)(col + e * 128); ks[e] = *(const LAS unsigned short*)(col + 2048 + e * 128); }
                    const v4u bu = {(unsigned)bs[0] | ((unsigned)bs[1] << 16), (unsigned)bs[2] | ((unsigned)bs[3] << 16), (unsigned)bs[4] | ((unsigned)bs[5] << 16), (unsigned)bs[6] | ((unsigned)bs[7] << 16)};
                    const v4u ku = {(unsigned)ks[0] | ((unsigned)ks[1] << 16), (unsigned)ks[2] | ((unsigned)ks[3] << 16), (unsigned)ks[4] | ((unsigned)ks[5] << 16), (unsigned)ks[6] | ((unsigned)ks[7] << 16)};
                    const bf16x8 ba = __builtin_bit_cast(bf16x8, bu), ka = __builtin_bit_cast(bf16x8, ku);
                    Tt[I][0] = MK_MFMA(ba, Sf[0], Tt[I][0]); Tt[I][1] = MK_MFMA(ba, Sf[1], Tt[I][1]); if (which == 0) { Tt[I][0] = MK_MFMA(ka, Vf[0], Tt[I][0]); Tt[I][1] = MK_MFMA(ka, Vf[1], Tt[I][1]); }
                }
                scan_renorm(Tt, (const LAS float*)(my + 8192), hl);
            }
            scan_store_T(Tt, PU + ((size_t)unit * 2 + (which ? 0 : 1)) * 4096, lane);
        }
    }
}
__device__ __forceinline__ void p5_scanA(Frame& F) {
    for (int unit = F.vcu * NWAVES + F.wave; unit < 2048; unit += F.G * NWAVES) { p5_pass<0>(F, unit); if (unit >= 64) p5_pass<1>(F, unit); }
}
__device__ __forceinline__ void p6_scanB(Frame& F) {
    const GAS char* PU = (const GAS char*)(F.ws + WS_PU); GAS char* SST = (GAS char*)(F.ws + WS_SST);
    LAS float* PiB = (LAS float*)(F.lds + RING_OFF);
    LAS float* TbB = (LAS float*)(F.lds + RING_OFF + 2 * 16640);
    const int w = F.wave;
    for (int q = F.vcu; q < 64; q += F.G) {
        const unsigned lane = (unsigned)pg8::mk_lane(), tid = (unsigned)w * 64u + lane, hl = lane >> 5, l31 = lane & 31u;
        const unsigned I1 = ((unsigned)w >> 1) & 1u, J = (unsigned)w & 1u;
        {   const GAS char* u0 = PU + ((size_t)q * 2 + 1) * 16384; GAS char* so = SST + ((size_t)q * NCHUNK + 1) * 16384;
            const f32x4 t0 = *(const GAS f32x4*)(u0 + tid * 32u), t1 = *(const GAS f32x4*)(u0 + tid * 32u + 16u);
            *((LAS f32x4*)TbB + tid * 2) = t0; *((LAS f32x4*)TbB + tid * 2 + 1) = t1;
            *(GAS f32x4*)(so + tid * 32u) = t0; *(GAS f32x4*)(so + tid * 32u + 16u) = t1; }
        f32x4 pn0, pn1; f32x16 un;
        {   const GAS char* pg = PU + (((size_t)q + 64) * 2 + 0) * 16384; pn0 = *(const GAS f32x4*)(pg + tid * 32u); pn1 = *(const GAS f32x4*)(pg + tid * 32u + 16u);
            const unsigned pb = (tid >> 3) * 65u + (tid & 7u) * 8u;
#pragma unroll
            for (int e = 0; e < 4; ++e) { PiB[pb + e] = pn0[e]; PiB[pb + 4 + e] = pn1[e]; }
            const GAS char* ug = PU + (((size_t)q + 64) * 2 + 1) * 16384;
#pragma unroll
            for (int r = 0; r < 16; ++r) un[r] = (w < 4) ? *(const GAS float*)(ug + ((32u * I1 + 8u * (r >> 2) + 4u * hl + (r & 3)) * 64u + 32u * J + l31) * 4u) : 0.f; }
        __syncthreads();
        for (int c = 1; c < 32; ++c) {
            const LAS float* Pi = PiB + ((c - 1) & 1) * 4160; const LAS float* Tb = TbB + ((c - 1) & 1) * 4096;
            LAS float* PiN = PiB + (c & 1) * 4160; LAS float* TbN = TbB + (c & 1) * 4096;
            f32x16 acc = un;
            if (c + 1 < 32) {
                const GAS char* pg = PU + (((size_t)q + 64 * (c + 1)) * 2 + 0) * 16384; pn0 = *(const GAS f32x4*)(pg + tid * 32u); pn1 = *(const GAS f32x4*)(pg + tid * 32u + 16u);
                const GAS char* ug = PU + (((size_t)q + 64 * (c + 1)) * 2 + 1) * 16384;
                if (w < 4) {
#pragma unroll
                    for (int r = 0; r < 16; ++r) un[r] = *(const GAS float*)(ug + ((32u * I1 + 8u * (r >> 2) + 4u * hl + (r & 3)) * 64u + 32u * J + l31) * 4u); }
            }
            if (w < 4) {
#pragma unroll
                for (int s2 = 0; s2 < 32; ++s2) { const float av = Pi[(32u * I1 + l31) * 65u + 2u * s2 + hl], bv = Tb[(2u * s2 + hl) * 64u + 32u * J + l31];
                    acc = __builtin_amdgcn_mfma_f32_32x32x2f32(av, bv, acc, 0, 0, 0);
                    if ((s2 & 7) == 7) MK_FENCE(); }
                GAS char* so = SST + ((size_t)q * NCHUNK + c + 1) * 16384;
#pragma unroll
                for (int r = 0; r < 16; ++r) { const unsigned e = (32u * I1 + 8u * (r >> 2) + 4u * hl + (r & 3)) * 64u + 32u * J + l31; TbN[e] = acc[r]; *(GAS float*)(so + e * 4u) = acc[r]; }
            }
            if (c + 1 < 32) { const unsigned pb = (tid >> 3) * 65u + (tid & 7u) * 8u;
#pragma unroll
                for (int e = 0; e < 4; ++e) { PiN[pb + e] = pn0[e]; PiN[pb + 4 + e] = pn1[e]; } }
            __syncthreads();
        }
    }
}
__device__ __forceinline__ void p7_scanC(Frame& F) {
    const unsigned char* PKB = F.ws + WS_PK; const bf16* VB = (const bf16*)(F.ws + WS_VBUF);
    const float* SST = (const float*)(F.ws + WS_SST); bf16* YS = (bf16*)(F.ws + WS_YS);
    LAS unsigned char* my = F.lds + RING_OFF + F.wave * (REC_BYTES + SCAN_SCR);
    LAS unsigned char* scr = my + REC_BYTES;
    for (int unit = F.vcu * NWAVES + F.wave; unit < 2048; unit += F.G * NWAVES) {
        const int d = unit & 1, h = (unit >> 1) & 31, c = (unit >> 6) + 1, q = unit & 63;
        const int lane = pg8::mk_lane(), hl = lane >> 5, l31 = lane & 31, l15 = lane & 15;
        f32x16 Tt[2][2];
        {   const float* s0 = SST + ((size_t)q * NCHUNK + c) * 4096;
#pragma unroll
            for (int I = 0; I < 2; ++I)
#pragma unroll
                for (int J = 0; J < 2; ++J)
#pragma unroll
                    for (int reg = 0; reg < 16; ++reg) Tt[I][J][reg] = *(const GAS float*)(s0 + (32 * I + 8 * (reg >> 2) + 4 * hl + (reg & 3)) * 64 + 32 * J + l31); }
        RecRegs R;
        scan_rload(PKB, d, h, scan_blkbase(d, c, 0), lane, R);
#pragma unroll 1
        for (int j = 0; j < 16; ++j) {
            const int tb = scan_blkbase(d, c, j);
            scan_rstore(my, lane, R);
            float Vv[16];
            {   const GAS bf16* gv = (const GAS bf16*)(VB + (size_t)(tb + (d == 0 ? 0 : 15)) * 2048 + h * 64) + lane; const int dstep = d == 0 ? 2048 : -2048;
#pragma unroll
                for (int t = 0; t < 16; ++t) Vv[t] = __builtin_bit_cast(float, (unsigned)gv[t * dstep] << 16); }
            const LAS unsigned char* arow = my + l15 * 128 + hl * 16;
            {   f32x16 Lab = zero16(), Lak = zero16(), Mrb = zero16(), Mrk = zero16();
#pragma unroll
                for (int qq = 0; qq < 4; ++qq) { const bf16x8 af = *(const LAS bf16x8*)(arow + qq * 32), rf = *(const LAS bf16x8*)(arow + 2048 + qq * 32), bf = *(const LAS bf16x8*)(arow + 4096 + qq * 32), kf = *(const LAS bf16x8*)(arow + 6144 + qq * 32);
                    Lab = MK_MFMA(af, bf, Lab); Lak = MK_MFMA(af, kf, Lak); Mrb = MK_MFMA(rf, bf, Mrb); Mrk = MK_MFMA(rf, kf, Mrk); }
                if (l31 < 16) {
                    LAS float* lb = (LAS float*)scr + 64 * hl + l31; LAS unsigned short* mb = (LAS unsigned short*)scr + 64 * hl + l31; const int lm = l31 - 4 * hl;
#pragma unroll
                    for (int r = 0; r < 8; ++r) { const int t0 = 8 * (r >> 2) + (r & 3);
                        lb[SCR_LAB / 4 + t0 * 16] = Lab[r]; lb[SCR_LAK / 4 + t0 * 16] = Lak[r];
                        mb[SCR_MRB / 2 + t0 * 16] = (unsigned short)f2bf(lm <= t0 ? Mrb[r] : 0.f); mb[SCR_MRK / 2 + t0 * 16] = (unsigned short)f2bf(lm <= t0 ? Mrk[r] : 0.f); }
                }
            }
            MK_FENCE();
            f32x16 G[2], Y[2];
            {   bf16x8 Tf[2][2][2]; scan_tfrags(Tt, Tf);
                G[0] = zero16(); G[1] = zero16(); Y[0] = zero16(); Y[1] = zero16();
#pragma unroll
                for (int qq = 0; qq < 4; ++qq) { const bf16x8 af = *(const LAS bf16x8*)(arow + qq * 32), rf = *(const LAS bf16x8*)(arow + 2048 + qq * 32);
                    G[0] = MK_MFMA(af, Tf[qq >> 1][0][qq & 1], G[0]); G[1] = MK_MFMA(af, Tf[qq >> 1][1][qq & 1], G[1]);
                    Y[0] = MK_MFMA(rf, Tf[qq >> 1][0][qq & 1], Y[0]); Y[1] = MK_MFMA(rf, Tf[qq >> 1][1][qq & 1], Y[1]); }
            }
            MK_FENCE();
            if (j + 1 < 16) scan_rload(PKB, d, h, scan_blkbase(d, c, j + 1), lane, R);
            float S[16];
#pragma unroll
            for (int r = 0; r < 8; ++r) { float x = G[0][r], y = G[1][r]; swap32(x, y); const int t = 8 * (r >> 2) + (r & 3); S[t] = x; S[t + 4] = y; }
#pragma unroll
            for (int t = 1; t < 16; ++t) {
                float acc = S[t], acc1 = 0.f, acc2 = 0.f, acc3 = 0.f;
#pragma unroll
                for (int s4 = 0; s4 < (t + 3) / 4; ++s4) { const f32x4 la = *(const LAS f32x4*)(scr + SCR_LAB + (t * 16 + 4 * s4) * 4), lk = *(const LAS f32x4*)(scr + SCR_LAK + (t * 16 + 4 * s4) * 4);
#pragma unroll
                    for (int e = 0; e < 4; ++e) if (4 * s4 + e < t) { if (e & 1) { acc1 += la[e] * S[4 * s4 + e]; acc3 += lk[e] * Vv[4 * s4 + e]; } else { acc += la[e] * S[4 * s4 + e]; acc2 += lk[e] * Vv[4 * s4 + e]; } } }
                S[t] = (acc + acc1) + (acc2 + acc3);
            }
            bf16x8 Sf[2], Vf[2]; scan_sfrags(S, Sf); scan_sfrags(Vv, Vf);
            {   const bf16x8 mb = *(const LAS bf16x8*)(scr + SCR_MRB + l15 * 32 + hl * 16), mk = *(const LAS bf16x8*)(scr + SCR_MRK + l15 * 32 + hl * 16);
                Y[0] = MK_MFMA(mb, Sf[0], Y[0]); Y[1] = MK_MFMA(mb, Sf[1], Y[1]); Y[0] = MK_MFMA(mk, Vf[0], Y[0]); Y[1] = MK_MFMA(mk, Vf[1], Y[1]); }
#pragma unroll
            for (int I = 0; I < 2; ++I) {
                const LAS unsigned char* col = my + 4096 + (8 * hl) * 128 + kperm(32 * I + l31) * 2;
                unsigned short bs[8], ks[8];
#pragma unroll
                for (int e = 0; e < 8; ++e) { bs[e] = *(const LAS unsigned short*)(col + e * 128); ks[e] = *(const LAS unsigned short*)(col + 2048 + e * 128); }
                const v4u bu = {(unsigned)bs[0] | ((unsigned)bs[1] << 16), (unsigned)bs[2] | ((unsigned)bs[3] << 16), (unsigned)bs[4] | ((unsigned)bs[5] << 16), (unsigned)bs[6] | ((unsigned)bs[7] << 16)};
                const v4u ku = {(unsigned)ks[0] | ((unsigned)ks[1] << 16), (unsigned)ks[2] | ((unsigned)ks[3] << 16), (unsigned)ks[4] | ((unsigned)ks[5] << 16), (unsigned)ks[6] | ((unsigned)ks[7] << 16)};
                const bf16x8 ba = __builtin_bit_cast(bf16x8, bu), ka = __builtin_bit_cast(bf16x8, ku);
                Tt[I][0] = MK_MFMA(ba, Sf[0], Tt[I][0]); Tt[I][1] = MK_MFMA(ba, Sf[1], Tt[I][1]); Tt[I][0] = MK_MFMA(ka, Vf[0], Tt[I][0]); Tt[I][1] = MK_MFMA(ka, Vf[1], Tt[I][1]);
            }
            {   GAS bf16* yb = (GAS bf16*)(YS + (size_t)d * T * 2048 + (size_t)(tb + (d == 0 ? 4 * hl : 15 - 4 * hl)) * 2048 + h * 64) + l31; const int ystep = d == 0 ? 2048 : -2048;
#pragma unroll
                for (int J = 0; J < 2; ++J)
#pragma unroll
                    for (int r = 0; r < 8; ++r) yb[(8 * (r >> 2) + (r & 3)) * ystep + 32 * J] = (bf16)f2bf(Y[J][r]); }
            scan_renorm(Tt, (const LAS float*)(my + 8192), hl);
        }
    }
}

__device__ __forceinline__ void p8_readout(Frame& F) {
    const bf16* RB = (const bf16*)(F.ws + WS_RBUF); const bf16* VB = (const bf16*)(F.ws + WS_VBUF); const bf16* YS = (const bf16*)(F.ws + WS_YS);
    const bf16* KD = (const bf16*)(F.ws + WS_KD);
    const bf16* G = (const bf16*)(F.ws + WS_G); bf16* CAT = (bf16*)(F.ws + WS_CAT);
    const int tpb = (T + F.G - 1) / F.G, tok0 = F.vcu * tpb, lane = pg8::mk_lane();
    for (int it = F.wave; it < tpb * 4; it += NWAVES) {
        const int j = it / tpb, tok = tok0 + it % tpb;
        if (tok >= T) continue;
        const int c = j * 512 + lane * 8;
        float y0[8], y1[8], y[8];
        ld8(YS + (size_t)tok * 2048 + c, y0); ld8(YS + ((size_t)T + tok) * 2048 + c, y1);
        float s = 0.f;
#pragma unroll
        for (int i = 0; i < 8; ++i) { y[i] = y0[i] + y1[i]; s += y[i]; }
        s += __shfl_xor(s, 1); s += __shfl_xor(s, 2); s += __shfl_xor(s, 4);
        const float mean = s * (1.0f / 64.0f); float q = 0.f;
#pragma unroll
        for (int i = 0; i < 8; ++i) { const float dlt = y[i] - mean; q += dlt * dlt; }
        q += __shfl_xor(q, 1); q += __shfl_xor(q, 2); q += __shfl_xor(q, 4);
        const float rstd = 1.0f / sqrtf(q * (1.0f / 64.0f) + LNX_EPS);
        float r8[8], v8[8], k0[8], k1[8], rk[8], lw[8], lb[8], g8[8];
        ld8(RB + (size_t)tok * 2048 + c, r8); ld8(VB + (size_t)tok * 2048 + c, v8);
        ld8(KD + (size_t)tok * 2048 + c, k0); ld8(KD + ((size_t)TT + tok) * 2048 + c, k1);
        ldf8(F.in[I_RK] + c, rk); ldf8(F.in[I_LNXW] + c, lw); ldf8(F.in[I_LNXB] + c, lb);
        ld8(G + (size_t)tok * 2048 + c, g8);
        float dot = 0.f;
#pragma unroll
        for (int i = 0; i < 8; ++i) dot += r8[i] * (k0[i] + k1[i]) * rk[i];
        dot += __shfl_xor(dot, 1); dot += __shfl_xor(dot, 2); dot += __shfl_xor(dot, 4);
        float o[8];
#pragma unroll
        for (int i = 0; i < 8; ++i) o[i] = ((y[i] - mean) * rstd * lw[i] + lb[i] + dot * v8[i]) * g8[i];
        stb8(CAT + (size_t)tok * D + c, o);
    }
}

template <int K> __device__ __forceinline__ void run_phase(Frame& F) {
    bf16* A1 = (bf16*)(F.ws + WS_A1); bf16* Zb = (bf16*)(F.ws + WS_Z);
    const float* MV = (const float*)(F.ws + WS_MODV);
    (void)A1; (void)Zb; (void)MV;
    asm volatile("; MK_PHASE %0" :: "i"(K) : "memory");
    if constexpr (K == 0) { p0_prologue(F);
    }
    if constexpr (K == 1) { p1_norm1(F);
    }
    if constexpr (K == 2) {
        { pg8::Gemm g{A1, (const bf16*)(F.ws + WS_WIN), T, NZ, D}; pg8::StaticOrder S; S.init(T, NZ, F.G, (int)blockIdx.x);
          pg8::EpiBf16<0> E{Zb, NZ, nullptr, 0, 0, 1.f};
          pg8::gemm_phase<pg8::EpiBf16<0>, pg8::StaticOrder, true, true>(F.lds + RING_OFF, g, S, E, F.wave); }
        { pg8::Gemm g{A1 + (size_t)T * D, (const bf16*)(F.ws + WS_WIN), CTXL, NCTXZ, D}; pg8::StaticOrder S; S.init(CTXL, NCTXZ, F.G, (int)((blockIdx.x + F.G - 64) % F.G));
          pg8::EpiBf16<0> E{Zb + (size_t)T * NZ, NZ, nullptr, 0, 0, 1.f};
          pg8::gemm_phase<pg8::EpiBf16<0>, pg8::StaticOrder, true, true>(F.lds + RING_OFF, g, S, E, F.wave); }
        tr_idle(F, P2T_B, P2T_E, (int)blockIdx.x - 81, 175);
    }
    if constexpr (K == 3) { p3_prep(F);
    }
    if constexpr (K == 4) {
        { int kl = KLORA; asm volatile("" : "+s"(kl));
          pg8::Gemm g{(const bf16*)(F.ws + WS_ALORA), (const bf16*)(F.ws + WS_WLORA), TT, NLORA, kl}; pg8::StaticOrder S; S.init(TT, NLORA, F.G, (int)blockIdx.x);
          pg8::EpiLora E{F.ws + WS_PK, (bf16*)(F.ws + WS_KD), (const bf16*)(F.ws + WS_KBUF), (const bf16*)(F.ws + WS_KKBUF), (const bf16*)(F.ws + WS_RBUF), F.in[I_W0], F.in[I_A0], F.in[I_KA], TT};
          pg8::gemm_phase<pg8::EpiLora, pg8::StaticOrder, true, true>(F.lds + RING_OFF, g, S, E, F.wave); }
        { int kl = KGATE; asm volatile("" : "+s"(kl));
          pg8::Gemm g{(const bf16*)(F.ws + WS_AGATE), (const bf16*)(F.ws + WS_WGATE), T, DR, kl}; pg8::StaticOrder S; S.init(T, DR, F.G, (int)blockIdx.x);
          pg8::EpiBf16<0> E{(bf16*)(F.ws + WS_G), DR, nullptr, 0, 0, 1.f};
          pg8::gemm_phase<pg8::EpiBf16<0>, pg8::StaticOrder, true, true>(F.lds + RING_OFF, g, S, E, F.wave); }

    }
    if constexpr (K == 5) { p5_scanA(F);
    }
    if constexpr (K == 6) { p6_scanB(F); tr_idle(F, P6T_B, P6T_E, F.vcu - 64, 192);

    }
    if constexpr (K == 7) { p7_scanC(F);
    }
    if constexpr (K == 8) { p8_readout(F);
    }
    if constexpr (K == 9) {
        pg8::Gemm g{(const bf16*)(F.ws + WS_CAT), (const bf16*)(F.ws + WS_WOUT), T, D, D}; pg8::StaticOrder S; S.init(T, D, F.G, (int)blockIdx.x);
        pg8::EpiResid E{F.in[I_X], (float*)(F.ws + WS_X1), D, MV + 2 * D};
        pg8::gemm_phase<pg8::EpiResid, pg8::StaticOrder, true, true>(F.lds + RING_OFF, g, S, E, F.wave);

    }
    if constexpr (K == 10) { p10_norm2(F);
    }
    if constexpr (K == 11) {
        pg8::Gemm g{A1, (const bf16*)(F.ws + WS_WGU), T, NGU, D}; pg8::StaticOrder S; S.init(T, NGU, F.G, (int)blockIdx.x);
        pg8::EpiSwiglu E{(bf16*)(F.ws + WS_ACT), DFF};
        pg8::gemm_phase<pg8::EpiSwiglu, pg8::StaticOrder, true, true>(F.lds + RING_OFF, g, S, E, F.wave);
        tr_idle(F, P11T_B, P11T_E, (int)blockIdx.x - 192, 64);
    }
    if constexpr (K == 12) {
        pg8::Gemm g{(const bf16*)(F.ws + WS_ACT), (const bf16*)(F.ws + WS_WDN), T, D, DFF}; pg8::StaticOrder S; S.init(T, D, F.G, (int)blockIdx.x);
        pg8::EpiResid E{(const float*)(F.ws + WS_X1), F.out, D, MV + 5 * D};
        pg8::gemm_phase<pg8::EpiResid, pg8::StaticOrder, true, true>(F.lds + RING_OFF, g, S, E, F.wave);

    }
    if constexpr (K == 13) { p13_final(F);
    }
}

struct Args { const float* in[26]; float* out; unsigned char* ws; int ph_lo, ph_hi, li, pad; };
__global__ void __launch_bounds__(NWAVES * 64, 2) mk_fwd(Args args) {
    extern __shared__ __attribute__((aligned(16))) unsigned char lds[];
    Frame F;
    F.lds = (LAS unsigned char*)lds;
    F.MISC = (volatile LAS unsigned*)(F.lds + MISC_OFF);
    F.wave = __builtin_amdgcn_readfirstlane((int)(threadIdx.x >> 6));
    F.G = gridDim.x; { const int bx = blockIdx.x; F.vcu = (F.G % 8 == 0) ? (bx % 8) * (F.G / 8) + bx / 8 : bx; }
    F.ws = args.ws; F.ctl = (gu32*)(args.ws + WS_CTL); F.out = args.out;
#pragma unroll
    for (int i = 0; i < 26; ++i) F.in[i] = args.in[i];
    for (int u = threadIdx.x; u < (LDS_BYTES - LDSCTL_OFF) / 4; u += NWAVES * 64) ((LAS unsigned*)(F.lds + LDSCTL_OFF))[u] = 0u;
    __syncthreads();
    XcdBarrier bar; bar.bar = (unsigned*)(F.ctl + CW_BAR); bar.x = 0; bar.st = nullptr;
    if (N_LAUNCHES == 1) bar = xcd_barrier_post((unsigned*)(F.ctl + CW_BAR), F.MISC + 8);
#define GRID_BAR() do { if (N_LAUNCHES == 1) xcd_barrier(bar, F.wave); } while (0)
    unsigned long long tp0 = 0, tpa = 0, tpb = 0; (void)tp0;
    const int lo = args.ph_lo, hi = args.ph_hi;
#define IN(k) (lo <= (k) && (k) < hi)
#define BOTH(k) (IN(k) && IN((k) + 1))

    if (IN(0)) { if constexpr (0 == TPA || 0 == TPB) tp0 = __builtin_amdgcn_s_memrealtime(); run_phase<0>(F); if constexpr (PH_REPS[0] > 1) { GRID_BAR(); run_phase<0>(F); } if constexpr (PH_REPS[0] > 2) { GRID_BAR(); run_phase<0>(F); } if (BOTH(0)) GRID_BAR(); if constexpr (0 == TPA) tpa = __builtin_amdgcn_s_memrealtime() - tp0; if constexpr (0 == TPB) tpb = __builtin_amdgcn_s_memrealtime() - tp0; }
    if (IN(1)) { if constexpr (1 == TPA || 1 == TPB) tp0 = __builtin_amdgcn_s_memrealtime(); run_phase<1>(F); if constexpr (PH_REPS[1] > 1) { GRID_BAR(); run_phase<1>(F); } if constexpr (PH_REPS[1] > 2) { GRID_BAR(); run_phase<1>(F); } if (BOTH(1)) GRID_BAR(); if constexpr (1 == TPA) tpa = __builtin_amdgcn_s_memrealtime() - tp0; if constexpr (1 == TPB) tpb = __builtin_amdgcn_s_memrealtime() - tp0; }
    if (IN(2)) { if constexpr (2 == TPA || 2 == TPB) tp0 = __builtin_amdgcn_s_memrealtime(); run_phase<2>(F); if constexpr (PH_REPS[2] > 1) { GRID_BAR(); run_phase<2>(F); } if constexpr (PH_REPS[2] > 2) { GRID_BAR(); run_phase<2>(F); } if (BOTH(2)) GRID_BAR(); if constexpr (2 == TPA) tpa = __builtin_amdgcn_s_memrealtime() - tp0; if constexpr (2 == TPB) tpb = __builtin_amdgcn_s_memrealtime() - tp0; }
    if (IN(3)) { if constexpr (3 == TPA || 3 == TPB) tp0 = __builtin_amdgcn_s_memrealtime(); run_phase<3>(F); if constexpr (PH_REPS[3] > 1) { GRID_BAR(); run_phase<3>(F); } if constexpr (PH_REPS[3] > 2) { GRID_BAR(); run_phase<3>(F); } if (BOTH(3)) GRID_BAR(); if constexpr (3 == TPA) tpa = __builtin_amdgcn_s_memrealtime() - tp0; if constexpr (3 == TPB) tpb = __builtin_amdgcn_s_memrealtime() - tp0; }
    if (IN(4)) { if constexpr (4 == TPA || 4 == TPB) tp0 = __builtin_amdgcn_s_memrealtime(); run_phase<4>(F); if constexpr (PH_REPS[4] > 1) { GRID_BAR(); run_phase<4>(F); } if constexpr (PH_REPS[4] > 2) { GRID_BAR(); run_phase<4>(F); } if (BOTH(4)) GRID_BAR(); if constexpr (4 == TPA) tpa = __builtin_amdgcn_s_memrealtime() - tp0; if constexpr (4 == TPB) tpb = __builtin_amdgcn_s_memrealtime() - tp0; }
    if (IN(5)) { if constexpr (5 == TPA || 5 == TPB) tp0 = __builtin_amdgcn_s_memrealtime(); run_phase<5>(F); if constexpr (PH_REPS[5] > 1) { GRID_BAR(); run_phase<5>(F); } if constexpr (PH_REPS[5] > 2) { GRID_BAR(); run_phase<5>(F); } if (BOTH(5)) GRID_BAR(); if constexpr (5 == TPA) tpa = __builtin_amdgcn_s_memrealtime() - tp0; if constexpr (5 == TPB) tpb = __builtin_amdgcn_s_memrealtime() - tp0; }
    if (IN(6)) { if constexpr (6 == TPA || 6 == TPB) tp0 = __builtin_amdgcn_s_memrealtime(); run_phase<6>(F); if constexpr (PH_REPS[6] > 1) { GRID_BAR(); run_phase<6>(F); } if constexpr (PH_REPS[6] > 2) { GRID_BAR(); run_phase<6>(F); } if (BOTH(6)) GRID_BAR(); if constexpr (6 == TPA) tpa = __builtin_amdgcn_s_memrealtime() - tp0; if constexpr (6 == TPB) tpb = __builtin_amdgcn_s_memrealtime() - tp0; }
    if (IN(7)) { if constexpr (7 == TPA || 7 == TPB) tp0 = __builtin_amdgcn_s_memrealtime(); run_phase<7>(F); if constexpr (PH_REPS[7] > 1) { GRID_BAR(); run_phase<7>(F); } if constexpr (PH_REPS[7] > 2) { GRID_BAR(); run_phase<7>(F); } if (BOTH(7)) GRID_BAR(); if constexpr (7 == TPA) tpa = __builtin_amdgcn_s_memrealtime() - tp0; if constexpr (7 == TPB) tpb = __builtin_amdgcn_s_memrealtime() - tp0; }
    if (IN(8)) { if constexpr (8 == TPA || 8 == TPB) tp0 = __builtin_amdgcn_s_memrealtime(); run_phase<8>(F); if constexpr (PH_REPS[8] > 1) { GRID_BAR(); run_phase<8>(F); } if constexpr (PH_REPS[8] > 2) { GRID_BAR(); run_phase<8>(F); } if (BOTH(8)) GRID_BAR(); if constexpr (8 == TPA) tpa = __builtin_amdgcn_s_memrealtime() - tp0; if constexpr (8 == TPB) tpb = __builtin_amdgcn_s_memrealtime() - tp0; }
    if (IN(9)) { if constexpr (9 == TPA || 9 == TPB) tp0 = __builtin_amdgcn_s_memrealtime(); run_phase<9>(F); if constexpr (PH_REPS[9] > 1) { GRID_BAR(); run_phase<9>(F); } if constexpr (PH_REPS[9] > 2) { GRID_BAR(); run_phase<9>(F); } if (BOTH(9)) GRID_BAR(); if constexpr (9 == TPA) tpa = __builtin_amdgcn_s_memrealtime() - tp0; if constexpr (9 == TPB) tpb = __builtin_amdgcn_s_memrealtime() - tp0; }
    if (IN(10)) { if constexpr (10 == TPA || 10 == TPB) tp0 = __builtin_amdgcn_s_memrealtime(); run_phase<10>(F); if constexpr (PH_REPS[10] > 1) { GRID_BAR(); run_phase<10>(F); } if constexpr (PH_REPS[10] > 2) { GRID_BAR(); run_phase<10>(F); } if (BOTH(10)) GRID_BAR(); if constexpr (10 == TPA) tpa = __builtin_amdgcn_s_memrealtime() - tp0; if constexpr (10 == TPB) tpb = __builtin_amdgcn_s_memrealtime() - tp0; }
    if (IN(11)) { if constexpr (11 == TPA || 11 == TPB) tp0 = __builtin_amdgcn_s_memrealtime(); run_phase<11>(F); if constexpr (PH_REPS[11] > 1) { GRID_BAR(); run_phase<11>(F); } if constexpr (PH_REPS[11] > 2) { GRID_BAR(); run_phase<11>(F); } if (BOTH(11)) GRID_BAR(); if constexpr (11 == TPA) tpa = __builtin_amdgcn_s_memrealtime() - tp0; if constexpr (11 == TPB) tpb = __builtin_amdgcn_s_memrealtime() - tp0; }
    if (IN(12)) { if constexpr (12 == TPA || 12 == TPB) tp0 = __builtin_amdgcn_s_memrealtime(); run_phase<12>(F); if constexpr (PH_REPS[12] > 1) { GRID_BAR(); run_phase<12>(F); } if constexpr (PH_REPS[12] > 2) { GRID_BAR(); run_phase<12>(F); } if (BOTH(12)) GRID_BAR(); if constexpr (12 == TPA) tpa = __builtin_amdgcn_s_memrealtime() - tp0; if constexpr (12 == TPB) tpb = __builtin_amdgcn_s_memrealtime() - tp0; }
    if (IN(13)) { if constexpr (13 == TPA || 13 == TPB) tp0 = __builtin_amdgcn_s_memrealtime(); run_phase<13>(F); if constexpr (PH_REPS[13] > 1) { GRID_BAR(); run_phase<13>(F); } if constexpr (PH_REPS[13] > 2) { GRID_BAR(); run_phase<13>(F); } if (BOTH(13)) GRID_BAR(); if constexpr (13 == TPA) tpa = __builtin_amdgcn_s_memrealtime() - tp0; if constexpr (13 == TPB) tpb = __builtin_amdgcn_s_memrealtime() - tp0; }
    if constexpr (TPA >= 0 || TPB >= 0) {
        if (blockIdx.x == 0 && F.wave == 0) { const unsigned long long ua = (tpa + 500ull) / 1000ull, ub = (tpb + 500ull) / 1000ull, extra = ua * 100000ull + ub * 1000ull, t1 = __builtin_amdgcn_s_memrealtime();
            while (__builtin_amdgcn_s_memrealtime() - t1 < extra) __builtin_amdgcn_s_sleep(16); }
    }
#undef IN
#undef BOTH
}

extern "C" void kernel_launch(void* const* d_in, const int* in_sizes, int n_in, void* d_out, int out_size, void* d_ws, size_t ws_size, hipStream_t stream) {
    static int grid = 0;
    if (grid == 0) {
        if (n_in != 26 || out_size != T * D || ws_size < WS_END) { fprintf(stderr, "kernel_launch: unexpected shapes: n_in %d out %d ws %zu (need %zu)\n", n_in, out_size, ws_size, (size_t)WS_END); grid = -1; return; }
        int dev = 0, cus = 0, per_cu = 0;
        if (hipGetDevice(&dev) != hipSuccess || hipDeviceGetAttribute(&cus, hipDeviceAttributeMultiprocessorCount, dev) != hipSuccess) { grid = -1; return; }
        if (hipFuncSetAttribute((const void*)mk_fwd, hipFuncAttributeMaxDynamicSharedMemorySize, LDS_BYTES) != hipSuccess) { fprintf(stderr, "kernel_launch: hipFuncSetAttribute failed\n"); grid = -1; return; }
        if (hipOccupancyMaxActiveBlocksPerMultiprocessor(&per_cu, (const void*)mk_fwd, NWAVES * 64, LDS_BYTES) != hipSuccess || per_cu < 1)
            fprintf(stderr, "kernel_launch: note: occupancy query reports %d workgroups per CU\n", per_cu);
        (void)hipGetLastError();
        grid = cus;
    }
    if (grid < 0) return;
    if (hipMemsetAsync((char*)d_ws + WS_CTL, 0, CTL_ZERO_BYTES, stream) != hipSuccess) return;
    Args a{};
    for (int i = 0; i < 26; ++i) a.in[i] = (const float*)d_in[i];
    a.out = (float*)d_out; a.ws = (unsigned char*)d_ws;
    for (int li = 0; li < N_LAUNCHES; ++li) {
        if (N_LAUNCHES == 1) { a.ph_lo = 0; a.ph_hi = N_PHASES; } else { a.ph_lo = li * N_PHASES / N_LAUNCHES; a.ph_hi = (li + 1) * N_PHASES / N_LAUNCHES; }
        a.li = li;
        hipLaunchKernelGGL(mk_fwd, dim3(grid), dim3(NWAVES * 64), LDS_BYTES, stream, a);
        if (hipPeekAtLastError() != hipSuccess) break;
    }
}
```

```cpp
#include <hip/hip_runtime.h>
#include <cstdio>
#include <cstdint>
namespace pg8 {
#define PG8_LAS __attribute__((address_space(3)))
typedef unsigned short bf16_t;
typedef short bf16x8 __attribute__((ext_vector_type(8)));
typedef float f32x4 __attribute__((ext_vector_type(4)));
typedef unsigned u32x4 __attribute__((ext_vector_type(4)));
constexpr int BM = 256, BK = 64, HALF = 128, HTB = HALF * BK * 2  , STAGE_BYTES = 8 * HTB, NXCD = 8, WGM = 8;

__host__ __device__ __forceinline__ int lds_byte(int r, int c) { const int st = (r >> 4) * 2 + (c >> 5), rr = r & 15, cc = c & 31, ob = rr * 64 + cc * 2; return st * 1024 + (ob ^ (((ob >> 9) & 1) << 5)); }
__host__ __device__ __forceinline__ void stage_rc(int b, int& R, int& C) { const int st = b / 1024, sb = b % 1024, swz = sb ^ (((sb >> 9) & 1) << 5); R = (st >> 1) * 16 + swz / 64; C = (st & 1) * 32 + (swz % 64) / 2; }
__host__ __device__ __forceinline__ int perm32(int rho) { const int n = rho >> 4, i = rho & 15; return 8 * (i >> 2) + 4 * n + (i & 3); }

__device__ __forceinline__ int mk_lane() { int l; asm volatile("v_mbcnt_lo_u32_b32 %0, -1, 0\n\tv_mbcnt_hi_u32_b32 %0, -1, %0" : "=v"(l)); return l; }
struct Unit { int pm, pn; };
struct Gemm { const bf16_t* A; const bf16_t* Bt; int M, N, K; };

struct StaticOrder {
    int nM, nN, nwg, G, c;
    __host__ __device__ void init(int M, int N, int G_, int c_) { nM = M / BM; nN = N / BM; nwg = nM * nN; G = G_; c = c_; }
    __host__ __device__ bool next(int i, Unit& u) const {
        const long L = (long)i * G + c; if (L >= nwg) return false;
        int wgid = (int)L; { const int q = nwg / NXCD, r = nwg % NXCD, xcd = wgid % NXCD, off = wgid / NXCD; wgid = (xcd < r ? xcd * (q + 1) : r * (q + 1) + (xcd - r) * q) + off; }
        const int nig = WGM * nN, gid = wgid / nig, fm = gid * WGM, gsz = (nM - fm) < WGM ? (nM - fm) : WGM;
        u.pm = fm + ((wgid % nig) % gsz); u.pn = (wgid % nig) / gsz; return true;
    }
    __device__ __forceinline__ void a_ready(const Unit&) const {}
    __device__ __forceinline__ void done(const Unit&) const {}
};

__device__ __forceinline__ unsigned cvt_pk_bf16(float lo, float hi) { unsigned r; asm volatile("v_cvt_pk_bf16_f32 %0, %1, %2" : "=v"(r) : "v"(lo), "v"(hi)); return r; }
typedef float f32x2 __attribute__((ext_vector_type(2)));
__device__ __forceinline__ f32x2 gelu_pk(f32x2 v) {
    const f32x2 av = __builtin_elementwise_abs(v), d = av * 0.2316418882f + 1.0f;
    f32x2 t; t.x = __builtin_amdgcn_rcpf(d.x); t.y = __builtin_amdgcn_rcpf(d.y);
    f32x2 q = t * 0.5307027145f + (-0.7265760135f); q = q * t + 0.7107068705f; q = q * t + (-0.142248368f); q = q * t + 0.127414796f; q = q * t;
    const f32x2 s = (v * v) * (-0.72134752044f);
    f32x2 e; e.x = __builtin_amdgcn_exp2f(s.x); e.y = __builtin_amdgcn_exp2f(s.y);
    const f32x2 m = v * (q * e), r = v - m;
    f32x2 o; o.x = v.x < 0.f ? m.x : r.x; o.y = v.y < 0.f ? m.y : r.y; return o;
}

template <int ACT  > struct EpiBf16 {
    static constexpr bool PERM = true, AFTER_DRAIN = false; static_assert(ACT == 0 || ACT == 1, "EpiBf16: ACT is 0 (none) or 1 (gelu_pk)");
    bf16_t* O; int ldc; const float* bias; int split_cols; size_t split_stride; float scale0;
    __device__ __forceinline__ void operator()(const f32x4 (&acc)[2][2][4][2], const Unit& u, int wr, int wc, int fr, int fq) const {
        const int row0 = u.pm * BM + wr * 64 + fr; int colt = u.pn * BM; bf16_t* base = O;
        float sc = 1.f; if (split_cols) { const int t = colt / split_cols; base += (size_t)t * split_stride; colt -= t * split_cols; if (t == 0) sc = scale0; }
        const int col0 = colt + wc * 32 + 8 * fq, bcol0 = u.pn * BM + wc * 32 + 8 * fq;
        f32x4 bv[2][2];
#pragma unroll
        for (int bj = 0; bj < 2; ++bj)
#pragma unroll
            for (int n = 0; n < 2; ++n) bv[bj][n] = bias ? *(const f32x4*)(bias + bcol0 + bj * HALF + 4 * n) : (f32x4){0.f, 0.f, 0.f, 0.f};
#pragma unroll
        for (int ai = 0; ai < 2; ++ai)
#pragma unroll
            for (int m = 0; m < 4; ++m) { bf16_t* rowp = base + (size_t)(row0 + ai * HALF + m * 16) * ldc + col0;
#pragma unroll
                for (int bj = 0; bj < 2; ++bj) { f32x4 v0 = acc[ai][bj][m][0] + bv[bj][0], v1 = acc[ai][bj][m][1] + bv[bj][1];
                    if (ACT == 1) { f32x2 a = gelu_pk((f32x2){v0[0], v0[1]}), b = gelu_pk((f32x2){v0[2], v0[3]}), c = gelu_pk((f32x2){v1[0], v1[1]}), d = gelu_pk((f32x2){v1[2], v1[3]});
                        v0 = (f32x4){a.x, a.y, b.x, b.y}; v1 = (f32x4){c.x, c.y, d.x, d.y}; }
                    v0 = v0 * sc; v1 = v1 * sc; u32x4 w; w.x = cvt_pk_bf16(v0[0], v0[1]); w.y = cvt_pk_bf16(v0[2], v0[3]); w.z = cvt_pk_bf16(v1[0], v1[1]); w.w = cvt_pk_bf16(v1[2], v1[3]);
                    *(u32x4*)(rowp + bj * HALF) = w; } }
    }
};
__device__ __forceinline__ float sigmoidf_(float x) { return __builtin_amdgcn_rcpf(1.0f + __expf(-x)); }
struct EpiResid {
    static constexpr bool PERM = false, AFTER_DRAIN = false;
    const float* base; float* out; int ldc; const float* gvec;
    __device__ __forceinline__ void operator()(const f32x4 (&acc)[2][2][4][2], const Unit& u, int wr, int wc, int fr, int fq) const {
        const int row0 = u.pm * BM + wr * 64 + fr, col0 = u.pn * BM + wc * 32 + 4 * fq;
        f32x4 gv[2][2];
#pragma unroll
        for (int bj = 0; bj < 2; ++bj)
#pragma unroll
            for (int n = 0; n < 2; ++n) gv[bj][n] = *(const __attribute__((address_space(1))) f32x4*)(gvec + col0 + bj * HALF + n * 16);
#pragma unroll
        for (int ai = 0; ai < 2; ++ai)
#pragma unroll
            for (int m = 0; m < 4; ++m) { const size_t off = (size_t)(row0 + ai * HALF + m * 16) * ldc + col0;
#pragma unroll
                for (int bj = 0; bj < 2; ++bj)
#pragma unroll
                    for (int n = 0; n < 2; ++n) { const f32x4 bs = *(const __attribute__((address_space(1))) f32x4*)(base + off + bj * HALF + n * 16);
                        *(__attribute__((address_space(1))) f32x4*)(out + off + bj * HALF + n * 16) = bs + gv[bj][n] * acc[ai][bj][m][n]; }
                if (m & 1) asm volatile("" ::: "memory"); }
    }
};
struct EpiSwiglu {
    static constexpr bool PERM = true, AFTER_DRAIN = false;
    bf16_t* O; int ldc;
    __device__ __forceinline__ void operator()(const f32x4 (&acc)[2][2][4][2], const Unit& u, int wr, int wc, int fr, int fq) const {
        const int row0 = u.pm * BM + wr * 64 + fr, col0 = u.pn * HALF + wc * 32 + 8 * fq;
#pragma unroll
        for (int ai = 0; ai < 2; ++ai)
#pragma unroll
            for (int m = 0; m < 4; ++m) { bf16_t* rowp = O + (size_t)(row0 + ai * HALF + m * 16) * ldc + col0;
                f32x4 h0, h1;
#pragma unroll
                for (int j = 0; j < 4; ++j) { const float g0 = acc[ai][0][m][0][j], g1 = acc[ai][0][m][1][j];
                    h0[j] = g0 * sigmoidf_(g0) * acc[ai][1][m][0][j]; h1[j] = g1 * sigmoidf_(g1) * acc[ai][1][m][1][j]; }
                u32x4 w; w.x = cvt_pk_bf16(h0[0], h0[1]); w.y = cvt_pk_bf16(h0[2], h0[3]); w.z = cvt_pk_bf16(h1[0], h1[1]); w.w = cvt_pk_bf16(h1[2], h1[3]);
                *(__attribute__((address_space(1))) u32x4*)rowp = w; }
    }
};
template <int CTRL> __device__ __forceinline__ float dpp_f(float old, float src) { return __builtin_bit_cast(float, __builtin_amdgcn_update_dpp(__builtin_bit_cast(int, old), __builtin_bit_cast(int, src), CTRL, 0xf, 0xf, false)); }
struct EpiLora {
    static constexpr bool PERM = true, AFTER_DRAIN = false;
    unsigned char* PKB; bf16_t* KD; const bf16_t* kbuf; const bf16_t* kkbuf; const bf16_t* rbuf; const float* w0; const float* a0; const float* k_a; int TT;
    __device__ __forceinline__ void operator()(const f32x4 (&acc)[2][2][4][2], const Unit& u, int wr, int wc, int fr, int fq) const {
        typedef __attribute__((address_space(1))) f32x4 gf4; typedef const __attribute__((address_space(1))) f32x4 cgf4;
        const int d = u.pn >> 4, cg = u.pn & 15;
        const int c8 = cg * HALF + wc * 32 + 8 * fq, h = c8 >> 6, ch = c8 & 63;
        const int row0 = u.pm * BM + wr * 64 + fr;
        f32x4 w0v[2], a0v[2], kav[2];
#pragma unroll
        for (int n = 0; n < 2; ++n) { w0v[n] = *(cgf4*)(w0 + d * 2048 + c8 + 4 * n); a0v[n] = *(cgf4*)(a0 + d * 2048 + c8 + 4 * n); kav[n] = *(cgf4*)(k_a + c8 + 4 * n); }
        typedef unsigned u32x2l __attribute__((ext_vector_type(2))); typedef const __attribute__((address_space(1))) u32x2l cgu2;
        u32x2l kq[2][2], kkq[2][2], rq[2][2];
        { const size_t fo0 = (size_t)row0 * 2048 + c8;
#pragma unroll
          for (int n = 0; n < 2; ++n) { kq[0][n] = *(cgu2*)(kbuf + fo0 + 4 * n); kkq[0][n] = *(cgu2*)(kkbuf + fo0 + 4 * n); rq[0][n] = *(cgu2*)(rbuf + fo0 + 4 * n); } }
#pragma unroll
        for (int it = 0; it < 8; ++it) {
            const int ai = it >> 2, m = it & 3;
            if (it + 1 < 8) { const size_t fo1 = (size_t)(row0 + ((it + 1) >> 2) * HALF + ((it + 1) & 3) * 16) * 2048 + c8;
#pragma unroll
                for (int n = 0; n < 2; ++n) { kq[(it + 1) & 1][n] = *(cgu2*)(kbuf + fo1 + 4 * n); kkq[(it + 1) & 1][n] = *(cgu2*)(kkbuf + fo1 + 4 * n); rq[(it + 1) & 1][n] = *(cgu2*)(rbuf + fo1 + 4 * n); } }
            asm volatile("" ::: "memory");
            const int tok = row0 + ai * HALF + m * 16;
            const int tau = d == 0 ? (tok & 15) : 15 - (tok & 15);
            unsigned char* rec = PKB + ((size_t)(d * 32 + h) * (TT / 16) + (tok >> 4)) * 8448;
            const size_t fo = (size_t)tok * 2048 + c8;
            f32x4 g[2]; u32x4 kw;
#pragma unroll
            for (int n = 0; n < 2; ++n) {
                f32x4 gp;
                const f32x4 x = acc[ai][0][m][n] + w0v[n];
#pragma unroll
                for (int j = 0; j < 4; ++j) { float w = __expf(-0.60653066f * sigmoidf_(x[j]));
                    if (d == 0) { w *= dpp_f<0x111>(1.0f, w); w *= dpp_f<0x112>(1.0f, w); w *= dpp_f<0x114>(1.0f, w); w *= dpp_f<0x118>(1.0f, w); g[n][j] = w; gp[j] = dpp_f<0x111>(1.0f, w); }
                    else        { w *= dpp_f<0x101>(1.0f, w); w *= dpp_f<0x102>(1.0f, w); w *= dpp_f<0x104>(1.0f, w); w *= dpp_f<0x108>(1.0f, w); g[n][j] = w; gp[j] = dpp_f<0x101>(1.0f, w); } }
                const f32x4 xa = acc[ai][1][m][n] + a0v[n];
                f32x4 k4, kk4, r4;
                { const u32x2l a_ = kq[it & 1][n], b_ = kkq[it & 1][n], c_ = rq[it & 1][n];
                  k4[0] = __builtin_bit_cast(float, a_.x << 16); k4[1] = __builtin_bit_cast(float, a_.x & 0xffff0000u); k4[2] = __builtin_bit_cast(float, a_.y << 16); k4[3] = __builtin_bit_cast(float, a_.y & 0xffff0000u);
                  kk4[0] = __builtin_bit_cast(float, b_.x << 16); kk4[1] = __builtin_bit_cast(float, b_.x & 0xffff0000u); kk4[2] = __builtin_bit_cast(float, b_.y << 16); kk4[3] = __builtin_bit_cast(float, b_.y & 0xffff0000u);
                  r4[0] = __builtin_bit_cast(float, c_.x << 16); r4[1] = __builtin_bit_cast(float, c_.x & 0xffff0000u); r4[2] = __builtin_bit_cast(float, c_.y << 16); r4[3] = __builtin_bit_cast(float, c_.y & 0xffff0000u); }
                f32x4 at, rt, bt, kdt; float kdv[4];
#pragma unroll
                for (int j = 0; j < 4; ++j) { const float a = sigmoidf_(xa[j]), rg = __builtin_amdgcn_rcpf(g[n][j]);
                    kdv[j] = k4[j] * (1.0f + (a - 1.0f) * kav[n][j]);
                    at[j] = -kk4[j] * gp[j]; rt[j] = r4[j] * g[n][j]; bt[j] = kk4[j] * a * rg; kdt[j] = kdv[j] * rg; }
                const int chn = ch + 4 * n;
                {
                    const int p0 = ((((chn >> 5) * 2 + ((chn >> 4) & 1)) * 2 + n) * 8 + ((chn >> 3) & 1) * 4);
                    typedef unsigned u32x2 __attribute__((ext_vector_type(2)));
                    __attribute__((address_space(1))) unsigned char* rp = (__attribute__((address_space(1))) unsigned char*)rec + (tau * 64 + p0) * 2;
                    u32x2 w;
                    w.x = cvt_pk_bf16(at[0], at[1]); w.y = cvt_pk_bf16(at[2], at[3]); *(__attribute__((address_space(1))) u32x2*)(rp) = w;
                    w.x = cvt_pk_bf16(rt[0], rt[1]); w.y = cvt_pk_bf16(rt[2], rt[3]); *(__attribute__((address_space(1))) u32x2*)(rp + 2048) = w;
                    w.x = cvt_pk_bf16(bt[0], bt[1]); w.y = cvt_pk_bf16(bt[2], bt[3]); *(__attribute__((address_space(1))) u32x2*)(rp + 4096) = w;
                    w.x = cvt_pk_bf16(kdt[0], kdt[1]); w.y = cvt_pk_bf16(kdt[2], kdt[3]); *(__attribute__((address_space(1))) u32x2*)(rp + 6144) = w; }
                if (n == 0) { kw.x = cvt_pk_bf16(kdv[0], kdv[1]); kw.y = cvt_pk_bf16(kdv[2], kdv[3]); } else { kw.z = cvt_pk_bf16(kdv[0], kdv[1]); kw.w = cvt_pk_bf16(kdv[2], kdv[3]); }
            }
            *(__attribute__((address_space(1))) u32x4*)(KD + (size_t)d * TT * 2048 + fo) = kw;
            if (fr == (d == 0 ? 15 : 0)) { float* ge = (float*)(rec + 8192) + ch; *(gf4*)ge = g[0]; *(gf4*)(ge + 4) = g[1]; }
        }
    }
};
template <class Epi, class Sched, bool ALIGN_EPI = false, bool SP2 = false>
__device__ __forceinline__ void gemm_phase(PG8_LAS unsigned char* lds, const Gemm g, const Sched& S, const Epi& E, const int wid) {
    const int lane = mk_lane(), tid = wid * 64 + lane, wr = wid >> 2, wc = wid & 3, fr = lane & 15, fq = lane >> 4;
    const int K = g.K, nt = K / BK;
    unsigned voffA[2], voffB[2];
#pragma unroll
    for (int i = 0; i < 2; ++i) { int R, C; stage_rc(tid * 16 + i * 8192, R, C); const int Rb = Epi::PERM ? ((R & ~31) + perm32(R & 31)) : R;
        voffA[i] = (unsigned)(R * K + C) * 2u; voffB[i] = (unsigned)(Rb * K + C) * 2u; }
    const size_t kstep = (size_t)(BK * 2);
    const size_t hstep = (size_t)HALF * K * 2;
    const size_t tstep = 2 * hstep;
    const unsigned ldsw = (unsigned)wid * 1024u;
    const int aoff = lds_byte(wr * 64 + fr, fq * 8), boff = lds_byte(wc * 32 + fr, fq * 8);
#define PG8_SA(b, h) (((b) * 2 + (h)) * HTB)
#define PG8_SB(b, h) ((4 + (b) * 2 + (h)) * HTB)
#define PG8_STAGE(bufoff, gbase, voff) do { _Pragma("unroll") for (int _i = 0; _i < 2; ++_i) \
        __builtin_amdgcn_global_load_lds((const unsigned*)((const char*)(gbase) + (voff)[_i]), (PG8_LAS unsigned*)(lds + (bufoff) + ldsw + _i * 8192), 16, 0, 0); } while (0)
#define PG8_LDA(dst, b, h) do { _Pragma("unroll") for (int m = 0; m < 4; ++m) _Pragma("unroll") for (int k = 0; k < 2; ++k) dst[m][k] = *(const PG8_LAS bf16x8*)(lds + PG8_SA(b, h) + aoff + m * 2048 + k * 1024); } while (0)
#define PG8_LDB(dst, b, h) do { _Pragma("unroll") for (int n = 0; n < 2; ++n) _Pragma("unroll") for (int k = 0; k < 2; ++k) dst[n][k] = *(const PG8_LAS bf16x8*)(lds + PG8_SB(b, h) + boff + n * 2048 + k * 1024); } while (0)
#define PG8_MMA(ai, bj, At, Bt) do { __builtin_amdgcn_s_setprio(1); _Pragma("unroll") for (int m = 0; m < 4; ++m) _Pragma("unroll") for (int n = 0; n < 2; ++n) _Pragma("unroll") for (int k = 0; k < 2; ++k) \
        acc[ai][bj][m][n] = __builtin_amdgcn_mfma_f32_16x16x32_bf16(Bt[n][k], At[m][k], acc[ai][bj][m][n], 0, 0, 0); __builtin_amdgcn_s_setprio(0); } while (0)
#define PG8_WAIT_V(n) asm volatile("s_waitcnt vmcnt(" #n ")" ::: "memory")
#define PG8_WAIT_L(n) asm volatile("s_waitcnt lgkmcnt(" #n ")" ::: "memory")
#define PG8_BAR __builtin_amdgcn_s_barrier()
#define PG8_SCHED __builtin_amdgcn_sched_barrier(0)
    Unit cur, nxt; int ui = 0;
    if (!S.next(0, cur)) return;
    f32x4 acc[2][2][4][2];
#pragma unroll
    for (int a = 0; a < 2; ++a)
#pragma unroll
        for (int b = 0; b < 2; ++b)
#pragma unroll
            for (int m = 0; m < 4; ++m)
#pragma unroll
                for (int n = 0; n < 2; ++n) acc[a][b][m][n] = (f32x4){0.f, 0.f, 0.f, 0.f};
    bf16x8 At[4][2], B0[2][2], B1[2][2];
    const char* cA = (const char*)g.A + (size_t)cur.pm * tstep; const char* cB = (const char*)g.Bt + (size_t)cur.pn * tstep;
    S.a_ready(cur);
    if constexpr (SP2) {
        PG8_STAGE(PG8_SB(0, 0), cB, voffB); PG8_STAGE(PG8_SB(0, 1), cB + hstep, voffB); PG8_STAGE(PG8_SA(0, 0), cA, voffA); PG8_STAGE(PG8_SA(0, 1), cA + hstep, voffA);
        if (wr == 1) PG8_BAR;
        PG8_WAIT_V(2); PG8_BAR;
        PG8_STAGE(PG8_SB(1, 0), cB + kstep, voffB); PG8_STAGE(PG8_SA(1, 0), cA + kstep, voffA); PG8_STAGE(PG8_SB(1, 1), cB + hstep + kstep, voffB);
        PG8_WAIT_V(6); PG8_BAR;
    } else {
        PG8_STAGE(PG8_SB(0, 0), cB, voffB); PG8_STAGE(PG8_SA(0, 0), cA, voffA); PG8_STAGE(PG8_SB(0, 1), cB + hstep, voffB); PG8_STAGE(PG8_SA(0, 1), cA + hstep, voffA);
        if (wr == 1) PG8_BAR;
        PG8_WAIT_V(4); PG8_BAR;
        PG8_STAGE(PG8_SB(1, 0), cB + kstep, voffB); PG8_STAGE(PG8_SA(1, 0), cA + kstep, voffA); PG8_STAGE(PG8_SB(1, 1), cB + hstep + kstep, voffB);
        PG8_WAIT_V(6); PG8_BAR;
    }
    for (;;) {
        const bool has_next = S.next(ui + 1, nxt);
        const char* nA = has_next ? (const char*)g.A + (size_t)nxt.pm * tstep : cA; const char* nB = has_next ? (const char*)g.Bt + (size_t)nxt.pn * tstep : cB;
        for (int t = 0; t < nt; t += 2) {
            const bool last = (t == nt - 2);
            const char* a1 = cA + (size_t)(t + 1) * kstep;
            const char* a2 = last ? nA : cA + (size_t)(t + 2) * kstep; const char* b2 = last ? nB : cB + (size_t)(t + 2) * kstep;
            const char* a3 = a2 + kstep; const char* b3 = b2 + kstep;
            if (last && has_next) S.a_ready(nxt);
            if constexpr (SP2) {
            PG8_LDB(B0, 0, 0); PG8_LDB(B1, 0, 1); PG8_SCHED; PG8_LDA(At, 0, 0); PG8_STAGE(PG8_SA(1, 1), a1 + hstep, voffA);
            PG8_WAIT_V(8); PG8_WAIT_L(0); PG8_BAR; PG8_MMA(0, 0, At, B0); PG8_MMA(0, 1, At, B1); PG8_BAR; PG8_SCHED;
            PG8_LDA(At, 0, 1); PG8_STAGE(PG8_SB(0, 0), b2, voffB); PG8_STAGE(PG8_SB(0, 1), b2 + hstep, voffB); PG8_STAGE(PG8_SA(0, 0), a2, voffA);
            PG8_WAIT_V(8); PG8_WAIT_L(0); PG8_BAR; PG8_MMA(1, 0, At, B0); PG8_MMA(1, 1, At, B1); PG8_BAR; PG8_SCHED;
            PG8_LDB(B0, 1, 0); PG8_LDB(B1, 1, 1); PG8_SCHED; PG8_LDA(At, 1, 0); PG8_STAGE(PG8_SA(0, 1), a2 + hstep, voffA);
            PG8_WAIT_V(8); PG8_WAIT_L(0); PG8_BAR; PG8_MMA(0, 0, At, B0); PG8_MMA(0, 1, At, B1); PG8_BAR; PG8_SCHED;
            PG8_LDA(At, 1, 1); PG8_STAGE(PG8_SB(1, 0), b3, voffB); PG8_STAGE(PG8_SB(1, 1), b3 + hstep, voffB); PG8_STAGE(PG8_SA(1, 0), a3, voffA);
            PG8_WAIT_V(8); PG8_WAIT_L(0); PG8_BAR; PG8_MMA(1, 0, At, B0); PG8_MMA(1, 1, At, B1); PG8_BAR; PG8_SCHED;
            } else {
            PG8_LDB(B0, 0, 0); PG8_SCHED; PG8_LDA(At, 0, 0); PG8_STAGE(PG8_SA(1, 1), a1 + hstep, voffA);
            PG8_WAIT_L(8); PG8_BAR; PG8_WAIT_L(0); PG8_MMA(0, 0, At, B0); PG8_BAR; PG8_SCHED;
            PG8_LDB(B1, 0, 1); PG8_STAGE(PG8_SB(0, 0), b2, voffB);
            PG8_BAR; PG8_WAIT_L(0); PG8_MMA(0, 1, At, B1); PG8_BAR;
            PG8_LDA(At, 0, 1); PG8_STAGE(PG8_SA(0, 0), a2, voffA);
            PG8_BAR; PG8_WAIT_L(0); PG8_MMA(1, 0, At, B0); PG8_BAR; PG8_SCHED;
            PG8_STAGE(PG8_SB(0, 1), b2 + hstep, voffB);
            PG8_WAIT_V(6); PG8_BAR; PG8_MMA(1, 1, At, B1); PG8_BAR;
            PG8_LDB(B0, 1, 0); PG8_SCHED; PG8_LDA(At, 1, 0); PG8_STAGE(PG8_SA(0, 1), a2 + hstep, voffA);
            PG8_WAIT_L(8); PG8_BAR; PG8_WAIT_L(0); PG8_MMA(0, 0, At, B0); PG8_BAR; PG8_SCHED;
            PG8_LDB(B1, 1, 1); PG8_STAGE(PG8_SB(1, 0), b3, voffB);
            PG8_BAR; PG8_WAIT_L(0); PG8_MMA(0, 1, At, B1); PG8_BAR;
            PG8_LDA(At, 1, 1); PG8_STAGE(PG8_SA(1, 0), a3, voffA);
            PG8_BAR; PG8_WAIT_L(0); PG8_MMA(1, 0, At, B0); PG8_BAR; PG8_SCHED;
            PG8_STAGE(PG8_SB(1, 1), b3 + hstep, voffB);
            PG8_WAIT_V(6); PG8_BAR; PG8_MMA(1, 1, At, B1); PG8_BAR;
            }
        }
        if constexpr (ALIGN_EPI) { if (wr == 0) PG8_BAR; }
        if constexpr (!Epi::AFTER_DRAIN) { const int l2 = mk_lane(); E(acc, cur, wr, wc, l2 & 15, l2 >> 4); S.done(cur); }
        if (!has_next) break;
#pragma unroll
        for (int a = 0; a < 2; ++a)
#pragma unroll
            for (int b = 0; b < 2; ++b)
#pragma unroll
                for (int m = 0; m < 4; ++m)
#pragma unroll
                    for (int n = 0; n < 2; ++n) acc[a][b][m][n] = (f32x4){0.f, 0.f, 0.f, 0.f};
        cur = nxt; cA = nA; cB = nB; ++ui;
        if constexpr (ALIGN_EPI) { if (wr == 1) PG8_BAR; }
    }
    PG8_WAIT_V(0);
    if constexpr (!ALIGN_EPI) { if (wr == 0) PG8_BAR; }
    PG8_BAR;
    if constexpr (Epi::AFTER_DRAIN) { E.fused(acc, cur, wr, wc, fr, fq, lds, wid, lane); S.done(cur); }
#undef PG8_SA
#undef PG8_SB
#undef PG8_STAGE
#undef PG8_LDA
#undef PG8_LDB
#undef PG8_MMA
#undef PG8_WAIT_V
#undef PG8_WAIT_L
#undef PG8_BAR
#undef PG8_SCHED
}
}

constexpr int NWAVES = 8;
#ifndef MK_N_LAUNCHES
#define MK_N_LAUNCHES 1
#endif
constexpr int N_PHASES = 14;
#ifndef MK_REPS
#define MK_REPS {1,1,1,1,1,1,1,1,1,1,1,1,1,1}
#endif
constexpr int PH_REPS[14] = MK_REPS;
#ifndef MK_TPA
#define MK_TPA -1
#endif
#ifndef MK_TPB
#define MK_TPB -1
#endif
constexpr int TPA = MK_TPA, TPB = MK_TPB;
constexpr int N_LAUNCHES = MK_N_LAUNCHES;

constexpr int D = 4096, T = 8192, CTXL = 256, TT = T + CTXL;
constexpr int DR = 2048, DC = 2048, NH = 32, HS = 64;
constexpr int OFF_K = 0, OFF_V = 2048, OFF_WL = 4096, OFF_AL = 4192, OFF_R = 4288, OFF_GL = 6336, RWKV_COLS = 6592;
constexpr int OFF_CB = 6592, OFF_CC = 8640, OFF_CX = 10688, IN_COLS = 12736, NZ = 12800;
constexpr int NCTXZ = 4352;
constexpr int DFF = 11008, NGU = 2 * DFF;
constexpr int NLORA = 8192, KLORA = 256, KGATE = 256;
constexpr int MODN = 6 * D;
constexpr int NKC = 16;
constexpr float NORM_EPS = 1e-6f, LNX_EPS = 64e-5f;
constexpr int CHUNK = 256, NCHUNK = 33;

constexpr size_t MiB = 1u << 20;
constexpr size_t WS_CTL = 0, CTL_ZERO_BYTES = 32768;
constexpr size_t WS_MODP = 1 * MiB;
constexpr size_t WS_MODV = 5 * MiB;
constexpr size_t WS_WLORA = 6 * MiB;
constexpr size_t WS_WGATE = 10 * MiB;
constexpr size_t WS_ALORA = 11 * MiB;
constexpr size_t WS_AGATE = 16 * MiB;
constexpr size_t WS_WOUT = 20 * MiB;
constexpr size_t WS_WGU = 52 * MiB;
constexpr size_t WS_WDN = 224 * MiB;
constexpr size_t WS_WIN = 310 * MiB;
constexpr size_t WS_PU = 310 * MiB;
constexpr size_t WS_SST = 374 * MiB;
constexpr size_t WS_A1 = 410 * MiB;
constexpr size_t WS_CAT = 410 * MiB;
constexpr size_t WS_Z = 476 * MiB;
constexpr size_t WS_YS = 476 * MiB;
constexpr size_t WS_KD = 604 * MiB;
constexpr size_t WS_GE = 670 * MiB;
constexpr size_t WS_KBUF = 683 * MiB;
constexpr size_t WS_KKBUF = 749 * MiB;
constexpr size_t WS_RBUF = 815 * MiB;
constexpr size_t WS_VBUF = 881 * MiB;
constexpr size_t WS_X1 = 683 * MiB;
constexpr size_t WS_PK = 947 * MiB;
constexpr size_t WS_ACT = 947 * MiB;
constexpr size_t WS_G = 1475 * MiB;
constexpr size_t WS_END = 1507 * MiB;
static_assert(WS_MODP + (size_t)NKC * 2 * MODN * 4 <= WS_MODV && WS_ALORA + (size_t)TT * 256 * 2 <= WS_AGATE && WS_WGU + (size_t)NGU * D * 2 <= WS_WDN && WS_WDN + (size_t)D * DFF * 2 <= WS_WIN, "ws map 1");
static_assert(WS_WIN + (size_t)NZ * D * 2 <= WS_A1 && WS_SST + (size_t)64 * NCHUNK * 16384 <= WS_A1 && WS_A1 + (size_t)TT * D * 2 <= WS_Z && WS_Z + (size_t)TT * NZ * 2 <= WS_KBUF, "ws map 2");
static_assert(WS_YS + (size_t)2 * T * 2048 * 4 <= WS_KD && WS_KD + (size_t)2 * TT * 2048 * 2 <= WS_GE && WS_GE + (size_t)64 * (TT / 16) * 256 <= WS_KBUF, "ws map 3");
static_assert(WS_KBUF + (size_t)TT * 2048 * 4 <= WS_KKBUF && WS_KKBUF + (size_t)TT * 2048 * 4 <= WS_RBUF && WS_RBUF + (size_t)TT * 2048 * 4 <= WS_VBUF && WS_VBUF + (size_t)TT * 2048 * 4 <= WS_PK, "ws map 4");
static_assert(WS_X1 + (size_t)T * D * 4 <= WS_RBUF && WS_PK + (size_t)64 * TT * 1024 <= WS_G && WS_ACT + (size_t)T * DFF * 2 <= WS_G && WS_G + (size_t)T * 2048 * 2 <= WS_END && WS_CAT + (size_t)T * D * 2 <= WS_Z, "ws map 5");
constexpr int CW_TMO = 0;
constexpr int CW_BAR = 4096;

constexpr int RING_OFF = 0, RING_BYTES = 131072;
constexpr int LDSCTL_OFF = RING_BYTES, MISC_OFF = LDSCTL_OFF + 320;
constexpr int LDS_BYTES = 147456;
static_assert(MISC_OFF + 128 <= LDS_BYTES, "LDS map");

#define GAS __attribute__((address_space(1)))
#define LAS __attribute__((address_space(3)))
typedef unsigned short bf16;
typedef unsigned v4u __attribute__((ext_vector_type(4)));
typedef unsigned v2u __attribute__((ext_vector_type(2)));
typedef float f32x4 __attribute__((ext_vector_type(4)));
typedef GAS unsigned gu32;
#define RLX_AGENT __ATOMIC_RELAXED, __HIP_MEMORY_SCOPE_AGENT
#define LDS_WAIT() asm volatile("s_waitcnt lgkmcnt(0)" ::: "memory")
#define VM_WAIT() asm volatile("s_waitcnt vmcnt(0)" ::: "memory")
__device__ __forceinline__ unsigned f2bf(float f) { unsigned u = __builtin_bit_cast(unsigned, f); return (u + 0x7fffu + ((u >> 16) & 1u)) >> 16; }
__device__ __forceinline__ unsigned pk2(float lo, float hi) { return f2bf(lo) | (f2bf(hi) << 16); }
__device__ __forceinline__ float bflo(unsigned w) { return __builtin_bit_cast(float, w << 16); }
__device__ __forceinline__ float bfhi(unsigned w) { return __builtin_bit_cast(float, w & 0xffff0000u); }
__device__ __forceinline__ float sigm(float x) { return 1.0f / (1.0f + __expf(-x)); }

#define XB_TMO      128
#define XB_XCNT(j)  (256  + 64 * (j))
#define XB_XSUB(j)  (1280 + 64 * (j))
#define XB_XGEN(j)  (2304 + 64 * (j))
#define XB_TOP      3328
#define XB_TOPGEN   3392
#define XCD_BAR_WORDS 3456
#define XB_SPIN_CAP (1u << 18)
__device__ __forceinline__ unsigned xb_ld(unsigned* p)              { return __hip_atomic_load(p, __ATOMIC_RELAXED, __HIP_MEMORY_SCOPE_AGENT); }
__device__ __forceinline__ unsigned xb_add(unsigned* p, unsigned v) { return __hip_atomic_fetch_add(p, v, __ATOMIC_RELAXED, __HIP_MEMORY_SCOPE_AGENT); }
__device__ __forceinline__ unsigned xb_xcc_id() { return (unsigned)__builtin_amdgcn_s_getreg((3 << 11) | 20) & 0xFu; }
#define XB_SPIN(cond, bar) do { unsigned _sp = 0; while (cond) { __builtin_amdgcn_s_sleep(1); \
    if ((++_sp & 255u) == 0u) { if (xb_ld(&(bar)[XB_TMO])) break; if (_sp > XB_SPIN_CAP) { atomicAdd(&(bar)[XB_TMO], 1u); break; } } } } while (0)
struct XcdBarrier { unsigned* bar; unsigned x; volatile LAS unsigned* st; };
__device__ __forceinline__ XcdBarrier xcd_barrier_post(unsigned* bar, volatile LAS unsigned* st) {
    XcdBarrier b; b.bar = bar; b.x = xb_xcc_id(); b.st = st;
    if (threadIdx.x == 0) (void)xb_add(&bar[XB_XCNT(b.x)], 1u);
    return b;
}
__device__ __forceinline__ void xcd_barrier_complete(unsigned* bar, unsigned x, unsigned& nloc, unsigned& nx) {
    const unsigned G = gridDim.x * gridDim.y * gridDim.z;
    unsigned sum, cnt, mine, sp = 0u;
    for (;;) {
        sum = 0u; cnt = 0u; mine = 0u;
#pragma unroll
        for (unsigned j = 0; j < 16; ++j) { const unsigned c = xb_ld(&bar[XB_XCNT(j)]); sum += c; cnt += (c > 0u) ? 1u : 0u; mine = (j == x) ? c : mine; }
        if (sum == G) break;
        __builtin_amdgcn_s_sleep(1);
        if ((++sp & 255u) == 0u) { if (xb_ld(&bar[XB_TMO])) break; if (sp > XB_SPIN_CAP) { atomicAdd(&bar[XB_TMO], 1u); break; } }
    }
    nloc = mine > 0u ? mine : 1u; nx = cnt > 0u ? cnt : 1u;
}
__device__ __forceinline__ void xcd_barrier(const XcdBarrier& b, const int wave) {
    asm volatile("s_waitcnt vmcnt(0)" ::: "memory");
    __syncthreads();
    if (wave == 0 && pg8::mk_lane() == 0) {
        unsigned* bar = b.bar;
        __builtin_amdgcn_s_waitcnt(0);
        unsigned nloc = b.st[0], nx = b.st[1];
        if (nloc == 0u) { xcd_barrier_complete(bar, b.x, nloc, nx); b.st[0] = nloc; b.st[1] = nx; }
        const unsigned old = xb_add(&bar[XB_XSUB(b.x)], 1u);
        const unsigned gen = old / nloc;
        if (old + 1u == (gen + 1u) * nloc) {
            __builtin_amdgcn_fence(__ATOMIC_RELEASE, "agent");
            asm volatile("s_waitcnt vmcnt(0)" ::: "memory");
            const unsigned og = xb_add(&bar[XB_TOP], 1u);
            const unsigned tg = og / nx;
            if (og + 1u == (tg + 1u) * nx) xb_add(&bar[XB_TOPGEN], 1u);
            else XB_SPIN(xb_ld(&bar[XB_TOPGEN]) == tg, bar);
            __builtin_amdgcn_fence(__ATOMIC_ACQUIRE, "agent");
            xb_add(&bar[XB_XGEN(b.x)], 1u);
            asm volatile("s_waitcnt vmcnt(0)" ::: "memory");
        } else {
            XB_SPIN(xb_ld(&bar[XB_XGEN(b.x)]) == gen, bar);
            __builtin_amdgcn_fence(__ATOMIC_ACQUIRE, "agent");
            asm volatile("s_waitcnt vmcnt(0)" ::: "memory");
        }
    }
    __syncthreads();
}

struct Frame {
    LAS unsigned char* lds;
    volatile LAS unsigned* MISC;
    gu32* ctl;
    int wave;
    int vcu, G;
    unsigned char* ws;
    const float* in[26];
    float* out;
};
enum { I_X = 0, I_C, I_CTX, I_CCTX, I_WADA, I_BADA, I_NORM1, I_WIN, I_MU, I_KK, I_KA, I_RK, I_W0, I_WDU, I_A0, I_WIU, I_WGU, I_LNXW, I_LNXB, I_CONVW, I_WOUT, I_NORM2, I_WFG, I_WFU, I_WFD, I_NORMF };

__device__ __forceinline__ float wave_sum(float v) {
#pragma unroll
    for (int o = 1; o < 64; o <<= 1) v += __shfl_xor(v, o);
    return v;
}

__device__ __forceinline__ void p0_transpose_item(const float* W, int K, int N, bf16* WT, int ldk, int row_off, LAS float* scr, int item, int lane) {
    const int nblk = N / 32, kb = item / nblk, nb = item % nblk, k0 = 64 * kb, n0 = 32 * nb;
    float tv[32];
#pragma unroll
    for (int i = 0; i < 32; ++i) tv[i] = *(const GAS float*)(W + (size_t)(k0 + 2 * i + (lane >> 5)) * N + n0 + (lane & 31));
#pragma unroll
    for (int i = 0; i < 32; ++i) scr[(2 * i + (lane >> 5)) * 33 + (lane & 31)] = tv[i];
    LDS_WAIT(); asm volatile("" ::: "memory");
    const int c = lane & 7;
#pragma unroll
    for (int j = 0; j < 4; ++j) { const int n = (lane >> 3) + 8 * j; const LAS float* s = scr + (8 * c) * 33 + n;
        v4u o; o.x = pk2(s[0 * 33], s[1 * 33]); o.y = pk2(s[2 * 33], s[3 * 33]); o.z = pk2(s[4 * 33], s[5 * 33]); o.w = pk2(s[6 * 33], s[7 * 33]);
        *(GAS v4u*)(WT + (size_t)(row_off + n0 + n) * ldk + k0 + 8 * c) = o; }
    LDS_WAIT(); asm volatile("" ::: "memory");
}
constexpr int TI_IN = (D / 64) * (IN_COLS / 32), TI_OUT = (D / 64) * (D / 32), TI_G = (D / 64) * (DFF / 32), TI_DN = (DFF / 64) * (D / 32);
constexpr int TI_TOTAL = TI_IN + TI_OUT + 2 * TI_G + TI_DN;
constexpr int GEMV_UNITS = NKC * (MODN / 256);
constexpr int IB_OUT = TI_IN, IB_G = IB_OUT + TI_OUT, IB_U = IB_G + TI_G, IB_D = IB_U + TI_G;
constexpr int P2T_B = IB_OUT, P2T_E = IB_G + 13200;
constexpr int P6T_B = P2T_E, P6T_E = IB_U + 11000;
constexpr int P0X_B = P6T_E, P0X_E = IB_D + 12000;
constexpr int P11T_B = P0X_E, P11T_E = TI_TOTAL;
constexpr int P0_ITEMS = TI_IN + (P0X_E - P0X_B);
constexpr int TI_PER_GEMV_WAVE = 18, TI_PER_OTHER_WAVE = 42;
static_assert(GEMV_UNITS <= 2048 && GEMV_UNITS * TI_PER_GEMV_WAVE + (2048 - GEMV_UNITS) * TI_PER_OTHER_WAVE >= P0_ITEMS, "P0 item split");

__device__ __forceinline__ void tr_item(Frame& F, int it, LAS float* scr, int lane) {
    int r = it;
    if (r < TI_IN) { p0_transpose_item(F.in[I_WIN], D, IN_COLS, (bf16*)(F.ws + WS_WIN), D, 0, scr, r, lane); return; } r -= TI_IN;
    if (r < TI_OUT) { p0_transpose_item(F.in[I_WOUT], D, D, (bf16*)(F.ws + WS_WOUT), D, 0, scr, r, lane); return; } r -= TI_OUT;
    if (r < TI_G) { const int n0 = 32 * (r % (DFF / 32)); p0_transpose_item(F.in[I_WFG], D, DFF, (bf16*)(F.ws + WS_WGU), D, 256 * (n0 >> 7) + (n0 & 127) - n0, scr, r, lane); return; } r -= TI_G;
    if (r < TI_G) { const int n0 = 32 * (r % (DFF / 32)); p0_transpose_item(F.in[I_WFU], D, DFF, (bf16*)(F.ws + WS_WGU), D, 256 * (n0 >> 7) + 128 + (n0 & 127) - n0, scr, r, lane); return; } r -= TI_G;
    p0_transpose_item(F.in[I_WFD], DFF, D, (bf16*)(F.ws + WS_WDN), DFF, 0, scr, r, lane);
}
__device__ __forceinline__ void tr_range(Frame& F, int b, int e, int rank, int nw, LAS float* scr, int lane) {
    const int per = (e - b + nw - 1) / nw; int i0 = b + rank * per, i1 = i0 + per; if (i1 > e) i1 = e;
    for (int it = i0; it < i1; ++it) tr_item(F, it, scr, lane);
}
__device__ __forceinline__ void tr_idle(Frame& F, int b, int e, int rank_blk, int nblk) {
    if (F.G != 256 || rank_blk < 0) return;
    tr_range(F, b, e, rank_blk * NWAVES + F.wave, nblk * NWAVES, (LAS float*)(F.lds + RING_OFF + F.wave * 16384), pg8::mk_lane());
}
__device__ __forceinline__ void p0_gemv_unit(Frame& F, int unit, int lane) {
    const int kc = unit / (MODN / 256), cc = unit % (MODN / 256);
    const int k0 = kc * 256, col = cc * 256 + lane * 4;
    int sv[4], sc[4];
#pragma unroll
    for (int q = 0; q < 4; ++q) { const float c = *(const GAS float*)(F.in[I_C] + k0 + q * 64 + lane), cx = *(const GAS float*)(F.in[I_CCTX] + k0 + q * 64 + lane);
        sv[q] = __builtin_bit_cast(int, c * sigm(c)); sc[q] = __builtin_bit_cast(int, cx * sigm(cx)); }
    f32x4 a0 = (f32x4){0.f, 0.f, 0.f, 0.f}, a1 = a0;
    const GAS f32x4* wp = (const GAS f32x4*)(F.in[I_WADA] + (size_t)k0 * MODN + col);
#pragma unroll
    for (int q = 0; q < 4; ++q) {
#pragma unroll 16
        for (int i = 0; i < 64; ++i) { const f32x4 w = wp[(size_t)(q * 64 + i) * (MODN / 4)];
            const float s = __builtin_bit_cast(float, __builtin_amdgcn_readlane(sv[q], i)), t = __builtin_bit_cast(float, __builtin_amdgcn_readlane(sc[q], i));
            a0 += w * s; a1 += w * t; }
    }
    float* mp = (float*)(F.ws + WS_MODP);
    *(GAS f32x4*)(mp + (size_t)(kc * 2 + 0) * MODN + col) = a0;
    *(GAS f32x4*)(mp + (size_t)(kc * 2 + 1) * MODN + col) = a1;
}

__device__ __forceinline__ void p0_prologue(Frame& F) {
    LAS float* scr = (LAS float*)(F.lds + RING_OFF + F.wave * 16384);
    const int lane = pg8::mk_lane();
    const int gw = F.vcu * NWAVES + F.wave, NGW = F.G * NWAVES;
    const int gt = gw * 64 + lane, NGT = NGW * 64;
    {
        unsigned* wl = (unsigned*)(F.ws + WS_WLORA);
        for (int i = gt; i < NLORA * KLORA / 2; i += NGT) { const int n = i >> 7, k = (i & 127) * 2, pn = n >> 8, d = pn >> 4, isic = (n >> 7) & 1, ch = (pn & 15) * 128 + (n & 127); float v0 = 0.f, v1 = 0.f;
            if (k < 96) { if (!isic) { v0 = *(const GAS float*)(F.in[I_WDU] + (size_t)(d * 96 + k) * 2048 + ch); v1 = *(const GAS float*)(F.in[I_WDU] + (size_t)(d * 96 + k + 1) * 2048 + ch); } }
            else if (k < 192) { if (isic) { v0 = *(const GAS float*)(F.in[I_WIU] + (size_t)(d * 96 + k - 96) * 2048 + ch); v1 = *(const GAS float*)(F.in[I_WIU] + (size_t)(d * 96 + k - 95) * 2048 + ch); } }
            *(GAS unsigned*)(wl + i) = pk2(v0, v1); }
        unsigned* wg = (unsigned*)(F.ws + WS_WGATE);
        for (int i = gt; i < 2048 * KGATE / 2; i += NGT) { const int n = i >> 7, k = (i & 127) * 2;
            *(GAS unsigned*)(wg + i) = pk2(*(const GAS float*)(F.in[I_WGU] + (size_t)k * 2048 + n), *(const GAS float*)(F.in[I_WGU] + (size_t)(k + 1) * 2048 + n)); }
        v4u* zp = (v4u*)(F.ws + WS_WIN + (size_t)IN_COLS * D * 2);
        for (int i = gt; i < (NZ - IN_COLS) * D * 2 / 16; i += NGT) *(GAS v4u*)(zp + i) = (v4u){0u, 0u, 0u, 0u};
    }
    for (int u = gw; u < GEMV_UNITS; u += NGW) p0_gemv_unit(F, u, lane);
    if (F.G == 256) {
        int it0, it1;
        if (gw < GEMV_UNITS) { it0 = gw * TI_PER_GEMV_WAVE; it1 = it0 + TI_PER_GEMV_WAVE; }
        else { it0 = GEMV_UNITS * TI_PER_GEMV_WAVE + (gw - GEMV_UNITS) * TI_PER_OTHER_WAVE; it1 = it0 + TI_PER_OTHER_WAVE; }
        if (it1 > P0_ITEMS) it1 = P0_ITEMS;
        for (int it = it0; it < it1; ++it) tr_item(F, it < TI_IN ? it : P0X_B + (it - TI_IN), scr, lane);
    } else tr_range(F, 0, TI_TOTAL, gw, NGW, scr, lane);
}

__device__ __forceinline__ void norm_row_load(const float* xrow, int lane, f32x4 (&v)[16]) {
    const GAS f32x4* xr = (const GAS f32x4*)xrow + lane;
#pragma unroll
    for (int j = 0; j < 16; ++j) v[j] = xr[64 * j];
}
__device__ __forceinline__ void norm_row_finish(const f32x4 (&v)[16], bf16* orow, const LAS float* gs, const LAS float* sh, int lane) {
    float s = 0.f;
#pragma unroll
    for (int j = 0; j < 16; ++j) s += (v[j].x * v[j].x + v[j].y * v[j].y) + (v[j].z * v[j].z + v[j].w * v[j].w);
    const float rstd = 1.0f / sqrtf(wave_sum(s) * (1.f / D) + NORM_EPS);
    GAS v2u* o8 = (GAS v2u*)orow + lane;
#pragma unroll
    for (int j = 0; j < 16; ++j) { const f32x4 g = *(const LAS f32x4*)(gs + 4 * lane + 256 * j), b = *(const LAS f32x4*)(sh + 4 * lane + 256 * j);
        const f32x4 y = v[j] * rstd * g + b; v2u o; o.x = pk2(y.x, y.y); o.y = pk2(y.z, y.w); o8[64 * j] = o; }
}
__device__ __forceinline__ void norm_row(const float* xrow, bf16* orow, const LAS float* gs, const LAS float* sh, int lane) {
    f32x4 v[16]; norm_row_load(xrow, lane, v); norm_row_finish(v, orow, gs, sh, lane);
}
__device__ __forceinline__ void p1_norm1(Frame& F) {
    const int lane = pg8::mk_lane(), tid = F.wave * 64 + lane;
    const int gw = F.vcu * NWAVES + F.wave, NGW = F.G * NWAVES;
    bf16* A1 = (bf16*)(F.ws + WS_A1);
    f32x4 v0[16]; norm_row_load(F.in[I_X] + (size_t)gw * D, lane, v0);
    LAS float* tab = (LAS float*)(F.lds + RING_OFF);
    const float* mp = (const float*)(F.ws + WS_MODP);
    bool need_ctx = false;
    for (int m = F.vcu * NWAVES; m < TT; m += NGW) if (m + NWAVES > T) need_ctx = true;
    for (int i = tid; i < (need_ctx ? 4 : 2) * (D / 4); i += NWAVES * 64) {
        const int which = i >> 10, k = (i & (D / 4 - 1)) * 4, isc = which >> 1, part = which & 1;
        const int col = part == 0 ? D + k : k;
        f32x4 s = *(const GAS f32x4*)(F.in[I_BADA] + col);
#pragma unroll
        for (int p = 0; p < NKC; ++p) s += *(const GAS f32x4*)(mp + (size_t)(p * 2 + isc) * MODN + col);
        if (part == 0) s = *(const GAS f32x4*)(F.in[I_NORM1] + k) * (1.0f + s);
        *(LAS f32x4*)(tab + which * D + k) = s;
    }
    {
        float* mv = (float*)(F.ws + WS_MODV);
        for (int i = F.vcu * (NWAVES * 64) + tid; i < 2 * MODN; i += F.G * NWAVES * 64) { const int isc = i / MODN, col = i % MODN;
            float s = *(const GAS float*)(F.in[I_BADA] + col);
#pragma unroll
            for (int p = 0; p < NKC; ++p) s += *(const GAS float*)(mp + (size_t)(p * 2 + isc) * MODN + col);
            *(GAS float*)(mv + i) = s; }
    }
    __syncthreads();
    f32x4 v1[16];
#define MK_P1_SRC(m_) ((m_) < T ? F.in[I_X] + (size_t)(m_) * D : F.in[I_CTX] + (size_t)((m_) - T) * D)
#define MK_P1_FIN(v_, m_) do { if ((m_) < T) norm_row_finish(v_, A1 + (size_t)(m_) * D, tab, tab + D, lane); else norm_row_finish(v_, A1 + (size_t)(m_) * D, tab + 2 * D, tab + 3 * D, lane); } while (0)
    for (int m = gw; m < TT; m += 2 * NGW) {
        const int m2 = m + NGW, m3 = m2 + NGW;
        if (m2 < TT) norm_row_load(MK_P1_SRC(m2), lane, v1);
        MK_P1_FIN(v0, m);
        if (m2 < TT) { if (m3 < TT) norm_row_load(MK_P1_SRC(m3), lane, v0); MK_P1_FIN(v1, m2); }
    }
#undef MK_P1_SRC
#undef MK_P1_FIN
    __syncthreads();
}
__device__ __forceinline__ void p10_norm2(Frame& F) {
    const int lane = pg8::mk_lane(), tid = F.wave * 64 + lane;
    LAS float* tab = (LAS float*)(F.lds + RING_OFF);
    const float* mv = (const float*)(F.ws + WS_MODV);
    const int gw = F.vcu * NWAVES + F.wave, NGW = F.G * NWAVES;
    bf16* A1 = (bf16*)(F.ws + WS_A1); const float* X1 = (const float*)(F.ws + WS_X1);
    f32x4 v0[16], v1[16];
    if (gw < T) norm_row_load(X1 + (size_t)gw * D, lane, v0);
    for (int i = tid; i < 2 * D; i += NWAVES * 64) { const int part = i >> 12, k = i & (D - 1);
        tab[i] = part == 0 ? *(const GAS float*)(F.in[I_NORM2] + k) * (1.0f + *(const GAS float*)(mv + 4 * D + k)) : *(const GAS float*)(mv + 3 * D + k); }
    __syncthreads();
    for (int m = gw; m < T; m += 2 * NGW) {
        const int m2 = m + NGW, m3 = m2 + NGW;
        if (m2 < T) norm_row_load(X1 + (size_t)m2 * D, lane, v1);
        asm volatile("" ::: "memory");
        norm_row_finish(v0, A1 + (size_t)m * D, tab, tab + D, lane);
        asm volatile("" ::: "memory");
        if (m2 < T) { if (m3 < T) norm_row_load(X1 + (size_t)m3 * D, lane, v0); asm volatile("" ::: "memory"); norm_row_finish(v1, A1 + (size_t)m2 * D, tab, tab + D, lane); asm volatile("" ::: "memory"); }
    }
    __syncthreads();
}
__device__ __forceinline__ void p13_final(Frame& F) {
    const int lane = pg8::mk_lane();
    const int gw = F.vcu * NWAVES + F.wave, NGW = F.G * NWAVES;
    f32x4 v0[16], v1[16];
#define MK_P13_FIN(v_, m_) do { float s_ = 0.f; _Pragma("unroll") for (int j = 0; j < 16; ++j) s_ += (v_[j].x * v_[j].x + v_[j].y * v_[j].y) + (v_[j].z * v_[j].z + v_[j].w * v_[j].w); \
        const float rstd_ = 1.0f / sqrtf(wave_sum(s_) * (1.f / D) + NORM_EPS); GAS f32x4* xo_ = (GAS f32x4*)(F.out + (size_t)(m_) * D) + lane; \
        _Pragma("unroll") for (int j = 0; j < 16; ++j) xo_[64 * j] = v_[j] * rstd_ * *((const GAS f32x4*)F.in[I_NORMF] + lane + 64 * j); } while (0)
    if (gw < T) norm_row_load(F.out + (size_t)gw * D, lane, v0);
    for (int m = gw; m < T; m += 2 * NGW) {
        const int m2 = m + NGW, m3 = m2 + NGW;
        if (m2 < T) norm_row_load(F.out + (size_t)m2 * D, lane, v1);
        MK_P13_FIN(v0, m);
        if (m2 < T) { if (m3 < T) norm_row_load(F.out + (size_t)m3 * D, lane, v0); MK_P13_FIN(v1, m2); }
    }
#undef MK_P13_FIN
}

__device__ __forceinline__ void ld8(const bf16* p, float (&f)[8]) { const v4u r = *(const GAS v4u*)p;
    f[0] = bflo(r.x); f[1] = bfhi(r.x); f[2] = bflo(r.y); f[3] = bfhi(r.y); f[4] = bflo(r.z); f[5] = bfhi(r.z); f[6] = bflo(r.w); f[7] = bfhi(r.w); }
__device__ __forceinline__ void ldf8(const float* p, float (&f)[8]) { const f32x4 a = *(const GAS f32x4*)p, b = *(const GAS f32x4*)(p + 4);
    f[0] = a.x; f[1] = a.y; f[2] = a.z; f[3] = a.w; f[4] = b.x; f[5] = b.y; f[6] = b.z; f[7] = b.w; }
__device__ __forceinline__ void stf8(float* p, const float (&f)[8]) { *(GAS f32x4*)p = (f32x4){f[0], f[1], f[2], f[3]}; *(GAS f32x4*)(p + 4) = (f32x4){f[4], f[5], f[6], f[7]}; }
__device__ __forceinline__ void stb8(bf16* p, const float (&f)[8]) { v4u o; o.x = pk2(f[0], f[1]); o.y = pk2(f[2], f[3]); o.z = pk2(f[4], f[5]); o.w = pk2(f[6], f[7]); *(GAS v4u*)p = o; }
__device__ __forceinline__ void za8(const bf16* Z, int row, bool hp, bool hn, int c, const float* mu, float (&o)[8]) {
    float zc[8], zp[8], zn[8], m8[8];
    ld8(Z + (size_t)row * NZ + c, zc);
    if (hp) ld8(Z + (size_t)(row - 1) * NZ + c, zp); else { _Pragma("unroll") for (int i = 0; i < 8; ++i) zp[i] = 0.f; }
    if (hn) ld8(Z + (size_t)(row + 1) * NZ + c, zn); else { _Pragma("unroll") for (int i = 0; i < 8; ++i) zn[i] = 0.f; }
    ldf8(mu + c, m8);
#pragma unroll
    for (int i = 0; i < 8; ++i) o[i] = zc[i] + m8[i] * (0.5f * (zp[i] + zn[i]) - zc[i]);
}
__device__ __forceinline__ void zero8(float (&f)[8]) {
#pragma unroll
    for (int i = 0; i < 8; ++i) f[i] = 0.f; }
__device__ __forceinline__ void cp8(float (&d)[8], const float (&s)[8]) {
#pragma unroll
    for (int i = 0; i < 8; ++i) d[i] = s[i]; }
__device__ __forceinline__ void un8(const v4u r, float (&f)[8]) { f[0] = bflo(r.x); f[1] = bfhi(r.x); f[2] = bflo(r.y); f[3] = bfhi(r.y); f[4] = bflo(r.z); f[5] = bfhi(r.z); f[6] = bflo(r.w); f[7] = bfhi(r.w); }
__device__ __forceinline__ v4u ldraw(const bf16* p, bool ok) { return ok ? *(const GAS v4u*)p : (v4u){0u, 0u, 0u, 0u}; }
__device__ __forceinline__ void p3_prep(Frame& F) {
    const bf16* Z = (const bf16*)(F.ws + WS_Z);
    bf16* KB = (bf16*)(F.ws + WS_KBUF); bf16* KKB = (bf16*)(F.ws + WS_KKBUF); bf16* RB = (bf16*)(F.ws + WS_RBUF); bf16* VB = (bf16*)(F.ws + WS_VBUF);
    bf16* AL = (bf16*)(F.ws + WS_ALORA); bf16* AG = (bf16*)(F.ws + WS_AGATE); bf16* CAT = (bf16*)(F.ws + WS_CAT);
    const float* mu = F.in[I_MU];
    const int tpb = (TT + F.G - 1) / F.G;
    const int tok0 = F.vcu * tpb, half0 = (tpb + 1) / 2;
    const int lane = pg8::mk_lane();
    for (int it = F.wave; it < 36; it += NWAVES) {
        const int type = it >> 1, hf = it & 1;
        int tA = tok0 + (hf ? half0 : 0), tB = tok0 + (hf ? tpb : half0);
        if (tB > TT) tB = TT;
        if (tA >= tB) continue;
        if (type < 14) {
            int zoff, c = 0; bool act = true;
            if (type < 12) { const int kind = type >> 2; c = (type & 3) * 512 + lane * 8; zoff = (kind == 0 ? OFF_K : (kind == 1 ? OFF_V : OFF_R)) + c; }
            else if (type == 12) { act = lane < 24; zoff = OFF_WL + (act ? lane : 0) * 8; }
            else { act = lane < 32; zoff = OFF_GL + (act ? lane : 0) * 8; }
            float m8[8], kk8[8]; ldf8(mu + zoff, m8);
            if (type < 4) ldf8(F.in[I_KK] + c, kk8); else zero8(kk8);
            const bf16* zb = Z + zoff;
            v4u rw[6];
#pragma unroll
            for (int u = 0; u < 6; ++u) { const int r = tA - 1 + u; rw[u] = ldraw(zb + (size_t)(r < 0 ? 0 : r) * NZ, r >= 0 && r < TT); }
            for (int t0 = tA; t0 < tB; t0 += 4) {
                v4u nx[4];
#pragma unroll
                for (int u = 0; u < 4; ++u) { const int r = t0 + 5 + u; nx[u] = ldraw(zb + (size_t)(r < TT ? r : 0) * NZ, r < TT); }
#pragma unroll
                for (int u = 0; u < 4; ++u) {
                    const int t = t0 + u;
                    if (t < tB) {
                        const bool isctx = t >= T; const int pos = isctx ? t - T : (t & 63);
                        const bool hp = pos > 0, hn = isctx ? (pos < CTXL - 1) : (pos < 63);
                        float zp[8], zc[8], zn[8], v[8]; un8(rw[u], zp); un8(rw[u + 1], zc); un8(rw[u + 2], zn);
#pragma unroll
                        for (int i = 0; i < 8; ++i) v[i] = zc[i] + m8[i] * (0.5f * ((hp ? zp[i] : 0.f) + (hn ? zn[i] : 0.f)) - zc[i]);
                        const size_t fo = (size_t)t * 2048 + c;
                        if (type < 4) {
                            stb8(KB + fo, v);
                            float q[8]; float ss = 0.f;
#pragma unroll
                            for (int i = 0; i < 8; ++i) { q[i] = v[i] * kk8[i]; ss += q[i] * q[i]; }
                            ss += __shfl_xor(ss, 1); ss += __shfl_xor(ss, 2); ss += __shfl_xor(ss, 4);
                            const float inv = 1.0f / fmaxf(sqrtf(ss), 1e-12f);
#pragma unroll
                            for (int i = 0; i < 8; ++i) q[i] *= inv;
                            stb8(KKB + fo, q);
                        } else if (type < 8) stb8(VB + fo, v);
                        else if (type < 12) { if (!isctx) stb8(RB + fo, v); }
                        else if (type == 12) {
                            if (lane < 32) { float o[8];
                                if (lane < 12) { _Pragma("unroll") for (int i = 0; i < 8; ++i) o[i] = tanhf(v[i]); }
                                else if (lane < 24) cp8(o, v);
                                else zero8(o);
                                stb8(AL + (size_t)t * KLORA + lane * 8, o); }
                        } else { if (!isctx && lane < 32) { float o[8];
#pragma unroll
                                for (int i = 0; i < 8; ++i) o[i] = sigm(v[i]);
                                stb8(AG + (size_t)t * KGATE + lane * 8, o); } }
                    }
                }
                rw[0] = rw[4]; rw[1] = rw[5]; rw[2] = nx[0]; rw[3] = nx[1]; rw[4] = nx[2]; rw[5] = nx[3];
            }
        } else {
            if (tA >= T) continue;
            if (tB > T) tB = T;
            const int c = (type - 14) * 512 + lane * 8;
            float w0[8], w1[8], w2[8];
            ldf8(F.in[I_CONVW] + c, w0); ldf8(F.in[I_CONVW] + 2048 + c, w1); ldf8(F.in[I_CONVW] + 4096 + c, w2);
            const bf16* zc_ = Z + OFF_CC + c; const bf16* zx_ = Z + OFF_CX + c; const bf16* zb_ = Z + OFF_CB + c;
            v4u cw[6], xw[6], bw[4];
#pragma unroll
            for (int u = 0; u < 6; ++u) { const int r = tA - 1 + u; const bool ok = r >= 0 && r < T; const size_t ro = (size_t)(ok ? r : 0) * NZ; cw[u] = ldraw(zc_ + ro, ok); xw[u] = ldraw(zx_ + ro, ok); }
#pragma unroll
            for (int u = 0; u < 4; ++u) { const int r = tA + u; const bool ok = r < T; bw[u] = ldraw(zb_ + (size_t)(ok ? r : 0) * NZ, ok); }
            for (int t0 = tA; t0 < tB; t0 += 4) {
                v4u cn[4], xn[4], bn[4];
#pragma unroll
                for (int u = 0; u < 4; ++u) { const int r = t0 + 5 + u; const bool ok = r < T; const size_t ro = (size_t)(ok ? r : 0) * NZ; cn[u] = ldraw(zc_ + ro, ok); xn[u] = ldraw(zx_ + ro, ok);
                    const int rb = t0 + 4 + u; const bool okb = rb < T; bn[u] = ldraw(zb_ + (size_t)(okb ? rb : 0) * NZ, okb); }
#pragma unroll
                for (int u = 0; u < 4; ++u) {
                    const int t = t0 + u;
                    if (t < tB) {
                        const int pos = t & 63; const bool hp = pos > 0, hn = pos < 63;
                        float cp_[8], xp_[8], cc_[8], xc_[8], cn_[8], xn_[8], bg[8], y[8];
                        un8(cw[u], cp_); un8(xw[u], xp_); un8(cw[u + 1], cc_); un8(xw[u + 1], xc_); un8(cw[u + 2], cn_); un8(xw[u + 2], xn_); un8(bw[u], bg);
#pragma unroll
                        for (int i = 0; i < 8; ++i) y[i] = bg[i] * (w0[i] * (hp ? cp_[i] * xp_[i] : 0.f) + w1[i] * (cc_[i] * xc_[i]) + w2[i] * (hn ? cn_[i] * xn_[i] : 0.f));
                        stb8(CAT + (size_t)t * D + DR + c, y);
                    }
                }
                cw[0] = cw[4]; cw[1] = cw[5]; cw[2] = cn[0]; cw[3] = cn[1]; cw[4] = cn[2]; cw[5] = cn[3];
                xw[0] = xw[4]; xw[1] = xw[5]; xw[2] = xn[0]; xw[3] = xn[1]; xw[4] = xn[2]; xw[5] = xn[3];
                bw[0] = bn[0]; bw[1] = bn[1]; bw[2] = bn[2]; bw[3] = bn[3];
            }
        }
    }
}

typedef float f32x16 __attribute__((ext_vector_type(16)));
#define MK_FENCE() asm volatile("" ::: "memory")
constexpr int REC_BYTES = 8448, NBLK = TT / 16, SCAN_LDS = REC_BYTES + 4096;
__device__ __forceinline__ void swap32(float& x, float& y) { asm volatile("s_nop 1\n\tv_permlane32_swap_b32 %0, %1\n\ts_nop 1" : "+v"(x), "+v"(y)); }
__device__ __forceinline__ int kperm(int k) { return ((((k >> 5) * 2 + ((k >> 4) & 1)) * 2 + ((k >> 2) & 1)) * 8 + ((k >> 3) & 1) * 4 + (k & 3)); }
__device__ __forceinline__ int scan_blkbase(int d, int c, int j) {
    if (c == 0) return T + (d == 0 ? 16 * j : CTXL - 16 - 16 * j);
    const int p0 = (c - 1) * CHUNK + 16 * j;
    return d == 0 ? p0 : T - 16 - p0;
}
__device__ __forceinline__ void scan_vec32(const LAS unsigned char* row, int hl, float (&f)[32]) {
#pragma unroll
    for (int q = 0; q < 4; ++q) { const v4u w = *(const LAS v4u*)(row + (q * 2 + hl) * 16);
        f[8 * q + 0] = bflo(w.x); f[8 * q + 1] = bfhi(w.x); f[8 * q + 2] = bflo(w.y); f[8 * q + 3] = bfhi(w.y); f[8 * q + 4] = bflo(w.z); f[8 * q + 5] = bfhi(w.z); f[8 * q + 6] = bflo(w.w); f[8 * q + 7] = bfhi(w.w); }
}
__device__ __forceinline__ void scan_matvec(const f32x16 (&Tt)[2][2], const float (&f)[32], float& sa) {
    float p0a = 0.f, p0b = 0.f, p1a = 0.f, p1b = 0.f;
#pragma unroll
    for (int I = 0; I < 2; ++I)
#pragma unroll
        for (int r = 0; r < 16; r += 2) { p0a += Tt[I][0][r] * f[16 * I + r]; p1a += Tt[I][1][r] * f[16 * I + r]; p0b += Tt[I][0][r + 1] * f[16 * I + r + 1]; p1b += Tt[I][1][r + 1] * f[16 * I + r + 1]; }
    float p0 = p0a + p0b, p1 = p1a + p1b;
    swap32(p0, p1);
    sa = p0 + p1;
}
__device__ __forceinline__ void scan_renorm(f32x16 (&Tt)[2][2], const LAS float* ge, int hl) {
#pragma unroll
    for (int I = 0; I < 2; ++I)
#pragma unroll
        for (int qd = 0; qd < 4; ++qd) { const f32x4 g = *(const LAS f32x4*)(ge + 32 * I + 8 * qd + 4 * hl);
#pragma unroll
            for (int e = 0; e < 4; ++e) { Tt[I][0][4 * qd + e] *= g[e]; Tt[I][1][4 * qd + e] *= g[e]; } }
}
__device__ __forceinline__ void scan_store_T(const f32x16 (&Tt)[2][2], float* dst, int lane) {
#pragma unroll
    for (int I = 0; I < 2; ++I)
#pragma unroll
        for (int J = 0; J < 2; ++J)
#pragma unroll
            for (int reg = 0; reg < 16; ++reg) *(GAS float*)(dst + (32 * I + 8 * (reg >> 2) + 4 * (lane >> 5) + (reg & 3)) * 64 + 32 * J + (lane & 31)) = Tt[I][J][reg];
}
typedef short bf16x8 __attribute__((ext_vector_type(8)));
#define MK_MFMA(a, b, c) __builtin_amdgcn_mfma_f32_32x32x16_bf16((a), (b), (c), 0, 0, 0)
constexpr int SCR_LAB = 0, SCR_LAK = 1024, SCR_MRB = 2048, SCR_MRK = 2560, SCAN_SCR = 3072;
struct RecRegs { v4u p[8]; float ge; };
__device__ __forceinline__ void scan_rload(const unsigned char* PKB, int d, int h, int tb, int lane, RecRegs& R) {
    const GAS unsigned char* rp = (const GAS unsigned char*)PKB + ((size_t)(d * 32 + h) * NBLK + (tb >> 4)) * REC_BYTES;
#pragma unroll
    for (int j = 0; j < 8; ++j) R.p[j] = *((const GAS v4u*)rp + 64 * j + lane);
    R.ge = *((const GAS float*)(rp + 8192) + lane);
}
__device__ __forceinline__ void scan_rstore(LAS unsigned char* buf, int lane, const RecRegs& R) {
#pragma unroll
    for (int j = 0; j < 8; ++j) *((LAS v4u*)buf + 64 * j + lane) = R.p[j];
    *((LAS float*)(buf + 8192) + lane) = R.ge;
}
typedef float f32x2n __attribute__((ext_vector_type(2)));
typedef __bf16 bf16x2n __attribute__((ext_vector_type(2)));
__device__ __forceinline__ unsigned cvt2bf(float a, float b) { const f32x2n v = {a, b}; return __builtin_bit_cast(unsigned, __builtin_convertvector(v, bf16x2n)); }
__device__ __forceinline__ bf16x8 pack8(float a0, float a1, float a2, float a3, float a4, float a5, float a6, float a7) {
    const v4u u = {cvt2bf(a0, a1), cvt2bf(a2, a3), cvt2bf(a4, a5), cvt2bf(a6, a7)}; return __builtin_bit_cast(bf16x8, u); }
__device__ __forceinline__ f32x16 zero16() { f32x16 z;
#pragma unroll
    for (int i = 0; i < 16; ++i) z[i] = 0.f;
    return z; }
__device__ __forceinline__ void scan_tfrags(const f32x16 (&Tt)[2][2], bf16x8 (&Tf)[2][2][2]) {
#pragma unroll
    for (int I = 0; I < 2; ++I)
#pragma unroll
        for (int J = 0; J < 2; ++J)
#pragma unroll
            for (int s = 0; s < 2; ++s) Tf[I][J][s] = pack8(Tt[I][J][8 * s], Tt[I][J][8 * s + 1], Tt[I][J][8 * s + 2], Tt[I][J][8 * s + 3], Tt[I][J][8 * s + 4], Tt[I][J][8 * s + 5], Tt[I][J][8 * s + 6], Tt[I][J][8 * s + 7]);
}
__device__ __forceinline__ void scan_sfrags(float (&S)[16], bf16x8 (&Sf)[2]) {
#pragma unroll
    for (int j = 0; j < 8; ++j) swap32(S[j], S[j + 8]);
    Sf[0] = pack8(S[0], S[1], S[2], S[3], S[4], S[5], S[6], S[7]); Sf[1] = pack8(S[8], S[9], S[10], S[11], S[12], S[13], S[14], S[15]);
}
template <int WHICH> __device__ __forceinline__ void p5_pass(Frame& F, const int unit) {
    const unsigned char* PKB = F.ws + WS_PK; const bf16* VB = (const bf16*)(F.ws + WS_VBUF);
    float* PU = (float*)(F.ws + WS_PU);
    LAS unsigned char* my = F.lds + RING_OFF + F.wave * (REC_BYTES + SCAN_SCR);
    LAS unsigned char* scr = my + REC_BYTES;
    {
        const int d = unit & 1, h = (unit >> 1) & 31, c = unit >> 6;
        constexpr int which = WHICH;
        {
            const int lane = pg8::mk_lane(), hl = lane >> 5, l31 = lane & 31, l15 = lane & 15;
            const float idv = which ? 1.0f : 0.0f;
            f32x16 Tt[2][2];
#pragma unroll
            for (int I = 0; I < 2; ++I)
#pragma unroll
                for (int J = 0; J < 2; ++J)
#pragma unroll
                    for (int reg = 0; reg < 16; ++reg) Tt[I][J][reg] = (32 * I + 8 * (reg >> 2) + 4 * hl + (reg & 3) == 32 * J + l31) ? idv : 0.0f;
            RecRegs R;
            scan_rload(PKB, d, h, scan_blkbase(d, c, 0), lane, R);
#pragma unroll 1
            for (int j = 0; j < 16; ++j) {
                const int tb = scan_blkbase(d, c, j);
                scan_rstore(my, lane, R);
                float Vv[16];
                if (which == 0) { const GAS bf16* gv = (const GAS bf16*)(VB + (size_t)(tb + (d == 0 ? 0 : 15)) * 2048 + h * 64) + lane; const int dstep = d == 0 ? 2048 : -2048;
#pragma unroll
                    for (int t = 0; t < 16; ++t) Vv[t] = __builtin_bit_cast(float, (unsigned)gv[t * dstep] << 16); }
                else {
#pragma unroll
                    for (int t = 0; t < 16; ++t) Vv[t] = 0.f; }
                const LAS unsigned char* arow = my + l15 * 128 + hl * 16;
                {   f32x16 Lab = zero16(), Lak = zero16();
#pragma unroll
                    for (int qq = 0; qq < 4; ++qq) { const bf16x8 af = *(const LAS bf16x8*)(arow + qq * 32), bf = *(const LAS bf16x8*)(arow + 4096 + qq * 32), kf = *(const LAS bf16x8*)(arow + 6144 + qq * 32);
                        Lab = MK_MFMA(af, bf, Lab); if (which == 0) Lak = MK_MFMA(af, kf, Lak); }
                    if (l31 < 16) { LAS float* lb = (LAS float*)scr + 64 * hl + l31;
#pragma unroll
                        for (int r = 0; r < 8; ++r) { const int t0 = 8 * (r >> 2) + (r & 3); lb[SCR_LAB / 4 + t0 * 16] = Lab[r]; lb[SCR_LAK / 4 + t0 * 16] = Lak[r]; } }
                }
                MK_FENCE();
                f32x16 G[2];
                {   bf16x8 Tf[2][2][2]; scan_tfrags(Tt, Tf);
                    G[0] = zero16(); G[1] = zero16();
#pragma unroll
                    for (int qq = 0; qq < 4; ++qq) { const bf16x8 af = *(const LAS bf16x8*)(arow + qq * 32);
                        G[0] = MK_MFMA(af, Tf[qq >> 1][0][qq & 1], G[0]); G[1] = MK_MFMA(af, Tf[qq >> 1][1][qq & 1], G[1]); }
                }
                MK_FENCE();
                if (j + 1 < 16) scan_rload(PKB, d, h, scan_blkbase(d, c, j + 1), lane, R);
                float S[16];
#pragma unroll
                for (int r = 0; r < 8; ++r) { float x = G[0][r], y = G[1][r]; swap32(x, y); const int t = 8 * (r >> 2) + (r & 3); S[t] = x; S[t + 4] = y; }
#pragma unroll
                for (int t = 1; t < 16; ++t) {
                    float acc = S[t], acc1 = 0.f, acc2 = 0.f, acc3 = 0.f;
#pragma unroll
                    for (int s4 = 0; s4 < (t + 3) / 4; ++s4) { const f32x4 la = *(const LAS f32x4*)(scr + SCR_LAB + (t * 16 + 4 * s4) * 4), lk = *(const LAS f32x4*)(scr + SCR_LAK + (t * 16 + 4 * s4) * 4);
#pragma unroll
                        for (int e = 0; e < 4; ++e) if (4 * s4 + e < t) { if (e & 1) acc1 += la[e] * S[4 * s4 + e]; else acc += la[e] * S[4 * s4 + e];
                            if (which == 0) { if (e & 1) acc3 += lk[e] * Vv[4 * s4 + e]; else acc2 += lk[e] * Vv[4 * s4 + e]; } } }
                    S[t] = (acc + acc1) + (acc2 + acc3);
                }
                bf16x8 Sf[2], Vf[2]; scan_sfrags(S, Sf); if (which == 0) scan_sfrags(Vv, Vf);
#pragma unroll
                for (int I = 0; I < 2; ++I) {
                    const LAS unsigned char* col = my + 4096 + (8 * hl) * 128 + kperm(32 * I + l31) * 2;
                    unsigned short bs[8], ks[8];
#pragma unroll
                    for (int e = 0; e < 8; ++e) { bs[e] = *(const LAS unsigned short*)(col + e * 128); ks[e] = *(const LAS unsigned short*)(col + 2048 + e * 128); }
                    const v4u bu = {(unsigned)bs[0] | ((unsigned)bs[1] << 16), (unsigned)bs[2] | ((unsigned)bs[3] << 16), (unsigned)bs[4] | ((unsigned)bs[5] << 16), (unsigned)bs[6] | ((unsigned)bs[7] << 16)};
                    const v4u ku = {(unsigned)ks[0] | ((unsigned)ks[1] << 16), (unsigned)ks[2] | ((unsigned)ks[3] << 16), (unsigned)ks[4] | ((unsigned)ks[5] << 16), (unsigned)ks[6] | ((unsigned)ks[7] << 16)};
                    const bf16x8 ba = __builtin_bit_cast(bf16x8, bu), ka = __builtin_bit_cast(bf16x8, ku);
                    Tt[I][0] = MK_MFMA(ba, Sf[0], Tt[I][0]); Tt[I][1] = MK_MFMA(ba, Sf[1], Tt[I][1]); if (which == 0) { Tt[I][0] = MK_MFMA(ka, Vf[0], Tt[I][0]); Tt[I][1] = MK_MFMA(ka, Vf[1], Tt[I][1]); }
                }
                scan_renorm(Tt, (const LAS float*)(my + 8192), hl);
            }
            scan_store_T(Tt, PU + ((size_t)unit * 2 + (which ? 0 : 1)) * 4096, lane);
        }
    }
}
__device__ __forceinline__ void p5_scanA(Frame& F) {
    for (int unit = F.vcu * NWAVES + F.wave; unit < 2048; unit += F.G * NWAVES) { p5_pass<0>(F, unit); if (unit >= 64) p5_pass<1>(F, unit); }
}
__device__ __forceinline__ void p6_scanB(Frame& F) {
    const GAS char* PU = (const GAS char*)(F.ws + WS_PU); GAS char* SST = (GAS char*)(F.ws + WS_SST);
    LAS float* PiB = (LAS float*)(F.lds + RING_OFF);
    LAS float* TbB = (LAS float*)(F.lds + RING_OFF + 2 * 16640);
    const int w = F.wave;
    for (int q = F.vcu; q < 64; q += F.G) {
        const unsigned lane = (unsigned)pg8::mk_lane(), tid = (unsigned)w * 64u + lane, hl = lane >> 5, l31 = lane & 31u;
        const unsigned I1 = ((unsigned)w >> 1) & 1u, J = (unsigned)w & 1u;
        {   const GAS char* u0 = PU + ((size_t)q * 2 + 1) * 16384; GAS char* so = SST + ((size_t)q * NCHUNK + 1) * 16384;
            const f32x4 t0 = *(const GAS f32x4*)(u0 + tid * 32u), t1 = *(const GAS f32x4*)(u0 + tid * 32u + 16u);
            *((LAS f32x4*)TbB + tid * 2) = t0; *((LAS f32x4*)TbB + tid * 2 + 1) = t1;
            *(GAS f32x4*)(so + tid * 32u) = t0; *(GAS f32x4*)(so + tid * 32u + 16u) = t1; }
        f32x4 pn0, pn1; f32x16 un;
        {   const GAS char* pg = PU + (((size_t)q + 64) * 2 + 0) * 16384; pn0 = *(const GAS f32x4*)(pg + tid * 32u); pn1 = *(const GAS f32x4*)(pg + tid * 32u + 16u);
            const unsigned pb = (tid >> 3) * 65u + (tid & 7u) * 8u;
#pragma unroll
            for (int e = 0; e < 4; ++e) { PiB[pb + e] = pn0[e]; PiB[pb + 4 + e] = pn1[e]; }
            const GAS char* ug = PU + (((size_t)q + 64) * 2 + 1) * 16384;
#pragma unroll
            for (int r = 0; r < 16; ++r) un[r] = (w < 4) ? *(const GAS float*)(ug + ((32u * I1 + 8u * (r >> 2) + 4u * hl + (r & 3)) * 64u + 32u * J + l31) * 4u) : 0.f; }
        __syncthreads();
        for (int c = 1; c < 32; ++c) {
            const LAS float* Pi = PiB + ((c - 1) & 1) * 4160; const LAS float* Tb = TbB + ((c - 1) & 1) * 4096;
            LAS float* PiN = PiB + (c & 1) * 4160; LAS float* TbN = TbB + (c & 1) * 4096;
            f32x16 acc = un;
            if (c + 1 < 32) {
                const GAS char* pg = PU + (((size_t)q + 64 * (c + 1)) * 2 + 0) * 16384; pn0 = *(const GAS f32x4*)(pg + tid * 32u); pn1 = *(const GAS f32x4*)(pg + tid * 32u + 16u);
                const GAS char* ug = PU + (((size_t)q + 64 * (c + 1)) * 2 + 1) * 16384;
                if (w < 4) {
#pragma unroll
                    for (int r = 0; r < 16; ++r) un[r] = *(const GAS float*)(ug + ((32u * I1 + 8u * (r >> 2) + 4u * hl + (r & 3)) * 64u + 32u * J + l31) * 4u); }
            }
            if (w < 4) {
#pragma unroll
                for (int s2 = 0; s2 < 32; ++s2) { const float av = Pi[(32u * I1 + l31) * 65u + 2u * s2 + hl], bv = Tb[(2u * s2 + hl) * 64u + 32u * J + l31];
                    acc = __builtin_amdgcn_mfma_f32_32x32x2f32(av, bv, acc, 0, 0, 0);
                    if ((s2 & 7) == 7) MK_FENCE(); }
                GAS char* so = SST + ((size_t)q * NCHUNK + c + 1) * 16384;
#pragma unroll
                for (int r = 0; r < 16; ++r) { const unsigned e = (32u * I1 + 8u * (r >> 2) + 4u * hl + (r & 3)) * 64u + 32u * J + l31; TbN[e] = acc[r]; *(GAS float*)(so + e * 4u) = acc[r]; }
            }
            if (c + 1 < 32) { const unsigned pb = (tid >> 3) * 65u + (tid & 7u) * 8u;
#pragma unroll
                for (int e = 0; e < 4; ++e) { PiN[pb + e] = pn0[e]; PiN[pb + 4 + e] = pn1[e]; } }
            __syncthreads();
        }
    }
}
__device__ __forceinline__ void p7_scanC(Frame& F) {
    const unsigned char* PKB = F.ws + WS_PK; const bf16* VB = (const bf16*)(F.ws + WS_VBUF);
    const float* SST = (const float*)(F.ws + WS_SST); bf16* YS = (bf16*)(F.ws + WS_YS);
    LAS unsigned char* my = F.lds + RING_OFF + F.wave * (REC_BYTES + SCAN_SCR);
    LAS unsigned char* scr = my + REC_BYTES;
    for (int unit = F.vcu * NWAVES + F.wave; unit < 2048; unit += F.G * NWAVES) {
        const int d = unit & 1, h = (unit >> 1) & 31, c = (unit >> 6) + 1, q = unit & 63;
        const int lane = pg8::mk_lane(), hl = lane >> 5, l31 = lane & 31, l15 = lane & 15;
        f32x16 Tt[2][2];
        {   const float* s0 = SST + ((size_t)q * NCHUNK + c) * 4096;
#pragma unroll
            for (int I = 0; I < 2; ++I)
#pragma unroll
                for (int J = 0; J < 2; ++J)
#pragma unroll
                    for (int reg = 0; reg < 16; ++reg) Tt[I][J][reg] = *(const GAS float*)(s0 + (32 * I + 8 * (reg >> 2) + 4 * hl + (reg & 3)) * 64 + 32 * J + l31); }
        RecRegs R;
        scan_rload(PKB, d, h, scan_blkbase(d, c, 0), lane, R);
#pragma unroll 1
        for (int j = 0; j < 16; ++j) {
            const int tb = scan_blkbase(d, c, j);
            scan_rstore(my, lane, R);
            float Vv[16];
            {   const GAS bf16* gv = (const GAS bf16*)(VB + (size_t)(tb + (d == 0 ? 0 : 15)) * 2048 + h * 64) + lane; const int dstep = d == 0 ? 2048 : -2048;
#pragma unroll
                for (int t = 0; t < 16; ++t) Vv[t] = __builtin_bit_cast(float, (unsigned)gv[t * dstep] << 16); }
            const LAS unsigned char* arow = my + l15 * 128 + hl * 16;
            {   f32x16 Lab = zero16(), Lak = zero16(), Mrb = zero16(), Mrk = zero16();
#pragma unroll
                for (int qq = 0; qq < 4; ++qq) { const bf16x8 af = *(const LAS bf16x8*)(arow + qq * 32), rf = *(const LAS bf16x8*)(arow + 2048 + qq * 32), bf = *(const LAS bf16x8*)(arow + 4096 + qq * 32), kf = *(const LAS bf16x8*)(arow + 6144 + qq * 32);
                    Lab = MK_MFMA(af, bf, Lab); Lak = MK_MFMA(af, kf, Lak); Mrb = MK_MFMA(rf, bf, Mrb); Mrk = MK_MFMA(rf, kf, Mrk); }
                if (l31 < 16) {
                    LAS float* lb = (LAS float*)scr + 64 * hl + l31; LAS unsigned short* mb = (LAS unsigned short*)scr + 64 * hl + l31; const int lm = l31 - 4 * hl;
#pragma unroll
                    for (int r = 0; r < 8; ++r) { const int t0 = 8 * (r >> 2) + (r & 3);
                        lb[SCR_LAB / 4 + t0 * 16] = Lab[r]; lb[SCR_LAK / 4 + t0 * 16] = Lak[r];
                        mb[SCR_MRB / 2 + t0 * 16] = (unsigned short)f2bf(lm <= t0 ? Mrb[r] : 0.f); mb[SCR_MRK / 2 + t0 * 16] = (unsigned short)f2bf(lm <= t0 ? Mrk[r] : 0.f); }
                }
            }
            MK_FENCE();
            f32x16 G[2], Y[2];
            {   bf16x8 Tf[2][2][2]; scan_tfrags(Tt, Tf);
                G[0] = zero16(); G[1] = zero16(); Y[0] = zero16(); Y[1] = zero16();
#pragma unroll
                for (int qq = 0; qq < 4; ++qq) { const bf16x8 af = *(const LAS bf16x8*)(arow + qq * 32), rf = *(const LAS bf16x8*)(arow + 2048 + qq * 32);
                    G[0] = MK_MFMA(af, Tf[qq >> 1][0][qq & 1], G[0]); G[1] = MK_MFMA(af, Tf[qq >> 1][1][qq & 1], G[1]);
                    Y[0] = MK_MFMA(rf, Tf[qq >> 1][0][qq & 1], Y[0]); Y[1] = MK_MFMA(rf, Tf[qq >> 1][1][qq & 1], Y[1]); }
            }
            MK_FENCE();
            if (j + 1 < 16) scan_rload(PKB, d, h, scan_blkbase(d, c, j + 1), lane, R);
            float S[16];
#pragma unroll
            for (int r = 0; r < 8; ++r) { float x = G[0][r], y = G[1][r]; swap32(x, y); const int t = 8 * (r >> 2) + (r & 3); S[t] = x; S[t + 4] = y; }
#pragma unroll
            for (int t = 1; t < 16; ++t) {
                float acc = S[t], acc1 = 0.f, acc2 = 0.f, acc3 = 0.f;
#pragma unroll
                for (int s4 = 0; s4 < (t + 3) / 4; ++s4) { const f32x4 la = *(const LAS f32x4*)(scr + SCR_LAB + (t * 16 + 4 * s4) * 4), lk = *(const LAS f32x4*)(scr + SCR_LAK + (t * 16 + 4 * s4) * 4);
#pragma unroll
                    for (int e = 0; e < 4; ++e) if (4 * s4 + e < t) { if (e & 1) { acc1 += la[e] * S[4 * s4 + e]; acc3 += lk[e] * Vv[4 * s4 + e]; } else { acc += la[e] * S[4 * s4 + e]; acc2 += lk[e] * Vv[4 * s4 + e]; } } }
                S[t] = (acc + acc1) + (acc2 + acc3);
            }
            bf16x8 Sf[2], Vf[2]; scan_sfrags(S, Sf); scan_sfrags(Vv, Vf);
            {   const bf16x8 mb = *(const LAS bf16x8*)(scr + SCR_MRB + l15 * 32 + hl * 16), mk = *(const LAS bf16x8*)(scr + SCR_MRK + l15 * 32 + hl * 16);
                Y[0] = MK_MFMA(mb, Sf[0], Y[0]); Y[1] = MK_MFMA(mb, Sf[1], Y[1]); Y[0] = MK_MFMA(mk, Vf[0], Y[0]); Y[1] = MK_MFMA(mk, Vf[1], Y[1]); }
#pragma unroll
            for (int I = 0; I < 2; ++I) {
                const LAS unsigned char* col = my + 4096 + (8 * hl) * 128 + kperm(32 * I + l31) * 2;
                unsigned short bs[8], ks[8];
#pragma unroll
                for (int e = 0; e < 8; ++e) { bs[e] = *(const LAS unsigned short*)(col + e * 128); ks[e] = *(const LAS unsigned short*)(col + 2048 + e * 128); }
                const v4u bu = {(unsigned)bs[0] | ((unsigned)bs[1] << 16), (unsigned)bs[2] | ((unsigned)bs[3] << 16), (unsigned)bs[4] | ((unsigned)bs[5] << 16), (unsigned)bs[6] | ((unsigned)bs[7] << 16)};
                const v4u ku = {(unsigned)ks[0] | ((unsigned)ks[1] << 16), (unsigned)ks[2] | ((unsigned)ks[3] << 16), (unsigned)ks[4] | ((unsigned)ks[5] << 16), (unsigned)ks[6] | ((unsigned)ks[7] << 16)};
                const bf16x8 ba = __builtin_bit_cast(bf16x8, bu), ka = __builtin_bit_cast(bf16x8, ku);
                Tt[I][0] = MK_MFMA(ba, Sf[0], Tt[I][0]); Tt[I][1] = MK_MFMA(ba, Sf[1], Tt[I][1]); Tt[I][0] = MK_MFMA(ka, Vf[0], Tt[I][0]); Tt[I][1] = MK_MFMA(ka, Vf[1], Tt[I][1]);
            }
            {   GAS bf16* yb = (GAS bf16*)(YS + (size_t)d * T * 2048 + (size_t)(tb + (d == 0 ? 4 * hl : 15 - 4 * hl)) * 2048 + h * 64) + l31; const int ystep = d == 0 ? 2048 : -2048;
#pragma unroll
                for (int J = 0; J < 2; ++J)
#pragma unroll
                    for (int r = 0; r < 8; ++r) yb[(8 * (r >> 2) + (r & 3)) * ystep + 32 * J] = (bf16)f2bf(Y[J][r]); }
            scan_renorm(Tt, (const LAS float*)(my + 8192), hl);
        }
    }
}

__device__ __forceinline__ void p8_readout(Frame& F) {
    const bf16* RB = (const bf16*)(F.ws + WS_RBUF); const bf16* VB = (const bf16*)(F.ws + WS_VBUF); const bf16* YS = (const bf16*)(F.ws + WS_YS);
    const bf16* KD = (const bf16*)(F.ws + WS_KD);
    const bf16* G = (const bf16*)(F.ws + WS_G); bf16* CAT = (bf16*)(F.ws + WS_CAT);
    const int tpb = (T + F.G - 1) / F.G, tok0 = F.vcu * tpb, lane = pg8::mk_lane();
    for (int it = F.wave; it < tpb * 4; it += NWAVES) {
        const int j = it / tpb, tok = tok0 + it % tpb;
        if (tok >= T) continue;
        const int c = j * 512 + lane * 8;
        float y0[8], y1[8], y[8];
        ld8(YS + (size_t)tok * 2048 + c, y0); ld8(YS + ((size_t)T + tok) * 2048 + c, y1);
        float s = 0.f;
#pragma unroll
        for (int i = 0; i < 8; ++i) { y[i] = y0[i] + y1[i]; s += y[i]; }
        s += __shfl_xor(s, 1); s += __shfl_xor(s, 2); s += __shfl_xor(s, 4);
        const float mean = s * (1.0f / 64.0f); float q = 0.f;
#pragma unroll
        for (int i = 0; i < 8; ++i) { const float dlt = y[i] - mean; q += dlt * dlt; }
        q += __shfl_xor(q, 1); q += __shfl_xor(q, 2); q += __shfl_xor(q, 4);
        const float rstd = 1.0f / sqrtf(q * (1.0f / 64.0f) + LNX_EPS);
        float r8[8], v8[8], k0[8], k1[8], rk[8], lw[8], lb[8], g8[8];
        ld8(RB + (size_t)tok * 2048 + c, r8); ld8(VB + (size_t)tok * 2048 + c, v8);
        ld8(KD + (size_t)tok * 2048 + c, k0); ld8(KD + ((size_t)TT + tok) * 2048 + c, k1);
        ldf8(F.in[I_RK] + c, rk); ldf8(F.in[I_LNXW] + c, lw); ldf8(F.in[I_LNXB] + c, lb);
        ld8(G + (size_t)tok * 2048 + c, g8);
        float dot = 0.f;
#pragma unroll
        for (int i = 0; i < 8; ++i) dot += r8[i] * (k0[i] + k1[i]) * rk[i];
        dot += __shfl_xor(dot, 1); dot += __shfl_xor(dot, 2); dot += __shfl_xor(dot, 4);
        float o[8];
#pragma unroll
        for (int i = 0; i < 8; ++i) o[i] = ((y[i] - mean) * rstd * lw[i] + lb[i] + dot * v8[i]) * g8[i];
        stb8(CAT + (size_t)tok * D + c, o);
    }
}

template <int K> __device__ __forceinline__ void run_phase(Frame& F) {
    bf16* A1 = (bf16*)(F.ws + WS_A1); bf16* Zb = (bf16*)(F.ws + WS_Z);
    const float* MV = (const float*)(F.ws + WS_MODV);
    (void)A1; (void)Zb; (void)MV;
    asm volatile("; MK_PHASE %0" :: "i"(K) : "memory");
    if constexpr (K == 0) { p0_prologue(F);
    }
    if constexpr (K == 1) { p1_norm1(F);
    }
    if constexpr (K == 2) {
        { pg8::Gemm g{A1, (const bf16*)(F.ws + WS_WIN), T, NZ, D}; pg8::StaticOrder S; S.init(T, NZ, F.G, (int)blockIdx.x);
          pg8::EpiBf16<0> E{Zb, NZ, nullptr, 0, 0, 1.f};
          pg8::gemm_phase<pg8::EpiBf16<0>, pg8::StaticOrder, true, true>(F.lds + RING_OFF, g, S, E, F.wave); }
        { pg8::Gemm g{A1 + (size_t)T * D, (const bf16*)(F.ws + WS_WIN), CTXL, NCTXZ, D}; pg8::StaticOrder S; S.init(CTXL, NCTXZ, F.G, (int)((blockIdx.x + F.G - 64) % F.G));
          pg8::EpiBf16<0> E{Zb + (size_t)T * NZ, NZ, nullptr, 0, 0, 1.f};
          pg8::gemm_phase<pg8::EpiBf16<0>, pg8::StaticOrder, true, true>(F.lds + RING_OFF, g, S, E, F.wave); }
        tr_idle(F, P2T_B, P2T_E, (int)blockIdx.x - 81, 175);
    }
    if constexpr (K == 3) { p3_prep(F);
    }
    if constexpr (K == 4) {
        { int kl = KLORA; asm volatile("" : "+s"(kl));
          pg8::Gemm g{(const bf16*)(F.ws + WS_ALORA), (const bf16*)(F.ws + WS_WLORA), TT, NLORA, kl}; pg8::StaticOrder S; S.init(TT, NLORA, F.G, (int)blockIdx.x);
          pg8::EpiLora E{F.ws + WS_PK, (bf16*)(F.ws + WS_KD), (const bf16*)(F.ws + WS_KBUF), (const bf16*)(F.ws + WS_KKBUF), (const bf16*)(F.ws + WS_RBUF), F.in[I_W0], F.in[I_A0], F.in[I_KA], TT};
          pg8::gemm_phase<pg8::EpiLora, pg8::StaticOrder, true, true>(F.lds + RING_OFF, g, S, E, F.wave); }
        { int kl = KGATE; asm volatile("" : "+s"(kl));
          pg8::Gemm g{(const bf16*)(F.ws + WS_AGATE), (const bf16*)(F.ws + WS_WGATE), T, DR, kl}; pg8::StaticOrder S;
          if (F.G == 256) S.init(T, DR, 224, blockIdx.x >= 32 ? (int)blockIdx.x - 32 : 1 << 20); else S.init(T, DR, F.G, (int)blockIdx.x);
          pg8::EpiBf16<0> E{(bf16*)(F.ws + WS_G), DR, nullptr, 0, 0, 1.f};
          pg8::gemm_phase<pg8::EpiBf16<0>, pg8::StaticOrder, true, true>(F.lds + RING_OFF, g, S, E, F.wave); }

    }
    if constexpr (K == 5) { p5_scanA(F);
    }
    if constexpr (K == 6) { p6_scanB(F); tr_idle(F, P6T_B, P6T_E, F.vcu - 64, 192);

    }
    if constexpr (K == 7) { p7_scanC(F);
    }
    if constexpr (K == 8) { p8_readout(F);
    }
    if constexpr (K == 9) {
        pg8::Gemm g{(const bf16*)(F.ws + WS_CAT), (const bf16*)(F.ws + WS_WOUT), T, D, D}; pg8::StaticOrder S; S.init(T, D, F.G, (int)blockIdx.x);
        pg8::EpiResid E{F.in[I_X], (float*)(F.ws + WS_X1), D, MV + 2 * D};
        pg8::gemm_phase<pg8::EpiResid, pg8::StaticOrder, true, true>(F.lds + RING_OFF, g, S, E, F.wave);

    }
    if constexpr (K == 10) { p10_norm2(F);
    }
    if constexpr (K == 11) {
        pg8::Gemm g{A1, (const bf16*)(F.ws + WS_WGU), T, NGU, D}; pg8::StaticOrder S; S.init(T, NGU, F.G, (int)blockIdx.x);
        pg8::EpiSwiglu E{(bf16*)(F.ws + WS_ACT), DFF};
        pg8::gemm_phase<pg8::EpiSwiglu, pg8::StaticOrder, true, true>(F.lds + RING_OFF, g, S, E, F.wave);
        tr_idle(F, P11T_B, P11T_E, (int)blockIdx.x - 192, 64);
    }
    if constexpr (K == 12) {
        pg8::Gemm g{(const bf16*)(F.ws + WS_ACT), (const bf16*)(F.ws + WS_WDN), T, D, DFF}; pg8::StaticOrder S; S.init(T, D, F.G, (int)blockIdx.x);
        pg8::EpiResid E{(const float*)(F.ws + WS_X1), F.out, D, MV + 5 * D};
        pg8::gemm_phase<pg8::EpiResid, pg8::StaticOrder, true, true>(F.lds + RING_OFF, g, S, E, F.wave);

    }
    if constexpr (K == 13) { p13_final(F);
    }
}

struct Args { const float* in[26]; float* out; unsigned char* ws; int ph_lo, ph_hi, li, pad; };
__global__ void __launch_bounds__(NWAVES * 64, 2) mk_fwd(Args args) {
    extern __shared__ __attribute__((aligned(16))) unsigned char lds[];
    Frame F;
    F.lds = (LAS unsigned char*)lds;
    F.MISC = (volatile LAS unsigned*)(F.lds + MISC_OFF);
    F.wave = __builtin_amdgcn_readfirstlane((int)(threadIdx.x >> 6));
    F.G = gridDim.x; { const int bx = blockIdx.x; F.vcu = (F.G % 8 == 0) ? (bx % 8) * (F.G / 8) + bx / 8 : bx; }
    F.ws = args.ws; F.ctl = (gu32*)(args.ws + WS_CTL); F.out = args.out;
#pragma unroll
    for (int i = 0; i < 26; ++i) F.in[i] = args.in[i];
    for (int u = threadIdx.x; u < (LDS_BYTES - LDSCTL_OFF) / 4; u += NWAVES * 64) ((LAS unsigned*)(F.lds + LDSCTL_OFF))[u] = 0u;
    __syncthreads();
    XcdBarrier bar; bar.bar = (unsigned*)(F.ctl + CW_BAR); bar.x = 0; bar.st = nullptr;
    if (N_LAUNCHES == 1) bar = xcd_barrier_post((unsigned*)(F.ctl + CW_BAR), F.MISC + 8);
#define GRID_BAR() do { if (N_LAUNCHES == 1) xcd_barrier(bar, F.wave); } while (0)
    unsigned long long tp0 = 0, tpa = 0, tpb = 0; (void)tp0;
    const int lo = args.ph_lo, hi = args.ph_hi;
#define IN(k) (lo <= (k) && (k) < hi)
#define BOTH(k) (IN(k) && IN((k) + 1))

    if (IN(0)) { if constexpr (0 == TPA || 0 == TPB) tp0 = __builtin_amdgcn_s_memrealtime(); run_phase<0>(F); if constexpr (PH_REPS[0] > 1) { GRID_BAR(); run_phase<0>(F); } if constexpr (PH_REPS[0] > 2) { GRID_BAR(); run_phase<0>(F); } if (BOTH(0)) GRID_BAR(); if constexpr (0 == TPA) tpa = __builtin_amdgcn_s_memrealtime() - tp0; if constexpr (0 == TPB) tpb = __builtin_amdgcn_s_memrealtime() - tp0; }
    if (IN(1)) { if constexpr (1 == TPA || 1 == TPB) tp0 = __builtin_amdgcn_s_memrealtime(); run_phase<1>(F); if constexpr (PH_REPS[1] > 1) { GRID_BAR(); run_phase<1>(F); } if constexpr (PH_REPS[1] > 2) { GRID_BAR(); run_phase<1>(F); } if (BOTH(1)) GRID_BAR(); if constexpr (1 == TPA) tpa = __builtin_amdgcn_s_memrealtime() - tp0; if constexpr (1 == TPB) tpb = __builtin_amdgcn_s_memrealtime() - tp0; }
    if (IN(2)) { if constexpr (2 == TPA || 2 == TPB) tp0 = __builtin_amdgcn_s_memrealtime(); run_phase<2>(F); if constexpr (PH_REPS[2] > 1) { GRID_BAR(); run_phase<2>(F); } if constexpr (PH_REPS[2] > 2) { GRID_BAR(); run_phase<2>(F); } if (BOTH(2)) GRID_BAR(); if constexpr (2 == TPA) tpa = __builtin_amdgcn_s_memrealtime() - tp0; if constexpr (2 == TPB) tpb = __builtin_amdgcn_s_memrealtime() - tp0; }
    if (IN(3)) { if constexpr (3 == TPA || 3 == TPB) tp0 = __builtin_amdgcn_s_memrealtime(); run_phase<3>(F); if constexpr (PH_REPS[3] > 1) { GRID_BAR(); run_phase<3>(F); } if constexpr (PH_REPS[3] > 2) { GRID_BAR(); run_phase<3>(F); } if (BOTH(3)) GRID_BAR(); if constexpr (3 == TPA) tpa = __builtin_amdgcn_s_memrealtime() - tp0; if constexpr (3 == TPB) tpb = __builtin_amdgcn_s_memrealtime() - tp0; }
    if (IN(4)) { if constexpr (4 == TPA || 4 == TPB) tp0 = __builtin_amdgcn_s_memrealtime(); run_phase<4>(F); if constexpr (PH_REPS[4] > 1) { GRID_BAR(); run_phase<4>(F); } if constexpr (PH_REPS[4] > 2) { GRID_BAR(); run_phase<4>(F); } if (BOTH(4)) GRID_BAR(); if constexpr (4 == TPA) tpa = __builtin_amdgcn_s_memrealtime() - tp0; if constexpr (4 == TPB) tpb = __builtin_amdgcn_s_memrealtime() - tp0; }
    if (IN(5)) { if constexpr (5 == TPA || 5 == TPB) tp0 = __builtin_amdgcn_s_memrealtime(); run_phase<5>(F); if constexpr (PH_REPS[5] > 1) { GRID_BAR(); run_phase<5>(F); } if constexpr (PH_REPS[5] > 2) { GRID_BAR(); run_phase<5>(F); } if (BOTH(5)) GRID_BAR(); if constexpr (5 == TPA) tpa = __builtin_amdgcn_s_memrealtime() - tp0; if constexpr (5 == TPB) tpb = __builtin_amdgcn_s_memrealtime() - tp0; }
    if (IN(6)) { if constexpr (6 == TPA || 6 == TPB) tp0 = __builtin_amdgcn_s_memrealtime(); run_phase<6>(F); if constexpr (PH_REPS[6] > 1) { GRID_BAR(); run_phase<6>(F); } if constexpr (PH_REPS[6] > 2) { GRID_BAR(); run_phase<6>(F); } if (BOTH(6)) GRID_BAR(); if constexpr (6 == TPA) tpa = __builtin_amdgcn_s_memrealtime() - tp0; if constexpr (6 == TPB) tpb = __builtin_amdgcn_s_memrealtime() - tp0; }
    if (IN(7)) { if constexpr (7 == TPA || 7 == TPB) tp0 = __builtin_amdgcn_s_memrealtime(); run_phase<7>(F); if constexpr (PH_REPS[7] > 1) { GRID_BAR(); run_phase<7>(F); } if constexpr (PH_REPS[7] > 2) { GRID_BAR(); run_phase<7>(F); } if (BOTH(7)) GRID_BAR(); if constexpr (7 == TPA) tpa = __builtin_amdgcn_s_memrealtime() - tp0; if constexpr (7 == TPB) tpb = __builtin_amdgcn_s_memrealtime() - tp0; }
    if (IN(8)) { if constexpr (8 == TPA || 8 == TPB) tp0 = __builtin_amdgcn_s_memrealtime(); run_phase<8>(F); if constexpr (PH_REPS[8] > 1) { GRID_BAR(); run_phase<8>(F); } if constexpr (PH_REPS[8] > 2) { GRID_BAR(); run_phase<8>(F); } if (BOTH(8)) GRID_BAR(); if constexpr (8 == TPA) tpa = __builtin_amdgcn_s_memrealtime() - tp0; if constexpr (8 == TPB) tpb = __builtin_amdgcn_s_memrealtime() - tp0; }
    if (IN(9)) { if constexpr (9 == TPA || 9 == TPB) tp0 = __builtin_amdgcn_s_memrealtime(); run_phase<9>(F); if constexpr (PH_REPS[9] > 1) { GRID_BAR(); run_phase<9>(F); } if constexpr (PH_REPS[9] > 2) { GRID_BAR(); run_phase<9>(F); } if (BOTH(9)) GRID_BAR(); if constexpr (9 == TPA) tpa = __builtin_amdgcn_s_memrealtime() - tp0; if constexpr (9 == TPB) tpb = __builtin_amdgcn_s_memrealtime() - tp0; }
    if (IN(10)) { if constexpr (10 == TPA || 10 == TPB) tp0 = __builtin_amdgcn_s_memrealtime(); run_phase<10>(F); if constexpr (PH_REPS[10] > 1) { GRID_BAR(); run_phase<10>(F); } if constexpr (PH_REPS[10] > 2) { GRID_BAR(); run_phase<10>(F); } if (BOTH(10)) GRID_BAR(); if constexpr (10 == TPA) tpa = __builtin_amdgcn_s_memrealtime() - tp0; if constexpr (10 == TPB) tpb = __builtin_amdgcn_s_memrealtime() - tp0; }
    if (IN(11)) { if constexpr (11 == TPA || 11 == TPB) tp0 = __builtin_amdgcn_s_memrealtime(); run_phase<11>(F); if constexpr (PH_REPS[11] > 1) { GRID_BAR(); run_phase<11>(F); } if constexpr (PH_REPS[11] > 2) { GRID_BAR(); run_phase<11>(F); } if (BOTH(11)) GRID_BAR(); if constexpr (11 == TPA) tpa = __builtin_amdgcn_s_memrealtime() - tp0; if constexpr (11 == TPB) tpb = __builtin_amdgcn_s_memrealtime() - tp0; }
    if (IN(12)) { if constexpr (12 == TPA || 12 == TPB) tp0 = __builtin_amdgcn_s_memrealtime(); run_phase<12>(F); if constexpr (PH_REPS[12] > 1) { GRID_BAR(); run_phase<12>(F); } if constexpr (PH_REPS[12] > 2) { GRID_BAR(); run_phase<12>(F); } if (BOTH(12)) GRID_BAR(); if constexpr (12 == TPA) tpa = __builtin_amdgcn_s_memrealtime() - tp0; if constexpr (12 == TPB) tpb = __builtin_amdgcn_s_memrealtime() - tp0; }
    if (IN(13)) { if constexpr (13 == TPA || 13 == TPB) tp0 = __builtin_amdgcn_s_memrealtime(); run_phase<13>(F); if constexpr (PH_REPS[13] > 1) { GRID_BAR(); run_phase<13>(F); } if constexpr (PH_REPS[13] > 2) { GRID_BAR(); run_phase<13>(F); } if (BOTH(13)) GRID_BAR(); if constexpr (13 == TPA) tpa = __builtin_amdgcn_s_memrealtime() - tp0; if constexpr (13 == TPB) tpb = __builtin_amdgcn_s_memrealtime() - tp0; }
    if constexpr (TPA >= 0 || TPB >= 0) {
        if (blockIdx.x == 0 && F.wave == 0) { const unsigned long long ua = (tpa + 500ull) / 1000ull, ub = (tpb + 500ull) / 1000ull, extra = ua * 100000ull + ub * 1000ull, t1 = __builtin_amdgcn_s_memrealtime();
            while (__builtin_amdgcn_s_memrealtime() - t1 < extra) __builtin_amdgcn_s_sleep(16); }
    }
#undef IN
#undef BOTH
}

extern "C" void kernel_launch(void* const* d_in, const int* in_sizes, int n_in, void* d_out, int out_size, void* d_ws, size_t ws_size, hipStream_t stream) {
    static int grid = 0;
    if (grid == 0) {
        if (n_in != 26 || out_size != T * D || ws_size < WS_END) { fprintf(stderr, "kernel_launch: unexpected shapes: n_in %d out %d ws %zu (need %zu)\n", n_in, out_size, ws_size, (size_t)WS_END); grid = -1; return; }
        int dev = 0, cus = 0, per_cu = 0;
        if (hipGetDevice(&dev) != hipSuccess || hipDeviceGetAttribute(&cus, hipDeviceAttributeMultiprocessorCount, dev) != hipSuccess) { grid = -1; return; }
        if (hipFuncSetAttribute((const void*)mk_fwd, hipFuncAttributeMaxDynamicSharedMemorySize, LDS_BYTES) != hipSuccess) { fprintf(stderr, "kernel_launch: hipFuncSetAttribute failed\n"); grid = -1; return; }
        if (hipOccupancyMaxActiveBlocksPerMultiprocessor(&per_cu, (const void*)mk_fwd, NWAVES * 64, LDS_BYTES) != hipSuccess || per_cu < 1)
            fprintf(stderr, "kernel_launch: note: occupancy query reports %d workgroups per CU\n", per_cu);
        (void)hipGetLastError();
        grid = cus;
    }
    if (grid < 0) return;
    if (hipMemsetAsync((char*)d_ws + WS_CTL, 0, CTL_ZERO_BYTES, stream) != hipSuccess) return;
    Args a{};
    for (int i = 0; i < 26; ++i) a.in[i] = (const float*)d_in[i];
    a.out = (float*)d_out; a.ws = (unsigned char*)d_ws;
    for (int li = 0; li < N_LAUNCHES; ++li) {
        if (N_LAUNCHES == 1) { a.ph_lo = 0; a.ph_hi = N_PHASES; } else { a.ph_lo = li * N_PHASES / N_LAUNCHES; a.ph_hi = (li + 1) * N_PHASES / N_LAUNCHES; }
        a.li = li;
        hipLaunchKernelGGL(mk_fwd, dim3(grid), dim3(NWAVES * 64), LDS_BYTES, stream, a);
        if (hipPeekAtLastError() != hipSuccess) break;
    }
}
```

```cpp
#include <hip/hip_runtime.h>
#include <cstdio>
#include <cstdint>
namespace pg8 {
#define PG8_LAS __attribute__((address_space(3)))
typedef unsigned short bf16_t;
typedef short bf16x8 __attribute__((ext_vector_type(8)));
typedef float f32x4 __attribute__((ext_vector_type(4)));
typedef unsigned u32x4 __attribute__((ext_vector_type(4)));
constexpr int BM = 256, BK = 64, HALF = 128, HTB = HALF * BK * 2  , STAGE_BYTES = 8 * HTB, NXCD = 8, WGM = 16;

__host__ __device__ __forceinline__ int lds_byte(int r, int c) { const int st = (r >> 4) * 2 + (c >> 5), rr = r & 15, cc = c & 31, ob = rr * 64 + cc * 2; return st * 1024 + (ob ^ (((ob >> 9) & 1) << 5)); }
__host__ __device__ __forceinline__ void stage_rc(int b, int& R, int& C) { const int st = b / 1024, sb = b % 1024, swz = sb ^ (((sb >> 9) & 1) << 5); R = (st >> 1) * 16 + swz / 64; C = (st & 1) * 32 + (swz % 64) / 2; }
__host__ __device__ __forceinline__ int perm32(int rho) { const int n = rho >> 4, i = rho & 15; return 8 * (i >> 2) + 4 * n + (i & 3); }

__device__ __forceinline__ int mk_lane() { int l; asm volatile("v_mbcnt_lo_u32_b32 %0, -1, 0\n\tv_mbcnt_hi_u32_b32 %0, -1, %0" : "=v"(l)); return l; }
struct Unit { int pm, pn; };
struct Gemm { const bf16_t* A; const bf16_t* Bt; int M, N, K; };

struct StaticOrder {
    int nM, nN, nwg, G, c;
    __host__ __device__ void init(int M, int N, int G_, int c_) { nM = M / BM; nN = N / BM; nwg = nM * nN; G = G_; c = c_; }
    __host__ __device__ bool next(int i, Unit& u) const {
        const long L = (long)i * G + c; if (L >= nwg) return false;
        int wgid = (int)L; { const int q = nwg / NXCD, r = nwg % NXCD, xcd = wgid % NXCD, off = wgid / NXCD; wgid = (xcd < r ? xcd * (q + 1) : r * (q + 1) + (xcd - r) * q) + off; }
        const int nig = WGM * nN, gid = wgid / nig, fm = gid * WGM, gsz = (nM - fm) < WGM ? (nM - fm) : WGM;
        u.pm = fm + ((wgid % nig) % gsz); u.pn = (wgid % nig) / gsz; return true;
    }
    __device__ __forceinline__ void a_ready(const Unit&) const {}
    __device__ __forceinline__ void done(const Unit&) const {}
};

__device__ __forceinline__ unsigned cvt_pk_bf16(float lo, float hi) { unsigned r; asm volatile("v_cvt_pk_bf16_f32 %0, %1, %2" : "=v"(r) : "v"(lo), "v"(hi)); return r; }
typedef float f32x2 __attribute__((ext_vector_type(2)));
__device__ __forceinline__ f32x2 gelu_pk(f32x2 v) {
    const f32x2 av = __builtin_elementwise_abs(v), d = av * 0.2316418882f + 1.0f;
    f32x2 t; t.x = __builtin_amdgcn_rcpf(d.x); t.y = __builtin_amdgcn_rcpf(d.y);
    f32x2 q = t * 0.5307027145f + (-0.7265760135f); q = q * t + 0.7107068705f; q = q * t + (-0.142248368f); q = q * t + 0.127414796f; q = q * t;
    const f32x2 s = (v * v) * (-0.72134752044f);
    f32x2 e; e.x = __builtin_amdgcn_exp2f(s.x); e.y = __builtin_amdgcn_exp2f(s.y);
    const f32x2 m = v * (q * e), r = v - m;
    f32x2 o; o.x = v.x < 0.f ? m.x : r.x; o.y = v.y < 0.f ? m.y : r.y; return o;
}

template <int ACT  > struct EpiBf16 {
    static constexpr bool PERM = true, AFTER_DRAIN = false; static_assert(ACT == 0 || ACT == 1, "EpiBf16: ACT is 0 (none) or 1 (gelu_pk)");
    bf16_t* O; int ldc; const float* bias; int split_cols; size_t split_stride; float scale0;
    __device__ __forceinline__ void operator()(const f32x4 (&acc)[2][2][4][2], const Unit& u, int wr, int wc, int fr, int fq) const {
        const int row0 = u.pm * BM + wr * 64 + fr; int colt = u.pn * BM; bf16_t* base = O;
        float sc = 1.f; if (split_cols) { const int t = colt / split_cols; base += (size_t)t * split_stride; colt -= t * split_cols; if (t == 0) sc = scale0; }
        const int col0 = colt + wc * 32 + 8 * fq, bcol0 = u.pn * BM + wc * 32 + 8 * fq;
        f32x4 bv[2][2];
#pragma unroll
        for (int bj = 0; bj < 2; ++bj)
#pragma unroll
            for (int n = 0; n < 2; ++n) bv[bj][n] = bias ? *(const f32x4*)(bias + bcol0 + bj * HALF + 4 * n) : (f32x4){0.f, 0.f, 0.f, 0.f};
#pragma unroll
        for (int ai = 0; ai < 2; ++ai)
#pragma unroll
            for (int m = 0; m < 4; ++m) { bf16_t* rowp = base + (size_t)(row0 + ai * HALF + m * 16) * ldc + col0;
#pragma unroll
                for (int bj = 0; bj < 2; ++bj) { f32x4 v0 = acc[ai][bj][m][0] + bv[bj][0], v1 = acc[ai][bj][m][1] + bv[bj][1];
                    if (ACT == 1) { f32x2 a = gelu_pk((f32x2){v0[0], v0[1]}), b = gelu_pk((f32x2){v0[2], v0[3]}), c = gelu_pk((f32x2){v1[0], v1[1]}), d = gelu_pk((f32x2){v1[2], v1[3]});
                        v0 = (f32x4){a.x, a.y, b.x, b.y}; v1 = (f32x4){c.x, c.y, d.x, d.y}; }
                    v0 = v0 * sc; v1 = v1 * sc; u32x4 w; w.x = cvt_pk_bf16(v0[0], v0[1]); w.y = cvt_pk_bf16(v0[2], v0[3]); w.z = cvt_pk_bf16(v1[0], v1[1]); w.w = cvt_pk_bf16(v1[2], v1[3]);
                    *(u32x4*)(rowp + bj * HALF) = w; } }
    }
};
__device__ __forceinline__ float sigmoidf_(float x) { return __builtin_amdgcn_rcpf(1.0f + __expf(-x)); }
struct EpiResid {
    static constexpr bool PERM = false, AFTER_DRAIN = false;
    const float* base; float* out; int ldc; const float* gvec;
    __device__ __forceinline__ void operator()(const f32x4 (&acc)[2][2][4][2], const Unit& u, int wr, int wc, int fr, int fq) const {
        const int row0 = u.pm * BM + wr * 64 + fr, col0 = u.pn * BM + wc * 32 + 4 * fq;
        f32x4 gv[2][2];
#pragma unroll
        for (int bj = 0; bj < 2; ++bj)
#pragma unroll
            for (int n = 0; n < 2; ++n) gv[bj][n] = *(const __attribute__((address_space(1))) f32x4*)(gvec + col0 + bj * HALF + n * 16);
#pragma unroll
        for (int ai = 0; ai < 2; ++ai)
#pragma unroll
            for (int m = 0; m < 4; ++m) { const size_t off = (size_t)(row0 + ai * HALF + m * 16) * ldc + col0;
#pragma unroll
                for (int bj = 0; bj < 2; ++bj)
#pragma unroll
                    for (int n = 0; n < 2; ++n) { const f32x4 bs = *(const __attribute__((address_space(1))) f32x4*)(base + off + bj * HALF + n * 16);
                        *(__attribute__((address_space(1))) f32x4*)(out + off + bj * HALF + n * 16) = bs + gv[bj][n] * acc[ai][bj][m][n]; }
                if (m & 1) asm volatile("" ::: "memory"); }
    }
};
struct EpiSwiglu {
    static constexpr bool PERM = true, AFTER_DRAIN = false;
    bf16_t* O; int ldc;
    __device__ __forceinline__ void operator()(const f32x4 (&acc)[2][2][4][2], const Unit& u, int wr, int wc, int fr, int fq) const {
        const int row0 = u.pm * BM + wr * 64 + fr, col0 = u.pn * HALF + wc * 32 + 8 * fq;
#pragma unroll
        for (int ai = 0; ai < 2; ++ai)
#pragma unroll
            for (int m = 0; m < 4; ++m) { bf16_t* rowp = O + (size_t)(row0 + ai * HALF + m * 16) * ldc + col0;
                f32x4 h0, h1;
#pragma unroll
                for (int j = 0; j < 4; ++j) { const float g0 = acc[ai][0][m][0][j], g1 = acc[ai][0][m][1][j];
                    h0[j] = g0 * sigmoidf_(g0) * acc[ai][1][m][0][j]; h1[j] = g1 * sigmoidf_(g1) * acc[ai][1][m][1][j]; }
                u32x4 w; w.x = cvt_pk_bf16(h0[0], h0[1]); w.y = cvt_pk_bf16(h0[2], h0[3]); w.z = cvt_pk_bf16(h1[0], h1[1]); w.w = cvt_pk_bf16(h1[2], h1[3]);
                *(__attribute__((address_space(1))) u32x4*)rowp = w; }
    }
};
template <int CTRL> __device__ __forceinline__ float dpp_f(float old, float src) { return __builtin_bit_cast(float, __builtin_amdgcn_update_dpp(__builtin_bit_cast(int, old), __builtin_bit_cast(int, src), CTRL, 0xf, 0xf, false)); }
struct EpiLora {
    static constexpr bool PERM = true, AFTER_DRAIN = false;
    unsigned char* PKB; bf16_t* KD; const bf16_t* kbuf; const bf16_t* kkbuf; const bf16_t* rbuf; const float* w0; const float* a0; const float* k_a; int TT;
    __device__ __forceinline__ void operator()(const f32x4 (&acc)[2][2][4][2], const Unit& u, int wr, int wc, int fr, int fq) const {
        typedef __attribute__((address_space(1))) f32x4 gf4; typedef const __attribute__((address_space(1))) f32x4 cgf4;
        const int d = u.pn >> 4, cg = u.pn & 15;
        const int c8 = cg * HALF + wc * 32 + 8 * fq, h = c8 >> 6, ch = c8 & 63;
        const int row0 = u.pm * BM + wr * 64 + fr;
        f32x4 w0v[2], a0v[2], kav[2];
#pragma unroll
        for (int n = 0; n < 2; ++n) { w0v[n] = *(cgf4*)(w0 + d * 2048 + c8 + 4 * n); a0v[n] = *(cgf4*)(a0 + d * 2048 + c8 + 4 * n); kav[n] = *(cgf4*)(k_a + c8 + 4 * n); }
        typedef unsigned u32x2l __attribute__((ext_vector_type(2))); typedef const __attribute__((address_space(1))) u32x2l cgu2;
        u32x2l kq[2][2], kkq[2][2], rq[2][2];
        { const size_t fo0 = (size_t)row0 * 2048 + c8;
#pragma unroll
          for (int n = 0; n < 2; ++n) { kq[0][n] = *(cgu2*)(kbuf + fo0 + 4 * n); kkq[0][n] = *(cgu2*)(kkbuf + fo0 + 4 * n); rq[0][n] = *(cgu2*)(rbuf + fo0 + 4 * n); } }
#pragma unroll
        for (int it = 0; it < 8; ++it) {
            const int ai = it >> 2, m = it & 3;
            if (it + 1 < 8) { const size_t fo1 = (size_t)(row0 + ((it + 1) >> 2) * HALF + ((it + 1) & 3) * 16) * 2048 + c8;
#pragma unroll
                for (int n = 0; n < 2; ++n) { kq[(it + 1) & 1][n] = *(cgu2*)(kbuf + fo1 + 4 * n); kkq[(it + 1) & 1][n] = *(cgu2*)(kkbuf + fo1 + 4 * n); rq[(it + 1) & 1][n] = *(cgu2*)(rbuf + fo1 + 4 * n); } }
            asm volatile("" ::: "memory");
            const int tok = row0 + ai * HALF + m * 16;
            const int tau = d == 0 ? (tok & 15) : 15 - (tok & 15);
            unsigned char* rec = PKB + ((size_t)(d * 32 + h) * (TT / 16) + (tok >> 4)) * 8448;
            const size_t fo = (size_t)tok * 2048 + c8;
            f32x4 g[2]; u32x4 kw;
#pragma unroll
            for (int n = 0; n < 2; ++n) {
                f32x4 gp;
                const f32x4 x = acc[ai][0][m][n] + w0v[n];
#pragma unroll
                for (int j = 0; j < 4; ++j) { float w = __expf(-0.60653066f * sigmoidf_(x[j]));
                    if (d == 0) { w *= dpp_f<0x111>(1.0f, w); w *= dpp_f<0x112>(1.0f, w); w *= dpp_f<0x114>(1.0f, w); w *= dpp_f<0x118>(1.0f, w); g[n][j] = w; gp[j] = dpp_f<0x111>(1.0f, w); }
                    else        { w *= dpp_f<0x101>(1.0f, w); w *= dpp_f<0x102>(1.0f, w); w *= dpp_f<0x104>(1.0f, w); w *= dpp_f<0x108>(1.0f, w); g[n][j] = w; gp[j] = dpp_f<0x101>(1.0f, w); } }
                const f32x4 xa = acc[ai][1][m][n] + a0v[n];
                f32x4 k4, kk4, r4;
                { const u32x2l a_ = kq[it & 1][n], b_ = kkq[it & 1][n], c_ = rq[it & 1][n];
                  k4[0] = __builtin_bit_cast(float, a_.x << 16); k4[1] = __builtin_bit_cast(float, a_.x & 0xffff0000u); k4[2] = __builtin_bit_cast(float, a_.y << 16); k4[3] = __builtin_bit_cast(float, a_.y & 0xffff0000u);
                  kk4[0] = __builtin_bit_cast(float, b_.x << 16); kk4[1] = __builtin_bit_cast(float, b_.x & 0xffff0000u); kk4[2] = __builtin_bit_cast(float, b_.y << 16); kk4[3] = __builtin_bit_cast(float, b_.y & 0xffff0000u);
                  r4[0] = __builtin_bit_cast(float, c_.x << 16); r4[1] = __builtin_bit_cast(float, c_.x & 0xffff0000u); r4[2] = __builtin_bit_cast(float, c_.y << 16); r4[3] = __builtin_bit_cast(float, c_.y & 0xffff0000u); }
                f32x4 at, rt, bt, kdt; float kdv[4];
#pragma unroll
                for (int j = 0; j < 4; ++j) { const float a = sigmoidf_(xa[j]), rg = __builtin_amdgcn_rcpf(g[n][j]);
                    kdv[j] = k4[j] * (1.0f + (a - 1.0f) * kav[n][j]);
                    at[j] = -kk4[j] * gp[j]; rt[j] = r4[j] * g[n][j]; bt[j] = kk4[j] * a * rg; kdt[j] = kdv[j] * rg; }
                const int chn = ch + 4 * n;
                {
                    const int p0 = ((((chn >> 5) * 2 + ((chn >> 4) & 1)) * 2 + n) * 8 + ((chn >> 3) & 1) * 4);
                    typedef unsigned u32x2 __attribute__((ext_vector_type(2)));
                    __attribute__((address_space(1))) unsigned char* rp = (__attribute__((address_space(1))) unsigned char*)rec + (tau * 64 + p0) * 2;
                    u32x2 w;
                    w.x = cvt_pk_bf16(at[0], at[1]); w.y = cvt_pk_bf16(at[2], at[3]); *(__attribute__((address_space(1))) u32x2*)(rp) = w;
                    w.x = cvt_pk_bf16(rt[0], rt[1]); w.y = cvt_pk_bf16(rt[2], rt[3]); *(__attribute__((address_space(1))) u32x2*)(rp + 2048) = w;
                    w.x = cvt_pk_bf16(bt[0], bt[1]); w.y = cvt_pk_bf16(bt[2], bt[3]); *(__attribute__((address_space(1))) u32x2*)(rp + 4096) = w;
                    w.x = cvt_pk_bf16(kdt[0], kdt[1]); w.y = cvt_pk_bf16(kdt[2], kdt[3]); *(__attribute__((address_space(1))) u32x2*)(rp + 6144) = w; }
                if (n == 0) { kw.x = cvt_pk_bf16(kdv[0], kdv[1]); kw.y = cvt_pk_bf16(kdv[2], kdv[3]); } else { kw.z = cvt_pk_bf16(kdv[0], kdv[1]); kw.w = cvt_pk_bf16(kdv[2], kdv[3]); }
            }
            *(__attribute__((address_space(1))) u32x4*)(KD + (size_t)d * TT * 2048 + fo) = kw;
            if (fr == (d == 0 ? 15 : 0)) { float* ge = (float*)(rec + 8192) + ch; *(gf4*)ge = g[0]; *(gf4*)(ge + 4) = g[1]; }
        }
    }
};
template <class Epi, class Sched, bool ALIGN_EPI = false, bool SP2 = false>
__device__ __forceinline__ void gemm_phase(PG8_LAS unsigned char* lds, const Gemm g, const Sched& S, const Epi& E, const int wid) {
    const int lane = mk_lane(), tid = wid * 64 + lane, wr = wid >> 2, wc = wid & 3, fr = lane & 15, fq = lane >> 4;
    const int K = g.K, nt = K / BK;
    unsigned voffA[2], voffB[2];
#pragma unroll
    for (int i = 0; i < 2; ++i) { int R, C; stage_rc(tid * 16 + i * 8192, R, C); const int Rb = Epi::PERM ? ((R & ~31) + perm32(R & 31)) : R;
        voffA[i] = (unsigned)(R * K + C) * 2u; voffB[i] = (unsigned)(Rb * K + C) * 2u; }
    const size_t kstep = (size_t)(BK * 2);
    const size_t hstep = (size_t)HALF * K * 2;
    const size_t tstep = 2 * hstep;
    const unsigned ldsw = (unsigned)wid * 1024u;
    const int aoff = lds_byte(wr * 64 + fr, fq * 8), boff = lds_byte(wc * 32 + fr, fq * 8);
#define PG8_SA(b, h) (((b) * 2 + (h)) * HTB)
#define PG8_SB(b, h) ((4 + (b) * 2 + (h)) * HTB)
#define PG8_STAGE(bufoff, gbase, voff) do { _Pragma("unroll") for (int _i = 0; _i < 2; ++_i) \
        __builtin_amdgcn_global_load_lds((const unsigned*)((const char*)(gbase) + (voff)[_i]), (PG8_LAS unsigned*)(lds + (bufoff) + ldsw + _i * 8192), 16, 0, 0); } while (0)
#define PG8_LDA(dst, b, h) do { _Pragma("unroll") for (int m = 0; m < 4; ++m) _Pragma("unroll") for (int k = 0; k < 2; ++k) dst[m][k] = *(const PG8_LAS bf16x8*)(lds + PG8_SA(b, h) + aoff + m * 2048 + k * 1024); } while (0)
#define PG8_LDB(dst, b, h) do { _Pragma("unroll") for (int n = 0; n < 2; ++n) _Pragma("unroll") for (int k = 0; k < 2; ++k) dst[n][k] = *(const PG8_LAS bf16x8*)(lds + PG8_SB(b, h) + boff + n * 2048 + k * 1024); } while (0)
#define PG8_MMA(ai, bj, At, Bt) do { __builtin_amdgcn_s_setprio(1); _Pragma("unroll") for (int m = 0; m < 4; ++m) _Pragma("unroll") for (int n = 0; n < 2; ++n) _Pragma("unroll") for (int k = 0; k < 2; ++k) \
        acc[ai][bj][m][n] = __builtin_amdgcn_mfma_f32_16x16x32_bf16(Bt[n][k], At[m][k], acc[ai][bj][m][n], 0, 0, 0); __builtin_amdgcn_s_setprio(0); } while (0)
#define PG8_WAIT_V(n) asm volatile("s_waitcnt vmcnt(" #n ")" ::: "memory")
#define PG8_WAIT_L(n) asm volatile("s_waitcnt lgkmcnt(" #n ")" ::: "memory")
#define PG8_BAR __builtin_amdgcn_s_barrier()
#define PG8_SCHED __builtin_amdgcn_sched_barrier(0)
    Unit cur, nxt; int ui = 0;
    if (!S.next(0, cur)) return;
    f32x4 acc[2][2][4][2];
#pragma unroll
    for (int a = 0; a < 2; ++a)
#pragma unroll
        for (int b = 0; b < 2; ++b)
#pragma unroll
            for (int m = 0; m < 4; ++m)
#pragma unroll
                for (int n = 0; n < 2; ++n) acc[a][b][m][n] = (f32x4){0.f, 0.f, 0.f, 0.f};
    bf16x8 At[4][2], B0[2][2], B1[2][2];
    const char* cA = (const char*)g.A + (size_t)cur.pm * tstep; const char* cB = (const char*)g.Bt + (size_t)cur.pn * tstep;
    S.a_ready(cur);
    if constexpr (SP2) {
        PG8_STAGE(PG8_SB(0, 0), cB, voffB); PG8_STAGE(PG8_SB(0, 1), cB + hstep, voffB); PG8_STAGE(PG8_SA(0, 0), cA, voffA); PG8_STAGE(PG8_SA(0, 1), cA + hstep, voffA);
        if (wr == 1) PG8_BAR;
        PG8_WAIT_V(2); PG8_BAR;
        PG8_STAGE(PG8_SB(1, 0), cB + kstep, voffB); PG8_STAGE(PG8_SA(1, 0), cA + kstep, voffA); PG8_STAGE(PG8_SB(1, 1), cB + hstep + kstep, voffB);
        PG8_WAIT_V(6); PG8_BAR;
    } else {
        PG8_STAGE(PG8_SB(0, 0), cB, voffB); PG8_STAGE(PG8_SA(0, 0), cA, voffA); PG8_STAGE(PG8_SB(0, 1), cB + hstep, voffB); PG8_STAGE(PG8_SA(0, 1), cA + hstep, voffA);
        if (wr == 1) PG8_BAR;
        PG8_WAIT_V(4); PG8_BAR;
        PG8_STAGE(PG8_SB(1, 0), cB + kstep, voffB); PG8_STAGE(PG8_SA(1, 0), cA + kstep, voffA); PG8_STAGE(PG8_SB(1, 1), cB + hstep + kstep, voffB);
        PG8_WAIT_V(6); PG8_BAR;
    }
    for (;;) {
        const bool has_next = S.next(ui + 1, nxt);
        const char* nA = has_next ? (const char*)g.A + (size_t)nxt.pm * tstep : cA; const char* nB = has_next ? (const char*)g.Bt + (size_t)nxt.pn * tstep : cB;
        for (int t = 0; t < nt; t += 2) {
            const bool last = (t == nt - 2);
            const char* a1 = cA + (size_t)(t + 1) * kstep;
            const char* a2 = last ? nA : cA + (size_t)(t + 2) * kstep; const char* b2 = last ? nB : cB + (size_t)(t + 2) * kstep;
            const char* a3 = a2 + kstep; const char* b3 = b2 + kstep;
            if (last && has_next) S.a_ready(nxt);
            if constexpr (SP2) {
            PG8_LDB(B0, 0, 0); PG8_LDB(B1, 0, 1); PG8_SCHED; PG8_LDA(At, 0, 0); PG8_STAGE(PG8_SA(1, 1), a1 + hstep, voffA);
            PG8_WAIT_V(8); PG8_WAIT_L(0); PG8_BAR; PG8_MMA(0, 0, At, B0); PG8_MMA(0, 1, At, B1); PG8_BAR; PG8_SCHED;
            PG8_LDA(At, 0, 1); PG8_STAGE(PG8_SB(0, 0), b2, voffB); PG8_STAGE(PG8_SB(0, 1), b2 + hstep, voffB); PG8_STAGE(PG8_SA(0, 0), a2, voffA);
            PG8_WAIT_V(8); PG8_WAIT_L(0); PG8_BAR; PG8_MMA(1, 0, At, B0); PG8_MMA(1, 1, At, B1); PG8_BAR; PG8_SCHED;
            PG8_LDB(B0, 1, 0); PG8_LDB(B1, 1, 1); PG8_SCHED; PG8_LDA(At, 1, 0); PG8_STAGE(PG8_SA(0, 1), a2 + hstep, voffA);
            PG8_WAIT_V(8); PG8_WAIT_L(0); PG8_BAR; PG8_MMA(0, 0, At, B0); PG8_MMA(0, 1, At, B1); PG8_BAR; PG8_SCHED;
            PG8_LDA(At, 1, 1); PG8_STAGE(PG8_SB(1, 0), b3, voffB); PG8_STAGE(PG8_SB(1, 1), b3 + hstep, voffB); PG8_STAGE(PG8_SA(1, 0), a3, voffA);
            PG8_WAIT_V(8); PG8_WAIT_L(0); PG8_BAR; PG8_MMA(1, 0, At, B0); PG8_MMA(1, 1, At, B1); PG8_BAR; PG8_SCHED;
            } else {
            PG8_LDB(B0, 0, 0); PG8_SCHED; PG8_LDA(At, 0, 0); PG8_STAGE(PG8_SA(1, 1), a1 + hstep, voffA);
            PG8_WAIT_L(8); PG8_BAR; PG8_WAIT_L(0); PG8_MMA(0, 0, At, B0); PG8_BAR; PG8_SCHED;
            PG8_LDB(B1, 0, 1); PG8_STAGE(PG8_SB(0, 0), b2, voffB);
            PG8_BAR; PG8_WAIT_L(0); PG8_MMA(0, 1, At, B1); PG8_BAR;
            PG8_LDA(At, 0, 1); PG8_STAGE(PG8_SA(0, 0), a2, voffA);
            PG8_BAR; PG8_WAIT_L(0); PG8_MMA(1, 0, At, B0); PG8_BAR; PG8_SCHED;
            PG8_STAGE(PG8_SB(0, 1), b2 + hstep, voffB);
            PG8_WAIT_V(6); PG8_BAR; PG8_MMA(1, 1, At, B1); PG8_BAR;
            PG8_LDB(B0, 1, 0); PG8_SCHED; PG8_LDA(At, 1, 0); PG8_STAGE(PG8_SA(0, 1), a2 + hstep, voffA);
            PG8_WAIT_L(8); PG8_BAR; PG8_WAIT_L(0); PG8_MMA(0, 0, At, B0); PG8_BAR; PG8_SCHED;
            PG8_LDB(B1, 1, 1); PG8_STAGE(PG8_SB(1, 0), b3, voffB);
            PG8_BAR; PG8_WAIT_L(0); PG8_MMA(0, 1, At, B1); PG8_BAR;
            PG8_LDA(At, 1, 1); PG8_STAGE(PG8_SA(1, 0), a3, voffA);
            PG8_BAR; PG8_WAIT_L(0); PG8_MMA(1, 0, At, B0); PG8_BAR; PG8_SCHED;
            PG8_STAGE(PG8_SB(1, 1), b3 + hstep, voffB);
            PG8_WAIT_V(6); PG8_BAR; PG8_MMA(1, 1, At, B1); PG8_BAR;
            }
        }
        if constexpr (ALIGN_EPI) { if (wr == 0) PG8_BAR; }
        if constexpr (!Epi::AFTER_DRAIN) { const int l2 = mk_lane(); E(acc, cur, wr, wc, l2 & 15, l2 >> 4); S.done(cur); }
        if (!has_next) break;
#pragma unroll
        for (int a = 0; a < 2; ++a)
#pragma unroll
            for (int b = 0; b < 2; ++b)
#pragma unroll
                for (int m = 0; m < 4; ++m)
#pragma unroll
                    for (int n = 0; n < 2; ++n) acc[a][b][m][n] = (f32x4){0.f, 0.f, 0.f, 0.f};
        cur = nxt; cA = nA; cB = nB; ++ui;
        if constexpr (ALIGN_EPI) { if (wr == 1) PG8_BAR; }
    }
    PG8_WAIT_V(0);
    if constexpr (!ALIGN_EPI) { if (wr == 0) PG8_BAR; }
    PG8_BAR;
    if constexpr (Epi::AFTER_DRAIN) { E.fused(acc, cur, wr, wc, fr, fq, lds, wid, lane); S.done(cur); }
#undef PG8_SA
#undef PG8_SB
#undef PG8_STAGE
#undef PG8_LDA
#undef PG8_LDB
#undef PG8_MMA
#undef PG8_WAIT_V
#undef PG8_WAIT_L
#undef PG8_BAR
#undef PG8_SCHED
}
}

constexpr int NWAVES = 8;
#ifndef MK_N_LAUNCHES
#define MK_N_LAUNCHES 1
#endif
constexpr int N_PHASES = 14;
#ifndef MK_REPS
#define MK_REPS {1,1,1,1,1,1,1,1,1,1,1,1,1,1}
#endif
constexpr int PH_REPS[14] = MK_REPS;
#ifndef MK_TPA
#define MK_TPA -1
#endif
#ifndef MK_TPB
#define MK_TPB -1
#endif
constexpr int TPA = MK_TPA, TPB = MK_TPB;
constexpr int N_LAUNCHES = MK_N_LAUNCHES;

constexpr int D = 4096, T = 8192, CTXL = 256, TT = T + CTXL;
constexpr int DR = 2048, DC = 2048, NH = 32, HS = 64;
constexpr int OFF_K = 0, OFF_V = 2048, OFF_WL = 4096, OFF_AL = 4192, OFF_R = 4288, OFF_GL = 6336, RWKV_COLS = 6592;
constexpr int OFF_CB = 6592, OFF_CC = 8640, OFF_CX = 10688, IN_COLS = 12736, NZ = 12800;
constexpr int NCTXZ = 4352;
constexpr int DFF = 11008, NGU = 2 * DFF;
constexpr int NLORA = 8192, KLORA = 256, KGATE = 256;
constexpr int MODN = 6 * D;
constexpr int NKC = 16;
constexpr float NORM_EPS = 1e-6f, LNX_EPS = 64e-5f;
constexpr int CHUNK = 256, NCHUNK = 33;

constexpr size_t MiB = 1u << 20;
constexpr size_t WS_CTL = 0, CTL_ZERO_BYTES = 32768;
constexpr size_t WS_MODP = 1 * MiB;
constexpr size_t WS_MODV = 5 * MiB;
constexpr size_t WS_WLORA = 6 * MiB;
constexpr size_t WS_WGATE = 10 * MiB;
constexpr size_t WS_ALORA = 11 * MiB;
constexpr size_t WS_AGATE = 16 * MiB;
constexpr size_t WS_WOUT = 20 * MiB;
constexpr size_t WS_WGU = 52 * MiB;
constexpr size_t WS_WDN = 224 * MiB;
constexpr size_t WS_WIN = 310 * MiB;
constexpr size_t WS_PU = 310 * MiB;
constexpr size_t WS_SST = 374 * MiB;
constexpr size_t WS_A1 = 410 * MiB;
constexpr size_t WS_CAT = 410 * MiB;
constexpr size_t WS_Z = 476 * MiB;
constexpr size_t WS_YS = 476 * MiB;
constexpr size_t WS_KD = 604 * MiB;
constexpr size_t WS_GE = 670 * MiB;
constexpr size_t WS_KBUF = 683 * MiB;
constexpr size_t WS_KKBUF = 749 * MiB;
constexpr size_t WS_RBUF = 815 * MiB;
constexpr size_t WS_VBUF = 881 * MiB;
constexpr size_t WS_X1 = 683 * MiB;
constexpr size_t WS_PK = 947 * MiB;
constexpr size_t WS_ACT = 947 * MiB;
constexpr size_t WS_G = 1475 * MiB;
constexpr size_t WS_END = 1507 * MiB;
static_assert(WS_MODP + (size_t)NKC * 2 * MODN * 4 <= WS_MODV && WS_ALORA + (size_t)TT * 256 * 2 <= WS_AGATE && WS_WGU + (size_t)NGU * D * 2 <= WS_WDN && WS_WDN + (size_t)D * DFF * 2 <= WS_WIN, "ws map 1");
static_assert(WS_WIN + (size_t)NZ * D * 2 <= WS_A1 && WS_SST + (size_t)64 * NCHUNK * 16384 <= WS_A1 && WS_A1 + (size_t)TT * D * 2 <= WS_Z && WS_Z + (size_t)TT * NZ * 2 <= WS_KBUF, "ws map 2");
static_assert(WS_YS + (size_t)2 * T * 2048 * 4 <= WS_KD && WS_KD + (size_t)2 * TT * 2048 * 2 <= WS_GE && WS_GE + (size_t)64 * (TT / 16) * 256 <= WS_KBUF, "ws map 3");
static_assert(WS_KBUF + (size_t)TT * 2048 * 4 <= WS_KKBUF && WS_KKBUF + (size_t)TT * 2048 * 4 <= WS_RBUF && WS_RBUF + (size_t)TT * 2048 * 4 <= WS_VBUF && WS_VBUF + (size_t)TT * 2048 * 4 <= WS_PK, "ws map 4");
static_assert(WS_X1 + (size_t)T * D * 4 <= WS_RBUF && WS_PK + (size_t)64 * TT * 1024 <= WS_G && WS_ACT + (size_t)T * DFF * 2 <= WS_G && WS_G + (size_t)T * 2048 * 2 <= WS_END && WS_CAT + (size_t)T * D * 2 <= WS_Z, "ws map 5");
constexpr int CW_TMO = 0;
constexpr int CW_BAR = 4096;

constexpr int RING_OFF = 0, RING_BYTES = 131072;
constexpr int LDSCTL_OFF = RING_BYTES, MISC_OFF = LDSCTL_OFF + 320;
constexpr int LDS_BYTES = 147456;
static_assert(MISC_OFF + 128 <= LDS_BYTES, "LDS map");

#define GAS __attribute__((address_space(1)))
#define LAS __attribute__((address_space(3)))
typedef unsigned short bf16;
typedef unsigned v4u __attribute__((ext_vector_type(4)));
typedef unsigned v2u __attribute__((ext_vector_type(2)));
typedef float f32x4 __attribute__((ext_vector_type(4)));
typedef GAS unsigned gu32;
#define RLX_AGENT __ATOMIC_RELAXED, __HIP_MEMORY_SCOPE_AGENT
#define LDS_WAIT() asm volatile("s_waitcnt lgkmcnt(0)" ::: "memory")
#define VM_WAIT() asm volatile("s_waitcnt vmcnt(0)" ::: "memory")
__device__ __forceinline__ unsigned f2bf(float f) { unsigned u = __builtin_bit_cast(unsigned, f); return (u + 0x7fffu + ((u >> 16) & 1u)) >> 16; }
__device__ __forceinline__ unsigned pk2(float lo, float hi) { return f2bf(lo) | (f2bf(hi) << 16); }
__device__ __forceinline__ float bflo(unsigned w) { return __builtin_bit_cast(float, w << 16); }
__device__ __forceinline__ float bfhi(unsigned w) { return __builtin_bit_cast(float, w & 0xffff0000u); }
__device__ __forceinline__ float sigm(float x) { return 1.0f / (1.0f + __expf(-x)); }

#define XB_TMO      128
#define XB_XCNT(j)  (256  + 64 * (j))
#define XB_XSUB(j)  (1280 + 64 * (j))
#define XB_XGEN(j)  (2304 + 64 * (j))
#define XB_TOP      3328
#define XB_TOPGEN   3392
#define XCD_BAR_WORDS 3456
#define XB_SPIN_CAP (1u << 18)
__device__ __forceinline__ unsigned xb_ld(unsigned* p)              { return __hip_atomic_load(p, __ATOMIC_RELAXED, __HIP_MEMORY_SCOPE_AGENT); }
__device__ __forceinline__ unsigned xb_add(unsigned* p, unsigned v) { return __hip_atomic_fetch_add(p, v, __ATOMIC_RELAXED, __HIP_MEMORY_SCOPE_AGENT); }
__device__ __forceinline__ unsigned xb_xcc_id() { return (unsigned)__builtin_amdgcn_s_getreg((3 << 11) | 20) & 0xFu; }
#define XB_SPIN(cond, bar) do { unsigned _sp = 0; while (cond) { __builtin_amdgcn_s_sleep(1); \
    if ((++_sp & 255u) == 0u) { if (xb_ld(&(bar)[XB_TMO])) break; if (_sp > XB_SPIN_CAP) { atomicAdd(&(bar)[XB_TMO], 1u); break; } } } } while (0)
struct XcdBarrier { unsigned* bar; unsigned x; volatile LAS unsigned* st; };
__device__ __forceinline__ XcdBarrier xcd_barrier_post(unsigned* bar, volatile LAS unsigned* st) {
    XcdBarrier b; b.bar = bar; b.x = xb_xcc_id(); b.st = st;
    if (threadIdx.x == 0) (void)xb_add(&bar[XB_XCNT(b.x)], 1u);
    return b;
}
__device__ __forceinline__ void xcd_barrier_complete(unsigned* bar, unsigned x, unsigned& nloc, unsigned& nx) {
    const unsigned G = gridDim.x * gridDim.y * gridDim.z;
    unsigned sum, cnt, mine, sp = 0u;
    for (;;) {
        sum = 0u; cnt = 0u; mine = 0u;
#pragma unroll
        for (unsigned j = 0; j < 16; ++j) { const unsigned c = xb_ld(&bar[XB_XCNT(j)]); sum += c; cnt += (c > 0u) ? 1u : 0u; mine = (j == x) ? c : mine; }
        if (sum == G) break;
        __builtin_amdgcn_s_sleep(1);
        if ((++sp & 255u) == 0u) { if (xb_ld(&bar[XB_TMO])) break; if (sp > XB_SPIN_CAP) { atomicAdd(&bar[XB_TMO], 1u); break; } }
    }
    nloc = mine > 0u ? mine : 1u; nx = cnt > 0u ? cnt : 1u;
}
__device__ __forceinline__ void xcd_barrier(const XcdBarrier& b, const int wave) {
    asm volatile("s_waitcnt vmcnt(0)" ::: "memory");
    __syncthreads();
    if (wave == 0 && pg8::mk_lane() == 0) {
        unsigned* bar = b.bar;
        __builtin_amdgcn_s_waitcnt(0);
        unsigned nloc = b.st[0], nx = b.st[1];
        if (nloc == 0u) { xcd_barrier_complete(bar, b.x, nloc, nx); b.st[0] = nloc; b.st[1] = nx; }
        const unsigned old = xb_add(&bar[XB_XSUB(b.x)], 1u);
        const unsigned gen = old / nloc;
        if (old + 1u == (gen + 1u) * nloc) {
            __builtin_amdgcn_fence(__ATOMIC_RELEASE, "agent");
            asm volatile("s_waitcnt vmcnt(0)" ::: "memory");
            const unsigned og = xb_add(&bar[XB_TOP], 1u);
            const unsigned tg = og / nx;
            if (og + 1u == (tg + 1u) * nx) xb_add(&bar[XB_TOPGEN], 1u);
            else XB_SPIN(xb_ld(&bar[XB_TOPGEN]) == tg, bar);
            __builtin_amdgcn_fence(__ATOMIC_ACQUIRE, "agent");
            xb_add(&bar[XB_XGEN(b.x)], 1u);
            asm volatile("s_waitcnt vmcnt(0)" ::: "memory");
        } else {
            XB_SPIN(xb_ld(&bar[XB_XGEN(b.x)]) == gen, bar);
            __builtin_amdgcn_fence(__ATOMIC_ACQUIRE, "agent");
            asm volatile("s_waitcnt vmcnt(0)" ::: "memory");
        }
    }
    __syncthreads();
}

struct Frame {
    LAS unsigned char* lds;
    volatile LAS unsigned* MISC;
    gu32* ctl;
    int wave;
    int vcu, G;
    unsigned char* ws;
    const float* in[26];
    float* out;
};
enum { I_X = 0, I_C, I_CTX, I_CCTX, I_WADA, I_BADA, I_NORM1, I_WIN, I_MU, I_KK, I_KA, I_RK, I_W0, I_WDU, I_A0, I_WIU, I_WGU, I_LNXW, I_LNXB, I_CONVW, I_WOUT, I_NORM2, I_WFG, I_WFU, I_WFD, I_NORMF };

__device__ __forceinline__ float wave_sum(float v) {
#pragma unroll
    for (int o = 1; o < 64; o <<= 1) v += __shfl_xor(v, o);
    return v;
}

__device__ __forceinline__ void p0_transpose_item(const float* W, int K, int N, bf16* WT, int ldk, int row_off, LAS float* scr, int item, int lane) {
    const int nblk = N / 32, kb = item / nblk, nb = item % nblk, k0 = 64 * kb, n0 = 32 * nb;
    float tv[32];
#pragma unroll
    for (int i = 0; i < 32; ++i) tv[i] = *(const GAS float*)(W + (size_t)(k0 + 2 * i + (lane >> 5)) * N + n0 + (lane & 31));
#pragma unroll
    for (int i = 0; i < 32; ++i) scr[(2 * i + (lane >> 5)) * 33 + (lane & 31)] = tv[i];
    LDS_WAIT(); asm volatile("" ::: "memory");
    const int c = lane & 7;
#pragma unroll
    for (int j = 0; j < 4; ++j) { const int n = (lane >> 3) + 8 * j; const LAS float* s = scr + (8 * c) * 33 + n;
        v4u o; o.x = pk2(s[0 * 33], s[1 * 33]); o.y = pk2(s[2 * 33], s[3 * 33]); o.z = pk2(s[4 * 33], s[5 * 33]); o.w = pk2(s[6 * 33], s[7 * 33]);
        *(GAS v4u*)(WT + (size_t)(row_off + n0 + n) * ldk + k0 + 8 * c) = o; }
    LDS_WAIT(); asm volatile("" ::: "memory");
}
constexpr int TI_IN = (D / 64) * (IN_COLS / 32), TI_OUT = (D / 64) * (D / 32), TI_G = (D / 64) * (DFF / 32), TI_DN = (DFF / 64) * (D / 32);
constexpr int TI_TOTAL = TI_IN + TI_OUT + 2 * TI_G + TI_DN;
constexpr int GEMV_UNITS = NKC * (MODN / 256);
constexpr int IB_OUT = TI_IN, IB_G = IB_OUT + TI_OUT, IB_U = IB_G + TI_G, IB_D = IB_U + TI_G;
constexpr int P2T_B = IB_OUT, P2T_E = IB_G + 13200;
constexpr int P6T_B = P2T_E, P6T_E = IB_U + 11000;
constexpr int P0X_B = P6T_E, P0X_E = IB_D + 12000;
constexpr int P11T_B = P0X_E, P11T_E = TI_TOTAL;
constexpr int P0_ITEMS = TI_IN + (P0X_E - P0X_B);
constexpr int TI_PER_GEMV_WAVE = 18, TI_PER_OTHER_WAVE = 42;
static_assert(GEMV_UNITS <= 2048 && GEMV_UNITS * TI_PER_GEMV_WAVE + (2048 - GEMV_UNITS) * TI_PER_OTHER_WAVE >= P0_ITEMS, "P0 item split");

__device__ __forceinline__ void tr_item(Frame& F, int it, LAS float* scr, int lane) {
    int r = it;
    if (r < TI_IN) { p0_transpose_item(F.in[I_WIN], D, IN_COLS, (bf16*)(F.ws + WS_WIN), D, 0, scr, r, lane); return; } r -= TI_IN;
    if (r < TI_OUT) { p0_transpose_item(F.in[I_WOUT], D, D, (bf16*)(F.ws + WS_WOUT), D, 0, scr, r, lane); return; } r -= TI_OUT;
    if (r < TI_G) { const int n0 = 32 * (r % (DFF / 32)); p0_transpose_item(F.in[I_WFG], D, DFF, (bf16*)(F.ws + WS_WGU), D, 256 * (n0 >> 7) + (n0 & 127) - n0, scr, r, lane); return; } r -= TI_G;
    if (r < TI_G) { const int n0 = 32 * (r % (DFF / 32)); p0_transpose_item(F.in[I_WFU], D, DFF, (bf16*)(F.ws + WS_WGU), D, 256 * (n0 >> 7) + 128 + (n0 & 127) - n0, scr, r, lane); return; } r -= TI_G;
    p0_transpose_item(F.in[I_WFD], DFF, D, (bf16*)(F.ws + WS_WDN), DFF, 0, scr, r, lane);
}
__device__ __forceinline__ void tr_range(Frame& F, int b, int e, int rank, int nw, LAS float* scr, int lane) {
    const int per = (e - b + nw - 1) / nw; int i0 = b + rank * per, i1 = i0 + per; if (i1 > e) i1 = e;
    for (int it = i0; it < i1; ++it) tr_item(F, it, scr, lane);
}
__device__ __forceinline__ void tr_idle(Frame& F, int b, int e, int rank_blk, int nblk) {
    if (F.G != 256 || rank_blk < 0) return;
    tr_range(F, b, e, rank_blk * NWAVES + F.wave, nblk * NWAVES, (LAS float*)(F.lds + RING_OFF + F.wave * 16384), pg8::mk_lane());
}
__device__ __forceinline__ void p0_gemv_unit(Frame& F, int unit, int lane) {
    const int kc = unit / (MODN / 256), cc = unit % (MODN / 256);
    const int k0 = kc * 256, col = cc * 256 + lane * 4;
    int sv[4], sc[4];
#pragma unroll
    for (int q = 0; q < 4; ++q) { const float c = *(const GAS float*)(F.in[I_C] + k0 + q * 64 + lane), cx = *(const GAS float*)(F.in[I_CCTX] + k0 + q * 64 + lane);
        sv[q] = __builtin_bit_cast(int, c * sigm(c)); sc[q] = __builtin_bit_cast(int, cx * sigm(cx)); }
    f32x4 a0 = (f32x4){0.f, 0.f, 0.f, 0.f}, a1 = a0;
    const GAS f32x4* wp = (const GAS f32x4*)(F.in[I_WADA] + (size_t)k0 * MODN + col);
#pragma unroll
    for (int q = 0; q < 4; ++q) {
#pragma unroll 16
        for (int i = 0; i < 64; ++i) { const f32x4 w = wp[(size_t)(q * 64 + i) * (MODN / 4)];
            const float s = __builtin_bit_cast(float, __builtin_amdgcn_readlane(sv[q], i)), t = __builtin_bit_cast(float, __builtin_amdgcn_readlane(sc[q], i));
            a0 += w * s; a1 += w * t; }
    }
    float* mp = (float*)(F.ws + WS_MODP);
    *(GAS f32x4*)(mp + (size_t)(kc * 2 + 0) * MODN + col) = a0;
    *(GAS f32x4*)(mp + (size_t)(kc * 2 + 1) * MODN + col) = a1;
}

__device__ __forceinline__ void p0_prologue(Frame& F) {
    LAS float* scr = (LAS float*)(F.lds + RING_OFF + F.wave * 16384);
    const int lane = pg8::mk_lane();
    const int gw = F.vcu * NWAVES + F.wave, NGW = F.G * NWAVES;
    const int gt = gw * 64 + lane, NGT = NGW * 64;
    {
        unsigned* wl = (unsigned*)(F.ws + WS_WLORA);
        for (int i = gt; i < NLORA * KLORA / 2; i += NGT) { const int n = i >> 7, k = (i & 127) * 2, pn = n >> 8, d = pn >> 4, isic = (n >> 7) & 1, ch = (pn & 15) * 128 + (n & 127); float v0 = 0.f, v1 = 0.f;
            if (k < 96) { if (!isic) { v0 = *(const GAS float*)(F.in[I_WDU] + (size_t)(d * 96 + k) * 2048 + ch); v1 = *(const GAS float*)(F.in[I_WDU] + (size_t)(d * 96 + k + 1) * 2048 + ch); } }
            else if (k < 192) { if (isic) { v0 = *(const GAS float*)(F.in[I_WIU] + (size_t)(d * 96 + k - 96) * 2048 + ch); v1 = *(const GAS float*)(F.in[I_WIU] + (size_t)(d * 96 + k - 95) * 2048 + ch); } }
            *(GAS unsigned*)(wl + i) = pk2(v0, v1); }
        unsigned* wg = (unsigned*)(F.ws + WS_WGATE);
        for (int i = gt; i < 2048 * KGATE / 2; i += NGT) { const int n = i >> 7, k = (i & 127) * 2;
            *(GAS unsigned*)(wg + i) = pk2(*(const GAS float*)(F.in[I_WGU] + (size_t)k * 2048 + n), *(const GAS float*)(F.in[I_WGU] + (size_t)(k + 1) * 2048 + n)); }
        v4u* zp = (v4u*)(F.ws + WS_WIN + (size_t)IN_COLS * D * 2);
        for (int i = gt; i < (NZ - IN_COLS) * D * 2 / 16; i += NGT) *(GAS v4u*)(zp + i) = (v4u){0u, 0u, 0u, 0u};
    }
    for (int u = gw; u < GEMV_UNITS; u += NGW) p0_gemv_unit(F, u, lane);
    if (F.G == 256) {
        int it0, it1;
        if (gw < GEMV_UNITS) { it0 = gw * TI_PER_GEMV_WAVE; it1 = it0 + TI_PER_GEMV_WAVE; }
        else { it0 = GEMV_UNITS * TI_PER_GEMV_WAVE + (gw - GEMV_UNITS) * TI_PER_OTHER_WAVE; it1 = it0 + TI_PER_OTHER_WAVE; }
        if (it1 > P0_ITEMS) it1 = P0_ITEMS;
        for (int it = it0; it < it1; ++it) tr_item(F, it < TI_IN ? it : P0X_B + (it - TI_IN), scr, lane);
    } else tr_range(F, 0, TI_TOTAL, gw, NGW, scr, lane);
}

__device__ __forceinline__ void norm_row_load(const float* xrow, int lane, f32x4 (&v)[16]) {
    const GAS f32x4* xr = (const GAS f32x4*)xrow + lane;
#pragma unroll
    for (int j = 0; j < 16; ++j) v[j] = xr[64 * j];
}
__device__ __forceinline__ void norm_row_finish(const f32x4 (&v)[16], bf16* orow, const LAS float* gs, const LAS float* sh, int lane) {
    float s = 0.f;
#pragma unroll
    for (int j = 0; j < 16; ++j) s += (v[j].x * v[j].x + v[j].y * v[j].y) + (v[j].z * v[j].z + v[j].w * v[j].w);
    const float rstd = 1.0f / sqrtf(wave_sum(s) * (1.f / D) + NORM_EPS);
    GAS v2u* o8 = (GAS v2u*)orow + lane;
#pragma unroll
    for (int j = 0; j < 16; ++j) { const f32x4 g = *(const LAS f32x4*)(gs + 4 * lane + 256 * j), b = *(const LAS f32x4*)(sh + 4 * lane + 256 * j);
        const f32x4 y = v[j] * rstd * g + b; v2u o; o.x = pk2(y.x, y.y); o.y = pk2(y.z, y.w); o8[64 * j] = o; }
}
__device__ __forceinline__ void norm_row(const float* xrow, bf16* orow, const LAS float* gs, const LAS float* sh, int lane) {
    f32x4 v[16]; norm_row_load(xrow, lane, v); norm_row_finish(v, orow, gs, sh, lane);
}
__device__ __forceinline__ void p1_norm1(Frame& F) {
    const int lane = pg8::mk_lane(), tid = F.wave * 64 + lane;
    const int gw = F.vcu * NWAVES + F.wave, NGW = F.G * NWAVES;
    bf16* A1 = (bf16*)(F.ws + WS_A1);
    f32x4 v0[16]; norm_row_load(F.in[I_X] + (size_t)gw * D, lane, v0);
    LAS float* tab = (LAS float*)(F.lds + RING_OFF);
    const float* mp = (const float*)(F.ws + WS_MODP);
    bool need_ctx = false;
    for (int m = F.vcu * NWAVES; m < TT; m += NGW) if (m + NWAVES > T) need_ctx = true;
    for (int i = tid; i < (need_ctx ? 4 : 2) * (D / 4); i += NWAVES * 64) {
        const int which = i >> 10, k = (i & (D / 4 - 1)) * 4, isc = which >> 1, part = which & 1;
        const int col = part == 0 ? D + k : k;
        f32x4 s = *(const GAS f32x4*)(F.in[I_BADA] + col);
#pragma unroll
        for (int p = 0; p < NKC; ++p) s += *(const GAS f32x4*)(mp + (size_t)(p * 2 + isc) * MODN + col);
        if (part == 0) s = *(const GAS f32x4*)(F.in[I_NORM1] + k) * (1.0f + s);
        *(LAS f32x4*)(tab + which * D + k) = s;
    }
    {
        float* mv = (float*)(F.ws + WS_MODV);
        for (int i = F.vcu * (NWAVES * 64) + tid; i < 2 * MODN; i += F.G * NWAVES * 64) { const int isc = i / MODN, col = i % MODN;
            float s = *(const GAS float*)(F.in[I_BADA] + col);
#pragma unroll
            for (int p = 0; p < NKC; ++p) s += *(const GAS float*)(mp + (size_t)(p * 2 + isc) * MODN + col);
            *(GAS float*)(mv + i) = s; }
    }
    __syncthreads();
    f32x4 v1[16];
#define MK_P1_SRC(m_) ((m_) < T ? F.in[I_X] + (size_t)(m_) * D : F.in[I_CTX] + (size_t)((m_) - T) * D)
#define MK_P1_FIN(v_, m_) do { if ((m_) < T) norm_row_finish(v_, A1 + (size_t)(m_) * D, tab, tab + D, lane); else norm_row_finish(v_, A1 + (size_t)(m_) * D, tab + 2 * D, tab + 3 * D, lane); } while (0)
    for (int m = gw; m < TT; m += 2 * NGW) {
        const int m2 = m + NGW, m3 = m2 + NGW;
        if (m2 < TT) norm_row_load(MK_P1_SRC(m2), lane, v1);
        MK_P1_FIN(v0, m);
        if (m2 < TT) { if (m3 < TT) norm_row_load(MK_P1_SRC(m3), lane, v0); MK_P1_FIN(v1, m2); }
    }
#undef MK_P1_SRC
#undef MK_P1_FIN
    __syncthreads();
}
__device__ __forceinline__ void p10_norm2(Frame& F) {
    const int lane = pg8::mk_lane(), tid = F.wave * 64 + lane;
    LAS float* tab = (LAS float*)(F.lds + RING_OFF);
    const float* mv = (const float*)(F.ws + WS_MODV);
    const int gw = F.vcu * NWAVES + F.wave, NGW = F.G * NWAVES;
    bf16* A1 = (bf16*)(F.ws + WS_A1); const float* X1 = (const float*)(F.ws + WS_X1);
    f32x4 v0[16], v1[16];
    if (gw < T) norm_row_load(X1 + (size_t)gw * D, lane, v0);
    for (int i = tid; i < 2 * D; i += NWAVES * 64) { const int part = i >> 12, k = i & (D - 1);
        tab[i] = part == 0 ? *(const GAS float*)(F.in[I_NORM2] + k) * (1.0f + *(const GAS float*)(mv + 4 * D + k)) : *(const GAS float*)(mv + 3 * D + k); }
    __syncthreads();
    for (int m = gw; m < T; m += 2 * NGW) {
        const int m2 = m + NGW, m3 = m2 + NGW;
        if (m2 < T) norm_row_load(X1 + (size_t)m2 * D, lane, v1);
        asm volatile("" ::: "memory");
        norm_row_finish(v0, A1 + (size_t)m * D, tab, tab + D, lane);
        asm volatile("" ::: "memory");
        if (m2 < T) { if (m3 < T) norm_row_load(X1 + (size_t)m3 * D, lane, v0); asm volatile("" ::: "memory"); norm_row_finish(v1, A1 + (size_t)m2 * D, tab, tab + D, lane); asm volatile("" ::: "memory"); }
    }
    __syncthreads();
}
__device__ __forceinline__ void p13_final(Frame& F) {
    const int lane = pg8::mk_lane();
    const int gw = F.vcu * NWAVES + F.wave, NGW = F.G * NWAVES;
    f32x4 v0[16], v1[16];
#define MK_P13_FIN(v_, m_) do { float s_ = 0.f; _Pragma("unroll") for (int j = 0; j < 16; ++j) s_ += (v_[j].x * v_[j].x + v_[j].y * v_[j].y) + (v_[j].z * v_[j].z + v_[j].w * v_[j].w); \
        const float rstd_ = 1.0f / sqrtf(wave_sum(s_) * (1.f / D) + NORM_EPS); GAS f32x4* xo_ = (GAS f32x4*)(F.out + (size_t)(m_) * D) + lane; \
        _Pragma("unroll") for (int j = 0; j < 16; ++j) xo_[64 * j] = v_[j] * rstd_ * *((const GAS f32x4*)F.in[I_NORMF] + lane + 64 * j); } while (0)
    if (gw < T) norm_row_load(F.out + (size_t)gw * D, lane, v0);
    for (int m = gw; m < T; m += 2 * NGW) {
        const int m2 = m + NGW, m3 = m2 + NGW;
        if (m2 < T) norm_row_load(F.out + (size_t)m2 * D, lane, v1);
        MK_P13_FIN(v0, m);
        if (m2 < T) { if (m3 < T) norm_row_load(F.out + (size_t)m3 * D, lane, v0); MK_P13_FIN(v1, m2); }
    }
#undef MK_P13_FIN
}

__device__ __forceinline__ void ld8(const bf16* p, float (&f)[8]) { const v4u r = *(const GAS v4u*)p;
    f[0] = bflo(r.x); f[1] = bfhi(r.x); f[2] = bflo(r.y); f[3] = bfhi(r.y); f[4] = bflo(r.z); f[5] = bfhi(r.z); f[6] = bflo(r.w); f[7] = bfhi(r.w); }
__device__ __forceinline__ void ldf8(const float* p, float (&f)[8]) { const f32x4 a = *(const GAS f32x4*)p, b = *(const GAS f32x4*)(p + 4);
    f[0] = a.x; f[1] = a.y; f[2] = a.z; f[3] = a.w; f[4] = b.x; f[5] = b.y; f[6] = b.z; f[7] = b.w; }
__device__ __forceinline__ void stf8(float* p, const float (&f)[8]) { *(GAS f32x4*)p = (f32x4){f[0], f[1], f[2], f[3]}; *(GAS f32x4*)(p + 4) = (f32x4){f[4], f[5], f[6], f[7]}; }
__device__ __forceinline__ void stb8(bf16* p, const float (&f)[8]) { v4u o; o.x = pk2(f[0], f[1]); o.y = pk2(f[2], f[3]); o.z = pk2(f[4], f[5]); o.w = pk2(f[6], f[7]); *(GAS v4u*)p = o; }
__device__ __forceinline__ void za8(const bf16* Z, int row, bool hp, bool hn, int c, const float* mu, float (&o)[8]) {
    float zc[8], zp[8], zn[8], m8[8];
    ld8(Z + (size_t)row * NZ + c, zc);
    if (hp) ld8(Z + (size_t)(row - 1) * NZ + c, zp); else { _Pragma("unroll") for (int i = 0; i < 8; ++i) zp[i] = 0.f; }
    if (hn) ld8(Z + (size_t)(row + 1) * NZ + c, zn); else { _Pragma("unroll") for (int i = 0; i < 8; ++i) zn[i] = 0.f; }
    ldf8(mu + c, m8);
#pragma unroll
    for (int i = 0; i < 8; ++i) o[i] = zc[i] + m8[i] * (0.5f * (zp[i] + zn[i]) - zc[i]);
}
__device__ __forceinline__ void zero8(float (&f)[8]) {
#pragma unroll
    for (int i = 0; i < 8; ++i) f[i] = 0.f; }
__device__ __forceinline__ void cp8(float (&d)[8], const float (&s)[8]) {
#pragma unroll
    for (int i = 0; i < 8; ++i) d[i] = s[i]; }
__device__ __forceinline__ void un8(const v4u r, float (&f)[8]) { f[0] = bflo(r.x); f[1] = bfhi(r.x); f[2] = bflo(r.y); f[3] = bfhi(r.y); f[4] = bflo(r.z); f[5] = bfhi(r.z); f[6] = bflo(r.w); f[7] = bfhi(r.w); }
__device__ __forceinline__ v4u ldraw(const bf16* p, bool ok) { return ok ? *(const GAS v4u*)p : (v4u){0u, 0u, 0u, 0u}; }
__device__ __forceinline__ void p3_prep(Frame& F) {
    const bf16* Z = (const bf16*)(F.ws + WS_Z);
    bf16* KB = (bf16*)(F.ws + WS_KBUF); bf16* KKB = (bf16*)(F.ws + WS_KKBUF); bf16* RB = (bf16*)(F.ws + WS_RBUF); bf16* VB = (bf16*)(F.ws + WS_VBUF);
    bf16* AL = (bf16*)(F.ws + WS_ALORA); bf16* AG = (bf16*)(F.ws + WS_AGATE); bf16* CAT = (bf16*)(F.ws + WS_CAT);
    const float* mu = F.in[I_MU];
    const int tpb = (TT + F.G - 1) / F.G;
    const int tok0 = F.vcu * tpb, half0 = (tpb + 1) / 2;
    const int lane = pg8::mk_lane();
    for (int it = F.wave; it < 36; it += NWAVES) {
        const int type = it >> 1, hf = it & 1;
        int tA = tok0 + (hf ? half0 : 0), tB = tok0 + (hf ? tpb : half0);
        if (tB > TT) tB = TT;
        if (tA >= tB) continue;
        if (type < 14) {
            int zoff, c = 0; bool act = true;
            if (type < 12) { const int kind = type >> 2; c = (type & 3) * 512 + lane * 8; zoff = (kind == 0 ? OFF_K : (kind == 1 ? OFF_V : OFF_R)) + c; }
            else if (type == 12) { act = lane < 24; zoff = OFF_WL + (act ? lane : 0) * 8; }
            else { act = lane < 32; zoff = OFF_GL + (act ? lane : 0) * 8; }
            float m8[8], kk8[8]; ldf8(mu + zoff, m8);
            if (type < 4) ldf8(F.in[I_KK] + c, kk8); else zero8(kk8);
            const bf16* zb = Z + zoff;
            v4u rw[6];
#pragma unroll
            for (int u = 0; u < 6; ++u) { const int r = tA - 1 + u; rw[u] = ldraw(zb + (size_t)(r < 0 ? 0 : r) * NZ, r >= 0 && r < TT); }
            for (int t0 = tA; t0 < tB; t0 += 4) {
                v4u nx[4];
#pragma unroll
                for (int u = 0; u < 4; ++u) { const int r = t0 + 5 + u; nx[u] = ldraw(zb + (size_t)(r < TT ? r : 0) * NZ, r < TT); }
#pragma unroll
                for (int u = 0; u < 4; ++u) {
                    const int t = t0 + u;
                    if (t < tB) {
                        const bool isctx = t >= T; const int pos = isctx ? t - T : (t & 63);
                        const bool hp = pos > 0, hn = isctx ? (pos < CTXL - 1) : (pos < 63);
                        float zp[8], zc[8], zn[8], v[8]; un8(rw[u], zp); un8(rw[u + 1], zc); un8(rw[u + 2], zn);
#pragma unroll
                        for (int i = 0; i < 8; ++i) v[i] = zc[i] + m8[i] * (0.5f * ((hp ? zp[i] : 0.f) + (hn ? zn[i] : 0.f)) - zc[i]);
                        const size_t fo = (size_t)t * 2048 + c;
                        if (type < 4) {
                            stb8(KB + fo, v);
                            float q[8]; float ss = 0.f;
#pragma unroll
                            for (int i = 0; i < 8; ++i) { q[i] = v[i] * kk8[i]; ss += q[i] * q[i]; }
                            ss += __shfl_xor(ss, 1); ss += __shfl_xor(ss, 2); ss += __shfl_xor(ss, 4);
                            const float inv = 1.0f / fmaxf(sqrtf(ss), 1e-12f);
#pragma unroll
                            for (int i = 0; i < 8; ++i) q[i] *= inv;
                            stb8(KKB + fo, q);
                        } else if (type < 8) stb8(VB + fo, v);
                        else if (type < 12) { if (!isctx) stb8(RB + fo, v); }
                        else if (type == 12) {
                            if (lane < 32) { float o[8];
                                if (lane < 12) { _Pragma("unroll") for (int i = 0; i < 8; ++i) o[i] = tanhf(v[i]); }
                                else if (lane < 24) cp8(o, v);
                                else zero8(o);
                                stb8(AL + (size_t)t * KLORA + lane * 8, o); }
                        } else { if (!isctx && lane < 32) { float o[8];
#pragma unroll
                                for (int i = 0; i < 8; ++i) o[i] = sigm(v[i]);
                                stb8(AG + (size_t)t * KGATE + lane * 8, o); } }
                    }
                }
                rw[0] = rw[4]; rw[1] = rw[5]; rw[2] = nx[0]; rw[3] = nx[1]; rw[4] = nx[2]; rw[5] = nx[3];
            }
        } else {
            if (tA >= T) continue;
            if (tB > T) tB = T;
            const int c = (type - 14) * 512 + lane * 8;
            float w0[8], w1[8], w2[8];
            ldf8(F.in[I_CONVW] + c, w0); ldf8(F.in[I_CONVW] + 2048 + c, w1); ldf8(F.in[I_CONVW] + 4096 + c, w2);
            const bf16* zc_ = Z + OFF_CC + c; const bf16* zx_ = Z + OFF_CX + c; const bf16* zb_ = Z + OFF_CB + c;
            v4u cw[6], xw[6], bw[4];
#pragma unroll
            for (int u = 0; u < 6; ++u) { const int r = tA - 1 + u; const bool ok = r >= 0 && r < T; const size_t ro = (size_t)(ok ? r : 0) * NZ; cw[u] = ldraw(zc_ + ro, ok); xw[u] = ldraw(zx_ + ro, ok); }
#pragma unroll
            for (int u = 0; u < 4; ++u) { const int r = tA + u; const bool ok = r < T; bw[u] = ldraw(zb_ + (size_t)(ok ? r : 0) * NZ, ok); }
            for (int t0 = tA; t0 < tB; t0 += 4) {
                v4u cn[4], xn[4], bn[4];
#pragma unroll
                for (int u = 0; u < 4; ++u) { const int r = t0 + 5 + u; const bool ok = r < T; const size_t ro = (size_t)(ok ? r : 0) * NZ; cn[u] = ldraw(zc_ + ro, ok); xn[u] = ldraw(zx_ + ro, ok);
                    const int rb = t0 + 4 + u; const bool okb = rb < T; bn[u] = ldraw(zb_ + (size_t)(okb ? rb : 0) * NZ, okb); }
#pragma unroll
                for (int u = 0; u < 4; ++u) {
                    const int t = t0 + u;
                    if (t < tB) {
                        const int pos = t & 63; const bool hp = pos > 0, hn = pos < 63;
                        float cp_[8], xp_[8], cc_[8], xc_[8], cn_[8], xn_[8], bg[8], y[8];
                        un8(cw[u], cp_); un8(xw[u], xp_); un8(cw[u + 1], cc_); un8(xw[u + 1], xc_); un8(cw[u + 2], cn_); un8(xw[u + 2], xn_); un8(bw[u], bg);
#pragma unroll
                        for (int i = 0; i < 8; ++i) y[i] = bg[i] * (w0[i] * (hp ? cp_[i] * xp_[i] : 0.f) + w1[i] * (cc_[i] * xc_[i]) + w2[i] * (hn ? cn_[i] * xn_[i] : 0.f));
                        stb8(CAT + (size_t)t * D + DR + c, y);
                    }
                }
                cw[0] = cw[4]; cw[1] = cw[5]; cw[2] = cn[0]; cw[3] = cn[1]; cw[4] = cn[2]; cw[5] = cn[3];
                xw[0] = xw[4]; xw[1] = xw[5]; xw[2] = xn[0]; xw[3] = xn[1]; xw[4] = xn[2]; xw[5] = xn[3];
                bw[0] = bn[0]; bw[1] = bn[1]; bw[2] = bn[2]; bw[3] = bn[3];
            }
        }
    }
}

typedef float f32x16 __attribute__((ext_vector_type(16)));
#define MK_FENCE() asm volatile("" ::: "memory")
constexpr int REC_BYTES = 8448, NBLK = TT / 16, SCAN_LDS = REC_BYTES + 4096;
__device__ __forceinline__ void swap32(float& x, float& y) { asm volatile("s_nop 1\n\tv_permlane32_swap_b32 %0, %1\n\ts_nop 1" : "+v"(x), "+v"(y)); }
__device__ __forceinline__ int kperm(int k) { return ((((k >> 5) * 2 + ((k >> 4) & 1)) * 2 + ((k >> 2) & 1)) * 8 + ((k >> 3) & 1) * 4 + (k & 3)); }
__device__ __forceinline__ int scan_blkbase(int d, int c, int j) {
    if (c == 0) return T + (d == 0 ? 16 * j : CTXL - 16 - 16 * j);
    const int p0 = (c - 1) * CHUNK + 16 * j;
    return d == 0 ? p0 : T - 16 - p0;
}
__device__ __forceinline__ void scan_vec32(const LAS unsigned char* row, int hl, float (&f)[32]) {
#pragma unroll
    for (int q = 0; q < 4; ++q) { const v4u w = *(const LAS v4u*)(row + (q * 2 + hl) * 16);
        f[8 * q + 0] = bflo(w.x); f[8 * q + 1] = bfhi(w.x); f[8 * q + 2] = bflo(w.y); f[8 * q + 3] = bfhi(w.y); f[8 * q + 4] = bflo(w.z); f[8 * q + 5] = bfhi(w.z); f[8 * q + 6] = bflo(w.w); f[8 * q + 7] = bfhi(w.w); }
}
__device__ __forceinline__ void scan_matvec(const f32x16 (&Tt)[2][2], const float (&f)[32], float& sa) {
    float p0a = 0.f, p0b = 0.f, p1a = 0.f, p1b = 0.f;
#pragma unroll
    for (int I = 0; I < 2; ++I)
#pragma unroll
        for (int r = 0; r < 16; r += 2) { p0a += Tt[I][0][r] * f[16 * I + r]; p1a += Tt[I][1][r] * f[16 * I + r]; p0b += Tt[I][0][r + 1] * f[16 * I + r + 1]; p1b += Tt[I][1][r + 1] * f[16 * I + r + 1]; }
    float p0 = p0a + p0b, p1 = p1a + p1b;
    swap32(p0, p1);
    sa = p0 + p1;
}
__device__ __forceinline__ void scan_renorm(f32x16 (&Tt)[2][2], const LAS float* ge, int hl) {
#pragma unroll
    for (int I = 0; I < 2; ++I)
#pragma unroll
        for (int qd = 0; qd < 4; ++qd) { const f32x4 g = *(const LAS f32x4*)(ge + 32 * I + 8 * qd + 4 * hl);
#pragma unroll
            for (int e = 0; e < 4; ++e) { Tt[I][0][4 * qd + e] *= g[e]; Tt[I][1][4 * qd + e] *= g[e]; } }
}
__device__ __forceinline__ void scan_store_T(const f32x16 (&Tt)[2][2], float* dst, int lane) {
#pragma unroll
    for (int I = 0; I < 2; ++I)
#pragma unroll
        for (int J = 0; J < 2; ++J)
#pragma unroll
            for (int reg = 0; reg < 16; ++reg) *(GAS float*)(dst + (32 * I + 8 * (reg >> 2) + 4 * (lane >> 5) + (reg & 3)) * 64 + 32 * J + (lane & 31)) = Tt[I][J][reg];
}
typedef short bf16x8 __attribute__((ext_vector_type(8)));
#define MK_MFMA(a, b, c) __builtin_amdgcn_mfma_f32_32x32x16_bf16((a), (b), (c), 0, 0, 0)
constexpr int SCR_LAB = 0, SCR_LAK = 1024, SCR_MRB = 2048, SCR_MRK = 2560, SCAN_SCR = 3072;
struct RecRegs { v4u p[8]; float ge; };
__device__ __forceinline__ void scan_rload(const unsigned char* PKB, int d, int h, int tb, int lane, RecRegs& R) {
    const GAS unsigned char* rp = (const GAS unsigned char*)PKB + ((size_t)(d * 32 + h) * NBLK + (tb >> 4)) * REC_BYTES;
#pragma unroll
    for (int j = 0; j < 8; ++j) R.p[j] = *((const GAS v4u*)rp + 64 * j + lane);
    R.ge = *((const GAS float*)(rp + 8192) + lane);
}
__device__ __forceinline__ void scan_rstore(LAS unsigned char* buf, int lane, const RecRegs& R) {
#pragma unroll
    for (int j = 0; j < 8; ++j) *((LAS v4u*)buf + 64 * j + lane) = R.p[j];
    *((LAS float*)(buf + 8192) + lane) = R.ge;
}
typedef float f32x2n __attribute__((ext_vector_type(2)));
typedef __bf16 bf16x2n __attribute__((ext_vector_type(2)));
__device__ __forceinline__ unsigned cvt2bf(float a, float b) { const f32x2n v = {a, b}; return __builtin_bit_cast(unsigned, __builtin_convertvector(v, bf16x2n)); }
__device__ __forceinline__ bf16x8 pack8(float a0, float a1, float a2, float a3, float a4, float a5, float a6, float a7) {
    const v4u u = {cvt2bf(a0, a1), cvt2bf(a2, a3), cvt2bf(a4, a5), cvt2bf(a6, a7)}; return __builtin_bit_cast(bf16x8, u); }
__device__ __forceinline__ f32x16 zero16() { f32x16 z;
#pragma unroll
    for (int i = 0; i < 16; ++i) z[i] = 0.f;
    return z; }
__device__ __forceinline__ void scan_tfrags(const f32x16 (&Tt)[2][2], bf16x8 (&Tf)[2][2][2]) {
#pragma unroll
    for (int I = 0; I < 2; ++I)
#pragma unroll
        for (int J = 0; J < 2; ++J)
#pragma unroll
            for (int s = 0; s < 2; ++s) Tf[I][J][s] = pack8(Tt[I][J][8 * s], Tt[I][J][8 * s + 1], Tt[I][J][8 * s + 2], Tt[I][J][8 * s + 3], Tt[I][J][8 * s + 4], Tt[I][J][8 * s + 5], Tt[I][J][8 * s + 6], Tt[I][J][8 * s + 7]);
}
__device__ __forceinline__ void scan_sfrags(float (&S)[16], bf16x8 (&Sf)[2]) {
#pragma unroll
    for (int j = 0; j < 8; ++j) swap32(S[j], S[j + 8]);
    Sf[0] = pack8(S[0], S[1], S[2], S[3], S[4], S[5], S[6], S[7]); Sf[1] = pack8(S[8], S[9], S[10], S[11], S[12], S[13], S[14], S[15]);
}
template <int WHICH> __device__ __forceinline__ void p5_pass(Frame& F, const int unit) {
    const unsigned char* PKB = F.ws + WS_PK; const bf16* VB = (const bf16*)(F.ws + WS_VBUF);
    float* PU = (float*)(F.ws + WS_PU);
    LAS unsigned char* my = F.lds + RING_OFF + F.wave * (REC_BYTES + SCAN_SCR);
    LAS unsigned char* scr = my + REC_BYTES;
    {
        const int d = unit & 1, h = (unit >> 1) & 31, c = unit >> 6;
        constexpr int which = WHICH;
        {
            const int lane = pg8::mk_lane(), hl = lane >> 5, l31 = lane & 31, l15 = lane & 15;
            const float idv = which ? 1.0f : 0.0f;
            f32x16 Tt[2][2];
#pragma unroll
            for (int I = 0; I < 2; ++I)
#pragma unroll
                for (int J = 0; J < 2; ++J)
#pragma unroll
                    for (int reg = 0; reg < 16; ++reg) Tt[I][J][reg] = (32 * I + 8 * (reg >> 2) + 4 * hl + (reg & 3) == 32 * J + l31) ? idv : 0.0f;
            RecRegs R;
            scan_rload(PKB, d, h, scan_blkbase(d, c, 0), lane, R);
#pragma unroll 1
            for (int j = 0; j < 16; ++j) {
                const int tb = scan_blkbase(d, c, j);
                scan_rstore(my, lane, R);
                float Vv[16];
                if (which == 0) { const GAS bf16* gv = (const GAS bf16*)(VB + (size_t)(tb + (d == 0 ? 0 : 15)) * 2048 + h * 64) + lane; const int dstep = d == 0 ? 2048 : -2048;
#pragma unroll
                    for (int t = 0; t < 16; ++t) Vv[t] = __builtin_bit_cast(float, (unsigned)gv[t * dstep] << 16); }
                else {
#pragma unroll
                    for (int t = 0; t < 16; ++t) Vv[t] = 0.f; }
                const LAS unsigned char* arow = my + l15 * 128 + hl * 16;
                {   f32x16 Lab = zero16(), Lak = zero16();
#pragma unroll
                    for (int qq = 0; qq < 4; ++qq) { const bf16x8 af = *(const LAS bf16x8*)(arow + qq * 32), bf = *(const LAS bf16x8*)(arow + 4096 + qq * 32), kf = *(const LAS bf16x8*)(arow + 6144 + qq * 32);
                        Lab = MK_MFMA(af, bf, Lab); if (which == 0) Lak = MK_MFMA(af, kf, Lak); }
                    if (l31 < 16) { LAS float* lb = (LAS float*)scr + 64 * hl + l31;
#pragma unroll
                        for (int r = 0; r < 8; ++r) { const int t0 = 8 * (r >> 2) + (r & 3); lb[SCR_LAB / 4 + t0 * 16] = Lab[r]; lb[SCR_LAK / 4 + t0 * 16] = Lak[r]; } }
                }
                MK_FENCE();
                f32x16 G[2];
                {   bf16x8 Tf[2][2][2]; scan_tfrags(Tt, Tf);
                    G[0] = zero16(); G[1] = zero16();
#pragma unroll
                    for (int qq = 0; qq < 4; ++qq) { const bf16x8 af = *(const LAS bf16x8*)(arow + qq * 32);
                        G[0] = MK_MFMA(af, Tf[qq >> 1][0][qq & 1], G[0]); G[1] = MK_MFMA(af, Tf[qq >> 1][1][qq & 1], G[1]); }
                }
                MK_FENCE();
                if (j + 1 < 16) scan_rload(PKB, d, h, scan_blkbase(d, c, j + 1), lane, R);
                float S[16];
#pragma unroll
                for (int r = 0; r < 8; ++r) { float x = G[0][r], y = G[1][r]; swap32(x, y); const int t = 8 * (r >> 2) + (r & 3); S[t] = x; S[t + 4] = y; }
#pragma unroll
                for (int t = 1; t < 16; ++t) {
                    float acc = S[t], acc1 = 0.f, acc2 = 0.f, acc3 = 0.f;
#pragma unroll
                    for (int s4 = 0; s4 < (t + 3) / 4; ++s4) { const f32x4 la = *(const LAS f32x4*)(scr + SCR_LAB + (t * 16 + 4 * s4) * 4), lk = *(const LAS f32x4*)(scr + SCR_LAK + (t * 16 + 4 * s4) * 4);
#pragma unroll
                        for (int e = 0; e < 4; ++e) if (4 * s4 + e < t) { if (e & 1) acc1 += la[e] * S[4 * s4 + e]; else acc += la[e] * S[4 * s4 + e];
                            if (which == 0) { if (e & 1) acc3 += lk[e] * Vv[4 * s4 + e]; else acc2 += lk[e] * Vv[4 * s4 + e]; } } }
                    S[t] = (acc + acc1) + (acc2 + acc3);
                }
                bf16x8 Sf[2], Vf[2]; scan_sfrags(S, Sf); if (which == 0) scan_sfrags(Vv, Vf);
#pragma unroll
                for (int I = 0; I < 2; ++I) {
                    const LAS unsigned char* col = my + 4096 + (8 * hl) * 128 + kperm(32 * I + l31) * 2;
                    unsigned short bs[8], ks[8];
#pragma unroll
                    for (int e = 0; e < 8; ++e) { bs[e] = *(const LAS unsigned short*)(col + e * 128); ks[e] = *(const LAS unsigned short*)(col + 2048 + e * 128); }
                    const v4u bu = {(unsigned)bs[0] | ((unsigned)bs[1] << 16), (unsigned)bs[2] | ((unsigned)bs[3] << 16), (unsigned)bs[4] | ((unsigned)bs[5] << 16), (unsigned)bs[6] | ((unsigned)bs[7] << 16)};
                    const v4u ku = {(unsigned)ks[0] | ((unsigned)ks[1] << 16), (unsigned)ks[2] | ((unsigned)ks[3] << 16), (unsigned)ks[4] | ((unsigned)ks[5] << 16), (unsigned)ks[6] | ((unsigned)ks[7] << 16)};
                    const bf16x8 ba = __builtin_bit_cast(bf16x8, bu), ka = __builtin_bit_cast(bf16x8, ku);
                    Tt[I][0] = MK_MFMA(ba, Sf[0], Tt[I][0]); Tt[I][1] = MK_MFMA(ba, Sf[1], Tt[I][1]); if (which == 0) { Tt[I][0] = MK_MFMA(ka, Vf[0], Tt[I][0]); Tt[I][1] = MK_MFMA(ka, Vf[1], Tt[I][1]); }
                }
                scan_renorm(Tt, (const LAS float*)(my + 8192), hl);
            }
            scan_store_T(Tt, PU + ((size_t)unit * 2 + (which ? 0 : 1)) * 4096, lane);
        }
    }
}
__device__ __forceinline__ void p5_scanA(Frame& F) {
    for (int unit = F.vcu * NWAVES + F.wave; unit < 2048; unit += F.G * NWAVES) { p5_pass<0>(F, unit); if (unit >= 64) p5_pass<1>(F, unit); }
}
__device__ __forceinline__ void p6_scanB(Frame& F) {
    const GAS char* PU = (const GAS char*)(F.ws + WS_PU); GAS char* SST = (GAS char*)(F.ws + WS_SST);
    LAS float* PiB = (LAS float*)(F.lds + RING_OFF);
    LAS float* TbB = (LAS float*)(F.lds + RING_OFF + 2 * 16640);
    const int w = F.wave;
    for (int q = F.vcu; q < 64; q += F.G) {
        const unsigned lane = (unsigned)pg8::mk_lane(), tid = (unsigned)w * 64u + lane, hl = lane >> 5, l31 = lane & 31u;
        const unsigned I1 = ((unsigned)w >> 1) & 1u, J = (unsigned)w & 1u;
        {   const GAS char* u0 = PU + ((size_t)q * 2 + 1) * 16384; GAS char* so = SST + ((size_t)q * NCHUNK + 1) * 16384;
            const f32x4 t0 = *(const GAS f32x4*)(u0 + tid * 32u), t1 = *(const GAS f32x4*)(u0 + tid * 32u + 16u);
            *((LAS f32x4*)TbB + tid * 2) = t0; *((LAS f32x4*)TbB + tid * 2 + 1) = t1;
            *(GAS f32x4*)(so + tid * 32u) = t0; *(GAS f32x4*)(so + tid * 32u + 16u) = t1; }
        f32x4 pn0, pn1; f32x16 un;
        {   const GAS char* pg = PU + (((size_t)q + 64) * 2 + 0) * 16384; pn0 = *(const GAS f32x4*)(pg + tid * 32u); pn1 = *(const GAS f32x4*)(pg + tid * 32u + 16u);
            const unsigned pb = (tid >> 3) * 65u + (tid & 7u) * 8u;
#pragma unroll
            for (int e = 0; e < 4; ++e) { PiB[pb + e] = pn0[e]; PiB[pb + 4 + e] = pn1[e]; }
            const GAS char* ug = PU + (((size_t)q + 64) * 2 + 1) * 16384;
#pragma unroll
            for (int r = 0; r < 16; ++r) un[r] = (w < 4) ? *(const GAS float*)(ug + ((32u * I1 + 8u * (r >> 2) + 4u * hl + (r & 3)) * 64u + 32u * J + l31) * 4u) : 0.f; }
        __syncthreads();
        for (int c = 1; c < 32; ++c) {
            const LAS float* Pi = PiB + ((c - 1) & 1) * 4160; const LAS float* Tb = TbB + ((c - 1) & 1) * 4096;
            LAS float* PiN = PiB + (c & 1) * 4160; LAS float* TbN = TbB + (c & 1) * 4096;
            f32x16 acc = un;
            if (c + 1 < 32) {
                const GAS char* pg = PU + (((size_t)q + 64 * (c + 1)) * 2 + 0) * 16384; pn0 = *(const GAS f32x4*)(pg + tid * 32u); pn1 = *(const GAS f32x4*)(pg + tid * 32u + 16u);
                const GAS char* ug = PU + (((size_t)q + 64 * (c + 1)) * 2 + 1) * 16384;
                if (w < 4) {
#pragma unroll
                    for (int r = 0; r < 16; ++r) un[r] = *(const GAS float*)(ug + ((32u * I1 + 8u * (r >> 2) + 4u * hl + (r & 3)) * 64u + 32u * J + l31) * 4u); }
            }
            if (w < 4) {
#pragma unroll
                for (int s2 = 0; s2 < 32; ++s2) { const float av = Pi[(32u * I1 + l31) * 65u + 2u * s2 + hl], bv = Tb[(2u * s2 + hl) * 64u + 32u * J + l31];
                    acc = __builtin_amdgcn_mfma_f32_32x32x2f32(av, bv, acc, 0, 0, 0);
                    if ((s2 & 7) == 7) MK_FENCE(); }
                GAS char* so = SST + ((size_t)q * NCHUNK + c + 1) * 16384;
#pragma unroll
                for (int r = 0; r < 16; ++r) { const unsigned e = (32u * I1 + 8u * (r >> 2) + 4u * hl + (r & 3)) * 64u + 32u * J + l31; TbN[e] = acc[r]; *(GAS float*)(so + e * 4u) = acc[r]; }
            }
            if (c + 1 < 32) { const unsigned pb = (tid >> 3) * 65u + (tid & 7u) * 8u;
#pragma unroll
                for (int e = 0; e < 4; ++e) { PiN[pb + e] = pn0[e]; PiN[pb + 4 + e] = pn1[e]; } }
            __syncthreads();
        }
    }
}
__device__ __forceinline__ void p7_scanC(Frame& F) {
    const unsigned char* PKB = F.ws + WS_PK; const bf16* VB = (const bf16*)(F.ws + WS_VBUF);
    const float* SST = (const float*)(F.ws + WS_SST); bf16* YS = (bf16*)(F.ws + WS_YS);
    LAS unsigned char* my = F.lds + RING_OFF + F.wave * (REC_BYTES + SCAN_SCR);
    LAS unsigned char* scr = my + REC_BYTES;
    for (int unit = F.vcu * NWAVES + F.wave; unit < 2048; unit += F.G * NWAVES) {
        const int d = unit & 1, h = (unit >> 1) & 31, c = (unit >> 6) + 1, q = unit & 63;
        const int lane = pg8::mk_lane(), hl = lane >> 5, l31 = lane & 31, l15 = lane & 15;
        f32x16 Tt[2][2];
        {   const float* s0 = SST + ((size_t)q * NCHUNK + c) * 4096;
#pragma unroll
            for (int I = 0; I < 2; ++I)
#pragma unroll
                for (int J = 0; J < 2; ++J)
#pragma unroll
                    for (int reg = 0; reg < 16; ++reg) Tt[I][J][reg] = *(const GAS float*)(s0 + (32 * I + 8 * (reg >> 2) + 4 * hl + (reg & 3)) * 64 + 32 * J + l31); }
        RecRegs R;
        scan_rload(PKB, d, h, scan_blkbase(d, c, 0), lane, R);
#pragma unroll 1
        for (int j = 0; j < 16; ++j) {
            const int tb = scan_blkbase(d, c, j);
            scan_rstore(my, lane, R);
            float Vv[16];
            {   const GAS bf16* gv = (const GAS bf16*)(VB + (size_t)(tb + (d == 0 ? 0 : 15)) * 2048 + h * 64) + lane; const int dstep = d == 0 ? 2048 : -2048;
#pragma unroll
                for (int t = 0; t < 16; ++t) Vv[t] = __builtin_bit_cast(float, (unsigned)gv[t * dstep] << 16); }
            const LAS unsigned char* arow = my + l15 * 128 + hl * 16;
            {   f32x16 Lab = zero16(), Lak = zero16(), Mrb = zero16(), Mrk = zero16();
#pragma unroll
                for (int qq = 0; qq < 4; ++qq) { const bf16x8 af = *(const LAS bf16x8*)(arow + qq * 32), rf = *(const LAS bf16x8*)(arow + 2048 + qq * 32), bf = *(const LAS bf16x8*)(arow + 4096 + qq * 32), kf = *(const LAS bf16x8*)(arow + 6144 + qq * 32);
                    Lab = MK_MFMA(af, bf, Lab); Lak = MK_MFMA(af, kf, Lak); Mrb = MK_MFMA(rf, bf, Mrb); Mrk = MK_MFMA(rf, kf, Mrk); }
                if (l31 < 16) {
                    LAS float* lb = (LAS float*)scr + 64 * hl + l31; LAS unsigned short* mb = (LAS unsigned short*)scr + 64 * hl + l31; const int lm = l31 - 4 * hl;
#pragma unroll
                    for (int r = 0; r < 8; ++r) { const int t0 = 8 * (r >> 2) + (r & 3);
                        lb[SCR_LAB / 4 + t0 * 16] = Lab[r]; lb[SCR_LAK / 4 + t0 * 16] = Lak[r];
                        mb[SCR_MRB / 2 + t0 * 16] = (unsigned short)f2bf(lm <= t0 ? Mrb[r] : 0.f); mb[SCR_MRK / 2 + t0 * 16] = (unsigned short)f2bf(lm <= t0 ? Mrk[r] : 0.f); }
                }
            }
            MK_FENCE();
            f32x16 G[2], Y[2];
            {   bf16x8 Tf[2][2][2]; scan_tfrags(Tt, Tf);
                G[0] = zero16(); G[1] = zero16(); Y[0] = zero16(); Y[1] = zero16();
#pragma unroll
                for (int qq = 0; qq < 4; ++qq) { const bf16x8 af = *(const LAS bf16x8*)(arow + qq * 32), rf = *(const LAS bf16x8*)(arow + 2048 + qq * 32);
                    G[0] = MK_MFMA(af, Tf[qq >> 1][0][qq & 1], G[0]); G[1] = MK_MFMA(af, Tf[qq >> 1][1][qq & 1], G[1]);
                    Y[0] = MK_MFMA(rf, Tf[qq >> 1][0][qq & 1], Y[0]); Y[1] = MK_MFMA(rf, Tf[qq >> 1][1][qq & 1], Y[1]); }
            }
            MK_FENCE();
            if (j + 1 < 16) scan_rload(PKB, d, h, scan_blkbase(d, c, j + 1), lane, R);
            float S[16];
#pragma unroll
            for (int r = 0; r < 8; ++r) { float x = G[0][r], y = G[1][r]; swap32(x, y); const int t = 8 * (r >> 2) + (r & 3); S[t] = x; S[t + 4] = y; }
#pragma unroll
            for (int t = 1; t < 16; ++t) {
                float acc = S[t], acc1 = 0.f, acc2 = 0.f, acc3 = 0.f;
#pragma unroll
                for (int s4 = 0; s4 < (t + 3) / 4; ++s4) { const f32x4 la = *(const LAS f32x4*)(scr + SCR_LAB + (t * 16 + 4 * s4) * 4), lk = *(const LAS f32x4*)(scr + SCR_LAK + (t * 16 + 4 * s4) * 4);
#pragma unroll
                    for (int e = 0; e < 4; ++e) if (4 * s4 + e < t) { if (e & 1) { acc1 += la[e] * S[4 * s4 + e]; acc3 += lk[e] * Vv[4 * s4 + e]; } else { acc += la[e] * S[4 * s4 + e]; acc2 += lk[e] * Vv[4 * s4 + e]; } } }
                S[t] = (acc + acc1) + (acc2 + acc3);
            }
            bf16x8 Sf[2], Vf[2]; scan_sfrags(S, Sf); scan_sfrags(Vv, Vf);
            {   const bf16x8 mb = *(const LAS bf16x8*)(scr + SCR_MRB + l15 * 32 + hl * 16), mk = *(const LAS bf16x8*)(scr + SCR_MRK + l15 * 32 + hl * 16);
                Y[0] = MK_MFMA(mb, Sf[0], Y[0]); Y[1] = MK_MFMA(mb, Sf[1], Y[1]); Y[0] = MK_MFMA(mk, Vf[0], Y[0]); Y[1] = MK_MFMA(mk, Vf[1], Y[1]); }
#pragma unroll
            for (int I = 0; I < 2; ++I) {
                const LAS unsigned char* col = my + 4096 + (8 * hl) * 128 + kperm(32 * I + l31) * 2;
                unsigned short bs[8], ks[8];
#pragma unroll
                for (int e = 0; e < 8; ++e) { bs[e] = *(const LAS unsigned short*)(col + e * 128); ks[e] = *(const LAS unsigned short*)(col + 2048 + e * 128); }
                const v4u bu = {(unsigned)bs[0] | ((unsigned)bs[1] << 16), (unsigned)bs[2] | ((unsigned)bs[3] << 16), (unsigned)bs[4] | ((unsigned)bs[5] << 16), (unsigned)bs[6] | ((unsigned)bs[7] << 16)};
                const v4u ku = {(unsigned)ks[0] | ((unsigned)ks[1] << 16), (unsigned)ks[2] | ((unsigned)ks[3] << 16), (unsigned)ks[4] | ((unsigned)ks[5] << 16), (unsigned)ks[6] | ((unsigned)ks[7] << 16)};
                const bf16x8 ba = __builtin_bit_cast(bf16x8, bu), ka = __builtin_bit_cast(bf16x8, ku);
                Tt[I][0] = MK_MFMA(ba, Sf[0], Tt[I][0]); Tt[I][1] = MK_MFMA(ba, Sf[1], Tt[I][1]); Tt[I][0] = MK_MFMA(ka, Vf[0], Tt[I][0]); Tt[I][1] = MK_MFMA(ka, Vf[1], Tt[I][1]);
            }
            {   GAS bf16* yb = (GAS bf16*)(YS + (size_t)d * T * 2048 + (size_t)(tb + (d == 0 ? 4 * hl : 15 - 4 * hl)) * 2048 + h * 64) + l31; const int ystep = d == 0 ? 2048 : -2048;
#pragma unroll
                for (int J = 0; J < 2; ++J)
#pragma unroll
                    for (int r = 0; r < 8; ++r) yb[(8 * (r >> 2) + (r & 3)) * ystep + 32 * J] = (bf16)f2bf(Y[J][r]); }
            scan_renorm(Tt, (const LAS float*)(my + 8192), hl);
        }
    }
}

__device__ __forceinline__ void p8_readout(Frame& F) {
    const bf16* RB = (const bf16*)(F.ws + WS_RBUF); const bf16* VB = (const bf16*)(F.ws + WS_VBUF); const bf16* YS = (const bf16*)(F.ws + WS_YS);
    const bf16* KD = (const bf16*)(F.ws + WS_KD);
    const bf16* G = (const bf16*)(F.ws + WS_G); bf16* CAT = (bf16*)(F.ws + WS_CAT);
    const int tpb = (T + F.G - 1) / F.G, tok0 = F.vcu * tpb, lane = pg8::mk_lane();
    for (int it = F.wave; it < tpb * 4; it += NWAVES) {
        const int j = it / tpb, tok = tok0 + it % tpb;
        if (tok >= T) continue;
        const int c = j * 512 + lane * 8;
        float y0[8], y1[8], y[8];
        ld8(YS + (size_t)tok * 2048 + c, y0); ld8(YS + ((size_t)T + tok) * 2048 + c, y1);
        float s = 0.f;
#pragma unroll
        for (int i = 0; i < 8; ++i) { y[i] = y0[i] + y1[i]; s += y[i]; }
        s += __shfl_xor(s, 1); s += __shfl_xor(s, 2); s += __shfl_xor(s, 4);
        const float mean = s * (1.0f / 64.0f); float q = 0.f;
#pragma unroll
        for (int i = 0; i < 8; ++i) { const float dlt = y[i] - mean; q += dlt * dlt; }
        q += __shfl_xor(q, 1); q += __shfl_xor(q, 2); q += __shfl_xor(q, 4);
        const float rstd = 1.0f / sqrtf(q * (1.0f / 64.0f) + LNX_EPS);
        float r8[8], v8[8], k0[8], k1[8], rk[8], lw[8], lb[8], g8[8];
        ld8(RB + (size_t)tok * 2048 + c, r8); ld8(VB + (size_t)tok * 2048 + c, v8);
        ld8(KD + (size_t)tok * 2048 + c, k0); ld8(KD + ((size_t)TT + tok) * 2048 + c, k1);
        ldf8(F.in[I_RK] + c, rk); ldf8(F.in[I_LNXW] + c, lw); ldf8(F.in[I_LNXB] + c, lb);
        ld8(G + (size_t)tok * 2048 + c, g8);
        float dot = 0.f;
#pragma unroll
        for (int i = 0; i < 8; ++i) dot += r8[i] * (k0[i] + k1[i]) * rk[i];
        dot += __shfl_xor(dot, 1); dot += __shfl_xor(dot, 2); dot += __shfl_xor(dot, 4);
        float o[8];
#pragma unroll
        for (int i = 0; i < 8; ++i) o[i] = ((y[i] - mean) * rstd * lw[i] + lb[i] + dot * v8[i]) * g8[i];
        stb8(CAT + (size_t)tok * D + c, o);
    }
}

template <int K> __device__ __forceinline__ void run_phase(Frame& F) {
    bf16* A1 = (bf16*)(F.ws + WS_A1); bf16* Zb = (bf16*)(F.ws + WS_Z);
    const float* MV = (const float*)(F.ws + WS_MODV);
    (void)A1; (void)Zb; (void)MV;
    asm volatile("; MK_PHASE %0" :: "i"(K) : "memory");
    if constexpr (K == 0) { p0_prologue(F);
    }
    if constexpr (K == 1) { p1_norm1(F);
    }
    if constexpr (K == 2) {
        { pg8::Gemm g{A1, (const bf16*)(F.ws + WS_WIN), T, NZ, D}; pg8::StaticOrder S; S.init(T, NZ, F.G, (int)blockIdx.x);
          pg8::EpiBf16<0> E{Zb, NZ, nullptr, 0, 0, 1.f};
          pg8::gemm_phase<pg8::EpiBf16<0>, pg8::StaticOrder, true, true>(F.lds + RING_OFF, g, S, E, F.wave); }
        { pg8::Gemm g{A1 + (size_t)T * D, (const bf16*)(F.ws + WS_WIN), CTXL, NCTXZ, D}; pg8::StaticOrder S; S.init(CTXL, NCTXZ, F.G, (int)((blockIdx.x + F.G - 64) % F.G));
          pg8::EpiBf16<0> E{Zb + (size_t)T * NZ, NZ, nullptr, 0, 0, 1.f};
          pg8::gemm_phase<pg8::EpiBf16<0>, pg8::StaticOrder, true, true>(F.lds + RING_OFF, g, S, E, F.wave); }
        tr_idle(F, P2T_B, P2T_E, (int)blockIdx.x - 81, 175);
    }
    if constexpr (K == 3) { p3_prep(F);
    }
    if constexpr (K == 4) {
        { int kl = KLORA; asm volatile("" : "+s"(kl));
          pg8::Gemm g{(const bf16*)(F.ws + WS_ALORA), (const bf16*)(F.ws + WS_WLORA), TT, NLORA, kl}; pg8::StaticOrder S; S.init(TT, NLORA, F.G, (int)blockIdx.x);
          pg8::EpiLora E{F.ws + WS_PK, (bf16*)(F.ws + WS_KD), (const bf16*)(F.ws + WS_KBUF), (const bf16*)(F.ws + WS_KKBUF), (const bf16*)(F.ws + WS_RBUF), F.in[I_W0], F.in[I_A0], F.in[I_KA], TT};
          pg8::gemm_phase<pg8::EpiLora, pg8::StaticOrder, true, true>(F.lds + RING_OFF, g, S, E, F.wave); }
        { int kl = KGATE; asm volatile("" : "+s"(kl));
          pg8::Gemm g{(const bf16*)(F.ws + WS_AGATE), (const bf16*)(F.ws + WS_WGATE), T, DR, kl}; pg8::StaticOrder S;
          if (F.G == 256) S.init(T, DR, 224, blockIdx.x >= 32 ? (int)blockIdx.x - 32 : 1 << 20); else S.init(T, DR, F.G, (int)blockIdx.x);
          pg8::EpiBf16<0> E{(bf16*)(F.ws + WS_G), DR, nullptr, 0, 0, 1.f};
          pg8::gemm_phase<pg8::EpiBf16<0>, pg8::StaticOrder, true, true>(F.lds + RING_OFF, g, S, E, F.wave); }

    }
    if constexpr (K == 5) { p5_scanA(F);
    }
    if constexpr (K == 6) { p6_scanB(F); tr_idle(F, P6T_B, P6T_E, F.vcu - 64, 192);

    }
    if constexpr (K == 7) { p7_scanC(F);
    }
    if constexpr (K == 8) { p8_readout(F);
    }
    if constexpr (K == 9) {
        pg8::Gemm g{(const bf16*)(F.ws + WS_CAT), (const bf16*)(F.ws + WS_WOUT), T, D, D}; pg8::StaticOrder S; S.init(T, D, F.G, (int)blockIdx.x);
        pg8::EpiResid E{F.in[I_X], (float*)(F.ws + WS_X1), D, MV + 2 * D};
        pg8::gemm_phase<pg8::EpiResid, pg8::StaticOrder, true, true>(F.lds + RING_OFF, g, S, E, F.wave);

    }
    if constexpr (K == 10) { p10_norm2(F);
    }
    if constexpr (K == 11) {
        pg8::Gemm g{A1, (const bf16*)(F.ws + WS_WGU), T, NGU, D}; pg8::StaticOrder S; S.init(T, NGU, F.G, (int)blockIdx.x);
        pg8::EpiSwiglu E{(bf16*)(F.ws + WS_ACT), DFF};
        pg8::gemm_phase<pg8::EpiSwiglu, pg8::StaticOrder, true, true>(F.lds + RING_OFF, g, S, E, F.wave);
        tr_idle(F, P11T_B, P11T_E, (int)blockIdx.x - 192, 64);
    }
    if constexpr (K == 12) {
        pg8::Gemm g{(const bf16*)(F.ws + WS_ACT), (const bf16*)(F.ws + WS_WDN), T, D, DFF}; pg8::StaticOrder S; S.init(T, D, F.G, (int)blockIdx.x);
        pg8::EpiResid E{(const float*)(F.ws + WS_X1), F.out, D, MV + 5 * D};
        pg8::gemm_phase<pg8::EpiResid, pg8::StaticOrder, true, true>(F.lds + RING_OFF, g, S, E, F.wave);

    }
    if constexpr (K == 13) { p13_final(F);
    }
}

struct Args { const float* in[26]; float* out; unsigned char* ws; int ph_lo, ph_hi, li, pad; };
__global__ void __launch_bounds__(NWAVES * 64, 2) mk_fwd(Args args) {
    extern __shared__ __attribute__((aligned(16))) unsigned char lds[];
    Frame F;
    F.lds = (LAS unsigned char*)lds;
    F.MISC = (volatile LAS unsigned*)(F.lds + MISC_OFF);
    F.wave = __builtin_amdgcn_readfirstlane((int)(threadIdx.x >> 6));
    F.G = gridDim.x; { const int bx = blockIdx.x; F.vcu = (F.G % 8 == 0) ? (bx % 8) * (F.G / 8) + bx / 8 : bx; }
    F.ws = args.ws; F.ctl = (gu32*)(args.ws + WS_CTL); F.out = args.out;
#pragma unroll
    for (int i = 0; i < 26; ++i) F.in[i] = args.in[i];
    for (int u = threadIdx.x; u < (LDS_BYTES - LDSCTL_OFF) / 4; u += NWAVES * 64) ((LAS unsigned*)(F.lds + LDSCTL_OFF))[u] = 0u;
    __syncthreads();
    XcdBarrier bar; bar.bar = (unsigned*)(F.ctl + CW_BAR); bar.x = 0; bar.st = nullptr;
    if (N_LAUNCHES == 1) bar = xcd_barrier_post((unsigned*)(F.ctl + CW_BAR), F.MISC + 8);
#define GRID_BAR() do { if (N_LAUNCHES == 1) xcd_barrier(bar, F.wave); } while (0)
    unsigned long long tp0 = 0, tpa = 0, tpb = 0; (void)tp0;
    const int lo = args.ph_lo, hi = args.ph_hi;
#define IN(k) (lo <= (k) && (k) < hi)
#define BOTH(k) (IN(k) && IN((k) + 1))

    if (IN(0)) { if constexpr (0 == TPA || 0 == TPB) tp0 = __builtin_amdgcn_s_memrealtime(); run_phase<0>(F); if constexpr (PH_REPS[0] > 1) { GRID_BAR(); run_phase<0>(F); } if constexpr (PH_REPS[0] > 2) { GRID_BAR(); run_phase<0>(F); } if (BOTH(0)) GRID_BAR(); if constexpr (0 == TPA) tpa = __builtin_amdgcn_s_memrealtime() - tp0; if constexpr (0 == TPB) tpb = __builtin_amdgcn_s_memrealtime() - tp0; }
    if (IN(1)) { if constexpr (1 == TPA || 1 == TPB) tp0 = __builtin_amdgcn_s_memrealtime(); run_phase<1>(F); if constexpr (PH_REPS[1] > 1) { GRID_BAR(); run_phase<1>(F); } if constexpr (PH_REPS[1] > 2) { GRID_BAR(); run_phase<1>(F); } if (BOTH(1)) GRID_BAR(); if constexpr (1 == TPA) tpa = __builtin_amdgcn_s_memrealtime() - tp0; if constexpr (1 == TPB) tpb = __builtin_amdgcn_s_memrealtime() - tp0; }
    if (IN(2)) { if constexpr (2 == TPA || 2 == TPB) tp0 = __builtin_amdgcn_s_memrealtime(); run_phase<2>(F); if constexpr (PH_REPS[2] > 1) { GRID_BAR(); run_phase<2>(F); } if constexpr (PH_REPS[2] > 2) { GRID_BAR(); run_phase<2>(F); } if (BOTH(2)) GRID_BAR(); if constexpr (2 == TPA) tpa = __builtin_amdgcn_s_memrealtime() - tp0; if constexpr (2 == TPB) tpb = __builtin_amdgcn_s_memrealtime() - tp0; }
    if (IN(3)) { if constexpr (3 == TPA || 3 == TPB) tp0 = __builtin_amdgcn_s_memrealtime(); run_phase<3>(F); if constexpr (PH_REPS[3] > 1) { GRID_BAR(); run_phase<3>(F); } if constexpr (PH_REPS[3] > 2) { GRID_BAR(); run_phase<3>(F); } if (BOTH(3)) GRID_BAR(); if constexpr (3 == TPA) tpa = __builtin_amdgcn_s_memrealtime() - tp0; if constexpr (3 == TPB) tpb = __builtin_amdgcn_s_memrealtime() - tp0; }
    if (IN(4)) { if constexpr (4 == TPA || 4 == TPB) tp0 = __builtin_amdgcn_s_memrealtime(); run_phase<4>(F); if constexpr (PH_REPS[4] > 1) { GRID_BAR(); run_phase<4>(F); } if constexpr (PH_REPS[4] > 2) { GRID_BAR(); run_phase<4>(F); } if (BOTH(4)) GRID_BAR(); if constexpr (4 == TPA) tpa = __builtin_amdgcn_s_memrealtime() - tp0; if constexpr (4 == TPB) tpb = __builtin_amdgcn_s_memrealtime() - tp0; }
    if (IN(5)) { if constexpr (5 == TPA || 5 == TPB) tp0 = __builtin_amdgcn_s_memrealtime(); run_phase<5>(F); if constexpr (PH_REPS[5] > 1) { GRID_BAR(); run_phase<5>(F); } if constexpr (PH_REPS[5] > 2) { GRID_BAR(); run_phase<5>(F); } if (BOTH(5)) GRID_BAR(); if constexpr (5 == TPA) tpa = __builtin_amdgcn_s_memrealtime() - tp0; if constexpr (5 == TPB) tpb = __builtin_amdgcn_s_memrealtime() - tp0; }
    if (IN(6)) { if constexpr (6 == TPA || 6 == TPB) tp0 = __builtin_amdgcn_s_memrealtime(); run_phase<6>(F); if constexpr (PH_REPS[6] > 1) { GRID_BAR(); run_phase<6>(F); } if constexpr (PH_REPS[6] > 2) { GRID_BAR(); run_phase<6>(F); } if (BOTH(6)) GRID_BAR(); if constexpr (6 == TPA) tpa = __builtin_amdgcn_s_memrealtime() - tp0; if constexpr (6 == TPB) tpb = __builtin_amdgcn_s_memrealtime() - tp0; }
    if (IN(7)) { if constexpr (7 == TPA || 7 == TPB) tp0 = __builtin_amdgcn_s_memrealtime(); run_phase<7>(F); if constexpr (PH_REPS[7] > 1) { GRID_BAR(); run_phase<7>(F); } if constexpr (PH_REPS[7] > 2) { GRID_BAR(); run_phase<7>(F); } if (BOTH(7)) GRID_BAR(); if constexpr (7 == TPA) tpa = __builtin_amdgcn_s_memrealtime() - tp0; if constexpr (7 == TPB) tpb = __builtin_amdgcn_s_memrealtime() - tp0; }
    if (IN(8)) { if constexpr (8 == TPA || 8 == TPB) tp0 = __builtin_amdgcn_s_memrealtime(); run_phase<8>(F); if constexpr (PH_REPS[8] > 1) { GRID_BAR(); run_phase<8>(F); } if constexpr (PH_REPS[8] > 2) { GRID_BAR(); run_phase<8>(F); } if (BOTH(8)) GRID_BAR(); if constexpr (8 == TPA) tpa = __builtin_amdgcn_s_memrealtime() - tp0; if constexpr (8 == TPB) tpb = __builtin_amdgcn_s_memrealtime() - tp0; }
    if (IN(9)) { if constexpr (9 == TPA || 9 == TPB) tp0 = __builtin_amdgcn_s_memrealtime(); run_phase<9>(F); if constexpr (PH_REPS[9] > 1) { GRID_BAR(); run_phase<9>(F); } if constexpr (PH_REPS[9] > 2) { GRID_BAR(); run_phase<9>(F); } if (BOTH(9)) GRID_BAR(); if constexpr (9 == TPA) tpa = __builtin_amdgcn_s_memrealtime() - tp0; if constexpr (9 == TPB) tpb = __builtin_amdgcn_s_memrealtime() - tp0; }
    if (IN(10)) { if constexpr (10 == TPA || 10 == TPB) tp0 = __builtin_amdgcn_s_memrealtime(); run_phase<10>(F); if constexpr (PH_REPS[10] > 1) { GRID_BAR(); run_phase<10>(F); } if constexpr (PH_REPS[10] > 2) { GRID_BAR(); run_phase<10>(F); } if (BOTH(10)) GRID_BAR(); if constexpr (10 == TPA) tpa = __builtin_amdgcn_s_memrealtime() - tp0; if constexpr (10 == TPB) tpb = __builtin_amdgcn_s_memrealtime() - tp0; }
    if (IN(11)) { if constexpr (11 == TPA || 11 == TPB) tp0 = __builtin_amdgcn_s_memrealtime(); run_phase<11>(F); if constexpr (PH_REPS[11] > 1) { GRID_BAR(); run_phase<11>(F); } if constexpr (PH_REPS[11] > 2) { GRID_BAR(); run_phase<11>(F); } if (BOTH(11)) GRID_BAR(); if constexpr (11 == TPA) tpa = __builtin_amdgcn_s_memrealtime() - tp0; if constexpr (11 == TPB) tpb = __builtin_amdgcn_s_memrealtime() - tp0; }
    if (IN(12)) { if constexpr (12 == TPA || 12 == TPB) tp0 = __builtin_amdgcn_s_memrealtime(); run_phase<12>(F); if constexpr (PH_REPS[12] > 1) { GRID_BAR(); run_phase<12>(F); } if constexpr (PH_REPS[12] > 2) { GRID_BAR(); run_phase<12>(F); } if (BOTH(12)) GRID_BAR(); if constexpr (12 == TPA) tpa = __builtin_amdgcn_s_memrealtime() - tp0; if constexpr (12 == TPB) tpb = __builtin_amdgcn_s_memrealtime() - tp0; }
    if (IN(13)) { if constexpr (13 == TPA || 13 == TPB) tp0 = __builtin_amdgcn_s_memrealtime(); run_phase<13>(F); if constexpr (PH_REPS[13] > 1) { GRID_BAR(); run_phase<13>(F); } if constexpr (PH_REPS[13] > 2) { GRID_BAR(); run_phase<13>(F); } if (BOTH(13)) GRID_BAR(); if constexpr (13 == TPA) tpa = __builtin_amdgcn_s_memrealtime() - tp0; if constexpr (13 == TPB) tpb = __builtin_amdgcn_s_memrealtime() - tp0; }
    if constexpr (TPA >= 0 || TPB >= 0) {
        if (blockIdx.x == 0 && F.wave == 0) { const unsigned long long ua = (tpa + 500ull) / 1000ull, ub = (tpb + 500ull) / 1000ull, extra = ua * 100000ull + ub * 1000ull, t1 = __builtin_amdgcn_s_memrealtime();
            while (__builtin_amdgcn_s_memrealtime() - t1 < extra) __builtin_amdgcn_s_sleep(16); }
    }
#undef IN
#undef BOTH
}

extern "C" void kernel_launch(void* const* d_in, const int* in_sizes, int n_in, void* d_out, int out_size, void* d_ws, size_t ws_size, hipStream_t stream) {
    static int grid = 0;
    if (grid == 0) {
        if (n_in != 26 || out_size != T * D || ws_size < WS_END) { fprintf(stderr, "kernel_launch: unexpected shapes: n_in %d out %d ws %zu (need %zu)\n", n_in, out_size, ws_size, (size_t)WS_END); grid = -1; return; }
        int dev = 0, cus = 0, per_cu = 0;
        if (hipGetDevice(&dev) != hipSuccess || hipDeviceGetAttribute(&cus, hipDeviceAttributeMultiprocessorCount, dev) != hipSuccess) { grid = -1; return; }
        if (hipFuncSetAttribute((const void*)mk_fwd, hipFuncAttributeMaxDynamicSharedMemorySize, LDS_BYTES) != hipSuccess) { fprintf(stderr, "kernel_launch: hipFuncSetAttribute failed\n"); grid = -1; return; }
        if (hipOccupancyMaxActiveBlocksPerMultiprocessor(&per_cu, (const void*)mk_fwd, NWAVES * 64, LDS_BYTES) != hipSuccess || per_cu < 1)
            fprintf(stderr, "kernel_launch: note: occupancy query reports %d workgroups per CU\n", per_cu);
        (void)hipGetLastError();
        grid = cus;
    }
    if (grid < 0) return;
    if (hipMemsetAsync((char*)d_ws + WS_CTL, 0, CTL_ZERO_BYTES, stream) != hipSuccess) return;
    Args a{};
    for (int i = 0; i < 26; ++i) a.in[i] = (const float*)d_in[i];
    a.out = (float*)d_out; a.ws = (unsigned char*)d_ws;
    for (int li = 0; li < N_LAUNCHES; ++li) {
        if (N_LAUNCHES == 1) { a.ph_lo = 0; a.ph_hi = N_PHASES; } else { a.ph_lo = li * N_PHASES / N_LAUNCHES; a.ph_hi = (li + 1) * N_PHASES / N_LAUNCHES; }
        a.li = li;
        hipLaunchKernelGGL(mk_fwd, dim3(grid), dim3(NWAVES * 64), LDS_BYTES, stream, a);
        if (hipPeekAtLastError() != hipSuccess) break;
    }
}
```

```cpp
#include <hip/hip_runtime.h>
#include <cstdio>
#include <cstdint>
namespace pg8 {
#define PG8_LAS __attribute__((address_space(3)))
typedef unsigned short bf16_t;
typedef short bf16x8 __attribute__((ext_vector_type(8)));
typedef float f32x4 __attribute__((ext_vector_type(4)));
typedef unsigned u32x4 __attribute__((ext_vector_type(4)));
constexpr int BM = 256, BK = 64, HALF = 128, HTB = HALF * BK * 2  , STAGE_BYTES = 8 * HTB, NXCD = 8, WGM = 8;

__host__ __device__ __forceinline__ int lds_byte(int r, int c) { const int st = (r >> 4) * 2 + (c >> 5), rr = r & 15, cc = c & 31, ob = rr * 64 + cc * 2; return st * 1024 + (ob ^ (((ob >> 9) & 1) << 5)); }
__host__ __device__ __forceinline__ void stage_rc(int b, int& R, int& C) { const int st = b / 1024, sb = b % 1024, swz = sb ^ (((sb >> 9) & 1) << 5); R = (st >> 1) * 16 + swz / 64; C = (st & 1) * 32 + (swz % 64) / 2; }
__host__ __device__ __forceinline__ int perm32(int rho) { const int n = rho >> 4, i = rho & 15; return 8 * (i >> 2) + 4 * n + (i & 3); }

__device__ __forceinline__ int mk_lane() { int l; asm volatile("v_mbcnt_lo_u32_b32 %0, -1, 0\n\tv_mbcnt_hi_u32_b32 %0, -1, %0" : "=v"(l)); return l; }
struct Unit { int pm, pn; };
struct Gemm { const bf16_t* A; const bf16_t* Bt; int M, N, K; };

struct StaticOrder {
    int nM, nN, nwg, G, c;
    __host__ __device__ void init(int M, int N, int G_, int c_) { nM = M / BM; nN = N / BM; nwg = nM * nN; G = G_; c = c_; }
    __host__ __device__ bool next(int i, Unit& u) const {
        const long L = (long)i * G + c; if (L >= nwg) return false;
        int wgid = (int)L; { const int q = nwg / NXCD, r = nwg % NXCD, xcd = wgid % NXCD, off = wgid / NXCD; wgid = (xcd < r ? xcd * (q + 1) : r * (q + 1) + (xcd - r) * q) + off; }
        const int nig = WGM * nN, gid = wgid / nig, fm = gid * WGM, gsz = (nM - fm) < WGM ? (nM - fm) : WGM;
        u.pm = fm + ((wgid % nig) % gsz); u.pn = (wgid % nig) / gsz; return true;
    }
    __device__ __forceinline__ void a_ready(const Unit&) const {}
    __device__ __forceinline__ void done(const Unit&) const {}
};

__device__ __forceinline__ unsigned cvt_pk_bf16(float lo, float hi) { unsigned r; asm volatile("v_cvt_pk_bf16_f32 %0, %1, %2" : "=v"(r) : "v"(lo), "v"(hi)); return r; }
typedef float f32x2 __attribute__((ext_vector_type(2)));
__device__ __forceinline__ f32x2 gelu_pk(f32x2 v) {
    const f32x2 av = __builtin_elementwise_abs(v), d = av * 0.2316418882f + 1.0f;
    f32x2 t; t.x = __builtin_amdgcn_rcpf(d.x); t.y = __builtin_amdgcn_rcpf(d.y);
    f32x2 q = t * 0.5307027145f + (-0.7265760135f); q = q * t + 0.7107068705f; q = q * t + (-0.142248368f); q = q * t + 0.127414796f; q = q * t;
    const f32x2 s = (v * v) * (-0.72134752044f);
    f32x2 e; e.x = __builtin_amdgcn_exp2f(s.x); e.y = __builtin_amdgcn_exp2f(s.y);
    const f32x2 m = v * (q * e), r = v - m;
    f32x2 o; o.x = v.x < 0.f ? m.x : r.x; o.y = v.y < 0.f ? m.y : r.y; return o;
}

template <int ACT  > struct EpiBf16 {
    static constexpr bool PERM = true, AFTER_DRAIN = false; static_assert(ACT == 0 || ACT == 1, "EpiBf16: ACT is 0 (none) or 1 (gelu_pk)");
    bf16_t* O; int ldc; const float* bias; int split_cols; size_t split_stride; float scale0;
    __device__ __forceinline__ void operator()(const f32x4 (&acc)[2][2][4][2], const Unit& u, int wr, int wc, int fr, int fq) const {
        const int row0 = u.pm * BM + wr * 64 + fr; int colt = u.pn * BM; bf16_t* base = O;
        float sc = 1.f; if (split_cols) { const int t = colt / split_cols; base += (size_t)t * split_stride; colt -= t * split_cols; if (t == 0) sc = scale0; }
        const int col0 = colt + wc * 32 + 8 * fq, bcol0 = u.pn * BM + wc * 32 + 8 * fq;
        f32x4 bv[2][2];
#pragma unroll
        for (int bj = 0; bj < 2; ++bj)
#pragma unroll
            for (int n = 0; n < 2; ++n) bv[bj][n] = bias ? *(const f32x4*)(bias + bcol0 + bj * HALF + 4 * n) : (f32x4){0.f, 0.f, 0.f, 0.f};
#pragma unroll
        for (int ai = 0; ai < 2; ++ai)
#pragma unroll
            for (int m = 0; m < 4; ++m) { bf16_t* rowp = base + (size_t)(row0 + ai * HALF + m * 16) * ldc + col0;
#pragma unroll
                for (int bj = 0; bj < 2; ++bj) { f32x4 v0 = acc[ai][bj][m][0] + bv[bj][0], v1 = acc[ai][bj][m][1] + bv[bj][1];
                    if (ACT == 1) { f32x2 a = gelu_pk((f32x2){v0[0], v0[1]}), b = gelu_pk((f32x2){v0[2], v0[3]}), c = gelu_pk((f32x2){v1[0], v1[1]}), d = gelu_pk((f32x2){v1[2], v1[3]});
                        v0 = (f32x4){a.x, a.y, b.x, b.y}; v1 = (f32x4){c.x, c.y, d.x, d.y}; }
                    v0 = v0 * sc; v1 = v1 * sc; u32x4 w; w.x = cvt_pk_bf16(v0[0], v0[1]); w.y = cvt_pk_bf16(v0[2], v0[3]); w.z = cvt_pk_bf16(v1[0], v1[1]); w.w = cvt_pk_bf16(v1[2], v1[3]);
                    *(u32x4*)(rowp + bj * HALF) = w; } }
    }
};
__device__ __forceinline__ float sigmoidf_(float x) { return __builtin_amdgcn_rcpf(1.0f + __expf(-x)); }
struct EpiResid {
    static constexpr bool PERM = false, AFTER_DRAIN = false;
    const float* base; float* out; int ldc; const float* gvec;
    __device__ __forceinline__ void operator()(const f32x4 (&acc)[2][2][4][2], const Unit& u, int wr, int wc, int fr, int fq) const {
        const int row0 = u.pm * BM + wr * 64 + fr, col0 = u.pn * BM + wc * 32 + 4 * fq;
        f32x4 gv[2][2];
#pragma unroll
        for (int bj = 0; bj < 2; ++bj)
#pragma unroll
            for (int n = 0; n < 2; ++n) gv[bj][n] = *(const __attribute__((address_space(1))) f32x4*)(gvec + col0 + bj * HALF + n * 16);
#pragma unroll
        for (int ai = 0; ai < 2; ++ai)
#pragma unroll
            for (int m = 0; m < 4; ++m) { const size_t off = (size_t)(row0 + ai * HALF + m * 16) * ldc + col0;
#pragma unroll
                for (int bj = 0; bj < 2; ++bj)
#pragma unroll
                    for (int n = 0; n < 2; ++n) { const f32x4 bs = *(const __attribute__((address_space(1))) f32x4*)(base + off + bj * HALF + n * 16);
                        *(__attribute__((address_space(1))) f32x4*)(out + off + bj * HALF + n * 16) = bs + gv[bj][n] * acc[ai][bj][m][n]; }
                if (m & 1) asm volatile("" ::: "memory"); }
    }
};
struct EpiSwiglu {
    static constexpr bool PERM = true, AFTER_DRAIN = false;
    bf16_t* O; int ldc;
    __device__ __forceinline__ void operator()(const f32x4 (&acc)[2][2][4][2], const Unit& u, int wr, int wc, int fr, int fq) const {
        const int row0 = u.pm * BM + wr * 64 + fr, col0 = u.pn * HALF + wc * 32 + 8 * fq;
#pragma unroll
        for (int ai = 0; ai < 2; ++ai)
#pragma unroll
            for (int m = 0; m < 4; ++m) { bf16_t* rowp = O + (size_t)(row0 + ai * HALF + m * 16) * ldc + col0;
                f32x4 h0, h1;
#pragma unroll
                for (int j = 0; j < 4; ++j) { const float g0 = acc[ai][0][m][0][j], g1 = acc[ai][0][m][1][j];
                    h0[j] = g0 * sigmoidf_(g0) * acc[ai][1][m][0][j]; h1[j] = g1 * sigmoidf_(g1) * acc[ai][1][m][1][j]; }
                u32x4 w; w.x = cvt_pk_bf16(h0[0], h0[1]); w.y = cvt_pk_bf16(h0[2], h0[3]); w.z = cvt_pk_bf16(h1[0], h1[1]); w.w = cvt_pk_bf16(h1[2], h1[3]);
                *(__attribute__((address_space(1))) u32x4*)rowp = w; }
    }
};
template <int CTRL> __device__ __forceinline__ float dpp_f(float old, float src) { return __builtin_bit_cast(float, __builtin_amdgcn_update_dpp(__builtin_bit_cast(int, old), __builtin_bit_cast(int, src), CTRL, 0xf, 0xf, false)); }
struct EpiLora {
    static constexpr bool PERM = true, AFTER_DRAIN = false;
    unsigned char* PKB; bf16_t* KD; const bf16_t* kbuf; const bf16_t* kkbuf; const bf16_t* rbuf; const float* w0; const float* a0; const float* k_a; int TT;
    __device__ __forceinline__ void operator()(const f32x4 (&acc)[2][2][4][2], const Unit& u, int wr, int wc, int fr, int fq) const {
        typedef __attribute__((address_space(1))) f32x4 gf4; typedef const __attribute__((address_space(1))) f32x4 cgf4;
        const int d = u.pn >> 4, cg = u.pn & 15;
        const int c8 = cg * HALF + wc * 32 + 8 * fq, h = c8 >> 6, ch = c8 & 63;
        const int row0 = u.pm * BM + wr * 64 + fr;
        f32x4 w0v[2], a0v[2], kav[2];
#pragma unroll
        for (int n = 0; n < 2; ++n) { w0v[n] = *(cgf4*)(w0 + d * 2048 + c8 + 4 * n); a0v[n] = *(cgf4*)(a0 + d * 2048 + c8 + 4 * n); kav[n] = *(cgf4*)(k_a + c8 + 4 * n); }
        typedef unsigned u32x2l __attribute__((ext_vector_type(2))); typedef const __attribute__((address_space(1))) u32x2l cgu2;
        u32x2l kq[2][2], kkq[2][2], rq[2][2];
        { const size_t fo0 = (size_t)row0 * 2048 + c8;
#pragma unroll
          for (int n = 0; n < 2; ++n) { kq[0][n] = *(cgu2*)(kbuf + fo0 + 4 * n); kkq[0][n] = *(cgu2*)(kkbuf + fo0 + 4 * n); rq[0][n] = *(cgu2*)(rbuf + fo0 + 4 * n); } }
#pragma unroll
        for (int it = 0; it < 8; ++it) {
            const int ai = it >> 2, m = it & 3;
            if (it + 1 < 8) { const size_t fo1 = (size_t)(row0 + ((it + 1) >> 2) * HALF + ((it + 1) & 3) * 16) * 2048 + c8;
#pragma unroll
                for (int n = 0; n < 2; ++n) { kq[(it + 1) & 1][n] = *(cgu2*)(kbuf + fo1 + 4 * n); kkq[(it + 1) & 1][n] = *(cgu2*)(kkbuf + fo1 + 4 * n); rq[(it + 1) & 1][n] = *(cgu2*)(rbuf + fo1 + 4 * n); } }
            asm volatile("" ::: "memory");
            const int tok = row0 + ai * HALF + m * 16;
            const int tau = d == 0 ? (tok & 15) : 15 - (tok & 15);
            unsigned char* rec = PKB + ((size_t)(d * 32 + h) * (TT / 16) + (tok >> 4)) * 8448;
            const size_t fo = (size_t)tok * 2048 + c8;
            f32x4 g[2]; u32x4 kw;
#pragma unroll
            for (int n = 0; n < 2; ++n) {
                f32x4 gp;
                const f32x4 x = acc[ai][0][m][n] + w0v[n];
#pragma unroll
                for (int j = 0; j < 4; ++j) { float w = __expf(-0.60653066f * sigmoidf_(x[j]));
                    if (d == 0) { w *= dpp_f<0x111>(1.0f, w); w *= dpp_f<0x112>(1.0f, w); w *= dpp_f<0x114>(1.0f, w); w *= dpp_f<0x118>(1.0f, w); g[n][j] = w; gp[j] = dpp_f<0x111>(1.0f, w); }
                    else        { w *= dpp_f<0x101>(1.0f, w); w *= dpp_f<0x102>(1.0f, w); w *= dpp_f<0x104>(1.0f, w); w *= dpp_f<0x108>(1.0f, w); g[n][j] = w; gp[j] = dpp_f<0x101>(1.0f, w); } }
                const f32x4 xa = acc[ai][1][m][n] + a0v[n];
                f32x4 k4, kk4, r4;
                { const u32x2l a_ = kq[it & 1][n], b_ = kkq[it & 1][n], c_ = rq[it & 1][n];
                  k4[0] = __builtin_bit_cast(float, a_.x << 16); k4[1] = __builtin_bit_cast(float, a_.x & 0xffff0000u); k4[2] = __builtin_bit_cast(float, a_.y << 16); k4[3] = __builtin_bit_cast(float, a_.y & 0xffff0000u);
                  kk4[0] = __builtin_bit_cast(float, b_.x << 16); kk4[1] = __builtin_bit_cast(float, b_.x & 0xffff0000u); kk4[2] = __builtin_bit_cast(float, b_.y << 16); kk4[3] = __builtin_bit_cast(float, b_.y & 0xffff0000u);
                  r4[0] = __builtin_bit_cast(float, c_.x << 16); r4[1] = __builtin_bit_cast(float, c_.x & 0xffff0000u); r4[2] = __builtin_bit_cast(float, c_.y << 16); r4[3] = __builtin_bit_cast(float, c_.y & 0xffff0000u); }
                f32x4 at, rt, bt, kdt; float kdv[4];
#pragma unroll
                for (int j = 0; j < 4; ++j) { const float a = sigmoidf_(xa[j]), rg = __builtin_amdgcn_rcpf(g[n][j]);
                    kdv[j] = k4[j] * (1.0f + (a - 1.0f) * kav[n][j]);
                    at[j] = -kk4[j] * gp[j]; rt[j] = r4[j] * g[n][j]; bt[j] = kk4[j] * a * rg; kdt[j] = kdv[j] * rg; }
                const int chn = ch + 4 * n;
                {
                    const int p0 = ((((chn >> 5) * 2 + ((chn >> 4) & 1)) * 2 + n) * 8 + ((chn >> 3) & 1) * 4);
                    typedef unsigned u32x2 __attribute__((ext_vector_type(2)));
                    __attribute__((address_space(1))) unsigned char* rp = (__attribute__((address_space(1))) unsigned char*)rec + (tau * 64 + p0) * 2;
                    u32x2 w;
                    w.x = cvt_pk_bf16(at[0], at[1]); w.y = cvt_pk_bf16(at[2], at[3]); *(__attribute__((address_space(1))) u32x2*)(rp) = w;
                    w.x = cvt_pk_bf16(rt[0], rt[1]); w.y = cvt_pk_bf16(rt[2], rt[3]); *(__attribute__((address_space(1))) u32x2*)(rp + 2048) = w;
                    w.x = cvt_pk_bf16(bt[0], bt[1]); w.y = cvt_pk_bf16(bt[2], bt[3]); *(__attribute__((address_space(1))) u32x2*)(rp + 4096) = w;
                    w.x = cvt_pk_bf16(kdt[0], kdt[1]); w.y = cvt_pk_bf16(kdt[2], kdt[3]); *(__attribute__((address_space(1))) u32x2*)(rp + 6144) = w; }
                if (n == 0) { kw.x = cvt_pk_bf16(kdv[0], kdv[1]); kw.y = cvt_pk_bf16(kdv[2], kdv[3]); } else { kw.z = cvt_pk_bf16(kdv[0], kdv[1]); kw.w = cvt_pk_bf16(kdv[2], kdv[3]); }
            }
            *(__attribute__((address_space(1))) u32x4*)(KD + (size_t)d * TT * 2048 + fo) = kw;
            if (fr == (d == 0 ? 15 : 0)) { float* ge = (float*)(rec + 8192) + ch; *(gf4*)ge = g[0]; *(gf4*)(ge + 4) = g[1]; }
        }
    }
};
template <class Epi, class Sched, bool ALIGN_EPI = false, bool SP2 = false>
__device__ __forceinline__ void gemm_phase(PG8_LAS unsigned char* lds, const Gemm g, const Sched& S, const Epi& E, const int wid) {
    const int lane = mk_lane(), tid = wid * 64 + lane, wr = wid >> 2, wc = wid & 3, fr = lane & 15, fq = lane >> 4;
    const int K = g.K, nt = K / BK;
    unsigned voffA[2], voffB[2];
#pragma unroll
    for (int i = 0; i < 2; ++i) { int R, C; stage_rc(tid * 16 + i * 8192, R, C); const int Rb = Epi::PERM ? ((R & ~31) + perm32(R & 31)) : R;
        voffA[i] = (unsigned)(R * K + C) * 2u; voffB[i] = (unsigned)(Rb * K + C) * 2u; }
    const size_t kstep = (size_t)(BK * 2);
    const size_t hstep = (size_t)HALF * K * 2;
    const size_t tstep = 2 * hstep;
    const unsigned ldsw = (unsigned)wid * 1024u;
    const int aoff = lds_byte(wr * 64 + fr, fq * 8), boff = lds_byte(wc * 32 + fr, fq * 8);
#define PG8_SA(b, h) (((b) * 2 + (h)) * HTB)
#define PG8_SB(b, h) ((4 + (b) * 2 + (h)) * HTB)
#define PG8_STAGE(bufoff, gbase, voff) do { _Pragma("unroll") for (int _i = 0; _i < 2; ++_i) \
        __builtin_amdgcn_global_load_lds((const unsigned*)((const char*)(gbase) + (voff)[_i]), (PG8_LAS unsigned*)(lds + (bufoff) + ldsw + _i * 8192), 16, 0, 0); } while (0)
#define PG8_LDA(dst, b, h) do { _Pragma("unroll") for (int m = 0; m < 4; ++m) _Pragma("unroll") for (int k = 0; k < 2; ++k) dst[m][k] = *(const PG8_LAS bf16x8*)(lds + PG8_SA(b, h) + aoff + m * 2048 + k * 1024); } while (0)
#define PG8_LDB(dst, b, h) do { _Pragma("unroll") for (int n = 0; n < 2; ++n) _Pragma("unroll") for (int k = 0; k < 2; ++k) dst[n][k] = *(const PG8_LAS bf16x8*)(lds + PG8_SB(b, h) + boff + n * 2048 + k * 1024); } while (0)
#define PG8_MMA(ai, bj, At, Bt) do { __builtin_amdgcn_s_setprio(1); _Pragma("unroll") for (int m = 0; m < 4; ++m) _Pragma("unroll") for (int n = 0; n < 2; ++n) _Pragma("unroll") for (int k = 0; k < 2; ++k) \
        acc[ai][bj][m][n] = __builtin_amdgcn_mfma_f32_16x16x32_bf16(Bt[n][k], At[m][k], acc[ai][bj][m][n], 0, 0, 0); __builtin_amdgcn_s_setprio(0); } while (0)
#define PG8_WAIT_V(n) asm volatile("s_waitcnt vmcnt(" #n ")" ::: "memory")
#define PG8_WAIT_L(n) asm volatile("s_waitcnt lgkmcnt(" #n ")" ::: "memory")
#define PG8_BAR __builtin_amdgcn_s_barrier()
#define PG8_SCHED __builtin_amdgcn_sched_barrier(0)
    Unit cur, nxt; int ui = 0;
    if (!S.next(0, cur)) return;
    f32x4 acc[2][2][4][2];
#pragma unroll
    for (int a = 0; a < 2; ++a)
#pragma unroll
        for (int b = 0; b < 2; ++b)
#pragma unroll
            for (int m = 0; m < 4; ++m)
#pragma unroll
                for (int n = 0; n < 2; ++n) acc[a][b][m][n] = (f32x4){0.f, 0.f, 0.f, 0.f};
    bf16x8 At[4][2], B0[2][2], B1[2][2];
    const char* cA = (const char*)g.A + (size_t)cur.pm * tstep; const char* cB = (const char*)g.Bt + (size_t)cur.pn * tstep;
    S.a_ready(cur);
    if constexpr (SP2) {
        PG8_STAGE(PG8_SB(0, 0), cB, voffB); PG8_STAGE(PG8_SB(0, 1), cB + hstep, voffB); PG8_STAGE(PG8_SA(0, 0), cA, voffA); PG8_STAGE(PG8_SA(0, 1), cA + hstep, voffA);
        if (wr == 1) PG8_BAR;
        PG8_WAIT_V(2); PG8_BAR;
        PG8_STAGE(PG8_SB(1, 0), cB + kstep, voffB); PG8_STAGE(PG8_SA(1, 0), cA + kstep, voffA); PG8_STAGE(PG8_SB(1, 1), cB + hstep + kstep, voffB);
        PG8_WAIT_V(6); PG8_BAR;
    } else {
        PG8_STAGE(PG8_SB(0, 0), cB, voffB); PG8_STAGE(PG8_SA(0, 0), cA, voffA); PG8_STAGE(PG8_SB(0, 1), cB + hstep, voffB); PG8_STAGE(PG8_SA(0, 1), cA + hstep, voffA);
        if (wr == 1) PG8_BAR;
        PG8_WAIT_V(4); PG8_BAR;
        PG8_STAGE(PG8_SB(1, 0), cB + kstep, voffB); PG8_STAGE(PG8_SA(1, 0), cA + kstep, voffA); PG8_STAGE(PG8_SB(1, 1), cB + hstep + kstep, voffB);
        PG8_WAIT_V(6); PG8_BAR;
    }
    for (;;) {
        const bool has_next = S.next(ui + 1, nxt);
        const char* nA = has_next ? (const char*)g.A + (size_t)nxt.pm * tstep : cA; const char* nB = has_next ? (const char*)g.Bt + (size_t)nxt.pn * tstep : cB;
        for (int t = 0; t < nt; t += 2) {
            const bool last = (t == nt - 2);
            const char* a1 = cA + (size_t)(t + 1) * kstep;
            const char* a2 = last ? nA : cA + (size_t)(t + 2) * kstep; const char* b2 = last ? nB : cB + (size_t)(t + 2) * kstep;
            const char* a3 = a2 + kstep; const char* b3 = b2 + kstep;
            if (last && has_next) S.a_ready(nxt);
            if constexpr (SP2) {
            PG8_LDB(B0, 0, 0); PG8_LDB(B1, 0, 1); PG8_SCHED; PG8_LDA(At, 0, 0); PG8_STAGE(PG8_SA(1, 1), a1 + hstep, voffA);
            PG8_WAIT_V(8); PG8_WAIT_L(0); PG8_BAR; PG8_MMA(0, 0, At, B0); PG8_MMA(0, 1, At, B1); PG8_BAR; PG8_SCHED;
            PG8_LDA(At, 0, 1); PG8_STAGE(PG8_SB(0, 0), b2, voffB); PG8_STAGE(PG8_SB(0, 1), b2 + hstep, voffB); PG8_STAGE(PG8_SA(0, 0), a2, voffA);
            PG8_WAIT_V(8); PG8_WAIT_L(0); PG8_BAR; PG8_MMA(1, 0, At, B0); PG8_MMA(1, 1, At, B1); PG8_BAR; PG8_SCHED;
            PG8_LDB(B0, 1, 0); PG8_LDB(B1, 1, 1); PG8_SCHED; PG8_LDA(At, 1, 0); PG8_STAGE(PG8_SA(0, 1), a2 + hstep, voffA);
            PG8_WAIT_V(8); PG8_WAIT_L(0); PG8_BAR; PG8_MMA(0, 0, At, B0); PG8_MMA(0, 1, At, B1); PG8_BAR; PG8_SCHED;
            PG8_LDA(At, 1, 1); PG8_STAGE(PG8_SB(1, 0), b3, voffB); PG8_STAGE(PG8_SB(1, 1), b3 + hstep, voffB); PG8_STAGE(PG8_SA(1, 0), a3, voffA);
            PG8_WAIT_V(8); PG8_WAIT_L(0); PG8_BAR; PG8_MMA(1, 0, At, B0); PG8_MMA(1, 1, At, B1); PG8_BAR; PG8_SCHED;
            } else {
            PG8_LDB(B0, 0, 0); PG8_SCHED; PG8_LDA(At, 0, 0); PG8_STAGE(PG8_SA(1, 1), a1 + hstep, voffA);
            PG8_WAIT_L(8); PG8_BAR; PG8_WAIT_L(0); PG8_MMA(0, 0, At, B0); PG8_BAR; PG8_SCHED;
            PG8_LDB(B1, 0, 1); PG8_STAGE(PG8_SB(0, 0), b2, voffB);
            PG8_BAR; PG8_WAIT_L(0); PG8_MMA(0, 1, At, B1); PG8_BAR;
            PG8_LDA(At, 0, 1); PG8_STAGE(PG8_SA(0, 0), a2, voffA);
            PG8_BAR; PG8_WAIT_L(0); PG8_MMA(1, 0, At, B0); PG8_BAR; PG8_SCHED;
            PG8_STAGE(PG8_SB(0, 1), b2 + hstep, voffB);
            PG8_WAIT_V(6); PG8_BAR; PG8_MMA(1, 1, At, B1); PG8_BAR;
            PG8_LDB(B0, 1, 0); PG8_SCHED; PG8_LDA(At, 1, 0); PG8_STAGE(PG8_SA(0, 1), a2 + hstep, voffA);
            PG8_WAIT_L(8); PG8_BAR; PG8_WAIT_L(0); PG8_MMA(0, 0, At, B0); PG8_BAR; PG8_SCHED;
            PG8_LDB(B1, 1, 1); PG8_STAGE(PG8_SB(1, 0), b3, voffB);
            PG8_BAR; PG8_WAIT_L(0); PG8_MMA(0, 1, At, B1); PG8_BAR;
            PG8_LDA(At, 1, 1); PG8_STAGE(PG8_SA(1, 0), a3, voffA);
            PG8_BAR; PG8_WAIT_L(0); PG8_MMA(1, 0, At, B0); PG8_BAR; PG8_SCHED;
            PG8_STAGE(PG8_SB(1, 1), b3 + hstep, voffB);
            PG8_WAIT_V(6); PG8_BAR; PG8_MMA(1, 1, At, B1); PG8_BAR;
            }
        }
        if constexpr (ALIGN_EPI) { if (wr == 0) PG8_BAR; }
        if constexpr (!Epi::AFTER_DRAIN) { const int l2 = mk_lane(); E(acc, cur, wr, wc, l2 & 15, l2 >> 4); S.done(cur); }
        if (!has_next) break;
#pragma unroll
        for (int a = 0; a < 2; ++a)
#pragma unroll
            for (int b = 0; b < 2; ++b)
#pragma unroll
                for (int m = 0; m < 4; ++m)
#pragma unroll
                    for (int n = 0; n < 2; ++n) acc[a][b][m][n] = (f32x4){0.f, 0.f, 0.f, 0.f};
        cur = nxt; cA = nA; cB = nB; ++ui;
        if constexpr (ALIGN_EPI) { if (wr == 1) PG8_BAR; }
    }
    PG8_WAIT_V(0);
    if constexpr (!ALIGN_EPI) { if (wr == 0) PG8_BAR; }
    PG8_BAR;
    if constexpr (Epi::AFTER_DRAIN) { E.fused(acc, cur, wr, wc, fr, fq, lds, wid, lane); S.done(cur); }
#undef PG8_SA
#undef PG8_SB
#undef PG8_STAGE
#undef PG8_LDA
#undef PG8_LDB
#undef PG8_MMA
#undef PG8_WAIT_V
#undef PG8_WAIT_L
#undef PG8_BAR
#undef PG8_SCHED
}
}

constexpr int NWAVES = 8;
#ifndef MK_N_LAUNCHES
#define MK_N_LAUNCHES 1
#endif
constexpr int N_PHASES = 14;
#ifndef MK_REPS
#define MK_REPS {1,1,1,1,1,1,1,1,1,1,1,1,1,1}
#endif
constexpr int PH_REPS[14] = MK_REPS;
#ifndef MK_TPA
#define MK_TPA -1
#endif
#ifndef MK_TPB
#define MK_TPB -1
#endif
constexpr int TPA = MK_TPA, TPB = MK_TPB;
constexpr int N_LAUNCHES = MK_N_LAUNCHES;

constexpr int D = 4096, T = 8192, CTXL = 256, TT = T + CTXL;
constexpr int DR = 2048, DC = 2048, NH = 32, HS = 64;
constexpr int OFF_K = 0, OFF_V = 2048, OFF_WL = 4096, OFF_AL = 4192, OFF_R = 4288, OFF_GL = 6336, RWKV_COLS = 6592;
constexpr int OFF_CB = 6592, OFF_CC = 8640, OFF_CX = 10688, IN_COLS = 12736, NZ = 12800;
constexpr int NCTXZ = 4352;
constexpr int DFF = 11008, NGU = 2 * DFF;
constexpr int NLORA = 8192, KLORA = 256, KGATE = 256;
constexpr int MODN = 6 * D;
constexpr int NKC = 16;
constexpr float NORM_EPS = 1e-6f, LNX_EPS = 64e-5f;
constexpr int CHUNK = 256, NCHUNK = 33;

constexpr size_t MiB = 1u << 20;
constexpr size_t WS_CTL = 0, CTL_ZERO_BYTES = 32768;
constexpr size_t WS_MODP = 1 * MiB;
constexpr size_t WS_MODV = 5 * MiB;
constexpr size_t WS_WLORA = 6 * MiB;
constexpr size_t WS_WGATE = 10 * MiB;
constexpr size_t WS_ALORA = 11 * MiB;
constexpr size_t WS_AGATE = 16 * MiB;
constexpr size_t WS_WOUT = 20 * MiB;
constexpr size_t WS_WGU = 52 * MiB;
constexpr size_t WS_WDN = 224 * MiB;
constexpr size_t WS_WIN = 310 * MiB;
constexpr size_t WS_PU = 310 * MiB;
constexpr size_t WS_SST = 374 * MiB;
constexpr size_t WS_A1 = 410 * MiB;
constexpr size_t WS_CAT = 410 * MiB;
constexpr size_t WS_Z = 476 * MiB;
constexpr size_t WS_YS = 476 * MiB;
constexpr size_t WS_KD = 604 * MiB;
constexpr size_t WS_GE = 670 * MiB;
constexpr size_t WS_KBUF = 683 * MiB;
constexpr size_t WS_KKBUF = 749 * MiB;
constexpr size_t WS_RBUF = 815 * MiB;
constexpr size_t WS_VBUF = 881 * MiB;
constexpr size_t WS_X1 = 683 * MiB;
constexpr size_t WS_PK = 947 * MiB;
constexpr size_t WS_ACT = 947 * MiB;
constexpr size_t WS_G = 1475 * MiB;
constexpr size_t WS_END = 1507 * MiB;
static_assert(WS_MODP + (size_t)NKC * 2 * MODN * 4 <= WS_MODV && WS_ALORA + (size_t)TT * 256 * 2 <= WS_AGATE && WS_WGU + (size_t)NGU * D * 2 <= WS_WDN && WS_WDN + (size_t)D * DFF * 2 <= WS_WIN, "ws map 1");
static_assert(WS_WIN + (size_t)NZ * D * 2 <= WS_A1 && WS_SST + (size_t)64 * NCHUNK * 16384 <= WS_A1 && WS_A1 + (size_t)TT * D * 2 <= WS_Z && WS_Z + (size_t)TT * NZ * 2 <= WS_KBUF, "ws map 2");
static_assert(WS_YS + (size_t)2 * T * 2048 * 4 <= WS_KD && WS_KD + (size_t)2 * TT * 2048 * 2 <= WS_GE && WS_GE + (size_t)64 * (TT / 16) * 256 <= WS_KBUF, "ws map 3");
static_assert(WS_KBUF + (size_t)TT * 2048 * 4 <= WS_KKBUF && WS_KKBUF + (size_t)TT * 2048 * 4 <= WS_RBUF && WS_RBUF + (size_t)TT * 2048 * 4 <= WS_VBUF && WS_VBUF + (size_t)TT * 2048 * 4 <= WS_PK, "ws map 4");
static_assert(WS_X1 + (size_t)T * D * 4 <= WS_RBUF && WS_PK + (size_t)64 * TT * 1024 <= WS_G && WS_ACT + (size_t)T * DFF * 2 <= WS_G && WS_G + (size_t)T * 2048 * 2 <= WS_END && WS_CAT + (size_t)T * D * 2 <= WS_Z, "ws map 5");
constexpr int CW_TMO = 0;
constexpr int CW_BAR = 4096;

constexpr int RING_OFF = 0, RING_BYTES = 131072;
constexpr int LDSCTL_OFF = RING_BYTES, MISC_OFF = LDSCTL_OFF + 320;
constexpr int LDS_BYTES = 147456;
static_assert(MISC_OFF + 128 <= LDS_BYTES, "LDS map");

#define GAS __attribute__((address_space(1)))
#define LAS __attribute__((address_space(3)))
typedef unsigned short bf16;
typedef unsigned v4u __attribute__((ext_vector_type(4)));
typedef unsigned v2u __attribute__((ext_vector_type(2)));
typedef float f32x4 __attribute__((ext_vector_type(4)));
typedef GAS unsigned gu32;
#define RLX_AGENT __ATOMIC_RELAXED, __HIP_MEMORY_SCOPE_AGENT
#define LDS_WAIT() asm volatile("s_waitcnt lgkmcnt(0)" ::: "memory")
#define VM_WAIT() asm volatile("s_waitcnt vmcnt(0)" ::: "memory")
__device__ __forceinline__ unsigned f2bf(float f) { unsigned u = __builtin_bit_cast(unsigned, f); return (u + 0x7fffu + ((u >> 16) & 1u)) >> 16; }
__device__ __forceinline__ unsigned pk2(float lo, float hi) { return f2bf(lo) | (f2bf(hi) << 16); }
__device__ __forceinline__ float bflo(unsigned w) { return __builtin_bit_cast(float, w << 16); }
__device__ __forceinline__ float bfhi(unsigned w) { return __builtin_bit_cast(float, w & 0xffff0000u); }
__device__ __forceinline__ float sigm(float x) { return 1.0f / (1.0f + __expf(-x)); }

#define XB_TMO      128
#define XB_XCNT(j)  (256  + 64 * (j))
#define XB_XSUB(j)  (1280 + 64 * (j))
#define XB_XGEN(j)  (2304 + 64 * (j))
#define XB_TOP      3328
#define XB_TOPGEN   3392
#define XCD_BAR_WORDS 3456
#define XB_SPIN_CAP (1u << 18)
__device__ __forceinline__ unsigned xb_ld(unsigned* p)              { return __hip_atomic_load(p, __ATOMIC_RELAXED, __HIP_MEMORY_SCOPE_AGENT); }
__device__ __forceinline__ unsigned xb_add(unsigned* p, unsigned v) { return __hip_atomic_fetch_add(p, v, __ATOMIC_RELAXED, __HIP_MEMORY_SCOPE_AGENT); }
__device__ __forceinline__ unsigned xb_xcc_id() { return (unsigned)__builtin_amdgcn_s_getreg((3 << 11) | 20) & 0xFu; }
#define XB_SPIN(cond, bar) do { unsigned _sp = 0; while (cond) { __builtin_amdgcn_s_sleep(1); \
    if ((++_sp & 255u) == 0u) { if (xb_ld(&(bar)[XB_TMO])) break; if (_sp > XB_SPIN_CAP) { atomicAdd(&(bar)[XB_TMO], 1u); break; } } } } while (0)
struct XcdBarrier { unsigned* bar; unsigned x; volatile LAS unsigned* st; };
__device__ __forceinline__ XcdBarrier xcd_barrier_post(unsigned* bar, volatile LAS unsigned* st) {
    XcdBarrier b; b.bar = bar; b.x = xb_xcc_id(); b.st = st;
    if (threadIdx.x == 0) (void)xb_add(&bar[XB_XCNT(b.x)], 1u);
    return b;
}
__device__ __forceinline__ void xcd_barrier_complete(unsigned* bar, unsigned x, unsigned& nloc, unsigned& nx) {
    const unsigned G = gridDim.x * gridDim.y * gridDim.z;
    unsigned sum, cnt, mine, sp = 0u;
    for (;;) {
        sum = 0u; cnt = 0u; mine = 0u;
#pragma unroll
        for (unsigned j = 0; j < 16; ++j) { const unsigned c = xb_ld(&bar[XB_XCNT(j)]); sum += c; cnt += (c > 0u) ? 1u : 0u; mine = (j == x) ? c : mine; }
        if (sum == G) break;
        __builtin_amdgcn_s_sleep(1);
        if ((++sp & 255u) == 0u) { if (xb_ld(&bar[XB_TMO])) break; if (sp > XB_SPIN_CAP) { atomicAdd(&bar[XB_TMO], 1u); break; } }
    }
    nloc = mine > 0u ? mine : 1u; nx = cnt > 0u ? cnt : 1u;
}
__device__ __forceinline__ void xcd_barrier(const XcdBarrier& b, const int wave) {
    asm volatile("s_waitcnt vmcnt(0)" ::: "memory");
    __syncthreads();
    if (wave == 0 && pg8::mk_lane() == 0) {
        unsigned* bar = b.bar;
        __builtin_amdgcn_s_waitcnt(0);
        unsigned nloc = b.st[0], nx = b.st[1];
        if (nloc == 0u) { xcd_barrier_complete(bar, b.x, nloc, nx); b.st[0] = nloc; b.st[1] = nx; }
        const unsigned old = xb_add(&bar[XB_XSUB(b.x)], 1u);
        const unsigned gen = old / nloc;
        if (old + 1u == (gen + 1u) * nloc) {
            __builtin_amdgcn_fence(__ATOMIC_RELEASE, "agent");
            asm volatile("s_waitcnt vmcnt(0)" ::: "memory");
            const unsigned og = xb_add(&bar[XB_TOP], 1u);
            const unsigned tg = og / nx;
            if (og + 1u == (tg + 1u) * nx) xb_add(&bar[XB_TOPGEN], 1u);
            else XB_SPIN(xb_ld(&bar[XB_TOPGEN]) == tg, bar);
            __builtin_amdgcn_fence(__ATOMIC_ACQUIRE, "agent");
            xb_add(&bar[XB_XGEN(b.x)], 1u);
            asm volatile("s_waitcnt vmcnt(0)" ::: "memory");
        } else {
            XB_SPIN(xb_ld(&bar[XB_XGEN(b.x)]) == gen, bar);
            __builtin_amdgcn_fence(__ATOMIC_ACQUIRE, "agent");
            asm volatile("s_waitcnt vmcnt(0)" ::: "memory");
        }
    }
    __syncthreads();
}

struct Frame {
    LAS unsigned char* lds;
    volatile LAS unsigned* MISC;
    gu32* ctl;
    int wave;
    int vcu, G;
    unsigned char* ws;
    const float* in[26];
    float* out;
};
enum { I_X = 0, I_C, I_CTX, I_CCTX, I_WADA, I_BADA, I_NORM1, I_WIN, I_MU, I_KK, I_KA, I_RK, I_W0, I_WDU, I_A0, I_WIU, I_WGU, I_LNXW, I_LNXB, I_CONVW, I_WOUT, I_NORM2, I_WFG, I_WFU, I_WFD, I_NORMF };

__device__ __forceinline__ float wave_sum(float v) {
#pragma unroll
    for (int o = 1; o < 64; o <<= 1) v += __shfl_xor(v, o);
    return v;
}

__device__ __forceinline__ void p0_transpose_item(const float* W, int K, int N, bf16* WT, int ldk, int row_off, LAS float* scr, int item, int lane) {
    const int nblk = N / 32, kb = item / nblk, nb = item % nblk, k0 = 64 * kb, n0 = 32 * nb;
    float tv[32];
#pragma unroll
    for (int i = 0; i < 32; ++i) tv[i] = *(const GAS float*)(W + (size_t)(k0 + 2 * i + (lane >> 5)) * N + n0 + (lane & 31));
#pragma unroll
    for (int i = 0; i < 32; ++i) scr[(2 * i + (lane >> 5)) * 33 + (lane & 31)] = tv[i];
    LDS_WAIT(); asm volatile("" ::: "memory");
    const int c = lane & 7;
#pragma unroll
    for (int j = 0; j < 4; ++j) { const int n = (lane >> 3) + 8 * j; const LAS float* s = scr + (8 * c) * 33 + n;
        v4u o; o.x = pk2(s[0 * 33], s[1 * 33]); o.y = pk2(s[2 * 33], s[3 * 33]); o.z = pk2(s[4 * 33], s[5 * 33]); o.w = pk2(s[6 * 33], s[7 * 33]);
        *(GAS v4u*)(WT + (size_t)(row_off + n0 + n) * ldk + k0 + 8 * c) = o; }
    LDS_WAIT(); asm volatile("" ::: "memory");
}
constexpr int TI_IN = (D / 64) * (IN_COLS / 32), TI_OUT = (D / 64) * (D / 32), TI_G = (D / 64) * (DFF / 32), TI_DN = (DFF / 64) * (D / 32);
constexpr int TI_TOTAL = TI_IN + TI_OUT + 2 * TI_G + TI_DN;
constexpr int GEMV_UNITS = NKC * (MODN / 256);
constexpr int IB_OUT = TI_IN, IB_G = IB_OUT + TI_OUT, IB_U = IB_G + TI_G, IB_D = IB_U + TI_G;
constexpr int P2T_B = IB_OUT, P2T_E = IB_G + 17200;
constexpr int P6T_B = P2T_E, P6T_E = IB_U + 15000;
constexpr int P0X_B = P6T_E, P0X_E = IB_D + 12000;
constexpr int P11T_B = P0X_E, P11T_E = TI_TOTAL;
constexpr int P0_ITEMS = TI_IN + (P0X_E - P0X_B);
constexpr int TI_PER_GEMV_WAVE = 16, TI_PER_OTHER_WAVE = 40;
static_assert(GEMV_UNITS <= 2048 && GEMV_UNITS * TI_PER_GEMV_WAVE + (2048 - GEMV_UNITS) * TI_PER_OTHER_WAVE >= P0_ITEMS, "P0 item split");

__device__ __forceinline__ void tr_item(Frame& F, int it, LAS float* scr, int lane) {
    int r = it;
    if (r < TI_IN) { p0_transpose_item(F.in[I_WIN], D, IN_COLS, (bf16*)(F.ws + WS_WIN), D, 0, scr, r, lane); return; } r -= TI_IN;
    if (r < TI_OUT) { p0_transpose_item(F.in[I_WOUT], D, D, (bf16*)(F.ws + WS_WOUT), D, 0, scr, r, lane); return; } r -= TI_OUT;
    if (r < TI_G) { const int n0 = 32 * (r % (DFF / 32)); p0_transpose_item(F.in[I_WFG], D, DFF, (bf16*)(F.ws + WS_WGU), D, 256 * (n0 >> 7) + (n0 & 127) - n0, scr, r, lane); return; } r -= TI_G;
    if (r < TI_G) { const int n0 = 32 * (r % (DFF / 32)); p0_transpose_item(F.in[I_WFU], D, DFF, (bf16*)(F.ws + WS_WGU), D, 256 * (n0 >> 7) + 128 + (n0 & 127) - n0, scr, r, lane); return; } r -= TI_G;
    p0_transpose_item(F.in[I_WFD], DFF, D, (bf16*)(F.ws + WS_WDN), DFF, 0, scr, r, lane);
}
__device__ __forceinline__ void tr_range(Frame& F, int b, int e, int rank, int nw, LAS float* scr, int lane) {
    const int per = (e - b + nw - 1) / nw; int i0 = b + rank * per, i1 = i0 + per; if (i1 > e) i1 = e;
    for (int it = i0; it < i1; ++it) tr_item(F, it, scr, lane);
}
__device__ __forceinline__ void tr_idle(Frame& F, int b, int e, int rank_blk, int nblk) {
    if (F.G != 256 || rank_blk < 0) return;
    tr_range(F, b, e, rank_blk * NWAVES + F.wave, nblk * NWAVES, (LAS float*)(F.lds + RING_OFF + F.wave * 16384), pg8::mk_lane());
}
__device__ __forceinline__ void p0_gemv_unit(Frame& F, int unit, int lane) {
    const int kc = unit / (MODN / 256), cc = unit % (MODN / 256);
    const int k0 = kc * 256, col = cc * 256 + lane * 4;
    int sv[4], sc[4];
#pragma unroll
    for (int q = 0; q < 4; ++q) { const float c = *(const GAS float*)(F.in[I_C] + k0 + q * 64 + lane), cx = *(const GAS float*)(F.in[I_CCTX] + k0 + q * 64 + lane);
        sv[q] = __builtin_bit_cast(int, c * sigm(c)); sc[q] = __builtin_bit_cast(int, cx * sigm(cx)); }
    f32x4 a0 = (f32x4){0.f, 0.f, 0.f, 0.f}, a1 = a0;
    const GAS f32x4* wp = (const GAS f32x4*)(F.in[I_WADA] + (size_t)k0 * MODN + col);
#pragma unroll
    for (int q = 0; q < 4; ++q) {
#pragma unroll 16
        for (int i = 0; i < 64; ++i) { const f32x4 w = wp[(size_t)(q * 64 + i) * (MODN / 4)];
            const float s = __builtin_bit_cast(float, __builtin_amdgcn_readlane(sv[q], i)), t = __builtin_bit_cast(float, __builtin_amdgcn_readlane(sc[q], i));
            a0 += w * s; a1 += w * t; }
    }
    float* mp = (float*)(F.ws + WS_MODP);
    *(GAS f32x4*)(mp + (size_t)(kc * 2 + 0) * MODN + col) = a0;
    *(GAS f32x4*)(mp + (size_t)(kc * 2 + 1) * MODN + col) = a1;
}

__device__ __forceinline__ void p0_prologue(Frame& F) {
    LAS float* scr = (LAS float*)(F.lds + RING_OFF + F.wave * 16384);
    const int lane = pg8::mk_lane();
    const int gw = F.vcu * NWAVES + F.wave, NGW = F.G * NWAVES;
    const int gt = gw * 64 + lane, NGT = NGW * 64;
    {
        unsigned* wl = (unsigned*)(F.ws + WS_WLORA);
        for (int i = gt; i < NLORA * KLORA / 2; i += NGT) { const int n = i >> 7, k = (i & 127) * 2, pn = n >> 8, d = pn >> 4, isic = (n >> 7) & 1, ch = (pn & 15) * 128 + (n & 127); float v0 = 0.f, v1 = 0.f;
            if (k < 96) { if (!isic) { v0 = *(const GAS float*)(F.in[I_WDU] + (size_t)(d * 96 + k) * 2048 + ch); v1 = *(const GAS float*)(F.in[I_WDU] + (size_t)(d * 96 + k + 1) * 2048 + ch); } }
            else if (k < 192) { if (isic) { v0 = *(const GAS float*)(F.in[I_WIU] + (size_t)(d * 96 + k - 96) * 2048 + ch); v1 = *(const GAS float*)(F.in[I_WIU] + (size_t)(d * 96 + k - 95) * 2048 + ch); } }
            *(GAS unsigned*)(wl + i) = pk2(v0, v1); }
        unsigned* wg = (unsigned*)(F.ws + WS_WGATE);
        for (int i = gt; i < 2048 * KGATE / 2; i += NGT) { const int n = i >> 7, k = (i & 127) * 2;
            *(GAS unsigned*)(wg + i) = pk2(*(const GAS float*)(F.in[I_WGU] + (size_t)k * 2048 + n), *(const GAS float*)(F.in[I_WGU] + (size_t)(k + 1) * 2048 + n)); }
        v4u* zp = (v4u*)(F.ws + WS_WIN + (size_t)IN_COLS * D * 2);
        for (int i = gt; i < (NZ - IN_COLS) * D * 2 / 16; i += NGT) *(GAS v4u*)(zp + i) = (v4u){0u, 0u, 0u, 0u};
    }
    for (int u = gw; u < GEMV_UNITS; u += NGW) p0_gemv_unit(F, u, lane);
    if (F.G == 256) {
        int it0, it1;
        if (gw < GEMV_UNITS) { it0 = gw * TI_PER_GEMV_WAVE; it1 = it0 + TI_PER_GEMV_WAVE; }
        else { it0 = GEMV_UNITS * TI_PER_GEMV_WAVE + (gw - GEMV_UNITS) * TI_PER_OTHER_WAVE; it1 = it0 + TI_PER_OTHER_WAVE; }
        if (it1 > P0_ITEMS) it1 = P0_ITEMS;
        for (int it = it0; it < it1; ++it) tr_item(F, it < TI_IN ? it : P0X_B + (it - TI_IN), scr, lane);
    } else tr_range(F, 0, TI_TOTAL, gw, NGW, scr, lane);
}

__device__ __forceinline__ void norm_row_load(const float* xrow, int lane, f32x4 (&v)[16]) {
    const GAS f32x4* xr = (const GAS f32x4*)xrow + lane;
#pragma unroll
    for (int j = 0; j < 16; ++j) v[j] = xr[64 * j];
}
__device__ __forceinline__ void norm_row_finish(const f32x4 (&v)[16], bf16* orow, const LAS float* gs, const LAS float* sh, int lane) {
    float s = 0.f;
#pragma unroll
    for (int j = 0; j < 16; ++j) s += (v[j].x * v[j].x + v[j].y * v[j].y) + (v[j].z * v[j].z + v[j].w * v[j].w);
    const float rstd = 1.0f / sqrtf(wave_sum(s) * (1.f / D) + NORM_EPS);
    GAS v2u* o8 = (GAS v2u*)orow + lane;
#pragma unroll
    for (int j = 0; j < 16; ++j) { const f32x4 g = *(const LAS f32x4*)(gs + 4 * lane + 256 * j), b = *(const LAS f32x4*)(sh + 4 * lane + 256 * j);
        const f32x4 y = v[j] * rstd * g + b; v2u o; o.x = pk2(y.x, y.y); o.y = pk2(y.z, y.w); o8[64 * j] = o; }
}
__device__ __forceinline__ void norm_row(const float* xrow, bf16* orow, const LAS float* gs, const LAS float* sh, int lane) {
    f32x4 v[16]; norm_row_load(xrow, lane, v); norm_row_finish(v, orow, gs, sh, lane);
}
__device__ __forceinline__ void p1_norm1(Frame& F) {
    const int lane = pg8::mk_lane(), tid = F.wave * 64 + lane;
    const int gw = F.vcu * NWAVES + F.wave, NGW = F.G * NWAVES;
    bf16* A1 = (bf16*)(F.ws + WS_A1);
    f32x4 v0[16]; norm_row_load(F.in[I_X] + (size_t)gw * D, lane, v0);
    LAS float* tab = (LAS float*)(F.lds + RING_OFF);
    const float* mp = (const float*)(F.ws + WS_MODP);
    bool need_ctx = false;
    for (int m = F.vcu * NWAVES; m < TT; m += NGW) if (m + NWAVES > T) need_ctx = true;
    for (int i = tid; i < (need_ctx ? 4 : 2) * (D / 4); i += NWAVES * 64) {
        const int which = i >> 10, k = (i & (D / 4 - 1)) * 4, isc = which >> 1, part = which & 1;
        const int col = part == 0 ? D + k : k;
        f32x4 s = *(const GAS f32x4*)(F.in[I_BADA] + col);
#pragma unroll
        for (int p = 0; p < NKC; ++p) s += *(const GAS f32x4*)(mp + (size_t)(p * 2 + isc) * MODN + col);
        if (part == 0) s = *(const GAS f32x4*)(F.in[I_NORM1] + k) * (1.0f + s);
        *(LAS f32x4*)(tab + which * D + k) = s;
    }
    {
        float* mv = (float*)(F.ws + WS_MODV);
        for (int i = F.vcu * (NWAVES * 64) + tid; i < 2 * MODN; i += F.G * NWAVES * 64) { const int isc = i / MODN, col = i % MODN;
            float s = *(const GAS float*)(F.in[I_BADA] + col);
#pragma unroll
            for (int p = 0; p < NKC; ++p) s += *(const GAS float*)(mp + (size_t)(p * 2 + isc) * MODN + col);
            *(GAS float*)(mv + i) = s; }
    }
    __syncthreads();
    f32x4 v1[16];
#define MK_P1_SRC(m_) ((m_) < T ? F.in[I_X] + (size_t)(m_) * D : F.in[I_CTX] + (size_t)((m_) - T) * D)
#define MK_P1_FIN(v_, m_) do { if ((m_) < T) norm_row_finish(v_, A1 + (size_t)(m_) * D, tab, tab + D, lane); else norm_row_finish(v_, A1 + (size_t)(m_) * D, tab + 2 * D, tab + 3 * D, lane); } while (0)
    for (int m = gw; m < TT; m += 2 * NGW) {
        const int m2 = m + NGW, m3 = m2 + NGW;
        if (m2 < TT) norm_row_load(MK_P1_SRC(m2), lane, v1);
        MK_P1_FIN(v0, m);
        if (m2 < TT) { if (m3 < TT) norm_row_load(MK_P1_SRC(m3), lane, v0); MK_P1_FIN(v1, m2); }
    }
#undef MK_P1_SRC
#undef MK_P1_FIN
    __syncthreads();
}
__device__ __forceinline__ void p10_norm2(Frame& F) {
    const int lane = pg8::mk_lane(), tid = F.wave * 64 + lane;
    LAS float* tab = (LAS float*)(F.lds + RING_OFF);
    const float* mv = (const float*)(F.ws + WS_MODV);
    const int gw = F.vcu * NWAVES + F.wave, NGW = F.G * NWAVES;
    bf16* A1 = (bf16*)(F.ws + WS_A1); const float* X1 = (const float*)(F.ws + WS_X1);
    f32x4 v0[16], v1[16];
    if (gw < T) norm_row_load(X1 + (size_t)gw * D, lane, v0);
    for (int i = tid; i < 2 * D; i += NWAVES * 64) { const int part = i >> 12, k = i & (D - 1);
        tab[i] = part == 0 ? *(const GAS float*)(F.in[I_NORM2] + k) * (1.0f + *(const GAS float*)(mv + 4 * D + k)) : *(const GAS float*)(mv + 3 * D + k); }
    __syncthreads();
    for (int m = gw; m < T; m += 2 * NGW) {
        const int m2 = m + NGW, m3 = m2 + NGW;
        if (m2 < T) norm_row_load(X1 + (size_t)m2 * D, lane, v1);
        asm volatile("" ::: "memory");
        norm_row_finish(v0, A1 + (size_t)m * D, tab, tab + D, lane);
        asm volatile("" ::: "memory");
        if (m2 < T) { if (m3 < T) norm_row_load(X1 + (size_t)m3 * D, lane, v0); asm volatile("" ::: "memory"); norm_row_finish(v1, A1 + (size_t)m2 * D, tab, tab + D, lane); asm volatile("" ::: "memory"); }
    }
    __syncthreads();
}
__device__ __forceinline__ void p13_final(Frame& F) {
    const int lane = pg8::mk_lane();
    const int gw = F.vcu * NWAVES + F.wave, NGW = F.G * NWAVES;
    f32x4 v0[16], v1[16];
#define MK_P13_FIN(v_, m_) do { float s_ = 0.f; _Pragma("unroll") for (int j = 0; j < 16; ++j) s_ += (v_[j].x * v_[j].x + v_[j].y * v_[j].y) + (v_[j].z * v_[j].z + v_[j].w * v_[j].w); \
        const float rstd_ = 1.0f / sqrtf(wave_sum(s_) * (1.f / D) + NORM_EPS); GAS f32x4* xo_ = (GAS f32x4*)(F.out + (size_t)(m_) * D) + lane; \
        _Pragma("unroll") for (int j = 0; j < 16; ++j) xo_[64 * j] = v_[j] * rstd_ * *((const GAS f32x4*)F.in[I_NORMF] + lane + 64 * j); } while (0)
    if (gw < T) norm_row_load(F.out + (size_t)gw * D, lane, v0);
    for (int m = gw; m < T; m += 2 * NGW) {
        const int m2 = m + NGW, m3 = m2 + NGW;
        if (m2 < T) norm_row_load(F.out + (size_t)m2 * D, lane, v1);
        MK_P13_FIN(v0, m);
        if (m2 < T) { if (m3 < T) norm_row_load(F.out + (size_t)m3 * D, lane, v0); MK_P13_FIN(v1, m2); }
    }
#undef MK_P13_FIN
}

__device__ __forceinline__ void ld8(const bf16* p, float (&f)[8]) { const v4u r = *(const GAS v4u*)p;
    f[0] = bflo(r.x); f[1] = bfhi(r.x); f[2] = bflo(r.y); f[3] = bfhi(r.y); f[4] = bflo(r.z); f[5] = bfhi(r.z); f[6] = bflo(r.w); f[7] = bfhi(r.w); }
__device__ __forceinline__ void ldf8(const float* p, float (&f)[8]) { const f32x4 a = *(const GAS f32x4*)p, b = *(const GAS f32x4*)(p + 4);
    f[0] = a.x; f[1] = a.y; f[2] = a.z; f[3] = a.w; f[4] = b.x; f[5] = b.y; f[6] = b.z; f[7] = b.w; }
__device__ __forceinline__ void stf8(float* p, const float (&f)[8]) { *(GAS f32x4*)p = (f32x4){f[0], f[1], f[2], f[3]}; *(GAS f32x4*)(p + 4) = (f32x4){f[4], f[5], f[6], f[7]}; }
__device__ __forceinline__ void stb8(bf16* p, const float (&f)[8]) { v4u o; o.x = pk2(f[0], f[1]); o.y = pk2(f[2], f[3]); o.z = pk2(f[4], f[5]); o.w = pk2(f[6], f[7]); *(GAS v4u*)p = o; }
__device__ __forceinline__ void za8(const bf16* Z, int row, bool hp, bool hn, int c, const float* mu, float (&o)[8]) {
    float zc[8], zp[8], zn[8], m8[8];
    ld8(Z + (size_t)row * NZ + c, zc);
    if (hp) ld8(Z + (size_t)(row - 1) * NZ + c, zp); else { _Pragma("unroll") for (int i = 0; i < 8; ++i) zp[i] = 0.f; }
    if (hn) ld8(Z + (size_t)(row + 1) * NZ + c, zn); else { _Pragma("unroll") for (int i = 0; i < 8; ++i) zn[i] = 0.f; }
    ldf8(mu + c, m8);
#pragma unroll
    for (int i = 0; i < 8; ++i) o[i] = zc[i] + m8[i] * (0.5f * (zp[i] + zn[i]) - zc[i]);
}
__device__ __forceinline__ void zero8(float (&f)[8]) {
#pragma unroll
    for (int i = 0; i < 8; ++i) f[i] = 0.f; }
__device__ __forceinline__ void cp8(float (&d)[8], const float (&s)[8]) {
#pragma unroll
    for (int i = 0; i < 8; ++i) d[i] = s[i]; }
__device__ __forceinline__ void un8(const v4u r, float (&f)[8]) { f[0] = bflo(r.x); f[1] = bfhi(r.x); f[2] = bflo(r.y); f[3] = bfhi(r.y); f[4] = bflo(r.z); f[5] = bfhi(r.z); f[6] = bflo(r.w); f[7] = bfhi(r.w); }
__device__ __forceinline__ v4u ldraw(const bf16* p, bool ok) { return ok ? *(const GAS v4u*)p : (v4u){0u, 0u, 0u, 0u}; }
__device__ __forceinline__ void p3_prep(Frame& F) {
    const bf16* Z = (const bf16*)(F.ws + WS_Z);
    bf16* KB = (bf16*)(F.ws + WS_KBUF); bf16* KKB = (bf16*)(F.ws + WS_KKBUF); bf16* RB = (bf16*)(F.ws + WS_RBUF); bf16* VB = (bf16*)(F.ws + WS_VBUF);
    bf16* AL = (bf16*)(F.ws + WS_ALORA); bf16* AG = (bf16*)(F.ws + WS_AGATE); bf16* CAT = (bf16*)(F.ws + WS_CAT);
    const float* mu = F.in[I_MU];
    const int tpb = (TT + F.G - 1) / F.G;
    const int tok0 = F.vcu * tpb, half0 = (tpb + 1) / 2;
    const int lane = pg8::mk_lane();
    for (int it = F.wave; it < 36; it += NWAVES) {
        const int type = it >> 1, hf = it & 1;
        int tA = tok0 + (hf ? half0 : 0), tB = tok0 + (hf ? tpb : half0);
        if (tB > TT) tB = TT;
        if (tA >= tB) continue;
        if (type < 14) {
            int zoff, c = 0; bool act = true;
            if (type < 12) { const int kind = type >> 2; c = (type & 3) * 512 + lane * 8; zoff = (kind == 0 ? OFF_K : (kind == 1 ? OFF_V : OFF_R)) + c; }
            else if (type == 12) { act = lane < 24; zoff = OFF_WL + (act ? lane : 0) * 8; }
            else { act = lane < 32; zoff = OFF_GL + (act ? lane : 0) * 8; }
            float m8[8], kk8[8]; ldf8(mu + zoff, m8);
            if (type < 4) ldf8(F.in[I_KK] + c, kk8); else zero8(kk8);
            const bf16* zb = Z + zoff;
            v4u rw[6];
#pragma unroll
            for (int u = 0; u < 6; ++u) { const int r = tA - 1 + u; rw[u] = ldraw(zb + (size_t)(r < 0 ? 0 : r) * NZ, r >= 0 && r < TT); }
            for (int t0 = tA; t0 < tB; t0 += 4) {
                v4u nx[4];
#pragma unroll
                for (int u = 0; u < 4; ++u) { const int r = t0 + 5 + u; nx[u] = ldraw(zb + (size_t)(r < TT ? r : 0) * NZ, r < TT); }
#pragma unroll
                for (int u = 0; u < 4; ++u) {
                    const int t = t0 + u;
                    if (t < tB) {
                        const bool isctx = t >= T; const int pos = isctx ? t - T : (t & 63);
                        const bool hp = pos > 0, hn = isctx ? (pos < CTXL - 1) : (pos < 63);
                        float zp[8], zc[8], zn[8], v[8]; un8(rw[u], zp); un8(rw[u + 1], zc); un8(rw[u + 2], zn);
#pragma unroll
                        for (int i = 0; i < 8; ++i) v[i] = zc[i] + m8[i] * (0.5f * ((hp ? zp[i] : 0.f) + (hn ? zn[i] : 0.f)) - zc[i]);
                        const size_t fo = (size_t)t * 2048 + c;
                        if (type < 4) {
                            stb8(KB + fo, v);
                            float q[8]; float ss = 0.f;
#pragma unroll
                            for (int i = 0; i < 8; ++i) { q[i] = v[i] * kk8[i]; ss += q[i] * q[i]; }
                            ss += __shfl_xor(ss, 1); ss += __shfl_xor(ss, 2); ss += __shfl_xor(ss, 4);
                            const float inv = 1.0f / fmaxf(sqrtf(ss), 1e-12f);
#pragma unroll
                            for (int i = 0; i < 8; ++i) q[i] *= inv;
                            stb8(KKB + fo, q);
                        } else if (type < 8) stb8(VB + fo, v);
                        else if (type < 12) { if (!isctx) stb8(RB + fo, v); }
                        else if (type == 12) {
                            if (lane < 32) { float o[8];
                                if (lane < 12) { _Pragma("unroll") for (int i = 0; i < 8; ++i) o[i] = tanhf(v[i]); }
                                else if (lane < 24) cp8(o, v);
                                else zero8(o);
                                stb8(AL + (size_t)t * KLORA + lane * 8, o); }
                        } else { if (!isctx && lane < 32) { float o[8];
#pragma unroll
                                for (int i = 0; i < 8; ++i) o[i] = sigm(v[i]);
                                stb8(AG + (size_t)t * KGATE + lane * 8, o); } }
                    }
                }
                rw[0] = rw[4]; rw[1] = rw[5]; rw[2] = nx[0]; rw[3] = nx[1]; rw[4] = nx[2]; rw[5] = nx[3];
            }
        } else {
            if (tA >= T) continue;
            if (tB > T) tB = T;
            const int c = (type - 14) * 512 + lane * 8;
            float w0[8], w1[8], w2[8];
            ldf8(F.in[I_CONVW] + c, w0); ldf8(F.in[I_CONVW] + 2048 + c, w1); ldf8(F.in[I_CONVW] + 4096 + c, w2);
            const bf16* zc_ = Z + OFF_CC + c; const bf16* zx_ = Z + OFF_CX + c; const bf16* zb_ = Z + OFF_CB + c;
            v4u cw[6], xw[6], bw[4];
#pragma unroll
            for (int u = 0; u < 6; ++u) { const int r = tA - 1 + u; const bool ok = r >= 0 && r < T; const size_t ro = (size_t)(ok ? r : 0) * NZ; cw[u] = ldraw(zc_ + ro, ok); xw[u] = ldraw(zx_ + ro, ok); }
#pragma unroll
            for (int u = 0; u < 4; ++u) { const int r = tA + u; const bool ok = r < T; bw[u] = ldraw(zb_ + (size_t)(ok ? r : 0) * NZ, ok); }
            for (int t0 = tA; t0 < tB; t0 += 4) {
                v4u cn[4], xn[4], bn[4];
#pragma unroll
                for (int u = 0; u < 4; ++u) { const int r = t0 + 5 + u; const bool ok = r < T; const size_t ro = (size_t)(ok ? r : 0) * NZ; cn[u] = ldraw(zc_ + ro, ok); xn[u] = ldraw(zx_ + ro, ok);
                    const int rb = t0 + 4 + u; const bool okb = rb < T; bn[u] = ldraw(zb_ + (size_t)(okb ? rb : 0) * NZ, okb); }
#pragma unroll
                for (int u = 0; u < 4; ++u) {
                    const int t = t0 + u;
                    if (t < tB) {
                        const int pos = t & 63; const bool hp = pos > 0, hn = pos < 63;
                        float cp_[8], xp_[8], cc_[8], xc_[8], cn_[8], xn_[8], bg[8], y[8];
                        un8(cw[u], cp_); un8(xw[u], xp_); un8(cw[u + 1], cc_); un8(xw[u + 1], xc_); un8(cw[u + 2], cn_); un8(xw[u + 2], xn_); un8(bw[u], bg);
#pragma unroll
                        for (int i = 0; i < 8; ++i) y[i] = bg[i] * (w0[i] * (hp ? cp_[i] * xp_[i] : 0.f) + w1[i] * (cc_[i] * xc_[i]) + w2[i] * (hn ? cn_[i] * xn_[i] : 0.f));
                        stb8(CAT + (size_t)t * D + DR + c, y);
                    }
                }
                cw[0] = cw[4]; cw[1] = cw[5]; cw[2] = cn[0]; cw[3] = cn[1]; cw[4] = cn[2]; cw[5] = cn[3];
                xw[0] = xw[4]; xw[1] = xw[5]; xw[2] = xn[0]; xw[3] = xn[1]; xw[4] = xn[2]; xw[5] = xn[3];
                bw[0] = bn[0]; bw[1] = bn[1]; bw[2] = bn[2]; bw[3] = bn[3];
            }
        }
    }
}

typedef float f32x16 __attribute__((ext_vector_type(16)));
#define MK_FENCE() asm volatile("" ::: "memory")
constexpr int REC_BYTES = 8448, NBLK = TT / 16, SCAN_LDS = REC_BYTES + 4096;
__device__ __forceinline__ void swap32(float& x, float& y) { asm volatile("s_nop 1\n\tv_permlane32_swap_b32 %0, %1\n\ts_nop 1" : "+v"(x), "+v"(y)); }
__device__ __forceinline__ int kperm(int k) { return ((((k >> 5) * 2 + ((k >> 4) & 1)) * 2 + ((k >> 2) & 1)) * 8 + ((k >> 3) & 1) * 4 + (k & 3)); }
__device__ __forceinline__ int scan_blkbase(int d, int c, int j) {
    if (c == 0) return T + (d == 0 ? 16 * j : CTXL - 16 - 16 * j);
    const int p0 = (c - 1) * CHUNK + 16 * j;
    return d == 0 ? p0 : T - 16 - p0;
}
__device__ __forceinline__ void scan_vec32(const LAS unsigned char* row, int hl, float (&f)[32]) {
#pragma unroll
    for (int q = 0; q < 4; ++q) { const v4u w = *(const LAS v4u*)(row + (q * 2 + hl) * 16);
        f[8 * q + 0] = bflo(w.x); f[8 * q + 1] = bfhi(w.x); f[8 * q + 2] = bflo(w.y); f[8 * q + 3] = bfhi(w.y); f[8 * q + 4] = bflo(w.z); f[8 * q + 5] = bfhi(w.z); f[8 * q + 6] = bflo(w.w); f[8 * q + 7] = bfhi(w.w); }
}
__device__ __forceinline__ void scan_matvec(const f32x16 (&Tt)[2][2], const float (&f)[32], float& sa) {
    float p0a = 0.f, p0b = 0.f, p1a = 0.f, p1b = 0.f;
#pragma unroll
    for (int I = 0; I < 2; ++I)
#pragma unroll
        for (int r = 0; r < 16; r += 2) { p0a += Tt[I][0][r] * f[16 * I + r]; p1a += Tt[I][1][r] * f[16 * I + r]; p0b += Tt[I][0][r + 1] * f[16 * I + r + 1]; p1b += Tt[I][1][r + 1] * f[16 * I + r + 1]; }
    float p0 = p0a + p0b, p1 = p1a + p1b;
    swap32(p0, p1);
    sa = p0 + p1;
}
__device__ __forceinline__ void scan_renorm(f32x16 (&Tt)[2][2], const LAS float* ge, int hl) {
#pragma unroll
    for (int I = 0; I < 2; ++I)
#pragma unroll
        for (int qd = 0; qd < 4; ++qd) { const f32x4 g = *(const LAS f32x4*)(ge + 32 * I + 8 * qd + 4 * hl);
#pragma unroll
            for (int e = 0; e < 4; ++e) { Tt[I][0][4 * qd + e] *= g[e]; Tt[I][1][4 * qd + e] *= g[e]; } }
}
__device__ __forceinline__ void scan_store_T(const f32x16 (&Tt)[2][2], float* dst, int lane) {
#pragma unroll
    for (int I = 0; I < 2; ++I)
#pragma unroll
        for (int J = 0; J < 2; ++J)
#pragma unroll
            for (int reg = 0; reg < 16; ++reg) *(GAS float*)(dst + (32 * I + 8 * (reg >> 2) + 4 * (lane >> 5) + (reg & 3)) * 64 + 32 * J + (lane & 31)) = Tt[I][J][reg];
}
typedef short bf16x8 __attribute__((ext_vector_type(8)));
#define MK_MFMA(a, b, c) __builtin_amdgcn_mfma_f32_32x32x16_bf16((a), (b), (c), 0, 0, 0)
constexpr int SCR_LAB = 0, SCR_LAK = 1024, SCR_MRB = 2048, SCR_MRK = 2560, SCAN_SCR = 3072;
struct RecRegs { v4u p[8]; float ge; };
__device__ __forceinline__ void scan_rload(const unsigned char* PKB, int d, int h, int tb, int lane, RecRegs& R) {
    const GAS unsigned char* rp = (const GAS unsigned char*)PKB + ((size_t)(d * 32 + h) * NBLK + (tb >> 4)) * REC_BYTES;
#pragma unroll
    for (int j = 0; j < 8; ++j) R.p[j] = *((const GAS v4u*)rp + 64 * j + lane);
    R.ge = *((const GAS float*)(rp + 8192) + lane);
}
__device__ __forceinline__ void scan_rstore(LAS unsigned char* buf, int lane, const RecRegs& R) {
#pragma unroll
    for (int j = 0; j < 8; ++j) *((LAS v4u*)buf + 64 * j + lane) = R.p[j];
    *((LAS float*)(buf + 8192) + lane) = R.ge;
}
typedef float f32x2n __attribute__((ext_vector_type(2)));
typedef __bf16 bf16x2n __attribute__((ext_vector_type(2)));
__device__ __forceinline__ unsigned cvt2bf(float a, float b) { const f32x2n v = {a, b}; return __builtin_bit_cast(unsigned, __builtin_convertvector(v, bf16x2n)); }
__device__ __forceinline__ bf16x8 pack8(float a0, float a1, float a2, float a3, float a4, float a5, float a6, float a7) {
    const v4u u = {cvt2bf(a0, a1), cvt2bf(a2, a3), cvt2bf(a4, a5), cvt2bf(a6, a7)}; return __builtin_bit_cast(bf16x8, u); }
__device__ __forceinline__ f32x16 zero16() { f32x16 z;
#pragma unroll
    for (int i = 0; i < 16; ++i) z[i] = 0.f;
    return z; }
__device__ __forceinline__ void scan_tfrags(const f32x16 (&Tt)[2][2], bf16x8 (&Tf)[2][2][2]) {
#pragma unroll
    for (int I = 0; I < 2; ++I)
#pragma unroll
        for (int J = 0; J < 2; ++J)
#pragma unroll
            for (int s = 0; s < 2; ++s) Tf[I][J][s] = pack8(Tt[I][J][8 * s], Tt[I][J][8 * s + 1], Tt[I][J][8 * s + 2], Tt[I][J][8 * s + 3], Tt[I][J][8 * s + 4], Tt[I][J][8 * s + 5], Tt[I][J][8 * s + 6], Tt[I][J][8 * s + 7]);
}
__device__ __forceinline__ void scan_sfrags(float (&S)[16], bf16x8 (&Sf)[2]) {
#pragma unroll
    for (int j = 0; j < 8; ++j) swap32(S[j], S[j + 8]);
    Sf[0] = pack8(S[0], S[1], S[2], S[3], S[4], S[5], S[6], S[7]); Sf[1] = pack8(S[8], S[9], S[10], S[11], S[12], S[13], S[14], S[15]);
}
template <int WHICH> __device__ __forceinline__ void p5_pass(Frame& F, const int unit) {
    const unsigned char* PKB = F.ws + WS_PK; const bf16* VB = (const bf16*)(F.ws + WS_VBUF);
    float* PU = (float*)(F.ws + WS_PU);
    LAS unsigned char* my = F.lds + RING_OFF + F.wave * (REC_BYTES + SCAN_SCR);
    LAS unsigned char* scr = my + REC_BYTES;
    {
        const int d = unit & 1, h = (unit >> 1) & 31, c = unit >> 6;
        constexpr int which = WHICH;
        {
            const int lane = pg8::mk_lane(), hl = lane >> 5, l31 = lane & 31, l15 = lane & 15;
            const float idv = which ? 1.0f : 0.0f;
            f32x16 Tt[2][2];
#pragma unroll
            for (int I = 0; I < 2; ++I)
#pragma unroll
                for (int J = 0; J < 2; ++J)
#pragma unroll
                    for (int reg = 0; reg < 16; ++reg) Tt[I][J][reg] = (32 * I + 8 * (reg >> 2) + 4 * hl + (reg & 3) == 32 * J + l31) ? idv : 0.0f;
            RecRegs R;
            scan_rload(PKB, d, h, scan_blkbase(d, c, 0), lane, R);
#pragma unroll 1
            for (int j = 0; j < 16; ++j) {
                const int tb = scan_blkbase(d, c, j);
                scan_rstore(my, lane, R);
                float Vv[16];
                if (which == 0) { const GAS bf16* gv = (const GAS bf16*)(VB + (size_t)(tb + (d == 0 ? 0 : 15)) * 2048 + h * 64) + lane; const int dstep = d == 0 ? 2048 : -2048;
#pragma unroll
                    for (int t = 0; t < 16; ++t) Vv[t] = __builtin_bit_cast(float, (unsigned)gv[t * dstep] << 16); }
                else {
#pragma unroll
                    for (int t = 0; t < 16; ++t) Vv[t] = 0.f; }
                const LAS unsigned char* arow = my + l15 * 128 + hl * 16;
                {   f32x16 Lab = zero16(), Lak = zero16();
#pragma unroll
                    for (int qq = 0; qq < 4; ++qq) { const bf16x8 af = *(const LAS bf16x8*)(arow + qq * 32), bf = *(const LAS bf16x8*)(arow + 4096 + qq * 32), kf = *(const LAS bf16x8*)(arow + 6144 + qq * 32);
                        Lab = MK_MFMA(af, bf, Lab); if (which == 0) Lak = MK_MFMA(af, kf, Lak); }
                    if (l31 < 16) { LAS float* lb = (LAS float*)scr + 64 * hl + l31;
#pragma unroll
                        for (int r = 0; r < 8; ++r) { const int t0 = 8 * (r >> 2) + (r & 3); lb[SCR_LAB / 4 + t0 * 16] = Lab[r]; lb[SCR_LAK / 4 + t0 * 16] = Lak[r]; } }
                }
                MK_FENCE();
                f32x16 G[2];
                {   bf16x8 Tf[2][2][2]; scan_tfrags(Tt, Tf);
                    G[0] = zero16(); G[1] = zero16();
#pragma unroll
                    for (int qq = 0; qq < 4; ++qq) { const bf16x8 af = *(const LAS bf16x8*)(arow + qq * 32);
                        G[0] = MK_MFMA(af, Tf[qq >> 1][0][qq & 1], G[0]); G[1] = MK_MFMA(af, Tf[qq >> 1][1][qq & 1], G[1]); }
                }
                MK_FENCE();
                if (j + 1 < 16) scan_rload(PKB, d, h, scan_blkbase(d, c, j + 1), lane, R);
                float S[16];
#pragma unroll
                for (int r = 0; r < 8; ++r) { float x = G[0][r], y = G[1][r]; swap32(x, y); const int t = 8 * (r >> 2) + (r & 3); S[t] = x; S[t + 4] = y; }
#pragma unroll
                for (int t = 1; t < 16; ++t) {
                    float acc = S[t], acc1 = 0.f, acc2 = 0.f, acc3 = 0.f;
#pragma unroll
                    for (int s4 = 0; s4 < (t + 3) / 4; ++s4) { const f32x4 la = *(const LAS f32x4*)(scr + SCR_LAB + (t * 16 + 4 * s4) * 4), lk = *(const LAS f32x4*)(scr + SCR_LAK + (t * 16 + 4 * s4) * 4);
#pragma unroll
                        for (int e = 0; e < 4; ++e) if (4 * s4 + e < t) { if (e & 1) acc1 += la[e] * S[4 * s4 + e]; else acc += la[e] * S[4 * s4 + e];
                            if (which == 0) { if (e & 1) acc3 += lk[e] * Vv[4 * s4 + e]; else acc2 += lk[e] * Vv[4 * s4 + e]; } } }
                    S[t] = (acc + acc1) + (acc2 + acc3);
                }
                bf16x8 Sf[2], Vf[2]; scan_sfrags(S, Sf); if (which == 0) scan_sfrags(Vv, Vf);
#pragma unroll
                for (int I = 0; I < 2; ++I) {
                    const LAS unsigned char* col = my + 4096 + (8 * hl) * 128 + kperm(32 * I + l31) * 2;
                    unsigned short bs[8], ks[8];
#pragma unroll
                    for (int e = 0; e < 8; ++e) { bs[e] = *(const LAS unsigned short*)(col + e * 128); ks[e] = *(const LAS unsigned short*)(col + 2048 + e * 128); }
                    const v4u bu = {(unsigned)bs[0] | ((unsigned)bs[1] << 16), (unsigned)bs[2] | ((unsigned)bs[3] << 16), (unsigned)bs[4] | ((unsigned)bs[5] << 16), (unsigned)bs[6] | ((unsigned)bs[7] << 16)};
                    const v4u ku = {(unsigned)ks[0] | ((unsigned)ks[1] << 16), (unsigned)ks[2] | ((unsigned)ks[3] << 16), (unsigned)ks[4] | ((unsigned)ks[5] << 16), (unsigned)ks[6] | ((unsigned)ks[7] << 16)};
                    const bf16x8 ba = __builtin_bit_cast(bf16x8, bu), ka = __builtin_bit_cast(bf16x8, ku);
                    Tt[I][0] = MK_MFMA(ba, Sf[0], Tt[I][0]); Tt[I][1] = MK_MFMA(ba, Sf[1], Tt[I][1]); if (which == 0) { Tt[I][0] = MK_MFMA(ka, Vf[0], Tt[I][0]); Tt[I][1] = MK_MFMA(ka, Vf[1], Tt[I][1]); }
                }
                scan_renorm(Tt, (const LAS float*)(my + 8192), hl);
            }
            scan_store_T(Tt, PU + ((size_t)unit * 2 + (which ? 0 : 1)) * 4096, lane);
        }
    }
}
__device__ __forceinline__ void p5_scanA(Frame& F) {
    for (int unit = F.vcu * NWAVES + F.wave; unit < 2048; unit += F.G * NWAVES) { p5_pass<0>(F, unit); if (unit >= 64) p5_pass<1>(F, unit); }
}
__device__ __forceinline__ void p6_scanB(Frame& F) {
    const GAS char* PU = (const GAS char*)(F.ws + WS_PU); GAS char* SST = (GAS char*)(F.ws + WS_SST);
    LAS float* PiB = (LAS float*)(F.lds + RING_OFF);
    LAS float* TbB = (LAS float*)(F.lds + RING_OFF + 2 * 16640);
    const int w = F.wave;
    for (int q = F.vcu; q < 64; q += F.G) {
        const unsigned lane = (unsigned)pg8::mk_lane(), tid = (unsigned)w * 64u + lane, hl = lane >> 5, l31 = lane & 31u;
        const unsigned I1 = ((unsigned)w >> 1) & 1u, J = (unsigned)w & 1u;
        {   const GAS char* u0 = PU + ((size_t)q * 2 + 1) * 16384; GAS char* so = SST + ((size_t)q * NCHUNK + 1) * 16384;
            const f32x4 t0 = *(const GAS f32x4*)(u0 + tid * 32u), t1 = *(const GAS f32x4*)(u0 + tid * 32u + 16u);
            *((LAS f32x4*)TbB + tid * 2) = t0; *((LAS f32x4*)TbB + tid * 2 + 1) = t1;
            *(GAS f32x4*)(so + tid * 32u) = t0; *(GAS f32x4*)(so + tid * 32u + 16u) = t1; }
        f32x4 pn0, pn1; f32x16 un;
        {   const GAS char* pg = PU + (((size_t)q + 64) * 2 + 0) * 16384; pn0 = *(const GAS f32x4*)(pg + tid * 32u); pn1 = *(const GAS f32x4*)(pg + tid * 32u + 16u);
            const unsigned pb = (tid >> 3) * 65u + (tid & 7u) * 8u;
#pragma unroll
            for (int e = 0; e < 4; ++e) { PiB[pb + e] = pn0[e]; PiB[pb + 4 + e] = pn1[e]; }
            const GAS char* ug = PU + (((size_t)q + 64) * 2 + 1) * 16384;
#pragma unroll
            for (int r = 0; r < 16; ++r) un[r] = (w < 4) ? *(const GAS float*)(ug + ((32u * I1 + 8u * (r >> 2) + 4u * hl + (r & 3)) * 64u + 32u * J + l31) * 4u) : 0.f; }
        __syncthreads();
        for (int c = 1; c < 32; ++c) {
            const LAS float* Pi = PiB + ((c - 1) & 1) * 4160; const LAS float* Tb = TbB + ((c - 1) & 1) * 4096;
            LAS float* PiN = PiB + (c & 1) * 4160; LAS float* TbN = TbB + (c & 1) * 4096;
            f32x16 acc = un;
            if (c + 1 < 32) {
                const GAS char* pg = PU + (((size_t)q + 64 * (c + 1)) * 2 + 0) * 16384; pn0 = *(const GAS f32x4*)(pg + tid * 32u); pn1 = *(const GAS f32x4*)(pg + tid * 32u + 16u);
                const GAS char* ug = PU + (((size_t)q + 64 * (c + 1)) * 2 + 1) * 16384;
                if (w < 4) {
#pragma unroll
                    for (int r = 0; r < 16; ++r) un[r] = *(const GAS float*)(ug + ((32u * I1 + 8u * (r >> 2) + 4u * hl + (r & 3)) * 64u + 32u * J + l31) * 4u); }
            }
            if (w < 4) {
#pragma unroll
                for (int s2 = 0; s2 < 32; ++s2) { const float av = Pi[(32u * I1 + l31) * 65u + 2u * s2 + hl], bv = Tb[(2u * s2 + hl) * 64u + 32u * J + l31];
                    acc = __builtin_amdgcn_mfma_f32_32x32x2f32(av, bv, acc, 0, 0, 0);
                    if ((s2 & 7) == 7) MK_FENCE(); }
                GAS char* so = SST + ((size_t)q * NCHUNK + c + 1) * 16384;
#pragma unroll
                for (int r = 0; r < 16; ++r) { const unsigned e = (32u * I1 + 8u * (r >> 2) + 4u * hl + (r & 3)) * 64u + 32u * J + l31; TbN[e] = acc[r]; *(GAS float*)(so + e * 4u) = acc[r]; }
            }
            if (c + 1 < 32) { const unsigned pb = (tid >> 3) * 65u + (tid & 7u) * 8u;
#pragma unroll
                for (int e = 0; e < 4; ++e) { PiN[pb + e] = pn0[e]; PiN[pb + 4 + e] = pn1[e]; } }
            __syncthreads();
        }
    }
}
__device__ __forceinline__ void p7_scanC(Frame& F) {
    const unsigned char* PKB = F.ws + WS_PK; const bf16* VB = (const bf16*)(F.ws + WS_VBUF);
    const float* SST = (const float*)(F.ws + WS_SST); bf16* YS = (bf16*)(F.ws + WS_YS);
    LAS unsigned char* my = F.lds + RING_OFF + F.wave * (REC_BYTES + SCAN_SCR);
    LAS unsigned char* scr = my + REC_BYTES;
    for (int unit = F.vcu * NWAVES + F.wave; unit < 2048; unit += F.G * NWAVES) {
        const int d = unit & 1, h = (unit >> 1) & 31, c = (unit >> 6) + 1, q = unit & 63;
        const int lane = pg8::mk_lane(), hl = lane >> 5, l31 = lane & 31, l15 = lane & 15;
        f32x16 Tt[2][2];
        {   const float* s0 = SST + ((size_t)q * NCHUNK + c) * 4096;
#pragma unroll
            for (int I = 0; I < 2; ++I)
#pragma unroll
                for (int J = 0; J < 2; ++J)
#pragma unroll
                    for (int reg = 0; reg < 16; ++reg) Tt[I][J][reg] = *(const GAS float*)(s0 + (32 * I + 8 * (reg >> 2) + 4 * hl + (reg & 3)) * 64 + 32 * J + l31); }
        RecRegs R;
        scan_rload(PKB, d, h, scan_blkbase(d, c, 0), lane, R);
#pragma unroll 1
        for (int j = 0; j < 16; ++j) {
            const int tb = scan_blkbase(d, c, j);
            scan_rstore(my, lane, R);
            float Vv[16];
            {   const GAS bf16* gv = (const GAS bf16*)(VB + (size_t)(tb + (d == 0 ? 0 : 15)) * 2048 + h * 64) + lane; const int dstep = d == 0 ? 2048 : -2048;
#pragma unroll
                for (int t = 0; t < 16; ++t) Vv[t] = __builtin_bit_cast(float, (unsigned)gv[t * dstep] << 16); }
            const LAS unsigned char* arow = my + l15 * 128 + hl * 16;
            {   f32x16 Lab = zero16(), Lak = zero16(), Mrb = zero16(), Mrk = zero16();
#pragma unroll
                for (int qq = 0; qq < 4; ++qq) { const bf16x8 af = *(const LAS bf16x8*)(arow + qq * 32), rf = *(const LAS bf16x8*)(arow + 2048 + qq * 32), bf = *(const LAS bf16x8*)(arow + 4096 + qq * 32), kf = *(const LAS bf16x8*)(arow + 6144 + qq * 32);
                    Lab = MK_MFMA(af, bf, Lab); Lak = MK_MFMA(af, kf, Lak); Mrb = MK_MFMA(rf, bf, Mrb); Mrk = MK_MFMA(rf, kf, Mrk); }
                if (l31 < 16) {
                    LAS float* lb = (LAS float*)scr + 64 * hl + l31; LAS unsigned short* mb = (LAS unsigned short*)scr + 64 * hl + l31; const int lm = l31 - 4 * hl;
#pragma unroll
                    for (int r = 0; r < 8; ++r) { const int t0 = 8 * (r >> 2) + (r & 3);
                        lb[SCR_LAB / 4 + t0 * 16] = Lab[r]; lb[SCR_LAK / 4 + t0 * 16] = Lak[r];
                        mb[SCR_MRB / 2 + t0 * 16] = (unsigned short)f2bf(lm <= t0 ? Mrb[r] : 0.f); mb[SCR_MRK / 2 + t0 * 16] = (unsigned short)f2bf(lm <= t0 ? Mrk[r] : 0.f); }
                }
            }
            MK_FENCE();
            f32x16 G[2], Y[2];
            {   bf16x8 Tf[2][2][2]; scan_tfrags(Tt, Tf);
                G[0] = zero16(); G[1] = zero16(); Y[0] = zero16(); Y[1] = zero16();
#pragma unroll
                for (int qq = 0; qq < 4; ++qq) { const bf16x8 af = *(const LAS bf16x8*)(arow + qq * 32), rf = *(const LAS bf16x8*)(arow + 2048 + qq * 32);
                    G[0] = MK_MFMA(af, Tf[qq >> 1][0][qq & 1], G[0]); G[1] = MK_MFMA(af, Tf[qq >> 1][1][qq & 1], G[1]);
                    Y[0] = MK_MFMA(rf, Tf[qq >> 1][0][qq & 1], Y[0]); Y[1] = MK_MFMA(rf, Tf[qq >> 1][1][qq & 1], Y[1]); }
            }
            MK_FENCE();
            if (j + 1 < 16) scan_rload(PKB, d, h, scan_blkbase(d, c, j + 1), lane, R);
            float S[16];
#pragma unroll
            for (int r = 0; r < 8; ++r) { float x = G[0][r], y = G[1][r]; swap32(x, y); const int t = 8 * (r >> 2) + (r & 3); S[t] = x; S[t + 4] = y; }
#pragma unroll
            for (int t = 1; t < 16; ++t) {
                float acc = S[t], acc1 = 0.f, acc2 = 0.f, acc3 = 0.f;
#pragma unroll
                for (int s4 = 0; s4 < (t + 3) / 4; ++s4) { const f32x4 la = *(const LAS f32x4*)(scr + SCR_LAB + (t * 16 + 4 * s4) * 4), lk = *(const LAS f32x4*)(scr + SCR_LAK + (t * 16 + 4 * s4) * 4);
#pragma unroll
                    for (int e = 0; e < 4; ++e) if (4 * s4 + e < t) { if (e & 1) { acc1 += la[e] * S[4 * s4 + e]; acc3 += lk[e] * Vv[4 * s4 + e]; } else { acc += la[e] * S[4 * s4 + e]; acc2 += lk[e] * Vv[4 * s4 + e]; } } }
                S[t] = (acc + acc1) + (acc2 + acc3);
            }
            bf16x8 Sf[2], Vf[2]; scan_sfrags(S, Sf); scan_sfrags(Vv, Vf);
            {   const bf16x8 mb = *(const LAS bf16x8*)(scr + SCR_MRB + l15 * 32 + hl * 16), mk = *(const LAS bf16x8*)(scr + SCR_MRK + l15 * 32 + hl * 16);
                Y[0] = MK_MFMA(mb, Sf[0], Y[0]); Y[1] = MK_MFMA(mb, Sf[1], Y[1]); Y[0] = MK_MFMA(mk, Vf[0], Y[0]); Y[1] = MK_MFMA(mk, Vf[1], Y[1]); }
#pragma unroll
            for (int I = 0; I < 2; ++I) {
                const LAS unsigned char* col = my + 4096 + (8 * hl) * 128 + kperm(32 * I + l31) * 2;
                unsigned short bs[8], ks[8];
#pragma unroll
                for (int e = 0; e < 8; ++e) { bs[e] = *(const LAS unsigned short*)(col + e * 128); ks[e] = *(const LAS unsigned short*)(col + 2048 + e * 128); }
                const v4u bu = {(unsigned)bs[0] | ((unsigned)bs[1] << 16), (unsigned)bs[2] | ((unsigned)bs[3] << 16), (unsigned)bs[4] | ((unsigned)bs[5] << 16), (unsigned)bs[6] | ((unsigned)bs[7] << 16)};
                const v4u ku = {(unsigned)ks[0] | ((unsigned)ks[1] << 16), (unsigned)ks[2] | ((unsigned)ks[3] << 16), (unsigned)ks[4] | ((unsigned)ks[5] << 16), (unsigned)ks[6] | ((unsigned)ks[7] << 16)};
                const bf16x8 ba = __builtin_bit_cast(bf16x8, bu), ka = __builtin_bit_cast(bf16x8, ku);
                Tt[I][0] = MK_MFMA(ba, Sf[0], Tt[I][0]); Tt[I][1] = MK_MFMA(ba, Sf[1], Tt[I][1]); Tt[I][0] = MK_MFMA(ka, Vf[0], Tt[I][0]); Tt[I][1] = MK_MFMA(ka, Vf[1], Tt[I][1]);
            }
            {   GAS bf16* yb = (GAS bf16*)(YS + (size_t)d * T * 2048 + (size_t)(tb + (d == 0 ? 4 * hl : 15 - 4 * hl)) * 2048 + h * 64) + l31; const int ystep = d == 0 ? 2048 : -2048;
#pragma unroll
                for (int J = 0; J < 2; ++J)
#pragma unroll
                    for (int r = 0; r < 8; ++r) yb[(8 * (r >> 2) + (r & 3)) * ystep + 32 * J] = (bf16)f2bf(Y[J][r]); }
            scan_renorm(Tt, (const LAS float*)(my + 8192), hl);
        }
    }
}

__device__ __forceinline__ void p8_readout(Frame& F) {
    const bf16* RB = (const bf16*)(F.ws + WS_RBUF); const bf16* VB = (const bf16*)(F.ws + WS_VBUF); const bf16* YS = (const bf16*)(F.ws + WS_YS);
    const bf16* KD = (const bf16*)(F.ws + WS_KD);
    const bf16* G = (const bf16*)(F.ws + WS_G); bf16* CAT = (bf16*)(F.ws + WS_CAT);
    const int tpb = (T + F.G - 1) / F.G, tok0 = F.vcu * tpb, lane = pg8::mk_lane();
    for (int it = F.wave; it < tpb * 4; it += NWAVES) {
        const int j = it / tpb, tok = tok0 + it % tpb;
        if (tok >= T) continue;
        const int c = j * 512 + lane * 8;
        float y0[8], y1[8], y[8];
        ld8(YS + (size_t)tok * 2048 + c, y0); ld8(YS + ((size_t)T + tok) * 2048 + c, y1);
        float s = 0.f;
#pragma unroll
        for (int i = 0; i < 8; ++i) { y[i] = y0[i] + y1[i]; s += y[i]; }
        s += __shfl_xor(s, 1); s += __shfl_xor(s, 2); s += __shfl_xor(s, 4);
        const float mean = s * (1.0f / 64.0f); float q = 0.f;
#pragma unroll
        for (int i = 0; i < 8; ++i) { const float dlt = y[i] - mean; q += dlt * dlt; }
        q += __shfl_xor(q, 1); q += __shfl_xor(q, 2); q += __shfl_xor(q, 4);
        const float rstd = 1.0f / sqrtf(q * (1.0f / 64.0f) + LNX_EPS);
        float r8[8], v8[8], k0[8], k1[8], rk[8], lw[8], lb[8], g8[8];
        ld8(RB + (size_t)tok * 2048 + c, r8); ld8(VB + (size_t)tok * 2048 + c, v8);
        ld8(KD + (size_t)tok * 2048 + c, k0); ld8(KD + ((size_t)TT + tok) * 2048 + c, k1);
        ldf8(F.in[I_RK] + c, rk); ldf8(F.in[I_LNXW] + c, lw); ldf8(F.in[I_LNXB] + c, lb);
        ld8(G + (size_t)tok * 2048 + c, g8);
        float dot = 0.f;
#pragma unroll
        for (int i = 0; i < 8; ++i) dot += r8[i] * (k0[i] + k1[i]) * rk[i];
        dot += __shfl_xor(dot, 1); dot += __shfl_xor(dot, 2); dot += __shfl_xor(dot, 4);
        float o[8];
#pragma unroll
        for (int i = 0; i < 8; ++i) o[i] = ((y[i] - mean) * rstd * lw[i] + lb[i] + dot * v8[i]) * g8[i];
        stb8(CAT + (size_t)tok * D + c, o);
    }
}

template <int K> __device__ __forceinline__ void run_phase(Frame& F) {
    bf16* A1 = (bf16*)(F.ws + WS_A1); bf16* Zb = (bf16*)(F.ws + WS_Z);
    const float* MV = (const float*)(F.ws + WS_MODV);
    (void)A1; (void)Zb; (void)MV;
    asm volatile("; MK_PHASE %0" :: "i"(K) : "memory");
    if constexpr (K == 0) { p0_prologue(F);
    }
    if constexpr (K == 1) { p1_norm1(F);
    }
    if constexpr (K == 2) {
        { pg8::Gemm g{A1, (const bf16*)(F.ws + WS_WIN), T, NZ, D}; pg8::StaticOrder S; S.init(T, NZ, F.G, (int)blockIdx.x);
          pg8::EpiBf16<0> E{Zb, NZ, nullptr, 0, 0, 1.f};
          pg8::gemm_phase<pg8::EpiBf16<0>, pg8::StaticOrder, true, true>(F.lds + RING_OFF, g, S, E, F.wave); }
        { pg8::Gemm g{A1 + (size_t)T * D, (const bf16*)(F.ws + WS_WIN), CTXL, NCTXZ, D}; pg8::StaticOrder S; S.init(CTXL, NCTXZ, F.G, (int)((blockIdx.x + F.G - 64) % F.G));
          pg8::EpiBf16<0> E{Zb + (size_t)T * NZ, NZ, nullptr, 0, 0, 1.f};
          pg8::gemm_phase<pg8::EpiBf16<0>, pg8::StaticOrder, true, true>(F.lds + RING_OFF, g, S, E, F.wave); }
        tr_idle(F, P2T_B, P2T_E, (int)blockIdx.x - 81, 175);
    }
    if constexpr (K == 3) { p3_prep(F);
    }
    if constexpr (K == 4) {
        { int kl = KLORA; asm volatile("" : "+s"(kl));
          pg8::Gemm g{(const bf16*)(F.ws + WS_ALORA), (const bf16*)(F.ws + WS_WLORA), TT, NLORA, kl}; pg8::StaticOrder S; S.init(TT, NLORA, F.G, (int)blockIdx.x);
          pg8::EpiLora E{F.ws + WS_PK, (bf16*)(F.ws + WS_KD), (const bf16*)(F.ws + WS_KBUF), (const bf16*)(F.ws + WS_KKBUF), (const bf16*)(F.ws + WS_RBUF), F.in[I_W0], F.in[I_A0], F.in[I_KA], TT};
          pg8::gemm_phase<pg8::EpiLora, pg8::StaticOrder, true, true>(F.lds + RING_OFF, g, S, E, F.wave); }
        { int kl = KGATE; asm volatile("" : "+s"(kl));
          pg8::Gemm g{(const bf16*)(F.ws + WS_AGATE), (const bf16*)(F.ws + WS_WGATE), T, DR, kl}; pg8::StaticOrder S;
          if (F.G == 256) S.init(T, DR, 224, blockIdx.x >= 32 ? (int)blockIdx.x - 32 : 1 << 20); else S.init(T, DR, F.G, (int)blockIdx.x);
          pg8::EpiBf16<0> E{(bf16*)(F.ws + WS_G), DR, nullptr, 0, 0, 1.f};
          pg8::gemm_phase<pg8::EpiBf16<0>, pg8::StaticOrder, true, true>(F.lds + RING_OFF, g, S, E, F.wave); }

    }
    if constexpr (K == 5) { p5_scanA(F);
    }
    if constexpr (K == 6) { p6_scanB(F); tr_idle(F, P6T_B, P6T_E, F.vcu - 64, 192);

    }
    if constexpr (K == 7) { p7_scanC(F);
    }
    if constexpr (K == 8) { p8_readout(F);
    }
    if constexpr (K == 9) {
        pg8::Gemm g{(const bf16*)(F.ws + WS_CAT), (const bf16*)(F.ws + WS_WOUT), T, D, D}; pg8::StaticOrder S; S.init(T, D, F.G, (int)blockIdx.x);
        pg8::EpiResid E{F.in[I_X], (float*)(F.ws + WS_X1), D, MV + 2 * D};
        pg8::gemm_phase<pg8::EpiResid, pg8::StaticOrder, true, true>(F.lds + RING_OFF, g, S, E, F.wave);

    }
    if constexpr (K == 10) { p10_norm2(F);
    }
    if constexpr (K == 11) {
        pg8::Gemm g{A1, (const bf16*)(F.ws + WS_WGU), T, NGU, D}; pg8::StaticOrder S; S.init(T, NGU, F.G, (int)blockIdx.x);
        pg8::EpiSwiglu E{(bf16*)(F.ws + WS_ACT), DFF};
        pg8::gemm_phase<pg8::EpiSwiglu, pg8::StaticOrder, true, true>(F.lds + RING_OFF, g, S, E, F.wave);
        tr_idle(F, P11T_B, P11T_E, (int)blockIdx.x - 192, 64);
    }
    if constexpr (K == 12) {
        pg8::Gemm g{(const bf16*)(F.ws + WS_ACT), (const bf16*)(F.ws + WS_WDN), T, D, DFF}; pg8::StaticOrder S; S.init(T, D, F.G, (int)blockIdx.x);
        pg8::EpiResid E{(const float*)(F.ws + WS_X1), F.out, D, MV + 5 * D};
        pg8::gemm_phase<pg8::EpiResid, pg8::StaticOrder, true, true>(F.lds + RING_OFF, g, S, E, F.wave);

    }
    if constexpr (K == 13) { p13_final(F);
    }
}

struct Args { const float* in[26]; float* out; unsigned char* ws; int ph_lo, ph_hi, li, pad; };
__global__ void __launch_bounds__(NWAVES * 64, 2) mk_fwd(Args args) {
    extern __shared__ __attribute__((aligned(16))) unsigned char lds[];
    Frame F;
    F.lds = (LAS unsigned char*)lds;
    F.MISC = (volatile LAS unsigned*)(F.lds + MISC_OFF);
    F.wave = __builtin_amdgcn_readfirstlane((int)(threadIdx.x >> 6));
    F.G = gridDim.x; { const int bx = blockIdx.x; F.vcu = (F.G % 8 == 0) ? (bx % 8) * (F.G / 8) + bx / 8 : bx; }
    F.ws = args.ws; F.ctl = (gu32*)(args.ws + WS_CTL); F.out = args.out;
#pragma unroll
    for (int i = 0; i < 26; ++i) F.in[i] = args.in[i];
    for (int u = threadIdx.x; u < (LDS_BYTES - LDSCTL_OFF) / 4; u += NWAVES * 64) ((LAS unsigned*)(F.lds + LDSCTL_OFF))[u] = 0u;
    __syncthreads();
    XcdBarrier bar; bar.bar = (unsigned*)(F.ctl + CW_BAR); bar.x = 0; bar.st = nullptr;
    if (N_LAUNCHES == 1) bar = xcd_barrier_post((unsigned*)(F.ctl + CW_BAR), F.MISC + 8);
#define GRID_BAR() do { if (N_LAUNCHES == 1) xcd_barrier(bar, F.wave); } while (0)
    unsigned long long tp0 = 0, tpa = 0, tpb = 0; (void)tp0;
    const int lo = args.ph_lo, hi = args.ph_hi;
#define IN(k) (lo <= (k) && (k) < hi)
#define BOTH(k) (IN(k) && IN((k) + 1))

    if (IN(0)) { if constexpr (0 == TPA || 0 == TPB) tp0 = __builtin_amdgcn_s_memrealtime(); run_phase<0>(F); if constexpr (PH_REPS[0] > 1) { GRID_BAR(); run_phase<0>(F); } if constexpr (PH_REPS[0] > 2) { GRID_BAR(); run_phase<0>(F); } if (BOTH(0)) GRID_BAR(); if constexpr (0 == TPA) tpa = __builtin_amdgcn_s_memrealtime() - tp0; if constexpr (0 == TPB) tpb = __builtin_amdgcn_s_memrealtime() - tp0; }
    if (IN(1)) { if constexpr (1 == TPA || 1 == TPB) tp0 = __builtin_amdgcn_s_memrealtime(); run_phase<1>(F); if constexpr (PH_REPS[1] > 1) { GRID_BAR(); run_phase<1>(F); } if constexpr (PH_REPS[1] > 2) { GRID_BAR(); run_phase<1>(F); } if (BOTH(1)) GRID_BAR(); if constexpr (1 == TPA) tpa = __builtin_amdgcn_s_memrealtime() - tp0; if constexpr (1 == TPB) tpb = __builtin_amdgcn_s_memrealtime() - tp0; }
    if (IN(2)) { if constexpr (2 == TPA || 2 == TPB) tp0 = __builtin_amdgcn_s_memrealtime(); run_phase<2>(F); if constexpr (PH_REPS[2] > 1) { GRID_BAR(); run_phase<2>(F); } if constexpr (PH_REPS[2] > 2) { GRID_BAR(); run_phase<2>(F); } if (BOTH(2)) GRID_BAR(); if constexpr (2 == TPA) tpa = __builtin_amdgcn_s_memrealtime() - tp0; if constexpr (2 == TPB) tpb = __builtin_amdgcn_s_memrealtime() - tp0; }
    if (IN(3)) { if constexpr (3 == TPA || 3 == TPB) tp0 = __builtin_amdgcn_s_memrealtime(); run_phase<3>(F); if constexpr (PH_REPS[3] > 1) { GRID_BAR(); run_phase<3>(F); } if constexpr (PH_REPS[3] > 2) { GRID_BAR(); run_phase<3>(F); } if (BOTH(3)) GRID_BAR(); if constexpr (3 == TPA) tpa = __builtin_amdgcn_s_memrealtime() - tp0; if constexpr (3 == TPB) tpb = __builtin_amdgcn_s_memrealtime() - tp0; }
    if (IN(4)) { if constexpr (4 == TPA || 4 == TPB) tp0 = __builtin_amdgcn_s_memrealtime(); run_phase<4>(F); if constexpr (PH_REPS[4] > 1) { GRID_BAR(); run_phase<4>(F); } if constexpr (PH_REPS[4] > 2) { GRID_BAR(); run_phase<4>(F); } if (BOTH(4)) GRID_BAR(); if constexpr (4 == TPA) tpa = __builtin_amdgcn_s_memrealtime() - tp0; if constexpr (4 == TPB) tpb = __builtin_amdgcn_s_memrealtime() - tp0; }
    if (IN(5)) { if constexpr (5 == TPA || 5 == TPB) tp0 = __builtin_amdgcn_s_memrealtime(); run_phase<5>(F); if constexpr (PH_REPS[5] > 1) { GRID_BAR(); run_phase<5>(F); } if constexpr (PH_REPS[5] > 2) { GRID_BAR(); run_phase<5>(F); } if (BOTH(5)) GRID_BAR(); if constexpr (5 == TPA) tpa = __builtin_amdgcn_s_memrealtime() - tp0; if constexpr (5 == TPB) tpb = __builtin_amdgcn_s_memrealtime() - tp0; }
    if (IN(6)) { if constexpr (6 == TPA || 6 == TPB) tp0 = __builtin_amdgcn_s_memrealtime(); run_phase<6>(F); if constexpr (PH_REPS[6] > 1) { GRID_BAR(); run_phase<6>(F); } if constexpr (PH_REPS[6] > 2) { GRID_BAR(); run_phase<6>(F); } if (BOTH(6)) GRID_BAR(); if constexpr (6 == TPA) tpa = __builtin_amdgcn_s_memrealtime() - tp0; if constexpr (6 == TPB) tpb = __builtin_amdgcn_s_memrealtime() - tp0; }
    if (IN(7)) { if constexpr (7 == TPA || 7 == TPB) tp0 = __builtin_amdgcn_s_memrealtime(); run_phase<7>(F); if constexpr (PH_REPS[7] > 1) { GRID_BAR(); run_phase<7>(F); } if constexpr (PH_REPS[7] > 2) { GRID_BAR(); run_phase<7>(F); } if (BOTH(7)) GRID_BAR(); if constexpr (7 == TPA) tpa = __builtin_amdgcn_s_memrealtime() - tp0; if constexpr (7 == TPB) tpb = __builtin_amdgcn_s_memrealtime() - tp0; }
    if (IN(8)) { if constexpr (8 == TPA || 8 == TPB) tp0 = __builtin_amdgcn_s_memrealtime(); run_phase<8>(F); if constexpr (PH_REPS[8] > 1) { GRID_BAR(); run_phase<8>(F); } if constexpr (PH_REPS[8] > 2) { GRID_BAR(); run_phase<8>(F); } if (BOTH(8)) GRID_BAR(); if constexpr (8 == TPA) tpa = __builtin_amdgcn_s_memrealtime() - tp0; if constexpr (8 == TPB) tpb = __builtin_amdgcn_s_memrealtime() - tp0; }
    if (IN(9)) { if constexpr (9 == TPA || 9 == TPB) tp0 = __builtin_amdgcn_s_memrealtime(); run_phase<9>(F); if constexpr (PH_REPS[9] > 1) { GRID_BAR(); run_phase<9>(F); } if constexpr (PH_REPS[9] > 2) { GRID_BAR(); run_phase<9>(F); } if (BOTH(9)) GRID_BAR(); if constexpr (9 == TPA) tpa = __builtin_amdgcn_s_memrealtime() - tp0; if constexpr (9 == TPB) tpb = __builtin_amdgcn_s_memrealtime() - tp0; }
    if (IN(10)) { if constexpr (10 == TPA || 10 == TPB) tp0 = __builtin_amdgcn_s_memrealtime(); run_phase<10>(F); if constexpr (PH_REPS[10] > 1) { GRID_BAR(); run_phase<10>(F); } if constexpr (PH_REPS[10] > 2) { GRID_BAR(); run_phase<10>(F); } if (BOTH(10)) GRID_BAR(); if constexpr (10 == TPA) tpa = __builtin_amdgcn_s_memrealtime() - tp0; if constexpr (10 == TPB) tpb = __builtin_amdgcn_s_memrealtime() - tp0; }
    if (IN(11)) { if constexpr (11 == TPA || 11 == TPB) tp0 = __builtin_amdgcn_s_memrealtime(); run_phase<11>(F); if constexpr (PH_REPS[11] > 1) { GRID_BAR(); run_phase<11>(F); } if constexpr (PH_REPS[11] > 2) { GRID_BAR(); run_phase<11>(F); } if (BOTH(11)) GRID_BAR(); if constexpr (11 == TPA) tpa = __builtin_amdgcn_s_memrealtime() - tp0; if constexpr (11 == TPB) tpb = __builtin_amdgcn_s_memrealtime() - tp0; }
    if (IN(12)) { if constexpr (12 == TPA || 12 == TPB) tp0 = __builtin_amdgcn_s_memrealtime(); run_phase<12>(F); if constexpr (PH_REPS[12] > 1) { GRID_BAR(); run_phase<12>(F); } if constexpr (PH_REPS[12] > 2) { GRID_BAR(); run_phase<12>(F); } if (BOTH(12)) GRID_BAR(); if constexpr (12 == TPA) tpa = __builtin_amdgcn_s_memrealtime() - tp0; if constexpr (12 == TPB) tpb = __builtin_amdgcn_s_memrealtime() - tp0; }
    if (IN(13)) { if constexpr (13 == TPA || 13 == TPB) tp0 = __builtin_amdgcn_s_memrealtime(); run_phase<13>(F); if constexpr (PH_REPS[13] > 1) { GRID_BAR(); run_phase<13>(F); } if constexpr (PH_REPS[13] > 2) { GRID_BAR(); run_phase<13>(F); } if (BOTH(13)) GRID_BAR(); if constexpr (13 == TPA) tpa = __builtin_amdgcn_s_memrealtime() - tp0; if constexpr (13 == TPB) tpb = __builtin_amdgcn_s_memrealtime() - tp0; }
    if constexpr (TPA >= 0 || TPB >= 0) {
        if (blockIdx.x == 0 && F.wave == 0) { const unsigned long long ua = (tpa + 500ull) / 1000ull, ub = (tpb + 500ull) / 1000ull, extra = ua * 100000ull + ub * 1000ull, t1 = __builtin_amdgcn_s_memrealtime();
            while (__builtin_amdgcn_s_memrealtime() - t1 < extra) __builtin_amdgcn_s_sleep(16); }
    }
#undef IN
#undef BOTH
}

extern "C" void kernel_launch(void* const* d_in, const int* in_sizes, int n_in, void* d_out, int out_size, void* d_ws, size_t ws_size, hipStream_t stream) {
    static int grid = 0;
    if (grid == 0) {
        if (n_in != 26 || out_size != T * D || ws_size < WS_END) { fprintf(stderr, "kernel_launch: unexpected shapes: n_in %d out %d ws %zu (need %zu)\n", n_in, out_size, ws_size, (size_t)WS_END); grid = -1; return; }
        int dev = 0, cus = 0, per_cu = 0;
        if (hipGetDevice(&dev) != hipSuccess || hipDeviceGetAttribute(&cus, hipDeviceAttributeMultiprocessorCount, dev) != hipSuccess) { grid = -1; return; }
        if (hipFuncSetAttribute((const void*)mk_fwd, hipFuncAttributeMaxDynamicSharedMemorySize, LDS_BYTES) != hipSuccess) { fprintf(stderr, "kernel_launch: hipFuncSetAttribute failed\n"); grid = -1; return; }
        if (hipOccupancyMaxActiveBlocksPerMultiprocessor(&per_cu, (const void*)mk_fwd, NWAVES * 64, LDS_BYTES) != hipSuccess || per_cu < 1)
            fprintf(stderr, "kernel_launch: note: occupancy query reports %d workgroups per CU\n", per_cu);
        (void)hipGetLastError();
        grid = cus;
    }
    if (grid < 0) return;
    if (hipMemsetAsync((char*)d_ws + WS_CTL, 0, CTL_ZERO_BYTES, stream) != hipSuccess) return;
    Args a{};
    for (int i = 0; i < 26; ++i) a.in[i] = (const float*)d_in[i];
    a.out = (float*)d_out; a.ws = (unsigned char*)d_ws;
    for (int li = 0; li < N_LAUNCHES; ++li) {
        if (N_LAUNCHES == 1) { a.ph_lo = 0; a.ph_hi = N_PHASES; } else { a.ph_lo = li * N_PHASES / N_LAUNCHES; a.ph_hi = (li + 1) * N_PHASES / N_LAUNCHES; }
        a.li = li;
        hipLaunchKernelGGL(mk_fwd, dim3(grid), dim3(NWAVES * 64), LDS_BYTES, stream, a);
        if (hipPeekAtLastError() != hipSuccess) break;
    }
}
```
